# Optimizing an MI355X kernel written in HIP

```python
import jax, jax.numpy as jnp
from jax import lax
import numpy as np

D_MODEL = 1024
BATCH = 1
SEQ = 16384
DEPTH = 2

CHUNK = 64
HEAD_DIM = 64
N_HEADS = D_MODEL // HEAD_DIM
DECAY_LORA = 64
AAA_LORA = 64
GATE_LORA = 128
GN_EPS = 64e-5
RMS_EPS = 1e-6
Q_BLOCK = 128
D_FF = 3584
N_EXPERTS = 8
TOP_K = 2
MOE_ROW_BLOCK = 256
N_A = (DEPTH + 1) // 2
N_B = DEPTH // 2

kernel_name = 'hybrid_rwkv7_fox_moe_trunk'


def rmsnorm(x, g):
    xf = x.astype(jnp.float32)
    y = xf * lax.rsqrt(jnp.mean(xf * xf, axis=-1, keepdims=True) + RMS_EPS)
    return (y * g).astype(x.dtype)


def swiglu(x, w_gu, w_down):
    gate, up = jnp.split(x @ w_gu, 2, axis=-1)
    return (jax.nn.silu(gate) * up) @ w_down


def rwkv7_time_mix(x, mu, w_rkv, w0, w1, w2, a0, a1, a2, g1, g2, k_k, k_a, r_k, gn_g, gn_b, w_o):
    B, T, D = x.shape
    H, N = N_HEADS, HEAD_DIM
    f32 = jnp.float32
    x_prev = jnp.pad(x, ((0, 0), (1, 0), (0, 0)))[:, :T]
    xs = x[None] + (x_prev - x)[None] * mu[:, None, None, :]
    r, k, v = jnp.einsum('nbtd,nde->nbte', xs[:3], w_rkv)
    xw, xa, xg = xs[3], xs[4], xs[5]
    w = -jax.nn.softplus(-(w0 + jnp.tanh(xw @ w1) @ w2).astype(f32)) - 0.5
    decay = jnp.exp(-jnp.exp(w))
    a = jax.nn.sigmoid((a0 + (xa @ a1) @ a2).astype(f32))
    g = jax.nn.sigmoid(xg @ g1) @ g2
    heads = lambda z: z.astype(f32).reshape(B, T, H, N)
    kk = heads(k * k_k)
    kk = kk / jnp.maximum(jnp.sqrt(jnp.sum(kk * kk, axis=-1, keepdims=True)), 1e-12)
    k_mod = k.astype(f32) * (1.0 + (a - 1.0) * k_a)
    r_h, k_h, v_h, w_h, a_h = heads(r), heads(k_mod), heads(v), heads(decay), heads(a)
    tm = lambda z: z.transpose(1, 0, 2, 3)

    def step(S, inp):
        r_t, w_t, k_t, v_t, kk_t, a_t = inp
        sa = jnp.einsum('bhij,bhj->bhi', S, -kk_t)
        S = (S * w_t[:, :, None, :] + sa[..., None] * (kk_t * a_t)[:, :, None, :]
             + v_t[..., None] * k_t[:, :, None, :])
        return S, jnp.einsum('bhij,bhj->bhi', S, r_t)

    S0 = jnp.zeros((B, H, N, N), f32)
    _, y = lax.scan(step, S0, (tm(r_h), tm(w_h), tm(k_h), tm(v_h), tm(kk), tm(a_h)))
    y = y.transpose(1, 0, 2, 3)
    mean = jnp.mean(y, axis=-1, keepdims=True)
    var = jnp.mean(jnp.square(y - mean), axis=-1, keepdims=True)
    y = ((y - mean) * lax.rsqrt(var + GN_EPS)).reshape(B, T, D) * gn_g + gn_b
    bonus = jnp.sum(r_h * k_h * r_k, axis=-1, keepdims=True) * v_h
    y = (y + bonus.reshape(B, T, D)) * g
    return y.astype(x.dtype) @ w_o


def forgetting_attention(x, w_in, b_f, q_gain, k_gain, w_o):
    B, T, D = x.shape
    H, N, QB = N_HEADS, HEAD_DIM, Q_BLOCK
    f32 = jnp.float32
    proj = x @ w_in
    q, k, v, og = jnp.split(proj[..., :4 * D], 4, axis=-1)
    log_f = jax.nn.log_sigmoid((proj[..., 4 * D:] + b_f).astype(f32))
    c = jnp.cumsum(log_f, axis=1).transpose(0, 2, 1)
    q = rmsnorm(q.reshape(B, T, H, N), q_gain).transpose(0, 2, 1, 3)
    k = rmsnorm(k.reshape(B, T, H, N), k_gain).transpose(0, 2, 1, 3)
    v = v.reshape(B, T, H, N).transpose(0, 2, 1, 3)
    nblk = T // QB
    q_blocks = q.reshape(B, H, nblk, QB, N).transpose(2, 0, 1, 3, 4)
    c_blocks = c.reshape(B, H, nblk, QB).transpose(2, 0, 1, 3)
    kpos = jnp.arange(T)
    scale = N ** -0.5

    def attend(args):
        i, q_i, c_i = args
        qpos = i * QB + jnp.arange(QB)
        s = (jnp.einsum('bhqd,bhkd->bhqk', q_i, k).astype(f32) * scale
             + (c_i[..., :, None] - c[..., None, :]))
        s = jnp.where(kpos[None, :] <= qpos[:, None], s, -jnp.inf)
        p = jax.nn.softmax(s, axis=-1)
        return jnp.einsum('bhqk,bhkd->bhqd', p.astype(v.dtype), v)

    o = lax.map(attend, (jnp.arange(nblk), q_blocks, c_blocks))
    o = o.transpose(1, 0, 3, 2, 4).reshape(B, T, D)
    return (o * jax.nn.sigmoid(og)) @ w_o


def moe_swiglu(x, w_router, w_gu, w_down):
    B, T, D = x.shape
    E, K, RB = N_EXPERTS, TOP_K, MOE_ROW_BLOCK
    xf = x.reshape(B * T, D)
    logits = (xf @ w_router).astype(jnp.float32)
    top_v, top_i = lax.top_k(logits, K)
    gates = jax.nn.softmax(top_v, axis=-1)
    A = B * T * K
    NB = -(-A // RB) + E
    flat_e = top_i.reshape(A)
    flat_tok = jnp.repeat(jnp.arange(B * T, dtype=jnp.int32), K)
    flat_w = gates.reshape(A)
    order = jnp.argsort(flat_e, stable=True)
    sorted_e = flat_e[order]
    counts = jnp.bincount(flat_e, length=E)
    padded = (counts + RB - 1) // RB * RB
    ends_pad = jnp.cumsum(padded)
    start_pad = ends_pad - padded
    start = jnp.cumsum(counts) - counts
    dest = start_pad[sorted_e] + jnp.arange(A, dtype=jnp.int32) - start[sorted_e]
    buf_tok = jnp.zeros((NB * RB,), jnp.int32).at[dest].set(flat_tok[order])
    buf_w = jnp.zeros((NB * RB,), jnp.float32).at[dest].set(flat_w[order])
    block_e = jnp.minimum(jnp.sum(jnp.arange(NB)[:, None] * RB >= ends_pad[None, :], axis=1), E - 1)

    def expert_block(args):
        e, tok, wt = args
        return swiglu(xf[tok], w_gu[e], w_down[e]).astype(jnp.float32) * wt[:, None]

    ys = lax.map(expert_block, (block_e, buf_tok.reshape(NB, RB), buf_w.reshape(NB, RB)))
    out = jnp.zeros((B * T, D), jnp.float32).at[buf_tok].add(ys.reshape(NB * RB, D))
    return out.astype(x.dtype).reshape(B, T, D)


def setup_inputs(seed: int = 0) -> dict:
    key = jax.random.key(seed)
    ks = iter(jax.random.split(key, 40))
    f32 = jnp.float32
    D, H, N, F, E = D_MODEL, N_HEADS, HEAD_DIM, D_FF, N_EXPERTS
    nrm = lambda shape, s: jax.random.normal(next(ks), shape, f32) * s
    uni = lambda shape, lo, hi: jax.random.uniform(next(ks), shape, f32, lo, hi)
    return {
        'x': nrm((BATCH, SEQ, D), 1.0),
        'norm_g': 1.0 + nrm((DEPTH, 2, D), 0.02),
        'final_g': 1.0 + nrm((D,), 0.02),
        'rwkv_mu': uni((N_A, 6, D), 0.0, 1.0),
        'rwkv_w_rkv': nrm((N_A, 3, D, D), D ** -0.5),
        'rwkv_w0': uni((N_A, D), -5.0, 1.0),
        'rwkv_w1': nrm((N_A, D, DECAY_LORA), D ** -0.5),
        'rwkv_w2': nrm((N_A, DECAY_LORA, D), 0.5 * DECAY_LORA ** -0.5),
        'rwkv_a0': nrm((N_A, D), 0.1),
        'rwkv_a1': nrm((N_A, D, AAA_LORA), D ** -0.5),
        'rwkv_a2': nrm((N_A, AAA_LORA, D), 0.5 * AAA_LORA ** -0.5),
        'rwkv_g1': nrm((N_A, D, GATE_LORA), D ** -0.5),
        'rwkv_g2': nrm((N_A, GATE_LORA, D), GATE_LORA ** -0.5),
        'rwkv_k_k': 0.85 + nrm((N_A, D), 0.02),
        'rwkv_k_a': 1.0 + nrm((N_A, D), 0.02),
        'rwkv_r_k': nrm((N_A, H, N), 0.1),
        'rwkv_gn_g': 1.0 + nrm((N_A, D), 0.02),
        'rwkv_gn_b': nrm((N_A, D), 0.02),
        'rwkv_w_o': nrm((N_A, D, D), D ** -0.5),
        'fox_w_in': nrm((N_B, D, 4 * D + H), D ** -0.5),
        'fox_b_f': uni((N_B, H), 1.0, 4.0),
        'fox_q_gain': 1.0 + nrm((N_B, N), 0.02),
        'fox_k_gain': 1.0 + nrm((N_B, N), 0.02),
        'fox_w_o': nrm((N_B, D, D), D ** -0.5),
        'ffn_w_gu': nrm((N_A, D, 2 * F), D ** -0.5),
        'ffn_w_down': nrm((N_A, F, D), F ** -0.5),
        'moe_w_router': nrm((N_B, D, E), D ** -0.5),
        'moe_w_gu': nrm((N_B, E, D, 2 * F), D ** -0.5),
        'moe_w_down': nrm((N_B, E, F, D), F ** -0.5),
    }


def reference(x, norm_g, final_g, rwkv_mu, rwkv_w_rkv, rwkv_w0, rwkv_w1, rwkv_w2, rwkv_a0, rwkv_a1,
              rwkv_a2, rwkv_g1, rwkv_g2, rwkv_k_k, rwkv_k_a, rwkv_r_k, rwkv_gn_g, rwkv_gn_b, rwkv_w_o,
              fox_w_in, fox_b_f, fox_q_gain, fox_k_gain, fox_w_o, ffn_w_gu, ffn_w_down,
              moe_w_router, moe_w_gu, moe_w_down):
    h = x
    for i in range(DEPTH):
        j = i // 2
        u = rmsnorm(h, norm_g[i, 0])
        if i % 2 == 0:
            h = h + rwkv7_time_mix(u, rwkv_mu[j], rwkv_w_rkv[j], rwkv_w0[j], rwkv_w1[j], rwkv_w2[j],
                                   rwkv_a0[j], rwkv_a1[j], rwkv_a2[j], rwkv_g1[j], rwkv_g2[j],
                                   rwkv_k_k[j], rwkv_k_a[j], rwkv_r_k[j], rwkv_gn_g[j], rwkv_gn_b[j],
                                   rwkv_w_o[j])
            u = rmsnorm(h, norm_g[i, 1])
            h = h + swiglu(u, ffn_w_gu[j], ffn_w_down[j])
        else:
            h = h + forgetting_attention(u, fox_w_in[j], fox_b_f[j], fox_q_gain[j], fox_k_gain[j],
                                         fox_w_o[j])
            u = rmsnorm(h, norm_g[i, 1])
            h = h + moe_swiglu(u, moe_w_router[j], moe_w_gu[j], moe_w_down[j])
    return rmsnorm(h, final_g)
```

```cpp
#include <hip/hip_runtime.h>
#include <cstdio>
#include <cstdint>

#ifndef LAUNCH_MODE
#define LAUNCH_MODE 1
#endif

#define GAS __attribute__((address_space(1)))
#define LAS __attribute__((address_space(3)))
typedef unsigned short bf16;
typedef short bf16x8 __attribute__((ext_vector_type(8)));
typedef float f32x4 __attribute__((ext_vector_type(4)));
typedef float f32x2 __attribute__((ext_vector_type(2)));
typedef float f32x16 __attribute__((ext_vector_type(16)));
typedef unsigned u32x4 __attribute__((ext_vector_type(4)));
typedef unsigned u32x2 __attribute__((ext_vector_type(2)));
typedef GAS unsigned gu32;
#define RLX_AGENT __ATOMIC_RELAXED, __HIP_MEMORY_SCOPE_AGENT

constexpr int T = 16384, D = 1024, NH = 16, HD = 64, FF = 3584, NE = 8, WIN_LD = 4 * D + NH;
constexpr int NWAVES = 8, NTHREADS = 512;
constexpr float RMS_EPS = 1e-6f, GN_EPS = 64e-5f;
constexpr int MOE_ROWS = (2 * T / 256 + NE) * 256;
constexpr float LOG2E = 1.4426950408889634f;

constexpr size_t MiB = 1u << 20;
constexpr size_t WS_CTL = 0, CTL_ZERO_BYTES = 1 * MiB;
constexpr size_t WS_W_RKV = 2 * MiB, WS_W_L1 = 8 * MiB, WS_W_L2 = 9 * MiB, WS_W_O0 = 11 * MiB, WS_W_GU = 13 * MiB, WS_W_DN = 27 * MiB,
                 WS_W_IN = 34 * MiB, WS_W_FO = 42 * MiB, WS_W_MGU = 44 * MiB, WS_W_MDN = 156 * MiB;
constexpr size_t WS_H = 216 * MiB;
constexpr size_t WS_UB = 280 * MiB, WS_XS = 313 * MiB;
constexpr size_t WS_KK = 280 * MiB, WS_BB = 344 * MiB;
constexpr size_t WS_Z = 280 * MiB, WS_U2 = 344 * MiB;
constexpr size_t WS_U3 = 280 * MiB, WS_Z2 = 312 * MiB, WS_U4 = 280 * MiB, WS_AM = 312 * MiB;
constexpr size_t WS_R = 410 * MiB, WS_K = 474 * MiB, WS_V = 538 * MiB;
constexpr size_t WS_ACT = 410 * MiB;
constexpr size_t WS_QKVG = 410 * MiB;
constexpr size_t WS_ACT2 = 410 * MiB;
constexpr size_t WS_LW = 602 * MiB, WS_AA = 666 * MiB, WS_G = 730 * MiB;
constexpr size_t WS_YT = 666 * MiB;
constexpr size_t WS_YS = 666 * MiB;
constexpr size_t WS_L1 = 794 * MiB;
constexpr size_t WS_CS = 802 * MiB;
constexpr size_t WS_LF = 806 * MiB, WS_C2 = 807 * MiB, WS_CB = 808 * MiB, WS_TOK = 809 * MiB;
constexpr size_t WS_END = 810 * MiB;
constexpr int CW_TMO = 0, CW_BAR = 4096, CW_CNT = 8192, CW_ATTQ = 9216;

constexpr int RING_BYTES = 131072, MISC_OFF = RING_BYTES + 320, LDS_BYTES = 147456;

__device__ __forceinline__ unsigned f2bf(float f) { unsigned u = __builtin_bit_cast(unsigned, f); return (u + 0x7fffu + ((u >> 16) & 1u)) >> 16; }
__device__ __forceinline__ unsigned pk2(float lo, float hi) { return f2bf(lo) | (f2bf(hi) << 16); }
__device__ __forceinline__ float bf2f(unsigned short b) { return __builtin_bit_cast(float, (unsigned)b << 16); }
__device__ __forceinline__ float bflo(unsigned w) { return __builtin_bit_cast(float, w << 16); }
__device__ __forceinline__ float bfhi(unsigned w) { return __builtin_bit_cast(float, w & 0xffff0000u); }
__device__ __forceinline__ float wave_sum(float v) {
#pragma unroll
    for (int o = 1; o < 64; o <<= 1) v += __shfl_xor(v, o);
    return v;
}
__device__ __forceinline__ float row16_sum(float v) {
#pragma unroll
    for (int o = 1; o < 16; o <<= 1) v += __shfl_xor(v, o);
    return v;
}
__device__ __forceinline__ float sigmoidf_(float x) { return 1.f / (1.f + __expf(-x)); }
#define LDS_WAIT() asm volatile("s_waitcnt lgkmcnt(0)" ::: "memory")

namespace pg8 {
constexpr int BM = 256, BK = 64, HALF = 128, HTB = HALF * BK * 2, STAGE_BYTES = 8 * HTB, NXCD = 8, WGM = 8;
__host__ __device__ __forceinline__ int lds_byte(int r, int c) { const int st = (r >> 4) * 2 + (c >> 5), rr = r & 15, cc = c & 31, ob = rr * 64 + cc * 2; return st * 1024 + (ob ^ (((ob >> 9) & 1) << 5)); }
__host__ __device__ __forceinline__ void stage_rc(int b, int& R, int& C) { const int st = b / 1024, sb = b % 1024, swz = sb ^ (((sb >> 9) & 1) << 5); R = (st >> 1) * 16 + swz / 64; C = (st & 1) * 32 + (swz % 64) / 2; }
__host__ __device__ __forceinline__ int perm32(int rho) { const int n = rho >> 4, i = rho & 15; return 8 * (i >> 2) + 4 * n + (i & 3); }

struct Unit { int pm, pn; };
struct Gemm { int lda, ldb, K; };

struct TileOrder {
    int nM, nN, nwg, G, c;
    __device__ __forceinline__ void init(int nM_, int nN_, int G_, int c_) { nM = nM_; nN = nN_; nwg = nM * nN; G = G_; c = c_; }
    __device__ __forceinline__ bool tile(int i, Unit& u) const {
        const long L = (long)i * G + c; if (L >= nwg) return false;
        int wgid = (int)L; { const int q = nwg / NXCD, r = nwg % NXCD, xcd = wgid % NXCD, off = wgid / NXCD; wgid = (xcd < r ? xcd * (q + 1) : r * (q + 1) + (xcd - r) * q) + off; }
        const int nig = WGM * nN, gid = wgid / nig, fm = gid * WGM, gsz = (nM - fm) < WGM ? (nM - fm) : WGM;
        u.pm = fm + ((wgid % nig) % gsz); u.pn = (wgid % nig) / gsz; return true;
    }
};

__device__ __forceinline__ unsigned cvt_pk_bf16(float lo, float hi) { unsigned r; asm volatile("v_cvt_pk_bf16_f32 %0, %1, %2" : "=v"(r) : "v"(lo), "v"(hi)); return r; }

template <class Epi, class Sched, bool ALIGN_EPI>
__device__ __forceinline__ void gemm_phase(LAS unsigned char* lds, const Gemm g, const Sched& S, const Epi& E) {
    const int tid = threadIdx.x, wid = __builtin_amdgcn_readfirstlane(tid >> 6), lane = tid & 63, wr = wid >> 2, wc = wid & 3, fr = lane & 15, fq = lane >> 4;
    const int K = g.K, nt = K / BK;
    unsigned voffA[2], voffB[2];
#pragma unroll
    for (int i = 0; i < 2; ++i) { int R, C; stage_rc(tid * 16 + i * 8192, R, C); const int Rb = Epi::PERM ? ((R & ~31) + perm32(R & 31)) : R;
        voffA[i] = (unsigned)(R * g.lda + C) * 2u; voffB[i] = (unsigned)(Rb * g.ldb + C) * 2u; }
    const size_t kstep = (size_t)(BK * 2);
    const size_t hstepA = (size_t)HALF * g.lda * 2, hstepB = (size_t)HALF * g.ldb * 2;
    const unsigned ldsw = (unsigned)wid * 1024u;
    const int aoff = lds_byte(wr * 64 + fr, fq * 8), boff = lds_byte(wc * 32 + fr, fq * 8);
#define PG8_SA(b, h) (((b) * 2 + (h)) * HTB)
#define PG8_SB(b, h) ((4 + (b) * 2 + (h)) * HTB)
#define PG8_STAGE(bufoff, gbase, voff) do { _Pragma("unroll") for (int _i = 0; _i < 2; ++_i) \
        __builtin_amdgcn_global_load_lds((const unsigned*)((const char*)(gbase) + (voff)[_i]), (LAS unsigned*)(lds + (bufoff) + ldsw + _i * 8192), 16, 0, 0); } while (0)
#define PG8_LDA(dst, b, h) do { _Pragma("unroll") for (int m = 0; m < 4; ++m) _Pragma("unroll") for (int k = 0; k < 2; ++k) dst[m][k] = *(const LAS bf16x8*)(lds + PG8_SA(b, h) + aoff + m * 2048 + k * 1024); } while (0)
#define PG8_LDB(dst, b, h) do { _Pragma("unroll") for (int n = 0; n < 2; ++n) _Pragma("unroll") for (int k = 0; k < 2; ++k) dst[n][k] = *(const LAS bf16x8*)(lds + PG8_SB(b, h) + boff + n * 2048 + k * 1024); } while (0)
#define PG8_MMA(ai, bj, At, Bt) do { __builtin_amdgcn_s_setprio(1); _Pragma("unroll") for (int m = 0; m < 4; ++m) _Pragma("unroll") for (int n = 0; n < 2; ++n) _Pragma("unroll") for (int k = 0; k < 2; ++k) \
        acc[ai][bj][m][n] = __builtin_amdgcn_mfma_f32_16x16x32_bf16(Bt[n][k], At[m][k], acc[ai][bj][m][n], 0, 0, 0); __builtin_amdgcn_s_setprio(0); } while (0)
#define PG8_WAIT_V(n) asm volatile("s_waitcnt vmcnt(" #n ")" ::: "memory")
#define PG8_WAIT_L(n) asm volatile("s_waitcnt lgkmcnt(" #n ")" ::: "memory")
#define PG8_BAR __builtin_amdgcn_s_barrier()
#define PG8_SCHED __builtin_amdgcn_sched_barrier(0)
    Unit cur, nxt; int ui = 0;
    if (!S.next(0, cur)) return;
    f32x4 acc[2][2][4][2];
#pragma unroll
    for (int a = 0; a < 2; ++a)
#pragma unroll
        for (int b = 0; b < 2; ++b)
#pragma unroll
            for (int m = 0; m < 4; ++m)
#pragma unroll
                for (int n = 0; n < 2; ++n) acc[a][b][m][n] = (f32x4){0.f, 0.f, 0.f, 0.f};
    bf16x8 At[4][2], B0[2][2], B1[2][2];
    const char* cA = S.pa(cur); const char* cB = S.pb(cur);
    PG8_STAGE(PG8_SB(0, 0), cB, voffB); PG8_STAGE(PG8_SB(0, 1), cB + hstepB, voffB); PG8_STAGE(PG8_SA(0, 0), cA, voffA); PG8_STAGE(PG8_SA(0, 1), cA + hstepA, voffA);
    if (wr == 1) PG8_BAR;
    PG8_WAIT_V(2); PG8_BAR;
    PG8_STAGE(PG8_SB(1, 0), cB + kstep, voffB); PG8_STAGE(PG8_SA(1, 0), cA + kstep, voffA); PG8_STAGE(PG8_SB(1, 1), cB + hstepB + kstep, voffB);
    PG8_WAIT_V(6); PG8_BAR;
    for (;;) {
        const bool has_next = S.next(ui + 1, nxt);
        const char* nA = has_next ? S.pa(nxt) : cA; const char* nB = has_next ? S.pb(nxt) : cB;
#pragma clang loop unroll(disable)
        for (int t = 0; t < nt; t += 2) {
            const bool last = (t == nt - 2);
            const char* a1 = cA + (size_t)(t + 1) * kstep;
            const char* a2 = last ? nA : cA + (size_t)(t + 2) * kstep; const char* b2 = last ? nB : cB + (size_t)(t + 2) * kstep;
            const char* a3 = a2 + kstep; const char* b3 = b2 + kstep;
            PG8_LDB(B0, 0, 0); PG8_LDB(B1, 0, 1); PG8_SCHED; PG8_LDA(At, 0, 0); PG8_STAGE(PG8_SA(1, 1), a1 + hstepA, voffA);
            PG8_WAIT_V(8); PG8_WAIT_L(0); PG8_BAR; PG8_MMA(0, 0, At, B0); PG8_MMA(0, 1, At, B1); PG8_BAR; PG8_SCHED;
            PG8_LDA(At, 0, 1); PG8_STAGE(PG8_SB(0, 0), b2, voffB); PG8_STAGE(PG8_SB(0, 1), b2 + hstepB, voffB); PG8_STAGE(PG8_SA(0, 0), a2, voffA);
            PG8_WAIT_V(8); PG8_WAIT_L(0); PG8_BAR; PG8_MMA(1, 0, At, B0); PG8_MMA(1, 1, At, B1); PG8_BAR; PG8_SCHED;
            PG8_LDB(B0, 1, 0); PG8_LDB(B1, 1, 1); PG8_SCHED; PG8_LDA(At, 1, 0); PG8_STAGE(PG8_SA(0, 1), a2 + hstepA, voffA);
            PG8_WAIT_V(8); PG8_WAIT_L(0); PG8_BAR; PG8_MMA(0, 0, At, B0); PG8_MMA(0, 1, At, B1); PG8_BAR; PG8_SCHED;
            PG8_LDA(At, 1, 1); PG8_STAGE(PG8_SB(1, 0), b3, voffB); PG8_STAGE(PG8_SB(1, 1), b3 + hstepB, voffB); PG8_STAGE(PG8_SA(1, 0), a3, voffA);
            PG8_WAIT_V(8); PG8_WAIT_L(0); PG8_BAR; PG8_MMA(1, 0, At, B0); PG8_MMA(1, 1, At, B1); PG8_BAR; PG8_SCHED;
        }
        if constexpr (ALIGN_EPI) { if (wr == 0) PG8_BAR; }
        E(acc, cur, wr, wc, fr, fq);
        if (!has_next) break;
#pragma unroll
        for (int a = 0; a < 2; ++a)
#pragma unroll
            for (int b = 0; b < 2; ++b)
#pragma unroll
                for (int m = 0; m < 4; ++m)
#pragma unroll
                    for (int n = 0; n < 2; ++n) acc[a][b][m][n] = (f32x4){0.f, 0.f, 0.f, 0.f};
        cur = nxt; cA = nA; cB = nB; ++ui;
        if constexpr (ALIGN_EPI) { if (wr == 1) PG8_BAR; }
    }
    PG8_WAIT_V(0);
    if constexpr (!ALIGN_EPI) { if (wr == 0) PG8_BAR; }
    PG8_BAR;
#undef PG8_SA
#undef PG8_SB
#undef PG8_STAGE
#undef PG8_LDA
#undef PG8_LDB
#undef PG8_MMA
#undef PG8_WAIT_V
#undef PG8_WAIT_L
#undef PG8_BAR
#undef PG8_SCHED
}

typedef const f32x4 (&AccRef)[2][2][4][2];

struct SchedPlain {
    TileOrder o; const char* A; const char* B; size_t astep, bstep;
    __device__ __forceinline__ bool next(int i, Unit& u) const { return o.tile(i, u); }
    __device__ __forceinline__ const char* pa(const Unit& u) const { return A + (size_t)u.pm * astep; }
    __device__ __forceinline__ const char* pb(const Unit& u) const { return B + (size_t)u.pn * bstep; }
};
struct SchedRKV {
    TileOrder o; const char* A; const char* B; size_t astep, bstep, azstride;
    __device__ __forceinline__ bool next(int i, Unit& u) const { return o.tile(i, u); }
    __device__ __forceinline__ const char* pa(const Unit& u) const { return A + (size_t)(u.pn >> 2) * azstride + (size_t)u.pm * astep; }
    __device__ __forceinline__ const char* pb(const Unit& u) const { return B + (size_t)u.pn * bstep; }
};
struct SchedMoe {
    TileOrder o; const char* A; const char* B; size_t astep, bstep, bestride; const LAS int* ends;
    __device__ __forceinline__ bool next(int i, Unit& u) const { return o.tile(i, u); }
    __device__ __forceinline__ int be(int pm) const { int e = 0;
#pragma unroll
        for (int j = 0; j < NE - 1; ++j) e += (pm >= ends[j]) ? 1 : 0; return e; }
    __device__ __forceinline__ const char* pa(const Unit& u) const { return A + (size_t)u.pm * astep; }
    __device__ __forceinline__ const char* pb(const Unit& u) const { return B + (size_t)be(u.pm) * bestride + (size_t)u.pn * bstep; }
};

struct EpiRKV {
    static constexpr bool PERM = false;
    float* C; size_t zstride;
    __device__ __forceinline__ void operator()(AccRef acc, const Unit& u, int wr, int wc, int fr, int fq) const {
        const int z = u.pn >> 2, pn = u.pn & 3; float* base = C + (size_t)z * zstride;
        const int row0 = u.pm * BM + wr * 64 + fr, col0 = pn * BM + wc * 32 + 4 * fq;
#pragma unroll
        for (int ai = 0; ai < 2; ++ai)
#pragma unroll
            for (int m = 0; m < 4; ++m) { float* rowp = base + (size_t)(row0 + ai * HALF + m * 16) * D + col0;
#pragma unroll
                for (int bj = 0; bj < 2; ++bj)
#pragma unroll
                    for (int n = 0; n < 2; ++n) *(f32x4*)(rowp + bj * HALF + n * 16) = acc[ai][bj][m][n]; }
    }
};
struct EpiRes {
    static constexpr bool PERM = false;
    const float* base; float* out;
    __device__ __forceinline__ void operator()(AccRef acc, const Unit& u, int wr, int wc, int fr, int fq) const {
        const int row0 = u.pm * BM + wr * 64 + fr, col0 = u.pn * BM + wc * 32 + 4 * fq;
#pragma unroll
        for (int ai = 0; ai < 2; ++ai)
#pragma unroll
            for (int m = 0; m < 4; ++m) { const size_t off = (size_t)(row0 + ai * HALF + m * 16) * D + col0;
#pragma unroll
                for (int bj = 0; bj < 2; ++bj)
#pragma unroll
                    for (int n = 0; n < 2; ++n) { const f32x4 b = *(const f32x4*)(base + off + bj * HALF + n * 16); *(f32x4*)(out + off + bj * HALF + n * 16) = b + acc[ai][bj][m][n]; } }
    }
};
struct EpiL1 {
    static constexpr bool PERM = true;
    bf16* O;
    __device__ __forceinline__ void operator()(AccRef acc, const Unit& u, int wr, int wc, int fr, int fq) const {
        const int row0 = u.pm * BM + wr * 64 + fr, col0 = wc * 32 + 8 * fq;
#pragma unroll
        for (int ai = 0; ai < 2; ++ai)
#pragma unroll
            for (int m = 0; m < 4; ++m) { bf16* rowp = O + (size_t)(row0 + ai * HALF + m * 16) * 256 + col0;
#pragma unroll
                for (int bj = 0; bj < 2; ++bj) { float v[8];
#pragma unroll
                    for (int i = 0; i < 4; ++i) { v[i] = acc[ai][bj][m][0][i]; v[4 + i] = acc[ai][bj][m][1][i]; }
#pragma unroll
                    for (int i = 0; i < 8; ++i) { if (bj == 1) v[i] = sigmoidf_(v[i]); else if (wc < 2) v[i] = tanhf(v[i]); }
                    u32x4 w; w.x = cvt_pk_bf16(v[0], v[1]); w.y = cvt_pk_bf16(v[2], v[3]); w.z = cvt_pk_bf16(v[4], v[5]); w.w = cvt_pk_bf16(v[6], v[7]);
                    *(u32x4*)(rowp + bj * HALF) = w; } }
    }
};
struct EpiL2 {
    static constexpr bool PERM = false;
    float* LW; const float* w0; const float* a0;
    __device__ __forceinline__ void operator()(AccRef acc, const Unit& u, int wr, int wc, int fr, int fq) const {
        const int z = u.pn >> 2, pn = u.pn & 3; float* base = LW + (size_t)z * ((WS_AA - WS_LW) / 4); const float* bias = z == 0 ? w0 : a0;
        const float mul = z == 0 ? -0.6065306597126334f : 1.f;
        const int row0 = u.pm * BM + wr * 64 + fr, col0 = pn * BM + wc * 32 + 4 * fq;
#pragma unroll
        for (int bj = 0; bj < 2; ++bj)
#pragma unroll
            for (int n = 0; n < 2; ++n) { const int c = col0 + bj * HALF + n * 16;
                const f32x4 bv = *(const f32x4*)(bias + c);
#pragma unroll
                for (int ai = 0; ai < 2; ++ai)
#pragma unroll
                    for (int m = 0; m < 4; ++m) { f32x4 v = acc[ai][bj][m][n];
                        if (z < 2) { v = v + bv;
#pragma unroll
                            for (int i = 0; i < 4; ++i) v[i] = mul * __builtin_amdgcn_rcpf(1.f + __expf(-v[i])); }
                        *(f32x4*)(base + (size_t)(row0 + ai * HALF + m * 16) * D + c) = v; } }
    }
};
struct EpiSwiGLU {
    static constexpr bool PERM = true;
    bf16* O;
    __device__ __forceinline__ void operator()(AccRef acc, const Unit& u, int wr, int wc, int fr, int fq) const {
        const int row0 = u.pm * BM + wr * 64 + fr, col0 = u.pn * HALF + wc * 32 + 8 * fq;
#pragma unroll
        for (int ai = 0; ai < 2; ++ai)
#pragma unroll
            for (int m = 0; m < 4; ++m) { float v[8];
#pragma unroll
                for (int n = 0; n < 2; ++n)
#pragma unroll
                    for (int i = 0; i < 4; ++i) { const float gt = acc[ai][0][m][n][i], up = acc[ai][1][m][n][i]; v[4 * n + i] = gt * sigmoidf_(gt) * up; }
                u32x4 w; w.x = cvt_pk_bf16(v[0], v[1]); w.y = cvt_pk_bf16(v[2], v[3]); w.z = cvt_pk_bf16(v[4], v[5]); w.w = cvt_pk_bf16(v[6], v[7]);
                *(u32x4*)(O + (size_t)(row0 + ai * HALF + m * 16) * FF + col0) = w; }
    }
};
struct EpiBf16 {
    static constexpr bool PERM = true;
    bf16* O; int ldc;
    __device__ __forceinline__ void operator()(AccRef acc, const Unit& u, int wr, int wc, int fr, int fq) const {
        const int row0 = u.pm * BM + wr * 64 + fr, col0 = u.pn * BM + wc * 32 + 8 * fq;
#pragma unroll
        for (int ai = 0; ai < 2; ++ai)
#pragma unroll
            for (int m = 0; m < 4; ++m) { bf16* rowp = O + (size_t)(row0 + ai * HALF + m * 16) * ldc + col0;
#pragma unroll
                for (int bj = 0; bj < 2; ++bj) { const f32x4 v0 = acc[ai][bj][m][0], v1 = acc[ai][bj][m][1];
                    u32x4 w; w.x = cvt_pk_bf16(v0[0], v0[1]); w.y = cvt_pk_bf16(v0[2], v0[3]); w.z = cvt_pk_bf16(v1[0], v1[1]); w.w = cvt_pk_bf16(v1[2], v1[3]);
                    *(u32x4*)(rowp + bj * HALF) = w; } }
    }
};
}

#define XB_TMO      128
#define XB_XCNT(j)  (256  + 64 * (j))
#define XB_XSUB(j)  (1280 + 64 * (j))
#define XB_XGEN(j)  (2304 + 64 * (j))
#define XB_TOP      3328
#define XB_TOPGEN   3392
#define XCD_BAR_WORDS 3456
#define XB_SPIN_CAP (1u << 18)
__device__ __forceinline__ unsigned xb_ld(unsigned* p)              { return __hip_atomic_load(p, __ATOMIC_RELAXED, __HIP_MEMORY_SCOPE_AGENT); }
__device__ __forceinline__ unsigned xb_add(unsigned* p, unsigned v) { return __hip_atomic_fetch_add(p, v, __ATOMIC_RELAXED, __HIP_MEMORY_SCOPE_AGENT); }
__device__ __forceinline__ unsigned xb_xcc_id() { return (unsigned)__builtin_amdgcn_s_getreg((3 << 11) | 20) & 0xFu; }
#define XB_SPIN(cond, bar) do { unsigned _sp = 0; while (cond) { __builtin_amdgcn_s_sleep(1); \
    if ((++_sp & 255u) == 0u) { if (xb_ld(&(bar)[XB_TMO])) break; if (_sp > XB_SPIN_CAP) { atomicAdd(&(bar)[XB_TMO], 1u); break; } } } } while (0)
struct XcdBarrier { unsigned* bar; unsigned x; volatile LAS unsigned* st; };
__device__ __forceinline__ XcdBarrier xcd_barrier_post(unsigned* bar, volatile LAS unsigned* st) {
    XcdBarrier b; b.bar = bar; b.x = xb_xcc_id(); b.st = st;
    if (threadIdx.x == 0) (void)xb_add(&bar[XB_XCNT(b.x)], 1u);
    return b;
}
__device__ __forceinline__ void xcd_barrier_complete(unsigned* bar, unsigned x, unsigned& nloc, unsigned& nx) {
    const unsigned G = gridDim.x * gridDim.y * gridDim.z;
    unsigned sum, cnt, mine, sp = 0u;
    for (;;) {
        sum = 0u; cnt = 0u; mine = 0u;
#pragma unroll
        for (unsigned j = 0; j < 16; ++j) { const unsigned c = xb_ld(&bar[XB_XCNT(j)]); sum += c; cnt += (c > 0u) ? 1u : 0u; mine = (j == x) ? c : mine; }
        if (sum == G) break;
        __builtin_amdgcn_s_sleep(1);
        if ((++sp & 255u) == 0u) { if (xb_ld(&bar[XB_TMO])) break; if (sp > XB_SPIN_CAP) { atomicAdd(&bar[XB_TMO], 1u); break; } }
    }
    nloc = mine > 0u ? mine : 1u; nx = cnt > 0u ? cnt : 1u;
}
__device__ __forceinline__ void xcd_barrier(const XcdBarrier& b) {
    asm volatile("s_waitcnt vmcnt(0)" ::: "memory");
    __syncthreads();
    if (threadIdx.x == 0) {
        unsigned* bar = b.bar;
        __builtin_amdgcn_s_waitcnt(0);
        unsigned nloc = b.st[0], nx = b.st[1];
        if (nloc == 0u) { xcd_barrier_complete(bar, b.x, nloc, nx); b.st[0] = nloc; b.st[1] = nx; }
        const unsigned old = xb_add(&bar[XB_XSUB(b.x)], 1u);
        const unsigned gen = old / nloc;
        if (old + 1u == (gen + 1u) * nloc) {
            __builtin_amdgcn_fence(__ATOMIC_RELEASE, "agent");
            asm volatile("s_waitcnt vmcnt(0)" ::: "memory");
            const unsigned og = xb_add(&bar[XB_TOP], 1u);
            const unsigned tg = og / nx;
            if (og + 1u == (tg + 1u) * nx) xb_add(&bar[XB_TOPGEN], 1u);
            else XB_SPIN(xb_ld(&bar[XB_TOPGEN]) == tg, bar);
            __builtin_amdgcn_fence(__ATOMIC_ACQUIRE, "agent");
            xb_add(&bar[XB_XGEN(b.x)], 1u);
            asm volatile("s_waitcnt vmcnt(0)" ::: "memory");
        } else {
            XB_SPIN(xb_ld(&bar[XB_XGEN(b.x)]) == gen, bar);
            __builtin_amdgcn_fence(__ATOMIC_ACQUIRE, "agent");
            asm volatile("s_waitcnt vmcnt(0)" ::: "memory");
        }
    }
    __syncthreads();
}

struct Args { const float* in[29]; float* out; unsigned char* ws; int ph_lo, ph_hi; };
struct Frame {
    LAS unsigned char* lds; gu32* ctl; unsigned char* ws;
    int tid, lane, wave, vcu, G, gw, NGW;
};

struct Row { f32x4 v[4]; };
__device__ __forceinline__ Row ld_row(const float* p, int lane) { Row r; const f32x4* q = (const f32x4*)p + lane;
#pragma unroll
    for (int j = 0; j < 4; ++j) r.v[j] = q[64 * j]; return r; }
__device__ __forceinline__ void st_row(float* p, int lane, const Row& r) { f32x4* q = (f32x4*)p + lane;
#pragma unroll
    for (int j = 0; j < 4; ++j) q[64 * j] = r.v[j]; }
__device__ __forceinline__ void st_row_bf16(bf16* p, int lane, const Row& r) { u32x2* q = (u32x2*)p + lane;
#pragma unroll
    for (int j = 0; j < 4; ++j) { u32x2 w; w.x = pk2(r.v[j][0], r.v[j][1]); w.y = pk2(r.v[j][2], r.v[j][3]); q[64 * j] = w; } }
__device__ __forceinline__ Row ld_row_bf16(const bf16* p, int lane) { Row r; const u32x2* q = (const u32x2*)p + lane;
#pragma unroll
    for (int j = 0; j < 4; ++j) { const u32x2 w = q[64 * j]; r.v[j] = (f32x4){bflo(w.x), bfhi(w.x), bflo(w.y), bfhi(w.y)}; } return r; }
__device__ __forceinline__ float row_sumsq(const Row& r) { float s = 0.f;
#pragma unroll
    for (int j = 0; j < 4; ++j) s += (r.v[j][0] * r.v[j][0] + r.v[j][1] * r.v[j][1]) + (r.v[j][2] * r.v[j][2] + r.v[j][3] * r.v[j][3]); return wave_sum(s); }
__device__ __forceinline__ Row rmsnorm_row(const Row& x, const Row& g) { const float rs = rsqrtf(row_sumsq(x) * (1.f / D) + RMS_EPS); Row y;
#pragma unroll
    for (int j = 0; j < 4; ++j) y.v[j] = x.v[j] * rs * g.v[j]; return y; }

__device__ __forceinline__ void tr_item(const float* W, int ldw, int k0, int n0, bf16* WT, int ldt, int drow0, int dcol0, const float* sc, int scmode, LAS float* scr, int lane) {
#pragma unroll 8
    for (int i = 0; i < 32; ++i) { const int kk = 2 * i + (lane >> 5); float v = W[(size_t)(k0 + kk) * ldw + n0 + (lane & 31)];
        if (scmode == 1) v *= sc[k0 + kk]; else if (scmode == 2) v *= (1.f - sc[k0 + kk]);
        scr[kk * 33 + (lane & 31)] = v; }
    LDS_WAIT(); asm volatile("" ::: "memory");
    const int c = lane & 7;
#pragma unroll
    for (int j = 0; j < 4; ++j) { const int n = (lane >> 3) + 8 * j; const LAS float* s = scr + (8 * c) * 33 + n;
        u32x4 o; o.x = pk2(s[0 * 33], s[1 * 33]); o.y = pk2(s[2 * 33], s[3 * 33]); o.z = pk2(s[4 * 33], s[5 * 33]); o.w = pk2(s[6 * 33], s[7 * 33]);
        *(GAS u32x4*)(WT + (size_t)(drow0 + n0 + n) * ldt + dcol0 + k0 + 8 * c) = o; }
    LDS_WAIT(); asm volatile("" ::: "memory");
}
__device__ __forceinline__ int gu_row(int n) { return n < FF ? 256 * (n >> 7) + (n & 127) : 256 * ((n - FF) >> 7) + 128 + ((n - FF) & 127); }

__device__ __forceinline__ void p0_prologue(Frame& F, const Args& a) {
    LAS float* scr = (LAS float*)(F.lds + F.wave * 16384);
    unsigned char* ws = F.ws;
    constexpr int I_SQ = 16 * 32;
    constexpr int I_RKV = 3 * I_SQ, I_L1 = 2 * 16 * 8, I_L2 = 4 * 32, I_GU = 16 * 224, I_DN = 56 * 32, I_IN = 16 * 128;
    constexpr int NITEMS = I_RKV + I_L1 + I_L2 + I_SQ + I_GU + I_DN + I_IN + I_SQ + NE * I_GU + NE * I_DN;
    for (int it = F.gw; it < NITEMS; it += F.NGW) {
        int r = it;
        if (r < I_RKV) { const int z = r / I_SQ, q = r % I_SQ; tr_item(a.in[4] + (size_t)z * D * D, D, 64 * (q / 32), 32 * (q % 32), (bf16*)(ws + WS_W_RKV) + (size_t)z * D * D, D, 0, 0, nullptr, 0, scr, F.lane); continue; } r -= I_RKV;
        if (r < I_L1) {
            const int half = r / 128, q = r % 128, kb = q / 8, nb = q % 8, n0 = 32 * nb;
            const float* W; int ldw, nn0, mi;
            if (n0 < 64) { W = a.in[6]; ldw = 64; nn0 = n0; mi = 3; } else if (n0 < 128) { W = a.in[9]; ldw = 64; nn0 = n0 - 64; mi = 4; } else { W = a.in[11]; ldw = 128; nn0 = n0 - 128; mi = 5; }
            tr_item(W, ldw, 64 * kb, nn0, (bf16*)(ws + WS_W_L1), 2 * D, n0 - nn0, half * D, a.in[3] + mi * D, half == 0 ? 1 : 2, scr, F.lane); continue; } r -= I_L1;
        if (r < I_L2) {
            const int part = r / 32, nb = r % 32;
            if (part == 0) tr_item(a.in[7], D, 0, 32 * nb, (bf16*)(ws + WS_W_L2), 256, 0, 0, nullptr, 0, scr, F.lane);
            else if (part == 1) tr_item(a.in[10], D, 0, 32 * nb, (bf16*)(ws + WS_W_L2), 256, D, 64, nullptr, 0, scr, F.lane);
            else tr_item(a.in[12], D, 64 * (part - 2), 32 * nb, (bf16*)(ws + WS_W_L2), 256, 2 * D, 128, nullptr, 0, scr, F.lane);
            continue; } r -= I_L2;
        if (r < I_SQ) { tr_item(a.in[18], D, 64 * (r / 32), 32 * (r % 32), (bf16*)(ws + WS_W_O0), D, 0, 0, nullptr, 0, scr, F.lane); continue; } r -= I_SQ;
        if (r < I_GU) { const int kb = r / 224, nb = r % 224; tr_item(a.in[24], 2 * FF, 64 * kb, 32 * nb, (bf16*)(ws + WS_W_GU), D, gu_row(32 * nb) - 32 * nb, 0, nullptr, 0, scr, F.lane); continue; } r -= I_GU;
        if (r < I_DN) { tr_item(a.in[25], D, 64 * (r / 32), 32 * (r % 32), (bf16*)(ws + WS_W_DN), FF, 0, 0, nullptr, 0, scr, F.lane); continue; } r -= I_DN;
        if (r < I_IN) { tr_item(a.in[19], WIN_LD, 64 * (r / 128), 32 * (r % 128), (bf16*)(ws + WS_W_IN), D, 0, 0, nullptr, 0, scr, F.lane); continue; } r -= I_IN;
        if (r < I_SQ) { tr_item(a.in[23], D, 64 * (r / 32), 32 * (r % 32), (bf16*)(ws + WS_W_FO), D, 0, 0, nullptr, 0, scr, F.lane); continue; } r -= I_SQ;
        if (r < NE * I_GU) { const int e = r / I_GU, q = r % I_GU, kb = q / 224, nb = q % 224;
            tr_item(a.in[27] + (size_t)e * D * 2 * FF, 2 * FF, 64 * kb, 32 * nb, (bf16*)(ws + WS_W_MGU) + (size_t)e * 2 * FF * D, D, gu_row(32 * nb) - 32 * nb, 0, nullptr, 0, scr, F.lane); continue; } r -= NE * I_GU;
        { const int e = r / I_DN, q = r % I_DN; tr_item(a.in[28] + (size_t)e * FF * D, D, 64 * (q / 32), 32 * (q % 32), (bf16*)(ws + WS_W_MDN) + (size_t)e * D * FF, FF, 0, 0, nullptr, 0, scr, F.lane); }
    }
    for (int i = F.gw * 64 + F.lane; i < 3 * D * 32; i += F.NGW * 64) { const int row = i >> 5, ch = i & 31, part = row / D, k = ch * 8;
        const bool nz = part == 0 ? (k < 64) : (part == 1 ? (k >= 64 && k < 128) : (k >= 128));
        if (!nz) *(GAS u32x4*)((bf16*)(ws + WS_W_L2) + (size_t)row * 256 + k) = (u32x4){0u, 0u, 0u, 0u}; }
}

__device__ __forceinline__ void p1_shift(Frame& F, const Args& a) {
    const int lane = F.lane; const float* x = a.in[0];
    bf16* UB = (bf16*)(F.ws + WS_UB); bf16* XS = (bf16*)(F.ws + WS_XS);
    const Row g0 = ld_row(a.in[1], lane);
    const int RPW = T / (256 * NWAVES);
    for (int t0 = F.gw * RPW; t0 < T; t0 += F.NGW * RPW) {
        Row prev;
        if (t0 > 0) prev = rmsnorm_row(ld_row(x + (size_t)(t0 - 1) * D, lane), g0);
        else { for (int j = 0; j < 4; ++j) prev.v[j] = (f32x4){0.f, 0.f, 0.f, 0.f}; st_row_bf16(UB, lane, prev); }
        for (int t = t0; t < t0 + RPW; ++t) {
            const Row u = rmsnorm_row(ld_row(x + (size_t)t * D, lane), g0);
            st_row_bf16(UB + (size_t)(t + 1) * D, lane, u);
#pragma unroll
            for (int n = 0; n < 3; ++n) { const Row mu = ld_row(a.in[3] + n * D, lane); Row o;
#pragma unroll
                for (int j = 0; j < 4; ++j) o.v[j] = u.v[j] + (prev.v[j] - u.v[j]) * mu.v[j];
                st_row_bf16(XS + (size_t)n * T * D + (size_t)t * D, lane, o); }
            prev = u;
        }
    }
}

__device__ __forceinline__ void p4_derive(Frame& F, const Args& a) {
    const int lane = F.lane;
    float* R = (float*)(F.ws + WS_R); float* K = (float*)(F.ws + WS_K); float* LW = (float*)(F.ws + WS_LW); float* AA = (float*)(F.ws + WS_AA);
    float* KK = (float*)(F.ws + WS_KK); float* BB = (float*)(F.ws + WS_BB); float* CS = (float*)(F.ws + WS_CS);
    const Row k_k = ld_row(a.in[13], lane), k_a = ld_row(a.in[14], lane), r_k = ld_row(a.in[15], lane);
    for (int t = F.gw; t < T; t += F.NGW) {
        const size_t o = (size_t)t * D;
        Row r = ld_row(R + o, lane), k = ld_row(K + o, lane), lw = ld_row(LW + o, lane), aa = ld_row(AA + o, lane), kk, bb, km, dec;
        float c1[4], c2[4], c3[4];
#pragma unroll
        for (int j = 0; j < 4; ++j) {
            kk.v[j] = k.v[j] * k_k.v[j];
            float ss = (kk.v[j][0] * kk.v[j][0] + kk.v[j][1] * kk.v[j][1]) + (kk.v[j][2] * kk.v[j][2] + kk.v[j][3] * kk.v[j][3]);
            ss = row16_sum(ss);
            const float inv = 1.f / fmaxf(sqrtf(ss), 1e-12f);
            kk.v[j] = kk.v[j] * inv;
            bb.v[j] = kk.v[j] * aa.v[j];
            km.v[j] = k.v[j] * (1.f + (aa.v[j] - 1.f) * k_a.v[j]);
#pragma unroll
            for (int i = 0; i < 4; ++i) dec.v[j][i] = __expf(lw.v[j][i]);
            float s1 = 0.f, s2 = 0.f, s3 = 0.f;
#pragma unroll
            for (int i = 0; i < 4; ++i) { s1 += bb.v[j][i] * r.v[j][i]; const float kr = km.v[j][i] * r.v[j][i]; s2 += kr; s3 += kr * r_k.v[j][i]; }
            c1[j] = row16_sum(s1); c2[j] = row16_sum(s2); c3[j] = row16_sum(s3);
            r.v[j] = r.v[j] * dec.v[j];
        }
        st_row(R + o, lane, r); st_row(K + o, lane, km); st_row(LW + o, lane, dec); st_row(KK + o, lane, kk); st_row(BB + o, lane, bb);
        if ((lane & 15) == 0) {
#pragma unroll
            for (int j = 0; j < 4; ++j) { const int h = 4 * j + (lane >> 4); CS[(size_t)t * 16 + h] = c1[j]; CS[(size_t)T * 16 + (size_t)t * 16 + h] = c2[j]; CS[(size_t)2 * T * 16 + (size_t)t * 16 + h] = c3[j]; }
        }
    }
}

__device__ __forceinline__ float dpp_row_allsum(float x) {
    int v = __builtin_bit_cast(int, x);
    x += __builtin_bit_cast(float, __builtin_amdgcn_update_dpp(0, v, 0xB1, 0xF, 0xF, true)); v = __builtin_bit_cast(int, x);
    x += __builtin_bit_cast(float, __builtin_amdgcn_update_dpp(0, v, 0x4E, 0xF, 0xF, true)); v = __builtin_bit_cast(int, x);
    x += __builtin_bit_cast(float, __builtin_amdgcn_update_dpp(0, v, 0x141, 0xF, 0xF, true)); v = __builtin_bit_cast(int, x);
    x += __builtin_bit_cast(float, __builtin_amdgcn_update_dpp(0, v, 0x140, 0xF, 0xF, true));
    return x;
}
__device__ __forceinline__ float wave_allsum_fast(float x) {
    x = dpp_row_allsum(x);
    const int v = __builtin_bit_cast(int, x);
    const float a = __builtin_bit_cast(float, __builtin_amdgcn_readlane(v, 0)), b = __builtin_bit_cast(float, __builtin_amdgcn_readlane(v, 16)),
                c = __builtin_bit_cast(float, __builtin_amdgcn_readlane(v, 32)), d = __builtin_bit_cast(float, __builtin_amdgcn_readlane(v, 48));
    return (a + b) + (c + d);
}
__device__ __forceinline__ void p5_scan(Frame& F) {
    if (F.wave >= 4) return;
    const int lane = F.lane;
    const float* KK = (const float*)(F.ws + WS_KK); const float* RW = (const float*)(F.ws + WS_R); const float* DEC = (const float*)(F.ws + WS_LW);
    const float* BB = (const float*)(F.ws + WS_BB); const float* KM = (const float*)(F.ws + WS_K); const float* V = (const float*)(F.ws + WS_V);
    const float* CS = (const float*)(F.ws + WS_CS); float* YT = (float*)(F.ws + WS_YT);
    for (int rho = F.vcu * 4 + F.wave; rho < D; rho += F.G * 4) {
        const int h = rho >> 6;
        const size_t col = (size_t)h * 64 + lane;
        float s = 0.f, ybuf = 0.f;
        constexpr int U = 8;
        float ik[2][U], ir[2][U], iw[2][U], ib[2][U], im[2][U], iv[2][U], i1[2][U], i2[2][U];
#define SCAN_LOAD(buf, tb) do { _Pragma("unroll") for (int u_ = 0; u_ < U; ++u_) { const size_t o_ = (size_t)((tb) + u_) * D; \
            ik[buf][u_] = KK[o_ + col]; ir[buf][u_] = RW[o_ + col]; iw[buf][u_] = DEC[o_ + col]; ib[buf][u_] = BB[o_ + col]; im[buf][u_] = KM[o_ + col]; \
            iv[buf][u_] = V[o_ + rho]; i1[buf][u_] = CS[(size_t)((tb) + u_) * 16 + h]; i2[buf][u_] = CS[(size_t)T * 16 + (size_t)((tb) + u_) * 16 + h]; } } while (0)
#define SCAN_STEPS(buf, tb) do { _Pragma("unroll") for (int u_ = 0; u_ < U; ++u_) { \
            const float p1 = wave_allsum_fast(s * ik[buf][u_]); const float p2 = wave_allsum_fast(s * ir[buf][u_]); \
            const float sa = -p1; const float y = p2 + sa * i1[buf][u_] + iv[buf][u_] * i2[buf][u_]; \
            s = s * iw[buf][u_] + sa * ib[buf][u_] + iv[buf][u_] * im[buf][u_]; \
            if (lane == (((tb) + u_) & 63)) ybuf = y; } } while (0)
        SCAN_LOAD(0, 0);
        for (int t0 = 0; t0 < T; t0 += 2 * U) {
            SCAN_LOAD(1, t0 + U);
            SCAN_STEPS(0, t0);
            if (t0 + 2 * U < T) SCAN_LOAD(0, t0 + 2 * U);
            SCAN_STEPS(1, t0 + U);
            if (((t0 + 2 * U) & 63) == 0) YT[(size_t)rho * T + (t0 + 2 * U - 64) + lane] = ybuf;
        }
#undef SCAN_LOAD
#undef SCAN_STEPS
    }
}

__device__ __forceinline__ void p6_gn(Frame& F, const Args& a) {
    const int lane = F.lane, wave = F.wave;
    const float* YT = (const float*)(F.ws + WS_YT); const float* V = (const float*)(F.ws + WS_V); const float* G = (const float*)(F.ws + WS_G);
    const float* C3 = (const float*)(F.ws + WS_CS) + (size_t)2 * T * 16; bf16* Z = (bf16*)(F.ws + WS_Z);
    LAS float* tile = (LAS float*)F.lds;
    for (int unit = F.vcu; unit < NH * (T / 64); unit += F.G) {
        const int h = unit / (T / 64), t0 = (unit % (T / 64)) * 64;
        __syncthreads();
#pragma unroll
        for (int q = 0; q < 8; ++q) { const int i = wave * 8 + q; tile[i * 65 + lane] = YT[(size_t)(h * 64 + i) * T + t0 + lane]; }
        __syncthreads();
        const float gg = a.in[16][h * 64 + lane], gb = a.in[17][h * 64 + lane];
#pragma unroll
        for (int q = 0; q < 8; ++q) { const int tt = wave * 8 + q, t = t0 + tt;
            const float y = tile[lane * 65 + tt];
            const float mean = wave_sum(y) * (1.f / 64.f); const float dlt = y - mean; const float var = wave_sum(dlt * dlt) * (1.f / 64.f);
            const size_t o = (size_t)t * D + h * 64 + lane;
            const float z = (dlt * rsqrtf(var + GN_EPS) * gg + gb + C3[(size_t)t * 16 + h] * V[o]) * G[o];
            Z[o] = (bf16)f2bf(z); }
    }
    __syncthreads();
}

__device__ __forceinline__ void p8_norm(Frame& F, const float* g, bf16* U) {
    const float* Hs = (const float*)(F.ws + WS_H); const Row gr = ld_row(g, F.lane);
    for (int t = F.gw; t < T; t += F.NGW) st_row_bf16(U + (size_t)t * D, F.lane, rmsnorm_row(ld_row(Hs + (size_t)t * D, F.lane), gr));
}
__device__ __forceinline__ void p11_norm_forget(Frame& F, const Args& a) {
    const int lane = F.lane; const float* Hs = (const float*)(F.ws + WS_H); bf16* U = (bf16*)(F.ws + WS_U3); float* LF = (float*)(F.ws + WS_LF);
    LAS float* wf = (LAS float*)F.lds;
    __syncthreads();
    for (int i = F.tid; i < 16 * D; i += NTHREADS) { const int hh = i & 15, k = i >> 4; wf[hh * D + k] = a.in[19][(size_t)k * WIN_LD + 4 * D + hh]; }
    __syncthreads();
    const Row gr = ld_row(a.in[1] + 2 * D, lane);
    for (int t = F.gw; t < T; t += F.NGW) {
        const Row u = rmsnorm_row(ld_row(Hs + (size_t)t * D, lane), gr);
        st_row_bf16(U + (size_t)t * D, lane, u);
        float mine = 0.f;
#pragma unroll 2
        for (int hh = 0; hh < 16; ++hh) { float s = 0.f;
#pragma unroll
            for (int j = 0; j < 4; ++j) { const f32x4 w = *(const LAS f32x4*)(wf + hh * D + 256 * j + 4 * lane); s += (u.v[j][0] * w[0] + u.v[j][1] * w[1]) + (u.v[j][2] * w[2] + u.v[j][3] * w[3]); }
            s = wave_sum(s); if (lane == hh) mine = s; }
        if (lane < 16) { const float x = mine + a.in[20][lane]; LF[(size_t)t * 16 + lane] = fminf(x, 0.f) - log1pf(__expf(-fabsf(x))); }
    }
    __syncthreads();
}
__device__ __forceinline__ void p13_cumsum_qknorm(Frame& F, const Args& a) {
    const int lane = F.lane, tid = F.tid;
    const float* LF = (const float*)(F.ws + WS_LF); float* C2 = (float*)(F.ws + WS_C2); float* CB = (float*)(F.ws + WS_CB);
    if (F.vcu < NH) {
        const int h = F.vcu; LAS double* part = (LAS double*)F.lds;
        __syncthreads();
        const int tb = tid * 32; double s = 0.0;
        for (int i = 0; i < 32; ++i) s += (double)LF[(size_t)(tb + i) * 16 + h];
        part[tid] = s; __syncthreads();
        if (tid == 0) { double run = 0.0; for (int i = 0; i < NTHREADS; ++i) { const double v = part[i]; part[i] = run; run += v; } }
        __syncthreads();
        double run = part[tid];
        for (int i = 0; i < 32; ++i) { run += (double)LF[(size_t)(tb + i) * 16 + h]; const float c = (float)(run * 1.4426950408889634); C2[(size_t)h * T + tb + i] = c; if (((tb + i) & 63) == 63) CB[h * 256 + ((tb + i) >> 6)] = c; }
        __syncthreads();
    }
    bf16* Q = (bf16*)(F.ws + WS_QKVG);
    f32x4 gq[4], gk[4];
#pragma unroll
    for (int j = 0; j < 4; ++j) { const int c = (4 * lane + 256 * j) & 63; gq[j] = *(const f32x4*)(a.in[21] + c) * (0.125f * LOG2E); gk[j] = *(const f32x4*)(a.in[22] + c); }
    for (int t = F.gw; t < T; t += F.NGW) {
#pragma unroll
        for (int which = 0; which < 2; ++which) {
            bf16* p = Q + (size_t)t * 4096 + which * D;
            Row x = ld_row_bf16(p, lane);
#pragma unroll
            for (int j = 0; j < 4; ++j) { float ss = (x.v[j][0] * x.v[j][0] + x.v[j][1] * x.v[j][1]) + (x.v[j][2] * x.v[j][2] + x.v[j][3] * x.v[j][3]); ss = row16_sum(ss);
                const float rs = rsqrtf(ss * (1.f / 64.f) + RMS_EPS); x.v[j] = x.v[j] * rs * (which == 0 ? gq[j] : gk[j]); }
            st_row_bf16(p, lane, x);
        }
    }
}

__device__ __forceinline__ int crow(int r, int hi) { return (r & 3) + 8 * (r >> 2) + 4 * hi; }
constexpr int KP = 144;
__device__ __forceinline__ void p14_attention(Frame& F, const Args& a) {
    const int tid = F.tid, lane = F.lane, wid = F.wave, r32 = lane & 31, hi = lane >> 5;
    const bf16* QKVG = (const bf16*)(F.ws + WS_QKVG); const float* C2 = (const float*)(F.ws + WS_C2); const float* CB = (const float*)(F.ws + WS_CB);
    bf16* Z2 = (bf16*)(F.ws + WS_Z2);
    LAS unsigned char* Ks = F.lds; LAS unsigned char* Vs = F.lds + 64 * KP; LAS float* bias = (LAS float*)(F.lds + 2 * 64 * KP); LAS int* uslot = (LAS int*)(F.lds + 2 * 64 * KP + 256);
    float mq = 0.f, mk = 0.f;
    for (int i = 0; i < 64; ++i) { mq = fmaxf(mq, fabsf(a.in[21][i])); mk = fmaxf(mk, fabsf(a.in[22][i])); }
    const float THR2 = (2.f * 8.f * mq * mk * 1.01f + 30.f) * LOG2E;
    gu32* qctr = F.ctl + CW_ATTQ;
    for (;;) {
        __syncthreads();
        if (tid == 0) uslot[0] = (int)__hip_atomic_fetch_add(qctr, 1u, RLX_AGENT);
        __syncthreads();
        const int unit = uslot[0];
        if (unit >= NH * (T / 256)) break;
        const int h = unit & 15, qb = (T / 256 - 1) - (unit >> 4), q0 = qb * 256;
        const float ct0 = C2[(size_t)h * T + q0];
        int jstart = 0;
        { int tot = 0; for (int j0 = 0; j0 < 4 * qb; j0 += 64) { const int j = j0 + lane; const bool skip = (j < 4 * qb) && ((ct0 - CB[h * 256 + j]) < -THR2); tot += __popcll(__ballot(skip)); } jstart = tot; }
        const int jend = 4 * qb + 3;
        const int qrow = q0 + wid * 32 + r32;
        bf16x8 qr[4];
#pragma unroll
        for (int d0 = 0; d0 < 4; ++d0) qr[d0] = *(const bf16x8*)(QKVG + (size_t)qrow * 4096 + h * 64 + d0 * 16 + hi * 8);
        f32x16 o0 = {}, o1 = {}; float m = -INFINITY, l = 0.f;
        const int lrow = tid >> 3, lch = tid & 7;
        u32x4 kreg, vreg; float breg = 0.f;
        auto gload = [&](int j) { const size_t row = (size_t)(64 * j + lrow) * 4096 + h * 64 + lch * 8;
            kreg = *(const u32x4*)(QKVG + row + D); vreg = *(const u32x4*)(QKVG + row + 2 * D); if (tid < 64) breg = -C2[(size_t)h * T + 64 * j + tid]; };
        gload(jstart);
        for (int j = jstart; j <= jend; ++j) {
            __syncthreads();
            *(LAS u32x4*)(Ks + lrow * KP + lch * 16) = kreg;
            { const int s_ = lrow >> 4, x_ = lrow & 15, p_ = s_ * 16 + ((x_ >> 2) & 1) * 8 + (((x_ >> 3) << 2) | (x_ & 3));
                const unsigned w_[4] = {vreg.x, vreg.y, vreg.z, vreg.w};
#pragma unroll
                for (int e = 0; e < 8; ++e) *(LAS unsigned short*)(Vs + (lch * 8 + e) * KP + p_ * 2) = (unsigned short)(w_[e >> 1] >> ((e & 1) * 16)); }
            if (tid < 64) bias[tid] = breg;
            __syncthreads();
            if (j < jend) gload(j + 1);
            f32x16 p0 = {}, p1 = {};
#pragma unroll
            for (int d0 = 0; d0 < 4; ++d0) {
                const bf16x8 k0 = *(const LAS bf16x8*)(Ks + r32 * KP + d0 * 32 + hi * 16);
                const bf16x8 k1 = *(const LAS bf16x8*)(Ks + (32 + r32) * KP + d0 * 32 + hi * 16);
                p0 = __builtin_amdgcn_mfma_f32_32x32x16_bf16(k0, qr[d0], p0, 0, 0, 0);
                p1 = __builtin_amdgcn_mfma_f32_32x32x16_bf16(k1, qr[d0], p1, 0, 0, 0);
            }
#pragma unroll
            for (int g4 = 0; g4 < 4; ++g4) { const f32x4 b0 = *(const LAS f32x4*)(bias + 8 * g4 + 4 * hi), b1 = *(const LAS f32x4*)(bias + 32 + 8 * g4 + 4 * hi);
#pragma unroll
                for (int i = 0; i < 4; ++i) { p0[4 * g4 + i] += b0[i]; p1[4 * g4 + i] += b1[i]; } }
            if (j >= 4 * qb) {
                const int kb = 64 * j;
#pragma unroll
                for (int r = 0; r < 16; ++r) { const int kv = kb + crow(r, hi); if (kv > qrow) p0[r] = -INFINITY; if (kv + 32 > qrow) p1[r] = -INFINITY; }
            }
            float mloc = fmaxf(p0[0], p1[0]);
#pragma unroll
            for (int r = 1; r < 16; ++r) mloc = fmaxf(mloc, fmaxf(p0[r], p1[r]));
            mloc = fmaxf(mloc, __shfl_xor(mloc, 32));
            const float mnew = fmaxf(m, mloc);
            const float alpha = exp2f(m - mnew);
            float ls = 0.f;
#pragma unroll
            for (int r = 0; r < 16; ++r) { p0[r] = exp2f(p0[r] - mnew); p1[r] = exp2f(p1[r] - mnew); ls += p0[r] + p1[r]; }
            l = l * alpha + ls; m = mnew;
#pragma unroll
            for (int r = 0; r < 16; ++r) { o0[r] *= alpha; o1[r] *= alpha; }
#pragma unroll
            for (int s = 0; s < 4; ++s) {
                u32x4 pw;
                if (s == 0) pw = (u32x4){pk2(p0[0], p0[1]), pk2(p0[2], p0[3]), pk2(p0[4], p0[5]), pk2(p0[6], p0[7])};
                else if (s == 1) pw = (u32x4){pk2(p0[8], p0[9]), pk2(p0[10], p0[11]), pk2(p0[12], p0[13]), pk2(p0[14], p0[15])};
                else if (s == 2) pw = (u32x4){pk2(p1[0], p1[1]), pk2(p1[2], p1[3]), pk2(p1[4], p1[5]), pk2(p1[6], p1[7])};
                else pw = (u32x4){pk2(p1[8], p1[9]), pk2(p1[10], p1[11]), pk2(p1[12], p1[13]), pk2(p1[14], p1[15])};
                const bf16x8 pf = __builtin_bit_cast(bf16x8, pw);
                const bf16x8 v0 = *(const LAS bf16x8*)(Vs + r32 * KP + s * 32 + hi * 16);
                const bf16x8 v1 = *(const LAS bf16x8*)(Vs + (32 + r32) * KP + s * 32 + hi * 16);
                o0 = __builtin_amdgcn_mfma_f32_32x32x16_bf16(v0, pf, o0, 0, 0, 0);
                o1 = __builtin_amdgcn_mfma_f32_32x32x16_bf16(v1, pf, o1, 0, 0, 0);
            }
        }
        l += __shfl_xor(l, 32);
        const float rl = 1.f / l;
#pragma unroll
        for (int dt = 0; dt < 2; ++dt)
#pragma unroll
            for (int g4 = 0; g4 < 4; ++g4) { const int d = 32 * dt + 8 * g4 + 4 * hi; const size_t col = (size_t)h * 64 + d;
                const u32x2 ogw = *(const u32x2*)(QKVG + (size_t)qrow * 4096 + 3 * D + col);
                const float og[4] = {bflo(ogw.x), bfhi(ogw.x), bflo(ogw.y), bfhi(ogw.y)}; float ov[4];
#pragma unroll
                for (int i = 0; i < 4; ++i) ov[i] = (dt == 0 ? o0[4 * g4 + i] : o1[4 * g4 + i]) * rl * sigmoidf_(og[i]);
                u32x2 w; w.x = pk2(ov[0], ov[1]); w.y = pk2(ov[2], ov[3]);
                *(u32x2*)(Z2 + (size_t)qrow * D + col) = w; }
    }
}

struct TokInfo { int e0, e1, p0, p1; float g0, g1; int d0, d1; };
__device__ __forceinline__ void p16_router(Frame& F, const Args& a) {
    const int lane = F.lane, tid = F.tid; const float* Hs = (const float*)(F.ws + WS_H); bf16* U = (bf16*)(F.ws + WS_U4);
    TokInfo* TI = (TokInfo*)(F.ws + WS_TOK);
    LAS float* wr_ = (LAS float*)F.lds;
    LAS int* lcnt = (LAS int*)(F.lds + 32768);
    const Row gr = ld_row(a.in[1] + 3 * D, lane);
    __syncthreads();
    for (int i = tid; i < NE * D; i += NTHREADS) { const int e = i & 7, k = i >> 3; wr_[e * D + k] = a.in[26][(size_t)k * NE + e]; }
    for (int tb = F.vcu * 64; tb < T; tb += F.G * 64) {
        __syncthreads();
        if (tid < 16) lcnt[tid] = 0;
        __syncthreads();
        int e0s[8], e1s[8], p0s[8], p1s[8]; float g0s[8];
#pragma unroll
        for (int q = 0; q < 8; ++q) { const int t = tb + F.wave * 8 + q;
            const Row u = rmsnorm_row(ld_row(Hs + (size_t)t * D, lane), gr);
            st_row_bf16(U + (size_t)t * D, lane, u);
            float lg[NE];
#pragma unroll
            for (int e = 0; e < NE; ++e) { float s = 0.f;
#pragma unroll
                for (int j = 0; j < 4; ++j) { const f32x4 w = *(const LAS f32x4*)(wr_ + e * D + 256 * j + 4 * lane); s += (u.v[j][0] * w[0] + u.v[j][1] * w[1]) + (u.v[j][2] * w[2] + u.v[j][3] * w[3]); }
                lg[e] = wave_sum(s); }
            int b0 = 0; float v0 = lg[0];
#pragma unroll
            for (int e = 1; e < NE; ++e) if (lg[e] > v0) { v0 = lg[e]; b0 = e; }
            int b1 = -1; float v1 = -INFINITY;
#pragma unroll
            for (int e = 0; e < NE; ++e) if (e != b0 && lg[e] > v1) { v1 = lg[e]; b1 = e; }
            e0s[q] = b0; e1s[q] = b1; g0s[q] = 1.f / (1.f + __expf(v1 - v0));
            int pa = 0, pb = 0;
            if (lane == 0) { pa = atomicAdd((int*)&lcnt[b0], 1); pb = atomicAdd((int*)&lcnt[b1], 1); }
            p0s[q] = pa; p1s[q] = pb;
        }
        __syncthreads();
        if (tid < NE) lcnt[8 + tid] = (int)__hip_atomic_fetch_add(F.ctl + CW_CNT + 64 * tid, (unsigned)lcnt[tid], RLX_AGENT);
        __syncthreads();
        if (lane == 0) {
#pragma unroll
            for (int q = 0; q < 8; ++q) { const int t = tb + F.wave * 8 + q; TokInfo ti; ti.e0 = e0s[q]; ti.e1 = e1s[q]; ti.p0 = lcnt[8 + e0s[q]] + p0s[q]; ti.p1 = lcnt[8 + e1s[q]] + p1s[q];
                ti.g0 = g0s[q]; ti.g1 = 1.f - g0s[q]; ti.d0 = 0; ti.d1 = 0; TI[t] = ti; }
        }
    }
    __syncthreads();
}
__device__ __forceinline__ int moe_ends(Frame& F, LAS int* ends) {
    __syncthreads();
    if (F.tid == 0) { int run = 0; for (int e = 0; e < NE; ++e) { const int c = (int)__hip_atomic_load(F.ctl + CW_CNT + 64 * e, RLX_AGENT); run += (c + 255) >> 8; ends[e] = run; } }
    __syncthreads();
    return ends[NE - 1];
}
__device__ __forceinline__ void p17_gather(Frame& F) {
    LAS int* ends = (LAS int*)(F.lds + RING_BYTES);
    moe_ends(F, ends);
    const bf16* U = (const bf16*)(F.ws + WS_U4); bf16* AM = (bf16*)(F.ws + WS_AM); TokInfo* TI = (TokInfo*)(F.ws + WS_TOK);
    for (int t = F.gw; t < T; t += F.NGW) {
        const TokInfo ti = TI[t];
        const int d0 = (ti.e0 ? ends[ti.e0 - 1] : 0) * 256 + ti.p0, d1 = (ti.e1 ? ends[ti.e1 - 1] : 0) * 256 + ti.p1;
        const u32x4* src = (const u32x4*)(U + (size_t)t * D) + F.lane; const u32x4 x0 = src[0], x1 = src[64];
        u32x4* o0 = (u32x4*)(AM + (size_t)d0 * D) + F.lane; o0[0] = x0; o0[64] = x1;
        u32x4* o1 = (u32x4*)(AM + (size_t)d1 * D) + F.lane; o1[0] = x0; o1[64] = x1;
        if (F.lane == 0) { TI[t].d0 = d0; TI[t].d1 = d1; }
    }
}
__device__ __forceinline__ void p20_combine(Frame& F, const Args& a) {
    const int lane = F.lane; const float* Hs = (const float*)(F.ws + WS_H); const bf16* YS = (const bf16*)(F.ws + WS_YS); const TokInfo* TI = (const TokInfo*)(F.ws + WS_TOK);
    const Row gr = ld_row(a.in[2], lane);
    for (int t = F.gw; t < T; t += F.NGW) {
        const TokInfo ti = TI[t];
        Row hrow = ld_row(Hs + (size_t)t * D, lane); const Row y0 = ld_row_bf16(YS + (size_t)ti.d0 * D, lane), y1 = ld_row_bf16(YS + (size_t)ti.d1 * D, lane);
#pragma unroll
        for (int j = 0; j < 4; ++j) hrow.v[j] = hrow.v[j] + ti.g0 * y0.v[j] + ti.g1 * y1.v[j];
        st_row(a.out + (size_t)t * D, lane, rmsnorm_row(hrow, gr));
    }
}

constexpr int N_PHASES = 21;
__global__ void __launch_bounds__(NTHREADS, 2) trunk_fwd(Args args) {
    extern __shared__ __attribute__((aligned(16))) unsigned char lds_raw[];
    Frame F;
    F.lds = (LAS unsigned char*)lds_raw; F.ws = args.ws; F.ctl = (gu32*)(args.ws + WS_CTL);
    F.tid = threadIdx.x; F.lane = F.tid & 63; F.wave = __builtin_amdgcn_readfirstlane(F.tid >> 6);
    F.G = gridDim.x; { const int bx = blockIdx.x; F.vcu = (F.G % 8 == 0) ? (bx % 8) * (F.G / 8) + bx / 8 : bx; }
    F.gw = F.vcu * NWAVES + F.wave; F.NGW = F.G * NWAVES;
    volatile LAS unsigned* MISC = (volatile LAS unsigned*)(F.lds + MISC_OFF);
    for (int u = F.tid; u < (LDS_BYTES - RING_BYTES) / 4; u += NTHREADS) ((LAS unsigned*)(F.lds + RING_BYTES))[u] = 0u;
    __syncthreads();
    const int lo = args.ph_lo, hi = args.ph_hi;
    const bool use_bar = (hi - lo) > 1;
    XcdBarrier bar; bar.bar = (unsigned*)(F.ctl + CW_BAR); bar.x = 0; bar.st = nullptr;
    if (use_bar) bar = xcd_barrier_post((unsigned*)(F.ctl + CW_BAR), MISC + 8);
#ifdef ONLY_PHASE
#define IN(k) ((k) == ONLY_PHASE && lo <= (k) && (k) < hi)
#else
#define IN(k) (lo <= (k) && (k) < hi)
#endif
#define SEAM(k) do { if (IN((k) + 1)) xcd_barrier(bar); } while (0)
    unsigned char* ws = args.ws;
    const int c = (int)blockIdx.x;
    LAS unsigned char* ring = F.lds;

    if (IN(0)) { p0_prologue(F, args); p1_shift(F, args); SEAM(0); }
    if (IN(1)) {
        { pg8::Gemm g{D, D, D}; pg8::SchedRKV S; S.o.init(T / 256, 12, F.G, c); S.A = (const char*)(ws + WS_XS); S.B = (const char*)(ws + WS_W_RKV); S.astep = (size_t)256 * D * 2; S.bstep = (size_t)256 * D * 2; S.azstride = (size_t)T * D * 2;
          pg8::EpiRKV E{(float*)(ws + WS_R), (size_t)T * D};
          pg8::gemm_phase<pg8::EpiRKV, pg8::SchedRKV, true>(ring, g, S, E); }
        { pg8::Gemm g{D, 2 * D, 2 * D}; pg8::SchedPlain S; S.o.init(T / 256, 1, F.G, c); S.A = (const char*)(ws + WS_UB); S.B = (const char*)(ws + WS_W_L1); S.astep = (size_t)256 * D * 2; S.bstep = (size_t)256 * 2 * D * 2;
          pg8::EpiL1 E{(bf16*)(ws + WS_L1)};
          pg8::gemm_phase<pg8::EpiL1, pg8::SchedPlain, true>(ring, g, S, E); }
        SEAM(1); }
    if (IN(2)) {
        pg8::Gemm g{256, 256, 256}; pg8::SchedPlain S; S.o.init(T / 256, 12, F.G, c); S.A = (const char*)(ws + WS_L1); S.B = (const char*)(ws + WS_W_L2); S.astep = (size_t)256 * 256 * 2; S.bstep = (size_t)256 * 256 * 2;
        static_assert(WS_AA - WS_LW == WS_G - WS_AA, "LW, AA, G evenly spaced");
        pg8::EpiL2 E{(float*)(ws + WS_LW), args.in[5], args.in[8]};
        pg8::gemm_phase<pg8::EpiL2, pg8::SchedPlain, true>(ring, g, S, E);
        SEAM(2); }
    if (IN(3)) { p4_derive(F, args); SEAM(3); }
    if (IN(4)) { p5_scan(F); SEAM(4); }
    if (IN(5)) { p6_gn(F, args); SEAM(5); }
    if (IN(6)) {
        pg8::Gemm g{D, D, D}; pg8::SchedPlain S; S.o.init(T / 256, 4, F.G, c); S.A = (const char*)(ws + WS_Z); S.B = (const char*)(ws + WS_W_O0); S.astep = (size_t)256 * D * 2; S.bstep = (size_t)256 * D * 2;
        pg8::EpiRes E{args.in[0], (float*)(ws + WS_H)};
        pg8::gemm_phase<pg8::EpiRes, pg8::SchedPlain, true>(ring, g, S, E);
        SEAM(6); }
    if (IN(7)) { p8_norm(F, args.in[1] + D, (bf16*)(ws + WS_U2)); SEAM(7); }
    if (IN(8)) {
        pg8::Gemm g{D, D, D}; pg8::SchedPlain S; S.o.init(T / 256, 2 * FF / 256, F.G, c); S.A = (const char*)(ws + WS_U2); S.B = (const char*)(ws + WS_W_GU); S.astep = (size_t)256 * D * 2; S.bstep = (size_t)256 * D * 2;
        pg8::EpiSwiGLU E{(bf16*)(ws + WS_ACT)};
        pg8::gemm_phase<pg8::EpiSwiGLU, pg8::SchedPlain, true>(ring, g, S, E);
        SEAM(8); }
    if (IN(9)) {
        pg8::Gemm g{FF, FF, FF}; pg8::SchedPlain S; S.o.init(T / 256, 4, F.G, c); S.A = (const char*)(ws + WS_ACT); S.B = (const char*)(ws + WS_W_DN); S.astep = (size_t)256 * FF * 2; S.bstep = (size_t)256 * FF * 2;
        pg8::EpiRes E{(const float*)(ws + WS_H), (float*)(ws + WS_H)};
        pg8::gemm_phase<pg8::EpiRes, pg8::SchedPlain, true>(ring, g, S, E);
        SEAM(9); }
    if (IN(10)) { p11_norm_forget(F, args); SEAM(10); }
    if (IN(11)) {
        pg8::Gemm g{D, D, D}; pg8::SchedPlain S; S.o.init(T / 256, 16, F.G, c); S.A = (const char*)(ws + WS_U3); S.B = (const char*)(ws + WS_W_IN); S.astep = (size_t)256 * D * 2; S.bstep = (size_t)256 * D * 2;
        pg8::EpiBf16 E{(bf16*)(ws + WS_QKVG), 4096};
        pg8::gemm_phase<pg8::EpiBf16, pg8::SchedPlain, true>(ring, g, S, E);
        SEAM(11); }
    if (IN(12)) { p13_cumsum_qknorm(F, args); SEAM(12); }
    if (IN(13)) { p14_attention(F, args); SEAM(13); }
    if (IN(14)) {
        pg8::Gemm g{D, D, D}; pg8::SchedPlain S; S.o.init(T / 256, 4, F.G, c); S.A = (const char*)(ws + WS_Z2); S.B = (const char*)(ws + WS_W_FO); S.astep = (size_t)256 * D * 2; S.bstep = (size_t)256 * D * 2;
        pg8::EpiRes E{(const float*)(ws + WS_H), (float*)(ws + WS_H)};
        pg8::gemm_phase<pg8::EpiRes, pg8::SchedPlain, true>(ring, g, S, E);
        SEAM(14); }
    if (IN(15)) { p16_router(F, args); SEAM(15); }
    if (IN(16)) { p17_gather(F); SEAM(16); }
    if (IN(17)) {
        LAS int* ends = (LAS int*)(F.lds + RING_BYTES); const int nblk = moe_ends(F, ends);
        pg8::Gemm g{D, D, D}; pg8::SchedMoe S; S.o.init(nblk, 2 * FF / 256, F.G, c); S.A = (const char*)(ws + WS_AM); S.B = (const char*)(ws + WS_W_MGU); S.astep = (size_t)256 * D * 2; S.bstep = (size_t)256 * D * 2; S.bestride = (size_t)2 * FF * D * 2; S.ends = ends;
        pg8::EpiSwiGLU E{(bf16*)(ws + WS_ACT2)};
        pg8::gemm_phase<pg8::EpiSwiGLU, pg8::SchedMoe, true>(ring, g, S, E);
        SEAM(17); }
    if (IN(18)) {
        LAS int* ends = (LAS int*)(F.lds + RING_BYTES); const int nblk = moe_ends(F, ends);
        pg8::Gemm g{FF, FF, FF}; pg8::SchedMoe S; S.o.init(nblk, 4, F.G, c); S.A = (const char*)(ws + WS_ACT2); S.B = (const char*)(ws + WS_W_MDN); S.astep = (size_t)256 * FF * 2; S.bstep = (size_t)256 * FF * 2; S.bestride = (size_t)D * FF * 2; S.ends = ends;
        pg8::EpiBf16 E{(bf16*)(ws + WS_YS), D};
        pg8::gemm_phase<pg8::EpiBf16, pg8::SchedMoe, true>(ring, g, S, E);
        SEAM(18); }
    if (IN(19)) { p20_combine(F, args); }
#undef IN
#undef SEAM
}

extern "C" void kernel_launch(void* const* d_in, const int* in_sizes, int n_in, void* d_out, int out_size, void* d_ws, size_t ws_size, hipStream_t stream) {
    static int grid = 0;
    if (grid == 0) {
        if (n_in != 29 || out_size != T * D || ws_size < WS_END) { fprintf(stderr, "kernel_launch: unexpected problem (n_in %d out %d ws %zu)\n", n_in, out_size, ws_size); grid = -1; return; }
        int dev = 0, cus = 0;
        if (hipGetDevice(&dev) != hipSuccess || hipDeviceGetAttribute(&cus, hipDeviceAttributeMultiprocessorCount, dev) != hipSuccess) { grid = -1; return; }
        if (hipFuncSetAttribute((const void*)trunk_fwd, hipFuncAttributeMaxDynamicSharedMemorySize, LDS_BYTES) != hipSuccess) { fprintf(stderr, "kernel_launch: hipFuncSetAttribute failed\n"); grid = -1; return; }
        int per_cu = 0;
        if (hipOccupancyMaxActiveBlocksPerMultiprocessor(&per_cu, (const void*)trunk_fwd, NTHREADS, LDS_BYTES) != hipSuccess || per_cu < 1) fprintf(stderr, "kernel_launch: occupancy query says %d\n", per_cu);
        (void)hipGetLastError();
        grid = cus;
    }
    if (grid < 0) return;
    (void)hipMemsetAsync((char*)d_ws + WS_CTL, 0, CTL_ZERO_BYTES, stream);
    Args a{};
    for (int i = 0; i < 29; ++i) a.in[i] = (const float*)d_in[i];
    a.out = (float*)d_out; a.ws = (unsigned char*)d_ws;
    constexpr int NPH = 20;
    if (LAUNCH_MODE == 1) { a.ph_lo = 0; a.ph_hi = NPH; hipLaunchKernelGGL(trunk_fwd, dim3(grid), dim3(NTHREADS), LDS_BYTES, stream, a); }
    else for (int p = 0; p < NPH; ++p) { a.ph_lo = p; a.ph_hi = p + 1; hipLaunchKernelGGL(trunk_fwd, dim3(grid), dim3(NTHREADS), LDS_BYTES, stream, a); }
}
```

```cpp
#include <hip/hip_runtime.h>
#include <cstdio>
#include <cstdint>

#ifndef DUP_PHASE
#define DUP_PHASE -1
#endif
#ifndef LAUNCH_MODE
#define LAUNCH_MODE 1
#endif

#define GAS __attribute__((address_space(1)))
#define LAS __attribute__((address_space(3)))
typedef unsigned short bf16;
typedef short bf16x8 __attribute__((ext_vector_type(8)));
typedef float f32x4 __attribute__((ext_vector_type(4)));
typedef float f32x2 __attribute__((ext_vector_type(2)));
typedef float f32x16 __attribute__((ext_vector_type(16)));
typedef unsigned u32x4 __attribute__((ext_vector_type(4)));
typedef unsigned u32x2 __attribute__((ext_vector_type(2)));
typedef GAS unsigned gu32;
#define RLX_AGENT __ATOMIC_RELAXED, __HIP_MEMORY_SCOPE_AGENT

constexpr int T = 16384, D = 1024, NH = 16, HD = 64, FF = 3584, NE = 8, WIN_LD = 4 * D + NH;
constexpr int NWAVES = 8, NTHREADS = 512;
constexpr float RMS_EPS = 1e-6f, GN_EPS = 64e-5f;
constexpr int MOE_ROWS = (2 * T / 256 + NE) * 256;
constexpr float LOG2E = 1.4426950408889634f;

constexpr size_t MiB = 1u << 20;
constexpr size_t WS_CTL = 0, CTL_ZERO_BYTES = 1 * MiB;
constexpr size_t WS_W_RKV = 2 * MiB, WS_W_L1 = 8 * MiB, WS_W_L2 = 9 * MiB, WS_W_O0 = 11 * MiB, WS_W_GU = 13 * MiB, WS_W_DN = 27 * MiB,
                 WS_W_IN = 34 * MiB, WS_W_FO = 42 * MiB, WS_W_MGU = 44 * MiB, WS_W_MDN = 156 * MiB;
constexpr size_t WS_H = 216 * MiB;
constexpr size_t WS_UB = 280 * MiB, WS_XS = 313 * MiB;
constexpr size_t WS_KK = 280 * MiB, WS_BB = 344 * MiB;
constexpr size_t WS_Z = 280 * MiB, WS_U2 = 344 * MiB;
constexpr size_t WS_U3 = 280 * MiB, WS_Z2 = 312 * MiB, WS_U4 = 280 * MiB, WS_AM = 312 * MiB;
constexpr size_t WS_R = 410 * MiB, WS_K = 474 * MiB, WS_V = 538 * MiB;
constexpr size_t WS_ACT = 410 * MiB;
constexpr size_t WS_QKVG = 410 * MiB;
constexpr size_t WS_ACT2 = 410 * MiB;
constexpr size_t WS_LW = 602 * MiB, WS_AA = 666 * MiB, WS_G = 730 * MiB;
constexpr size_t WS_YT = 666 * MiB;
constexpr size_t WS_YS = 666 * MiB;
constexpr size_t WS_L1 = 794 * MiB;
constexpr size_t WS_CS = 802 * MiB;
constexpr size_t WS_LF = 806 * MiB, WS_C2 = 807 * MiB, WS_CB = 808 * MiB, WS_TOK = 809 * MiB;
constexpr size_t WS_END = 810 * MiB;
constexpr size_t WS_AT = 280 * MiB, WS_RT = 312 * MiB, WS_BH = 344 * MiB, WS_KH = 376 * MiB;
constexpr size_t WS_V16 = 216 * MiB, WS_GC = 248 * MiB;
constexpr size_t WS_QM = 410 * MiB, WS_PLR = 474 * MiB, WS_TM = 506 * MiB, WS_S0 = 538 * MiB;
constexpr size_t WS_Y = 602 * MiB;
constexpr int NCH = T / 64;
constexpr int CW_TMO = 0, CW_BAR = 4096, CW_CNT = 8192, CW_ATTQ = 9216;

constexpr int RING_BYTES = 131072, MISC_OFF = RING_BYTES + 320, LDS_BYTES = 147456;

__device__ __forceinline__ unsigned f2bf(float f) { unsigned u = __builtin_bit_cast(unsigned, f); return (u + 0x7fffu + ((u >> 16) & 1u)) >> 16; }
__device__ __forceinline__ unsigned pk2(float lo, float hi) { return f2bf(lo) | (f2bf(hi) << 16); }
__device__ __forceinline__ float bf2f(unsigned short b) { return __builtin_bit_cast(float, (unsigned)b << 16); }
__device__ __forceinline__ float bflo(unsigned w) { return __builtin_bit_cast(float, w << 16); }
__device__ __forceinline__ float bfhi(unsigned w) { return __builtin_bit_cast(float, w & 0xffff0000u); }
__device__ __forceinline__ float wave_sum(float v) {
#pragma unroll
    for (int o = 1; o < 64; o <<= 1) v += __shfl_xor(v, o);
    return v;
}
__device__ __forceinline__ float row16_sum(float v) {
#pragma unroll
    for (int o = 1; o < 16; o <<= 1) v += __shfl_xor(v, o);
    return v;
}
__device__ __forceinline__ float sigmoidf_(float x) { return 1.f / (1.f + __expf(-x)); }
#define LDS_WAIT() asm volatile("s_waitcnt lgkmcnt(0)" ::: "memory")
__device__ __forceinline__ int crow(int r, int hi) { return (r & 3) + 8 * (r >> 2) + 4 * hi; }

namespace pg8 {
constexpr int BM = 256, BK = 64, HALF = 128, HTB = HALF * BK * 2, STAGE_BYTES = 8 * HTB, NXCD = 8, WGM = 8;
__host__ __device__ __forceinline__ int lds_byte(int r, int c) { const int st = (r >> 4) * 2 + (c >> 5), rr = r & 15, cc = c & 31, ob = rr * 64 + cc * 2; return st * 1024 + (ob ^ (((ob >> 9) & 1) << 5)); }
__host__ __device__ __forceinline__ void stage_rc(int b, int& R, int& C) { const int st = b / 1024, sb = b % 1024, swz = sb ^ (((sb >> 9) & 1) << 5); R = (st >> 1) * 16 + swz / 64; C = (st & 1) * 32 + (swz % 64) / 2; }
__host__ __device__ __forceinline__ int perm32(int rho) { const int n = rho >> 4, i = rho & 15; return 8 * (i >> 2) + 4 * n + (i & 3); }

struct Unit { int pm, pn; };
struct Gemm { int lda, ldb, K; };

struct TileOrder {
    int nM, nN, nwg, G, c;
    __device__ __forceinline__ void init(int nM_, int nN_, int G_, int c_) { nM = nM_; nN = nN_; nwg = nM * nN; G = G_; c = c_; }
    __device__ __forceinline__ bool tile(int i, Unit& u) const {
        const long L = (long)i * G + c; if (L >= nwg) return false;
        int wgid = (int)L; { const int q = nwg / NXCD, r = nwg % NXCD, xcd = wgid % NXCD, off = wgid / NXCD; wgid = (xcd < r ? xcd * (q + 1) : r * (q + 1) + (xcd - r) * q) + off; }
        const int nig = WGM * nN, gid = wgid / nig, fm = gid * WGM, gsz = (nM - fm) < WGM ? (nM - fm) : WGM;
        u.pm = fm + ((wgid % nig) % gsz); u.pn = (wgid % nig) / gsz; return true;
    }
};

__device__ __forceinline__ unsigned cvt_pk_bf16(float lo, float hi) { unsigned r; asm volatile("v_cvt_pk_bf16_f32 %0, %1, %2" : "=v"(r) : "v"(lo), "v"(hi)); return r; }

template <class Epi, class Sched, bool ALIGN_EPI>
__device__ __forceinline__ void gemm_phase(LAS unsigned char* lds, const Gemm g, const Sched& S, const Epi& E) {
    const int tid = threadIdx.x, wid = __builtin_amdgcn_readfirstlane(tid >> 6), lane = tid & 63, wr = wid >> 2, wc = wid & 3, fr = lane & 15, fq = lane >> 4;
    const int K = g.K, nt = K / BK;
    unsigned voffA[2], voffB[2];
#pragma unroll
    for (int i = 0; i < 2; ++i) { int R, C; stage_rc(tid * 16 + i * 8192, R, C); const int Rb = Epi::PERM ? ((R & ~31) + perm32(R & 31)) : R;
        voffA[i] = (unsigned)(R * g.lda + C) * 2u; voffB[i] = (unsigned)(Rb * g.ldb + C) * 2u; }
    const size_t kstep = (size_t)(BK * 2);
    const size_t hstepA = (size_t)HALF * g.lda * 2, hstepB = (size_t)HALF * g.ldb * 2;
    const unsigned ldsw = (unsigned)wid * 1024u;
    const int aoff = lds_byte(wr * 64 + fr, fq * 8), boff = lds_byte(wc * 32 + fr, fq * 8);
#define PG8_SA(b, h) (((b) * 2 + (h)) * HTB)
#define PG8_SB(b, h) ((4 + (b) * 2 + (h)) * HTB)
#define PG8_STAGE(bufoff, gbase, voff) do { _Pragma("unroll") for (int _i = 0; _i < 2; ++_i) \
        __builtin_amdgcn_global_load_lds((const unsigned*)((const char*)(gbase) + (voff)[_i]), (LAS unsigned*)(lds + (bufoff) + ldsw + _i * 8192), 16, 0, 0); } while (0)
#define PG8_LDA(dst, b, h) do { _Pragma("unroll") for (int m = 0; m < 4; ++m) _Pragma("unroll") for (int k = 0; k < 2; ++k) dst[m][k] = *(const LAS bf16x8*)(lds + PG8_SA(b, h) + aoff + m * 2048 + k * 1024); } while (0)
#define PG8_LDB(dst, b, h) do { _Pragma("unroll") for (int n = 0; n < 2; ++n) _Pragma("unroll") for (int k = 0; k < 2; ++k) dst[n][k] = *(const LAS bf16x8*)(lds + PG8_SB(b, h) + boff + n * 2048 + k * 1024); } while (0)
#define PG8_MMA(ai, bj, At, Bt) do { __builtin_amdgcn_s_setprio(1); _Pragma("unroll") for (int m = 0; m < 4; ++m) _Pragma("unroll") for (int n = 0; n < 2; ++n) _Pragma("unroll") for (int k = 0; k < 2; ++k) \
        acc[ai][bj][m][n] = __builtin_amdgcn_mfma_f32_16x16x32_bf16(Bt[n][k], At[m][k], acc[ai][bj][m][n], 0, 0, 0); __builtin_amdgcn_s_setprio(0); } while (0)
#define PG8_WAIT_V(n) asm volatile("s_waitcnt vmcnt(" #n ")" ::: "memory")
#define PG8_WAIT_L(n) asm volatile("s_waitcnt lgkmcnt(" #n ")" ::: "memory")
#define PG8_BAR __builtin_amdgcn_s_barrier()
#define PG8_SCHED __builtin_amdgcn_sched_barrier(0)
    Unit cur, nxt; int ui = 0;
    if (!S.next(0, cur)) return;
    f32x4 acc[2][2][4][2];
#pragma unroll
    for (int a = 0; a < 2; ++a)
#pragma unroll
        for (int b = 0; b < 2; ++b)
#pragma unroll
            for (int m = 0; m < 4; ++m)
#pragma unroll
                for (int n = 0; n < 2; ++n) acc[a][b][m][n] = (f32x4){0.f, 0.f, 0.f, 0.f};
    bf16x8 At[4][2], B0[2][2], B1[2][2];
    const char* cA = S.pa(cur); const char* cB = S.pb(cur);
    PG8_STAGE(PG8_SB(0, 0), cB, voffB); PG8_STAGE(PG8_SB(0, 1), cB + hstepB, voffB); PG8_STAGE(PG8_SA(0, 0), cA, voffA); PG8_STAGE(PG8_SA(0, 1), cA + hstepA, voffA);
    if (wr == 1) PG8_BAR;
    PG8_WAIT_V(2); PG8_BAR;
    PG8_STAGE(PG8_SB(1, 0), cB + kstep, voffB); PG8_STAGE(PG8_SA(1, 0), cA + kstep, voffA); PG8_STAGE(PG8_SB(1, 1), cB + hstepB + kstep, voffB);
    PG8_WAIT_V(6); PG8_BAR;
    for (;;) {
        const bool has_next = S.next(ui + 1, nxt);
        const char* nA = has_next ? S.pa(nxt) : cA; const char* nB = has_next ? S.pb(nxt) : cB;
#pragma clang loop unroll(disable)
        for (int t = 0; t < nt; t += 2) {
            const bool last = (t == nt - 2);
            const char* a1 = cA + (size_t)(t + 1) * kstep;
            const char* a2 = last ? nA : cA + (size_t)(t + 2) * kstep; const char* b2 = last ? nB : cB + (size_t)(t + 2) * kstep;
            const char* a3 = a2 + kstep; const char* b3 = b2 + kstep;
            PG8_LDB(B0, 0, 0); PG8_LDB(B1, 0, 1); PG8_SCHED; PG8_LDA(At, 0, 0); PG8_STAGE(PG8_SA(1, 1), a1 + hstepA, voffA);
            PG8_WAIT_V(8); PG8_WAIT_L(0); PG8_BAR; PG8_MMA(0, 0, At, B0); PG8_MMA(0, 1, At, B1); PG8_BAR; PG8_SCHED;
            PG8_LDA(At, 0, 1); PG8_STAGE(PG8_SB(0, 0), b2, voffB); PG8_STAGE(PG8_SB(0, 1), b2 + hstepB, voffB); PG8_STAGE(PG8_SA(0, 0), a2, voffA);
            PG8_WAIT_V(8); PG8_WAIT_L(0); PG8_BAR; PG8_MMA(1, 0, At, B0); PG8_MMA(1, 1, At, B1); PG8_BAR; PG8_SCHED;
            PG8_LDB(B0, 1, 0); PG8_LDB(B1, 1, 1); PG8_SCHED; PG8_LDA(At, 1, 0); PG8_STAGE(PG8_SA(0, 1), a2 + hstepA, voffA);
            PG8_WAIT_V(8); PG8_WAIT_L(0); PG8_BAR; PG8_MMA(0, 0, At, B0); PG8_MMA(0, 1, At, B1); PG8_BAR; PG8_SCHED;
            PG8_LDA(At, 1, 1); PG8_STAGE(PG8_SB(1, 0), b3, voffB); PG8_STAGE(PG8_SB(1, 1), b3 + hstepB, voffB); PG8_STAGE(PG8_SA(1, 0), a3, voffA);
            PG8_WAIT_V(8); PG8_WAIT_L(0); PG8_BAR; PG8_MMA(1, 0, At, B0); PG8_MMA(1, 1, At, B1); PG8_BAR; PG8_SCHED;
        }
        if constexpr (ALIGN_EPI) { if (wr == 0) PG8_BAR; }
        E(acc, cur, wr, wc, fr, fq);
        if (!has_next) break;
#pragma unroll
        for (int a = 0; a < 2; ++a)
#pragma unroll
            for (int b = 0; b < 2; ++b)
#pragma unroll
                for (int m = 0; m < 4; ++m)
#pragma unroll
                    for (int n = 0; n < 2; ++n) acc[a][b][m][n] = (f32x4){0.f, 0.f, 0.f, 0.f};
        cur = nxt; cA = nA; cB = nB; ++ui;
        if constexpr (ALIGN_EPI) { if (wr == 1) PG8_BAR; }
    }
    PG8_WAIT_V(0);
    if constexpr (!ALIGN_EPI) { if (wr == 0) PG8_BAR; }
    PG8_BAR;
#undef PG8_SA
#undef PG8_SB
#undef PG8_STAGE
#undef PG8_LDA
#undef PG8_LDB
#undef PG8_MMA
#undef PG8_WAIT_V
#undef PG8_WAIT_L
#undef PG8_BAR
#undef PG8_SCHED
}

typedef const f32x4 (&AccRef)[2][2][4][2];

struct SchedPlain {
    TileOrder o; const char* A; const char* B; size_t astep, bstep;
    __device__ __forceinline__ bool next(int i, Unit& u) const { return o.tile(i, u); }
    __device__ __forceinline__ const char* pa(const Unit& u) const { return A + (size_t)u.pm * astep; }
    __device__ __forceinline__ const char* pb(const Unit& u) const { return B + (size_t)u.pn * bstep; }
};
struct SchedRKV {
    TileOrder o; const char* A; const char* B; size_t astep, bstep, azstride;
    __device__ __forceinline__ bool next(int i, Unit& u) const { return o.tile(i, u); }
    __device__ __forceinline__ const char* pa(const Unit& u) const { return A + (size_t)(u.pn >> 2) * azstride + (size_t)u.pm * astep; }
    __device__ __forceinline__ const char* pb(const Unit& u) const { return B + (size_t)u.pn * bstep; }
};
struct SchedMoe {
    TileOrder o; const char* A; const char* B; size_t astep, bstep, bestride; const LAS int* ends;
    __device__ __forceinline__ bool next(int i, Unit& u) const { return o.tile(i, u); }
    __device__ __forceinline__ int be(int pm) const { int e = 0;
#pragma unroll
        for (int j = 0; j < NE - 1; ++j) e += (pm >= ends[j]) ? 1 : 0; return e; }
    __device__ __forceinline__ const char* pa(const Unit& u) const { return A + (size_t)u.pm * astep; }
    __device__ __forceinline__ const char* pb(const Unit& u) const { return B + (size_t)be(u.pm) * bestride + (size_t)u.pn * bstep; }
};

struct EpiRKV {
    static constexpr bool PERM = false;
    float* C; size_t zstride;
    __device__ __forceinline__ void operator()(AccRef acc, const Unit& u, int wr, int wc, int fr, int fq) const {
        const int z = u.pn >> 2, pn = u.pn & 3; float* base = C + (size_t)z * zstride;
        const int row0 = u.pm * BM + wr * 64 + fr, col0 = pn * BM + wc * 32 + 4 * fq;
#pragma unroll
        for (int ai = 0; ai < 2; ++ai)
#pragma unroll
            for (int m = 0; m < 4; ++m) { float* rowp = base + (size_t)(row0 + ai * HALF + m * 16) * D + col0;
#pragma unroll
                for (int bj = 0; bj < 2; ++bj)
#pragma unroll
                    for (int n = 0; n < 2; ++n) *(f32x4*)(rowp + bj * HALF + n * 16) = acc[ai][bj][m][n]; }
    }
};
struct EpiRes {
    static constexpr bool PERM = false;
    const float* base; float* out;
    __device__ __forceinline__ void operator()(AccRef acc, const Unit& u, int wr, int wc, int fr, int fq) const {
        const int row0 = u.pm * BM + wr * 64 + fr, col0 = u.pn * BM + wc * 32 + 4 * fq;
#pragma unroll
        for (int ai = 0; ai < 2; ++ai)
#pragma unroll
            for (int m = 0; m < 4; ++m) { const size_t off = (size_t)(row0 + ai * HALF + m * 16) * D + col0;
#pragma unroll
                for (int bj = 0; bj < 2; ++bj)
#pragma unroll
                    for (int n = 0; n < 2; ++n) { const f32x4 b = *(const f32x4*)(base + off + bj * HALF + n * 16); *(f32x4*)(out + off + bj * HALF + n * 16) = b + acc[ai][bj][m][n]; } }
    }
};
struct EpiL1 {
    static constexpr bool PERM = true;
    bf16* O;
    __device__ __forceinline__ void operator()(AccRef acc, const Unit& u, int wr, int wc, int fr, int fq) const {
        const int row0 = u.pm * BM + wr * 64 + fr, col0 = wc * 32 + 8 * fq;
#pragma unroll
        for (int ai = 0; ai < 2; ++ai)
#pragma unroll
            for (int m = 0; m < 4; ++m) { bf16* rowp = O + (size_t)(row0 + ai * HALF + m * 16) * 256 + col0;
#pragma unroll
                for (int bj = 0; bj < 2; ++bj) { float v[8];
#pragma unroll
                    for (int i = 0; i < 4; ++i) { v[i] = acc[ai][bj][m][0][i]; v[4 + i] = acc[ai][bj][m][1][i]; }
#pragma unroll
                    for (int i = 0; i < 8; ++i) { if (bj == 1) v[i] = sigmoidf_(v[i]); else if (wc < 2) v[i] = tanhf(v[i]); }
                    u32x4 w; w.x = cvt_pk_bf16(v[0], v[1]); w.y = cvt_pk_bf16(v[2], v[3]); w.z = cvt_pk_bf16(v[4], v[5]); w.w = cvt_pk_bf16(v[6], v[7]);
                    *(u32x4*)(rowp + bj * HALF) = w; } }
    }
};
struct EpiL2 {
    static constexpr bool PERM = false;
    float* LW; const float* w0; const float* a0;
    __device__ __forceinline__ void operator()(AccRef acc, const Unit& u, int wr, int wc, int fr, int fq) const {
        const int z = u.pn >> 2, pn = u.pn & 3; float* base = LW + (size_t)z * ((WS_AA - WS_LW) / 4); const float* bias = z == 0 ? w0 : a0;
        const float mul = z == 0 ? -0.6065306597126334f : 1.f;
        const int row0 = u.pm * BM + wr * 64 + fr, col0 = pn * BM + wc * 32 + 4 * fq;
#pragma unroll
        for (int bj = 0; bj < 2; ++bj)
#pragma unroll
            for (int n = 0; n < 2; ++n) { const int c = col0 + bj * HALF + n * 16;
                const f32x4 bv = *(const f32x4*)(bias + c);
#pragma unroll
                for (int ai = 0; ai < 2; ++ai)
#pragma unroll
                    for (int m = 0; m < 4; ++m) { f32x4 v = acc[ai][bj][m][n];
                        if (z < 2) { v = v + bv;
#pragma unroll
                            for (int i = 0; i < 4; ++i) v[i] = mul * __builtin_amdgcn_rcpf(1.f + __expf(-v[i])); }
                        *(f32x4*)(base + (size_t)(row0 + ai * HALF + m * 16) * D + c) = v; } }
    }
};
struct EpiSwiGLU {
    static constexpr bool PERM = true;
    bf16* O;
    __device__ __forceinline__ void operator()(AccRef acc, const Unit& u, int wr, int wc, int fr, int fq) const {
        const int row0 = u.pm * BM + wr * 64 + fr, col0 = u.pn * HALF + wc * 32 + 8 * fq;
#pragma unroll
        for (int ai = 0; ai < 2; ++ai)
#pragma unroll
            for (int m = 0; m < 4; ++m) { float v[8];
#pragma unroll
                for (int n = 0; n < 2; ++n)
#pragma unroll
                    for (int i = 0; i < 4; ++i) { const float gt = acc[ai][0][m][n][i], up = acc[ai][1][m][n][i]; v[4 * n + i] = gt * sigmoidf_(gt) * up; }
                u32x4 w; w.x = cvt_pk_bf16(v[0], v[1]); w.y = cvt_pk_bf16(v[2], v[3]); w.z = cvt_pk_bf16(v[4], v[5]); w.w = cvt_pk_bf16(v[6], v[7]);
                *(u32x4*)(O + (size_t)(row0 + ai * HALF + m * 16) * FF + col0) = w; }
    }
};
struct EpiBf16 {
    static constexpr bool PERM = true;
    bf16* O; int ldc;
    __device__ __forceinline__ void operator()(AccRef acc, const Unit& u, int wr, int wc, int fr, int fq) const {
        const int row0 = u.pm * BM + wr * 64 + fr, col0 = u.pn * BM + wc * 32 + 8 * fq;
#pragma unroll
        for (int ai = 0; ai < 2; ++ai)
#pragma unroll
            for (int m = 0; m < 4; ++m) { bf16* rowp = O + (size_t)(row0 + ai * HALF + m * 16) * ldc + col0;
#pragma unroll
                for (int bj = 0; bj < 2; ++bj) { const f32x4 v0 = acc[ai][bj][m][0], v1 = acc[ai][bj][m][1];
                    u32x4 w; w.x = cvt_pk_bf16(v0[0], v0[1]); w.y = cvt_pk_bf16(v0[2], v0[3]); w.z = cvt_pk_bf16(v1[0], v1[1]); w.w = cvt_pk_bf16(v1[2], v1[3]);
                    *(u32x4*)(rowp + bj * HALF) = w; } }
    }
};
}

#define XB_TMO      128
#define XB_XCNT(j)  (256  + 64 * (j))
#define XB_XSUB(j)  (1280 + 64 * (j))
#define XB_XGEN(j)  (2304 + 64 * (j))
#define XB_TOP      3328
#define XB_TOPGEN   3392
#define XCD_BAR_WORDS 3456
#define XB_SPIN_CAP (1u << 18)
__device__ __forceinline__ unsigned xb_ld(unsigned* p)              { return __hip_atomic_load(p, __ATOMIC_RELAXED, __HIP_MEMORY_SCOPE_AGENT); }
__device__ __forceinline__ unsigned xb_add(unsigned* p, unsigned v) { return __hip_atomic_fetch_add(p, v, __ATOMIC_RELAXED, __HIP_MEMORY_SCOPE_AGENT); }
__device__ __forceinline__ unsigned xb_xcc_id() { return (unsigned)__builtin_amdgcn_s_getreg((3 << 11) | 20) & 0xFu; }
#define XB_SPIN(cond, bar) do { unsigned _sp = 0; while (cond) { __builtin_amdgcn_s_sleep(1); \
    if ((++_sp & 255u) == 0u) { if (xb_ld(&(bar)[XB_TMO])) break; if (_sp > XB_SPIN_CAP) { atomicAdd(&(bar)[XB_TMO], 1u); break; } } } } while (0)
struct XcdBarrier { unsigned* bar; unsigned x; volatile LAS unsigned* st; };
__device__ __forceinline__ XcdBarrier xcd_barrier_post(unsigned* bar, volatile LAS unsigned* st) {
    XcdBarrier b; b.bar = bar; b.x = xb_xcc_id(); b.st = st;
    if (threadIdx.x == 0) (void)xb_add(&bar[XB_XCNT(b.x)], 1u);
    return b;
}
__device__ __forceinline__ void xcd_barrier_complete(unsigned* bar, unsigned x, unsigned& nloc, unsigned& nx) {
    const unsigned G = gridDim.x * gridDim.y * gridDim.z;
    unsigned sum, cnt, mine, sp = 0u;
    for (;;) {
        sum = 0u; cnt = 0u; mine = 0u;
#pragma unroll
        for (unsigned j = 0; j < 16; ++j) { const unsigned c = xb_ld(&bar[XB_XCNT(j)]); sum += c; cnt += (c > 0u) ? 1u : 0u; mine = (j == x) ? c : mine; }
        if (sum == G) break;
        __builtin_amdgcn_s_sleep(1);
        if ((++sp & 255u) == 0u) { if (xb_ld(&bar[XB_TMO])) break; if (sp > XB_SPIN_CAP) { atomicAdd(&bar[XB_TMO], 1u); break; } }
    }
    nloc = mine > 0u ? mine : 1u; nx = cnt > 0u ? cnt : 1u;
}
__device__ __forceinline__ void xcd_barrier(const XcdBarrier& b) {
    asm volatile("s_waitcnt vmcnt(0)" ::: "memory");
    __syncthreads();
    if (threadIdx.x == 0) {
        unsigned* bar = b.bar;
        __builtin_amdgcn_s_waitcnt(0);
        unsigned nloc = b.st[0], nx = b.st[1];
        if (nloc == 0u) { xcd_barrier_complete(bar, b.x, nloc, nx); b.st[0] = nloc; b.st[1] = nx; }
        const unsigned old = xb_add(&bar[XB_XSUB(b.x)], 1u);
        const unsigned gen = old / nloc;
        if (old + 1u == (gen + 1u) * nloc) {
            __builtin_amdgcn_fence(__ATOMIC_RELEASE, "agent");
            asm volatile("s_waitcnt vmcnt(0)" ::: "memory");
            const unsigned og = xb_add(&bar[XB_TOP], 1u);
            const unsigned tg = og / nx;
            if (og + 1u == (tg + 1u) * nx) xb_add(&bar[XB_TOPGEN], 1u);
            else XB_SPIN(xb_ld(&bar[XB_TOPGEN]) == tg, bar);
            __builtin_amdgcn_fence(__ATOMIC_ACQUIRE, "agent");
            xb_add(&bar[XB_XGEN(b.x)], 1u);
            asm volatile("s_waitcnt vmcnt(0)" ::: "memory");
        } else {
            XB_SPIN(xb_ld(&bar[XB_XGEN(b.x)]) == gen, bar);
            __builtin_amdgcn_fence(__ATOMIC_ACQUIRE, "agent");
            asm volatile("s_waitcnt vmcnt(0)" ::: "memory");
        }
    }
    __syncthreads();
}

struct Args { const float* in[29]; float* out; unsigned char* ws; int ph_lo, ph_hi; };
struct Frame {
    LAS unsigned char* lds; gu32* ctl; unsigned char* ws;
    int tid, lane, wave, vcu, G, gw, NGW;
};

struct Row { f32x4 v[4]; };
__device__ __forceinline__ Row ld_row(const float* p, int lane) { Row r; const f32x4* q = (const f32x4*)p + lane;
#pragma unroll
    for (int j = 0; j < 4; ++j) r.v[j] = q[64 * j]; return r; }
__device__ __forceinline__ void st_row(float* p, int lane, const Row& r) { f32x4* q = (f32x4*)p + lane;
#pragma unroll
    for (int j = 0; j < 4; ++j) q[64 * j] = r.v[j]; }
__device__ __forceinline__ void st_row_bf16(bf16* p, int lane, const Row& r) { u32x2* q = (u32x2*)p + lane;
#pragma unroll
    for (int j = 0; j < 4; ++j) { u32x2 w; w.x = pk2(r.v[j][0], r.v[j][1]); w.y = pk2(r.v[j][2], r.v[j][3]); q[64 * j] = w; } }
__device__ __forceinline__ Row ld_row_bf16(const bf16* p, int lane) { Row r; const u32x2* q = (const u32x2*)p + lane;
#pragma unroll
    for (int j = 0; j < 4; ++j) { const u32x2 w = q[64 * j]; r.v[j] = (f32x4){bflo(w.x), bfhi(w.x), bflo(w.y), bfhi(w.y)}; } return r; }
__device__ __forceinline__ float row_sumsq(const Row& r) { float s = 0.f;
#pragma unroll
    for (int j = 0; j < 4; ++j) s += (r.v[j][0] * r.v[j][0] + r.v[j][1] * r.v[j][1]) + (r.v[j][2] * r.v[j][2] + r.v[j][3] * r.v[j][3]); return wave_sum(s); }
__device__ __forceinline__ Row rmsnorm_row(const Row& x, const Row& g) { const float rs = rsqrtf(row_sumsq(x) * (1.f / D) + RMS_EPS); Row y;
#pragma unroll
    for (int j = 0; j < 4; ++j) y.v[j] = x.v[j] * rs * g.v[j]; return y; }

__device__ __forceinline__ void tr_item(const float* W, int ldw, int k0, int n0, bf16* WT, int ldt, int drow0, int dcol0, const float* sc, int scmode, LAS float* scr, int lane) {
#pragma unroll 8
    for (int i = 0; i < 32; ++i) { const int kk = 2 * i + (lane >> 5); float v = W[(size_t)(k0 + kk) * ldw + n0 + (lane & 31)];
        if (scmode == 1) v *= sc[k0 + kk]; else if (scmode == 2) v *= (1.f - sc[k0 + kk]);
        scr[kk * 33 + (lane & 31)] = v; }
    LDS_WAIT(); asm volatile("" ::: "memory");
    const int c = lane & 7;
#pragma unroll
    for (int j = 0; j < 4; ++j) { const int n = (lane >> 3) + 8 * j; const LAS float* s = scr + (8 * c) * 33 + n;
        u32x4 o; o.x = pk2(s[0 * 33], s[1 * 33]); o.y = pk2(s[2 * 33], s[3 * 33]); o.z = pk2(s[4 * 33], s[5 * 33]); o.w = pk2(s[6 * 33], s[7 * 33]);
        *(GAS u32x4*)(WT + (size_t)(drow0 + n0 + n) * ldt + dcol0 + k0 + 8 * c) = o; }
    LDS_WAIT(); asm volatile("" ::: "memory");
}
__device__ __forceinline__ int gu_row(int n) { return n < FF ? 256 * (n >> 7) + (n & 127) : 256 * ((n - FF) >> 7) + 128 + ((n - FF) & 127); }

__device__ __forceinline__ void p0_prologue(Frame& F, const Args& a) {
    LAS float* scr = (LAS float*)(F.lds + F.wave * 16384);
    unsigned char* ws = F.ws;
    constexpr int I_SQ = 16 * 32;
    constexpr int I_RKV = 3 * I_SQ, I_L1 = 2 * 16 * 8, I_L2 = 4 * 32, I_GU = 16 * 224, I_DN = 56 * 32, I_IN = 16 * 128;
    constexpr int NITEMS = I_RKV + I_L1 + I_L2 + I_SQ + I_GU + I_DN + I_IN + I_SQ + NE * I_GU + NE * I_DN;
    for (int it = F.gw; it < NITEMS; it += F.NGW) {
        int r = it;
        if (r < I_RKV) { const int z = r / I_SQ, q = r % I_SQ; tr_item(a.in[4] + (size_t)z * D * D, D, 64 * (q / 32), 32 * (q % 32), (bf16*)(ws + WS_W_RKV) + (size_t)z * D * D, D, 0, 0, nullptr, 0, scr, F.lane); continue; } r -= I_RKV;
        if (r < I_L1) {
            const int half = r / 128, q = r % 128, kb = q / 8, nb = q % 8, n0 = 32 * nb;
            const float* W; int ldw, nn0, mi;
            if (n0 < 64) { W = a.in[6]; ldw = 64; nn0 = n0; mi = 3; } else if (n0 < 128) { W = a.in[9]; ldw = 64; nn0 = n0 - 64; mi = 4; } else { W = a.in[11]; ldw = 128; nn0 = n0 - 128; mi = 5; }
            tr_item(W, ldw, 64 * kb, nn0, (bf16*)(ws + WS_W_L1), 2 * D, n0 - nn0, half * D, a.in[3] + mi * D, half == 0 ? 1 : 2, scr, F.lane); continue; } r -= I_L1;
        if (r < I_L2) {
            const int part = r / 32, nb = r % 32;
            if (part == 0) tr_item(a.in[7], D, 0, 32 * nb, (bf16*)(ws + WS_W_L2), 256, 0, 0, nullptr, 0, scr, F.lane);
            else if (part == 1) tr_item(a.in[10], D, 0, 32 * nb, (bf16*)(ws + WS_W_L2), 256, D, 64, nullptr, 0, scr, F.lane);
            else tr_item(a.in[12], D, 64 * (part - 2), 32 * nb, (bf16*)(ws + WS_W_L2), 256, 2 * D, 128, nullptr, 0, scr, F.lane);
            continue; } r -= I_L2;
        if (r < I_SQ) { tr_item(a.in[18], D, 64 * (r / 32), 32 * (r % 32), (bf16*)(ws + WS_W_O0), D, 0, 0, nullptr, 0, scr, F.lane); continue; } r -= I_SQ;
        if (r < I_GU) { const int kb = r / 224, nb = r % 224; tr_item(a.in[24], 2 * FF, 64 * kb, 32 * nb, (bf16*)(ws + WS_W_GU), D, gu_row(32 * nb) - 32 * nb, 0, nullptr, 0, scr, F.lane); continue; } r -= I_GU;
        if (r < I_DN) { tr_item(a.in[25], D, 64 * (r / 32), 32 * (r % 32), (bf16*)(ws + WS_W_DN), FF, 0, 0, nullptr, 0, scr, F.lane); continue; } r -= I_DN;
        if (r < I_IN) { tr_item(a.in[19], WIN_LD, 64 * (r / 128), 32 * (r % 128), (bf16*)(ws + WS_W_IN), D, 0, 0, nullptr, 0, scr, F.lane); continue; } r -= I_IN;
        if (r < I_SQ) { tr_item(a.in[23], D, 64 * (r / 32), 32 * (r % 32), (bf16*)(ws + WS_W_FO), D, 0, 0, nullptr, 0, scr, F.lane); continue; } r -= I_SQ;
        if (r < NE * I_GU) { const int e = r / I_GU, q = r % I_GU, kb = q / 224, nb = q % 224;
            tr_item(a.in[27] + (size_t)e * D * 2 * FF, 2 * FF, 64 * kb, 32 * nb, (bf16*)(ws + WS_W_MGU) + (size_t)e * 2 * FF * D, D, gu_row(32 * nb) - 32 * nb, 0, nullptr, 0, scr, F.lane); continue; } r -= NE * I_GU;
        { const int e = r / I_DN, q = r % I_DN; tr_item(a.in[28] + (size_t)e * FF * D, D, 64 * (q / 32), 32 * (q % 32), (bf16*)(ws + WS_W_MDN) + (size_t)e * D * FF, FF, 0, 0, nullptr, 0, scr, F.lane); }
    }
    for (int i = F.gw * 64 + F.lane; i < 3 * D * 32; i += F.NGW * 64) { const int row = i >> 5, ch = i & 31, part = row / D, k = ch * 8;
        const bool nz = part == 0 ? (k < 64) : (part == 1 ? (k >= 64 && k < 128) : (k >= 128));
        if (!nz) *(GAS u32x4*)((bf16*)(ws + WS_W_L2) + (size_t)row * 256 + k) = (u32x4){0u, 0u, 0u, 0u}; }
}

__device__ __forceinline__ void p1_shift(Frame& F, const Args& a) {
    const int lane = F.lane; const float* x = a.in[0];
    bf16* UB = (bf16*)(F.ws + WS_UB); bf16* XS = (bf16*)(F.ws + WS_XS);
    const Row g0 = ld_row(a.in[1], lane);
    const int RPW = T / (256 * NWAVES);
    for (int t0 = F.gw * RPW; t0 < T; t0 += F.NGW * RPW) {
        Row prev;
        if (t0 > 0) prev = rmsnorm_row(ld_row(x + (size_t)(t0 - 1) * D, lane), g0);
        else { for (int j = 0; j < 4; ++j) prev.v[j] = (f32x4){0.f, 0.f, 0.f, 0.f}; st_row_bf16(UB, lane, prev); }
        for (int t = t0; t < t0 + RPW; ++t) {
            const Row u = rmsnorm_row(ld_row(x + (size_t)t * D, lane), g0);
            st_row_bf16(UB + (size_t)(t + 1) * D, lane, u);
#pragma unroll
            for (int n = 0; n < 3; ++n) { const Row mu = ld_row(a.in[3] + n * D, lane); Row o;
#pragma unroll
                for (int j = 0; j < 4; ++j) o.v[j] = u.v[j] + (prev.v[j] - u.v[j]) * mu.v[j];
                st_row_bf16(XS + (size_t)n * T * D + (size_t)t * D, lane, o); }
            prev = u;
        }
    }
}

__device__ __forceinline__ void p4_derive(Frame& F, const Args& a) {
    const int lane = F.lane;
    float* R = (float*)(F.ws + WS_R); float* K = (float*)(F.ws + WS_K); float* LW = (float*)(F.ws + WS_LW); float* AA = (float*)(F.ws + WS_AA);
    float* KK = (float*)(F.ws + WS_KK); float* BB = (float*)(F.ws + WS_BB); float* CS = (float*)(F.ws + WS_CS);
    const Row k_k = ld_row(a.in[13], lane), k_a = ld_row(a.in[14], lane), r_k = ld_row(a.in[15], lane);
    for (int t = F.gw; t < T; t += F.NGW) {
        const size_t o = (size_t)t * D;
        Row r = ld_row(R + o, lane), k = ld_row(K + o, lane), lw = ld_row(LW + o, lane), aa = ld_row(AA + o, lane), kk, bb, km, dec;
        float c1[4], c2[4], c3[4];
#pragma unroll
        for (int j = 0; j < 4; ++j) {
            kk.v[j] = k.v[j] * k_k.v[j];
            float ss = (kk.v[j][0] * kk.v[j][0] + kk.v[j][1] * kk.v[j][1]) + (kk.v[j][2] * kk.v[j][2] + kk.v[j][3] * kk.v[j][3]);
            ss = row16_sum(ss);
            const float inv = 1.f / fmaxf(sqrtf(ss), 1e-12f);
            kk.v[j] = kk.v[j] * inv;
            bb.v[j] = kk.v[j] * aa.v[j];
            km.v[j] = k.v[j] * (1.f + (aa.v[j] - 1.f) * k_a.v[j]);
#pragma unroll
            for (int i = 0; i < 4; ++i) dec.v[j][i] = __expf(lw.v[j][i]);
            float s1 = 0.f, s2 = 0.f, s3 = 0.f;
#pragma unroll
            for (int i = 0; i < 4; ++i) { s1 += bb.v[j][i] * r.v[j][i]; const float kr = km.v[j][i] * r.v[j][i]; s2 += kr; s3 += kr * r_k.v[j][i]; }
            c1[j] = row16_sum(s1); c2[j] = row16_sum(s2); c3[j] = row16_sum(s3);
            r.v[j] = r.v[j] * dec.v[j];
        }
        st_row(R + o, lane, r); st_row(K + o, lane, km); st_row(LW + o, lane, dec); st_row(KK + o, lane, kk); st_row(BB + o, lane, bb);
        if ((lane & 15) == 0) {
#pragma unroll
            for (int j = 0; j < 4; ++j) { const int h = 4 * j + (lane >> 4); CS[(size_t)t * 16 + h] = c1[j]; CS[(size_t)T * 16 + (size_t)t * 16 + h] = c2[j]; CS[(size_t)2 * T * 16 + (size_t)t * 16 + h] = c3[j]; }
        }
    }
}

__device__ __forceinline__ float dpp_row_allsum(float x) {
    int v = __builtin_bit_cast(int, x);
    x += __builtin_bit_cast(float, __builtin_amdgcn_update_dpp(0, v, 0xB1, 0xF, 0xF, true)); v = __builtin_bit_cast(int, x);
    x += __builtin_bit_cast(float, __builtin_amdgcn_update_dpp(0, v, 0x4E, 0xF, 0xF, true)); v = __builtin_bit_cast(int, x);
    x += __builtin_bit_cast(float, __builtin_amdgcn_update_dpp(0, v, 0x141, 0xF, 0xF, true)); v = __builtin_bit_cast(int, x);
    x += __builtin_bit_cast(float, __builtin_amdgcn_update_dpp(0, v, 0x140, 0xF, 0xF, true));
    return x;
}
__device__ __forceinline__ float wave_allsum_fast(float x) {
    x = dpp_row_allsum(x);
    const int v = __builtin_bit_cast(int, x);
    const float a = __builtin_bit_cast(float, __builtin_amdgcn_readlane(v, 0)), b = __builtin_bit_cast(float, __builtin_amdgcn_readlane(v, 16)),
                c = __builtin_bit_cast(float, __builtin_amdgcn_readlane(v, 32)), d = __builtin_bit_cast(float, __builtin_amdgcn_readlane(v, 48));
    return (a + b) + (c + d);
}
__device__ __forceinline__ void p5_scan(Frame& F) {
    if (F.wave >= 4) return;
    const int lane = F.lane;
    const float* KK = (const float*)(F.ws + WS_KK); const float* RW = (const float*)(F.ws + WS_R); const float* DEC = (const float*)(F.ws + WS_LW);
    const float* BB = (const float*)(F.ws + WS_BB); const float* KM = (const float*)(F.ws + WS_K); const float* V = (const float*)(F.ws + WS_V);
    const float* CS = (const float*)(F.ws + WS_CS); float* YT = (float*)(F.ws + WS_YT);
    for (int rho = F.vcu * 4 + F.wave; rho < D; rho += F.G * 4) {
        const int h = rho >> 6;
        const size_t col = (size_t)h * 64 + lane;
        float s = 0.f, ybuf = 0.f;
        constexpr int U = 8;
        float ik[2][U], ir[2][U], iw[2][U], ib[2][U], im[2][U], iv[2][U], i1[2][U], i2[2][U];
#define SCAN_LOAD(buf, tb) do { _Pragma("unroll") for (int u_ = 0; u_ < U; ++u_) { const size_t o_ = (size_t)((tb) + u_) * D; \
            ik[buf][u_] = KK[o_ + col]; ir[buf][u_] = RW[o_ + col]; iw[buf][u_] = DEC[o_ + col]; ib[buf][u_] = BB[o_ + col]; im[buf][u_] = KM[o_ + col]; \
            iv[buf][u_] = V[o_ + rho]; i1[buf][u_] = CS[(size_t)((tb) + u_) * 16 + h]; i2[buf][u_] = CS[(size_t)T * 16 + (size_t)((tb) + u_) * 16 + h]; } } while (0)
#define SCAN_STEPS(buf, tb) do { _Pragma("unroll") for (int u_ = 0; u_ < U; ++u_) { \
            const float p1 = wave_allsum_fast(s * ik[buf][u_]); const float p2 = wave_allsum_fast(s * ir[buf][u_]); \
            const float sa = -p1; const float y = p2 + sa * i1[buf][u_] + iv[buf][u_] * i2[buf][u_]; \
            s = s * iw[buf][u_] + sa * ib[buf][u_] + iv[buf][u_] * im[buf][u_]; \
            if (lane == (((tb) + u_) & 63)) ybuf = y; } } while (0)
        SCAN_LOAD(0, 0);
        for (int t0 = 0; t0 < T; t0 += 2 * U) {
            SCAN_LOAD(1, t0 + U);
            SCAN_STEPS(0, t0);
            if (t0 + 2 * U < T) SCAN_LOAD(0, t0 + 2 * U);
            SCAN_STEPS(1, t0 + U);
            if (((t0 + 2 * U) & 63) == 0) YT[(size_t)rho * T + (t0 + 2 * U - 64) + lane] = ybuf;
        }
#undef SCAN_LOAD
#undef SCAN_STEPS
    }
}

typedef __bf16 bf16x2_t __attribute__((ext_vector_type(2)));
__device__ __forceinline__ unsigned cvtpk(float lo, float hi) { f32x2 v = {lo, hi}; bf16x2_t b = __builtin_convertvector(v, bf16x2_t); return __builtin_bit_cast(unsigned, b); }
struct Pk { bf16x8 k0, k1; };
__device__ __forceinline__ Pk pack_tile(const f32x16& t) {
    const u32x4 a = {cvtpk(t[0], t[1]), cvtpk(t[2], t[3]), cvtpk(t[4], t[5]), cvtpk(t[6], t[7])}, b = {cvtpk(t[8], t[9]), cvtpk(t[10], t[11]), cvtpk(t[12], t[13]), cvtpk(t[14], t[15])};
    Pk p; p.k0 = __builtin_bit_cast(bf16x8, a); p.k1 = __builtin_bit_cast(bf16x8, b); return p; }
#define MFMA32(a, b, c) __builtin_amdgcn_mfma_f32_32x32x16_bf16((a), (b), (c), 0, 0, 0)
__device__ __forceinline__ f32x16 xt(const Pk& X, const Pk& Z, f32x16 acc) { acc = MFMA32(X.k0, Z.k0, acc); acc = MFMA32(X.k1, Z.k1, acc); return acc; }
__device__ __forceinline__ bf16x8 nfrag(const bf16* m, int rt, int ks, int lane) { return *(const bf16x8*)(m + (size_t)(32 * rt + (lane & 31)) * D + 16 * ks + 8 * (lane >> 5)); }
__device__ __forceinline__ f32x16 nat(const bf16* am, int a, const bf16* bm, int b, int lane, f32x16 acc) {
#pragma unroll
    for (int ks = 0; ks < 4; ++ks) acc = MFMA32(nfrag(am, a, ks, lane), nfrag(bm, b, ks, lane), acc);
    return acc; }
__device__ __forceinline__ f32x16 dl_copy(const bf16* am, int a, int ct, int lane) {
    f32x16 acc = {};
#pragma unroll
    for (int kk2 = 0; kk2 < 2; ++kk2) { const int ks = 2 * ct + kk2; bf16x8 id;
#pragma unroll
        for (int e = 0; e < 8; ++e) id[e] = (32 * ct + (lane & 31) == 16 * ks + 8 * (lane >> 5) + e) ? (short)0x3F80 : (short)0;
        acc = MFMA32(nfrag(am, a, ks, lane), id, acc); }
    return acc; }
__device__ __forceinline__ void mask_lt(f32x16& t, int lane) {
#pragma unroll
    for (int r = 0; r < 16; ++r) if (!(crow(r, lane >> 5) < (lane & 31))) t[r] = 0.f; }
__device__ __forceinline__ void mask_gt(f32x16& t, int lane) {
#pragma unroll
    for (int r = 0; r < 16; ++r) if (!(crow(r, lane >> 5) > (lane & 31))) t[r] = 0.f; }
__device__ __forceinline__ void mask_le(f32x16& t, int lane) {
#pragma unroll
    for (int r = 0; r < 16; ++r) if (!(crow(r, lane >> 5) <= (lane & 31))) t[r] = 0.f; }
__device__ __forceinline__ void add_eye(f32x16& t, int lane) {
#pragma unroll
    for (int r = 0; r < 16; ++r) if (crow(r, lane >> 5) == (lane & 31)) t[r] += 1.f; }

__device__ __forceinline__ void p3_prep(Frame& F, const Args& a) {
    const int lane = F.lane;
    const float* R = (const float*)(F.ws + WS_R); const float* K = (const float*)(F.ws + WS_K); const float* V = (const float*)(F.ws + WS_V);
    const float* LW = (const float*)(F.ws + WS_LW); const float* AA = (const float*)(F.ws + WS_AA);
    bf16* AT = (bf16*)(F.ws + WS_AT); bf16* RT = (bf16*)(F.ws + WS_RT); bf16* BH = (bf16*)(F.ws + WS_BH); bf16* KH = (bf16*)(F.ws + WS_KH); bf16* V16 = (bf16*)(F.ws + WS_V16);
    float* GC = (float*)(F.ws + WS_GC); float* C3 = (float*)(F.ws + WS_CS) + (size_t)2 * T * 16;
    for (int task = F.gw; task < NCH * 4; task += F.NGW) {
        const int c = task >> 2, hg = task & 3, col = hg * 256 + 4 * lane;
        const f32x4 k_k = *(const f32x4*)(a.in[13] + col), k_a = *(const f32x4*)(a.in[14] + col), r_k = *(const f32x4*)(a.in[15] + col);
        f32x4 lg = {0.f, 0.f, 0.f, 0.f};
        for (int tt = 0; tt < 64; ++tt) {
            const size_t o = (size_t)(64 * c + tt) * D + col;
            const f32x4 r = *(const f32x4*)(R + o), k = *(const f32x4*)(K + o), v = *(const f32x4*)(V + o), lw = *(const f32x4*)(LW + o), aa = *(const f32x4*)(AA + o);
            f32x4 kk = k * k_k;
            float ss = (kk[0] * kk[0] + kk[1] * kk[1]) + (kk[2] * kk[2] + kk[3] * kk[3]); ss = row16_sum(ss);
            kk = kk * (1.f / fmaxf(sqrtf(ss), 1e-12f));
            const f32x4 b = kk * aa, km = k * (1.f + (aa - 1.f) * k_a);
            float s3 = (r[0] * km[0] * r_k[0] + r[1] * km[1] * r_k[1]) + (r[2] * km[2] * r_k[2] + r[3] * km[3] * r_k[3]); s3 = row16_sum(s3);
            if ((lane & 15) == 0) C3[(size_t)(64 * c + tt) * 16 + hg * 4 + (lane >> 4)] = s3;
            const f32x4 lgm1 = lg; lg = lg + lw;
            f32x4 at, rt, bh, kh;
#pragma unroll
            for (int i = 0; i < 4; ++i) { const float em = __expf(lgm1[i]), ep = __expf(lg[i]), en = __expf(-lg[i]); at[i] = -kk[i] * em; rt[i] = r[i] * ep; bh[i] = b[i] * en; kh[i] = km[i] * en; }
            *(u32x2*)(AT + o) = (u32x2){pk2(at[0], at[1]), pk2(at[2], at[3])}; *(u32x2*)(RT + o) = (u32x2){pk2(rt[0], rt[1]), pk2(rt[2], rt[3])};
            *(u32x2*)(BH + o) = (u32x2){pk2(bh[0], bh[1]), pk2(bh[2], bh[3])}; *(u32x2*)(KH + o) = (u32x2){pk2(kh[0], kh[1]), pk2(kh[2], kh[3])};
            *(u32x2*)(V16 + o) = (u32x2){pk2(v[0], v[1]), pk2(v[2], v[3])};
        }
        f32x4 g; for (int i = 0; i < 4; ++i) g[i] = __expf(lg[i]);
        *(f32x4*)(GC + (size_t)c * D + col) = g;
    }
}

__device__ __forceinline__ void inv32(f32x16 N, f32x16 NT, f32x16& Tm, f32x16& TT, int lane) {
    Tm = N; TT = NT; add_eye(Tm, lane); add_eye(TT, lane);
    Pk Np = pack_tile(N), NTp = pack_tile(NT);
#pragma unroll
    for (int it = 0; it < 4; ++it) {
        const f32x16 z = {};
        const f32x16 N2 = xt(NTp, Np, z), N2T = xt(Np, NTp, z);
        const Pk N2p = pack_tile(N2), N2Tp = pack_tile(N2T), TTp = pack_tile(TT);
        Tm = xt(TTp, N2p, Tm);
        TT = xt(N2p, TTp, TT);
        Np = N2p; NTp = N2Tp;
    }
}

__device__ __forceinline__ void pa_chunk(Frame& F) {
    const int lane = F.lane, c32 = lane & 31, hh = lane >> 5;
    const bf16* AT = (const bf16*)(F.ws + WS_AT); const bf16* BH = (const bf16*)(F.ws + WS_BH); const bf16* KH = (const bf16*)(F.ws + WS_KH); const bf16* V16 = (const bf16*)(F.ws + WS_V16);
    const float* GC = (const float*)(F.ws + WS_GC);
    for (int task = F.gw; task < NCH * NH; task += F.NGW) {
        const int c = task >> 4, h = task & 15; const size_t o = (size_t)(64 * c) * D + h * 64;
        const bf16* at = AT + o; const bf16* bh = BH + o; const bf16* kh = KH + o; const bf16* vv = V16 + o;
        const f32x16 z = {};
        Pk T11, T22, T12, T11T, T22T, T12T;
        {
            f32x16 n = nat(bh, 0, at, 0, lane, z), nt = nat(at, 0, bh, 0, lane, z); mask_lt(n, lane); mask_gt(nt, lane);
            f32x16 t, tt; inv32(n, nt, t, tt, lane); T11 = pack_tile(t); T11T = pack_tile(tt);
            n = nat(bh, 1, at, 1, lane, z); nt = nat(at, 1, bh, 1, lane, z); mask_lt(n, lane); mask_gt(nt, lane);
            inv32(n, nt, t, tt, lane); T22 = pack_tile(t); T22T = pack_tile(tt);
            const Pk N12 = pack_tile(nat(bh, 0, at, 1, lane, z)), N12T = pack_tile(nat(at, 1, bh, 0, lane, z));
            const Pk Z1 = pack_tile(xt(N12T, T22, z));
            T12 = pack_tile(xt(T11T, Z1, z));
            const Pk Z2 = pack_tile(xt(N12, T11T, z));
            T12T = pack_tile(xt(T22, Z2, z));
        }
        {
            u32x4* tm = (u32x4*)(F.ws + WS_TM) + (size_t)task * 6 * 64 + lane;
            tm[0] = __builtin_bit_cast(u32x4, T11.k0); tm[64] = __builtin_bit_cast(u32x4, T11.k1); tm[128] = __builtin_bit_cast(u32x4, T12.k0); tm[192] = __builtin_bit_cast(u32x4, T12.k1);
            tm[256] = __builtin_bit_cast(u32x4, T22.k0); tm[320] = __builtin_bit_cast(u32x4, T22.k1);
        }
        const float g0 = GC[(size_t)c * D + h * 64 + c32], g1 = GC[(size_t)c * D + h * 64 + 32 + c32];
        Pk W1p[2][2];
#pragma unroll
        for (int b = 0; b < 2; ++b) { const float gcol = b == 0 ? g0 : g1;
            f32x16 bb0 = dl_copy(bh, 0, b, lane), bb1 = dl_copy(bh, 1, b, lane);
#pragma unroll
            for (int r = 0; r < 16; ++r) { bb0[r] *= gcol; bb1[r] *= gcol; }
            const Pk B0 = pack_tile(bb0), B1 = pack_tile(bb1);
            f32x16 w0 = xt(T11T, B0, z); w0 = xt(T12T, B1, w0);
            const f32x16 w1 = xt(T22T, B1, z);
            W1p[0][b] = pack_tile(w0); W1p[1][b] = pack_tile(w1); }
        {
            bf16* plr = (bf16*)(F.ws + WS_PLR) + (size_t)task * 4096;
#pragma unroll
            for (int a2 = 0; a2 < 2; ++a2) { const Pk A0 = pack_tile(dl_copy(at, 0, a2, lane)), A1 = pack_tile(dl_copy(at, 1, a2, lane));
#pragma unroll
                for (int b = 0; b < 2; ++b) { f32x16 p = xt(A0, W1p[0][b], z); p = xt(A1, W1p[1][b], p);
#pragma unroll
                    for (int g4 = 0; g4 < 4; ++g4) *(u32x2*)(plr + (32 * b + c32) * 64 + 32 * a2 + 8 * g4 + 4 * hh) = (u32x2){cvtpk(p[4 * g4], p[4 * g4 + 1]), cvtpk(p[4 * g4 + 2], p[4 * g4 + 3])}; } }
        }
        Pk M2p[2][2];
        {
            f32x16 e = nat(at, 0, kh, 0, lane, z); mask_gt(e, lane); const Pk E00 = pack_tile(e);
            e = nat(at, 1, kh, 1, lane, z); mask_gt(e, lane); const Pk E11 = pack_tile(e);
            const Pk E10 = pack_tile(nat(at, 1, kh, 0, lane, z));
#pragma unroll
            for (int b = 0; b < 2; ++b) { const float gcol = b == 0 ? g0 : g1;
                f32x16 m0 = xt(E00, W1p[0][b], z); m0 = xt(E10, W1p[1][b], m0);
                f32x16 m1 = xt(E11, W1p[1][b], z);
                const f32x16 k0 = dl_copy(kh, 0, b, lane), k1 = dl_copy(kh, 1, b, lane);
#pragma unroll
                for (int r = 0; r < 16; ++r) { m0[r] += k0[r] * gcol; m1[r] += k1[r] * gcol; }
                M2p[0][b] = pack_tile(m0); M2p[1][b] = pack_tile(m1); }
        }
        {
            float* qm = (float*)(F.ws + WS_QM) + (size_t)task * 4096;
#pragma unroll
            for (int b = 0; b < 2; ++b) { const Pk V0 = pack_tile(dl_copy(vv, 0, b, lane)), V1 = pack_tile(dl_copy(vv, 1, b, lane));
#pragma unroll
                for (int a2 = 0; a2 < 2; ++a2) { f32x16 q = xt(M2p[0][a2], V0, z); q = xt(M2p[1][a2], V1, q);
#pragma unroll
                    for (int g4 = 0; g4 < 4; ++g4) *(f32x4*)(qm + (32 * b + c32) * 64 + 32 * a2 + 8 * g4 + 4 * hh) = (f32x4){q[4 * g4], q[4 * g4 + 1], q[4 * g4 + 2], q[4 * g4 + 3]}; } }
        }
    }
}

__device__ __forceinline__ void pb_chain(Frame& F) {
    if (F.vcu >= NH || F.wave >= 4) return;
    const int lane = F.lane, n16 = lane & 15, q4 = lane >> 4, h = F.vcu, rg = F.wave;
    const bf16* PLR = (const bf16*)(F.ws + WS_PLR); const float* QM = (const float*)(F.ws + WS_QM); const float* GC = (const float*)(F.ws + WS_GC); bf16* S0 = (bf16*)(F.ws + WS_S0);
    f32x4 s[4];
#pragma unroll
    for (int m = 0; m < 4; ++m) s[m] = (f32x4){0.f, 0.f, 0.f, 0.f};
    u32x2 af[4][2][2]; f32x4 qv[4], gc[4];
#define PB_LOAD(cc) do { const size_t tk_ = (size_t)(cc) * 16 + h; const bf16* pl_ = PLR + tk_ * 4096; const float* qm_ = QM + tk_ * 4096 + (16 * rg + n16) * 64; const float* gp_ = GC + (size_t)(cc) * D + h * 64; \
        _Pragma("unroll") for (int m = 0; m < 4; ++m) { _Pragma("unroll") for (int kb = 0; kb < 2; ++kb) { af[m][kb][0] = *(const u32x2*)(pl_ + (16 * m + n16) * 64 + 32 * kb + 4 * q4); af[m][kb][1] = *(const u32x2*)(pl_ + (16 * m + n16) * 64 + 32 * kb + 16 + 4 * q4); } \
            qv[m] = *(const f32x4*)(qm_ + 16 * m + 4 * q4); gc[m] = *(const f32x4*)(gp_ + 16 * m + 4 * q4); } } while (0)
    PB_LOAD(0);
    for (int c = 0; c < NCH; ++c) {
        bf16* s0 = S0 + ((size_t)c * 16 + h) * 4096 + (16 * rg + n16) * 64;
        u32x2 sp[4];
#pragma unroll
        for (int m = 0; m < 4; ++m) { sp[m] = (u32x2){cvtpk(s[m][0], s[m][1]), cvtpk(s[m][2], s[m][3])}; *(u32x2*)(s0 + 16 * m + 4 * q4) = sp[m]; }
        const bf16x8 B0 = __builtin_bit_cast(bf16x8, (u32x4){sp[0].x, sp[0].y, sp[1].x, sp[1].y}), B1 = __builtin_bit_cast(bf16x8, (u32x4){sp[2].x, sp[2].y, sp[3].x, sp[3].y});
        f32x4 acc[4];
#pragma unroll
        for (int m = 0; m < 4; ++m) { acc[m] = s[m] * gc[m] + qv[m];
            acc[m] = __builtin_amdgcn_mfma_f32_16x16x32_bf16(__builtin_bit_cast(bf16x8, (u32x4){af[m][0][0].x, af[m][0][0].y, af[m][0][1].x, af[m][0][1].y}), B0, acc[m], 0, 0, 0);
            acc[m] = __builtin_amdgcn_mfma_f32_16x16x32_bf16(__builtin_bit_cast(bf16x8, (u32x4){af[m][1][0].x, af[m][1][0].y, af[m][1][1].x, af[m][1][1].y}), B1, acc[m], 0, 0, 0); }
        if (c + 1 < NCH) PB_LOAD(c + 1);
#pragma unroll
        for (int m = 0; m < 4; ++m) s[m] = acc[m];
    }
#undef PB_LOAD
}

__device__ __forceinline__ void pc_out(Frame& F) {
    const int lane = F.lane, c32 = lane & 31, hh = lane >> 5;
    const bf16* AT = (const bf16*)(F.ws + WS_AT); const bf16* RT = (const bf16*)(F.ws + WS_RT); const bf16* BH = (const bf16*)(F.ws + WS_BH); const bf16* KH = (const bf16*)(F.ws + WS_KH);
    const bf16* V16 = (const bf16*)(F.ws + WS_V16); const bf16* S0 = (const bf16*)(F.ws + WS_S0); float* Y = (float*)(F.ws + WS_Y);
    for (int task = F.gw; task < NCH * NH; task += F.NGW) {
        const int c = task >> 4, h = task & 15; const size_t o = (size_t)(64 * c) * D + h * 64;
        const bf16* at = AT + o; const bf16* rt = RT + o; const bf16* bh = BH + o; const bf16* kh = KH + o; const bf16* vv = V16 + o;
        const bf16* s0 = S0 + (size_t)task * 4096;
        const f32x16 z = {};
        auto s0frag = [&](int it, int ks) { return *(const bf16x8*)(s0 + (32 * it + c32) * 64 + 16 * ks + 8 * hh); };
        Pk Tm00, Tm01, Tm11;
        { const u32x4* tm = (const u32x4*)(F.ws + WS_TM) + (size_t)task * 6 * 64 + lane;
          Tm00.k0 = __builtin_bit_cast(bf16x8, tm[0]); Tm00.k1 = __builtin_bit_cast(bf16x8, tm[64]); Tm01.k0 = __builtin_bit_cast(bf16x8, tm[128]); Tm01.k1 = __builtin_bit_cast(bf16x8, tm[192]);
          Tm11.k0 = __builtin_bit_cast(bf16x8, tm[256]); Tm11.k1 = __builtin_bit_cast(bf16x8, tm[320]); }
        f32x16 e = nat(kh, 0, at, 0, lane, z); mask_lt(e, lane); const Pk K00 = pack_tile(e);
        e = nat(kh, 1, at, 1, lane, z); mask_lt(e, lane); const Pk K11 = pack_tile(e);
        const Pk K01 = pack_tile(nat(kh, 0, at, 1, lane, z));
#pragma unroll 1
        for (int b = 0; b < 2; ++b) {
            const Pk V0 = pack_tile(dl_copy(vv, 0, b, lane)), V1 = pack_tile(dl_copy(vv, 1, b, lane));
            f32x16 x0 = z, x1 = z;
#pragma unroll
            for (int ks = 0; ks < 4; ++ks) { const bf16x8 sf = s0frag(b, ks); x0 = MFMA32(nfrag(at, 0, ks, lane), sf, x0); x1 = MFMA32(nfrag(at, 1, ks, lane), sf, x1); }
            x0 = xt(K00, V0, x0);
            x1 = xt(K01, V0, x1); x1 = xt(K11, V1, x1);
            const Pk X0 = pack_tile(x0), X1 = pack_tile(x1);
            const Pk U0 = pack_tile(xt(Tm00, X0, z));
            f32x16 u1 = xt(Tm01, X0, z); u1 = xt(Tm11, X1, u1); const Pk U1 = pack_tile(u1);
            f32x16 y0 = z, y1 = z;
#pragma unroll
            for (int ks = 0; ks < 4; ++ks) { const bf16x8 sf = s0frag(b, ks); y0 = MFMA32(nfrag(rt, 0, ks, lane), sf, y0); y1 = MFMA32(nfrag(rt, 1, ks, lane), sf, y1); }
            { f32x16 m = nat(bh, 0, rt, 0, lane, z); mask_le(m, lane); const Pk R00 = pack_tile(m); y0 = xt(R00, U0, y0);
              const Pk R01 = pack_tile(nat(bh, 0, rt, 1, lane, z)); y1 = xt(R01, U0, y1);
              m = nat(bh, 1, rt, 1, lane, z); mask_le(m, lane); const Pk R11 = pack_tile(m); y1 = xt(R11, U1, y1); }
            { f32x16 m = nat(kh, 0, rt, 0, lane, z); mask_le(m, lane); const Pk R00 = pack_tile(m); y0 = xt(R00, V0, y0);
              const Pk R01 = pack_tile(nat(kh, 0, rt, 1, lane, z)); y1 = xt(R01, V0, y1);
              m = nat(kh, 1, rt, 1, lane, z); mask_le(m, lane); const Pk R11 = pack_tile(m); y1 = xt(R11, V1, y1); }
            float* yp = Y + (size_t)(64 * c) * D + h * 64 + 32 * b + c32;
#pragma unroll
            for (int r = 0; r < 16; ++r) { yp[(size_t)crow(r, hh) * D] = y0[r]; yp[(size_t)(32 + crow(r, hh)) * D] = y1[r]; }
        }
    }
}

__device__ __forceinline__ void p6_gn_rows(Frame& F, const Args& a) {
    const int lane = F.lane;
    const float* Y = (const float*)(F.ws + WS_Y); const bf16* V16 = (const bf16*)(F.ws + WS_V16); const float* G = (const float*)(F.ws + WS_G);
    const float* C3 = (const float*)(F.ws + WS_CS) + (size_t)2 * T * 16; bf16* Z = (bf16*)(F.ws + WS_Z);
    const Row gg = ld_row(a.in[16], lane), gb = ld_row(a.in[17], lane);
    for (int t = F.gw; t < T; t += F.NGW) {
        const size_t o = (size_t)t * D;
        const Row y = ld_row(Y + o, lane), g = ld_row(G + o, lane), v = ld_row_bf16(V16 + o, lane); Row zr;
#pragma unroll
        for (int j = 0; j < 4; ++j) {
            const float mean = row16_sum((y.v[j][0] + y.v[j][1]) + (y.v[j][2] + y.v[j][3])) * (1.f / 64.f);
            const f32x4 d = y.v[j] - mean;
            const float var = row16_sum((d[0] * d[0] + d[1] * d[1]) + (d[2] * d[2] + d[3] * d[3])) * (1.f / 64.f);
            const float rs = rsqrtf(var + GN_EPS), c3 = C3[(size_t)t * 16 + 4 * j + (lane >> 4)];
            zr.v[j] = (d * rs * gg.v[j] + gb.v[j] + c3 * v.v[j]) * g.v[j];
        }
        st_row_bf16(Z + o, lane, zr);
    }
}

__device__ __forceinline__ void p6_gn(Frame& F, const Args& a) {
    const int lane = F.lane, wave = F.wave;
    const float* YT = (const float*)(F.ws + WS_YT); const float* V = (const float*)(F.ws + WS_V); const float* G = (const float*)(F.ws + WS_G);
    const float* C3 = (const float*)(F.ws + WS_CS) + (size_t)2 * T * 16; bf16* Z = (bf16*)(F.ws + WS_Z);
    LAS float* tile = (LAS float*)F.lds;
    for (int unit = F.vcu; unit < NH * (T / 64); unit += F.G) {
        const int h = unit / (T / 64), t0 = (unit % (T / 64)) * 64;
        __syncthreads();
#pragma unroll
        for (int q = 0; q < 8; ++q) { const int i = wave * 8 + q; tile[i * 65 + lane] = YT[(size_t)(h * 64 + i) * T + t0 + lane]; }
        __syncthreads();
        const float gg = a.in[16][h * 64 + lane], gb = a.in[17][h * 64 + lane];
#pragma unroll
        for (int q = 0; q < 8; ++q) { const int tt = wave * 8 + q, t = t0 + tt;
            const float y = tile[lane * 65 + tt];
            const float mean = wave_sum(y) * (1.f / 64.f); const float dlt = y - mean; const float var = wave_sum(dlt * dlt) * (1.f / 64.f);
            const size_t o = (size_t)t * D + h * 64 + lane;
            const float z = (dlt * rsqrtf(var + GN_EPS) * gg + gb + C3[(size_t)t * 16 + h] * V[o]) * G[o];
            Z[o] = (bf16)f2bf(z); }
    }
    __syncthreads();
}

__device__ __forceinline__ void p8_norm(Frame& F, const float* g, bf16* U) {
    const float* Hs = (const float*)(F.ws + WS_H); const Row gr = ld_row(g, F.lane);
    for (int t = F.gw; t < T; t += F.NGW) st_row_bf16(U + (size_t)t * D, F.lane, rmsnorm_row(ld_row(Hs + (size_t)t * D, F.lane), gr));
}
__device__ __forceinline__ void p11_norm_forget(Frame& F, const Args& a) {
    const int lane = F.lane; const float* Hs = (const float*)(F.ws + WS_H); bf16* U = (bf16*)(F.ws + WS_U3); float* LF = (float*)(F.ws + WS_LF);
    LAS float* wf = (LAS float*)F.lds;
    __syncthreads();
    for (int i = F.tid; i < 16 * D; i += NTHREADS) { const int hh = i & 15, k = i >> 4; wf[hh * D + k] = a.in[19][(size_t)k * WIN_LD + 4 * D + hh]; }
    __syncthreads();
    const Row gr = ld_row(a.in[1] + 2 * D, lane);
    for (int t = F.gw; t < T; t += F.NGW) {
        const Row u = rmsnorm_row(ld_row(Hs + (size_t)t * D, lane), gr);
        st_row_bf16(U + (size_t)t * D, lane, u);
        float mine = 0.f;
#pragma unroll 2
        for (int hh = 0; hh < 16; ++hh) { float s = 0.f;
#pragma unroll
            for (int j = 0; j < 4; ++j) { const f32x4 w = *(const LAS f32x4*)(wf + hh * D + 256 * j + 4 * lane); s += (u.v[j][0] * w[0] + u.v[j][1] * w[1]) + (u.v[j][2] * w[2] + u.v[j][3] * w[3]); }
            s = wave_sum(s); if (lane == hh) mine = s; }
        if (lane < 16) { const float x = mine + a.in[20][lane]; LF[(size_t)t * 16 + lane] = fminf(x, 0.f) - log1pf(__expf(-fabsf(x))); }
    }
    __syncthreads();
}
__device__ __forceinline__ void p13_cumsum_qknorm(Frame& F, const Args& a) {
    const int lane = F.lane, tid = F.tid;
    const float* LF = (const float*)(F.ws + WS_LF); float* C2 = (float*)(F.ws + WS_C2); float* CB = (float*)(F.ws + WS_CB);
    if (F.vcu < NH) {
        const int h = F.vcu; LAS double* part = (LAS double*)F.lds;
        __syncthreads();
        const int tb = tid * 32; double s = 0.0;
        for (int i = 0; i < 32; ++i) s += (double)LF[(size_t)(tb + i) * 16 + h];
        part[tid] = s; __syncthreads();
        if (tid == 0) { double run = 0.0; for (int i = 0; i < NTHREADS; ++i) { const double v = part[i]; part[i] = run; run += v; } }
        __syncthreads();
        double run = part[tid];
        for (int i = 0; i < 32; ++i) { run += (double)LF[(size_t)(tb + i) * 16 + h]; const float c = (float)(run * 1.4426950408889634); C2[(size_t)h * T + tb + i] = c; if (((tb + i) & 63) == 63) CB[h * 256 + ((tb + i) >> 6)] = c; }
        __syncthreads();
    }
    bf16* Q = (bf16*)(F.ws + WS_QKVG);
    f32x4 gq[4], gk[4];
#pragma unroll
    for (int j = 0; j < 4; ++j) { const int c = (4 * lane + 256 * j) & 63; gq[j] = *(const f32x4*)(a.in[21] + c) * (0.125f * LOG2E); gk[j] = *(const f32x4*)(a.in[22] + c); }
    for (int t = F.gw; t < T; t += F.NGW) {
#pragma unroll
        for (int which = 0; which < 2; ++which) {
            bf16* p = Q + (size_t)t * 4096 + which * D;
            Row x = ld_row_bf16(p, lane);
#pragma unroll
            for (int j = 0; j < 4; ++j) { float ss = (x.v[j][0] * x.v[j][0] + x.v[j][1] * x.v[j][1]) + (x.v[j][2] * x.v[j][2] + x.v[j][3] * x.v[j][3]); ss = row16_sum(ss);
                const float rs = rsqrtf(ss * (1.f / 64.f) + RMS_EPS); x.v[j] = x.v[j] * rs * (which == 0 ? gq[j] : gk[j]); }
            st_row_bf16(p, lane, x);
        }
    }
}

constexpr int KP = 144;
__device__ __forceinline__ void p14_attention(Frame& F, const Args& a, int qword = CW_ATTQ) {
    const int tid = F.tid, lane = F.lane, wid = F.wave, r32 = lane & 31, hi = lane >> 5;
    const bf16* QKVG = (const bf16*)(F.ws + WS_QKVG); const float* C2 = (const float*)(F.ws + WS_C2); const float* CB = (const float*)(F.ws + WS_CB);
    bf16* Z2 = (bf16*)(F.ws + WS_Z2);
    LAS unsigned char* Ks = F.lds; LAS unsigned char* Vs = F.lds + 64 * KP; LAS float* bias = (LAS float*)(F.lds + 2 * 64 * KP); LAS int* uslot = (LAS int*)(F.lds + 2 * 64 * KP + 256);
    float mq = 0.f, mk = 0.f;
    for (int i = 0; i < 64; ++i) { mq = fmaxf(mq, fabsf(a.in[21][i])); mk = fmaxf(mk, fabsf(a.in[22][i])); }
    const float THR2 = (2.f * 8.f * mq * mk * 1.01f + 30.f) * LOG2E;
    gu32* qctr = F.ctl + qword;
    for (;;) {
        __syncthreads();
        if (tid == 0) uslot[0] = (int)__hip_atomic_fetch_add(qctr, 1u, RLX_AGENT);
        __syncthreads();
        const int unit = uslot[0];
        if (unit >= NH * (T / 256)) break;
        const int h = unit & 15, qb = (T / 256 - 1) - (unit >> 4), q0 = qb * 256;
        const float ct0 = C2[(size_t)h * T + q0];
        int jstart = 0;
        { int tot = 0; for (int j0 = 0; j0 < 4 * qb; j0 += 64) { const int j = j0 + lane; const bool skip = (j < 4 * qb) && ((ct0 - CB[h * 256 + j]) < -THR2); tot += __popcll(__ballot(skip)); } jstart = tot; }
        const int jend = 4 * qb + 3;
        const int qrow = q0 + wid * 32 + r32;
        bf16x8 qr[4];
#pragma unroll
        for (int d0 = 0; d0 < 4; ++d0) qr[d0] = *(const bf16x8*)(QKVG + (size_t)qrow * 4096 + h * 64 + d0 * 16 + hi * 8);
        f32x16 o0 = {}, o1 = {}; float m = -INFINITY, l = 0.f;
        const int lrow = tid >> 3, lch = tid & 7;
        u32x4 kreg, vreg; float breg = 0.f;
        auto gload = [&](int j) { const size_t row = (size_t)(64 * j + lrow) * 4096 + h * 64 + lch * 8;
            kreg = *(const u32x4*)(QKVG + row + D); vreg = *(const u32x4*)(QKVG + row + 2 * D); if (tid < 64) breg = -C2[(size_t)h * T + 64 * j + tid]; };
        gload(jstart);
        for (int j = jstart; j <= jend; ++j) {
            __syncthreads();
            *(LAS u32x4*)(Ks + lrow * KP + lch * 16) = kreg;
            { const int s_ = lrow >> 4, x_ = lrow & 15, p_ = s_ * 16 + ((x_ >> 2) & 1) * 8 + (((x_ >> 3) << 2) | (x_ & 3));
                const unsigned w_[4] = {vreg.x, vreg.y, vreg.z, vreg.w};
#pragma unroll
                for (int e = 0; e < 8; ++e) *(LAS unsigned short*)(Vs + (lch * 8 + e) * KP + p_ * 2) = (unsigned short)(w_[e >> 1] >> ((e & 1) * 16)); }
            if (tid < 64) bias[tid] = breg;
            __syncthreads();
            if (j < jend) gload(j + 1);
            f32x16 p0 = {}, p1 = {};
#pragma unroll
            for (int d0 = 0; d0 < 4; ++d0) {
                const bf16x8 k0 = *(const LAS bf16x8*)(Ks + r32 * KP + d0 * 32 + hi * 16);
                const bf16x8 k1 = *(const LAS bf16x8*)(Ks + (32 + r32) * KP + d0 * 32 + hi * 16);
                p0 = __builtin_amdgcn_mfma_f32_32x32x16_bf16(k0, qr[d0], p0, 0, 0, 0);
                p1 = __builtin_amdgcn_mfma_f32_32x32x16_bf16(k1, qr[d0], p1, 0, 0, 0);
            }
#pragma unroll
            for (int g4 = 0; g4 < 4; ++g4) { const f32x4 b0 = *(const LAS f32x4*)(bias + 8 * g4 + 4 * hi), b1 = *(const LAS f32x4*)(bias + 32 + 8 * g4 + 4 * hi);
#pragma unroll
                for (int i = 0; i < 4; ++i) { p0[4 * g4 + i] += b0[i]; p1[4 * g4 + i] += b1[i]; } }
            if (j >= 4 * qb) {
                const int kb = 64 * j;
#pragma unroll
                for (int r = 0; r < 16; ++r) { const int kv = kb + crow(r, hi); if (kv > qrow) p0[r] = -INFINITY; if (kv + 32 > qrow) p1[r] = -INFINITY; }
            }
            float mloc = fmaxf(p0[0], p1[0]);
#pragma unroll
            for (int r = 1; r < 16; ++r) mloc = fmaxf(mloc, fmaxf(p0[r], p1[r]));
            mloc = fmaxf(mloc, __shfl_xor(mloc, 32));
            const float mnew = fmaxf(m, mloc);
            const float alpha = exp2f(m - mnew);
            float ls = 0.f;
#pragma unroll
            for (int r = 0; r < 16; ++r) { p0[r] = exp2f(p0[r] - mnew); p1[r] = exp2f(p1[r] - mnew); ls += p0[r] + p1[r]; }
            l = l * alpha + ls; m = mnew;
#pragma unroll
            for (int r = 0; r < 16; ++r) { o0[r] *= alpha; o1[r] *= alpha; }
#pragma unroll
            for (int s = 0; s < 4; ++s) {
                u32x4 pw;
                if (s == 0) pw = (u32x4){pk2(p0[0], p0[1]), pk2(p0[2], p0[3]), pk2(p0[4], p0[5]), pk2(p0[6], p0[7])};
                else if (s == 1) pw = (u32x4){pk2(p0[8], p0[9]), pk2(p0[10], p0[11]), pk2(p0[12], p0[13]), pk2(p0[14], p0[15])};
                else if (s == 2) pw = (u32x4){pk2(p1[0], p1[1]), pk2(p1[2], p1[3]), pk2(p1[4], p1[5]), pk2(p1[6], p1[7])};
                else pw = (u32x4){pk2(p1[8], p1[9]), pk2(p1[10], p1[11]), pk2(p1[12], p1[13]), pk2(p1[14], p1[15])};
                const bf16x8 pf = __builtin_bit_cast(bf16x8, pw);
                const bf16x8 v0 = *(const LAS bf16x8*)(Vs + r32 * KP + s * 32 + hi * 16);
                const bf16x8 v1 = *(const LAS bf16x8*)(Vs + (32 + r32) * KP + s * 32 + hi * 16);
                o0 = __builtin_amdgcn_mfma_f32_32x32x16_bf16(v0, pf, o0, 0, 0, 0);
                o1 = __builtin_amdgcn_mfma_f32_32x32x16_bf16(v1, pf, o1, 0, 0, 0);
            }
        }
        l += __shfl_xor(l, 32);
        const float rl = 1.f / l;
#pragma unroll
        for (int dt = 0; dt < 2; ++dt)
#pragma unroll
            for (int g4 = 0; g4 < 4; ++g4) { const int d = 32 * dt + 8 * g4 + 4 * hi; const size_t col = (size_t)h * 64 + d;
                const u32x2 ogw = *(const u32x2*)(QKVG + (size_t)qrow * 4096 + 3 * D + col);
                const float og[4] = {bflo(ogw.x), bfhi(ogw.x), bflo(ogw.y), bfhi(ogw.y)}; float ov[4];
#pragma unroll
                for (int i = 0; i < 4; ++i) ov[i] = (dt == 0 ? o0[4 * g4 + i] : o1[4 * g4 + i]) * rl * sigmoidf_(og[i]);
                u32x2 w; w.x = pk2(ov[0], ov[1]); w.y = pk2(ov[2], ov[3]);
                *(u32x2*)(Z2 + (size_t)qrow * D + col) = w; }
    }
}

struct TokInfo { int e0, e1, p0, p1; float g0, g1; int d0, d1; };
__device__ __forceinline__ void p16_router(Frame& F, const Args& a) {
    const int lane = F.lane, tid = F.tid; const float* Hs = (const float*)(F.ws + WS_H); bf16* U = (bf16*)(F.ws + WS_U4);
    TokInfo* TI = (TokInfo*)(F.ws + WS_TOK);
    LAS float* wr_ = (LAS float*)F.lds;
    LAS int* lcnt = (LAS int*)(F.lds + 32768);
    const Row gr = ld_row(a.in[1] + 3 * D, lane);
    __syncthreads();
    for (int i = tid; i < NE * D; i += NTHREADS) { const int e = i & 7, k = i >> 3; wr_[e * D + k] = a.in[26][(size_t)k * NE + e]; }
    for (int tb = F.vcu * 64; tb < T; tb += F.G * 64) {
        __syncthreads();
        if (tid < 16) lcnt[tid] = 0;
        __syncthreads();
        int e0s[8], e1s[8], p0s[8], p1s[8]; float g0s[8];
#pragma unroll
        for (int q = 0; q < 8; ++q) { const int t = tb + F.wave * 8 + q;
            const Row u = rmsnorm_row(ld_row(Hs + (size_t)t * D, lane), gr);
            st_row_bf16(U + (size_t)t * D, lane, u);
            float lg[NE];
#pragma unroll
            for (int e = 0; e < NE; ++e) { float s = 0.f;
#pragma unroll
                for (int j = 0; j < 4; ++j) { const f32x4 w = *(const LAS f32x4*)(wr_ + e * D + 256 * j + 4 * lane); s += (u.v[j][0] * w[0] + u.v[j][1] * w[1]) + (u.v[j][2] * w[2] + u.v[j][3] * w[3]); }
                lg[e] = wave_sum(s); }
            int b0 = 0; float v0 = lg[0];
#pragma unroll
            for (int e = 1; e < NE; ++e) if (lg[e] > v0) { v0 = lg[e]; b0 = e; }
            int b1 = -1; float v1 = -INFINITY;
#pragma unroll
            for (int e = 0; e < NE; ++e) if (e != b0 && lg[e] > v1) { v1 = lg[e]; b1 = e; }
            e0s[q] = b0; e1s[q] = b1; g0s[q] = 1.f / (1.f + __expf(v1 - v0));
            int pa = 0, pb = 0;
            if (lane == 0) { pa = atomicAdd((int*)&lcnt[b0], 1); pb = atomicAdd((int*)&lcnt[b1], 1); }
            p0s[q] = pa; p1s[q] = pb;
        }
        __syncthreads();
        if (tid < NE) lcnt[8 + tid] = (int)__hip_atomic_fetch_add(F.ctl + CW_CNT + 64 * tid, (unsigned)lcnt[tid], RLX_AGENT);
        __syncthreads();
        if (lane == 0) {
#pragma unroll
            for (int q = 0; q < 8; ++q) { const int t = tb + F.wave * 8 + q; TokInfo ti; ti.e0 = e0s[q]; ti.e1 = e1s[q]; ti.p0 = lcnt[8 + e0s[q]] + p0s[q]; ti.p1 = lcnt[8 + e1s[q]] + p1s[q];
                ti.g0 = g0s[q]; ti.g1 = 1.f - g0s[q]; ti.d0 = 0; ti.d1 = 0; TI[t] = ti; }
        }
    }
    __syncthreads();
}
__device__ __forceinline__ int moe_ends(Frame& F, LAS int* ends) {
    __syncthreads();
    if (F.tid == 0) { int run = 0; for (int e = 0; e < NE; ++e) { const int c = (int)__hip_atomic_load(F.ctl + CW_CNT + 64 * e, RLX_AGENT); run += (c + 255) >> 8; ends[e] = run; } }
    __syncthreads();
    return ends[NE - 1];
}
__device__ __forceinline__ void p17_gather(Frame& F) {
    LAS int* ends = (LAS int*)(F.lds + RING_BYTES);
    moe_ends(F, ends);
    const bf16* U = (const bf16*)(F.ws + WS_U4); bf16* AM = (bf16*)(F.ws + WS_AM); TokInfo* TI = (TokInfo*)(F.ws + WS_TOK);
    for (int t = F.gw; t < T; t += F.NGW) {
        const TokInfo ti = TI[t];
        const int d0 = (ti.e0 ? ends[ti.e0 - 1] : 0) * 256 + ti.p0, d1 = (ti.e1 ? ends[ti.e1 - 1] : 0) * 256 + ti.p1;
        const u32x4* src = (const u32x4*)(U + (size_t)t * D) + F.lane; const u32x4 x0 = src[0], x1 = src[64];
        u32x4* o0 = (u32x4*)(AM + (size_t)d0 * D) + F.lane; o0[0] = x0; o0[64] = x1;
        u32x4* o1 = (u32x4*)(AM + (size_t)d1 * D) + F.lane; o1[0] = x0; o1[64] = x1;
        if (F.lane == 0) { TI[t].d0 = d0; TI[t].d1 = d1; }
    }
}
__device__ __forceinline__ void p20_combine(Frame& F, const Args& a) {
    const int lane = F.lane; const float* Hs = (const float*)(F.ws + WS_H); const bf16* YS = (const bf16*)(F.ws + WS_YS); const TokInfo* TI = (const TokInfo*)(F.ws + WS_TOK);
    const Row gr = ld_row(a.in[2], lane);
    for (int t = F.gw; t < T; t += F.NGW) {
        const TokInfo ti = TI[t];
        Row hrow = ld_row(Hs + (size_t)t * D, lane); const Row y0 = ld_row_bf16(YS + (size_t)ti.d0 * D, lane), y1 = ld_row_bf16(YS + (size_t)ti.d1 * D, lane);
#pragma unroll
        for (int j = 0; j < 4; ++j) hrow.v[j] = hrow.v[j] + ti.g0 * y0.v[j] + ti.g1 * y1.v[j];
        st_row(a.out + (size_t)t * D, lane, rmsnorm_row(hrow, gr));
    }
}

constexpr int N_PHASES = 21;
__global__ void __launch_bounds__(NTHREADS, 2) trunk_fwd(Args args) {
    extern __shared__ __attribute__((aligned(16))) unsigned char lds_raw[];
    Frame F;
    F.lds = (LAS unsigned char*)lds_raw; F.ws = args.ws; F.ctl = (gu32*)(args.ws + WS_CTL);
    F.tid = threadIdx.x; F.lane = F.tid & 63; F.wave = __builtin_amdgcn_readfirstlane(F.tid >> 6);
    F.G = gridDim.x; { const int bx = blockIdx.x; F.vcu = (F.G % 8 == 0) ? (bx % 8) * (F.G / 8) + bx / 8 : bx; }
    F.gw = F.vcu * NWAVES + F.wave; F.NGW = F.G * NWAVES;
    volatile LAS unsigned* MISC = (volatile LAS unsigned*)(F.lds + MISC_OFF);
    for (int u = F.tid; u < (LDS_BYTES - RING_BYTES) / 4; u += NTHREADS) ((LAS unsigned*)(F.lds + RING_BYTES))[u] = 0u;
    __syncthreads();
    const int lo = args.ph_lo, hi = args.ph_hi;
    const bool use_bar = (hi - lo) > 1;
    XcdBarrier bar; bar.bar = (unsigned*)(F.ctl + CW_BAR); bar.x = 0; bar.st = nullptr;
    if (use_bar) bar = xcd_barrier_post((unsigned*)(F.ctl + CW_BAR), MISC + 8);
#ifdef ONLY_PHASE
#define IN(k) ((k) == ONLY_PHASE && lo <= (k) && (k) < hi)
#else
#define IN(k) (lo <= (k) && (k) < hi)
#endif
#define SEAM(k) do { if (IN((k) + 1)) xcd_barrier(bar); } while (0)
    unsigned char* ws = args.ws;
    const int c = (int)blockIdx.x;
    LAS unsigned char* ring = F.lds;

    if (IN(0)) { p0_prologue(F, args); if (DUP_PHASE == 0) { xcd_barrier(bar); p0_prologue(F, args); } p1_shift(F, args); SEAM(0); }
    if (IN(1)) {
        { pg8::Gemm g{D, D, D}; pg8::SchedRKV S; S.o.init(T / 256, 12, F.G, c); S.A = (const char*)(ws + WS_XS); S.B = (const char*)(ws + WS_W_RKV); S.astep = (size_t)256 * D * 2; S.bstep = (size_t)256 * D * 2; S.azstride = (size_t)T * D * 2;
          pg8::EpiRKV E{(float*)(ws + WS_R), (size_t)T * D};
          pg8::gemm_phase<pg8::EpiRKV, pg8::SchedRKV, true>(ring, g, S, E); }
        { pg8::Gemm g{D, 2 * D, 2 * D}; pg8::SchedPlain S; S.o.init(T / 256, 1, F.G, c); S.A = (const char*)(ws + WS_UB); S.B = (const char*)(ws + WS_W_L1); S.astep = (size_t)256 * D * 2; S.bstep = (size_t)256 * 2 * D * 2;
          pg8::EpiL1 E{(bf16*)(ws + WS_L1)};
          pg8::gemm_phase<pg8::EpiL1, pg8::SchedPlain, true>(ring, g, S, E); }
        SEAM(1); }
    if (IN(2)) {
        pg8::Gemm g{256, 256, 256}; pg8::SchedPlain S; S.o.init(T / 256, 12, F.G, c); S.A = (const char*)(ws + WS_L1); S.B = (const char*)(ws + WS_W_L2); S.astep = (size_t)256 * 256 * 2; S.bstep = (size_t)256 * 256 * 2;
        static_assert(WS_AA - WS_LW == WS_G - WS_AA, "LW, AA, G evenly spaced");
        pg8::EpiL2 E{(float*)(ws + WS_LW), args.in[5], args.in[8]};
        pg8::gemm_phase<pg8::EpiL2, pg8::SchedPlain, true>(ring, g, S, E);
        SEAM(2); }
    if (IN(3)) { p3_prep(F, args); SEAM(3); }
    if (IN(4)) { pa_chunk(F); SEAM(4); }
    if (IN(5)) { pb_chain(F); SEAM(5); }
    if (IN(6)) { pc_out(F); SEAM(6); }
    if (IN(7)) { p6_gn_rows(F, args); SEAM(7); }
    if (IN(8)) {
        pg8::Gemm g{D, D, D}; pg8::SchedPlain S; S.o.init(T / 256, 4, F.G, c); S.A = (const char*)(ws + WS_Z); S.B = (const char*)(ws + WS_W_O0); S.astep = (size_t)256 * D * 2; S.bstep = (size_t)256 * D * 2;
        pg8::EpiRes E{args.in[0], (float*)(ws + WS_H)};
        pg8::gemm_phase<pg8::EpiRes, pg8::SchedPlain, true>(ring, g, S, E);
        SEAM(8); }
    if (IN(9)) { p8_norm(F, args.in[1] + D, (bf16*)(ws + WS_U2)); SEAM(9); }
    if (IN(10)) {
        pg8::Gemm g{D, D, D}; pg8::SchedPlain S; S.o.init(T / 256, 2 * FF / 256, F.G, c); S.A = (const char*)(ws + WS_U2); S.B = (const char*)(ws + WS_W_GU); S.astep = (size_t)256 * D * 2; S.bstep = (size_t)256 * D * 2;
        pg8::EpiSwiGLU E{(bf16*)(ws + WS_ACT)};
        pg8::gemm_phase<pg8::EpiSwiGLU, pg8::SchedPlain, true>(ring, g, S, E);
        SEAM(10); }
    if (IN(11)) {
        pg8::Gemm g{FF, FF, FF}; pg8::SchedPlain S; S.o.init(T / 256, 4, F.G, c); S.A = (const char*)(ws + WS_ACT); S.B = (const char*)(ws + WS_W_DN); S.astep = (size_t)256 * FF * 2; S.bstep = (size_t)256 * FF * 2;
        pg8::EpiRes E{(const float*)(ws + WS_H), (float*)(ws + WS_H)};
        pg8::gemm_phase<pg8::EpiRes, pg8::SchedPlain, true>(ring, g, S, E);
        SEAM(11); }
    if (IN(12)) { p11_norm_forget(F, args); SEAM(12); }
    if (IN(13)) {
        pg8::Gemm g{D, D, D}; pg8::SchedPlain S; S.o.init(T / 256, 16, F.G, c); S.A = (const char*)(ws + WS_U3); S.B = (const char*)(ws + WS_W_IN); S.astep = (size_t)256 * D * 2; S.bstep = (size_t)256 * D * 2;
        pg8::EpiBf16 E{(bf16*)(ws + WS_QKVG), 4096};
        pg8::gemm_phase<pg8::EpiBf16, pg8::SchedPlain, true>(ring, g, S, E);
        SEAM(13); }
    if (IN(14)) { p13_cumsum_qknorm(F, args); SEAM(14); }
    if (IN(15)) { p14_attention(F, args); if (DUP_PHASE == 15) { xcd_barrier(bar); p14_attention(F, args, CW_ATTQ + 64); } SEAM(15); }
    if (IN(16)) {
        pg8::Gemm g{D, D, D}; pg8::SchedPlain S; S.o.init(T / 256, 4, F.G, c); S.A = (const char*)(ws + WS_Z2); S.B = (const char*)(ws + WS_W_FO); S.astep = (size_t)256 * D * 2; S.bstep = (size_t)256 * D * 2;
        pg8::EpiRes E{(const float*)(ws + WS_H), (float*)(ws + WS_H)};
        pg8::gemm_phase<pg8::EpiRes, pg8::SchedPlain, true>(ring, g, S, E);
        SEAM(16); }
    if (IN(17)) { p16_router(F, args); SEAM(17); }
    if (IN(18)) { p17_gather(F); SEAM(18); }
    if (IN(19)) {
        LAS int* ends = (LAS int*)(F.lds + RING_BYTES); const int nblk = moe_ends(F, ends);
        pg8::Gemm g{D, D, D}; pg8::SchedMoe S; S.o.init(nblk, 2 * FF / 256, F.G, c); S.A = (const char*)(ws + WS_AM); S.B = (const char*)(ws + WS_W_MGU); S.astep = (size_t)256 * D * 2; S.bstep = (size_t)256 * D * 2; S.bestride = (size_t)2 * FF * D * 2; S.ends = ends;
        pg8::EpiSwiGLU E{(bf16*)(ws + WS_ACT2)};
        pg8::gemm_phase<pg8::EpiSwiGLU, pg8::SchedMoe, true>(ring, g, S, E);
        SEAM(19); }
    if (IN(20)) {
        LAS int* ends = (LAS int*)(F.lds + RING_BYTES); const int nblk = moe_ends(F, ends);
        pg8::Gemm g{FF, FF, FF}; pg8::SchedMoe S; S.o.init(nblk, 4, F.G, c); S.A = (const char*)(ws + WS_ACT2); S.B = (const char*)(ws + WS_W_MDN); S.astep = (size_t)256 * FF * 2; S.bstep = (size_t)256 * FF * 2; S.bestride = (size_t)D * FF * 2; S.ends = ends;
        pg8::EpiBf16 E{(bf16*)(ws + WS_YS), D};
        pg8::gemm_phase<pg8::EpiBf16, pg8::SchedMoe, true>(ring, g, S, E);
        SEAM(20); }
    if (IN(21)) { p20_combine(F, args); }
#undef IN
#undef SEAM
}

extern "C" void kernel_launch(void* const* d_in, const int* in_sizes, int n_in, void* d_out, int out_size, void* d_ws, size_t ws_size, hipStream_t stream) {
    static int grid = 0;
    if (grid == 0) {
        if (n_in != 29 || out_size != T * D || ws_size < WS_END) { fprintf(stderr, "kernel_launch: unexpected problem (n_in %d out %d ws %zu)\n", n_in, out_size, ws_size); grid = -1; return; }
        int dev = 0, cus = 0;
        if (hipGetDevice(&dev) != hipSuccess || hipDeviceGetAttribute(&cus, hipDeviceAttributeMultiprocessorCount, dev) != hipSuccess) { grid = -1; return; }
        if (hipFuncSetAttribute((const void*)trunk_fwd, hipFuncAttributeMaxDynamicSharedMemorySize, LDS_BYTES) != hipSuccess) { fprintf(stderr, "kernel_launch: hipFuncSetAttribute failed\n"); grid = -1; return; }
        int per_cu = 0;
        if (hipOccupancyMaxActiveBlocksPerMultiprocessor(&per_cu, (const void*)trunk_fwd, NTHREADS, LDS_BYTES) != hipSuccess || per_cu < 1) fprintf(stderr, "kernel_launch: occupancy query says %d\n", per_cu);
        (void)hipGetLastError();
        grid = cus;
    }
    if (grid < 0) return;
    (void)hipMemsetAsync((char*)d_ws + WS_CTL, 0, CTL_ZERO_BYTES, stream);
    Args a{};
    for (int i = 0; i < 29; ++i) a.in[i] = (const float*)d_in[i];
    a.out = (float*)d_out; a.ws = (unsigned char*)d_ws;
    constexpr int NPH = 22;
    if (LAUNCH_MODE == 1) { a.ph_lo = 0; a.ph_hi = NPH; hipLaunchKernelGGL(trunk_fwd, dim3(grid), dim3(NTHREADS), LDS_BYTES, stream, a); }
    else for (int p = 0; p < NPH; ++p) { a.ph_lo = p; a.ph_hi = p + 1; hipLaunchKernelGGL(trunk_fwd, dim3(grid), dim3(NTHREADS), LDS_BYTES, stream, a); }
}
```

```cpp
#include <hip/hip_runtime.h>
#include <cstdio>
#include <cstdint>

#ifndef DUP_PHASE
#define DUP_PHASE -1
#endif
#ifndef LAUNCH_MODE
#define LAUNCH_MODE 1
#endif

#define GAS __attribute__((address_space(1)))
#define LAS __attribute__((address_space(3)))
typedef unsigned short bf16;
typedef short bf16x8 __attribute__((ext_vector_type(8)));
typedef float f32x4 __attribute__((ext_vector_type(4)));
typedef float f32x2 __attribute__((ext_vector_type(2)));
typedef float f32x16 __attribute__((ext_vector_type(16)));
typedef unsigned u32x4 __attribute__((ext_vector_type(4)));
typedef unsigned u32x2 __attribute__((ext_vector_type(2)));
typedef GAS unsigned gu32;
#define RLX_AGENT __ATOMIC_RELAXED, __HIP_MEMORY_SCOPE_AGENT

constexpr int T = 16384, D = 1024, NH = 16, HD = 64, FF = 3584, NE = 8, WIN_LD = 4 * D + NH;
constexpr int NWAVES = 8, NTHREADS = 512;
constexpr float RMS_EPS = 1e-6f, GN_EPS = 64e-5f;
constexpr int MOE_ROWS = (2 * T / 256 + NE) * 256;
constexpr float LOG2E = 1.4426950408889634f;

constexpr size_t MiB = 1u << 20;
constexpr size_t WS_CTL = 0, CTL_ZERO_BYTES = 1 * MiB;
constexpr size_t WS_W_RKV = 2 * MiB, WS_W_L1 = 8 * MiB, WS_W_L2 = 9 * MiB, WS_W_O0 = 11 * MiB, WS_W_GU = 13 * MiB, WS_W_DN = 27 * MiB,
                 WS_W_IN = 34 * MiB, WS_W_FO = 42 * MiB, WS_W_MGU = 44 * MiB, WS_W_MDN = 156 * MiB;
constexpr size_t WS_H = 216 * MiB;
constexpr size_t WS_UB = 280 * MiB, WS_XS = 313 * MiB;
constexpr size_t WS_KK = 280 * MiB, WS_BB = 344 * MiB;
constexpr size_t WS_Z = 280 * MiB, WS_U2 = 344 * MiB;
constexpr size_t WS_U3 = 280 * MiB, WS_Z2 = 312 * MiB, WS_U4 = 280 * MiB, WS_AM = 312 * MiB;
constexpr size_t WS_R = 410 * MiB, WS_K = 474 * MiB, WS_V = 538 * MiB;
constexpr size_t WS_ACT = 410 * MiB;
constexpr size_t WS_QKVG = 410 * MiB;
constexpr size_t WS_ACT2 = 410 * MiB;
constexpr size_t WS_LW = 602 * MiB, WS_AA = 666 * MiB, WS_G = 730 * MiB;
constexpr size_t WS_YT = 666 * MiB;
constexpr size_t WS_YS = 666 * MiB;
constexpr size_t WS_L1 = 794 * MiB;
constexpr size_t WS_CS = 802 * MiB;
constexpr size_t WS_LF = 806 * MiB, WS_C2 = 807 * MiB, WS_CB = 808 * MiB, WS_TOK = 809 * MiB;
constexpr size_t WS_END = 810 * MiB;
constexpr size_t WS_AT = 280 * MiB, WS_RT = 312 * MiB, WS_BH = 344 * MiB, WS_KH = 376 * MiB;
constexpr size_t WS_V16 = 216 * MiB, WS_GC = 248 * MiB;
constexpr size_t WS_QM = 410 * MiB, WS_PLR = 474 * MiB, WS_TM = 506 * MiB, WS_S0 = 538 * MiB;
constexpr size_t WS_Y = 602 * MiB;
constexpr int NCH = T / 64;
constexpr int CW_TMO = 0, CW_BAR = 4096, CW_CNT = 8192, CW_ATTQ = 9216;

constexpr int RING_BYTES = 131072, MISC_OFF = RING_BYTES + 320, LDS_BYTES = 147456;

__device__ __forceinline__ unsigned f2bf(float f) { unsigned u = __builtin_bit_cast(unsigned, f); return (u + 0x7fffu + ((u >> 16) & 1u)) >> 16; }
__device__ __forceinline__ unsigned pk2(float lo, float hi) { return f2bf(lo) | (f2bf(hi) << 16); }
__device__ __forceinline__ float bf2f(unsigned short b) { return __builtin_bit_cast(float, (unsigned)b << 16); }
__device__ __forceinline__ float bflo(unsigned w) { return __builtin_bit_cast(float, w << 16); }
__device__ __forceinline__ float bfhi(unsigned w) { return __builtin_bit_cast(float, w & 0xffff0000u); }
__device__ __forceinline__ float wave_sum(float v) {
#pragma unroll
    for (int o = 1; o < 64; o <<= 1) v += __shfl_xor(v, o);
    return v;
}
__device__ __forceinline__ float row16_sum(float v) {
#pragma unroll
    for (int o = 1; o < 16; o <<= 1) v += __shfl_xor(v, o);
    return v;
}
__device__ __forceinline__ float sigmoidf_(float x) { return 1.f / (1.f + __expf(-x)); }
#define LDS_WAIT() asm volatile("s_waitcnt lgkmcnt(0)" ::: "memory")
__device__ __forceinline__ int crow(int r, int hi) { return (r & 3) + 8 * (r >> 2) + 4 * hi; }

namespace pg8 {
constexpr int BM = 256, BK = 64, HALF = 128, HTB = HALF * BK * 2, STAGE_BYTES = 8 * HTB, NXCD = 8, WGM = 8;
__host__ __device__ __forceinline__ int lds_byte(int r, int c) { const int st = (r >> 4) * 2 + (c >> 5), rr = r & 15, cc = c & 31, ob = rr * 64 + cc * 2; return st * 1024 + (ob ^ (((ob >> 9) & 1) << 5)); }
__host__ __device__ __forceinline__ void stage_rc(int b, int& R, int& C) { const int st = b / 1024, sb = b % 1024, swz = sb ^ (((sb >> 9) & 1) << 5); R = (st >> 1) * 16 + swz / 64; C = (st & 1) * 32 + (swz % 64) / 2; }
__host__ __device__ __forceinline__ int perm32(int rho) { const int n = rho >> 4, i = rho & 15; return 8 * (i >> 2) + 4 * n + (i & 3); }

struct Unit { int pm, pn; };
struct Gemm { int lda, ldb, K; };

struct TileOrder {
    int nM, nN, nwg, G, c;
    __device__ __forceinline__ void init(int nM_, int nN_, int G_, int c_) { nM = nM_; nN = nN_; nwg = nM * nN; G = G_; c = c_; }
    __device__ __forceinline__ bool tile(int i, Unit& u) const {
        const long L = (long)i * G + c; if (L >= nwg) return false;
        int wgid = (int)L; { const int q = nwg / NXCD, r = nwg % NXCD, xcd = wgid % NXCD, off = wgid / NXCD; wgid = (xcd < r ? xcd * (q + 1) : r * (q + 1) + (xcd - r) * q) + off; }
        const int nig = WGM * nN, gid = wgid / nig, fm = gid * WGM, gsz = (nM - fm) < WGM ? (nM - fm) : WGM;
        u.pm = fm + ((wgid % nig) % gsz); u.pn = (wgid % nig) / gsz; return true;
    }
};

__device__ __forceinline__ unsigned cvt_pk_bf16(float lo, float hi) { unsigned r; asm volatile("v_cvt_pk_bf16_f32 %0, %1, %2" : "=v"(r) : "v"(lo), "v"(hi)); return r; }

template <class Epi, class Sched, bool ALIGN_EPI>
__device__ __forceinline__ void gemm_phase(LAS unsigned char* lds, const Gemm g, const Sched& S, const Epi& E) {
    const int tid = threadIdx.x, wid = __builtin_amdgcn_readfirstlane(tid >> 6), lane = tid & 63, wr = wid >> 2, wc = wid & 3, fr = lane & 15, fq = lane >> 4;
    const int K = g.K, nt = K / BK;
    unsigned voffA[2], voffB[2];
#pragma unroll
    for (int i = 0; i < 2; ++i) { int R, C; stage_rc(tid * 16 + i * 8192, R, C); const int Rb = Epi::PERM ? ((R & ~31) + perm32(R & 31)) : R;
        voffA[i] = (unsigned)(R * g.lda + C) * 2u; voffB[i] = (unsigned)(Rb * g.ldb + C) * 2u; }
    const size_t kstep = (size_t)(BK * 2);
    const size_t hstepA = (size_t)HALF * g.lda * 2, hstepB = (size_t)HALF * g.ldb * 2;
    const unsigned ldsw = (unsigned)wid * 1024u;
    const int aoff = lds_byte(wr * 64 + fr, fq * 8), boff = lds_byte(wc * 32 + fr, fq * 8);
#define PG8_SA(b, h) (((b) * 2 + (h)) * HTB)
#define PG8_SB(b, h) ((4 + (b) * 2 + (h)) * HTB)
#define PG8_STAGE(bufoff, gbase, voff) do { _Pragma("unroll") for (int _i = 0; _i < 2; ++_i) \
        __builtin_amdgcn_global_load_lds((const unsigned*)((const char*)(gbase) + (voff)[_i]), (LAS unsigned*)(lds + (bufoff) + ldsw + _i * 8192), 16, 0, 0); } while (0)
#define PG8_LDA(dst, b, h) do { _Pragma("unroll") for (int m = 0; m < 4; ++m) _Pragma("unroll") for (int k = 0; k < 2; ++k) dst[m][k] = *(const LAS bf16x8*)(lds + PG8_SA(b, h) + aoff + m * 2048 + k * 1024); } while (0)
#define PG8_LDB(dst, b, h) do { _Pragma("unroll") for (int n = 0; n < 2; ++n) _Pragma("unroll") for (int k = 0; k < 2; ++k) dst[n][k] = *(const LAS bf16x8*)(lds + PG8_SB(b, h) + boff + n * 2048 + k * 1024); } while (0)
#define PG8_MMA(ai, bj, At, Bt) do { __builtin_amdgcn_s_setprio(1); _Pragma("unroll") for (int m = 0; m < 4; ++m) _Pragma("unroll") for (int n = 0; n < 2; ++n) _Pragma("unroll") for (int k = 0; k < 2; ++k) \
        acc[ai][bj][m][n] = __builtin_amdgcn_mfma_f32_16x16x32_bf16(Bt[n][k], At[m][k], acc[ai][bj][m][n], 0, 0, 0); __builtin_amdgcn_s_setprio(0); } while (0)
#define PG8_WAIT_V(n) asm volatile("s_waitcnt vmcnt(" #n ")" ::: "memory")
#define PG8_WAIT_L(n) asm volatile("s_waitcnt lgkmcnt(" #n ")" ::: "memory")
#define PG8_BAR __builtin_amdgcn_s_barrier()
#define PG8_SCHED __builtin_amdgcn_sched_barrier(0)
    Unit cur, nxt; int ui = 0;
    if (!S.next(0, cur)) return;
    f32x4 acc[2][2][4][2];
#pragma unroll
    for (int a = 0; a < 2; ++a)
#pragma unroll
        for (int b = 0; b < 2; ++b)
#pragma unroll
            for (int m = 0; m < 4; ++m)
#pragma unroll
                for (int n = 0; n < 2; ++n) acc[a][b][m][n] = (f32x4){0.f, 0.f, 0.f, 0.f};
    bf16x8 At[4][2], B0[2][2], B1[2][2];
    const char* cA = S.pa(cur); const char* cB = S.pb(cur);
    PG8_STAGE(PG8_SB(0, 0), cB, voffB); PG8_STAGE(PG8_SB(0, 1), cB + hstepB, voffB); PG8_STAGE(PG8_SA(0, 0), cA, voffA); PG8_STAGE(PG8_SA(0, 1), cA + hstepA, voffA);
    if (wr == 1) PG8_BAR;
    PG8_WAIT_V(2); PG8_BAR;
    PG8_STAGE(PG8_SB(1, 0), cB + kstep, voffB); PG8_STAGE(PG8_SA(1, 0), cA + kstep, voffA); PG8_STAGE(PG8_SB(1, 1), cB + hstepB + kstep, voffB);
    PG8_WAIT_V(6); PG8_BAR;
    for (;;) {
        const bool has_next = S.next(ui + 1, nxt);
        const char* nA = has_next ? S.pa(nxt) : cA; const char* nB = has_next ? S.pb(nxt) : cB;
#pragma clang loop unroll(disable)
        for (int t = 0; t < nt; t += 2) {
            const bool last = (t == nt - 2);
            const char* a1 = cA + (size_t)(t + 1) * kstep;
            const char* a2 = last ? nA : cA + (size_t)(t + 2) * kstep; const char* b2 = last ? nB : cB + (size_t)(t + 2) * kstep;
            const char* a3 = a2 + kstep; const char* b3 = b2 + kstep;
            PG8_LDB(B0, 0, 0); PG8_LDB(B1, 0, 1); PG8_SCHED; PG8_LDA(At, 0, 0); PG8_STAGE(PG8_SA(1, 1), a1 + hstepA, voffA);
            PG8_WAIT_V(8); PG8_WAIT_L(0); PG8_BAR; PG8_MMA(0, 0, At, B0); PG8_MMA(0, 1, At, B1); PG8_BAR; PG8_SCHED;
            PG8_LDA(At, 0, 1); PG8_STAGE(PG8_SB(0, 0), b2, voffB); PG8_STAGE(PG8_SB(0, 1), b2 + hstepB, voffB); PG8_STAGE(PG8_SA(0, 0), a2, voffA);
            PG8_WAIT_V(8); PG8_WAIT_L(0); PG8_BAR; PG8_MMA(1, 0, At, B0); PG8_MMA(1, 1, At, B1); PG8_BAR; PG8_SCHED;
            PG8_LDB(B0, 1, 0); PG8_LDB(B1, 1, 1); PG8_SCHED; PG8_LDA(At, 1, 0); PG8_STAGE(PG8_SA(0, 1), a2 + hstepA, voffA);
            PG8_WAIT_V(8); PG8_WAIT_L(0); PG8_BAR; PG8_MMA(0, 0, At, B0); PG8_MMA(0, 1, At, B1); PG8_BAR; PG8_SCHED;
            PG8_LDA(At, 1, 1); PG8_STAGE(PG8_SB(1, 0), b3, voffB); PG8_STAGE(PG8_SB(1, 1), b3 + hstepB, voffB); PG8_STAGE(PG8_SA(1, 0), a3, voffA);
            PG8_WAIT_V(8); PG8_WAIT_L(0); PG8_BAR; PG8_MMA(1, 0, At, B0); PG8_MMA(1, 1, At, B1); PG8_BAR; PG8_SCHED;
        }
        if constexpr (ALIGN_EPI) { if (wr == 0) PG8_BAR; }
        E(acc, cur, wr, wc, fr, fq);
        if (!has_next) break;
#pragma unroll
        for (int a = 0; a < 2; ++a)
#pragma unroll
            for (int b = 0; b < 2; ++b)
#pragma unroll
                for (int m = 0; m < 4; ++m)
#pragma unroll
                    for (int n = 0; n < 2; ++n) acc[a][b][m][n] = (f32x4){0.f, 0.f, 0.f, 0.f};
        cur = nxt; cA = nA; cB = nB; ++ui;
        if constexpr (ALIGN_EPI) { if (wr == 1) PG8_BAR; }
    }
    PG8_WAIT_V(0);
    if constexpr (!ALIGN_EPI) { if (wr == 0) PG8_BAR; }
    PG8_BAR;
#undef PG8_SA
#undef PG8_SB
#undef PG8_STAGE
#undef PG8_LDA
#undef PG8_LDB
#undef PG8_MMA
#undef PG8_WAIT_V
#undef PG8_WAIT_L
#undef PG8_BAR
#undef PG8_SCHED
}

typedef const f32x4 (&AccRef)[2][2][4][2];

struct SchedPlain {
    TileOrder o; const char* A; const char* B; size_t astep, bstep;
    __device__ __forceinline__ bool next(int i, Unit& u) const { return o.tile(i, u); }
    __device__ __forceinline__ const char* pa(const Unit& u) const { return A + (size_t)u.pm * astep; }
    __device__ __forceinline__ const char* pb(const Unit& u) const { return B + (size_t)u.pn * bstep; }
};
struct SchedRKV {
    TileOrder o; const char* A; const char* B; size_t astep, bstep, azstride;
    __device__ __forceinline__ bool next(int i, Unit& u) const { return o.tile(i, u); }
    __device__ __forceinline__ const char* pa(const Unit& u) const { return A + (size_t)(u.pn >> 2) * azstride + (size_t)u.pm * astep; }
    __device__ __forceinline__ const char* pb(const Unit& u) const { return B + (size_t)u.pn * bstep; }
};
struct SchedMoe {
    TileOrder o; const char* A; const char* B; size_t astep, bstep, bestride; const LAS int* ends;
    __device__ __forceinline__ bool next(int i, Unit& u) const { return o.tile(i, u); }
    __device__ __forceinline__ int be(int pm) const { int e = 0;
#pragma unroll
        for (int j = 0; j < NE - 1; ++j) e += (pm >= ends[j]) ? 1 : 0; return e; }
    __device__ __forceinline__ const char* pa(const Unit& u) const { return A + (size_t)u.pm * astep; }
    __device__ __forceinline__ const char* pb(const Unit& u) const { return B + (size_t)be(u.pm) * bestride + (size_t)u.pn * bstep; }
};

struct EpiRKV {
    static constexpr bool PERM = false;
    float* C; size_t zstride;
    __device__ __forceinline__ void operator()(AccRef acc, const Unit& u, int wr, int wc, int fr, int fq) const {
        const int z = u.pn >> 2, pn = u.pn & 3; float* base = C + (size_t)z * zstride;
        const int row0 = u.pm * BM + wr * 64 + fr, col0 = pn * BM + wc * 32 + 4 * fq;
#pragma unroll
        for (int ai = 0; ai < 2; ++ai)
#pragma unroll
            for (int m = 0; m < 4; ++m) { float* rowp = base + (size_t)(row0 + ai * HALF + m * 16) * D + col0;
#pragma unroll
                for (int bj = 0; bj < 2; ++bj)
#pragma unroll
                    for (int n = 0; n < 2; ++n) *(f32x4*)(rowp + bj * HALF + n * 16) = acc[ai][bj][m][n]; }
    }
};
struct EpiRes {
    static constexpr bool PERM = false;
    const float* base; float* out;
    __device__ __forceinline__ void operator()(AccRef acc, const Unit& u, int wr, int wc, int fr, int fq) const {
        const int row0 = u.pm * BM + wr * 64 + fr, col0 = u.pn * BM + wc * 32 + 4 * fq;
#pragma unroll
        for (int ai = 0; ai < 2; ++ai)
#pragma unroll
            for (int m = 0; m < 4; ++m) { const size_t off = (size_t)(row0 + ai * HALF + m * 16) * D + col0;
#pragma unroll
                for (int bj = 0; bj < 2; ++bj)
#pragma unroll
                    for (int n = 0; n < 2; ++n) { const f32x4 b = *(const f32x4*)(base + off + bj * HALF + n * 16); *(f32x4*)(out + off + bj * HALF + n * 16) = b + acc[ai][bj][m][n]; } }
    }
};
struct EpiL1 {
    static constexpr bool PERM = true;
    bf16* O;
    __device__ __forceinline__ void operator()(AccRef acc, const Unit& u, int wr, int wc, int fr, int fq) const {
        const int row0 = u.pm * BM + wr * 64 + fr, col0 = wc * 32 + 8 * fq;
#pragma unroll
        for (int ai = 0; ai < 2; ++ai)
#pragma unroll
            for (int m = 0; m < 4; ++m) { bf16* rowp = O + (size_t)(row0 + ai * HALF + m * 16) * 256 + col0;
#pragma unroll
                for (int bj = 0; bj < 2; ++bj) { float v[8];
#pragma unroll
                    for (int i = 0; i < 4; ++i) { v[i] = acc[ai][bj][m][0][i]; v[4 + i] = acc[ai][bj][m][1][i]; }
#pragma unroll
                    for (int i = 0; i < 8; ++i) { if (bj == 1) v[i] = sigmoidf_(v[i]); else if (wc < 2) v[i] = tanhf(v[i]); }
                    u32x4 w; w.x = cvt_pk_bf16(v[0], v[1]); w.y = cvt_pk_bf16(v[2], v[3]); w.z = cvt_pk_bf16(v[4], v[5]); w.w = cvt_pk_bf16(v[6], v[7]);
                    *(u32x4*)(rowp + bj * HALF) = w; } }
    }
};
struct EpiL2 {
    static constexpr bool PERM = false;
    float* LW; const float* w0; const float* a0;
    __device__ __forceinline__ void operator()(AccRef acc, const Unit& u, int wr, int wc, int fr, int fq) const {
        const int z = u.pn >> 2, pn = u.pn & 3; float* base = LW + (size_t)z * ((WS_AA - WS_LW) / 4); const float* bias = z == 0 ? w0 : a0;
        const float mul = z == 0 ? -0.6065306597126334f : 1.f;
        const int row0 = u.pm * BM + wr * 64 + fr, col0 = pn * BM + wc * 32 + 4 * fq;
#pragma unroll
        for (int bj = 0; bj < 2; ++bj)
#pragma unroll
            for (int n = 0; n < 2; ++n) { const int c = col0 + bj * HALF + n * 16;
                const f32x4 bv = *(const f32x4*)(bias + c);
#pragma unroll
                for (int ai = 0; ai < 2; ++ai)
#pragma unroll
                    for (int m = 0; m < 4; ++m) { f32x4 v = acc[ai][bj][m][n];
                        if (z < 2) { v = v + bv;
#pragma unroll
                            for (int i = 0; i < 4; ++i) v[i] = mul * __builtin_amdgcn_rcpf(1.f + __expf(-v[i])); }
                        *(f32x4*)(base + (size_t)(row0 + ai * HALF + m * 16) * D + c) = v; } }
    }
};
struct EpiSwiGLU {
    static constexpr bool PERM = true;
    bf16* O;
    __device__ __forceinline__ void operator()(AccRef acc, const Unit& u, int wr, int wc, int fr, int fq) const {
        const int row0 = u.pm * BM + wr * 64 + fr, col0 = u.pn * HALF + wc * 32 + 8 * fq;
#pragma unroll
        for (int ai = 0; ai < 2; ++ai)
#pragma unroll
            for (int m = 0; m < 4; ++m) { float v[8];
#pragma unroll
                for (int n = 0; n < 2; ++n)
#pragma unroll
                    for (int i = 0; i < 4; ++i) { const float gt = acc[ai][0][m][n][i], up = acc[ai][1][m][n][i]; v[4 * n + i] = gt * sigmoidf_(gt) * up; }
                u32x4 w; w.x = cvt_pk_bf16(v[0], v[1]); w.y = cvt_pk_bf16(v[2], v[3]); w.z = cvt_pk_bf16(v[4], v[5]); w.w = cvt_pk_bf16(v[6], v[7]);
                *(u32x4*)(O + (size_t)(row0 + ai * HALF + m * 16) * FF + col0) = w; }
    }
};
struct EpiBf16 {
    static constexpr bool PERM = true;
    bf16* O; int ldc;
    __device__ __forceinline__ void operator()(AccRef acc, const Unit& u, int wr, int wc, int fr, int fq) const {
        const int row0 = u.pm * BM + wr * 64 + fr, col0 = u.pn * BM + wc * 32 + 8 * fq;
#pragma unroll
        for (int ai = 0; ai < 2; ++ai)
#pragma unroll
            for (int m = 0; m < 4; ++m) { bf16* rowp = O + (size_t)(row0 + ai * HALF + m * 16) * ldc + col0;
#pragma unroll
                for (int bj = 0; bj < 2; ++bj) { const f32x4 v0 = acc[ai][bj][m][0], v1 = acc[ai][bj][m][1];
                    u32x4 w; w.x = cvt_pk_bf16(v0[0], v0[1]); w.y = cvt_pk_bf16(v0[2], v0[3]); w.z = cvt_pk_bf16(v1[0], v1[1]); w.w = cvt_pk_bf16(v1[2], v1[3]);
                    *(u32x4*)(rowp + bj * HALF) = w; } }
    }
};
}

#define XB_TMO      128
#define XB_XCNT(j)  (256  + 64 * (j))
#define XB_XSUB(j)  (1280 + 64 * (j))
#define XB_XGEN(j)  (2304 + 64 * (j))
#define XB_TOP      3328
#define XB_TOPGEN   3392
#define XCD_BAR_WORDS 3456
#define XB_SPIN_CAP (1u << 18)
__device__ __forceinline__ unsigned xb_ld(unsigned* p)              { return __hip_atomic_load(p, __ATOMIC_RELAXED, __HIP_MEMORY_SCOPE_AGENT); }
__device__ __forceinline__ unsigned xb_add(unsigned* p, unsigned v) { return __hip_atomic_fetch_add(p, v, __ATOMIC_RELAXED, __HIP_MEMORY_SCOPE_AGENT); }
__device__ __forceinline__ unsigned xb_xcc_id() { return (unsigned)__builtin_amdgcn_s_getreg((3 << 11) | 20) & 0xFu; }
#define XB_SPIN(cond, bar) do { unsigned _sp = 0; while (cond) { __builtin_amdgcn_s_sleep(1); \
    if ((++_sp & 255u) == 0u) { if (xb_ld(&(bar)[XB_TMO])) break; if (_sp > XB_SPIN_CAP) { atomicAdd(&(bar)[XB_TMO], 1u); break; } } } } while (0)
struct XcdBarrier { unsigned* bar; unsigned x; volatile LAS unsigned* st; };
__device__ __forceinline__ XcdBarrier xcd_barrier_post(unsigned* bar, volatile LAS unsigned* st) {
    XcdBarrier b; b.bar = bar; b.x = xb_xcc_id(); b.st = st;
    if (threadIdx.x == 0) (void)xb_add(&bar[XB_XCNT(b.x)], 1u);
    return b;
}
__device__ __forceinline__ void xcd_barrier_complete(unsigned* bar, unsigned x, unsigned& nloc, unsigned& nx) {
    const unsigned G = gridDim.x * gridDim.y * gridDim.z;
    unsigned sum, cnt, mine, sp = 0u;
    for (;;) {
        sum = 0u; cnt = 0u; mine = 0u;
#pragma unroll
        for (unsigned j = 0; j < 16; ++j) { const unsigned c = xb_ld(&bar[XB_XCNT(j)]); sum += c; cnt += (c > 0u) ? 1u : 0u; mine = (j == x) ? c : mine; }
        if (sum == G) break;
        __builtin_amdgcn_s_sleep(1);
        if ((++sp & 255u) == 0u) { if (xb_ld(&bar[XB_TMO])) break; if (sp > XB_SPIN_CAP) { atomicAdd(&bar[XB_TMO], 1u); break; } }
    }
    nloc = mine > 0u ? mine : 1u; nx = cnt > 0u ? cnt : 1u;
}
__device__ __forceinline__ void xcd_barrier(const XcdBarrier& b) {
    asm volatile("s_waitcnt vmcnt(0)" ::: "memory");
    __syncthreads();
    if (threadIdx.x == 0) {
        unsigned* bar = b.bar;
        __builtin_amdgcn_s_waitcnt(0);
        unsigned nloc = b.st[0], nx = b.st[1];
        if (nloc == 0u) { xcd_barrier_complete(bar, b.x, nloc, nx); b.st[0] = nloc; b.st[1] = nx; }
        const unsigned old = xb_add(&bar[XB_XSUB(b.x)], 1u);
        const unsigned gen = old / nloc;
        if (old + 1u == (gen + 1u) * nloc) {
            __builtin_amdgcn_fence(__ATOMIC_RELEASE, "agent");
            asm volatile("s_waitcnt vmcnt(0)" ::: "memory");
            const unsigned og = xb_add(&bar[XB_TOP], 1u);
            const unsigned tg = og / nx;
            if (og + 1u == (tg + 1u) * nx) xb_add(&bar[XB_TOPGEN], 1u);
            else XB_SPIN(xb_ld(&bar[XB_TOPGEN]) == tg, bar);
            __builtin_amdgcn_fence(__ATOMIC_ACQUIRE, "agent");
            xb_add(&bar[XB_XGEN(b.x)], 1u);
            asm volatile("s_waitcnt vmcnt(0)" ::: "memory");
        } else {
            XB_SPIN(xb_ld(&bar[XB_XGEN(b.x)]) == gen, bar);
            __builtin_amdgcn_fence(__ATOMIC_ACQUIRE, "agent");
            asm volatile("s_waitcnt vmcnt(0)" ::: "memory");
        }
    }
    __syncthreads();
}

struct Args { const float* in[29]; float* out; unsigned char* ws; int ph_lo, ph_hi; };
struct Frame {
    LAS unsigned char* lds; gu32* ctl; unsigned char* ws;
    int tid, lane, wave, vcu, G, gw, NGW;
};

struct Row { f32x4 v[4]; };
__device__ __forceinline__ Row ld_row(const float* p, int lane) { Row r; const f32x4* q = (const f32x4*)p + lane;
#pragma unroll
    for (int j = 0; j < 4; ++j) r.v[j] = q[64 * j]; return r; }
__device__ __forceinline__ void st_row(float* p, int lane, const Row& r) { f32x4* q = (f32x4*)p + lane;
#pragma unroll
    for (int j = 0; j < 4; ++j) q[64 * j] = r.v[j]; }
__device__ __forceinline__ void st_row_bf16(bf16* p, int lane, const Row& r) { u32x2* q = (u32x2*)p + lane;
#pragma unroll
    for (int j = 0; j < 4; ++j) { u32x2 w; w.x = pk2(r.v[j][0], r.v[j][1]); w.y = pk2(r.v[j][2], r.v[j][3]); q[64 * j] = w; } }
__device__ __forceinline__ Row ld_row_bf16(const bf16* p, int lane) { Row r; const u32x2* q = (const u32x2*)p + lane;
#pragma unroll
    for (int j = 0; j < 4; ++j) { const u32x2 w = q[64 * j]; r.v[j] = (f32x4){bflo(w.x), bfhi(w.x), bflo(w.y), bfhi(w.y)}; } return r; }
__device__ __forceinline__ float row_sumsq(const Row& r) { float s = 0.f;
#pragma unroll
    for (int j = 0; j < 4; ++j) s += (r.v[j][0] * r.v[j][0] + r.v[j][1] * r.v[j][1]) + (r.v[j][2] * r.v[j][2] + r.v[j][3] * r.v[j][3]); return wave_sum(s); }
__device__ __forceinline__ Row rmsnorm_row(const Row& x, const Row& g) { const float rs = rsqrtf(row_sumsq(x) * (1.f / D) + RMS_EPS); Row y;
#pragma unroll
    for (int j = 0; j < 4; ++j) y.v[j] = x.v[j] * rs * g.v[j]; return y; }

__device__ __forceinline__ void tr_item(const float* W, int ldw, int k0, int n0, bf16* WT, int ldt, int drow0, int dcol0, const float* sc, int scmode, LAS float* scr, int lane) {
#pragma unroll 8
    for (int i = 0; i < 32; ++i) { const int kk = 2 * i + (lane >> 5); float v = W[(size_t)(k0 + kk) * ldw + n0 + (lane & 31)];
        if (scmode == 1) v *= sc[k0 + kk]; else if (scmode == 2) v *= (1.f - sc[k0 + kk]);
        scr[kk * 33 + (lane & 31)] = v; }
    LDS_WAIT(); asm volatile("" ::: "memory");
    const int c = lane & 7;
#pragma unroll
    for (int j = 0; j < 4; ++j) { const int n = (lane >> 3) + 8 * j; const LAS float* s = scr + (8 * c) * 33 + n;
        u32x4 o; o.x = pk2(s[0 * 33], s[1 * 33]); o.y = pk2(s[2 * 33], s[3 * 33]); o.z = pk2(s[4 * 33], s[5 * 33]); o.w = pk2(s[6 * 33], s[7 * 33]);
        *(GAS u32x4*)(WT + (size_t)(drow0 + n0 + n) * ldt + dcol0 + k0 + 8 * c) = o; }
    LDS_WAIT(); asm volatile("" ::: "memory");
}
__device__ __forceinline__ int gu_row(int n) { return n < FF ? 256 * (n >> 7) + (n & 127) : 256 * ((n - FF) >> 7) + 128 + ((n - FF) & 127); }

__device__ __forceinline__ void p0_prologue(Frame& F, const Args& a) {
    LAS float* scr = (LAS float*)(F.lds + F.wave * 16384);
    unsigned char* ws = F.ws;
    constexpr int I_SQ = 16 * 32;
    constexpr int I_RKV = 3 * I_SQ, I_L1 = 2 * 16 * 8, I_L2 = 4 * 32, I_GU = 16 * 224, I_DN = 56 * 32, I_IN = 16 * 128;
    constexpr int NITEMS = I_RKV + I_L1 + I_L2 + I_SQ + I_GU + I_DN + I_IN + I_SQ + NE * I_GU + NE * I_DN;
    for (int it = F.gw; it < NITEMS; it += F.NGW) {
        int r = it;
        if (r < I_RKV) { const int z = r / I_SQ, q = r % I_SQ; tr_item(a.in[4] + (size_t)z * D * D, D, 64 * (q / 32), 32 * (q % 32), (bf16*)(ws + WS_W_RKV) + (size_t)z * D * D, D, 0, 0, nullptr, 0, scr, F.lane); continue; } r -= I_RKV;
        if (r < I_L1) {
            const int half = r / 128, q = r % 128, kb = q / 8, nb = q % 8, n0 = 32 * nb;
            const float* W; int ldw, nn0, mi;
            if (n0 < 64) { W = a.in[6]; ldw = 64; nn0 = n0; mi = 3; } else if (n0 < 128) { W = a.in[9]; ldw = 64; nn0 = n0 - 64; mi = 4; } else { W = a.in[11]; ldw = 128; nn0 = n0 - 128; mi = 5; }
            tr_item(W, ldw, 64 * kb, nn0, (bf16*)(ws + WS_W_L1), 2 * D, n0 - nn0, half * D, a.in[3] + mi * D, half == 0 ? 1 : 2, scr, F.lane); continue; } r -= I_L1;
        if (r < I_L2) {
            const int part = r / 32, nb = r % 32;
            if (part == 0) tr_item(a.in[7], D, 0, 32 * nb, (bf16*)(ws + WS_W_L2), 256, 0, 0, nullptr, 0, scr, F.lane);
            else if (part == 1) tr_item(a.in[10], D, 0, 32 * nb, (bf16*)(ws + WS_W_L2), 256, D, 64, nullptr, 0, scr, F.lane);
            else tr_item(a.in[12], D, 64 * (part - 2), 32 * nb, (bf16*)(ws + WS_W_L2), 256, 2 * D, 128, nullptr, 0, scr, F.lane);
            continue; } r -= I_L2;
        if (r < I_SQ) { tr_item(a.in[18], D, 64 * (r / 32), 32 * (r % 32), (bf16*)(ws + WS_W_O0), D, 0, 0, nullptr, 0, scr, F.lane); continue; } r -= I_SQ;
        if (r < I_GU) { const int kb = r / 224, nb = r % 224; tr_item(a.in[24], 2 * FF, 64 * kb, 32 * nb, (bf16*)(ws + WS_W_GU), D, gu_row(32 * nb) - 32 * nb, 0, nullptr, 0, scr, F.lane); continue; } r -= I_GU;
        if (r < I_DN) { tr_item(a.in[25], D, 64 * (r / 32), 32 * (r % 32), (bf16*)(ws + WS_W_DN), FF, 0, 0, nullptr, 0, scr, F.lane); continue; } r -= I_DN;
        if (r < I_IN) { tr_item(a.in[19], WIN_LD, 64 * (r / 128), 32 * (r % 128), (bf16*)(ws + WS_W_IN), D, 0, 0, nullptr, 0, scr, F.lane); continue; } r -= I_IN;
        if (r < I_SQ) { tr_item(a.in[23], D, 64 * (r / 32), 32 * (r % 32), (bf16*)(ws + WS_W_FO), D, 0, 0, nullptr, 0, scr, F.lane); continue; } r -= I_SQ;
        if (r < NE * I_GU) { const int e = r / I_GU, q = r % I_GU, kb = q / 224, nb = q % 224;
            tr_item(a.in[27] + (size_t)e * D * 2 * FF, 2 * FF, 64 * kb, 32 * nb, (bf16*)(ws + WS_W_MGU) + (size_t)e * 2 * FF * D, D, gu_row(32 * nb) - 32 * nb, 0, nullptr, 0, scr, F.lane); continue; } r -= NE * I_GU;
        { const int e = r / I_DN, q = r % I_DN; tr_item(a.in[28] + (size_t)e * FF * D, D, 64 * (q / 32), 32 * (q % 32), (bf16*)(ws + WS_W_MDN) + (size_t)e * D * FF, FF, 0, 0, nullptr, 0, scr, F.lane); }
    }
    for (int i = F.gw * 64 + F.lane; i < 3 * D * 32; i += F.NGW * 64) { const int row = i >> 5, ch = i & 31, part = row / D, k = ch * 8;
        const bool nz = part == 0 ? (k < 64) : (part == 1 ? (k >= 64 && k < 128) : (k >= 128));
        if (!nz) *(GAS u32x4*)((bf16*)(ws + WS_W_L2) + (size_t)row * 256 + k) = (u32x4){0u, 0u, 0u, 0u}; }
}

__device__ __forceinline__ void p1_shift(Frame& F, const Args& a) {
    const int lane = F.lane; const float* x = a.in[0];
    bf16* UB = (bf16*)(F.ws + WS_UB); bf16* XS = (bf16*)(F.ws + WS_XS);
    const Row g0 = ld_row(a.in[1], lane);
    const int RPW = T / (256 * NWAVES);
    for (int t0 = F.gw * RPW; t0 < T; t0 += F.NGW * RPW) {
        Row prev;
        if (t0 > 0) prev = rmsnorm_row(ld_row(x + (size_t)(t0 - 1) * D, lane), g0);
        else { for (int j = 0; j < 4; ++j) prev.v[j] = (f32x4){0.f, 0.f, 0.f, 0.f}; st_row_bf16(UB, lane, prev); }
        for (int t = t0; t < t0 + RPW; ++t) {
            const Row u = rmsnorm_row(ld_row(x + (size_t)t * D, lane), g0);
            st_row_bf16(UB + (size_t)(t + 1) * D, lane, u);
#pragma unroll
            for (int n = 0; n < 3; ++n) { const Row mu = ld_row(a.in[3] + n * D, lane); Row o;
#pragma unroll
                for (int j = 0; j < 4; ++j) o.v[j] = u.v[j] + (prev.v[j] - u.v[j]) * mu.v[j];
                st_row_bf16(XS + (size_t)n * T * D + (size_t)t * D, lane, o); }
            prev = u;
        }
    }
}

__device__ __forceinline__ void p4_derive(Frame& F, const Args& a) {
    const int lane = F.lane;
    float* R = (float*)(F.ws + WS_R); float* K = (float*)(F.ws + WS_K); float* LW = (float*)(F.ws + WS_LW); float* AA = (float*)(F.ws + WS_AA);
    float* KK = (float*)(F.ws + WS_KK); float* BB = (float*)(F.ws + WS_BB); float* CS = (float*)(F.ws + WS_CS);
    const Row k_k = ld_row(a.in[13], lane), k_a = ld_row(a.in[14], lane), r_k = ld_row(a.in[15], lane);
    for (int t = F.gw; t < T; t += F.NGW) {
        const size_t o = (size_t)t * D;
        Row r = ld_row(R + o, lane), k = ld_row(K + o, lane), lw = ld_row(LW + o, lane), aa = ld_row(AA + o, lane), kk, bb, km, dec;
        float c1[4], c2[4], c3[4];
#pragma unroll
        for (int j = 0; j < 4; ++j) {
            kk.v[j] = k.v[j] * k_k.v[j];
            float ss = (kk.v[j][0] * kk.v[j][0] + kk.v[j][1] * kk.v[j][1]) + (kk.v[j][2] * kk.v[j][2] + kk.v[j][3] * kk.v[j][3]);
            ss = row16_sum(ss);
            const float inv = 1.f / fmaxf(sqrtf(ss), 1e-12f);
            kk.v[j] = kk.v[j] * inv;
            bb.v[j] = kk.v[j] * aa.v[j];
            km.v[j] = k.v[j] * (1.f + (aa.v[j] - 1.f) * k_a.v[j]);
#pragma unroll
            for (int i = 0; i < 4; ++i) dec.v[j][i] = __expf(lw.v[j][i]);
            float s1 = 0.f, s2 = 0.f, s3 = 0.f;
#pragma unroll
            for (int i = 0; i < 4; ++i) { s1 += bb.v[j][i] * r.v[j][i]; const float kr = km.v[j][i] * r.v[j][i]; s2 += kr; s3 += kr * r_k.v[j][i]; }
            c1[j] = row16_sum(s1); c2[j] = row16_sum(s2); c3[j] = row16_sum(s3);
            r.v[j] = r.v[j] * dec.v[j];
        }
        st_row(R + o, lane, r); st_row(K + o, lane, km); st_row(LW + o, lane, dec); st_row(KK + o, lane, kk); st_row(BB + o, lane, bb);
        if ((lane & 15) == 0) {
#pragma unroll
            for (int j = 0; j < 4; ++j) { const int h = 4 * j + (lane >> 4); CS[(size_t)t * 16 + h] = c1[j]; CS[(size_t)T * 16 + (size_t)t * 16 + h] = c2[j]; CS[(size_t)2 * T * 16 + (size_t)t * 16 + h] = c3[j]; }
        }
    }
}

__device__ __forceinline__ float dpp_row_allsum(float x) {
    int v = __builtin_bit_cast(int, x);
    x += __builtin_bit_cast(float, __builtin_amdgcn_update_dpp(0, v, 0xB1, 0xF, 0xF, true)); v = __builtin_bit_cast(int, x);
    x += __builtin_bit_cast(float, __builtin_amdgcn_update_dpp(0, v, 0x4E, 0xF, 0xF, true)); v = __builtin_bit_cast(int, x);
    x += __builtin_bit_cast(float, __builtin_amdgcn_update_dpp(0, v, 0x141, 0xF, 0xF, true)); v = __builtin_bit_cast(int, x);
    x += __builtin_bit_cast(float, __builtin_amdgcn_update_dpp(0, v, 0x140, 0xF, 0xF, true));
    return x;
}
__device__ __forceinline__ float wave_allsum_fast(float x) {
    x = dpp_row_allsum(x);
    const int v = __builtin_bit_cast(int, x);
    const float a = __builtin_bit_cast(float, __builtin_amdgcn_readlane(v, 0)), b = __builtin_bit_cast(float, __builtin_amdgcn_readlane(v, 16)),
                c = __builtin_bit_cast(float, __builtin_amdgcn_readlane(v, 32)), d = __builtin_bit_cast(float, __builtin_amdgcn_readlane(v, 48));
    return (a + b) + (c + d);
}
__device__ __forceinline__ void p5_scan(Frame& F) {
    if (F.wave >= 4) return;
    const int lane = F.lane;
    const float* KK = (const float*)(F.ws + WS_KK); const float* RW = (const float*)(F.ws + WS_R); const float* DEC = (const float*)(F.ws + WS_LW);
    const float* BB = (const float*)(F.ws + WS_BB); const float* KM = (const float*)(F.ws + WS_K); const float* V = (const float*)(F.ws + WS_V);
    const float* CS = (const float*)(F.ws + WS_CS); float* YT = (float*)(F.ws + WS_YT);
    for (int rho = F.vcu * 4 + F.wave; rho < D; rho += F.G * 4) {
        const int h = rho >> 6;
        const size_t col = (size_t)h * 64 + lane;
        float s = 0.f, ybuf = 0.f;
        constexpr int U = 8;
        float ik[2][U], ir[2][U], iw[2][U], ib[2][U], im[2][U], iv[2][U], i1[2][U], i2[2][U];
#define SCAN_LOAD(buf, tb) do { _Pragma("unroll") for (int u_ = 0; u_ < U; ++u_) { const size_t o_ = (size_t)((tb) + u_) * D; \
            ik[buf][u_] = KK[o_ + col]; ir[buf][u_] = RW[o_ + col]; iw[buf][u_] = DEC[o_ + col]; ib[buf][u_] = BB[o_ + col]; im[buf][u_] = KM[o_ + col]; \
            iv[buf][u_] = V[o_ + rho]; i1[buf][u_] = CS[(size_t)((tb) + u_) * 16 + h]; i2[buf][u_] = CS[(size_t)T * 16 + (size_t)((tb) + u_) * 16 + h]; } } while (0)
#define SCAN_STEPS(buf, tb) do { _Pragma("unroll") for (int u_ = 0; u_ < U; ++u_) { \
            const float p1 = wave_allsum_fast(s * ik[buf][u_]); const float p2 = wave_allsum_fast(s * ir[buf][u_]); \
            const float sa = -p1; const float y = p2 + sa * i1[buf][u_] + iv[buf][u_] * i2[buf][u_]; \
            s = s * iw[buf][u_] + sa * ib[buf][u_] + iv[buf][u_] * im[buf][u_]; \
            if (lane == (((tb) + u_) & 63)) ybuf = y; } } while (0)
        SCAN_LOAD(0, 0);
        for (int t0 = 0; t0 < T; t0 += 2 * U) {
            SCAN_LOAD(1, t0 + U);
            SCAN_STEPS(0, t0);
            if (t0 + 2 * U < T) SCAN_LOAD(0, t0 + 2 * U);
            SCAN_STEPS(1, t0 + U);
            if (((t0 + 2 * U) & 63) == 0) YT[(size_t)rho * T + (t0 + 2 * U - 64) + lane] = ybuf;
        }
#undef SCAN_LOAD
#undef SCAN_STEPS
    }
}

typedef __bf16 bf16x2_t __attribute__((ext_vector_type(2)));
__device__ __forceinline__ unsigned cvtpk(float lo, float hi) { f32x2 v = {lo, hi}; bf16x2_t b = __builtin_convertvector(v, bf16x2_t); return __builtin_bit_cast(unsigned, b); }
struct Pk { bf16x8 k0, k1; };
__device__ __forceinline__ Pk pack_tile(const f32x16& t) {
    const u32x4 a = {cvtpk(t[0], t[1]), cvtpk(t[2], t[3]), cvtpk(t[4], t[5]), cvtpk(t[6], t[7])}, b = {cvtpk(t[8], t[9]), cvtpk(t[10], t[11]), cvtpk(t[12], t[13]), cvtpk(t[14], t[15])};
    Pk p; p.k0 = __builtin_bit_cast(bf16x8, a); p.k1 = __builtin_bit_cast(bf16x8, b); return p; }
#define MFMA32(a, b, c) __builtin_amdgcn_mfma_f32_32x32x16_bf16((a), (b), (c), 0, 0, 0)
__device__ __forceinline__ f32x16 xt(const Pk& X, const Pk& Z, f32x16 acc) { acc = MFMA32(X.k0, Z.k0, acc); acc = MFMA32(X.k1, Z.k1, acc); return acc; }
__device__ __forceinline__ bf16x8 nfrag(const bf16* m, int rt, int ks, int lane) { return *(const bf16x8*)(m + (size_t)(32 * rt + (lane & 31)) * D + 16 * ks + 8 * (lane >> 5)); }
__device__ __forceinline__ f32x16 nat(const bf16* am, int a, const bf16* bm, int b, int lane, f32x16 acc) {
#pragma unroll
    for (int ks = 0; ks < 4; ++ks) acc = MFMA32(nfrag(am, a, ks, lane), nfrag(bm, b, ks, lane), acc);
    return acc; }
__device__ __forceinline__ f32x16 dl_copy(const bf16* am, int a, int ct, int lane) {
    f32x16 acc = {};
#pragma unroll
    for (int kk2 = 0; kk2 < 2; ++kk2) { const int ks = 2 * ct + kk2; bf16x8 id;
#pragma unroll
        for (int e = 0; e < 8; ++e) id[e] = (32 * ct + (lane & 31) == 16 * ks + 8 * (lane >> 5) + e) ? (short)0x3F80 : (short)0;
        acc = MFMA32(nfrag(am, a, ks, lane), id, acc); }
    return acc; }
__device__ __forceinline__ void mask_lt(f32x16& t, int lane) {
#pragma unroll
    for (int r = 0; r < 16; ++r) if (!(crow(r, lane >> 5) < (lane & 31))) t[r] = 0.f; }
__device__ __forceinline__ void mask_gt(f32x16& t, int lane) {
#pragma unroll
    for (int r = 0; r < 16; ++r) if (!(crow(r, lane >> 5) > (lane & 31))) t[r] = 0.f; }
__device__ __forceinline__ void mask_le(f32x16& t, int lane) {
#pragma unroll
    for (int r = 0; r < 16; ++r) if (!(crow(r, lane >> 5) <= (lane & 31))) t[r] = 0.f; }
__device__ __forceinline__ void add_eye(f32x16& t, int lane) {
#pragma unroll
    for (int r = 0; r < 16; ++r) if (crow(r, lane >> 5) == (lane & 31)) t[r] += 1.f; }

__device__ __forceinline__ void p3_prep(Frame& F, const Args& a) {
    const int lane = F.lane;
    const float* R = (const float*)(F.ws + WS_R); const float* K = (const float*)(F.ws + WS_K); const float* V = (const float*)(F.ws + WS_V);
    const float* LW = (const float*)(F.ws + WS_LW); const float* AA = (const float*)(F.ws + WS_AA);
    bf16* AT = (bf16*)(F.ws + WS_AT); bf16* RT = (bf16*)(F.ws + WS_RT); bf16* BH = (bf16*)(F.ws + WS_BH); bf16* KH = (bf16*)(F.ws + WS_KH); bf16* V16 = (bf16*)(F.ws + WS_V16);
    float* GC = (float*)(F.ws + WS_GC); float* C3 = (float*)(F.ws + WS_CS) + (size_t)2 * T * 16;
    for (int task = F.gw; task < NCH * 4; task += F.NGW) {
        const int c = task >> 2, hg = task & 3, col = hg * 256 + 4 * lane;
        const f32x4 k_k = *(const f32x4*)(a.in[13] + col), k_a = *(const f32x4*)(a.in[14] + col), r_k = *(const f32x4*)(a.in[15] + col);
        f32x4 lg = {0.f, 0.f, 0.f, 0.f};
        for (int tt = 0; tt < 64; ++tt) {
            const size_t o = (size_t)(64 * c + tt) * D + col;
            const f32x4 r = *(const f32x4*)(R + o), k = *(const f32x4*)(K + o), v = *(const f32x4*)(V + o), lw = *(const f32x4*)(LW + o), aa = *(const f32x4*)(AA + o);
            f32x4 kk = k * k_k;
            float ss = (kk[0] * kk[0] + kk[1] * kk[1]) + (kk[2] * kk[2] + kk[3] * kk[3]); ss = row16_sum(ss);
            kk = kk * (1.f / fmaxf(sqrtf(ss), 1e-12f));
            const f32x4 b = kk * aa, km = k * (1.f + (aa - 1.f) * k_a);
            float s3 = (r[0] * km[0] * r_k[0] + r[1] * km[1] * r_k[1]) + (r[2] * km[2] * r_k[2] + r[3] * km[3] * r_k[3]); s3 = row16_sum(s3);
            if ((lane & 15) == 0) C3[(size_t)(64 * c + tt) * 16 + hg * 4 + (lane >> 4)] = s3;
            const f32x4 lgm1 = lg; lg = lg + lw;
            f32x4 at, rt, bh, kh;
#pragma unroll
            for (int i = 0; i < 4; ++i) { const float em = __expf(lgm1[i]), ep = __expf(lg[i]), en = __expf(-lg[i]); at[i] = -kk[i] * em; rt[i] = r[i] * ep; bh[i] = b[i] * en; kh[i] = km[i] * en; }
            *(u32x2*)(AT + o) = (u32x2){pk2(at[0], at[1]), pk2(at[2], at[3])}; *(u32x2*)(RT + o) = (u32x2){pk2(rt[0], rt[1]), pk2(rt[2], rt[3])};
            *(u32x2*)(BH + o) = (u32x2){pk2(bh[0], bh[1]), pk2(bh[2], bh[3])}; *(u32x2*)(KH + o) = (u32x2){pk2(kh[0], kh[1]), pk2(kh[2], kh[3])};
            *(u32x2*)(V16 + o) = (u32x2){pk2(v[0], v[1]), pk2(v[2], v[3])};
        }
        f32x4 g; for (int i = 0; i < 4; ++i) g[i] = __expf(lg[i]);
        *(f32x4*)(GC + (size_t)c * D + col) = g;
    }
}

__device__ __forceinline__ void inv32(f32x16 N, f32x16 NT, f32x16& Tm, f32x16& TT, int lane) {
    Tm = N; TT = NT; add_eye(Tm, lane); add_eye(TT, lane);
    Pk Np = pack_tile(N), NTp = pack_tile(NT);
#pragma unroll
    for (int it = 0; it < 4; ++it) {
        const f32x16 z = {};
        const f32x16 N2 = xt(NTp, Np, z), N2T = xt(Np, NTp, z);
        const Pk N2p = pack_tile(N2), N2Tp = pack_tile(N2T), TTp = pack_tile(TT);
        Tm = xt(TTp, N2p, Tm);
        TT = xt(N2p, TTp, TT);
        Np = N2p; NTp = N2Tp;
    }
}

__device__ __forceinline__ void pa_chunk(Frame& F) {
    const int lane = F.lane, c32 = lane & 31, hh = lane >> 5;
    const bf16* AT = (const bf16*)(F.ws + WS_AT); const bf16* BH = (const bf16*)(F.ws + WS_BH); const bf16* KH = (const bf16*)(F.ws + WS_KH); const bf16* V16 = (const bf16*)(F.ws + WS_V16);
    const float* GC = (const float*)(F.ws + WS_GC);
    for (int task = F.gw; task < NCH * NH; task += F.NGW) {
        const int c = task >> 4, h = task & 15; const size_t o = (size_t)(64 * c) * D + h * 64;
        const bf16* at = AT + o; const bf16* bh = BH + o; const bf16* kh = KH + o; const bf16* vv = V16 + o;
        const f32x16 z = {};
        Pk T11, T22, T12, T11T, T22T, T12T;
        {
            f32x16 n = nat(bh, 0, at, 0, lane, z), nt = nat(at, 0, bh, 0, lane, z); mask_lt(n, lane); mask_gt(nt, lane);
            f32x16 t, tt; inv32(n, nt, t, tt, lane); T11 = pack_tile(t); T11T = pack_tile(tt);
            n = nat(bh, 1, at, 1, lane, z); nt = nat(at, 1, bh, 1, lane, z); mask_lt(n, lane); mask_gt(nt, lane);
            inv32(n, nt, t, tt, lane); T22 = pack_tile(t); T22T = pack_tile(tt);
            const Pk N12 = pack_tile(nat(bh, 0, at, 1, lane, z)), N12T = pack_tile(nat(at, 1, bh, 0, lane, z));
            const Pk Z1 = pack_tile(xt(N12T, T22, z));
            T12 = pack_tile(xt(T11T, Z1, z));
            const Pk Z2 = pack_tile(xt(N12, T11T, z));
            T12T = pack_tile(xt(T22, Z2, z));
        }
        {
            u32x4* tm = (u32x4*)(F.ws + WS_TM) + (size_t)task * 6 * 64 + lane;
            tm[0] = __builtin_bit_cast(u32x4, T11.k0); tm[64] = __builtin_bit_cast(u32x4, T11.k1); tm[128] = __builtin_bit_cast(u32x4, T12.k0); tm[192] = __builtin_bit_cast(u32x4, T12.k1);
            tm[256] = __builtin_bit_cast(u32x4, T22.k0); tm[320] = __builtin_bit_cast(u32x4, T22.k1);
        }
        const float g0 = GC[(size_t)c * D + h * 64 + c32], g1 = GC[(size_t)c * D + h * 64 + 32 + c32];
        Pk W1p[2][2];
#pragma unroll
        for (int b = 0; b < 2; ++b) { const float gcol = b == 0 ? g0 : g1;
            f32x16 bb0 = dl_copy(bh, 0, b, lane), bb1 = dl_copy(bh, 1, b, lane);
#pragma unroll
            for (int r = 0; r < 16; ++r) { bb0[r] *= gcol; bb1[r] *= gcol; }
            const Pk B0 = pack_tile(bb0), B1 = pack_tile(bb1);
            f32x16 w0 = xt(T11T, B0, z); w0 = xt(T12T, B1, w0);
            const f32x16 w1 = xt(T22T, B1, z);
            W1p[0][b] = pack_tile(w0); W1p[1][b] = pack_tile(w1); }
        {
            bf16* plr = (bf16*)(F.ws + WS_PLR) + (size_t)task * 4096;
#pragma unroll
            for (int a2 = 0; a2 < 2; ++a2) { const Pk A0 = pack_tile(dl_copy(at, 0, a2, lane)), A1 = pack_tile(dl_copy(at, 1, a2, lane));
#pragma unroll
                for (int b = 0; b < 2; ++b) { f32x16 p = xt(A0, W1p[0][b], z); p = xt(A1, W1p[1][b], p);
#pragma unroll
                    for (int g4 = 0; g4 < 4; ++g4) {
                        const int m_ = 2 * b + (c32 >> 4), lb_ = (c32 & 15) + 16 * (2 * (g4 & 1) + hh);
                        *(u32x2*)(plr + ((m_ * 2 + a2) * 64 + lb_) * 8 + 4 * (g4 >> 1)) = (u32x2){cvtpk(p[4 * g4], p[4 * g4 + 1]), cvtpk(p[4 * g4 + 2], p[4 * g4 + 3])}; } } }
        }
        Pk M2p[2][2];
        {
            f32x16 e = nat(at, 0, kh, 0, lane, z); mask_gt(e, lane); const Pk E00 = pack_tile(e);
            e = nat(at, 1, kh, 1, lane, z); mask_gt(e, lane); const Pk E11 = pack_tile(e);
            const Pk E10 = pack_tile(nat(at, 1, kh, 0, lane, z));
#pragma unroll
            for (int b = 0; b < 2; ++b) { const float gcol = b == 0 ? g0 : g1;
                f32x16 m0 = xt(E00, W1p[0][b], z); m0 = xt(E10, W1p[1][b], m0);
                f32x16 m1 = xt(E11, W1p[1][b], z);
                const f32x16 k0 = dl_copy(kh, 0, b, lane), k1 = dl_copy(kh, 1, b, lane);
#pragma unroll
                for (int r = 0; r < 16; ++r) { m0[r] += k0[r] * gcol; m1[r] += k1[r] * gcol; }
                M2p[0][b] = pack_tile(m0); M2p[1][b] = pack_tile(m1); }
        }
        {
            float* qm = (float*)(F.ws + WS_QM) + (size_t)task * 4096;
#pragma unroll
            for (int b = 0; b < 2; ++b) { const Pk V0 = pack_tile(dl_copy(vv, 0, b, lane)), V1 = pack_tile(dl_copy(vv, 1, b, lane));
#pragma unroll
                for (int a2 = 0; a2 < 2; ++a2) { f32x16 q = xt(M2p[0][a2], V0, z); q = xt(M2p[1][a2], V1, q);
#pragma unroll
                    for (int g4 = 0; g4 < 4; ++g4) {
                        const int rg_ = 2 * b + (c32 >> 4), m_ = 2 * a2 + (g4 >> 1), lb_ = (c32 & 15) + 16 * (2 * (g4 & 1) + hh);
                        *(f32x4*)(qm + rg_ * 1024 + (m_ * 64 + lb_) * 4) = (f32x4){q[4 * g4], q[4 * g4 + 1], q[4 * g4 + 2], q[4 * g4 + 3]}; } } }
        }
    }
}

constexpr int PB_NST = 10, PB_STB = 8192 + 4096 + 256, PB_NLD = 3;
constexpr int PB_FULL_OFF = RING_BYTES + 64, PB_CONS_OFF = RING_BYTES + 128;
static_assert(PB_NST * PB_STB <= RING_BYTES && PB_FULL_OFF + 4 * PB_NST <= PB_CONS_OFF && PB_CONS_OFF + 4 <= MISC_OFF, "phase-B LDS map");
__device__ __forceinline__ void pb_chain(Frame& F) {
    if ((F.vcu & 31) >= 8 || F.vcu >= 256 || F.wave > PB_NLD) return;
    const int lane = F.lane, h = 2 * (F.vcu >> 5) + ((F.vcu & 31) >> 2), rg = F.vcu & 3;
    volatile LAS unsigned* FULL = (volatile LAS unsigned*)(F.lds + PB_FULL_OFF); volatile LAS unsigned* CONS = (volatile LAS unsigned*)(F.lds + PB_CONS_OFF);
    if (F.wave >= 1) {
        const int L = F.wave - 1;
        const char* PLR = (const char*)(F.ws + WS_PLR); const char* QM = (const char*)(F.ws + WS_QM); const float* GC = (const float*)(F.ws + WS_GC);
        int k = 0;
        for (int c = L; c < NCH; c += PB_NLD, ++k) {
            if (c >= PB_NST) { const unsigned need = (unsigned)(c - PB_NST + 1); unsigned sp = 0; while (CONS[0] < need) { __builtin_amdgcn_s_sleep(1); if (++sp > (1u << 22)) break; } }
            const size_t task = (size_t)c * 16 + h;
            LAS unsigned char* slot = F.lds + (c % PB_NST) * PB_STB;
            const char* pl = PLR + task * 8192 + lane * 16; const char* qm = QM + task * 16384 + rg * 4096 + lane * 16;
#pragma unroll
            for (int i = 0; i < 8; ++i) __builtin_amdgcn_global_load_lds((const unsigned*)(pl + i * 1024), (LAS unsigned*)(slot + i * 1024), 16, 0, 0);
#pragma unroll
            for (int i = 0; i < 4; ++i) __builtin_amdgcn_global_load_lds((const unsigned*)(qm + i * 1024), (LAS unsigned*)(slot + 8192 + i * 1024), 16, 0, 0);
            __builtin_amdgcn_global_load_lds((const unsigned*)(GC + (size_t)c * D + h * 64 + lane), (LAS unsigned*)(slot + 12288), 4, 0, 0);
            if (k >= 2) { asm volatile("s_waitcnt vmcnt(26)" ::: "memory"); const int cp = c - 2 * PB_NLD; FULL[cp % PB_NST] = (unsigned)(cp + 1); }
        }
        const int clast = L + PB_NLD * (k - 1);
        if (k >= 2) { asm volatile("s_waitcnt vmcnt(13)" ::: "memory"); const int cp = clast - PB_NLD; FULL[cp % PB_NST] = (unsigned)(cp + 1); }
        asm volatile("s_waitcnt vmcnt(0)" ::: "memory"); FULL[clast % PB_NST] = (unsigned)(clast + 1);
        return;
    }
    const int n16 = lane & 15, q4 = lane >> 4;
    bf16* S0 = (bf16*)(F.ws + WS_S0);
    f32x4 s[4];
#pragma unroll
    for (int m = 0; m < 4; ++m) s[m] = (f32x4){0.f, 0.f, 0.f, 0.f};
    for (int c = 0; c < NCH; ++c) {
        { const unsigned need = (unsigned)(c + 1); unsigned sp = 0; while (FULL[c % PB_NST] < need) { if (++sp > (1u << 24)) break; } }
        const LAS unsigned char* slot = F.lds + (c % PB_NST) * PB_STB;
        bf16x8 af[4][2]; f32x4 qv[4], gc[4];
#pragma unroll
        for (int m = 0; m < 4; ++m) {
#pragma unroll
            for (int kb = 0; kb < 2; ++kb) af[m][kb] = *(const LAS bf16x8*)(slot + ((m * 2 + kb) * 64 + lane) * 16);
            qv[m] = *(const LAS f32x4*)(slot + 8192 + (m * 64 + lane) * 16); gc[m] = *(const LAS f32x4*)(slot + 12288 + 64 * m + 16 * q4); }
        asm volatile("s_waitcnt lgkmcnt(0)" ::: "memory");
        CONS[0] = (unsigned)(c + 1);
        bf16* s0 = S0 + ((size_t)c * 16 + h) * 4096 + (16 * rg + n16) * 64;
        u32x2 sp2[4];
#pragma unroll
        for (int m = 0; m < 4; ++m) { sp2[m] = (u32x2){cvtpk(s[m][0], s[m][1]), cvtpk(s[m][2], s[m][3])}; *(u32x2*)(s0 + 16 * m + 4 * q4) = sp2[m]; }
        const bf16x8 B0 = __builtin_bit_cast(bf16x8, (u32x4){sp2[0].x, sp2[0].y, sp2[1].x, sp2[1].y}), B1 = __builtin_bit_cast(bf16x8, (u32x4){sp2[2].x, sp2[2].y, sp2[3].x, sp2[3].y});
#pragma unroll
        for (int m = 0; m < 4; ++m) { f32x4 acc = s[m] * gc[m] + qv[m];
            acc = __builtin_amdgcn_mfma_f32_16x16x32_bf16(af[m][0], B0, acc, 0, 0, 0);
            acc = __builtin_amdgcn_mfma_f32_16x16x32_bf16(af[m][1], B1, acc, 0, 0, 0);
            s[m] = acc; }
    }
}

__device__ __forceinline__ void pc_out(Frame& F) {
    const int lane = F.lane, c32 = lane & 31, hh = lane >> 5;
    const bf16* AT = (const bf16*)(F.ws + WS_AT); const bf16* RT = (const bf16*)(F.ws + WS_RT); const bf16* BH = (const bf16*)(F.ws + WS_BH); const bf16* KH = (const bf16*)(F.ws + WS_KH);
    const bf16* V16 = (const bf16*)(F.ws + WS_V16); const bf16* S0 = (const bf16*)(F.ws + WS_S0); float* Y = (float*)(F.ws + WS_Y);
    for (int task = F.gw; task < NCH * NH; task += F.NGW) {
        const int c = task >> 4, h = task & 15; const size_t o = (size_t)(64 * c) * D + h * 64;
        const bf16* at = AT + o; const bf16* rt = RT + o; const bf16* bh = BH + o; const bf16* kh = KH + o; const bf16* vv = V16 + o;
        const bf16* s0 = S0 + (size_t)task * 4096;
        const f32x16 z = {};
        auto s0frag = [&](int it, int ks) { return *(const bf16x8*)(s0 + (32 * it + c32) * 64 + 16 * ks + 8 * hh); };
        Pk Tm00, Tm01, Tm11;
        { const u32x4* tm = (const u32x4*)(F.ws + WS_TM) + (size_t)task * 6 * 64 + lane;
          Tm00.k0 = __builtin_bit_cast(bf16x8, tm[0]); Tm00.k1 = __builtin_bit_cast(bf16x8, tm[64]); Tm01.k0 = __builtin_bit_cast(bf16x8, tm[128]); Tm01.k1 = __builtin_bit_cast(bf16x8, tm[192]);
          Tm11.k0 = __builtin_bit_cast(bf16x8, tm[256]); Tm11.k1 = __builtin_bit_cast(bf16x8, tm[320]); }
        f32x16 e = nat(kh, 0, at, 0, lane, z); mask_lt(e, lane); const Pk K00 = pack_tile(e);
        e = nat(kh, 1, at, 1, lane, z); mask_lt(e, lane); const Pk K11 = pack_tile(e);
        const Pk K01 = pack_tile(nat(kh, 0, at, 1, lane, z));
#pragma unroll 1
        for (int b = 0; b < 2; ++b) {
            const Pk V0 = pack_tile(dl_copy(vv, 0, b, lane)), V1 = pack_tile(dl_copy(vv, 1, b, lane));
            f32x16 x0 = z, x1 = z;
#pragma unroll
            for (int ks = 0; ks < 4; ++ks) { const bf16x8 sf = s0frag(b, ks); x0 = MFMA32(nfrag(at, 0, ks, lane), sf, x0); x1 = MFMA32(nfrag(at, 1, ks, lane), sf, x1); }
            x0 = xt(K00, V0, x0);
            x1 = xt(K01, V0, x1); x1 = xt(K11, V1, x1);
            const Pk X0 = pack_tile(x0), X1 = pack_tile(x1);
            const Pk U0 = pack_tile(xt(Tm00, X0, z));
            f32x16 u1 = xt(Tm01, X0, z); u1 = xt(Tm11, X1, u1); const Pk U1 = pack_tile(u1);
            f32x16 y0 = z, y1 = z;
#pragma unroll
            for (int ks = 0; ks < 4; ++ks) { const bf16x8 sf = s0frag(b, ks); y0 = MFMA32(nfrag(rt, 0, ks, lane), sf, y0); y1 = MFMA32(nfrag(rt, 1, ks, lane), sf, y1); }
            { f32x16 m = nat(bh, 0, rt, 0, lane, z); mask_le(m, lane); const Pk R00 = pack_tile(m); y0 = xt(R00, U0, y0);
              const Pk R01 = pack_tile(nat(bh, 0, rt, 1, lane, z)); y1 = xt(R01, U0, y1);
              m = nat(bh, 1, rt, 1, lane, z); mask_le(m, lane); const Pk R11 = pack_tile(m); y1 = xt(R11, U1, y1); }
            { f32x16 m = nat(kh, 0, rt, 0, lane, z); mask_le(m, lane); const Pk R00 = pack_tile(m); y0 = xt(R00, V0, y0);
              const Pk R01 = pack_tile(nat(kh, 0, rt, 1, lane, z)); y1 = xt(R01, V0, y1);
              m = nat(kh, 1, rt, 1, lane, z); mask_le(m, lane); const Pk R11 = pack_tile(m); y1 = xt(R11, V1, y1); }
            float* yp = Y + (size_t)(64 * c) * D + h * 64 + 32 * b + c32;
#pragma unroll
            for (int r = 0; r < 16; ++r) { yp[(size_t)crow(r, hh) * D] = y0[r]; yp[(size_t)(32 + crow(r, hh)) * D] = y1[r]; }
        }
    }
}

__device__ __forceinline__ void p6_gn_rows(Frame& F, const Args& a) {
    const int lane = F.lane;
    const float* Y = (const float*)(F.ws + WS_Y); const bf16* V16 = (const bf16*)(F.ws + WS_V16); const float* G = (const float*)(F.ws + WS_G);
    const float* C3 = (const float*)(F.ws + WS_CS) + (size_t)2 * T * 16; bf16* Z = (bf16*)(F.ws + WS_Z);
    const Row gg = ld_row(a.in[16], lane), gb = ld_row(a.in[17], lane);
    for (int t = F.gw; t < T; t += F.NGW) {
        const size_t o = (size_t)t * D;
        const Row y = ld_row(Y + o, lane), g = ld_row(G + o, lane), v = ld_row_bf16(V16 + o, lane); Row zr;
#pragma unroll
        for (int j = 0; j < 4; ++j) {
            const float mean = row16_sum((y.v[j][0] + y.v[j][1]) + (y.v[j][2] + y.v[j][3])) * (1.f / 64.f);
            const f32x4 d = y.v[j] - mean;
            const float var = row16_sum((d[0] * d[0] + d[1] * d[1]) + (d[2] * d[2] + d[3] * d[3])) * (1.f / 64.f);
            const float rs = rsqrtf(var + GN_EPS), c3 = C3[(size_t)t * 16 + 4 * j + (lane >> 4)];
            zr.v[j] = (d * rs * gg.v[j] + gb.v[j] + c3 * v.v[j]) * g.v[j];
        }
        st_row_bf16(Z + o, lane, zr);
    }
}

__device__ __forceinline__ void p6_gn(Frame& F, const Args& a) {
    const int lane = F.lane, wave = F.wave;
    const float* YT = (const float*)(F.ws + WS_YT); const float* V = (const float*)(F.ws + WS_V); const float* G = (const float*)(F.ws + WS_G);
    const float* C3 = (const float*)(F.ws + WS_CS) + (size_t)2 * T * 16; bf16* Z = (bf16*)(F.ws + WS_Z);
    LAS float* tile = (LAS float*)F.lds;
    for (int unit = F.vcu; unit < NH * (T / 64); unit += F.G) {
        const int h = unit / (T / 64), t0 = (unit % (T / 64)) * 64;
        __syncthreads();
#pragma unroll
        for (int q = 0; q < 8; ++q) { const int i = wave * 8 + q; tile[i * 65 + lane] = YT[(size_t)(h * 64 + i) * T + t0 + lane]; }
        __syncthreads();
        const float gg = a.in[16][h * 64 + lane], gb = a.in[17][h * 64 + lane];
#pragma unroll
        for (int q = 0; q < 8; ++q) { const int tt = wave * 8 + q, t = t0 + tt;
            const float y = tile[lane * 65 + tt];
            const float mean = wave_sum(y) * (1.f / 64.f); const float dlt = y - mean; const float var = wave_sum(dlt * dlt) * (1.f / 64.f);
            const size_t o = (size_t)t * D + h * 64 + lane;
            const float z = (dlt * rsqrtf(var + GN_EPS) * gg + gb + C3[(size_t)t * 16 + h] * V[o]) * G[o];
            Z[o] = (bf16)f2bf(z); }
    }
    __syncthreads();
}

__device__ __forceinline__ void p8_norm(Frame& F, const float* g, bf16* U) {
    const float* Hs = (const float*)(F.ws + WS_H); const Row gr = ld_row(g, F.lane);
    for (int t = F.gw; t < T; t += F.NGW) st_row_bf16(U + (size_t)t * D, F.lane, rmsnorm_row(ld_row(Hs + (size_t)t * D, F.lane), gr));
}
__device__ __forceinline__ void p11_norm_forget(Frame& F, const Args& a) {
    const int lane = F.lane; const float* Hs = (const float*)(F.ws + WS_H); bf16* U = (bf16*)(F.ws + WS_U3); float* LF = (float*)(F.ws + WS_LF);
    LAS float* wf = (LAS float*)F.lds;
    __syncthreads();
    for (int i = F.tid; i < 16 * D; i += NTHREADS) { const int hh = i & 15, k = i >> 4; wf[hh * D + k] = a.in[19][(size_t)k * WIN_LD + 4 * D + hh]; }
    __syncthreads();
    const Row gr = ld_row(a.in[1] + 2 * D, lane);
    for (int t = F.gw; t < T; t += F.NGW) {
        const Row u = rmsnorm_row(ld_row(Hs + (size_t)t * D, lane), gr);
        st_row_bf16(U + (size_t)t * D, lane, u);
        float mine = 0.f;
#pragma unroll 2
        for (int hh = 0; hh < 16; ++hh) { float s = 0.f;
#pragma unroll
            for (int j = 0; j < 4; ++j) { const f32x4 w = *(const LAS f32x4*)(wf + hh * D + 256 * j + 4 * lane); s += (u.v[j][0] * w[0] + u.v[j][1] * w[1]) + (u.v[j][2] * w[2] + u.v[j][3] * w[3]); }
            s = wave_sum(s); if (lane == hh) mine = s; }
        if (lane < 16) { const float x = mine + a.in[20][lane]; LF[(size_t)t * 16 + lane] = fminf(x, 0.f) - log1pf(__expf(-fabsf(x))); }
    }
    __syncthreads();
}
__device__ __forceinline__ void p13_cumsum_qknorm(Frame& F, const Args& a) {
    const int lane = F.lane, tid = F.tid;
    const float* LF = (const float*)(F.ws + WS_LF); float* C2 = (float*)(F.ws + WS_C2); float* CB = (float*)(F.ws + WS_CB);
    if (F.vcu < NH) {
        const int h = F.vcu; LAS double* part = (LAS double*)F.lds;
        __syncthreads();
        const int tb = tid * 32; double s = 0.0;
        for (int i = 0; i < 32; ++i) s += (double)LF[(size_t)(tb + i) * 16 + h];
        part[tid] = s; __syncthreads();
        if (tid == 0) { double run = 0.0; for (int i = 0; i < NTHREADS; ++i) { const double v = part[i]; part[i] = run; run += v; } }
        __syncthreads();
        double run = part[tid];
        for (int i = 0; i < 32; ++i) { run += (double)LF[(size_t)(tb + i) * 16 + h]; const float c = (float)(run * 1.4426950408889634); C2[(size_t)h * T + tb + i] = c; if (((tb + i) & 63) == 63) CB[h * 256 + ((tb + i) >> 6)] = c; }
        __syncthreads();
    }
    bf16* Q = (bf16*)(F.ws + WS_QKVG);
    f32x4 gq[4], gk[4];
#pragma unroll
    for (int j = 0; j < 4; ++j) { const int c = (4 * lane + 256 * j) & 63; gq[j] = *(const f32x4*)(a.in[21] + c) * (0.125f * LOG2E); gk[j] = *(const f32x4*)(a.in[22] + c); }
    for (int t = F.gw; t < T; t += F.NGW) {
#pragma unroll
        for (int which = 0; which < 2; ++which) {
            bf16* p = Q + (size_t)t * 4096 + which * D;
            Row x = ld_row_bf16(p, lane);
#pragma unroll
            for (int j = 0; j < 4; ++j) { float ss = (x.v[j][0] * x.v[j][0] + x.v[j][1] * x.v[j][1]) + (x.v[j][2] * x.v[j][2] + x.v[j][3] * x.v[j][3]); ss = row16_sum(ss);
                const float rs = rsqrtf(ss * (1.f / 64.f) + RMS_EPS); x.v[j] = x.v[j] * rs * (which == 0 ? gq[j] : gk[j]); }
            st_row_bf16(p, lane, x);
        }
    }
}

constexpr int KP = 144;
__device__ __forceinline__ void p14_attention(Frame& F, const Args& a, int qword = CW_ATTQ) {
    const int tid = F.tid, lane = F.lane, wid = F.wave, r32 = lane & 31, hi = lane >> 5;
    const bf16* QKVG = (const bf16*)(F.ws + WS_QKVG); const float* C2 = (const float*)(F.ws + WS_C2); const float* CB = (const float*)(F.ws + WS_CB);
    bf16* Z2 = (bf16*)(F.ws + WS_Z2);
    LAS unsigned char* Ks = F.lds; LAS unsigned char* Vs = F.lds + 64 * KP; LAS float* bias = (LAS float*)(F.lds + 2 * 64 * KP); LAS int* uslot = (LAS int*)(F.lds + 2 * 64 * KP + 256);
    float mq = 0.f, mk = 0.f;
    for (int i = 0; i < 64; ++i) { mq = fmaxf(mq, fabsf(a.in[21][i])); mk = fmaxf(mk, fabsf(a.in[22][i])); }
    const float THR2 = (2.f * 8.f * mq * mk * 1.01f + 30.f) * LOG2E;
    gu32* qctr = F.ctl + qword;
    for (;;) {
        __syncthreads();
        if (tid == 0) uslot[0] = (int)__hip_atomic_fetch_add(qctr, 1u, RLX_AGENT);
        __syncthreads();
        const int unit = uslot[0];
        if (unit >= NH * (T / 256)) break;
        const int h = unit & 15, qb = (T / 256 - 1) - (unit >> 4), q0 = qb * 256;
        const float ct0 = C2[(size_t)h * T + q0];
        int jstart = 0;
        { int tot = 0; for (int j0 = 0; j0 < 4 * qb; j0 += 64) { const int j = j0 + lane; const bool skip = (j < 4 * qb) && ((ct0 - CB[h * 256 + j]) < -THR2); tot += __popcll(__ballot(skip)); } jstart = tot; }
        const int jend = 4 * qb + 3;
        const int qrow = q0 + wid * 32 + r32;
        bf16x8 qr[4];
#pragma unroll
        for (int d0 = 0; d0 < 4; ++d0) qr[d0] = *(const bf16x8*)(QKVG + (size_t)qrow * 4096 + h * 64 + d0 * 16 + hi * 8);
        f32x16 o0 = {}, o1 = {}; float m = -INFINITY, l = 0.f;
        const int lrow = tid >> 3, lch = tid & 7;
        u32x4 kreg, vreg; float breg = 0.f;
        auto gload = [&](int j) { const size_t row = (size_t)(64 * j + lrow) * 4096 + h * 64 + lch * 8;
            kreg = *(const u32x4*)(QKVG + row + D); vreg = *(const u32x4*)(QKVG + row + 2 * D); if (tid < 64) breg = -C2[(size_t)h * T + 64 * j + tid]; };
        gload(jstart);
        for (int j = jstart; j <= jend; ++j) {
            __syncthreads();
            *(LAS u32x4*)(Ks + lrow * KP + lch * 16) = kreg;
            { const int s_ = lrow >> 4, x_ = lrow & 15, p_ = s_ * 16 + ((x_ >> 2) & 1) * 8 + (((x_ >> 3) << 2) | (x_ & 3));
                const unsigned w_[4] = {vreg.x, vreg.y, vreg.z, vreg.w};
#pragma unroll
                for (int e = 0; e < 8; ++e) *(LAS unsigned short*)(Vs + (lch * 8 + e) * KP + p_ * 2) = (unsigned short)(w_[e >> 1] >> ((e & 1) * 16)); }
            if (tid < 64) bias[tid] = breg;
            __syncthreads();
            if (j < jend) gload(j + 1);
            f32x16 p0 = {}, p1 = {};
#pragma unroll
            for (int d0 = 0; d0 < 4; ++d0) {
                const bf16x8 k0 = *(const LAS bf16x8*)(Ks + r32 * KP + d0 * 32 + hi * 16);
                const bf16x8 k1 = *(const LAS bf16x8*)(Ks + (32 + r32) * KP + d0 * 32 + hi * 16);
                p0 = __builtin_amdgcn_mfma_f32_32x32x16_bf16(k0, qr[d0], p0, 0, 0, 0);
                p1 = __builtin_amdgcn_mfma_f32_32x32x16_bf16(k1, qr[d0], p1, 0, 0, 0);
            }
#pragma unroll
            for (int g4 = 0; g4 < 4; ++g4) { const f32x4 b0 = *(const LAS f32x4*)(bias + 8 * g4 + 4 * hi), b1 = *(const LAS f32x4*)(bias + 32 + 8 * g4 + 4 * hi);
#pragma unroll
                for (int i = 0; i < 4; ++i) { p0[4 * g4 + i] += b0[i]; p1[4 * g4 + i] += b1[i]; } }
            if (j >= 4 * qb) {
                const int kb = 64 * j;
#pragma unroll
                for (int r = 0; r < 16; ++r) { const int kv = kb + crow(r, hi); if (kv > qrow) p0[r] = -INFINITY; if (kv + 32 > qrow) p1[r] = -INFINITY; }
            }
            float mloc = fmaxf(p0[0], p1[0]);
#pragma unroll
            for (int r = 1; r < 16; ++r) mloc = fmaxf(mloc, fmaxf(p0[r], p1[r]));
            mloc = fmaxf(mloc, __shfl_xor(mloc, 32));
            const float mnew = fmaxf(m, mloc);
            const float alpha = exp2f(m - mnew);
            float ls = 0.f;
#pragma unroll
            for (int r = 0; r < 16; ++r) { p0[r] = exp2f(p0[r] - mnew); p1[r] = exp2f(p1[r] - mnew); ls += p0[r] + p1[r]; }
            l = l * alpha + ls; m = mnew;
#pragma unroll
            for (int r = 0; r < 16; ++r) { o0[r] *= alpha; o1[r] *= alpha; }
#pragma unroll
            for (int s = 0; s < 4; ++s) {
                u32x4 pw;
                if (s == 0) pw = (u32x4){pk2(p0[0], p0[1]), pk2(p0[2], p0[3]), pk2(p0[4], p0[5]), pk2(p0[6], p0[7])};
                else if (s == 1) pw = (u32x4){pk2(p0[8], p0[9]), pk2(p0[10], p0[11]), pk2(p0[12], p0[13]), pk2(p0[14], p0[15])};
                else if (s == 2) pw = (u32x4){pk2(p1[0], p1[1]), pk2(p1[2], p1[3]), pk2(p1[4], p1[5]), pk2(p1[6], p1[7])};
                else pw = (u32x4){pk2(p1[8], p1[9]), pk2(p1[10], p1[11]), pk2(p1[12], p1[13]), pk2(p1[14], p1[15])};
                const bf16x8 pf = __builtin_bit_cast(bf16x8, pw);
                const bf16x8 v0 = *(const LAS bf16x8*)(Vs + r32 * KP + s * 32 + hi * 16);
                const bf16x8 v1 = *(const LAS bf16x8*)(Vs + (32 + r32) * KP + s * 32 + hi * 16);
                o0 = __builtin_amdgcn_mfma_f32_32x32x16_bf16(v0, pf, o0, 0, 0, 0);
                o1 = __builtin_amdgcn_mfma_f32_32x32x16_bf16(v1, pf, o1, 0, 0, 0);
            }
        }
        l += __shfl_xor(l, 32);
        const float rl = 1.f / l;
#pragma unroll
        for (int dt = 0; dt < 2; ++dt)
#pragma unroll
            for (int g4 = 0; g4 < 4; ++g4) { const int d = 32 * dt + 8 * g4 + 4 * hi; const size_t col = (size_t)h * 64 + d;
                const u32x2 ogw = *(const u32x2*)(QKVG + (size_t)qrow * 4096 + 3 * D + col);
                const float og[4] = {bflo(ogw.x), bfhi(ogw.x), bflo(ogw.y), bfhi(ogw.y)}; float ov[4];
#pragma unroll
                for (int i = 0; i < 4; ++i) ov[i] = (dt == 0 ? o0[4 * g4 + i] : o1[4 * g4 + i]) * rl * sigmoidf_(og[i]);
                u32x2 w; w.x = pk2(ov[0], ov[1]); w.y = pk2(ov[2], ov[3]);
                *(u32x2*)(Z2 + (size_t)qrow * D + col) = w; }
    }
}

struct TokInfo { int e0, e1, p0, p1; float g0, g1; int d0, d1; };
__device__ __forceinline__ void p16_router(Frame& F, const Args& a) {
    const int lane = F.lane, tid = F.tid; const float* Hs = (const float*)(F.ws + WS_H); bf16* U = (bf16*)(F.ws + WS_U4);
    TokInfo* TI = (TokInfo*)(F.ws + WS_TOK);
    LAS float* wr_ = (LAS float*)F.lds;
    LAS int* lcnt = (LAS int*)(F.lds + 32768);
    const Row gr = ld_row(a.in[1] + 3 * D, lane);
    __syncthreads();
    for (int i = tid; i < NE * D; i += NTHREADS) { const int e = i & 7, k = i >> 3; wr_[e * D + k] = a.in[26][(size_t)k * NE + e]; }
    for (int tb = F.vcu * 64; tb < T; tb += F.G * 64) {
        __syncthreads();
        if (tid < 16) lcnt[tid] = 0;
        __syncthreads();
        int e0s[8], e1s[8], p0s[8], p1s[8]; float g0s[8];
#pragma unroll
        for (int q = 0; q < 8; ++q) { const int t = tb + F.wave * 8 + q;
            const Row u = rmsnorm_row(ld_row(Hs + (size_t)t * D, lane), gr);
            st_row_bf16(U + (size_t)t * D, lane, u);
            float lg[NE];
#pragma unroll
            for (int e = 0; e < NE; ++e) { float s = 0.f;
#pragma unroll
                for (int j = 0; j < 4; ++j) { const f32x4 w = *(const LAS f32x4*)(wr_ + e * D + 256 * j + 4 * lane); s += (u.v[j][0] * w[0] + u.v[j][1] * w[1]) + (u.v[j][2] * w[2] + u.v[j][3] * w[3]); }
                lg[e] = wave_sum(s); }
            int b0 = 0; float v0 = lg[0];
#pragma unroll
            for (int e = 1; e < NE; ++e) if (lg[e] > v0) { v0 = lg[e]; b0 = e; }
            int b1 = -1; float v1 = -INFINITY;
#pragma unroll
            for (int e = 0; e < NE; ++e) if (e != b0 && lg[e] > v1) { v1 = lg[e]; b1 = e; }
            e0s[q] = b0; e1s[q] = b1; g0s[q] = 1.f / (1.f + __expf(v1 - v0));
            int pa = 0, pb = 0;
            if (lane == 0) { pa = atomicAdd((int*)&lcnt[b0], 1); pb = atomicAdd((int*)&lcnt[b1], 1); }
            p0s[q] = pa; p1s[q] = pb;
        }
        __syncthreads();
        if (tid < NE) lcnt[8 + tid] = (int)__hip_atomic_fetch_add(F.ctl + CW_CNT + 64 * tid, (unsigned)lcnt[tid], RLX_AGENT);
        __syncthreads();
        if (lane == 0) {
#pragma unroll
            for (int q = 0; q < 8; ++q) { const int t = tb + F.wave * 8 + q; TokInfo ti; ti.e0 = e0s[q]; ti.e1 = e1s[q]; ti.p0 = lcnt[8 + e0s[q]] + p0s[q]; ti.p1 = lcnt[8 + e1s[q]] + p1s[q];
                ti.g0 = g0s[q]; ti.g1 = 1.f - g0s[q]; ti.d0 = 0; ti.d1 = 0; TI[t] = ti; }
        }
    }
    __syncthreads();
}
__device__ __forceinline__ int moe_ends(Frame& F, LAS int* ends) {
    __syncthreads();
    if (F.tid == 0) { int run = 0; for (int e = 0; e < NE; ++e) { const int c = (int)__hip_atomic_load(F.ctl + CW_CNT + 64 * e, RLX_AGENT); run += (c + 255) >> 8; ends[e] = run; } }
    __syncthreads();
    return ends[NE - 1];
}
__device__ __forceinline__ void p17_gather(Frame& F) {
    LAS int* ends = (LAS int*)(F.lds + RING_BYTES);
    moe_ends(F, ends);
    const bf16* U = (const bf16*)(F.ws + WS_U4); bf16* AM = (bf16*)(F.ws + WS_AM); TokInfo* TI = (TokInfo*)(F.ws + WS_TOK);
    for (int t = F.gw; t < T; t += F.NGW) {
        const TokInfo ti = TI[t];
        const int d0 = (ti.e0 ? ends[ti.e0 - 1] : 0) * 256 + ti.p0, d1 = (ti.e1 ? ends[ti.e1 - 1] : 0) * 256 + ti.p1;
        const u32x4* src = (const u32x4*)(U + (size_t)t * D) + F.lane; const u32x4 x0 = src[0], x1 = src[64];
        u32x4* o0 = (u32x4*)(AM + (size_t)d0 * D) + F.lane; o0[0] = x0; o0[64] = x1;
        u32x4* o1 = (u32x4*)(AM + (size_t)d1 * D) + F.lane; o1[0] = x0; o1[64] = x1;
        if (F.lane == 0) { TI[t].d0 = d0; TI[t].d1 = d1; }
    }
}
__device__ __forceinline__ void p20_combine(Frame& F, const Args& a) {
    const int lane = F.lane; const float* Hs = (const float*)(F.ws + WS_H); const bf16* YS = (const bf16*)(F.ws + WS_YS); const TokInfo* TI = (const TokInfo*)(F.ws + WS_TOK);
    const Row gr = ld_row(a.in[2], lane);
    for (int t = F.gw; t < T; t += F.NGW) {
        const TokInfo ti = TI[t];
        Row hrow = ld_row(Hs + (size_t)t * D, lane); const Row y0 = ld_row_bf16(YS + (size_t)ti.d0 * D, lane), y1 = ld_row_bf16(YS + (size_t)ti.d1 * D, lane);
#pragma unroll
        for (int j = 0; j < 4; ++j) hrow.v[j] = hrow.v[j] + ti.g0 * y0.v[j] + ti.g1 * y1.v[j];
        st_row(a.out + (size_t)t * D, lane, rmsnorm_row(hrow, gr));
    }
}

constexpr int N_PHASES = 21;
__global__ void __launch_bounds__(NTHREADS, 2) trunk_fwd(Args args) {
    extern __shared__ __attribute__((aligned(16))) unsigned char lds_raw[];
    Frame F;
    F.lds = (LAS unsigned char*)lds_raw; F.ws = args.ws; F.ctl = (gu32*)(args.ws + WS_CTL);
    F.tid = threadIdx.x; F.lane = F.tid & 63; F.wave = __builtin_amdgcn_readfirstlane(F.tid >> 6);
    F.G = gridDim.x; { const int bx = blockIdx.x; F.vcu = (F.G % 8 == 0) ? (bx % 8) * (F.G / 8) + bx / 8 : bx; }
    F.gw = F.vcu * NWAVES + F.wave; F.NGW = F.G * NWAVES;
    volatile LAS unsigned* MISC = (volatile LAS unsigned*)(F.lds + MISC_OFF);
    for (int u = F.tid; u < (LDS_BYTES - RING_BYTES) / 4; u += NTHREADS) ((LAS unsigned*)(F.lds + RING_BYTES))[u] = 0u;
    __syncthreads();
    const int lo = args.ph_lo, hi = args.ph_hi;
    const bool use_bar = (hi - lo) > 1;
    XcdBarrier bar; bar.bar = (unsigned*)(F.ctl + CW_BAR); bar.x = 0; bar.st = nullptr;
    if (use_bar) bar = xcd_barrier_post((unsigned*)(F.ctl + CW_BAR), MISC + 8);
#ifdef ONLY_PHASE
#define IN(k) ((k) == ONLY_PHASE && lo <= (k) && (k) < hi)
#else
#define IN(k) (lo <= (k) && (k) < hi)
#endif
#define SEAM(k) do { if (IN((k) + 1)) xcd_barrier(bar); } while (0)
    unsigned char* ws = args.ws;
    const int c = (int)blockIdx.x;
    LAS unsigned char* ring = F.lds;

    if (IN(0)) { p0_prologue(F, args); if (DUP_PHASE == 0) { xcd_barrier(bar); p0_prologue(F, args); } p1_shift(F, args); SEAM(0); }
    if (IN(1)) {
        { pg8::Gemm g{D, D, D}; pg8::SchedRKV S; S.o.init(T / 256, 12, F.G, c); S.A = (const char*)(ws + WS_XS); S.B = (const char*)(ws + WS_W_RKV); S.astep = (size_t)256 * D * 2; S.bstep = (size_t)256 * D * 2; S.azstride = (size_t)T * D * 2;
          pg8::EpiRKV E{(float*)(ws + WS_R), (size_t)T * D};
          pg8::gemm_phase<pg8::EpiRKV, pg8::SchedRKV, true>(ring, g, S, E); }
        { pg8::Gemm g{D, 2 * D, 2 * D}; pg8::SchedPlain S; S.o.init(T / 256, 1, F.G, c); S.A = (const char*)(ws + WS_UB); S.B = (const char*)(ws + WS_W_L1); S.astep = (size_t)256 * D * 2; S.bstep = (size_t)256 * 2 * D * 2;
          pg8::EpiL1 E{(bf16*)(ws + WS_L1)};
          pg8::gemm_phase<pg8::EpiL1, pg8::SchedPlain, true>(ring, g, S, E); }
        SEAM(1); }
    if (IN(2)) {
        pg8::Gemm g{256, 256, 256}; pg8::SchedPlain S; S.o.init(T / 256, 12, F.G, c); S.A = (const char*)(ws + WS_L1); S.B = (const char*)(ws + WS_W_L2); S.astep = (size_t)256 * 256 * 2; S.bstep = (size_t)256 * 256 * 2;
        static_assert(WS_AA - WS_LW == WS_G - WS_AA, "LW, AA, G evenly spaced");
        pg8::EpiL2 E{(float*)(ws + WS_LW), args.in[5], args.in[8]};
        pg8::gemm_phase<pg8::EpiL2, pg8::SchedPlain, true>(ring, g, S, E);
        SEAM(2); }
    if (IN(3)) { p3_prep(F, args); if (DUP_PHASE == 3) { xcd_barrier(bar); p3_prep(F, args); } SEAM(3); }
    if (IN(4)) { pa_chunk(F); if (DUP_PHASE == 4) { xcd_barrier(bar); pa_chunk(F); } SEAM(4); }
    if (IN(5)) { pb_chain(F); if (DUP_PHASE == 5) { xcd_barrier(bar); pb_chain(F); } SEAM(5); }
    if (IN(6)) { pc_out(F); if (DUP_PHASE == 6) { xcd_barrier(bar); pc_out(F); } SEAM(6); }
    if (IN(7)) { p6_gn_rows(F, args); if (DUP_PHASE == 7) { xcd_barrier(bar); p6_gn_rows(F, args); } SEAM(7); }
    if (IN(8)) {
        pg8::Gemm g{D, D, D}; pg8::SchedPlain S; S.o.init(T / 256, 4, F.G, c); S.A = (const char*)(ws + WS_Z); S.B = (const char*)(ws + WS_W_O0); S.astep = (size_t)256 * D * 2; S.bstep = (size_t)256 * D * 2;
        pg8::EpiRes E{args.in[0], (float*)(ws + WS_H)};
        pg8::gemm_phase<pg8::EpiRes, pg8::SchedPlain, true>(ring, g, S, E);
        SEAM(8); }
    if (IN(9)) { p8_norm(F, args.in[1] + D, (bf16*)(ws + WS_U2)); SEAM(9); }
    if (IN(10)) {
        pg8::Gemm g{D, D, D}; pg8::SchedPlain S; S.o.init(T / 256, 2 * FF / 256, F.G, c); S.A = (const char*)(ws + WS_U2); S.B = (const char*)(ws + WS_W_GU); S.astep = (size_t)256 * D * 2; S.bstep = (size_t)256 * D * 2;
        pg8::EpiSwiGLU E{(bf16*)(ws + WS_ACT)};
        pg8::gemm_phase<pg8::EpiSwiGLU, pg8::SchedPlain, true>(ring, g, S, E);
        SEAM(10); }
    if (IN(11)) {
        pg8::Gemm g{FF, FF, FF}; pg8::SchedPlain S; S.o.init(T / 256, 4, F.G, c); S.A = (const char*)(ws + WS_ACT); S.B = (const char*)(ws + WS_W_DN); S.astep = (size_t)256 * FF * 2; S.bstep = (size_t)256 * FF * 2;
        pg8::EpiRes E{(const float*)(ws + WS_H), (float*)(ws + WS_H)};
        pg8::gemm_phase<pg8::EpiRes, pg8::SchedPlain, true>(ring, g, S, E);
        SEAM(11); }
    if (IN(12)) { p11_norm_forget(F, args); SEAM(12); }
    if (IN(13)) {
        pg8::Gemm g{D, D, D}; pg8::SchedPlain S; S.o.init(T / 256, 16, F.G, c); S.A = (const char*)(ws + WS_U3); S.B = (const char*)(ws + WS_W_IN); S.astep = (size_t)256 * D * 2; S.bstep = (size_t)256 * D * 2;
        pg8::EpiBf16 E{(bf16*)(ws + WS_QKVG), 4096};
        pg8::gemm_phase<pg8::EpiBf16, pg8::SchedPlain, true>(ring, g, S, E);
        SEAM(13); }
    if (IN(14)) { p13_cumsum_qknorm(F, args); SEAM(14); }
    if (IN(15)) { p14_attention(F, args); if (DUP_PHASE == 15) { xcd_barrier(bar); p14_attention(F, args, CW_ATTQ + 64); } SEAM(15); }
    if (IN(16)) {
        pg8::Gemm g{D, D, D}; pg8::SchedPlain S; S.o.init(T / 256, 4, F.G, c); S.A = (const char*)(ws + WS_Z2); S.B = (const char*)(ws + WS_W_FO); S.astep = (size_t)256 * D * 2; S.bstep = (size_t)256 * D * 2;
        pg8::EpiRes E{(const float*)(ws + WS_H), (float*)(ws + WS_H)};
        pg8::gemm_phase<pg8::EpiRes, pg8::SchedPlain, true>(ring, g, S, E);
        SEAM(16); }
    if (IN(17)) { p16_router(F, args); SEAM(17); }
    if (IN(18)) { p17_gather(F); SEAM(18); }
    if (IN(19)) {
        LAS int* ends = (LAS int*)(F.lds + RING_BYTES); const int nblk = moe_ends(F, ends);
        pg8::Gemm g{D, D, D}; pg8::SchedMoe S; S.o.init(nblk, 2 * FF / 256, F.G, c); S.A = (const char*)(ws + WS_AM); S.B = (const char*)(ws + WS_W_MGU); S.astep = (size_t)256 * D * 2; S.bstep = (size_t)256 * D * 2; S.bestride = (size_t)2 * FF * D * 2; S.ends = ends;
        pg8::EpiSwiGLU E{(bf16*)(ws + WS_ACT2)};
        pg8::gemm_phase<pg8::EpiSwiGLU, pg8::SchedMoe, true>(ring, g, S, E);
        SEAM(19); }
    if (IN(20)) {
        LAS int* ends = (LAS int*)(F.lds + RING_BYTES); const int nblk = moe_ends(F, ends);
        pg8::Gemm g{FF, FF, FF}; pg8::SchedMoe S; S.o.init(nblk, 4, F.G, c); S.A = (const char*)(ws + WS_ACT2); S.B = (const char*)(ws + WS_W_MDN); S.astep = (size_t)256 * FF * 2; S.bstep = (size_t)256 * FF * 2; S.bestride = (size_t)D * FF * 2; S.ends = ends;
        pg8::EpiBf16 E{(bf16*)(ws + WS_YS), D};
        pg8::gemm_phase<pg8::EpiBf16, pg8::SchedMoe, true>(ring, g, S, E);
        SEAM(20); }
    if (IN(21)) { p20_combine(F, args); }
#undef IN
#undef SEAM
}

extern "C" void kernel_launch(void* const* d_in, const int* in_sizes, int n_in, void* d_out, int out_size, void* d_ws, size_t ws_size, hipStream_t stream) {
    static int grid = 0;
    if (grid == 0) {
        if (n_in != 29 || out_size != T * D || ws_size < WS_END) { fprintf(stderr, "kernel_launch: unexpected problem (n_in %d out %d ws %zu)\n", n_in, out_size, ws_size); grid = -1; return; }
        int dev = 0, cus = 0;
        if (hipGetDevice(&dev) != hipSuccess || hipDeviceGetAttribute(&cus, hipDeviceAttributeMultiprocessorCount, dev) != hipSuccess) { grid = -1; return; }
        if (hipFuncSetAttribute((const void*)trunk_fwd, hipFuncAttributeMaxDynamicSharedMemorySize, LDS_BYTES) != hipSuccess) { fprintf(stderr, "kernel_launch: hipFuncSetAttribute failed\n"); grid = -1; return; }
        int per_cu = 0;
        if (hipOccupancyMaxActiveBlocksPerMultiprocessor(&per_cu, (const void*)trunk_fwd, NTHREADS, LDS_BYTES) != hipSuccess || per_cu < 1) fprintf(stderr, "kernel_launch: occupancy query says %d\n", per_cu);
        (void)hipGetLastError();
        grid = cus;
    }
    if (grid < 0) return;
    (void)hipMemsetAsync((char*)d_ws + WS_CTL, 0, CTL_ZERO_BYTES, stream);
    Args a{};
    for (int i = 0; i < 29; ++i) a.in[i] = (const float*)d_in[i];
    a.out = (float*)d_out; a.ws = (unsigned char*)d_ws;
    constexpr int NPH = 22;
    if (LAUNCH_MODE == 1) { a.ph_lo = 0; a.ph_hi = NPH; hipLaunchKernelGGL(trunk_fwd, dim3(grid), dim3(NTHREADS), LDS_BYTES, stream, a); }
    else for (int p = 0; p < NPH; ++p) { a.ph_lo = p; a.ph_hi = p + 1; hipLaunchKernelGGL(trunk_fwd, dim3(grid), dim3(NTHREADS), LDS_BYTES, stream, a); }
}
```

```cpp
#include <hip/hip_runtime.h>
#include <cstdio>
#include <cstdint>

#ifndef DUP_PHASE
#define DUP_PHASE -1
#endif
#ifndef LAUNCH_MODE
#define LAUNCH_MODE 1
#endif

#define GAS __attribute__((address_space(1)))
#define LAS __attribute__((address_space(3)))
typedef unsigned short bf16;
typedef short bf16x8 __attribute__((ext_vector_type(8)));
typedef float f32x4 __attribute__((ext_vector_type(4)));
typedef float f32x2 __attribute__((ext_vector_type(2)));
typedef float f32x16 __attribute__((ext_vector_type(16)));
typedef unsigned u32x4 __attribute__((ext_vector_type(4)));
typedef unsigned u32x2 __attribute__((ext_vector_type(2)));
typedef GAS unsigned gu32;
#define RLX_AGENT __ATOMIC_RELAXED, __HIP_MEMORY_SCOPE_AGENT

constexpr int T = 16384, D = 1024, NH = 16, HD = 64, FF = 3584, NE = 8, WIN_LD = 4 * D + NH;
constexpr int NWAVES = 8, NTHREADS = 512;
constexpr float RMS_EPS = 1e-6f, GN_EPS = 64e-5f;
constexpr int MOE_ROWS = (2 * T / 256 + NE) * 256;
constexpr float LOG2E = 1.4426950408889634f;

constexpr size_t MiB = 1u << 20;
constexpr size_t WS_CTL = 0, CTL_ZERO_BYTES = 1 * MiB;
constexpr size_t WS_W_RKV = 2 * MiB, WS_W_L1 = 8 * MiB, WS_W_L2 = 9 * MiB, WS_W_O0 = 11 * MiB, WS_W_GU = 13 * MiB, WS_W_DN = 27 * MiB,
                 WS_W_IN = 34 * MiB, WS_W_FO = 42 * MiB, WS_W_MGU = 44 * MiB, WS_W_MDN = 156 * MiB;
constexpr size_t WS_H = 216 * MiB;
constexpr size_t WS_UB = 280 * MiB, WS_XS = 313 * MiB;
constexpr size_t WS_KK = 280 * MiB, WS_BB = 344 * MiB;
constexpr size_t WS_Z = 280 * MiB, WS_U2 = 344 * MiB;
constexpr size_t WS_U3 = 280 * MiB, WS_Z2 = 312 * MiB, WS_U4 = 280 * MiB, WS_AM = 312 * MiB;
constexpr size_t WS_R = 410 * MiB, WS_K = 474 * MiB, WS_V = 538 * MiB;
constexpr size_t WS_ACT = 410 * MiB;
constexpr size_t WS_QKVG = 410 * MiB;
constexpr size_t WS_ACT2 = 410 * MiB;
constexpr size_t WS_LW = 602 * MiB, WS_AA = 666 * MiB, WS_G = 730 * MiB;
constexpr size_t WS_YT = 666 * MiB;
constexpr size_t WS_YS = 666 * MiB;
constexpr size_t WS_L1 = 794 * MiB;
constexpr size_t WS_CS = 802 * MiB;
constexpr size_t WS_LF = 806 * MiB, WS_C2 = 807 * MiB, WS_CB = 808 * MiB, WS_TOK = 809 * MiB;
constexpr size_t WS_END = 810 * MiB;
constexpr size_t WS_AT = 280 * MiB, WS_RT = 312 * MiB, WS_BH = 344 * MiB, WS_KH = 376 * MiB;
constexpr size_t WS_V16 = 216 * MiB, WS_GC = 248 * MiB;
constexpr size_t WS_QM = 410 * MiB, WS_PLR = 474 * MiB, WS_TM = 506 * MiB, WS_S0 = 538 * MiB;
constexpr size_t WS_Y = 602 * MiB;
constexpr int NCH = T / 64;
constexpr int CW_TMO = 0, CW_BAR = 4096, CW_CNT = 8192, CW_ATTQ = 9216;

constexpr int RING_BYTES = 131072, MISC_OFF = RING_BYTES + 320, LDS_BYTES = 147456;

__device__ __forceinline__ unsigned f2bf(float f) { unsigned u = __builtin_bit_cast(unsigned, f); return (u + 0x7fffu + ((u >> 16) & 1u)) >> 16; }
__device__ __forceinline__ unsigned pk2(float lo, float hi) { return f2bf(lo) | (f2bf(hi) << 16); }
__device__ __forceinline__ float bf2f(unsigned short b) { return __builtin_bit_cast(float, (unsigned)b << 16); }
__device__ __forceinline__ float bflo(unsigned w) { return __builtin_bit_cast(float, w << 16); }
__device__ __forceinline__ float bfhi(unsigned w) { return __builtin_bit_cast(float, w & 0xffff0000u); }
__device__ __forceinline__ float wave_sum(float v) {
#pragma unroll
    for (int o = 1; o < 64; o <<= 1) v += __shfl_xor(v, o);
    return v;
}
__device__ __forceinline__ float row16_sum(float v) {
#pragma unroll
    for (int o = 1; o < 16; o <<= 1) v += __shfl_xor(v, o);
    return v;
}
__device__ __forceinline__ float sigmoidf_(float x) { return 1.f / (1.f + __expf(-x)); }
#define LDS_WAIT() asm volatile("s_waitcnt lgkmcnt(0)" ::: "memory")
__device__ __forceinline__ int crow(int r, int hi) { return (r & 3) + 8 * (r >> 2) + 4 * hi; }

namespace pg8 {
constexpr int BM = 256, BK = 64, HALF = 128, HTB = HALF * BK * 2, STAGE_BYTES = 8 * HTB, NXCD = 8, WGM = 8;
__host__ __device__ __forceinline__ int lds_byte(int r, int c) { const int st = (r >> 4) * 2 + (c >> 5), rr = r & 15, cc = c & 31, ob = rr * 64 + cc * 2; return st * 1024 + (ob ^ (((ob >> 9) & 1) << 5)); }
__host__ __device__ __forceinline__ void stage_rc(int b, int& R, int& C) { const int st = b / 1024, sb = b % 1024, swz = sb ^ (((sb >> 9) & 1) << 5); R = (st >> 1) * 16 + swz / 64; C = (st & 1) * 32 + (swz % 64) / 2; }
__host__ __device__ __forceinline__ int perm32(int rho) { const int n = rho >> 4, i = rho & 15; return 8 * (i >> 2) + 4 * n + (i & 3); }

struct Unit { int pm, pn; };
struct Gemm { int lda, ldb, K; };

struct TileOrder {
    int nM, nN, nwg, G, c;
    __device__ __forceinline__ void init(int nM_, int nN_, int G_, int c_) { nM = nM_; nN = nN_; nwg = nM * nN; G = G_; c = c_; }
    __device__ __forceinline__ bool tile(int i, Unit& u) const {
        const long L = (long)i * G + c; if (L >= nwg) return false;
        int wgid = (int)L; { const int q = nwg / NXCD, r = nwg % NXCD, xcd = wgid % NXCD, off = wgid / NXCD; wgid = (xcd < r ? xcd * (q + 1) : r * (q + 1) + (xcd - r) * q) + off; }
        const int nig = WGM * nN, gid = wgid / nig, fm = gid * WGM, gsz = (nM - fm) < WGM ? (nM - fm) : WGM;
        u.pm = fm + ((wgid % nig) % gsz); u.pn = (wgid % nig) / gsz; return true;
    }
};

__device__ __forceinline__ unsigned cvt_pk_bf16(float lo, float hi) { unsigned r; asm volatile("v_cvt_pk_bf16_f32 %0, %1, %2" : "=v"(r) : "v"(lo), "v"(hi)); return r; }

template <class Epi, class Sched, bool ALIGN_EPI>
__device__ __forceinline__ void gemm_phase(LAS unsigned char* lds, const Gemm g, const Sched& S, const Epi& E) {
    const int tid = threadIdx.x, wid = __builtin_amdgcn_readfirstlane(tid >> 6), lane = tid & 63, wr = wid >> 2, wc = wid & 3, fr = lane & 15, fq = lane >> 4;
    const int K = g.K, nt = K / BK;
    unsigned voffA[2], voffB[2];
#pragma unroll
    for (int i = 0; i < 2; ++i) { int R, C; stage_rc(tid * 16 + i * 8192, R, C); const int Rb = Epi::PERM ? ((R & ~31) + perm32(R & 31)) : R;
        voffA[i] = (unsigned)(R * g.lda + C) * 2u; voffB[i] = (unsigned)(Rb * g.ldb + C) * 2u; }
    const size_t kstep = (size_t)(BK * 2);
    const size_t hstepA = (size_t)HALF * g.lda * 2, hstepB = (size_t)HALF * g.ldb * 2;
    const unsigned ldsw = (unsigned)wid * 1024u;
    const int aoff = lds_byte(wr * 64 + fr, fq * 8), boff = lds_byte(wc * 32 + fr, fq * 8);
#define PG8_SA(b, h) (((b) * 2 + (h)) * HTB)
#define PG8_SB(b, h) ((4 + (b) * 2 + (h)) * HTB)
#define PG8_STAGE(bufoff, gbase, voff) do { _Pragma("unroll") for (int _i = 0; _i < 2; ++_i) \
        __builtin_amdgcn_global_load_lds((const unsigned*)((const char*)(gbase) + (voff)[_i]), (LAS unsigned*)(lds + (bufoff) + ldsw + _i * 8192), 16, 0, 0); } while (0)
#define PG8_LDA(dst, b, h) do { _Pragma("unroll") for (int m = 0; m < 4; ++m) _Pragma("unroll") for (int k = 0; k < 2; ++k) dst[m][k] = *(const LAS bf16x8*)(lds + PG8_SA(b, h) + aoff + m * 2048 + k * 1024); } while (0)
#define PG8_LDB(dst, b, h) do { _Pragma("unroll") for (int n = 0; n < 2; ++n) _Pragma("unroll") for (int k = 0; k < 2; ++k) dst[n][k] = *(const LAS bf16x8*)(lds + PG8_SB(b, h) + boff + n * 2048 + k * 1024); } while (0)
#define PG8_MMA(ai, bj, At, Bt) do { __builtin_amdgcn_s_setprio(1); _Pragma("unroll") for (int m = 0; m < 4; ++m) _Pragma("unroll") for (int n = 0; n < 2; ++n) _Pragma("unroll") for (int k = 0; k < 2; ++k) \
        acc[ai][bj][m][n] = __builtin_amdgcn_mfma_f32_16x16x32_bf16(Bt[n][k], At[m][k], acc[ai][bj][m][n], 0, 0, 0); __builtin_amdgcn_s_setprio(0); } while (0)
#define PG8_WAIT_V(n) asm volatile("s_waitcnt vmcnt(" #n ")" ::: "memory")
#define PG8_WAIT_L(n) asm volatile("s_waitcnt lgkmcnt(" #n ")" ::: "memory")
#define PG8_BAR __builtin_amdgcn_s_barrier()
#define PG8_SCHED __builtin_amdgcn_sched_barrier(0)
    Unit cur, nxt; int ui = 0;
    if (!S.next(0, cur)) return;
    f32x4 acc[2][2][4][2];
#pragma unroll
    for (int a = 0; a < 2; ++a)
#pragma unroll
        for (int b = 0; b < 2; ++b)
#pragma unroll
            for (int m = 0; m < 4; ++m)
#pragma unroll
                for (int n = 0; n < 2; ++n) acc[a][b][m][n] = (f32x4){0.f, 0.f, 0.f, 0.f};
    bf16x8 At[4][2], B0[2][2], B1[2][2];
    const char* cA = S.pa(cur); const char* cB = S.pb(cur);
    PG8_STAGE(PG8_SB(0, 0), cB, voffB); PG8_STAGE(PG8_SB(0, 1), cB + hstepB, voffB); PG8_STAGE(PG8_SA(0, 0), cA, voffA); PG8_STAGE(PG8_SA(0, 1), cA + hstepA, voffA);
    if (wr == 1) PG8_BAR;
    PG8_WAIT_V(2); PG8_BAR;
    PG8_STAGE(PG8_SB(1, 0), cB + kstep, voffB); PG8_STAGE(PG8_SA(1, 0), cA + kstep, voffA); PG8_STAGE(PG8_SB(1, 1), cB + hstepB + kstep, voffB);
    PG8_WAIT_V(6); PG8_BAR;
    for (;;) {
        const bool has_next = S.next(ui + 1, nxt);
        const char* nA = has_next ? S.pa(nxt) : cA; const char* nB = has_next ? S.pb(nxt) : cB;
#pragma clang loop unroll(disable)
        for (int t = 0; t < nt; t += 2) {
            const bool last = (t == nt - 2);
            const char* a1 = cA + (size_t)(t + 1) * kstep;
            const char* a2 = last ? nA : cA + (size_t)(t + 2) * kstep; const char* b2 = last ? nB : cB + (size_t)(t + 2) * kstep;
            const char* a3 = a2 + kstep; const char* b3 = b2 + kstep;
            PG8_LDB(B0, 0, 0); PG8_LDB(B1, 0, 1); PG8_SCHED; PG8_LDA(At, 0, 0); PG8_STAGE(PG8_SA(1, 1), a1 + hstepA, voffA);
            PG8_WAIT_V(8); PG8_WAIT_L(0); PG8_BAR; PG8_MMA(0, 0, At, B0); PG8_MMA(0, 1, At, B1); PG8_BAR; PG8_SCHED;
            PG8_LDA(At, 0, 1); PG8_STAGE(PG8_SB(0, 0), b2, voffB); PG8_STAGE(PG8_SB(0, 1), b2 + hstepB, voffB); PG8_STAGE(PG8_SA(0, 0), a2, voffA);
            PG8_WAIT_V(8); PG8_WAIT_L(0); PG8_BAR; PG8_MMA(1, 0, At, B0); PG8_MMA(1, 1, At, B1); PG8_BAR; PG8_SCHED;
            PG8_LDB(B0, 1, 0); PG8_LDB(B1, 1, 1); PG8_SCHED; PG8_LDA(At, 1, 0); PG8_STAGE(PG8_SA(0, 1), a2 + hstepA, voffA);
            PG8_WAIT_V(8); PG8_WAIT_L(0); PG8_BAR; PG8_MMA(0, 0, At, B0); PG8_MMA(0, 1, At, B1); PG8_BAR; PG8_SCHED;
            PG8_LDA(At, 1, 1); PG8_STAGE(PG8_SB(1, 0), b3, voffB); PG8_STAGE(PG8_SB(1, 1), b3 + hstepB, voffB); PG8_STAGE(PG8_SA(1, 0), a3, voffA);
            PG8_WAIT_V(8); PG8_WAIT_L(0); PG8_BAR; PG8_MMA(1, 0, At, B0); PG8_MMA(1, 1, At, B1); PG8_BAR; PG8_SCHED;
        }
        if constexpr (ALIGN_EPI) { if (wr == 0) PG8_BAR; }
        E(acc, cur, wr, wc, fr, fq);
        if (!has_next) break;
#pragma unroll
        for (int a = 0; a < 2; ++a)
#pragma unroll
            for (int b = 0; b < 2; ++b)
#pragma unroll
                for (int m = 0; m < 4; ++m)
#pragma unroll
                    for (int n = 0; n < 2; ++n) acc[a][b][m][n] = (f32x4){0.f, 0.f, 0.f, 0.f};
        cur = nxt; cA = nA; cB = nB; ++ui;
        if constexpr (ALIGN_EPI) { if (wr == 1) PG8_BAR; }
    }
    PG8_WAIT_V(0);
    if constexpr (!ALIGN_EPI) { if (wr == 0) PG8_BAR; }
    PG8_BAR;
#undef PG8_SA
#undef PG8_SB
#undef PG8_STAGE
#undef PG8_LDA
#undef PG8_LDB
#undef PG8_MMA
#undef PG8_WAIT_V
#undef PG8_WAIT_L
#undef PG8_BAR
#undef PG8_SCHED
}

typedef const f32x4 (&AccRef)[2][2][4][2];

struct SchedPlain {
    TileOrder o; const char* A; const char* B; size_t astep, bstep;
    __device__ __forceinline__ bool next(int i, Unit& u) const { return o.tile(i, u); }
    __device__ __forceinline__ const char* pa(const Unit& u) const { return A + (size_t)u.pm * astep; }
    __device__ __forceinline__ const char* pb(const Unit& u) const { return B + (size_t)u.pn * bstep; }
};
struct SchedRKV {
    TileOrder o; const char* A; const char* B; size_t astep, bstep, azstride;
    __device__ __forceinline__ bool next(int i, Unit& u) const { return o.tile(i, u); }
    __device__ __forceinline__ const char* pa(const Unit& u) const { return A + (size_t)(u.pn >> 2) * azstride + (size_t)u.pm * astep; }
    __device__ __forceinline__ const char* pb(const Unit& u) const { return B + (size_t)u.pn * bstep; }
};
struct SchedMoe {
    TileOrder o; const char* A; const char* B; size_t astep, bstep, bestride; const LAS int* ends;
    __device__ __forceinline__ bool next(int i, Unit& u) const { return o.tile(i, u); }
    __device__ __forceinline__ int be(int pm) const { int e = 0;
#pragma unroll
        for (int j = 0; j < NE - 1; ++j) e += (pm >= ends[j]) ? 1 : 0; return e; }
    __device__ __forceinline__ const char* pa(const Unit& u) const { return A + (size_t)u.pm * astep; }
    __device__ __forceinline__ const char* pb(const Unit& u) const { return B + (size_t)be(u.pm) * bestride + (size_t)u.pn * bstep; }
};

struct EpiRKV {
    static constexpr bool PERM = false;
    float* C; size_t zstride;
    __device__ __forceinline__ void operator()(AccRef acc, const Unit& u, int wr, int wc, int fr, int fq) const {
        const int z = u.pn >> 2, pn = u.pn & 3; float* base = C + (size_t)z * zstride;
        const int row0 = u.pm * BM + wr * 64 + fr, col0 = pn * BM + wc * 32 + 4 * fq;
#pragma unroll
        for (int ai = 0; ai < 2; ++ai)
#pragma unroll
            for (int m = 0; m < 4; ++m) { float* rowp = base + (size_t)(row0 + ai * HALF + m * 16) * D + col0;
#pragma unroll
                for (int bj = 0; bj < 2; ++bj)
#pragma unroll
                    for (int n = 0; n < 2; ++n) *(f32x4*)(rowp + bj * HALF + n * 16) = acc[ai][bj][m][n]; }
    }
};
struct EpiRes {
    static constexpr bool PERM = false;
    const float* base; float* out;
    __device__ __forceinline__ void operator()(AccRef acc, const Unit& u, int wr, int wc, int fr, int fq) const {
        const int row0 = u.pm * BM + wr * 64 + fr, col0 = u.pn * BM + wc * 32 + 4 * fq;
#pragma unroll
        for (int ai = 0; ai < 2; ++ai)
#pragma unroll
            for (int m = 0; m < 4; ++m) { const size_t off = (size_t)(row0 + ai * HALF + m * 16) * D + col0;
#pragma unroll
                for (int bj = 0; bj < 2; ++bj)
#pragma unroll
                    for (int n = 0; n < 2; ++n) { const f32x4 b = *(const f32x4*)(base + off + bj * HALF + n * 16); *(f32x4*)(out + off + bj * HALF + n * 16) = b + acc[ai][bj][m][n]; } }
    }
};
struct EpiL1 {
    static constexpr bool PERM = true;
    bf16* O;
    __device__ __forceinline__ void operator()(AccRef acc, const Unit& u, int wr, int wc, int fr, int fq) const {
        const int row0 = u.pm * BM + wr * 64 + fr, col0 = wc * 32 + 8 * fq;
#pragma unroll
        for (int ai = 0; ai < 2; ++ai)
#pragma unroll
            for (int m = 0; m < 4; ++m) { bf16* rowp = O + (size_t)(row0 + ai * HALF + m * 16) * 256 + col0;
#pragma unroll
                for (int bj = 0; bj < 2; ++bj) { float v[8];
#pragma unroll
                    for (int i = 0; i < 4; ++i) { v[i] = acc[ai][bj][m][0][i]; v[4 + i] = acc[ai][bj][m][1][i]; }
#pragma unroll
                    for (int i = 0; i < 8; ++i) { if (bj == 1) v[i] = sigmoidf_(v[i]); else if (wc < 2) v[i] = tanhf(v[i]); }
                    u32x4 w; w.x = cvt_pk_bf16(v[0], v[1]); w.y = cvt_pk_bf16(v[2], v[3]); w.z = cvt_pk_bf16(v[4], v[5]); w.w = cvt_pk_bf16(v[6], v[7]);
                    *(u32x4*)(rowp + bj * HALF) = w; } }
    }
};
struct EpiL2 {
    static constexpr bool PERM = false;
    float* LW; const float* w0; const float* a0;
    __device__ __forceinline__ void operator()(AccRef acc, const Unit& u, int wr, int wc, int fr, int fq) const {
        const int z = u.pn >> 2, pn = u.pn & 3; float* base = LW + (size_t)z * ((WS_AA - WS_LW) / 4); const float* bias = z == 0 ? w0 : a0;
        const float mul = z == 0 ? -0.6065306597126334f : 1.f;
        const int row0 = u.pm * BM + wr * 64 + fr, col0 = pn * BM + wc * 32 + 4 * fq;
#pragma unroll
        for (int bj = 0; bj < 2; ++bj)
#pragma unroll
            for (int n = 0; n < 2; ++n) { const int c = col0 + bj * HALF + n * 16;
                const f32x4 bv = *(const f32x4*)(bias + c);
#pragma unroll
                for (int ai = 0; ai < 2; ++ai)
#pragma unroll
                    for (int m = 0; m < 4; ++m) { f32x4 v = acc[ai][bj][m][n];
                        if (z < 2) { v = v + bv;
#pragma unroll
                            for (int i = 0; i < 4; ++i) v[i] = mul * __builtin_amdgcn_rcpf(1.f + __expf(-v[i])); }
                        *(f32x4*)(base + (size_t)(row0 + ai * HALF + m * 16) * D + c) = v; } }
    }
};
struct EpiSwiGLU {
    static constexpr bool PERM = true;
    bf16* O;
    __device__ __forceinline__ void operator()(AccRef acc, const Unit& u, int wr, int wc, int fr, int fq) const {
        const int row0 = u.pm * BM + wr * 64 + fr, col0 = u.pn * HALF + wc * 32 + 8 * fq;
#pragma unroll
        for (int ai = 0; ai < 2; ++ai)
#pragma unroll
            for (int m = 0; m < 4; ++m) { float v[8];
#pragma unroll
                for (int n = 0; n < 2; ++n)
#pragma unroll
                    for (int i = 0; i < 4; ++i) { const float gt = acc[ai][0][m][n][i], up = acc[ai][1][m][n][i]; v[4 * n + i] = gt * sigmoidf_(gt) * up; }
                u32x4 w; w.x = cvt_pk_bf16(v[0], v[1]); w.y = cvt_pk_bf16(v[2], v[3]); w.z = cvt_pk_bf16(v[4], v[5]); w.w = cvt_pk_bf16(v[6], v[7]);
                *(u32x4*)(O + (size_t)(row0 + ai * HALF + m * 16) * FF + col0) = w; }
    }
};
struct EpiBf16 {
    static constexpr bool PERM = true;
    bf16* O; int ldc;
    __device__ __forceinline__ void operator()(AccRef acc, const Unit& u, int wr, int wc, int fr, int fq) const {
        const int row0 = u.pm * BM + wr * 64 + fr, col0 = u.pn * BM + wc * 32 + 8 * fq;
#pragma unroll
        for (int ai = 0; ai < 2; ++ai)
#pragma unroll
            for (int m = 0; m < 4; ++m) { bf16* rowp = O + (size_t)(row0 + ai * HALF + m * 16) * ldc + col0;
#pragma unroll
                for (int bj = 0; bj < 2; ++bj) { const f32x4 v0 = acc[ai][bj][m][0], v1 = acc[ai][bj][m][1];
                    u32x4 w; w.x = cvt_pk_bf16(v0[0], v0[1]); w.y = cvt_pk_bf16(v0[2], v0[3]); w.z = cvt_pk_bf16(v1[0], v1[1]); w.w = cvt_pk_bf16(v1[2], v1[3]);
                    *(u32x4*)(rowp + bj * HALF) = w; } }
    }
};
}

#define XB_TMO      128
#define XB_XCNT(j)  (256  + 64 * (j))
#define XB_XSUB(j)  (1280 + 64 * (j))
#define XB_XGEN(j)  (2304 + 64 * (j))
#define XB_TOP      3328
#define XB_TOPGEN   3392
#define XCD_BAR_WORDS 3456
#define XB_SPIN_CAP (1u << 18)
__device__ __forceinline__ unsigned xb_ld(unsigned* p)              { return __hip_atomic_load(p, __ATOMIC_RELAXED, __HIP_MEMORY_SCOPE_AGENT); }
__device__ __forceinline__ unsigned xb_add(unsigned* p, unsigned v) { return __hip_atomic_fetch_add(p, v, __ATOMIC_RELAXED, __HIP_MEMORY_SCOPE_AGENT); }
__device__ __forceinline__ unsigned xb_xcc_id() { return (unsigned)__builtin_amdgcn_s_getreg((3 << 11) | 20) & 0xFu; }
#define XB_SPIN(cond, bar) do { unsigned _sp = 0; while (cond) { __builtin_amdgcn_s_sleep(1); \
    if ((++_sp & 255u) == 0u) { if (xb_ld(&(bar)[XB_TMO])) break; if (_sp > XB_SPIN_CAP) { atomicAdd(&(bar)[XB_TMO], 1u); break; } } } } while (0)
struct XcdBarrier { unsigned* bar; unsigned x; volatile LAS unsigned* st; };
__device__ __forceinline__ XcdBarrier xcd_barrier_post(unsigned* bar, volatile LAS unsigned* st) {
    XcdBarrier b; b.bar = bar; b.x = xb_xcc_id(); b.st = st;
    if (threadIdx.x == 0) (void)xb_add(&bar[XB_XCNT(b.x)], 1u);
    return b;
}
__device__ __forceinline__ void xcd_barrier_complete(unsigned* bar, unsigned x, unsigned& nloc, unsigned& nx) {
    const unsigned G = gridDim.x * gridDim.y * gridDim.z;
    unsigned sum, cnt, mine, sp = 0u;
    for (;;) {
        sum = 0u; cnt = 0u; mine = 0u;
#pragma unroll
        for (unsigned j = 0; j < 16; ++j) { const unsigned c = xb_ld(&bar[XB_XCNT(j)]); sum += c; cnt += (c > 0u) ? 1u : 0u; mine = (j == x) ? c : mine; }
        if (sum == G) break;
        __builtin_amdgcn_s_sleep(1);
        if ((++sp & 255u) == 0u) { if (xb_ld(&bar[XB_TMO])) break; if (sp > XB_SPIN_CAP) { atomicAdd(&bar[XB_TMO], 1u); break; } }
    }
    nloc = mine > 0u ? mine : 1u; nx = cnt > 0u ? cnt : 1u;
}
__device__ __forceinline__ void xcd_barrier(const XcdBarrier& b) {
    asm volatile("s_waitcnt vmcnt(0)" ::: "memory");
    __syncthreads();
    if (threadIdx.x == 0) {
        unsigned* bar = b.bar;
        __builtin_amdgcn_s_waitcnt(0);
        unsigned nloc = b.st[0], nx = b.st[1];
        if (nloc == 0u) { xcd_barrier_complete(bar, b.x, nloc, nx); b.st[0] = nloc; b.st[1] = nx; }
        const unsigned old = xb_add(&bar[XB_XSUB(b.x)], 1u);
        const unsigned gen = old / nloc;
        if (old + 1u == (gen + 1u) * nloc) {
            __builtin_amdgcn_fence(__ATOMIC_RELEASE, "agent");
            asm volatile("s_waitcnt vmcnt(0)" ::: "memory");
            const unsigned og = xb_add(&bar[XB_TOP], 1u);
            const unsigned tg = og / nx;
            if (og + 1u == (tg + 1u) * nx) xb_add(&bar[XB_TOPGEN], 1u);
            else XB_SPIN(xb_ld(&bar[XB_TOPGEN]) == tg, bar);
            __builtin_amdgcn_fence(__ATOMIC_ACQUIRE, "agent");
            xb_add(&bar[XB_XGEN(b.x)], 1u);
            asm volatile("s_waitcnt vmcnt(0)" ::: "memory");
        } else {
            XB_SPIN(xb_ld(&bar[XB_XGEN(b.x)]) == gen, bar);
            __builtin_amdgcn_fence(__ATOMIC_ACQUIRE, "agent");
            asm volatile("s_waitcnt vmcnt(0)" ::: "memory");
        }
    }
    __syncthreads();
}

struct Args { const float* in[29]; float* out; unsigned char* ws; int ph_lo, ph_hi; };
struct Frame {
    LAS unsigned char* lds; gu32* ctl; unsigned char* ws;
    int tid, lane, wave, vcu, G, gw, NGW;
};

struct Row { f32x4 v[4]; };
__device__ __forceinline__ Row ld_row(const float* p, int lane) { Row r; const f32x4* q = (const f32x4*)p + lane;
#pragma unroll
    for (int j = 0; j < 4; ++j) r.v[j] = q[64 * j]; return r; }
__device__ __forceinline__ void st_row(float* p, int lane, const Row& r) { f32x4* q = (f32x4*)p + lane;
#pragma unroll
    for (int j = 0; j < 4; ++j) q[64 * j] = r.v[j]; }
__device__ __forceinline__ void st_row_bf16(bf16* p, int lane, const Row& r) { u32x2* q = (u32x2*)p + lane;
#pragma unroll
    for (int j = 0; j < 4; ++j) { u32x2 w; w.x = pk2(r.v[j][0], r.v[j][1]); w.y = pk2(r.v[j][2], r.v[j][3]); q[64 * j] = w; } }
__device__ __forceinline__ Row ld_row_bf16(const bf16* p, int lane) { Row r; const u32x2* q = (const u32x2*)p + lane;
#pragma unroll
    for (int j = 0; j < 4; ++j) { const u32x2 w = q[64 * j]; r.v[j] = (f32x4){bflo(w.x), bfhi(w.x), bflo(w.y), bfhi(w.y)}; } return r; }
__device__ __forceinline__ float row_sumsq(const Row& r) { float s = 0.f;
#pragma unroll
    for (int j = 0; j < 4; ++j) s += (r.v[j][0] * r.v[j][0] + r.v[j][1] * r.v[j][1]) + (r.v[j][2] * r.v[j][2] + r.v[j][3] * r.v[j][3]); return wave_sum(s); }
__device__ __forceinline__ Row rmsnorm_row(const Row& x, const Row& g) { const float rs = rsqrtf(row_sumsq(x) * (1.f / D) + RMS_EPS); Row y;
#pragma unroll
    for (int j = 0; j < 4; ++j) y.v[j] = x.v[j] * rs * g.v[j]; return y; }

__device__ __forceinline__ void tr_item(const float* W, int ldw, int k0, int n0, bf16* WT, int ldt, int drow0, int dcol0, const float* sc, int scmode, LAS float* scr, int lane) {
#pragma unroll 8
    for (int i = 0; i < 32; ++i) { const int kk = 2 * i + (lane >> 5); float v = W[(size_t)(k0 + kk) * ldw + n0 + (lane & 31)];
        if (scmode == 1) v *= sc[k0 + kk]; else if (scmode == 2) v *= (1.f - sc[k0 + kk]);
        scr[kk * 33 + (lane & 31)] = v; }
    LDS_WAIT(); asm volatile("" ::: "memory");
    const int c = lane & 7;
#pragma unroll
    for (int j = 0; j < 4; ++j) { const int n = (lane >> 3) + 8 * j; const LAS float* s = scr + (8 * c) * 33 + n;
        u32x4 o; o.x = pk2(s[0 * 33], s[1 * 33]); o.y = pk2(s[2 * 33], s[3 * 33]); o.z = pk2(s[4 * 33], s[5 * 33]); o.w = pk2(s[6 * 33], s[7 * 33]);
        *(GAS u32x4*)(WT + (size_t)(drow0 + n0 + n) * ldt + dcol0 + k0 + 8 * c) = o; }
    LDS_WAIT(); asm volatile("" ::: "memory");
}
__device__ __forceinline__ int gu_row(int n) { return n < FF ? 256 * (n >> 7) + (n & 127) : 256 * ((n - FF) >> 7) + 128 + ((n - FF) & 127); }

__device__ __forceinline__ void p0_prologue(Frame& F, const Args& a) {
    LAS float* scr = (LAS float*)(F.lds + F.wave * 16384);
    unsigned char* ws = F.ws;
    constexpr int I_SQ = 16 * 32;
    constexpr int I_RKV = 3 * I_SQ, I_L1 = 2 * 16 * 8, I_L2 = 4 * 32, I_GU = 16 * 224, I_DN = 56 * 32, I_IN = 16 * 128;
    constexpr int NITEMS = I_RKV + I_L1 + I_L2 + I_SQ + I_GU + I_DN + I_IN + I_SQ + NE * I_GU + NE * I_DN;
    for (int it = F.gw; it < NITEMS; it += F.NGW) {
        int r = it;
        if (r < I_RKV) { const int z = r / I_SQ, q = r % I_SQ; tr_item(a.in[4] + (size_t)z * D * D, D, 64 * (q / 32), 32 * (q % 32), (bf16*)(ws + WS_W_RKV) + (size_t)z * D * D, D, 0, 0, nullptr, 0, scr, F.lane); continue; } r -= I_RKV;
        if (r < I_L1) {
            const int half = r / 128, q = r % 128, kb = q / 8, nb = q % 8, n0 = 32 * nb;
            const float* W; int ldw, nn0, mi;
            if (n0 < 64) { W = a.in[6]; ldw = 64; nn0 = n0; mi = 3; } else if (n0 < 128) { W = a.in[9]; ldw = 64; nn0 = n0 - 64; mi = 4; } else { W = a.in[11]; ldw = 128; nn0 = n0 - 128; mi = 5; }
            tr_item(W, ldw, 64 * kb, nn0, (bf16*)(ws + WS_W_L1), 2 * D, n0 - nn0, half * D, a.in[3] + mi * D, half == 0 ? 1 : 2, scr, F.lane); continue; } r -= I_L1;
        if (r < I_L2) {
            const int part = r / 32, nb = r % 32;
            if (part == 0) tr_item(a.in[7], D, 0, 32 * nb, (bf16*)(ws + WS_W_L2), 256, 0, 0, nullptr, 0, scr, F.lane);
            else if (part == 1) tr_item(a.in[10], D, 0, 32 * nb, (bf16*)(ws + WS_W_L2), 256, D, 64, nullptr, 0, scr, F.lane);
            else tr_item(a.in[12], D, 64 * (part - 2), 32 * nb, (bf16*)(ws + WS_W_L2), 256, 2 * D, 128, nullptr, 0, scr, F.lane);
            continue; } r -= I_L2;
        if (r < I_SQ) { tr_item(a.in[18], D, 64 * (r / 32), 32 * (r % 32), (bf16*)(ws + WS_W_O0), D, 0, 0, nullptr, 0, scr, F.lane); continue; } r -= I_SQ;
        if (r < I_GU) { const int kb = r / 224, nb = r % 224; tr_item(a.in[24], 2 * FF, 64 * kb, 32 * nb, (bf16*)(ws + WS_W_GU), D, gu_row(32 * nb) - 32 * nb, 0, nullptr, 0, scr, F.lane); continue; } r -= I_GU;
        if (r < I_DN) { tr_item(a.in[25], D, 64 * (r / 32), 32 * (r % 32), (bf16*)(ws + WS_W_DN), FF, 0, 0, nullptr, 0, scr, F.lane); continue; } r -= I_DN;
        if (r < I_IN) { tr_item(a.in[19], WIN_LD, 64 * (r / 128), 32 * (r % 128), (bf16*)(ws + WS_W_IN), D, 0, 0, nullptr, 0, scr, F.lane); continue; } r -= I_IN;
        if (r < I_SQ) { tr_item(a.in[23], D, 64 * (r / 32), 32 * (r % 32), (bf16*)(ws + WS_W_FO), D, 0, 0, nullptr, 0, scr, F.lane); continue; } r -= I_SQ;
        if (r < NE * I_GU) { const int e = r / I_GU, q = r % I_GU, kb = q / 224, nb = q % 224;
            tr_item(a.in[27] + (size_t)e * D * 2 * FF, 2 * FF, 64 * kb, 32 * nb, (bf16*)(ws + WS_W_MGU) + (size_t)e * 2 * FF * D, D, gu_row(32 * nb) - 32 * nb, 0, nullptr, 0, scr, F.lane); continue; } r -= NE * I_GU;
        { const int e = r / I_DN, q = r % I_DN; tr_item(a.in[28] + (size_t)e * FF * D, D, 64 * (q / 32), 32 * (q % 32), (bf16*)(ws + WS_W_MDN) + (size_t)e * D * FF, FF, 0, 0, nullptr, 0, scr, F.lane); }
    }
    for (int i = F.gw * 64 + F.lane; i < 3 * D * 32; i += F.NGW * 64) { const int row = i >> 5, ch = i & 31, part = row / D, k = ch * 8;
        const bool nz = part == 0 ? (k < 64) : (part == 1 ? (k >= 64 && k < 128) : (k >= 128));
        if (!nz) *(GAS u32x4*)((bf16*)(ws + WS_W_L2) + (size_t)row * 256 + k) = (u32x4){0u, 0u, 0u, 0u}; }
}

__device__ __forceinline__ void p1_shift(Frame& F, const Args& a) {
    const int lane = F.lane; const float* x = a.in[0];
    bf16* UB = (bf16*)(F.ws + WS_UB); bf16* XS = (bf16*)(F.ws + WS_XS);
    const Row g0 = ld_row(a.in[1], lane);
    const int RPW = T / (256 * NWAVES);
    for (int t0 = F.gw * RPW; t0 < T; t0 += F.NGW * RPW) {
        Row prev;
        if (t0 > 0) prev = rmsnorm_row(ld_row(x + (size_t)(t0 - 1) * D, lane), g0);
        else { for (int j = 0; j < 4; ++j) prev.v[j] = (f32x4){0.f, 0.f, 0.f, 0.f}; st_row_bf16(UB, lane, prev); }
        for (int t = t0; t < t0 + RPW; ++t) {
            const Row u = rmsnorm_row(ld_row(x + (size_t)t * D, lane), g0);
            st_row_bf16(UB + (size_t)(t + 1) * D, lane, u);
#pragma unroll
            for (int n = 0; n < 3; ++n) { const Row mu = ld_row(a.in[3] + n * D, lane); Row o;
#pragma unroll
                for (int j = 0; j < 4; ++j) o.v[j] = u.v[j] + (prev.v[j] - u.v[j]) * mu.v[j];
                st_row_bf16(XS + (size_t)n * T * D + (size_t)t * D, lane, o); }
            prev = u;
        }
    }
}

__device__ __forceinline__ void p4_derive(Frame& F, const Args& a) {
    const int lane = F.lane;
    float* R = (float*)(F.ws + WS_R); float* K = (float*)(F.ws + WS_K); float* LW = (float*)(F.ws + WS_LW); float* AA = (float*)(F.ws + WS_AA);
    float* KK = (float*)(F.ws + WS_KK); float* BB = (float*)(F.ws + WS_BB); float* CS = (float*)(F.ws + WS_CS);
    const Row k_k = ld_row(a.in[13], lane), k_a = ld_row(a.in[14], lane), r_k = ld_row(a.in[15], lane);
    for (int t = F.gw; t < T; t += F.NGW) {
        const size_t o = (size_t)t * D;
        Row r = ld_row(R + o, lane), k = ld_row(K + o, lane), lw = ld_row(LW + o, lane), aa = ld_row(AA + o, lane), kk, bb, km, dec;
        float c1[4], c2[4], c3[4];
#pragma unroll
        for (int j = 0; j < 4; ++j) {
            kk.v[j] = k.v[j] * k_k.v[j];
            float ss = (kk.v[j][0] * kk.v[j][0] + kk.v[j][1] * kk.v[j][1]) + (kk.v[j][2] * kk.v[j][2] + kk.v[j][3] * kk.v[j][3]);
            ss = row16_sum(ss);
            const float inv = 1.f / fmaxf(sqrtf(ss), 1e-12f);
            kk.v[j] = kk.v[j] * inv;
            bb.v[j] = kk.v[j] * aa.v[j];
            km.v[j] = k.v[j] * (1.f + (aa.v[j] - 1.f) * k_a.v[j]);
#pragma unroll
            for (int i = 0; i < 4; ++i) dec.v[j][i] = __expf(lw.v[j][i]);
            float s1 = 0.f, s2 = 0.f, s3 = 0.f;
#pragma unroll
            for (int i = 0; i < 4; ++i) { s1 += bb.v[j][i] * r.v[j][i]; const float kr = km.v[j][i] * r.v[j][i]; s2 += kr; s3 += kr * r_k.v[j][i]; }
            c1[j] = row16_sum(s1); c2[j] = row16_sum(s2); c3[j] = row16_sum(s3);
            r.v[j] = r.v[j] * dec.v[j];
        }
        st_row(R + o, lane, r); st_row(K + o, lane, km); st_row(LW + o, lane, dec); st_row(KK + o, lane, kk); st_row(BB + o, lane, bb);
        if ((lane & 15) == 0) {
#pragma unroll
            for (int j = 0; j < 4; ++j) { const int h = 4 * j + (lane >> 4); CS[(size_t)t * 16 + h] = c1[j]; CS[(size_t)T * 16 + (size_t)t * 16 + h] = c2[j]; CS[(size_t)2 * T * 16 + (size_t)t * 16 + h] = c3[j]; }
        }
    }
}

__device__ __forceinline__ float dpp_row_allsum(float x) {
    int v = __builtin_bit_cast(int, x);
    x += __builtin_bit_cast(float, __builtin_amdgcn_update_dpp(0, v, 0xB1, 0xF, 0xF, true)); v = __builtin_bit_cast(int, x);
    x += __builtin_bit_cast(float, __builtin_amdgcn_update_dpp(0, v, 0x4E, 0xF, 0xF, true)); v = __builtin_bit_cast(int, x);
    x += __builtin_bit_cast(float, __builtin_amdgcn_update_dpp(0, v, 0x141, 0xF, 0xF, true)); v = __builtin_bit_cast(int, x);
    x += __builtin_bit_cast(float, __builtin_amdgcn_update_dpp(0, v, 0x140, 0xF, 0xF, true));
    return x;
}
__device__ __forceinline__ float wave_allsum_fast(float x) {
    x = dpp_row_allsum(x);
    const int v = __builtin_bit_cast(int, x);
    const float a = __builtin_bit_cast(float, __builtin_amdgcn_readlane(v, 0)), b = __builtin_bit_cast(float, __builtin_amdgcn_readlane(v, 16)),
                c = __builtin_bit_cast(float, __builtin_amdgcn_readlane(v, 32)), d = __builtin_bit_cast(float, __builtin_amdgcn_readlane(v, 48));
    return (a + b) + (c + d);
}
__device__ __forceinline__ void p5_scan(Frame& F) {
    if (F.wave >= 4) return;
    const int lane = F.lane;
    const float* KK = (const float*)(F.ws + WS_KK); const float* RW = (const float*)(F.ws + WS_R); const float* DEC = (const float*)(F.ws + WS_LW);
    const float* BB = (const float*)(F.ws + WS_BB); const float* KM = (const float*)(F.ws + WS_K); const float* V = (const float*)(F.ws + WS_V);
    const float* CS = (const float*)(F.ws + WS_CS); float* YT = (float*)(F.ws + WS_YT);
    for (int rho = F.vcu * 4 + F.wave; rho < D; rho += F.G * 4) {
        const int h = rho >> 6;
        const size_t col = (size_t)h * 64 + lane;
        float s = 0.f, ybuf = 0.f;
        constexpr int U = 8;
        float ik[2][U], ir[2][U], iw[2][U], ib[2][U], im[2][U], iv[2][U], i1[2][U], i2[2][U];
#define SCAN_LOAD(buf, tb) do { _Pragma("unroll") for (int u_ = 0; u_ < U; ++u_) { const size_t o_ = (size_t)((tb) + u_) * D; \
            ik[buf][u_] = KK[o_ + col]; ir[buf][u_] = RW[o_ + col]; iw[buf][u_] = DEC[o_ + col]; ib[buf][u_] = BB[o_ + col]; im[buf][u_] = KM[o_ + col]; \
            iv[buf][u_] = V[o_ + rho]; i1[buf][u_] = CS[(size_t)((tb) + u_) * 16 + h]; i2[buf][u_] = CS[(size_t)T * 16 + (size_t)((tb) + u_) * 16 + h]; } } while (0)
#define SCAN_STEPS(buf, tb) do { _Pragma("unroll") for (int u_ = 0; u_ < U; ++u_) { \
            const float p1 = wave_allsum_fast(s * ik[buf][u_]); const float p2 = wave_allsum_fast(s * ir[buf][u_]); \
            const float sa = -p1; const float y = p2 + sa * i1[buf][u_] + iv[buf][u_] * i2[buf][u_]; \
            s = s * iw[buf][u_] + sa * ib[buf][u_] + iv[buf][u_] * im[buf][u_]; \
            if (lane == (((tb) + u_) & 63)) ybuf = y; } } while (0)
        SCAN_LOAD(0, 0);
        for (int t0 = 0; t0 < T; t0 += 2 * U) {
            SCAN_LOAD(1, t0 + U);
            SCAN_STEPS(0, t0);
            if (t0 + 2 * U < T) SCAN_LOAD(0, t0 + 2 * U);
            SCAN_STEPS(1, t0 + U);
            if (((t0 + 2 * U) & 63) == 0) YT[(size_t)rho * T + (t0 + 2 * U - 64) + lane] = ybuf;
        }
#undef SCAN_LOAD
#undef SCAN_STEPS
    }
}

typedef __bf16 bf16x2_t __attribute__((ext_vector_type(2)));
__device__ __forceinline__ unsigned cvtpk(float lo, float hi) { f32x2 v = {lo, hi}; bf16x2_t b = __builtin_convertvector(v, bf16x2_t); return __builtin_bit_cast(unsigned, b); }
struct Pk { bf16x8 k0, k1; };
__device__ __forceinline__ Pk pack_tile(const f32x16& t) {
    const u32x4 a = {cvtpk(t[0], t[1]), cvtpk(t[2], t[3]), cvtpk(t[4], t[5]), cvtpk(t[6], t[7])}, b = {cvtpk(t[8], t[9]), cvtpk(t[10], t[11]), cvtpk(t[12], t[13]), cvtpk(t[14], t[15])};
    Pk p; p.k0 = __builtin_bit_cast(bf16x8, a); p.k1 = __builtin_bit_cast(bf16x8, b); return p; }
#define MFMA32(a, b, c) __builtin_amdgcn_mfma_f32_32x32x16_bf16((a), (b), (c), 0, 0, 0)
__device__ __forceinline__ f32x16 xt(const Pk& X, const Pk& Z, f32x16 acc) { acc = MFMA32(X.k0, Z.k0, acc); acc = MFMA32(X.k1, Z.k1, acc); return acc; }
__device__ __forceinline__ bf16x8 nfrag(const bf16* m, int rt, int ks, int lane) { return *(const bf16x8*)(m + (size_t)(32 * rt + (lane & 31)) * D + 16 * ks + 8 * (lane >> 5)); }
__device__ __forceinline__ f32x16 nat(const bf16* am, int a, const bf16* bm, int b, int lane, f32x16 acc) {
#pragma unroll
    for (int ks = 0; ks < 4; ++ks) acc = MFMA32(nfrag(am, a, ks, lane), nfrag(bm, b, ks, lane), acc);
    return acc; }
__device__ __forceinline__ f32x16 dl_copy(const bf16* am, int a, int ct, int lane) {
    f32x16 acc = {};
#pragma unroll
    for (int kk2 = 0; kk2 < 2; ++kk2) { const int ks = 2 * ct + kk2; bf16x8 id;
#pragma unroll
        for (int e = 0; e < 8; ++e) id[e] = (32 * ct + (lane & 31) == 16 * ks + 8 * (lane >> 5) + e) ? (short)0x3F80 : (short)0;
        acc = MFMA32(nfrag(am, a, ks, lane), id, acc); }
    return acc; }
__device__ __forceinline__ void mask_lt(f32x16& t, int lane) {
#pragma unroll
    for (int r = 0; r < 16; ++r) if (!(crow(r, lane >> 5) < (lane & 31))) t[r] = 0.f; }
__device__ __forceinline__ void mask_gt(f32x16& t, int lane) {
#pragma unroll
    for (int r = 0; r < 16; ++r) if (!(crow(r, lane >> 5) > (lane & 31))) t[r] = 0.f; }
__device__ __forceinline__ void mask_le(f32x16& t, int lane) {
#pragma unroll
    for (int r = 0; r < 16; ++r) if (!(crow(r, lane >> 5) <= (lane & 31))) t[r] = 0.f; }
__device__ __forceinline__ void add_eye(f32x16& t, int lane) {
#pragma unroll
    for (int r = 0; r < 16; ++r) if (crow(r, lane >> 5) == (lane & 31)) t[r] += 1.f; }

__device__ __forceinline__ void p3_prep(Frame& F, const Args& a) {
    const int lane = F.lane;
    const float* R = (const float*)(F.ws + WS_R); const float* K = (const float*)(F.ws + WS_K); const float* V = (const float*)(F.ws + WS_V);
    const float* LW = (const float*)(F.ws + WS_LW); const float* AA = (const float*)(F.ws + WS_AA);
    bf16* AT = (bf16*)(F.ws + WS_AT); bf16* RT = (bf16*)(F.ws + WS_RT); bf16* BH = (bf16*)(F.ws + WS_BH); bf16* KH = (bf16*)(F.ws + WS_KH); bf16* V16 = (bf16*)(F.ws + WS_V16);
    float* GC = (float*)(F.ws + WS_GC); float* C3 = (float*)(F.ws + WS_CS) + (size_t)2 * T * 16;
    for (int task = F.gw; task < NCH * 4; task += F.NGW) {
        const int c = task >> 2, hg = task & 3, col = hg * 256 + 4 * lane;
        const f32x4 k_k = *(const f32x4*)(a.in[13] + col), k_a = *(const f32x4*)(a.in[14] + col), r_k = *(const f32x4*)(a.in[15] + col);
        f32x4 lg = {0.f, 0.f, 0.f, 0.f};
        constexpr int PF = 8;
        for (int tb = 0; tb < 64; tb += PF) {
            f32x4 rr[PF], kx[PF], vx[PF], lx[PF], ax[PF];
#pragma unroll
            for (int u = 0; u < PF; ++u) { const size_t o = (size_t)(64 * c + tb + u) * D + col;
                rr[u] = *(const f32x4*)(R + o); kx[u] = *(const f32x4*)(K + o); vx[u] = *(const f32x4*)(V + o); lx[u] = *(const f32x4*)(LW + o); ax[u] = *(const f32x4*)(AA + o); }
#pragma unroll
            for (int u = 0; u < PF; ++u) { const int tt = tb + u;
                const size_t o = (size_t)(64 * c + tt) * D + col;
                const f32x4 r = rr[u], k = kx[u], v = vx[u], lw = lx[u], aa = ax[u];
                f32x4 kk = k * k_k;
                float ss = (kk[0] * kk[0] + kk[1] * kk[1]) + (kk[2] * kk[2] + kk[3] * kk[3]); ss = row16_sum(ss);
                kk = kk * (1.f / fmaxf(sqrtf(ss), 1e-12f));
                const f32x4 b = kk * aa, km = k * (1.f + (aa - 1.f) * k_a);
                float s3 = (r[0] * km[0] * r_k[0] + r[1] * km[1] * r_k[1]) + (r[2] * km[2] * r_k[2] + r[3] * km[3] * r_k[3]); s3 = row16_sum(s3);
                if ((lane & 15) == 0) C3[(size_t)(64 * c + tt) * 16 + hg * 4 + (lane >> 4)] = s3;
                const f32x4 lgm1 = lg; lg = lg + lw;
                f32x4 at, rt, bh, kh;
#pragma unroll
                for (int i = 0; i < 4; ++i) { const float em = __expf(lgm1[i]), ep = __expf(lg[i]), en = __expf(-lg[i]); at[i] = -kk[i] * em; rt[i] = r[i] * ep; bh[i] = b[i] * en; kh[i] = km[i] * en; }
                *(u32x2*)(AT + o) = (u32x2){pk2(at[0], at[1]), pk2(at[2], at[3])}; *(u32x2*)(RT + o) = (u32x2){pk2(rt[0], rt[1]), pk2(rt[2], rt[3])};
                *(u32x2*)(BH + o) = (u32x2){pk2(bh[0], bh[1]), pk2(bh[2], bh[3])}; *(u32x2*)(KH + o) = (u32x2){pk2(kh[0], kh[1]), pk2(kh[2], kh[3])};
                *(u32x2*)(V16 + o) = (u32x2){pk2(v[0], v[1]), pk2(v[2], v[3])};
            }
        }
        f32x4 g; for (int i = 0; i < 4; ++i) g[i] = __expf(lg[i]);
        *(f32x4*)(GC + (size_t)c * D + col) = g;
    }
}

__device__ __forceinline__ void inv32(f32x16 N, f32x16 NT, f32x16& Tm, f32x16& TT, int lane) {
    Tm = N; TT = NT; add_eye(Tm, lane); add_eye(TT, lane);
    Pk Np = pack_tile(N), NTp = pack_tile(NT);
#pragma unroll
    for (int it = 0; it < 4; ++it) {
        const f32x16 z = {};
        const f32x16 N2 = xt(NTp, Np, z), N2T = xt(Np, NTp, z);
        const Pk N2p = pack_tile(N2), N2Tp = pack_tile(N2T), TTp = pack_tile(TT);
        Tm = xt(TTp, N2p, Tm);
        TT = xt(N2p, TTp, TT);
        Np = N2p; NTp = N2Tp;
    }
}

__device__ __forceinline__ void pa_chunk(Frame& F) {
    const int lane = F.lane, c32 = lane & 31, hh = lane >> 5;
    const bf16* AT = (const bf16*)(F.ws + WS_AT); const bf16* BH = (const bf16*)(F.ws + WS_BH); const bf16* KH = (const bf16*)(F.ws + WS_KH); const bf16* V16 = (const bf16*)(F.ws + WS_V16);
    const float* GC = (const float*)(F.ws + WS_GC);
    for (int task = F.gw; task < NCH * NH; task += F.NGW) {
        const int c = task >> 4, h = task & 15; const size_t o = (size_t)(64 * c) * D + h * 64;
        const bf16* at = AT + o; const bf16* bh = BH + o; const bf16* kh = KH + o; const bf16* vv = V16 + o;
        const f32x16 z = {};
        Pk T11, T22, T12, T11T, T22T, T12T;
        {
            f32x16 n = nat(bh, 0, at, 0, lane, z), nt = nat(at, 0, bh, 0, lane, z); mask_lt(n, lane); mask_gt(nt, lane);
            f32x16 t, tt; inv32(n, nt, t, tt, lane); T11 = pack_tile(t); T11T = pack_tile(tt);
            n = nat(bh, 1, at, 1, lane, z); nt = nat(at, 1, bh, 1, lane, z); mask_lt(n, lane); mask_gt(nt, lane);
            inv32(n, nt, t, tt, lane); T22 = pack_tile(t); T22T = pack_tile(tt);
            const Pk N12 = pack_tile(nat(bh, 0, at, 1, lane, z)), N12T = pack_tile(nat(at, 1, bh, 0, lane, z));
            const Pk Z1 = pack_tile(xt(N12T, T22, z));
            T12 = pack_tile(xt(T11T, Z1, z));
            const Pk Z2 = pack_tile(xt(N12, T11T, z));
            T12T = pack_tile(xt(T22, Z2, z));
        }
        {
            u32x4* tm = (u32x4*)(F.ws + WS_TM) + (size_t)task * 6 * 64 + lane;
            tm[0] = __builtin_bit_cast(u32x4, T11.k0); tm[64] = __builtin_bit_cast(u32x4, T11.k1); tm[128] = __builtin_bit_cast(u32x4, T12.k0); tm[192] = __builtin_bit_cast(u32x4, T12.k1);
            tm[256] = __builtin_bit_cast(u32x4, T22.k0); tm[320] = __builtin_bit_cast(u32x4, T22.k1);
        }
        const float g0 = GC[(size_t)c * D + h * 64 + c32], g1 = GC[(size_t)c * D + h * 64 + 32 + c32];
        Pk W1p[2][2];
#pragma unroll
        for (int b = 0; b < 2; ++b) { const float gcol = b == 0 ? g0 : g1;
            f32x16 bb0 = dl_copy(bh, 0, b, lane), bb1 = dl_copy(bh, 1, b, lane);
#pragma unroll
            for (int r = 0; r < 16; ++r) { bb0[r] *= gcol; bb1[r] *= gcol; }
            const Pk B0 = pack_tile(bb0), B1 = pack_tile(bb1);
            f32x16 w0 = xt(T11T, B0, z); w0 = xt(T12T, B1, w0);
            const f32x16 w1 = xt(T22T, B1, z);
            W1p[0][b] = pack_tile(w0); W1p[1][b] = pack_tile(w1); }
        {
            bf16* plr = (bf16*)(F.ws + WS_PLR) + (size_t)task * 4096;
#pragma unroll
            for (int a2 = 0; a2 < 2; ++a2) { const Pk A0 = pack_tile(dl_copy(at, 0, a2, lane)), A1 = pack_tile(dl_copy(at, 1, a2, lane));
#pragma unroll
                for (int b = 0; b < 2; ++b) { f32x16 p = xt(A0, W1p[0][b], z); p = xt(A1, W1p[1][b], p);
#pragma unroll
                    for (int g4 = 0; g4 < 4; ++g4) {
                        const int m_ = 2 * b + (c32 >> 4), lb_ = (c32 & 15) + 16 * (2 * (g4 & 1) + hh);
                        *(u32x2*)(plr + ((m_ * 2 + a2) * 64 + lb_) * 8 + 4 * (g4 >> 1)) = (u32x2){cvtpk(p[4 * g4], p[4 * g4 + 1]), cvtpk(p[4 * g4 + 2], p[4 * g4 + 3])}; } } }
        }
        Pk M2p[2][2];
        {
            f32x16 e = nat(at, 0, kh, 0, lane, z); mask_gt(e, lane); const Pk E00 = pack_tile(e);
            e = nat(at, 1, kh, 1, lane, z); mask_gt(e, lane); const Pk E11 = pack_tile(e);
            const Pk E10 = pack_tile(nat(at, 1, kh, 0, lane, z));
#pragma unroll
            for (int b = 0; b < 2; ++b) { const float gcol = b == 0 ? g0 : g1;
                f32x16 m0 = xt(E00, W1p[0][b], z); m0 = xt(E10, W1p[1][b], m0);
                f32x16 m1 = xt(E11, W1p[1][b], z);
                const f32x16 k0 = dl_copy(kh, 0, b, lane), k1 = dl_copy(kh, 1, b, lane);
#pragma unroll
                for (int r = 0; r < 16; ++r) { m0[r] += k0[r] * gcol; m1[r] += k1[r] * gcol; }
                M2p[0][b] = pack_tile(m0); M2p[1][b] = pack_tile(m1); }
        }
        {
            float* qm = (float*)(F.ws + WS_QM) + (size_t)task * 4096;
#pragma unroll
            for (int b = 0; b < 2; ++b) { const Pk V0 = pack_tile(dl_copy(vv, 0, b, lane)), V1 = pack_tile(dl_copy(vv, 1, b, lane));
#pragma unroll
                for (int a2 = 0; a2 < 2; ++a2) { f32x16 q = xt(M2p[0][a2], V0, z); q = xt(M2p[1][a2], V1, q);
#pragma unroll
                    for (int g4 = 0; g4 < 4; ++g4) {
                        const int rg_ = 2 * b + (c32 >> 4), m_ = 2 * a2 + (g4 >> 1), lb_ = (c32 & 15) + 16 * (2 * (g4 & 1) + hh);
                        *(f32x4*)(qm + rg_ * 1024 + (m_ * 64 + lb_) * 4) = (f32x4){q[4 * g4], q[4 * g4 + 1], q[4 * g4 + 2], q[4 * g4 + 3]}; } } }
        }
    }
}

constexpr int PB_NST = 10, PB_STB = 8192 + 4096 + 256, PB_NLD = 3;
constexpr int PB_FULL_OFF = RING_BYTES + 64, PB_CONS_OFF = RING_BYTES + 128;
static_assert(PB_NST * PB_STB <= RING_BYTES && PB_FULL_OFF + 4 * PB_NST <= PB_CONS_OFF && PB_CONS_OFF + 4 <= MISC_OFF, "phase-B LDS map");
__device__ __forceinline__ void pb_chain(Frame& F) {
    if ((F.vcu & 31) >= 8 || F.vcu >= 256 || F.wave > PB_NLD) return;
    const int lane = F.lane, h = 2 * (F.vcu >> 5) + ((F.vcu & 31) >> 2), rg = F.vcu & 3;
    volatile LAS unsigned* FULL = (volatile LAS unsigned*)(F.lds + PB_FULL_OFF); volatile LAS unsigned* CONS = (volatile LAS unsigned*)(F.lds + PB_CONS_OFF);
    if (F.wave >= 1) {
        const int L = F.wave - 1;
        const char* PLR = (const char*)(F.ws + WS_PLR); const char* QM = (const char*)(F.ws + WS_QM); const float* GC = (const float*)(F.ws + WS_GC);
        int k = 0;
        for (int c = L; c < NCH; c += PB_NLD, ++k) {
            if (c >= PB_NST) { const unsigned need = (unsigned)(c - PB_NST + 1); unsigned sp = 0; while (CONS[0] < need) { __builtin_amdgcn_s_sleep(1); if (++sp > (1u << 22)) break; } }
            const size_t task = (size_t)c * 16 + h;
            LAS unsigned char* slot = F.lds + (c % PB_NST) * PB_STB;
            const char* pl = PLR + task * 8192 + lane * 16; const char* qm = QM + task * 16384 + rg * 4096 + lane * 16;
#pragma unroll
            for (int i = 0; i < 8; ++i) __builtin_amdgcn_global_load_lds((const unsigned*)(pl + i * 1024), (LAS unsigned*)(slot + i * 1024), 16, 0, 0);
#pragma unroll
            for (int i = 0; i < 4; ++i) __builtin_amdgcn_global_load_lds((const unsigned*)(qm + i * 1024), (LAS unsigned*)(slot + 8192 + i * 1024), 16, 0, 0);
            __builtin_amdgcn_global_load_lds((const unsigned*)(GC + (size_t)c * D + h * 64 + lane), (LAS unsigned*)(slot + 12288), 4, 0, 0);
            if (k >= 2) { asm volatile("s_waitcnt vmcnt(26)" ::: "memory"); const int cp = c - 2 * PB_NLD; FULL[cp % PB_NST] = (unsigned)(cp + 1); }
        }
        const int clast = L + PB_NLD * (k - 1);
        if (k >= 2) { asm volatile("s_waitcnt vmcnt(13)" ::: "memory"); const int cp = clast - PB_NLD; FULL[cp % PB_NST] = (unsigned)(cp + 1); }
        asm volatile("s_waitcnt vmcnt(0)" ::: "memory"); FULL[clast % PB_NST] = (unsigned)(clast + 1);
        return;
    }
    const int n16 = lane & 15, q4 = lane >> 4;
    bf16* S0 = (bf16*)(F.ws + WS_S0);
    f32x4 s[4];
#pragma unroll
    for (int m = 0; m < 4; ++m) s[m] = (f32x4){0.f, 0.f, 0.f, 0.f};
    for (int c = 0; c < NCH; ++c) {
        { const unsigned need = (unsigned)(c + 1); unsigned sp = 0; while (FULL[c % PB_NST] < need) { if (++sp > (1u << 24)) break; } }
        const LAS unsigned char* slot = F.lds + (c % PB_NST) * PB_STB;
        bf16x8 af[4][2]; f32x4 qv[4], gc[4];
#pragma unroll
        for (int m = 0; m < 4; ++m) {
#pragma unroll
            for (int kb = 0; kb < 2; ++kb) af[m][kb] = *(const LAS bf16x8*)(slot + ((m * 2 + kb) * 64 + lane) * 16);
            qv[m] = *(const LAS f32x4*)(slot + 8192 + (m * 64 + lane) * 16); gc[m] = *(const LAS f32x4*)(slot + 12288 + 64 * m + 16 * q4); }
        asm volatile("s_waitcnt lgkmcnt(0)" ::: "memory");
        CONS[0] = (unsigned)(c + 1);
        bf16* s0 = S0 + ((size_t)c * 16 + h) * 4096 + (16 * rg + n16) * 64;
        u32x2 sp2[4];
#pragma unroll
        for (int m = 0; m < 4; ++m) { sp2[m] = (u32x2){cvtpk(s[m][0], s[m][1]), cvtpk(s[m][2], s[m][3])}; *(u32x2*)(s0 + 16 * m + 4 * q4) = sp2[m]; }
        const bf16x8 B0 = __builtin_bit_cast(bf16x8, (u32x4){sp2[0].x, sp2[0].y, sp2[1].x, sp2[1].y}), B1 = __builtin_bit_cast(bf16x8, (u32x4){sp2[2].x, sp2[2].y, sp2[3].x, sp2[3].y});
#pragma unroll
        for (int m = 0; m < 4; ++m) { f32x4 acc = s[m] * gc[m] + qv[m];
            acc = __builtin_amdgcn_mfma_f32_16x16x32_bf16(af[m][0], B0, acc, 0, 0, 0);
            acc = __builtin_amdgcn_mfma_f32_16x16x32_bf16(af[m][1], B1, acc, 0, 0, 0);
            s[m] = acc; }
    }
}

__device__ __forceinline__ void pc_out(Frame& F) {
    const int lane = F.lane, c32 = lane & 31, hh = lane >> 5;
    const bf16* AT = (const bf16*)(F.ws + WS_AT); const bf16* RT = (const bf16*)(F.ws + WS_RT); const bf16* BH = (const bf16*)(F.ws + WS_BH); const bf16* KH = (const bf16*)(F.ws + WS_KH);
    const bf16* V16 = (const bf16*)(F.ws + WS_V16); const bf16* S0 = (const bf16*)(F.ws + WS_S0); float* Y = (float*)(F.ws + WS_Y);
    for (int task = F.gw; task < NCH * NH; task += F.NGW) {
        const int c = task >> 4, h = task & 15; const size_t o = (size_t)(64 * c) * D + h * 64;
        const bf16* at = AT + o; const bf16* rt = RT + o; const bf16* bh = BH + o; const bf16* kh = KH + o; const bf16* vv = V16 + o;
        const bf16* s0 = S0 + (size_t)task * 4096;
        const f32x16 z = {};
        auto s0frag = [&](int it, int ks) { return *(const bf16x8*)(s0 + (32 * it + c32) * 64 + 16 * ks + 8 * hh); };
        Pk Tm00, Tm01, Tm11;
        { const u32x4* tm = (const u32x4*)(F.ws + WS_TM) + (size_t)task * 6 * 64 + lane;
          Tm00.k0 = __builtin_bit_cast(bf16x8, tm[0]); Tm00.k1 = __builtin_bit_cast(bf16x8, tm[64]); Tm01.k0 = __builtin_bit_cast(bf16x8, tm[128]); Tm01.k1 = __builtin_bit_cast(bf16x8, tm[192]);
          Tm11.k0 = __builtin_bit_cast(bf16x8, tm[256]); Tm11.k1 = __builtin_bit_cast(bf16x8, tm[320]); }
        f32x16 e = nat(kh, 0, at, 0, lane, z); mask_lt(e, lane); const Pk K00 = pack_tile(e);
        e = nat(kh, 1, at, 1, lane, z); mask_lt(e, lane); const Pk K11 = pack_tile(e);
        const Pk K01 = pack_tile(nat(kh, 0, at, 1, lane, z));
#pragma unroll 1
        for (int b = 0; b < 2; ++b) {
            const Pk V0 = pack_tile(dl_copy(vv, 0, b, lane)), V1 = pack_tile(dl_copy(vv, 1, b, lane));
            f32x16 x0 = z, x1 = z;
#pragma unroll
            for (int ks = 0; ks < 4; ++ks) { const bf16x8 sf = s0frag(b, ks); x0 = MFMA32(nfrag(at, 0, ks, lane), sf, x0); x1 = MFMA32(nfrag(at, 1, ks, lane), sf, x1); }
            x0 = xt(K00, V0, x0);
            x1 = xt(K01, V0, x1); x1 = xt(K11, V1, x1);
            const Pk X0 = pack_tile(x0), X1 = pack_tile(x1);
            const Pk U0 = pack_tile(xt(Tm00, X0, z));
            f32x16 u1 = xt(Tm01, X0, z); u1 = xt(Tm11, X1, u1); const Pk U1 = pack_tile(u1);
            f32x16 y0 = z, y1 = z;
#pragma unroll
            for (int ks = 0; ks < 4; ++ks) { const bf16x8 sf = s0frag(b, ks); y0 = MFMA32(nfrag(rt, 0, ks, lane), sf, y0); y1 = MFMA32(nfrag(rt, 1, ks, lane), sf, y1); }
            { f32x16 m = nat(bh, 0, rt, 0, lane, z); mask_le(m, lane); const Pk R00 = pack_tile(m); y0 = xt(R00, U0, y0);
              const Pk R01 = pack_tile(nat(bh, 0, rt, 1, lane, z)); y1 = xt(R01, U0, y1);
              m = nat(bh, 1, rt, 1, lane, z); mask_le(m, lane); const Pk R11 = pack_tile(m); y1 = xt(R11, U1, y1); }
            { f32x16 m = nat(kh, 0, rt, 0, lane, z); mask_le(m, lane); const Pk R00 = pack_tile(m); y0 = xt(R00, V0, y0);
              const Pk R01 = pack_tile(nat(kh, 0, rt, 1, lane, z)); y1 = xt(R01, V0, y1);
              m = nat(kh, 1, rt, 1, lane, z); mask_le(m, lane); const Pk R11 = pack_tile(m); y1 = xt(R11, V1, y1); }
            float* yp = Y + (size_t)(64 * c) * D + h * 64 + 32 * b + c32;
#pragma unroll
            for (int r = 0; r < 16; ++r) { yp[(size_t)crow(r, hh) * D] = y0[r]; yp[(size_t)(32 + crow(r, hh)) * D] = y1[r]; }
        }
    }
}

__device__ __forceinline__ void p6_gn_rows(Frame& F, const Args& a) {
    const int lane = F.lane;
    const float* Y = (const float*)(F.ws + WS_Y); const bf16* V16 = (const bf16*)(F.ws + WS_V16); const float* G = (const float*)(F.ws + WS_G);
    const float* C3 = (const float*)(F.ws + WS_CS) + (size_t)2 * T * 16; bf16* Z = (bf16*)(F.ws + WS_Z);
    const Row gg = ld_row(a.in[16], lane), gb = ld_row(a.in[17], lane);
    for (int t = F.gw; t < T; t += F.NGW) {
        const size_t o = (size_t)t * D;
        const Row y = ld_row(Y + o, lane), g = ld_row(G + o, lane), v = ld_row_bf16(V16 + o, lane); Row zr;
#pragma unroll
        for (int j = 0; j < 4; ++j) {
            const float mean = row16_sum((y.v[j][0] + y.v[j][1]) + (y.v[j][2] + y.v[j][3])) * (1.f / 64.f);
            const f32x4 d = y.v[j] - mean;
            const float var = row16_sum((d[0] * d[0] + d[1] * d[1]) + (d[2] * d[2] + d[3] * d[3])) * (1.f / 64.f);
            const float rs = rsqrtf(var + GN_EPS), c3 = C3[(size_t)t * 16 + 4 * j + (lane >> 4)];
            zr.v[j] = (d * rs * gg.v[j] + gb.v[j] + c3 * v.v[j]) * g.v[j];
        }
        st_row_bf16(Z + o, lane, zr);
    }
}

__device__ __forceinline__ void p6_gn(Frame& F, const Args& a) {
    const int lane = F.lane, wave = F.wave;
    const float* YT = (const float*)(F.ws + WS_YT); const float* V = (const float*)(F.ws + WS_V); const float* G = (const float*)(F.ws + WS_G);
    const float* C3 = (const float*)(F.ws + WS_CS) + (size_t)2 * T * 16; bf16* Z = (bf16*)(F.ws + WS_Z);
    LAS float* tile = (LAS float*)F.lds;
    for (int unit = F.vcu; unit < NH * (T / 64); unit += F.G) {
        const int h = unit / (T / 64), t0 = (unit % (T / 64)) * 64;
        __syncthreads();
#pragma unroll
        for (int q = 0; q < 8; ++q) { const int i = wave * 8 + q; tile[i * 65 + lane] = YT[(size_t)(h * 64 + i) * T + t0 + lane]; }
        __syncthreads();
        const float gg = a.in[16][h * 64 + lane], gb = a.in[17][h * 64 + lane];
#pragma unroll
        for (int q = 0; q < 8; ++q) { const int tt = wave * 8 + q, t = t0 + tt;
            const float y = tile[lane * 65 + tt];
            const float mean = wave_sum(y) * (1.f / 64.f); const float dlt = y - mean; const float var = wave_sum(dlt * dlt) * (1.f / 64.f);
            const size_t o = (size_t)t * D + h * 64 + lane;
            const float z = (dlt * rsqrtf(var + GN_EPS) * gg + gb + C3[(size_t)t * 16 + h] * V[o]) * G[o];
            Z[o] = (bf16)f2bf(z); }
    }
    __syncthreads();
}

__device__ __forceinline__ void p8_norm(Frame& F, const float* g, bf16* U) {
    const float* Hs = (const float*)(F.ws + WS_H); const Row gr = ld_row(g, F.lane);
    for (int t = F.gw; t < T; t += F.NGW) st_row_bf16(U + (size_t)t * D, F.lane, rmsnorm_row(ld_row(Hs + (size_t)t * D, F.lane), gr));
}
__device__ __forceinline__ void p11_norm_forget(Frame& F, const Args& a) {
    const int lane = F.lane; const float* Hs = (const float*)(F.ws + WS_H); bf16* U = (bf16*)(F.ws + WS_U3); float* LF = (float*)(F.ws + WS_LF);
    LAS float* wf = (LAS float*)F.lds;
    __syncthreads();
    for (int i = F.tid; i < 16 * D; i += NTHREADS) { const int hh = i & 15, k = i >> 4; wf[hh * D + k] = a.in[19][(size_t)k * WIN_LD + 4 * D + hh]; }
    __syncthreads();
    const Row gr = ld_row(a.in[1] + 2 * D, lane);
    for (int t = F.gw; t < T; t += F.NGW) {
        const Row u = rmsnorm_row(ld_row(Hs + (size_t)t * D, lane), gr);
        st_row_bf16(U + (size_t)t * D, lane, u);
        float mine = 0.f;
#pragma unroll 2
        for (int hh = 0; hh < 16; ++hh) { float s = 0.f;
#pragma unroll
            for (int j = 0; j < 4; ++j) { const f32x4 w = *(const LAS f32x4*)(wf + hh * D + 256 * j + 4 * lane); s += (u.v[j][0] * w[0] + u.v[j][1] * w[1]) + (u.v[j][2] * w[2] + u.v[j][3] * w[3]); }
            s = wave_sum(s); if (lane == hh) mine = s; }
        if (lane < 16) { const float x = mine + a.in[20][lane]; LF[(size_t)t * 16 + lane] = fminf(x, 0.f) - log1pf(__expf(-fabsf(x))); }
    }
    __syncthreads();
}
__device__ __forceinline__ void p13_cumsum_qknorm(Frame& F, const Args& a) {
    const int lane = F.lane, tid = F.tid;
    const float* LF = (const float*)(F.ws + WS_LF); float* C2 = (float*)(F.ws + WS_C2); float* CB = (float*)(F.ws + WS_CB);
    if (F.vcu < NH) {
        const int h = F.vcu; LAS double* part = (LAS double*)F.lds;
        __syncthreads();
        const int tb = tid * 32; double s = 0.0;
        for (int i = 0; i < 32; ++i) s += (double)LF[(size_t)(tb + i) * 16 + h];
        part[tid] = s; __syncthreads();
        if (tid == 0) { double run = 0.0; for (int i = 0; i < NTHREADS; ++i) { const double v = part[i]; part[i] = run; run += v; } }
        __syncthreads();
        double run = part[tid];
        for (int i = 0; i < 32; ++i) { run += (double)LF[(size_t)(tb + i) * 16 + h]; const float c = (float)(run * 1.4426950408889634); C2[(size_t)h * T + tb + i] = c; if (((tb + i) & 63) == 63) CB[h * 256 + ((tb + i) >> 6)] = c; }
        __syncthreads();
    }
    bf16* Q = (bf16*)(F.ws + WS_QKVG);
    f32x4 gq[4], gk[4];
#pragma unroll
    for (int j = 0; j < 4; ++j) { const int c = (4 * lane + 256 * j) & 63; gq[j] = *(const f32x4*)(a.in[21] + c) * (0.125f * LOG2E); gk[j] = *(const f32x4*)(a.in[22] + c); }
    for (int t = F.gw; t < T; t += F.NGW) {
#pragma unroll
        for (int which = 0; which < 2; ++which) {
            bf16* p = Q + (size_t)t * 4096 + which * D;
            Row x = ld_row_bf16(p, lane);
#pragma unroll
            for (int j = 0; j < 4; ++j) { float ss = (x.v[j][0] * x.v[j][0] + x.v[j][1] * x.v[j][1]) + (x.v[j][2] * x.v[j][2] + x.v[j][3] * x.v[j][3]); ss = row16_sum(ss);
                const float rs = rsqrtf(ss * (1.f / 64.f) + RMS_EPS); x.v[j] = x.v[j] * rs * (which == 0 ? gq[j] : gk[j]); }
            st_row_bf16(p, lane, x);
        }
    }
}

#ifndef ATTN_STORE16
#define ATTN_STORE16(p,v) (*(u32x4*)(p)=(v))
#endif
namespace attn_body {
using bf16x8=__attribute__((ext_vector_type(8)))short;
using s16x4=__attribute__((ext_vector_type(4)))short;
using f32x16=__attribute__((ext_vector_type(16)))float;
using u32x4=__attribute__((ext_vector_type(4)))unsigned;
constexpr int NHEAD=16,SEQ=16384,D=64,DM=4096,OM=1024;
constexpr int NW=8,QBLK=32,QB=QBLK*NW,KVBLK=64,NQB=SEQ/QB;
constexpr int ATTN_UNIT_ROWS=QB;
__device__ __forceinline__ int crow(int r,int hi){return (r&3)+8*(r>>2)+4*hi;}
#define SBAR() __builtin_amdgcn_sched_barrier(0)
__device__ __forceinline__ void cmask(f32x16&p0,f32x16&p1,int jb,int qrel,int hi){
  const float NEG=-INFINITY; int kb=64*jb+4*hi;
  #pragma unroll
  for(int r=0;r<16;++r){int kv=kb+(r&3)+8*(r>>2); if(kv>qrel)p0[r]=NEG; if(kv+32>qrel)p1[r]=NEG;}
}

constexpr int NSLOT=3, SLOTB=8192;
constexpr int LDS_K=0, LDS_V=NSLOT*SLOTB, LDS_WS=2*NSLOT*SLOTB, LDS_OST=LDS_WS+NW*64*4, LDS_BYTES=LDS_OST+NW*4096;
constexpr float C2=0.125f*1.4426950408889634f;
__device__ __forceinline__ void glds16(const void*gsrc,unsigned lds_dst){unsigned keep;
  asm volatile("s_mov_b32 %0, m0\n\ts_mov_b32 m0, %2\n\ts_nop 0\n\tglobal_load_lds_dwordx4 %1, off\n\ts_mov_b32 m0, %0":"=&s"(keep):"v"(gsrc),"s"(lds_dst):"memory");}
__device__ __forceinline__ float max3f(float a,float b,float c){float r;asm("v_max3_f32 %0, %1, %2, %3":"=v"(r):"v"(a),"v"(b),"v"(c));return r;}
__device__ __forceinline__ float max2f(float a,float b){float r;asm("v_max_f32_e32 %0, %1, %2":"=v"(r):"v"(a),"v"(b));return r;}
__device__ __forceinline__ float fadd_s(float a,float b){float r;asm("v_add_f32_e32 %0, %1, %2":"=v"(r):"v"(a),"v"(b));return r;}
__device__ __forceinline__ float fsub_s(float a,float b){float r;asm("v_sub_f32_e32 %0, %1, %2":"=v"(r):"v"(a),"v"(b));return r;}
typedef float f32x2_t __attribute__((ext_vector_type(2))); typedef __bf16 bf16x2_t __attribute__((ext_vector_type(2)));
__device__ __forceinline__ unsigned cvtpk_s(float lo,float hi){f32x2_t v={lo,hi};bf16x2_t b=__builtin_convertvector(v,bf16x2_t);return __builtin_bit_cast(unsigned,b);}
#define WAIT_BAR(N) asm volatile("s_waitcnt vmcnt(" #N ") lgkmcnt(0)\n\ts_barrier":::"memory")

__device__ __forceinline__ void qkt(f32x16&p0,f32x16&p1,const char*Kslot,const __attribute__((address_space(3))) char*qst,const f32x16&cin0,const f32x16&cin1,int r32,int hi){
  #define QF_(i) (*(const __attribute__((address_space(3))) bf16x8*)(qst+(i)*1024))
  const char*kb=Kslot+hi*1024+r32*16;
  #pragma unroll
  for(int d0=0;d0<4;++d0){
    const bf16x8 b0=*reinterpret_cast<const bf16x8*>(kb+d0*2048);
    const bf16x8 b1=*reinterpret_cast<const bf16x8*>(kb+d0*2048+512);
    const bf16x8 qd=QF_(d0);
    if(d0==0){p0=__builtin_amdgcn_mfma_f32_32x32x16_bf16(b0,qd,cin0,0,0,0);p1=__builtin_amdgcn_mfma_f32_32x32x16_bf16(b1,qd,cin1,0,0,0);}
    else{p0=__builtin_amdgcn_mfma_f32_32x32x16_bf16(b0,qd,p0,0,0,0);p1=__builtin_amdgcn_mfma_f32_32x32x16_bf16(b1,qd,p1,0,0,0);}}
  #undef QF_
}
typedef __attribute__((address_space(3))) const char* lds_cptr;
typedef short v4i16_t __attribute__((ext_vector_type(4)));
__device__ __forceinline__ void kload8(bf16x8*kf,lds_cptr kp){
  kf[0]=*(const __attribute__((address_space(3))) bf16x8*)(kp);      kf[1]=*(const __attribute__((address_space(3))) bf16x8*)(kp+512);
  kf[2]=*(const __attribute__((address_space(3))) bf16x8*)(kp+2048); kf[3]=*(const __attribute__((address_space(3))) bf16x8*)(kp+2560);
  kf[4]=*(const __attribute__((address_space(3))) bf16x8*)(kp+4096); kf[5]=*(const __attribute__((address_space(3))) bf16x8*)(kp+4608);
  kf[6]=*(const __attribute__((address_space(3))) bf16x8*)(kp+6144); kf[7]=*(const __attribute__((address_space(3))) bf16x8*)(kp+6656);
}
__device__ __forceinline__ void kload2(bf16x8*kf,lds_cptr kp,int j){ kf[2*j]=*(const __attribute__((address_space(3))) bf16x8*)(kp+j*2048); kf[2*j+1]=*(const __attribute__((address_space(3))) bf16x8*)(kp+j*2048+512); }
__device__ __forceinline__ s16x4 vtr(lds_cptr p){ return __builtin_bit_cast(s16x4,__builtin_amdgcn_ds_read_tr16_b64_v4i16((__attribute__((address_space(3))) v4i16_t*)p)); }
__device__ __forceinline__ float rowmax(const f32x16&p0,const f32x16&p1){
  float a=max3f(p0[0],p0[1],p1[0]),b=max3f(p0[2],p0[3],p1[1]);a=max3f(a,p1[2],p1[3]);
  #pragma unroll
  for(int r=4;r<16;r+=4){a=max3f(a,p0[r],p0[r+1]);b=max3f(b,p0[r+2],p0[r+3]);a=max3f(a,p1[r],p1[r+1]);b=max3f(b,p1[r+2],p1[r+3]);}
  const float m=max2f(a,b);
  auto rr=__builtin_amdgcn_permlane32_swap(__float_as_uint(m),__float_as_uint(m),false,false);
  return max2f(__uint_as_float(rr[0]),__uint_as_float(rr[1]));
}
__device__ __forceinline__ void pv(f32x16*o,int vb,bf16x8 pa0,bf16x8 pa1,bf16x8 pa2,bf16x8 pa3){
  #pragma unroll
  for(int d0=0;d0<2;++d0){s16x4 lo[4],hi[4];
    #pragma unroll
    for(int ks=0;ks<4;++ks){
      asm volatile("ds_read_b64_tr_b16 %0,%1 offset:%c2":"=&v"(lo[ks]):"v"(vb),"i"(d0*4096+ks*1024):"memory");
      asm volatile("ds_read_b64_tr_b16 %0,%1 offset:%c2":"=&v"(hi[ks]):"v"(vb),"i"(d0*4096+ks*1024+512):"memory");}
    asm volatile("s_waitcnt lgkmcnt(0)":::"memory");SBAR();
    #define PK(k) (bf16x8){lo[k][0],lo[k][1],lo[k][2],lo[k][3],hi[k][0],hi[k][1],hi[k][2],hi[k][3]}
    o[d0]=__builtin_amdgcn_mfma_f32_32x32x16_bf16(pa0,PK(0),o[d0],0,0,0);
    o[d0]=__builtin_amdgcn_mfma_f32_32x32x16_bf16(pa1,PK(1),o[d0],0,0,0);
    o[d0]=__builtin_amdgcn_mfma_f32_32x32x16_bf16(pa2,PK(2),o[d0],0,0,0);
    o[d0]=__builtin_amdgcn_mfma_f32_32x32x16_bf16(pa3,PK(3),o[d0],0,0,0);
    #undef PK
  }
}

#ifndef ATTN_STORE16
#define ATTN_STORE16(p,v) (*(u32x4*)(p)=(v))
#endif
template<int THRL> __device__ __forceinline__ void attn_unit(int h,int qb,int jstart,const bf16*Q,const bf16*__restrict__ K,const bf16*__restrict__ V,const bf16*__restrict__ OG,bf16*O,const float*__restrict__ C2h,char*shm){
  const int tid=threadIdx.x,lane=tid&63,r32=lane&31,hi=lane>>5; const int wid=__builtin_amdgcn_readfirstlane(tid>>6);
  const long rowbase=0; const int q0=qb*QB;
  const bf16*Qw=Q+(rowbase+q0+wid*QBLK)*DM+h*D;
  const bf16*Kh=K+(rowbase+(long)jstart*KVBLK)*DM+h*D,*Vh=V+(rowbase+(long)jstart*KVBLK)*DM+h*D;
  const lds_cptr shm3=(lds_cptr)shm;
  const unsigned lds0=(unsigned)(uintptr_t)shm;
  float*wsf=(float*)(shm+LDS_WS)+wid*64;
  const bf16*ksrc=Kh+(long)lane*DM+wid*8;
  const bf16*vsrc=Vh+(long)(16*(wid&3)+(lane>>2))*DM+(wid>>2)*32+(lane&3)*8;
  const unsigned kdst=lds0+LDS_K+wid*1024, vdst=lds0+LDS_V+wid*1024;
  #define DMA_K(t,slot) glds16(ksrc+(long)(t)*KVBLK*DM,(unsigned)__builtin_amdgcn_readfirstlane(kdst+(slot)))
  #define DMA_V(t,slot) glds16(vsrc+(long)(t)*KVBLK*DM,(unsigned)__builtin_amdgcn_readfirstlane(vdst+(slot)))
  const int vb0=(int)(lds0+LDS_V)+((lane>>4)&1)*32+(lane&3)*8+(4*hi+((lane&15)>>2))*64;
  const char*Kbase=shm+LDS_K; bf16x8 kf[8];
  const lds_cptr kp0=shm3+LDS_K+hi*1024+r32*16; const lds_cptr vp0=shm3+LDS_V+((lane>>4)&1)*32+(lane&3)*8+(4*hi+((lane&15)>>2))*64;
  const int NT=(q0+QB)/KVBLK-jstart;
  DMA_K(0,0);DMA_V(0,0);DMA_K(1,SLOTB);
  typedef __attribute__((address_space(3))) u32x4* lds_rptr; const lds_rptr brec=(lds_rptr)(shm3+LDS_BYTES);
  { const float cref=C2h[q0]; const float*cs=C2h+(long)jstart*KVBLK;
    int tid_e=tid; asm volatile("":"+v"(tid_e));
    for(int i_=tid_e;i_<NT*KVBLK;i_+=NW*64){ const float x_=cref-cs[i_]; const unsigned a1_=f2bf(x_); const float r1_=x_-__uint_as_float(a1_<<16); const unsigned a2_=f2bf(r1_); const float r2_=r1_-__uint_as_float(a2_<<16); const unsigned a3_=f2bf(r2_);
      brec[i_]=(u32x4){a1_|(a2_<<16),a3_,0u,0u}; }
    if(tid==0)brec[NT*KVBLK]=(u32x4){0x3F803F80u,0x00003F80u,0u,0u}; }
  const lds_cptr abp=(lds_cptr)brec+(hi?NT*KVBLK*16:r32*16); const int ast=hi?0:KVBLK*16, ab1=hi?0:32*16;
  #define ABF(t,half) (*(const __attribute__((address_space(3))) bf16x8*)(abp+(t)*ast+(half)*ab1))
  const lds_cptr qst=shm3+LDS_OST+wid*4096+lane*16;
  #pragma unroll
  for(int d0=0;d0<4;++d0){ const u32x4 qv_=*reinterpret_cast<const u32x4*>(&Qw[(long)r32*DM+d0*16+hi*8]); *(__attribute__((address_space(3))) u32x4*)(const_cast<__attribute__((address_space(3))) char*>(qst)+d0*1024)=qv_; }
  #define QF(i) (*(const __attribute__((address_space(3))) bf16x8*)(qst+(i)*1024))
  float mhat=0.f,l_reg=0.f;f32x16 o[2];o[0]=f32x16{};o[1]=f32x16{};
  u32x4 bmw=hi?(u32x4){0u,0u,0u,0u}:(u32x4){0x3F803F80u,0x00003F80u,0u,0u};
  #define SETBM() do{ const float nm_=-mhat; const unsigned a1_=f2bf(nm_); const float r1_=nm_-__uint_as_float(a1_<<16); const unsigned a2_=f2bf(r1_); const float r2_=r1_-__uint_as_float(a2_<<16); const unsigned a3_=f2bf(r2_); if(hi){bmw[0]=a1_|(a2_<<16);bmw[1]=a3_;} }while(0)
  #define BMF() __builtin_bit_cast(bf16x8,bmw)
  const f32x16 zero16=f32x16{};
  const int qrel=wid*QBLK+r32;
  #define CMASK(P0,P1,t) do{int jb_=(t)-(NT-4); if(jb_>=0)cmask(P0,P1,jb_,qrel,hi);}while(0)
  bool resc=false;
  #define START(P0,P1) do{ const float rm=rowmax(P0,P1); resc=false; \
    { const float dl=rm; mhat=fadd_s(mhat,dl); \
      _Pragma("unroll") for(int r=0;r<16;++r){P0[r]=fsub_s(P0[r],dl);P1[r]=fsub_s(P1[r],dl);} \
      SETBM(); } \
    _Pragma("unroll") for(int r=0;r<16;++r)P0[r]=__builtin_amdgcn_exp2f(P0[r]); }while(0)
  #define RESC() do{ if(resc){ asm volatile("s_waitcnt lgkmcnt(0)":::"memory"); \
      _Pragma("unroll") for(int d_=0;d_<2;++d_) _Pragma("unroll") for(int r=0;r<16;++r)o[d_][r]*=wsf[crow(r,hi)]; } }while(0)
  f32x16 pA0,pA1,pB0,pB1;
  int sl_prev=0,sl_cur=0,sl_next=SLOTB;
  #define ROT() do{sl_prev=sl_cur;sl_cur=sl_next;sl_next=(sl_next==(NSLOT-1)*SLOTB)?0:sl_next+SLOTB;}while(0)
  DMA_K(2,2*SLOTB);
  WAIT_BAR(3);
  { const f32x16 c0_=__builtin_amdgcn_mfma_f32_32x32x16_bf16(ABF(0,0),BMF(),zero16,0,0,0), c1_=__builtin_amdgcn_mfma_f32_32x32x16_bf16(ABF(0,1),BMF(),zero16,0,0,0); qkt(pA0,pA1,Kbase,qst,c0_,c1_,r32,hi); }
  asm volatile("s_nop 15\n\ts_nop 7":"+v"(pA0),"+v"(pA1));CMASK(pA0,pA1,0);
  START(pA0,pA1);
  _Pragma("unroll") for(int r=0;r<16;++r)pA1[r]=__builtin_amdgcn_exp2f(pA1[r]);
  WAIT_BAR(0);
  DMA_K(3,0);DMA_V(1,SLOTB);
  ROT();
  kload8(kf,kp0+sl_cur);
  WAIT_BAR(2);
  s16x4 vlo[8],vhi[8]; u32x4 pw0,pw1,pw2,pw3;
  #define PKW(P,B) cvtpk_s(P[B],P[B+1])
  #define PAF(k) __builtin_bit_cast(bf16x8,pw##k)
  #define VFR(i) (bf16x8){vlo[i][0],vlo[i][1],vlo[i][2],vlo[i][3],vhi[i][0],vhi[i][1],vhi[i][2],vhi[i][3]}
  #define PIN(x) asm volatile("":"+v"(x))
  #define MX3(a,b,c) __builtin_fmaxf(__builtin_fmaxf((a),(b)),(c))
  #define GAPA(MF,A0,A1,A2,A3,W0,W1,PW) do{ MF; sacc+=A0; sacc+=A1; sacc+=A2; sacc+=A3; PIN(sacc); W0; W1; PIN(PW); SBAR(); }while(0)
  #define EX(v) __builtin_amdgcn_exp2f(v)
  #define GAPB(MF,X,B) do{ MF; X[B]=EX(X[B]); X[B+1]=EX(X[B+1]); X[B+2]=EX(X[B+2]); X[B+3]=EX(X[B+3]); PIN(X); SBAR(); }while(0)
  #define VRD(i) do{ vlo[i]=vtr(vp_+(((i)>>2)*4096+((i)&3)*1024)); vhi[i]=vtr(vp_+(((i)>>2)*4096+((i)&3)*1024+512)); }while(0)
  #define KRD(G,j) do{ if(G){ kload2(kf,kp0+sl_next,j); SBAR(); } }while(0)
  #define STEP(C0,C1,P0,P1,t,GK,GV,GL) do{ SBAR(); \
    const lds_cptr vp_=vp0+sl_prev; \
    VRD(0); SBAR(); float sacc=(P0[0]+P0[1]); \
    C0=__builtin_amdgcn_mfma_f32_32x32x16_bf16(ABF(t,0),BMF(),zero16,0,0,0); C1=__builtin_amdgcn_mfma_f32_32x32x16_bf16(ABF(t,1),BMF(),zero16,0,0,0); SBAR(); \
    GAPA(C0=__builtin_amdgcn_mfma_f32_32x32x16_bf16(kf[0],QF(0),C0,0,0,0), P0[2],P0[3],P0[4],P0[5],     pw0[0]=PKW(P0,0), pw0[1]=PKW(P0,2), pw0); \
    VRD(4); SBAR(); GAPA(C1=__builtin_amdgcn_mfma_f32_32x32x16_bf16(kf[1],QF(0),C1,0,0,0), P0[6],P0[7],P0[8],P0[9],     pw0[2]=PKW(P0,4), pw0[3]=PKW(P0,6), pw0); \
    VRD(1); SBAR(); GAPA(C0=__builtin_amdgcn_mfma_f32_32x32x16_bf16(kf[2],QF(1),C0,0,0,0),   P0[10],P0[11],P0[12],P0[13], pw1[0]=PKW(P0,8), pw1[1]=PKW(P0,10), pw1); \
    VRD(5); SBAR(); GAPA(C1=__builtin_amdgcn_mfma_f32_32x32x16_bf16(kf[3],QF(1),C1,0,0,0),   P0[14],P0[15],P1[0],P1[1],   pw1[2]=PKW(P0,12),pw1[3]=PKW(P0,14), pw1); \
    VRD(2); SBAR(); GAPA(C0=__builtin_amdgcn_mfma_f32_32x32x16_bf16(kf[4],QF(2),C0,0,0,0),   P1[2],P1[3],P1[4],P1[5],     pw2[0]=PKW(P1,0), pw2[1]=PKW(P1,2), pw2); \
    VRD(6); SBAR(); GAPA(C1=__builtin_amdgcn_mfma_f32_32x32x16_bf16(kf[5],QF(2),C1,0,0,0),   P1[6],P1[7],P1[8],P1[9],     pw2[2]=PKW(P1,4), pw2[3]=PKW(P1,6), pw2); \
    VRD(3); SBAR(); GAPA(C0=__builtin_amdgcn_mfma_f32_32x32x16_bf16(kf[6],QF(3),C0,0,0,0),   P1[10],P1[11],P1[12],P1[13], pw3[0]=PKW(P1,8), pw3[1]=PKW(P1,10), pw3); \
    VRD(7); SBAR(); GAPA(C1=__builtin_amdgcn_mfma_f32_32x32x16_bf16(kf[7],QF(3),C1,0,0,0),   P1[14],P1[15],0.f,0.f,       pw3[2]=PKW(P1,12),pw3[3]=PKW(P1,14), pw3); \
    l_reg+=sacc; \
    if(GK){DMA_K((t)+3,sl_cur);} if(GV){DMA_V((t)+1,sl_next);} \
    CMASK(C0,C1,t); \
    { float a=MX3(C0[0],C0[1],C1[0]),b=MX3(C0[2],C0[3],C1[1]); a=MX3(a,C1[2],C1[3]); \
      _Pragma("unroll") for(int r=4;r<16;r+=4){a=MX3(a,C0[r],C0[r+1]);b=MX3(b,C0[r+2],C0[r+3]);a=MX3(a,C1[r],C1[r+1]);b=MX3(b,C1[r+2],C1[r+3]);} \
      float rm=__builtin_fmaxf(a,b); { auto rr=__builtin_amdgcn_permlane32_swap(__float_as_uint(rm),__float_as_uint(rm),false,false); rm=__builtin_fmaxf(__uint_as_float(rr[0]),__uint_as_float(rr[1])); } \
      resc=false; \
      if(__builtin_expect(__any(rm>(float)THRL),0)){ const float dl=__builtin_fmaxf(rm,0.f); mhat+=dl; \
        _Pragma("unroll") for(int r=0;r<16;++r){C0[r]-=dl;C1[r]-=dl;} \
        SETBM(); \
        const float f=__builtin_amdgcn_exp2f(-dl); l_reg*=f; if(hi==0)wsf[r32]=f; resc=true; } } \
    SBAR(); \
    GAPB(o[0]=__builtin_amdgcn_mfma_f32_32x32x16_bf16(PAF(0),VFR(0),o[0],0,0,0), C0,0); \
    GAPB(o[1]=__builtin_amdgcn_mfma_f32_32x32x16_bf16(PAF(0),VFR(4),o[1],0,0,0), C0,4); \
    KRD(GL,0); GAPB(o[0]=__builtin_amdgcn_mfma_f32_32x32x16_bf16(PAF(1),VFR(1),o[0],0,0,0), C0,8); \
    KRD(GL,1); GAPB(o[1]=__builtin_amdgcn_mfma_f32_32x32x16_bf16(PAF(1),VFR(5),o[1],0,0,0), C0,12); \
    KRD(GL,2); GAPB(o[0]=__builtin_amdgcn_mfma_f32_32x32x16_bf16(PAF(2),VFR(2),o[0],0,0,0), C1,0); \
    KRD(GL,3); GAPB(o[1]=__builtin_amdgcn_mfma_f32_32x32x16_bf16(PAF(2),VFR(6),o[1],0,0,0), C1,4); \
    GAPB(o[0]=__builtin_amdgcn_mfma_f32_32x32x16_bf16(PAF(3),VFR(3),o[0],0,0,0), C1,8); \
    GAPB(o[1]=__builtin_amdgcn_mfma_f32_32x32x16_bf16(PAF(3),VFR(7),o[1],0,0,0), C1,12); \
    }while(0)
  int t=1;
  #undef CMASK
  #define CMASK(P0,P1,t) do{}while(0)
  for(;t+5<NT;t+=2){
    STEP(pB0,pB1,pA0,pA1,t,true,true,true);     WAIT_BAR(2); RESC(); ROT();
    STEP(pA0,pA1,pB0,pB1,t+1,true,true,true);   WAIT_BAR(2); RESC(); ROT();
  }
  #undef CMASK
  #define CMASK(P0,P1,t) do{int jb_=(t)-(NT-4); if(jb_>=0)cmask(P0,P1,jb_,qrel,hi);}while(0)
  #define ENDW(tt) do{ if((tt)+3<NT){WAIT_BAR(2);} else if((tt)+2<NT){WAIT_BAR(1);} else {WAIT_BAR(0);} }while(0)
  for(;t+1<NT;t+=2){
    STEP(pB0,pB1,pA0,pA1,t,(t+3<NT),(t+1<NT),(t+1<NT));       ENDW(t);   RESC(); ROT();
    STEP(pA0,pA1,pB0,pB1,t+1,(t+4<NT),(t+2<NT),(t+2<NT));     ENDW(t+1); RESC(); ROT();
  }
  STEP(pB0,pB1,pA0,pA1,NT-1,false,false,false); RESC();
  { float sacc=pB0[0]+pB0[1]; _Pragma("unroll") for(int r=2;r<16;++r)sacc+=pB0[r]; _Pragma("unroll") for(int r=0;r<16;++r)sacc+=pB1[r]; l_reg+=sacc;
    pw0=(u32x4){PKW(pB0,0),PKW(pB0,2),PKW(pB0,4),PKW(pB0,6)};pw1=(u32x4){PKW(pB0,8),PKW(pB0,10),PKW(pB0,12),PKW(pB0,14)};pw2=(u32x4){PKW(pB1,0),PKW(pB1,2),PKW(pB1,4),PKW(pB1,6)};pw3=(u32x4){PKW(pB1,8),PKW(pB1,10),PKW(pB1,12),PKW(pB1,14)};
    SBAR(); pv(o,vb0+sl_cur,PAF(0),PAF(1),PAF(2),PAF(3)); }
  #undef PKW
  #undef PAF
  #undef VFR
  #undef PIN
  #undef MX3
  #undef GAPA
  #undef GAPB
  #undef EX
  #undef VRD
  #undef KRD
  #undef STEP
  #undef ENDW
  {auto rr=__builtin_amdgcn_permlane32_swap(__float_as_uint(l_reg),__float_as_uint(l_reg),false,false);l_reg=__uint_as_float(rr[0])+__uint_as_float(rr[1]);}
  int lane_e=lane; asm volatile("":"+v"(lane_e));
  const int r32e=lane_e&31,hie=lane_e>>5;
  if(hie==0)wsf[32+r32e]=l_reg;asm volatile("s_waitcnt lgkmcnt(0)":::"memory");
  float rli[16];
  #pragma unroll
  for(int r=0;r<16;++r)rli[r]=__builtin_amdgcn_rcpf(wsf[32+crow(r,hie)]);
  bf16*Ow=O+(rowbase+q0+wid*QBLK)*OM+h*D; const bf16*OGw=OG+(rowbase+q0+wid*QBLK)*DM+h*D;
  { bf16*stg=(bf16*)(shm+LDS_OST)+wid*2048;
    #pragma unroll
    for(int r=0;r<16;++r){const int orow=crow(r,hie);
      #pragma unroll
      for(int d0=0;d0<2;++d0)stg[orow*64+d0*32+r32e]=(bf16)f2bf(o[d0][r]*rli[r]);}
    asm volatile("s_waitcnt lgkmcnt(0)":::"memory");
    #pragma unroll
    for(int i=0;i<4;++i){const int row=i*8+(lane_e>>3),ch=lane_e&7; const u32x4 v=*(const u32x4*)(stg+row*64+ch*8); const u32x4 g=*(const u32x4*)(OGw+(long)row*DM+ch*8); u32x4 w;
      #pragma unroll
      for(int e=0;e<4;++e){ const float lo=bflo(v[e])*sigmoidf_(bflo(g[e])), hh_=bfhi(v[e])*sigmoidf_(bfhi(g[e])); w[e]=pk2(lo,hh_); }
      ATTN_STORE16(Ow+(long)row*OM+ch*8,w);} }
  asm volatile("s_waitcnt lgkmcnt(0)\n\ts_barrier":::"memory");
  #undef QF
  #undef ABF
  #undef SETBM
  #undef BMF
  #undef DMA_K
  #undef DMA_V
  #undef CMASK
  #undef START
  #undef RESC
  #undef ROT
}
constexpr int ATTN_LDS_BYTES=LDS_BYTES;
#undef SBAR
#undef WAIT_BAR
}

constexpr int KP = 144;
__device__ __forceinline__ void p14_attention(Frame& F, const Args& a, int qword = CW_ATTQ) {
    const int tid0 = F.tid, lane0 = F.lane;
    const bf16* QKVG = (const bf16*)(F.ws + WS_QKVG); const float* C2 = (const float*)(F.ws + WS_C2); const float* CB = (const float*)(F.ws + WS_CB);
    bf16* Z2 = (bf16*)(F.ws + WS_Z2);
    LAS unsigned char* Ks = F.lds; LAS unsigned char* Vs = F.lds + 64 * KP; LAS float* bias = (LAS float*)(F.lds + 2 * 64 * KP); LAS int* uslot = (LAS int*)(F.lds + RING_BYTES + 192);
    constexpr int ATT_MAXT = (RING_BYTES - attn_body::ATTN_LDS_BYTES - 16) / 1024;
    float mq = 0.f, mk = 0.f;
    for (int i = 0; i < 64; ++i) { mq = fmaxf(mq, fabsf(a.in[21][i])); mk = fmaxf(mk, fabsf(a.in[22][i])); }
    const float THR2 = (2.f * 8.f * mq * mk * 1.01f + 30.f) * LOG2E;
    gu32* qctr = F.ctl + qword;
    for (;;) {
        __syncthreads();
        if (tid0 == 0) uslot[0] = (int)__hip_atomic_fetch_add(qctr, 1u, RLX_AGENT);
        __syncthreads();
        const int unit = uslot[0];
        if (unit >= NH * (T / 256)) break;
        const int h = unit & 15, qb = (T / 256 - 1) - (unit >> 4), q0 = qb * 256;
        const float ct0 = C2[(size_t)h * T + q0];
        int jstart = 0;
        { int tot = 0; for (int j0 = 0; j0 < 4 * qb; j0 += 64) { const int j = j0 + lane0; const bool skip = (j < 4 * qb) && ((ct0 - CB[h * 256 + j]) < -THR2); tot += __popcll(__ballot(skip)); } jstart = tot; }
        jstart &= ~1;
        if (4 * qb + 4 - jstart <= ATT_MAXT) {
            attn_body::attn_unit<8>(h, qb, jstart, QKVG, QKVG + D, QKVG + 2 * D, QKVG + 3 * D, Z2, C2 + (size_t)h * T, (char*)F.lds);
            continue;
        }
        int tid_s = F.tid; asm volatile("" : "+v"(tid_s));
        const int tid = tid_s, lane = tid & 63, wid = F.wave, r32 = lane & 31, hi = lane >> 5;
        const int jend = 4 * qb + 3;
        const int qrow = q0 + wid * 32 + r32;
        bf16x8 qr[4];
#pragma unroll
        for (int d0 = 0; d0 < 4; ++d0) qr[d0] = *(const bf16x8*)(QKVG + (size_t)qrow * 4096 + h * 64 + d0 * 16 + hi * 8);
        f32x16 o0 = {}, o1 = {}; float m = -INFINITY, l = 0.f;
        const int lrow = tid >> 3, lch = tid & 7;
        u32x4 kreg, vreg; float breg = 0.f;
        auto gload = [&](int j) { const size_t row = (size_t)(64 * j + lrow) * 4096 + h * 64 + lch * 8;
            kreg = *(const u32x4*)(QKVG + row + D); vreg = *(const u32x4*)(QKVG + row + 2 * D); if (tid < 64) breg = -C2[(size_t)h * T + 64 * j + tid]; };
        gload(jstart);
        for (int j = jstart; j <= jend; ++j) {
            __syncthreads();
            *(LAS u32x4*)(Ks + lrow * KP + lch * 16) = kreg;
            { const int s_ = lrow >> 4, x_ = lrow & 15, p_ = s_ * 16 + ((x_ >> 2) & 1) * 8 + (((x_ >> 3) << 2) | (x_ & 3));
                const unsigned w_[4] = {vreg.x, vreg.y, vreg.z, vreg.w};
#pragma unroll
                for (int e = 0; e < 8; ++e) *(LAS unsigned short*)(Vs + (lch * 8 + e) * KP + p_ * 2) = (unsigned short)(w_[e >> 1] >> ((e & 1) * 16)); }
            if (tid < 64) bias[tid] = breg;
            __syncthreads();
            if (j < jend) gload(j + 1);
            f32x16 p0 = {}, p1 = {};
#pragma unroll
            for (int d0 = 0; d0 < 4; ++d0) {
                const bf16x8 k0 = *(const LAS bf16x8*)(Ks + r32 * KP + d0 * 32 + hi * 16);
                const bf16x8 k1 = *(const LAS bf16x8*)(Ks + (32 + r32) * KP + d0 * 32 + hi * 16);
                p0 = __builtin_amdgcn_mfma_f32_32x32x16_bf16(k0, qr[d0], p0, 0, 0, 0);
                p1 = __builtin_amdgcn_mfma_f32_32x32x16_bf16(k1, qr[d0], p1, 0, 0, 0);
            }
#pragma unroll
            for (int g4 = 0; g4 < 4; ++g4) { const f32x4 b0 = *(const LAS f32x4*)(bias + 8 * g4 + 4 * hi), b1 = *(const LAS f32x4*)(bias + 32 + 8 * g4 + 4 * hi);
#pragma unroll
                for (int i = 0; i < 4; ++i) { p0[4 * g4 + i] += b0[i]; p1[4 * g4 + i] += b1[i]; } }
            if (j >= 4 * qb) {
                const int kb = 64 * j;
#pragma unroll
                for (int r = 0; r < 16; ++r) { const int kv = kb + crow(r, hi); if (kv > qrow) p0[r] = -INFINITY; if (kv + 32 > qrow) p1[r] = -INFINITY; }
            }
            float mloc = fmaxf(p0[0], p1[0]);
#pragma unroll
            for (int r = 1; r < 16; ++r) mloc = fmaxf(mloc, fmaxf(p0[r], p1[r]));
            mloc = fmaxf(mloc, __shfl_xor(mloc, 32));
            const float mnew = fmaxf(m, mloc);
            const float alpha = exp2f(m - mnew);
            float ls = 0.f;
#pragma unroll
            for (int r = 0; r < 16; ++r) { p0[r] = exp2f(p0[r] - mnew); p1[r] = exp2f(p1[r] - mnew); ls += p0[r] + p1[r]; }
            l = l * alpha + ls; m = mnew;
#pragma unroll
            for (int r = 0; r < 16; ++r) { o0[r] *= alpha; o1[r] *= alpha; }
#pragma unroll
            for (int s = 0; s < 4; ++s) {
                u32x4 pw;
                if (s == 0) pw = (u32x4){pk2(p0[0], p0[1]), pk2(p0[2], p0[3]), pk2(p0[4], p0[5]), pk2(p0[6], p0[7])};
                else if (s == 1) pw = (u32x4){pk2(p0[8], p0[9]), pk2(p0[10], p0[11]), pk2(p0[12], p0[13]), pk2(p0[14], p0[15])};
                else if (s == 2) pw = (u32x4){pk2(p1[0], p1[1]), pk2(p1[2], p1[3]), pk2(p1[4], p1[5]), pk2(p1[6], p1[7])};
                else pw = (u32x4){pk2(p1[8], p1[9]), pk2(p1[10], p1[11]), pk2(p1[12], p1[13]), pk2(p1[14], p1[15])};
                const bf16x8 pf = __builtin_bit_cast(bf16x8, pw);
                const bf16x8 v0 = *(const LAS bf16x8*)(Vs + r32 * KP + s * 32 + hi * 16);
                const bf16x8 v1 = *(const LAS bf16x8*)(Vs + (32 + r32) * KP + s * 32 + hi * 16);
                o0 = __builtin_amdgcn_mfma_f32_32x32x16_bf16(v0, pf, o0, 0, 0, 0);
                o1 = __builtin_amdgcn_mfma_f32_32x32x16_bf16(v1, pf, o1, 0, 0, 0);
            }
        }
        l += __shfl_xor(l, 32);
        const float rl = 1.f / l;
#pragma unroll
        for (int dt = 0; dt < 2; ++dt)
#pragma unroll
            for (int g4 = 0; g4 < 4; ++g4) { const int d = 32 * dt + 8 * g4 + 4 * hi; const size_t col = (size_t)h * 64 + d;
                const u32x2 ogw = *(const u32x2*)(QKVG + (size_t)qrow * 4096 + 3 * D + col);
                const float og[4] = {bflo(ogw.x), bfhi(ogw.x), bflo(ogw.y), bfhi(ogw.y)}; float ov[4];
#pragma unroll
                for (int i = 0; i < 4; ++i) ov[i] = (dt == 0 ? o0[4 * g4 + i] : o1[4 * g4 + i]) * rl * sigmoidf_(og[i]);
                u32x2 w; w.x = pk2(ov[0], ov[1]); w.y = pk2(ov[2], ov[3]);
                *(u32x2*)(Z2 + (size_t)qrow * D + col) = w; }
    }
}

struct TokInfo { int e0, e1, p0, p1; float g0, g1; int d0, d1; };
__device__ __forceinline__ void p16_router(Frame& F, const Args& a) {
    const int lane = F.lane, tid = F.tid; const float* Hs = (const float*)(F.ws + WS_H); bf16* U = (bf16*)(F.ws + WS_U4);
    TokInfo* TI = (TokInfo*)(F.ws + WS_TOK);
    LAS float* wr_ = (LAS float*)F.lds;
    LAS int* lcnt = (LAS int*)(F.lds + 32768);
    const Row gr = ld_row(a.in[1] + 3 * D, lane);
    __syncthreads();
    for (int i = tid; i < NE * D; i += NTHREADS) { const int e = i & 7, k = i >> 3; wr_[e * D + k] = a.in[26][(size_t)k * NE + e]; }
    for (int tb = F.vcu * 64; tb < T; tb += F.G * 64) {
        __syncthreads();
        if (tid < 16) lcnt[tid] = 0;
        __syncthreads();
        int e0s[8], e1s[8], p0s[8], p1s[8]; float g0s[8];
#pragma unroll
        for (int q = 0; q < 8; ++q) { const int t = tb + F.wave * 8 + q;
            const Row u = rmsnorm_row(ld_row(Hs + (size_t)t * D, lane), gr);
            st_row_bf16(U + (size_t)t * D, lane, u);
            float lg[NE];
#pragma unroll
            for (int e = 0; e < NE; ++e) { float s = 0.f;
#pragma unroll
                for (int j = 0; j < 4; ++j) { const f32x4 w = *(const LAS f32x4*)(wr_ + e * D + 256 * j + 4 * lane); s += (u.v[j][0] * w[0] + u.v[j][1] * w[1]) + (u.v[j][2] * w[2] + u.v[j][3] * w[3]); }
                lg[e] = wave_sum(s); }
            int b0 = 0; float v0 = lg[0];
#pragma unroll
            for (int e = 1; e < NE; ++e) if (lg[e] > v0) { v0 = lg[e]; b0 = e; }
            int b1 = -1; float v1 = -INFINITY;
#pragma unroll
            for (int e = 0; e < NE; ++e) if (e != b0 && lg[e] > v1) { v1 = lg[e]; b1 = e; }
            e0s[q] = b0; e1s[q] = b1; g0s[q] = 1.f / (1.f + __expf(v1 - v0));
            int pa = 0, pb = 0;
            if (lane == 0) { pa = atomicAdd((int*)&lcnt[b0], 1); pb = atomicAdd((int*)&lcnt[b1], 1); }
            p0s[q] = pa; p1s[q] = pb;
        }
        __syncthreads();
        if (tid < NE) lcnt[8 + tid] = (int)__hip_atomic_fetch_add(F.ctl + CW_CNT + 64 * tid, (unsigned)lcnt[tid], RLX_AGENT);
        __syncthreads();
        if (lane == 0) {
#pragma unroll
            for (int q = 0; q < 8; ++q) { const int t = tb + F.wave * 8 + q; TokInfo ti; ti.e0 = e0s[q]; ti.e1 = e1s[q]; ti.p0 = lcnt[8 + e0s[q]] + p0s[q]; ti.p1 = lcnt[8 + e1s[q]] + p1s[q];
                ti.g0 = g0s[q]; ti.g1 = 1.f - g0s[q]; ti.d0 = 0; ti.d1 = 0; TI[t] = ti; }
        }
    }
    __syncthreads();
}
__device__ __forceinline__ int moe_ends(Frame& F, LAS int* ends) {
    __syncthreads();
    if (F.tid == 0) { int run = 0; for (int e = 0; e < NE; ++e) { const int c = (int)__hip_atomic_load(F.ctl + CW_CNT + 64 * e, RLX_AGENT); run += (c + 255) >> 8; ends[e] = run; } }
    __syncthreads();
    return ends[NE - 1];
}
__device__ __forceinline__ void p17_gather(Frame& F) {
    LAS int* ends = (LAS int*)(F.lds + RING_BYTES);
    moe_ends(F, ends);
    const bf16* U = (const bf16*)(F.ws + WS_U4); bf16* AM = (bf16*)(F.ws + WS_AM); TokInfo* TI = (TokInfo*)(F.ws + WS_TOK);
    for (int t = F.gw; t < T; t += F.NGW) {
        const TokInfo ti = TI[t];
        const int d0 = (ti.e0 ? ends[ti.e0 - 1] : 0) * 256 + ti.p0, d1 = (ti.e1 ? ends[ti.e1 - 1] : 0) * 256 + ti.p1;
        const u32x4* src = (const u32x4*)(U + (size_t)t * D) + F.lane; const u32x4 x0 = src[0], x1 = src[64];
        u32x4* o0 = (u32x4*)(AM + (size_t)d0 * D) + F.lane; o0[0] = x0; o0[64] = x1;
        u32x4* o1 = (u32x4*)(AM + (size_t)d1 * D) + F.lane; o1[0] = x0; o1[64] = x1;
        if (F.lane == 0) { TI[t].d0 = d0; TI[t].d1 = d1; }
    }
}
__device__ __forceinline__ void p20_combine(Frame& F, const Args& a) {
    const int lane = F.lane; const float* Hs = (const float*)(F.ws + WS_H); const bf16* YS = (const bf16*)(F.ws + WS_YS); const TokInfo* TI = (const TokInfo*)(F.ws + WS_TOK);
    const Row gr = ld_row(a.in[2], lane);
    for (int t = F.gw; t < T; t += F.NGW) {
        const TokInfo ti = TI[t];
        Row hrow = ld_row(Hs + (size_t)t * D, lane); const Row y0 = ld_row_bf16(YS + (size_t)ti.d0 * D, lane), y1 = ld_row_bf16(YS + (size_t)ti.d1 * D, lane);
#pragma unroll
        for (int j = 0; j < 4; ++j) hrow.v[j] = hrow.v[j] + ti.g0 * y0.v[j] + ti.g1 * y1.v[j];
        st_row(a.out + (size_t)t * D, lane, rmsnorm_row(hrow, gr));
    }
}

constexpr int N_PHASES = 21;
__global__ void __launch_bounds__(NTHREADS, 2) trunk_fwd(Args args) {
    extern __shared__ __attribute__((aligned(16))) unsigned char lds_raw[];
    Frame F;
    F.lds = (LAS unsigned char*)lds_raw; F.ws = args.ws; F.ctl = (gu32*)(args.ws + WS_CTL);
    F.tid = threadIdx.x; F.lane = F.tid & 63; F.wave = __builtin_amdgcn_readfirstlane(F.tid >> 6);
    F.G = gridDim.x; { const int bx = blockIdx.x; F.vcu = (F.G % 8 == 0) ? (bx % 8) * (F.G / 8) + bx / 8 : bx; }
    F.gw = F.vcu * NWAVES + F.wave; F.NGW = F.G * NWAVES;
    volatile LAS unsigned* MISC = (volatile LAS unsigned*)(F.lds + MISC_OFF);
    for (int u = F.tid; u < (LDS_BYTES - RING_BYTES) / 4; u += NTHREADS) ((LAS unsigned*)(F.lds + RING_BYTES))[u] = 0u;
    __syncthreads();
    const int lo = args.ph_lo, hi = args.ph_hi;
    const bool use_bar = (hi - lo) > 1;
    XcdBarrier bar; bar.bar = (unsigned*)(F.ctl + CW_BAR); bar.x = 0; bar.st = nullptr;
    if (use_bar) bar = xcd_barrier_post((unsigned*)(F.ctl + CW_BAR), MISC + 8);
#ifdef ONLY_PHASE
#define IN(k) ((k) == ONLY_PHASE && lo <= (k) && (k) < hi)
#else
#define IN(k) (lo <= (k) && (k) < hi)
#endif
#define SEAM(k) do { if (IN((k) + 1)) xcd_barrier(bar); } while (0)
    unsigned char* ws = args.ws;
    const int c = (int)blockIdx.x;
    LAS unsigned char* ring = F.lds;

    if (IN(0)) { p0_prologue(F, args); if (DUP_PHASE == 0) { xcd_barrier(bar); p0_prologue(F, args); } p1_shift(F, args); SEAM(0); }
    if (IN(1)) {
        { pg8::Gemm g{D, D, D}; pg8::SchedRKV S; S.o.init(T / 256, 12, F.G, c); S.A = (const char*)(ws + WS_XS); S.B = (const char*)(ws + WS_W_RKV); S.astep = (size_t)256 * D * 2; S.bstep = (size_t)256 * D * 2; S.azstride = (size_t)T * D * 2;
          pg8::EpiRKV E{(float*)(ws + WS_R), (size_t)T * D};
          pg8::gemm_phase<pg8::EpiRKV, pg8::SchedRKV, true>(ring, g, S, E); }
        { pg8::Gemm g{D, 2 * D, 2 * D}; pg8::SchedPlain S; S.o.init(T / 256, 1, F.G, c); S.A = (const char*)(ws + WS_UB); S.B = (const char*)(ws + WS_W_L1); S.astep = (size_t)256 * D * 2; S.bstep = (size_t)256 * 2 * D * 2;
          pg8::EpiL1 E{(bf16*)(ws + WS_L1)};
          pg8::gemm_phase<pg8::EpiL1, pg8::SchedPlain, true>(ring, g, S, E); }
        SEAM(1); }
    if (IN(2)) {
        pg8::Gemm g{256, 256, 256}; pg8::SchedPlain S; S.o.init(T / 256, 12, F.G, c); S.A = (const char*)(ws + WS_L1); S.B = (const char*)(ws + WS_W_L2); S.astep = (size_t)256 * 256 * 2; S.bstep = (size_t)256 * 256 * 2;
        static_assert(WS_AA - WS_LW == WS_G - WS_AA, "LW, AA, G evenly spaced");
        pg8::EpiL2 E{(float*)(ws + WS_LW), args.in[5], args.in[8]};
        pg8::gemm_phase<pg8::EpiL2, pg8::SchedPlain, true>(ring, g, S, E);
        SEAM(2); }
    if (IN(3)) { p3_prep(F, args); if (DUP_PHASE == 3) { xcd_barrier(bar); p3_prep(F, args); } SEAM(3); }
    if (IN(4)) { pa_chunk(F); if (DUP_PHASE == 4) { xcd_barrier(bar); pa_chunk(F); } SEAM(4); }
    if (IN(5)) { pb_chain(F); if (DUP_PHASE == 5) { xcd_barrier(bar); pb_chain(F); } SEAM(5); }
    if (IN(6)) { pc_out(F); if (DUP_PHASE == 6) { xcd_barrier(bar); pc_out(F); } SEAM(6); }
    if (IN(7)) { p6_gn_rows(F, args); if (DUP_PHASE == 7) { xcd_barrier(bar); p6_gn_rows(F, args); } SEAM(7); }
    if (IN(8)) {
        pg8::Gemm g{D, D, D}; pg8::SchedPlain S; S.o.init(T / 256, 4, F.G, c); S.A = (const char*)(ws + WS_Z); S.B = (const char*)(ws + WS_W_O0); S.astep = (size_t)256 * D * 2; S.bstep = (size_t)256 * D * 2;
        pg8::EpiRes E{args.in[0], (float*)(ws + WS_H)};
        pg8::gemm_phase<pg8::EpiRes, pg8::SchedPlain, true>(ring, g, S, E);
        SEAM(8); }
    if (IN(9)) { p8_norm(F, args.in[1] + D, (bf16*)(ws + WS_U2)); SEAM(9); }
    if (IN(10)) {
        pg8::Gemm g{D, D, D}; pg8::SchedPlain S; S.o.init(T / 256, 2 * FF / 256, F.G, c); S.A = (const char*)(ws + WS_U2); S.B = (const char*)(ws + WS_W_GU); S.astep = (size_t)256 * D * 2; S.bstep = (size_t)256 * D * 2;
        pg8::EpiSwiGLU E{(bf16*)(ws + WS_ACT)};
        pg8::gemm_phase<pg8::EpiSwiGLU, pg8::SchedPlain, true>(ring, g, S, E);
        SEAM(10); }
    if (IN(11)) {
        pg8::Gemm g{FF, FF, FF}; pg8::SchedPlain S; S.o.init(T / 256, 4, F.G, c); S.A = (const char*)(ws + WS_ACT); S.B = (const char*)(ws + WS_W_DN); S.astep = (size_t)256 * FF * 2; S.bstep = (size_t)256 * FF * 2;
        pg8::EpiRes E{(const float*)(ws + WS_H), (float*)(ws + WS_H)};
        pg8::gemm_phase<pg8::EpiRes, pg8::SchedPlain, true>(ring, g, S, E);
        SEAM(11); }
    if (IN(12)) { p11_norm_forget(F, args); SEAM(12); }
    if (IN(13)) {
        pg8::Gemm g{D, D, D}; pg8::SchedPlain S; S.o.init(T / 256, 16, F.G, c); S.A = (const char*)(ws + WS_U3); S.B = (const char*)(ws + WS_W_IN); S.astep = (size_t)256 * D * 2; S.bstep = (size_t)256 * D * 2;
        pg8::EpiBf16 E{(bf16*)(ws + WS_QKVG), 4096};
        pg8::gemm_phase<pg8::EpiBf16, pg8::SchedPlain, true>(ring, g, S, E);
        SEAM(13); }
    if (IN(14)) { p13_cumsum_qknorm(F, args); SEAM(14); }
    if (IN(15)) { p14_attention(F, args); if (DUP_PHASE == 15) { xcd_barrier(bar); p14_attention(F, args, CW_ATTQ + 64); } SEAM(15); }
    if (IN(16)) {
        pg8::Gemm g{D, D, D}; pg8::SchedPlain S; S.o.init(T / 256, 4, F.G, c); S.A = (const char*)(ws + WS_Z2); S.B = (const char*)(ws + WS_W_FO); S.astep = (size_t)256 * D * 2; S.bstep = (size_t)256 * D * 2;
        pg8::EpiRes E{(const float*)(ws + WS_H), (float*)(ws + WS_H)};
        pg8::gemm_phase<pg8::EpiRes, pg8::SchedPlain, true>(ring, g, S, E);
        SEAM(16); }
    if (IN(17)) { p16_router(F, args); SEAM(17); }
    if (IN(18)) { p17_gather(F); SEAM(18); }
    if (IN(19)) {
        LAS int* ends = (LAS int*)(F.lds + RING_BYTES); const int nblk = moe_ends(F, ends);
        pg8::Gemm g{D, D, D}; pg8::SchedMoe S; S.o.init(nblk, 2 * FF / 256, F.G, c); S.A = (const char*)(ws + WS_AM); S.B = (const char*)(ws + WS_W_MGU); S.astep = (size_t)256 * D * 2; S.bstep = (size_t)256 * D * 2; S.bestride = (size_t)2 * FF * D * 2; S.ends = ends;
        pg8::EpiSwiGLU E{(bf16*)(ws + WS_ACT2)};
        pg8::gemm_phase<pg8::EpiSwiGLU, pg8::SchedMoe, true>(ring, g, S, E);
        SEAM(19); }
    if (IN(20)) {
        LAS int* ends = (LAS int*)(F.lds + RING_BYTES); const int nblk = moe_ends(F, ends);
        pg8::Gemm g{FF, FF, FF}; pg8::SchedMoe S; S.o.init(nblk, 4, F.G, c); S.A = (const char*)(ws + WS_ACT2); S.B = (const char*)(ws + WS_W_MDN); S.astep = (size_t)256 * FF * 2; S.bstep = (size_t)256 * FF * 2; S.bestride = (size_t)D * FF * 2; S.ends = ends;
        pg8::EpiBf16 E{(bf16*)(ws + WS_YS), D};
        pg8::gemm_phase<pg8::EpiBf16, pg8::SchedMoe, true>(ring, g, S, E);
        SEAM(20); }
    if (IN(21)) { p20_combine(F, args); }
#undef IN
#undef SEAM
}

extern "C" void kernel_launch(void* const* d_in, const int* in_sizes, int n_in, void* d_out, int out_size, void* d_ws, size_t ws_size, hipStream_t stream) {
    static int grid = 0;
    if (grid == 0) {
        if (n_in != 29 || out_size != T * D || ws_size < WS_END) { fprintf(stderr, "kernel_launch: unexpected problem (n_in %d out %d ws %zu)\n", n_in, out_size, ws_size); grid = -1; return; }
        int dev = 0, cus = 0;
        if (hipGetDevice(&dev) != hipSuccess || hipDeviceGetAttribute(&cus, hipDeviceAttributeMultiprocessorCount, dev) != hipSuccess) { grid = -1; return; }
        if (hipFuncSetAttribute((const void*)trunk_fwd, hipFuncAttributeMaxDynamicSharedMemorySize, LDS_BYTES) != hipSuccess) { fprintf(stderr, "kernel_launch: hipFuncSetAttribute failed\n"); grid = -1; return; }
        int per_cu = 0;
        if (hipOccupancyMaxActiveBlocksPerMultiprocessor(&per_cu, (const void*)trunk_fwd, NTHREADS, LDS_BYTES) != hipSuccess || per_cu < 1) fprintf(stderr, "kernel_launch: occupancy query says %d\n", per_cu);
        (void)hipGetLastError();
        grid = cus;
    }
    if (grid < 0) return;
    (void)hipMemsetAsync((char*)d_ws + WS_CTL, 0, CTL_ZERO_BYTES, stream);
    Args a{};
    for (int i = 0; i < 29; ++i) a.in[i] = (const float*)d_in[i];
    a.out = (float*)d_out; a.ws = (unsigned char*)d_ws;
    constexpr int NPH = 22;
    if (LAUNCH_MODE == 1) { a.ph_lo = 0; a.ph_hi = NPH; hipLaunchKernelGGL(trunk_fwd, dim3(grid), dim3(NTHREADS), LDS_BYTES, stream, a); }
    else for (int p = 0; p < NPH; ++p) { a.ph_lo = p; a.ph_hi = p + 1; hipLaunchKernelGGL(trunk_fwd, dim3(grid), dim3(NTHREADS), LDS_BYTES, stream, a); }
}
```

```cpp
#include <hip/hip_runtime.h>
#include <cstdio>
#include <cstdint>

#ifndef DUP_PHASE
#define DUP_PHASE -1
#endif
#ifndef LAUNCH_MODE
#define LAUNCH_MODE 1
#endif

#define GAS __attribute__((address_space(1)))
#define LAS __attribute__((address_space(3)))
typedef unsigned short bf16;
typedef short bf16x8 __attribute__((ext_vector_type(8)));
typedef float f32x4 __attribute__((ext_vector_type(4)));
typedef float f32x2 __attribute__((ext_vector_type(2)));
typedef float f32x16 __attribute__((ext_vector_type(16)));
typedef unsigned u32x4 __attribute__((ext_vector_type(4)));
typedef unsigned u32x2 __attribute__((ext_vector_type(2)));
typedef GAS unsigned gu32;
#define RLX_AGENT __ATOMIC_RELAXED, __HIP_MEMORY_SCOPE_AGENT

constexpr int T = 16384, D = 1024, NH = 16, HD = 64, FF = 3584, NE = 8, WIN_LD = 4 * D + NH;
constexpr int NWAVES = 8, NTHREADS = 512;
constexpr float RMS_EPS = 1e-6f, GN_EPS = 64e-5f;
constexpr int MOE_ROWS = (2 * T / 256 + NE) * 256;
constexpr float LOG2E = 1.4426950408889634f;

constexpr size_t MiB = 1u << 20;
constexpr size_t WS_CTL = 0, CTL_ZERO_BYTES = 1 * MiB;
constexpr size_t WS_W_RKV = 2 * MiB, WS_W_L1 = 8 * MiB, WS_W_L2 = 9 * MiB, WS_W_O0 = 11 * MiB, WS_W_GU = 13 * MiB, WS_W_DN = 27 * MiB,
                 WS_W_IN = 34 * MiB, WS_W_FO = 42 * MiB, WS_W_MGU = 44 * MiB, WS_W_MDN = 156 * MiB;
constexpr size_t WS_H = 216 * MiB;
constexpr size_t WS_UB = 280 * MiB, WS_XS = 313 * MiB;
constexpr size_t WS_KK = 280 * MiB, WS_BB = 344 * MiB;
constexpr size_t WS_Z = 280 * MiB, WS_U2 = 344 * MiB;
constexpr size_t WS_U3 = 280 * MiB, WS_Z2 = 312 * MiB, WS_U4 = 280 * MiB, WS_AM = 312 * MiB;
constexpr size_t WS_R = 410 * MiB, WS_K = 474 * MiB, WS_V = 538 * MiB;
constexpr size_t WS_ACT = 410 * MiB;
constexpr size_t WS_QKVG = 410 * MiB;
constexpr size_t WS_ACT2 = 410 * MiB;
constexpr size_t WS_LW = 602 * MiB, WS_AA = 666 * MiB, WS_G = 730 * MiB;
constexpr size_t WS_YT = 666 * MiB;
constexpr size_t WS_YS = 666 * MiB;
constexpr size_t WS_L1 = 794 * MiB;
constexpr size_t WS_CS = 802 * MiB;
constexpr size_t WS_LF = 806 * MiB, WS_C2 = 807 * MiB, WS_CB = 808 * MiB, WS_TOK = 809 * MiB;
constexpr size_t WS_END = 810 * MiB;
constexpr size_t WS_AT = 280 * MiB, WS_RT = 312 * MiB, WS_BH = 344 * MiB, WS_KH = 376 * MiB;
constexpr size_t WS_V16 = 538 * MiB  , WS_GC = 248 * MiB;
constexpr size_t WS_QM = 410 * MiB, WS_PLR = 474 * MiB, WS_TM = 506 * MiB, WS_S0 = 570 * MiB;
constexpr size_t WS_Y = 602 * MiB;
constexpr int NCH = T / 64;
constexpr int CW_TMO = 0, CW_BAR = 4096, CW_CNT = 8192, CW_ATTQ = 9216;

constexpr int RING_BYTES = 131072, MISC_OFF = RING_BYTES + 320, LDS_BYTES = 147456;

__device__ __forceinline__ unsigned f2bf(float f) { unsigned u = __builtin_bit_cast(unsigned, f); return (u + 0x7fffu + ((u >> 16) & 1u)) >> 16; }
__device__ __forceinline__ unsigned pk2(float lo, float hi) { return f2bf(lo) | (f2bf(hi) << 16); }
__device__ __forceinline__ float bf2f(unsigned short b) { return __builtin_bit_cast(float, (unsigned)b << 16); }
__device__ __forceinline__ float bflo(unsigned w) { return __builtin_bit_cast(float, w << 16); }
__device__ __forceinline__ float bfhi(unsigned w) { return __builtin_bit_cast(float, w & 0xffff0000u); }
__device__ __forceinline__ float wave_sum(float v) {
#pragma unroll
    for (int o = 1; o < 64; o <<= 1) v += __shfl_xor(v, o);
    return v;
}
__device__ __forceinline__ float row16_sum(float v) {
#pragma unroll
    for (int o = 1; o < 16; o <<= 1) v += __shfl_xor(v, o);
    return v;
}
__device__ __forceinline__ float sigmoidf_(float x) { return 1.f / (1.f + __expf(-x)); }
#define LDS_WAIT() asm volatile("s_waitcnt lgkmcnt(0)" ::: "memory")
__device__ __forceinline__ int crow(int r, int hi) { return (r & 3) + 8 * (r >> 2) + 4 * hi; }

namespace pg8 {
constexpr int BM = 256, BK = 64, HALF = 128, HTB = HALF * BK * 2, STAGE_BYTES = 8 * HTB, NXCD = 8, WGM = 8;
__host__ __device__ __forceinline__ int lds_byte(int r, int c) { const int st = (r >> 4) * 2 + (c >> 5), rr = r & 15, cc = c & 31, ob = rr * 64 + cc * 2; return st * 1024 + (ob ^ (((ob >> 9) & 1) << 5)); }
__host__ __device__ __forceinline__ void stage_rc(int b, int& R, int& C) { const int st = b / 1024, sb = b % 1024, swz = sb ^ (((sb >> 9) & 1) << 5); R = (st >> 1) * 16 + swz / 64; C = (st & 1) * 32 + (swz % 64) / 2; }
__host__ __device__ __forceinline__ int perm32(int rho) { const int n = rho >> 4, i = rho & 15; return 8 * (i >> 2) + 4 * n + (i & 3); }

struct Unit { int pm, pn; };
struct Gemm { int lda, ldb, K; };

struct TileOrder {
    int nM, nN, nwg, G, c;
    __device__ __forceinline__ void init(int nM_, int nN_, int G_, int c_) { nM = nM_; nN = nN_; nwg = nM * nN; G = G_; c = c_; }
    __device__ __forceinline__ bool tile(int i, Unit& u) const {
        const long L = (long)i * G + c; if (L >= nwg) return false;
        int wgid = (int)L; { const int q = nwg / NXCD, r = nwg % NXCD, xcd = wgid % NXCD, off = wgid / NXCD; wgid = (xcd < r ? xcd * (q + 1) : r * (q + 1) + (xcd - r) * q) + off; }
        const int nig = WGM * nN, gid = wgid / nig, fm = gid * WGM, gsz = (nM - fm) < WGM ? (nM - fm) : WGM;
        u.pm = fm + ((wgid % nig) % gsz); u.pn = (wgid % nig) / gsz; return true;
    }
};

__device__ __forceinline__ unsigned cvt_pk_bf16(float lo, float hi) { unsigned r; asm volatile("v_cvt_pk_bf16_f32 %0, %1, %2" : "=v"(r) : "v"(lo), "v"(hi)); return r; }

template <class Epi, class Sched, bool ALIGN_EPI>
__device__ __forceinline__ void gemm_phase(LAS unsigned char* lds, const Gemm g, const Sched& S, const Epi& E) {
    const int tid = threadIdx.x, wid = __builtin_amdgcn_readfirstlane(tid >> 6), lane = tid & 63, wr = wid >> 2, wc = wid & 3, fr = lane & 15, fq = lane >> 4;
    const int K = g.K, nt = K / BK;
    unsigned voffA[2], voffB[2];
#pragma unroll
    for (int i = 0; i < 2; ++i) { int R, C; stage_rc(tid * 16 + i * 8192, R, C); const int Rb = Epi::PERM ? ((R & ~31) + perm32(R & 31)) : R;
        voffA[i] = (unsigned)(R * g.lda + C) * 2u; voffB[i] = (unsigned)(Rb * g.ldb + C) * 2u; }
    const size_t kstep = (size_t)(BK * 2);
    const size_t hstepA = (size_t)HALF * g.lda * 2, hstepB = (size_t)HALF * g.ldb * 2;
    const unsigned ldsw = (unsigned)wid * 1024u;
    const int aoff = lds_byte(wr * 64 + fr, fq * 8), boff = lds_byte(wc * 32 + fr, fq * 8);
#define PG8_SA(b, h) (((b) * 2 + (h)) * HTB)
#define PG8_SB(b, h) ((4 + (b) * 2 + (h)) * HTB)
#define PG8_STAGE(bufoff, gbase, voff) do { _Pragma("unroll") for (int _i = 0; _i < 2; ++_i) \
        __builtin_amdgcn_global_load_lds((const unsigned*)((const char*)(gbase) + (voff)[_i]), (LAS unsigned*)(lds + (bufoff) + ldsw + _i * 8192), 16, 0, 0); } while (0)
#define PG8_LDA(dst, b, h) do { _Pragma("unroll") for (int m = 0; m < 4; ++m) _Pragma("unroll") for (int k = 0; k < 2; ++k) dst[m][k] = *(const LAS bf16x8*)(lds + PG8_SA(b, h) + aoff + m * 2048 + k * 1024); } while (0)
#define PG8_LDB(dst, b, h) do { _Pragma("unroll") for (int n = 0; n < 2; ++n) _Pragma("unroll") for (int k = 0; k < 2; ++k) dst[n][k] = *(const LAS bf16x8*)(lds + PG8_SB(b, h) + boff + n * 2048 + k * 1024); } while (0)
#define PG8_MMA(ai, bj, At, Bt) do { __builtin_amdgcn_s_setprio(1); _Pragma("unroll") for (int m = 0; m < 4; ++m) _Pragma("unroll") for (int n = 0; n < 2; ++n) _Pragma("unroll") for (int k = 0; k < 2; ++k) \
        acc[ai][bj][m][n] = __builtin_amdgcn_mfma_f32_16x16x32_bf16(Bt[n][k], At[m][k], acc[ai][bj][m][n], 0, 0, 0); __builtin_amdgcn_s_setprio(0); } while (0)
#define PG8_WAIT_V(n) asm volatile("s_waitcnt vmcnt(" #n ")" ::: "memory")
#define PG8_WAIT_L(n) asm volatile("s_waitcnt lgkmcnt(" #n ")" ::: "memory")
#define PG8_BAR __builtin_amdgcn_s_barrier()
#define PG8_SCHED __builtin_amdgcn_sched_barrier(0)
    Unit cur, nxt; int ui = 0;
    if (!S.next(0, cur)) return;
    f32x4 acc[2][2][4][2];
#pragma unroll
    for (int a = 0; a < 2; ++a)
#pragma unroll
        for (int b = 0; b < 2; ++b)
#pragma unroll
            for (int m = 0; m < 4; ++m)
#pragma unroll
                for (int n = 0; n < 2; ++n) acc[a][b][m][n] = (f32x4){0.f, 0.f, 0.f, 0.f};
    bf16x8 At[4][2], B0[2][2], B1[2][2];
    const char* cA = S.pa(cur); const char* cB = S.pb(cur);
    PG8_STAGE(PG8_SB(0, 0), cB, voffB); PG8_STAGE(PG8_SB(0, 1), cB + hstepB, voffB); PG8_STAGE(PG8_SA(0, 0), cA, voffA); PG8_STAGE(PG8_SA(0, 1), cA + hstepA, voffA);
    if (wr == 1) PG8_BAR;
    PG8_WAIT_V(2); PG8_BAR;
    PG8_STAGE(PG8_SB(1, 0), cB + kstep, voffB); PG8_STAGE(PG8_SA(1, 0), cA + kstep, voffA); PG8_STAGE(PG8_SB(1, 1), cB + hstepB + kstep, voffB);
    PG8_WAIT_V(6); PG8_BAR;
    for (;;) {
        const bool has_next = S.next(ui + 1, nxt);
        const char* nA = has_next ? S.pa(nxt) : cA; const char* nB = has_next ? S.pb(nxt) : cB;
#pragma clang loop unroll(disable)
        for (int t = 0; t < nt; t += 2) {
            const bool last = (t == nt - 2);
            const char* a1 = cA + (size_t)(t + 1) * kstep;
            const char* a2 = last ? nA : cA + (size_t)(t + 2) * kstep; const char* b2 = last ? nB : cB + (size_t)(t + 2) * kstep;
            const char* a3 = a2 + kstep; const char* b3 = b2 + kstep;
            PG8_LDB(B0, 0, 0); PG8_LDB(B1, 0, 1); PG8_SCHED; PG8_LDA(At, 0, 0); PG8_STAGE(PG8_SA(1, 1), a1 + hstepA, voffA);
            PG8_WAIT_V(8); PG8_WAIT_L(0); PG8_BAR; PG8_MMA(0, 0, At, B0); PG8_MMA(0, 1, At, B1); PG8_BAR; PG8_SCHED;
            PG8_LDA(At, 0, 1); PG8_STAGE(PG8_SB(0, 0), b2, voffB); PG8_STAGE(PG8_SB(0, 1), b2 + hstepB, voffB); PG8_STAGE(PG8_SA(0, 0), a2, voffA);
            PG8_WAIT_V(8); PG8_WAIT_L(0); PG8_BAR; PG8_MMA(1, 0, At, B0); PG8_MMA(1, 1, At, B1); PG8_BAR; PG8_SCHED;
            PG8_LDB(B0, 1, 0); PG8_LDB(B1, 1, 1); PG8_SCHED; PG8_LDA(At, 1, 0); PG8_STAGE(PG8_SA(0, 1), a2 + hstepA, voffA);
            PG8_WAIT_V(8); PG8_WAIT_L(0); PG8_BAR; PG8_MMA(0, 0, At, B0); PG8_MMA(0, 1, At, B1); PG8_BAR; PG8_SCHED;
            PG8_LDA(At, 1, 1); PG8_STAGE(PG8_SB(1, 0), b3, voffB); PG8_STAGE(PG8_SB(1, 1), b3 + hstepB, voffB); PG8_STAGE(PG8_SA(1, 0), a3, voffA);
            PG8_WAIT_V(8); PG8_WAIT_L(0); PG8_BAR; PG8_MMA(1, 0, At, B0); PG8_MMA(1, 1, At, B1); PG8_BAR; PG8_SCHED;
        }
        if constexpr (ALIGN_EPI) { if (wr == 0) PG8_BAR; }
        E(acc, cur, wr, wc, fr, fq);
        if (!has_next) break;
#pragma unroll
        for (int a = 0; a < 2; ++a)
#pragma unroll
            for (int b = 0; b < 2; ++b)
#pragma unroll
                for (int m = 0; m < 4; ++m)
#pragma unroll
                    for (int n = 0; n < 2; ++n) acc[a][b][m][n] = (f32x4){0.f, 0.f, 0.f, 0.f};
        cur = nxt; cA = nA; cB = nB; ++ui;
        if constexpr (ALIGN_EPI) { if (wr == 1) PG8_BAR; }
    }
    PG8_WAIT_V(0);
    if constexpr (!ALIGN_EPI) { if (wr == 0) PG8_BAR; }
    PG8_BAR;
#undef PG8_SA
#undef PG8_SB
#undef PG8_STAGE
#undef PG8_LDA
#undef PG8_LDB
#undef PG8_MMA
#undef PG8_WAIT_V
#undef PG8_WAIT_L
#undef PG8_BAR
#undef PG8_SCHED
}

typedef const f32x4 (&AccRef)[2][2][4][2];

struct SchedPlain {
    TileOrder o; const char* A; const char* B; size_t astep, bstep;
    __device__ __forceinline__ bool next(int i, Unit& u) const { return o.tile(i, u); }
    __device__ __forceinline__ const char* pa(const Unit& u) const { return A + (size_t)u.pm * astep; }
    __device__ __forceinline__ const char* pb(const Unit& u) const { return B + (size_t)u.pn * bstep; }
};
struct SchedRKV {
    TileOrder o; const char* A; const char* B; size_t astep, bstep, azstride;
    __device__ __forceinline__ bool next(int i, Unit& u) const { return o.tile(i, u); }
    __device__ __forceinline__ const char* pa(const Unit& u) const { return A + (size_t)(u.pn >> 2) * azstride + (size_t)u.pm * astep; }
    __device__ __forceinline__ const char* pb(const Unit& u) const { return B + (size_t)u.pn * bstep; }
};
struct SchedMoe {
    TileOrder o; const char* A; const char* B; size_t astep, bstep, bestride; const LAS int* ends;
    __device__ __forceinline__ bool next(int i, Unit& u) const { return o.tile(i, u); }
    __device__ __forceinline__ int be(int pm) const { int e = 0;
#pragma unroll
        for (int j = 0; j < NE - 1; ++j) e += (pm >= ends[j]) ? 1 : 0; return e; }
    __device__ __forceinline__ const char* pa(const Unit& u) const { return A + (size_t)u.pm * astep; }
    __device__ __forceinline__ const char* pb(const Unit& u) const { return B + (size_t)be(u.pm) * bestride + (size_t)u.pn * bstep; }
};

struct EpiRKV {
    static constexpr bool PERM = true;
    bf16* C; size_t zstride;
    __device__ __forceinline__ void operator()(AccRef acc, const Unit& u, int wr, int wc, int fr, int fq) const {
        const int z = u.pn >> 2, pn = u.pn & 3; bf16* base = C + (size_t)z * zstride;
        const int row0 = u.pm * BM + wr * 64 + fr, col0 = pn * BM + wc * 32 + 8 * fq;
#pragma unroll
        for (int ai = 0; ai < 2; ++ai)
#pragma unroll
            for (int m = 0; m < 4; ++m) { bf16* rowp = base + (size_t)(row0 + ai * HALF + m * 16) * D + col0;
#pragma unroll
                for (int bj = 0; bj < 2; ++bj) { const f32x4 v0 = acc[ai][bj][m][0], v1 = acc[ai][bj][m][1];
                    u32x4 w; w.x = cvt_pk_bf16(v0[0], v0[1]); w.y = cvt_pk_bf16(v0[2], v0[3]); w.z = cvt_pk_bf16(v1[0], v1[1]); w.w = cvt_pk_bf16(v1[2], v1[3]);
                    *(u32x4*)(rowp + bj * HALF) = w; } }
    }
};
struct EpiRes {
    static constexpr bool PERM = false;
    const float* base; float* out;
    __device__ __forceinline__ void operator()(AccRef acc, const Unit& u, int wr, int wc, int fr, int fq) const {
        const int row0 = u.pm * BM + wr * 64 + fr, col0 = u.pn * BM + wc * 32 + 4 * fq;
#pragma unroll
        for (int ai = 0; ai < 2; ++ai)
#pragma unroll
            for (int m = 0; m < 4; ++m) { const size_t off = (size_t)(row0 + ai * HALF + m * 16) * D + col0;
#pragma unroll
                for (int bj = 0; bj < 2; ++bj)
#pragma unroll
                    for (int n = 0; n < 2; ++n) { const f32x4 b = *(const f32x4*)(base + off + bj * HALF + n * 16); *(f32x4*)(out + off + bj * HALF + n * 16) = b + acc[ai][bj][m][n]; } }
    }
};
struct EpiL1 {
    static constexpr bool PERM = true;
    bf16* O;
    __device__ __forceinline__ void operator()(AccRef acc, const Unit& u, int wr, int wc, int fr, int fq) const {
        const int row0 = u.pm * BM + wr * 64 + fr, col0 = wc * 32 + 8 * fq;
#pragma unroll
        for (int ai = 0; ai < 2; ++ai)
#pragma unroll
            for (int m = 0; m < 4; ++m) { bf16* rowp = O + (size_t)(row0 + ai * HALF + m * 16) * 256 + col0;
#pragma unroll
                for (int bj = 0; bj < 2; ++bj) { float v[8];
#pragma unroll
                    for (int i = 0; i < 4; ++i) { v[i] = acc[ai][bj][m][0][i]; v[4 + i] = acc[ai][bj][m][1][i]; }
#pragma unroll
                    for (int i = 0; i < 8; ++i) { if (bj == 1) v[i] = sigmoidf_(v[i]); else if (wc < 2) v[i] = tanhf(v[i]); }
                    u32x4 w; w.x = cvt_pk_bf16(v[0], v[1]); w.y = cvt_pk_bf16(v[2], v[3]); w.z = cvt_pk_bf16(v[4], v[5]); w.w = cvt_pk_bf16(v[6], v[7]);
                    *(u32x4*)(rowp + bj * HALF) = w; } }
    }
};
struct EpiL2 {
    static constexpr bool PERM = false;
    float* LW; const float* w0; const float* a0;
    __device__ __forceinline__ void operator()(AccRef acc, const Unit& u, int wr, int wc, int fr, int fq) const {
        const int z = u.pn >> 2, pn = u.pn & 3; float* base = LW + (size_t)z * ((WS_AA - WS_LW) / 4); const float* bias = z == 0 ? w0 : a0;
        const float mul = z == 0 ? -0.6065306597126334f : 1.f;
        const int row0 = u.pm * BM + wr * 64 + fr, col0 = pn * BM + wc * 32 + 4 * fq;
#pragma unroll
        for (int bj = 0; bj < 2; ++bj)
#pragma unroll
            for (int n = 0; n < 2; ++n) { const int c = col0 + bj * HALF + n * 16;
                const f32x4 bv = *(const f32x4*)(bias + c);
#pragma unroll
                for (int ai = 0; ai < 2; ++ai)
#pragma unroll
                    for (int m = 0; m < 4; ++m) { f32x4 v = acc[ai][bj][m][n];
                        if (z < 2) { v = v + bv;
#pragma unroll
                            for (int i = 0; i < 4; ++i) v[i] = mul * __builtin_amdgcn_rcpf(1.f + __expf(-v[i])); }
                        *(f32x4*)(base + (size_t)(row0 + ai * HALF + m * 16) * D + c) = v; } }
    }
};
struct EpiSwiGLU {
    static constexpr bool PERM = true;
    bf16* O;
    __device__ __forceinline__ void operator()(AccRef acc, const Unit& u, int wr, int wc, int fr, int fq) const {
        const int row0 = u.pm * BM + wr * 64 + fr, col0 = u.pn * HALF + wc * 32 + 8 * fq;
#pragma unroll
        for (int ai = 0; ai < 2; ++ai)
#pragma unroll
            for (int m = 0; m < 4; ++m) { float v[8];
#pragma unroll
                for (int n = 0; n < 2; ++n)
#pragma unroll
                    for (int i = 0; i < 4; ++i) { const float gt = acc[ai][0][m][n][i], up = acc[ai][1][m][n][i]; v[4 * n + i] = gt * sigmoidf_(gt) * up; }
                u32x4 w; w.x = cvt_pk_bf16(v[0], v[1]); w.y = cvt_pk_bf16(v[2], v[3]); w.z = cvt_pk_bf16(v[4], v[5]); w.w = cvt_pk_bf16(v[6], v[7]);
                *(u32x4*)(O + (size_t)(row0 + ai * HALF + m * 16) * FF + col0) = w; }
    }
};
struct EpiBf16 {
    static constexpr bool PERM = true;
    bf16* O; int ldc;
    __device__ __forceinline__ void operator()(AccRef acc, const Unit& u, int wr, int wc, int fr, int fq) const {
        const int row0 = u.pm * BM + wr * 64 + fr, col0 = u.pn * BM + wc * 32 + 8 * fq;
#pragma unroll
        for (int ai = 0; ai < 2; ++ai)
#pragma unroll
            for (int m = 0; m < 4; ++m) { bf16* rowp = O + (size_t)(row0 + ai * HALF + m * 16) * ldc + col0;
#pragma unroll
                for (int bj = 0; bj < 2; ++bj) { const f32x4 v0 = acc[ai][bj][m][0], v1 = acc[ai][bj][m][1];
                    u32x4 w; w.x = cvt_pk_bf16(v0[0], v0[1]); w.y = cvt_pk_bf16(v0[2], v0[3]); w.z = cvt_pk_bf16(v1[0], v1[1]); w.w = cvt_pk_bf16(v1[2], v1[3]);
                    *(u32x4*)(rowp + bj * HALF) = w; } }
    }
};
}

#define XB_TMO      128
#define XB_XCNT(j)  (256  + 64 * (j))
#define XB_XSUB(j)  (1280 + 64 * (j))
#define XB_XGEN(j)  (2304 + 64 * (j))
#define XB_TOP      3328
#define XB_TOPGEN   3392
#define XCD_BAR_WORDS 3456
#define XB_SPIN_CAP (1u << 18)
__device__ __forceinline__ unsigned xb_ld(unsigned* p)              { return __hip_atomic_load(p, __ATOMIC_RELAXED, __HIP_MEMORY_SCOPE_AGENT); }
__device__ __forceinline__ unsigned xb_add(unsigned* p, unsigned v) { return __hip_atomic_fetch_add(p, v, __ATOMIC_RELAXED, __HIP_MEMORY_SCOPE_AGENT); }
__device__ __forceinline__ unsigned xb_xcc_id() { return (unsigned)__builtin_amdgcn_s_getreg((3 << 11) | 20) & 0xFu; }
#define XB_SPIN(cond, bar) do { unsigned _sp = 0; while (cond) { __builtin_amdgcn_s_sleep(1); \
    if ((++_sp & 255u) == 0u) { if (xb_ld(&(bar)[XB_TMO])) break; if (_sp > XB_SPIN_CAP) { atomicAdd(&(bar)[XB_TMO], 1u); break; } } } } while (0)
struct XcdBarrier { unsigned* bar; unsigned x; volatile LAS unsigned* st; };
__device__ __forceinline__ XcdBarrier xcd_barrier_post(unsigned* bar, volatile LAS unsigned* st) {
    XcdBarrier b; b.bar = bar; b.x = xb_xcc_id(); b.st = st;
    if (threadIdx.x == 0) (void)xb_add(&bar[XB_XCNT(b.x)], 1u);
    return b;
}
__device__ __forceinline__ void xcd_barrier_complete(unsigned* bar, unsigned x, unsigned& nloc, unsigned& nx) {
    const unsigned G = gridDim.x * gridDim.y * gridDim.z;
    unsigned sum, cnt, mine, sp = 0u;
    for (;;) {
        sum = 0u; cnt = 0u; mine = 0u;
#pragma unroll
        for (unsigned j = 0; j < 16; ++j) { const unsigned c = xb_ld(&bar[XB_XCNT(j)]); sum += c; cnt += (c > 0u) ? 1u : 0u; mine = (j == x) ? c : mine; }
        if (sum == G) break;
        __builtin_amdgcn_s_sleep(1);
        if ((++sp & 255u) == 0u) { if (xb_ld(&bar[XB_TMO])) break; if (sp > XB_SPIN_CAP) { atomicAdd(&bar[XB_TMO], 1u); break; } }
    }
    nloc = mine > 0u ? mine : 1u; nx = cnt > 0u ? cnt : 1u;
}
__device__ __forceinline__ void xcd_barrier(const XcdBarrier& b) {
    asm volatile("s_waitcnt vmcnt(0)" ::: "memory");
    __syncthreads();
    if (threadIdx.x == 0) {
        unsigned* bar = b.bar;
        __builtin_amdgcn_s_waitcnt(0);
        unsigned nloc = b.st[0], nx = b.st[1];
        if (nloc == 0u) { xcd_barrier_complete(bar, b.x, nloc, nx); b.st[0] = nloc; b.st[1] = nx; }
        const unsigned old = xb_add(&bar[XB_XSUB(b.x)], 1u);
        const unsigned gen = old / nloc;
        if (old + 1u == (gen + 1u) * nloc) {
            __builtin_amdgcn_fence(__ATOMIC_RELEASE, "agent");
            asm volatile("s_waitcnt vmcnt(0)" ::: "memory");
            const unsigned og = xb_add(&bar[XB_TOP], 1u);
            const unsigned tg = og / nx;
            if (og + 1u == (tg + 1u) * nx) xb_add(&bar[XB_TOPGEN], 1u);
            else XB_SPIN(xb_ld(&bar[XB_TOPGEN]) == tg, bar);
            __builtin_amdgcn_fence(__ATOMIC_ACQUIRE, "agent");
            xb_add(&bar[XB_XGEN(b.x)], 1u);
            asm volatile("s_waitcnt vmcnt(0)" ::: "memory");
        } else {
            XB_SPIN(xb_ld(&bar[XB_XGEN(b.x)]) == gen, bar);
            __builtin_amdgcn_fence(__ATOMIC_ACQUIRE, "agent");
            asm volatile("s_waitcnt vmcnt(0)" ::: "memory");
        }
    }
    __syncthreads();
}

struct Args { const float* in[29]; float* out; unsigned char* ws; int ph_lo, ph_hi; };
struct Frame {
    LAS unsigned char* lds; gu32* ctl; unsigned char* ws;
    int tid, lane, wave, vcu, G, gw, NGW;
};

struct Row { f32x4 v[4]; };
__device__ __forceinline__ Row ld_row(const float* p, int lane) { Row r; const f32x4* q = (const f32x4*)p + lane;
#pragma unroll
    for (int j = 0; j < 4; ++j) r.v[j] = q[64 * j]; return r; }
__device__ __forceinline__ void st_row(float* p, int lane, const Row& r) { f32x4* q = (f32x4*)p + lane;
#pragma unroll
    for (int j = 0; j < 4; ++j) q[64 * j] = r.v[j]; }
__device__ __forceinline__ void st_row_bf16(bf16* p, int lane, const Row& r) { u32x2* q = (u32x2*)p + lane;
#pragma unroll
    for (int j = 0; j < 4; ++j) { u32x2 w; w.x = pk2(r.v[j][0], r.v[j][1]); w.y = pk2(r.v[j][2], r.v[j][3]); q[64 * j] = w; } }
__device__ __forceinline__ Row ld_row_bf16(const bf16* p, int lane) { Row r; const u32x2* q = (const u32x2*)p + lane;
#pragma unroll
    for (int j = 0; j < 4; ++j) { const u32x2 w = q[64 * j]; r.v[j] = (f32x4){bflo(w.x), bfhi(w.x), bflo(w.y), bfhi(w.y)}; } return r; }
__device__ __forceinline__ float row_sumsq(const Row& r) { float s = 0.f;
#pragma unroll
    for (int j = 0; j < 4; ++j) s += (r.v[j][0] * r.v[j][0] + r.v[j][1] * r.v[j][1]) + (r.v[j][2] * r.v[j][2] + r.v[j][3] * r.v[j][3]); return wave_sum(s); }
__device__ __forceinline__ Row rmsnorm_row(const Row& x, const Row& g) { const float rs = rsqrtf(row_sumsq(x) * (1.f / D) + RMS_EPS); Row y;
#pragma unroll
    for (int j = 0; j < 4; ++j) y.v[j] = x.v[j] * rs * g.v[j]; return y; }

__device__ __forceinline__ void tr_item(const float* W, int ldw, int k0, int n0, bf16* WT, int ldt, int drow0, int dcol0, const float* sc, int scmode, LAS float* scr, int lane) {
#pragma unroll 8
    for (int i = 0; i < 32; ++i) { const int kk = 2 * i + (lane >> 5); float v = W[(size_t)(k0 + kk) * ldw + n0 + (lane & 31)];
        if (scmode == 1) v *= sc[k0 + kk]; else if (scmode == 2) v *= (1.f - sc[k0 + kk]);
        scr[kk * 33 + (lane & 31)] = v; }
    LDS_WAIT(); asm volatile("" ::: "memory");
    const int c = lane & 7;
#pragma unroll
    for (int j = 0; j < 4; ++j) { const int n = (lane >> 3) + 8 * j; const LAS float* s = scr + (8 * c) * 33 + n;
        u32x4 o; o.x = pk2(s[0 * 33], s[1 * 33]); o.y = pk2(s[2 * 33], s[3 * 33]); o.z = pk2(s[4 * 33], s[5 * 33]); o.w = pk2(s[6 * 33], s[7 * 33]);
        *(GAS u32x4*)(WT + (size_t)(drow0 + n0 + n) * ldt + dcol0 + k0 + 8 * c) = o; }
    LDS_WAIT(); asm volatile("" ::: "memory");
}
__device__ __forceinline__ int gu_row(int n) { return n < FF ? 256 * (n >> 7) + (n & 127) : 256 * ((n - FF) >> 7) + 128 + ((n - FF) & 127); }

__device__ __forceinline__ void p0_prologue(Frame& F, const Args& a) {
    LAS float* scr = (LAS float*)(F.lds + F.wave * 16384);
    unsigned char* ws = F.ws;
    constexpr int I_SQ = 16 * 32;
    constexpr int I_RKV = 3 * I_SQ, I_L1 = 2 * 16 * 8, I_L2 = 4 * 32, I_GU = 16 * 224, I_DN = 56 * 32, I_IN = 16 * 128;
    constexpr int NITEMS = I_RKV + I_L1 + I_L2 + I_SQ + I_GU + I_DN + I_IN + I_SQ + NE * I_GU + NE * I_DN;
    for (int it = F.gw; it < NITEMS; it += F.NGW) {
        int r = it;
        if (r < I_RKV) { const int z = r / I_SQ, q = r % I_SQ; tr_item(a.in[4] + (size_t)z * D * D, D, 64 * (q / 32), 32 * (q % 32), (bf16*)(ws + WS_W_RKV) + (size_t)z * D * D, D, 0, 0, nullptr, 0, scr, F.lane); continue; } r -= I_RKV;
        if (r < I_L1) {
            const int half = r / 128, q = r % 128, kb = q / 8, nb = q % 8, n0 = 32 * nb;
            const float* W; int ldw, nn0, mi;
            if (n0 < 64) { W = a.in[6]; ldw = 64; nn0 = n0; mi = 3; } else if (n0 < 128) { W = a.in[9]; ldw = 64; nn0 = n0 - 64; mi = 4; } else { W = a.in[11]; ldw = 128; nn0 = n0 - 128; mi = 5; }
            tr_item(W, ldw, 64 * kb, nn0, (bf16*)(ws + WS_W_L1), 2 * D, n0 - nn0, half * D, a.in[3] + mi * D, half == 0 ? 1 : 2, scr, F.lane); continue; } r -= I_L1;
        if (r < I_L2) {
            const int part = r / 32, nb = r % 32;
            if (part == 0) tr_item(a.in[7], D, 0, 32 * nb, (bf16*)(ws + WS_W_L2), 256, 0, 0, nullptr, 0, scr, F.lane);
            else if (part == 1) tr_item(a.in[10], D, 0, 32 * nb, (bf16*)(ws + WS_W_L2), 256, D, 64, nullptr, 0, scr, F.lane);
            else tr_item(a.in[12], D, 64 * (part - 2), 32 * nb, (bf16*)(ws + WS_W_L2), 256, 2 * D, 128, nullptr, 0, scr, F.lane);
            continue; } r -= I_L2;
        if (r < I_SQ) { tr_item(a.in[18], D, 64 * (r / 32), 32 * (r % 32), (bf16*)(ws + WS_W_O0), D, 0, 0, nullptr, 0, scr, F.lane); continue; } r -= I_SQ;
        if (r < I_GU) { const int kb = r / 224, nb = r % 224; tr_item(a.in[24], 2 * FF, 64 * kb, 32 * nb, (bf16*)(ws + WS_W_GU), D, gu_row(32 * nb) - 32 * nb, 0, nullptr, 0, scr, F.lane); continue; } r -= I_GU;
        if (r < I_DN) { tr_item(a.in[25], D, 64 * (r / 32), 32 * (r % 32), (bf16*)(ws + WS_W_DN), FF, 0, 0, nullptr, 0, scr, F.lane); continue; } r -= I_DN;
        if (r < I_IN) { tr_item(a.in[19], WIN_LD, 64 * (r / 128), 32 * (r % 128), (bf16*)(ws + WS_W_IN), D, 0, 0, nullptr, 0, scr, F.lane); continue; } r -= I_IN;
        if (r < I_SQ) { tr_item(a.in[23], D, 64 * (r / 32), 32 * (r % 32), (bf16*)(ws + WS_W_FO), D, 0, 0, nullptr, 0, scr, F.lane); continue; } r -= I_SQ;
        if (r < NE * I_GU) { const int e = r / I_GU, q = r % I_GU, kb = q / 224, nb = q % 224;
            tr_item(a.in[27] + (size_t)e * D * 2 * FF, 2 * FF, 64 * kb, 32 * nb, (bf16*)(ws + WS_W_MGU) + (size_t)e * 2 * FF * D, D, gu_row(32 * nb) - 32 * nb, 0, nullptr, 0, scr, F.lane); continue; } r -= NE * I_GU;
        { const int e = r / I_DN, q = r % I_DN; tr_item(a.in[28] + (size_t)e * FF * D, D, 64 * (q / 32), 32 * (q % 32), (bf16*)(ws + WS_W_MDN) + (size_t)e * D * FF, FF, 0, 0, nullptr, 0, scr, F.lane); }
    }
    for (int i = F.gw * 64 + F.lane; i < 3 * D * 32; i += F.NGW * 64) { const int row = i >> 5, ch = i & 31, part = row / D, k = ch * 8;
        const bool nz = part == 0 ? (k < 64) : (part == 1 ? (k >= 64 && k < 128) : (k >= 128));
        if (!nz) *(GAS u32x4*)((bf16*)(ws + WS_W_L2) + (size_t)row * 256 + k) = (u32x4){0u, 0u, 0u, 0u}; }
}

__device__ __forceinline__ void p1_shift(Frame& F, const Args& a) {
    const int lane = F.lane; const float* x = a.in[0];
    bf16* UB = (bf16*)(F.ws + WS_UB); bf16* XS = (bf16*)(F.ws + WS_XS);
    const Row g0 = ld_row(a.in[1], lane);
    const int RPW = T / (256 * NWAVES);
    for (int t0 = F.gw * RPW; t0 < T; t0 += F.NGW * RPW) {
        Row prev;
        if (t0 > 0) prev = rmsnorm_row(ld_row(x + (size_t)(t0 - 1) * D, lane), g0);
        else { for (int j = 0; j < 4; ++j) prev.v[j] = (f32x4){0.f, 0.f, 0.f, 0.f}; st_row_bf16(UB, lane, prev); }
        for (int t = t0; t < t0 + RPW; ++t) {
            const Row u = rmsnorm_row(ld_row(x + (size_t)t * D, lane), g0);
            st_row_bf16(UB + (size_t)(t + 1) * D, lane, u);
#pragma unroll
            for (int n = 0; n < 3; ++n) { const Row mu = ld_row(a.in[3] + n * D, lane); Row o;
#pragma unroll
                for (int j = 0; j < 4; ++j) o.v[j] = u.v[j] + (prev.v[j] - u.v[j]) * mu.v[j];
                st_row_bf16(XS + (size_t)n * T * D + (size_t)t * D, lane, o); }
            prev = u;
        }
    }
}

__device__ __forceinline__ void p4_derive(Frame& F, const Args& a) {
    const int lane = F.lane;
    float* R = (float*)(F.ws + WS_R); float* K = (float*)(F.ws + WS_K); float* LW = (float*)(F.ws + WS_LW); float* AA = (float*)(F.ws + WS_AA);
    float* KK = (float*)(F.ws + WS_KK); float* BB = (float*)(F.ws + WS_BB); float* CS = (float*)(F.ws + WS_CS);
    const Row k_k = ld_row(a.in[13], lane), k_a = ld_row(a.in[14], lane), r_k = ld_row(a.in[15], lane);
    for (int t = F.gw; t < T; t += F.NGW) {
        const size_t o = (size_t)t * D;
        Row r = ld_row(R + o, lane), k = ld_row(K + o, lane), lw = ld_row(LW + o, lane), aa = ld_row(AA + o, lane), kk, bb, km, dec;
        float c1[4], c2[4], c3[4];
#pragma unroll
        for (int j = 0; j < 4; ++j) {
            kk.v[j] = k.v[j] * k_k.v[j];
            float ss = (kk.v[j][0] * kk.v[j][0] + kk.v[j][1] * kk.v[j][1]) + (kk.v[j][2] * kk.v[j][2] + kk.v[j][3] * kk.v[j][3]);
            ss = row16_sum(ss);
            const float inv = 1.f / fmaxf(sqrtf(ss), 1e-12f);
            kk.v[j] = kk.v[j] * inv;
            bb.v[j] = kk.v[j] * aa.v[j];
            km.v[j] = k.v[j] * (1.f + (aa.v[j] - 1.f) * k_a.v[j]);
#pragma unroll
            for (int i = 0; i < 4; ++i) dec.v[j][i] = __expf(lw.v[j][i]);
            float s1 = 0.f, s2 = 0.f, s3 = 0.f;
#pragma unroll
            for (int i = 0; i < 4; ++i) { s1 += bb.v[j][i] * r.v[j][i]; const float kr = km.v[j][i] * r.v[j][i]; s2 += kr; s3 += kr * r_k.v[j][i]; }
            c1[j] = row16_sum(s1); c2[j] = row16_sum(s2); c3[j] = row16_sum(s3);
            r.v[j] = r.v[j] * dec.v[j];
        }
        st_row(R + o, lane, r); st_row(K + o, lane, km); st_row(LW + o, lane, dec); st_row(KK + o, lane, kk); st_row(BB + o, lane, bb);
        if ((lane & 15) == 0) {
#pragma unroll
            for (int j = 0; j < 4; ++j) { const int h = 4 * j + (lane >> 4); CS[(size_t)t * 16 + h] = c1[j]; CS[(size_t)T * 16 + (size_t)t * 16 + h] = c2[j]; CS[(size_t)2 * T * 16 + (size_t)t * 16 + h] = c3[j]; }
        }
    }
}

__device__ __forceinline__ float dpp_row_allsum(float x) {
    int v = __builtin_bit_cast(int, x);
    x += __builtin_bit_cast(float, __builtin_amdgcn_update_dpp(0, v, 0xB1, 0xF, 0xF, true)); v = __builtin_bit_cast(int, x);
    x += __builtin_bit_cast(float, __builtin_amdgcn_update_dpp(0, v, 0x4E, 0xF, 0xF, true)); v = __builtin_bit_cast(int, x);
    x += __builtin_bit_cast(float, __builtin_amdgcn_update_dpp(0, v, 0x141, 0xF, 0xF, true)); v = __builtin_bit_cast(int, x);
    x += __builtin_bit_cast(float, __builtin_amdgcn_update_dpp(0, v, 0x140, 0xF, 0xF, true));
    return x;
}
__device__ __forceinline__ float wave_allsum_fast(float x) {
    x = dpp_row_allsum(x);
    const int v = __builtin_bit_cast(int, x);
    const float a = __builtin_bit_cast(float, __builtin_amdgcn_readlane(v, 0)), b = __builtin_bit_cast(float, __builtin_amdgcn_readlane(v, 16)),
                c = __builtin_bit_cast(float, __builtin_amdgcn_readlane(v, 32)), d = __builtin_bit_cast(float, __builtin_amdgcn_readlane(v, 48));
    return (a + b) + (c + d);
}
__device__ __forceinline__ void p5_scan(Frame& F) {
    if (F.wave >= 4) return;
    const int lane = F.lane;
    const float* KK = (const float*)(F.ws + WS_KK); const float* RW = (const float*)(F.ws + WS_R); const float* DEC = (const float*)(F.ws + WS_LW);
    const float* BB = (const float*)(F.ws + WS_BB); const float* KM = (const float*)(F.ws + WS_K); const float* V = (const float*)(F.ws + WS_V);
    const float* CS = (const float*)(F.ws + WS_CS); float* YT = (float*)(F.ws + WS_YT);
    for (int rho = F.vcu * 4 + F.wave; rho < D; rho += F.G * 4) {
        const int h = rho >> 6;
        const size_t col = (size_t)h * 64 + lane;
        float s = 0.f, ybuf = 0.f;
        constexpr int U = 8;
        float ik[2][U], ir[2][U], iw[2][U], ib[2][U], im[2][U], iv[2][U], i1[2][U], i2[2][U];
#define SCAN_LOAD(buf, tb) do { _Pragma("unroll") for (int u_ = 0; u_ < U; ++u_) { const size_t o_ = (size_t)((tb) + u_) * D; \
            ik[buf][u_] = KK[o_ + col]; ir[buf][u_] = RW[o_ + col]; iw[buf][u_] = DEC[o_ + col]; ib[buf][u_] = BB[o_ + col]; im[buf][u_] = KM[o_ + col]; \
            iv[buf][u_] = V[o_ + rho]; i1[buf][u_] = CS[(size_t)((tb) + u_) * 16 + h]; i2[buf][u_] = CS[(size_t)T * 16 + (size_t)((tb) + u_) * 16 + h]; } } while (0)
#define SCAN_STEPS(buf, tb) do { _Pragma("unroll") for (int u_ = 0; u_ < U; ++u_) { \
            const float p1 = wave_allsum_fast(s * ik[buf][u_]); const float p2 = wave_allsum_fast(s * ir[buf][u_]); \
            const float sa = -p1; const float y = p2 + sa * i1[buf][u_] + iv[buf][u_] * i2[buf][u_]; \
            s = s * iw[buf][u_] + sa * ib[buf][u_] + iv[buf][u_] * im[buf][u_]; \
            if (lane == (((tb) + u_) & 63)) ybuf = y; } } while (0)
        SCAN_LOAD(0, 0);
        for (int t0 = 0; t0 < T; t0 += 2 * U) {
            SCAN_LOAD(1, t0 + U);
            SCAN_STEPS(0, t0);
            if (t0 + 2 * U < T) SCAN_LOAD(0, t0 + 2 * U);
            SCAN_STEPS(1, t0 + U);
            if (((t0 + 2 * U) & 63) == 0) YT[(size_t)rho * T + (t0 + 2 * U - 64) + lane] = ybuf;
        }
#undef SCAN_LOAD
#undef SCAN_STEPS
    }
}

typedef __bf16 bf16x2_t __attribute__((ext_vector_type(2)));
__device__ __forceinline__ unsigned cvtpk(float lo, float hi) { f32x2 v = {lo, hi}; bf16x2_t b = __builtin_convertvector(v, bf16x2_t); return __builtin_bit_cast(unsigned, b); }
struct Pk { bf16x8 k0, k1; };
__device__ __forceinline__ Pk pack_tile(const f32x16& t) {
    const u32x4 a = {cvtpk(t[0], t[1]), cvtpk(t[2], t[3]), cvtpk(t[4], t[5]), cvtpk(t[6], t[7])}, b = {cvtpk(t[8], t[9]), cvtpk(t[10], t[11]), cvtpk(t[12], t[13]), cvtpk(t[14], t[15])};
    Pk p; p.k0 = __builtin_bit_cast(bf16x8, a); p.k1 = __builtin_bit_cast(bf16x8, b); return p; }
#define MFMA32(a, b, c) __builtin_amdgcn_mfma_f32_32x32x16_bf16((a), (b), (c), 0, 0, 0)
__device__ __forceinline__ f32x16 xt(const Pk& X, const Pk& Z, f32x16 acc) { acc = MFMA32(X.k0, Z.k0, acc); acc = MFMA32(X.k1, Z.k1, acc); return acc; }
__device__ __forceinline__ bf16x8 nfrag(const bf16* m, int rt, int ks, int lane) { return *(const bf16x8*)(m + (size_t)(32 * rt + (lane & 31)) * D + 16 * ks + 8 * (lane >> 5)); }
__device__ __forceinline__ f32x16 nat(const bf16* am, int a, const bf16* bm, int b, int lane, f32x16 acc) {
#pragma unroll
    for (int ks = 0; ks < 4; ++ks) acc = MFMA32(nfrag(am, a, ks, lane), nfrag(bm, b, ks, lane), acc);
    return acc; }
__device__ __forceinline__ f32x16 dl_copy(const bf16* am, int a, int ct, int lane) {
    f32x16 acc = {};
#pragma unroll
    for (int kk2 = 0; kk2 < 2; ++kk2) { const int ks = 2 * ct + kk2; bf16x8 id;
#pragma unroll
        for (int e = 0; e < 8; ++e) id[e] = (32 * ct + (lane & 31) == 16 * ks + 8 * (lane >> 5) + e) ? (short)0x3F80 : (short)0;
        acc = MFMA32(nfrag(am, a, ks, lane), id, acc); }
    return acc; }
__device__ __forceinline__ void mask_lt(f32x16& t, int lane) {
#pragma unroll
    for (int r = 0; r < 16; ++r) if (!(crow(r, lane >> 5) < (lane & 31))) t[r] = 0.f; }
__device__ __forceinline__ void mask_gt(f32x16& t, int lane) {
#pragma unroll
    for (int r = 0; r < 16; ++r) if (!(crow(r, lane >> 5) > (lane & 31))) t[r] = 0.f; }
__device__ __forceinline__ void mask_le(f32x16& t, int lane) {
#pragma unroll
    for (int r = 0; r < 16; ++r) if (!(crow(r, lane >> 5) <= (lane & 31))) t[r] = 0.f; }
__device__ __forceinline__ void add_eye(f32x16& t, int lane) {
#pragma unroll
    for (int r = 0; r < 16; ++r) if (crow(r, lane >> 5) == (lane & 31)) t[r] += 1.f; }

__device__ __forceinline__ void p3_prep(Frame& F, const Args& a) {
    const int lane = F.lane;
    const bf16* R = (const bf16*)(F.ws + WS_R); const bf16* K = (const bf16*)(F.ws + WS_K); const bf16* V = (const bf16*)(F.ws + WS_V);
    const float* LW = (const float*)(F.ws + WS_LW); const float* AA = (const float*)(F.ws + WS_AA);
    bf16* AT = (bf16*)(F.ws + WS_AT); bf16* RT = (bf16*)(F.ws + WS_RT); bf16* BH = (bf16*)(F.ws + WS_BH); bf16* KH = (bf16*)(F.ws + WS_KH); bf16* V16 = (bf16*)(F.ws + WS_V16);
    float* GC = (float*)(F.ws + WS_GC); float* C3 = (float*)(F.ws + WS_CS) + (size_t)2 * T * 16;
    for (int task = F.gw; task < NCH * 4; task += F.NGW) {
        const int c = task >> 2, hg = task & 3, col = hg * 256 + 4 * lane;
        const f32x4 k_k = *(const f32x4*)(a.in[13] + col), k_a = *(const f32x4*)(a.in[14] + col), r_k = *(const f32x4*)(a.in[15] + col);
        f32x4 lg = {0.f, 0.f, 0.f, 0.f};
        constexpr int PF = 8;
        for (int tb = 0; tb < 64; tb += PF) {
            u32x2 rr[PF], kx[PF]; f32x4 lx[PF], ax[PF];
#pragma unroll
            for (int u = 0; u < PF; ++u) { const size_t o = (size_t)(64 * c + tb + u) * D + col;
                rr[u] = *(const u32x2*)(R + o); kx[u] = *(const u32x2*)(K + o); lx[u] = *(const f32x4*)(LW + o); ax[u] = *(const f32x4*)(AA + o); }
#pragma unroll
            for (int u = 0; u < PF; ++u) { const int tt = tb + u;
                const size_t o = (size_t)(64 * c + tt) * D + col;
                const f32x4 r = {bflo(rr[u].x), bfhi(rr[u].x), bflo(rr[u].y), bfhi(rr[u].y)}, k = {bflo(kx[u].x), bfhi(kx[u].x), bflo(kx[u].y), bfhi(kx[u].y)}, lw = lx[u], aa = ax[u];
                f32x4 kk = k * k_k;
                float ss = (kk[0] * kk[0] + kk[1] * kk[1]) + (kk[2] * kk[2] + kk[3] * kk[3]); ss = row16_sum(ss);
                kk = kk * (1.f / fmaxf(sqrtf(ss), 1e-12f));
                const f32x4 b = kk * aa, km = k * (1.f + (aa - 1.f) * k_a);
                float s3 = (r[0] * km[0] * r_k[0] + r[1] * km[1] * r_k[1]) + (r[2] * km[2] * r_k[2] + r[3] * km[3] * r_k[3]); s3 = row16_sum(s3);
                if ((lane & 15) == 0) C3[(size_t)(64 * c + tt) * 16 + hg * 4 + (lane >> 4)] = s3;
                const f32x4 lgm1 = lg; lg = lg + lw;
                f32x4 at, rt, bh, kh;
#pragma unroll
                for (int i = 0; i < 4; ++i) { const float em = __expf(lgm1[i]), ep = __expf(lg[i]), en = __expf(-lg[i]); at[i] = -kk[i] * em; rt[i] = r[i] * ep; bh[i] = b[i] * en; kh[i] = km[i] * en; }
                *(u32x2*)(AT + o) = (u32x2){pk2(at[0], at[1]), pk2(at[2], at[3])}; *(u32x2*)(RT + o) = (u32x2){pk2(rt[0], rt[1]), pk2(rt[2], rt[3])};
                *(u32x2*)(BH + o) = (u32x2){pk2(bh[0], bh[1]), pk2(bh[2], bh[3])}; *(u32x2*)(KH + o) = (u32x2){pk2(kh[0], kh[1]), pk2(kh[2], kh[3])};
            }
        }
        f32x4 g; for (int i = 0; i < 4; ++i) g[i] = __expf(lg[i]);
        *(f32x4*)(GC + (size_t)c * D + col) = g;
    }
}

__device__ __forceinline__ void inv32(f32x16 N, f32x16 NT, f32x16& Tm, f32x16& TT, int lane) {
    Tm = N; TT = NT; add_eye(Tm, lane); add_eye(TT, lane);
    Pk Np = pack_tile(N), NTp = pack_tile(NT);
#pragma unroll
    for (int it = 0; it < 4; ++it) {
        const f32x16 z = {};
        const f32x16 N2 = xt(NTp, Np, z), N2T = xt(Np, NTp, z);
        const Pk N2p = pack_tile(N2), N2Tp = pack_tile(N2T), TTp = pack_tile(TT);
        Tm = xt(TTp, N2p, Tm);
        TT = xt(N2p, TTp, TT);
        Np = N2p; NTp = N2Tp;
    }
}

__device__ __forceinline__ void pa_chunk(Frame& F) {
    const int lane = F.lane, c32 = lane & 31, hh = lane >> 5;
    const bf16* AT = (const bf16*)(F.ws + WS_AT); const bf16* BH = (const bf16*)(F.ws + WS_BH); const bf16* KH = (const bf16*)(F.ws + WS_KH); const bf16* V16 = (const bf16*)(F.ws + WS_V16);
    const float* GC = (const float*)(F.ws + WS_GC);
    for (int task = F.gw; task < NCH * NH; task += F.NGW) {
        const int c = task >> 4, h = task & 15; const size_t o = (size_t)(64 * c) * D + h * 64;
        const bf16* at = AT + o; const bf16* bh = BH + o; const bf16* kh = KH + o; const bf16* vv = V16 + o;
        const f32x16 z = {};
        Pk T11, T22, T12, T11T, T22T, T12T;
        {
            f32x16 n = nat(bh, 0, at, 0, lane, z), nt = nat(at, 0, bh, 0, lane, z); mask_lt(n, lane); mask_gt(nt, lane);
            f32x16 t, tt; inv32(n, nt, t, tt, lane); T11 = pack_tile(t); T11T = pack_tile(tt);
            n = nat(bh, 1, at, 1, lane, z); nt = nat(at, 1, bh, 1, lane, z); mask_lt(n, lane); mask_gt(nt, lane);
            inv32(n, nt, t, tt, lane); T22 = pack_tile(t); T22T = pack_tile(tt);
            const Pk N12 = pack_tile(nat(bh, 0, at, 1, lane, z)), N12T = pack_tile(nat(at, 1, bh, 0, lane, z));
            const Pk Z1 = pack_tile(xt(N12T, T22, z));
            T12 = pack_tile(xt(T11T, Z1, z));
            const Pk Z2 = pack_tile(xt(N12, T11T, z));
            T12T = pack_tile(xt(T22, Z2, z));
        }
        {
            u32x4* tm = (u32x4*)(F.ws + WS_TM) + (size_t)task * 6 * 64 + lane;
            tm[0] = __builtin_bit_cast(u32x4, T11.k0); tm[64] = __builtin_bit_cast(u32x4, T11.k1); tm[128] = __builtin_bit_cast(u32x4, T12.k0); tm[192] = __builtin_bit_cast(u32x4, T12.k1);
            tm[256] = __builtin_bit_cast(u32x4, T22.k0); tm[320] = __builtin_bit_cast(u32x4, T22.k1);
        }
        const float g0 = GC[(size_t)c * D + h * 64 + c32], g1 = GC[(size_t)c * D + h * 64 + 32 + c32];
        Pk W1p[2][2];
#pragma unroll
        for (int b = 0; b < 2; ++b) { const float gcol = b == 0 ? g0 : g1;
            f32x16 bb0 = dl_copy(bh, 0, b, lane), bb1 = dl_copy(bh, 1, b, lane);
#pragma unroll
            for (int r = 0; r < 16; ++r) { bb0[r] *= gcol; bb1[r] *= gcol; }
            const Pk B0 = pack_tile(bb0), B1 = pack_tile(bb1);
            f32x16 w0 = xt(T11T, B0, z); w0 = xt(T12T, B1, w0);
            const f32x16 w1 = xt(T22T, B1, z);
            W1p[0][b] = pack_tile(w0); W1p[1][b] = pack_tile(w1); }
        {
            bf16* plr = (bf16*)(F.ws + WS_PLR) + (size_t)task * 4096;
#pragma unroll
            for (int a2 = 0; a2 < 2; ++a2) { const Pk A0 = pack_tile(dl_copy(at, 0, a2, lane)), A1 = pack_tile(dl_copy(at, 1, a2, lane));
#pragma unroll
                for (int b = 0; b < 2; ++b) { f32x16 p = xt(A0, W1p[0][b], z); p = xt(A1, W1p[1][b], p);
#pragma unroll
                    for (int g4 = 0; g4 < 4; ++g4) {
                        const int m_ = 2 * b + (c32 >> 4), lb_ = (c32 & 15) + 16 * (2 * (g4 & 1) + hh);
                        *(u32x2*)(plr + ((m_ * 2 + a2) * 64 + lb_) * 8 + 4 * (g4 >> 1)) = (u32x2){cvtpk(p[4 * g4], p[4 * g4 + 1]), cvtpk(p[4 * g4 + 2], p[4 * g4 + 3])}; } } }
        }
        Pk M2p[2][2];
        {
            f32x16 e = nat(at, 0, kh, 0, lane, z); mask_gt(e, lane); const Pk E00 = pack_tile(e);
            e = nat(at, 1, kh, 1, lane, z); mask_gt(e, lane); const Pk E11 = pack_tile(e);
            const Pk E10 = pack_tile(nat(at, 1, kh, 0, lane, z));
#pragma unroll
            for (int b = 0; b < 2; ++b) { const float gcol = b == 0 ? g0 : g1;
                f32x16 m0 = xt(E00, W1p[0][b], z); m0 = xt(E10, W1p[1][b], m0);
                f32x16 m1 = xt(E11, W1p[1][b], z);
                const f32x16 k0 = dl_copy(kh, 0, b, lane), k1 = dl_copy(kh, 1, b, lane);
#pragma unroll
                for (int r = 0; r < 16; ++r) { m0[r] += k0[r] * gcol; m1[r] += k1[r] * gcol; }
                M2p[0][b] = pack_tile(m0); M2p[1][b] = pack_tile(m1); }
        }
        {
            float* qm = (float*)(F.ws + WS_QM) + (size_t)task * 4096;
#pragma unroll
            for (int b = 0; b < 2; ++b) { const Pk V0 = pack_tile(dl_copy(vv, 0, b, lane)), V1 = pack_tile(dl_copy(vv, 1, b, lane));
#pragma unroll
                for (int a2 = 0; a2 < 2; ++a2) { f32x16 q = xt(M2p[0][a2], V0, z); q = xt(M2p[1][a2], V1, q);
#pragma unroll
                    for (int g4 = 0; g4 < 4; ++g4) {
                        const int rg_ = 2 * b + (c32 >> 4), m_ = 2 * a2 + (g4 >> 1), lb_ = (c32 & 15) + 16 * (2 * (g4 & 1) + hh);
                        *(f32x4*)(qm + rg_ * 1024 + (m_ * 64 + lb_) * 4) = (f32x4){q[4 * g4], q[4 * g4 + 1], q[4 * g4 + 2], q[4 * g4 + 3]}; } } }
        }
    }
}

constexpr int PB_NST = 10, PB_STB = 8192 + 4096 + 256, PB_NLD = 3;
constexpr int PB_FULL_OFF = RING_BYTES + 64, PB_CONS_OFF = RING_BYTES + 128;
static_assert(PB_NST * PB_STB <= RING_BYTES && PB_FULL_OFF + 4 * PB_NST <= PB_CONS_OFF && PB_CONS_OFF + 4 <= MISC_OFF, "phase-B LDS map");
__device__ __forceinline__ void pb_chain(Frame& F) {
    if ((F.vcu & 31) >= 8 || F.vcu >= 256 || F.wave > PB_NLD) return;
    const int lane = F.lane, h = 2 * (F.vcu >> 5) + ((F.vcu & 31) >> 2), rg = F.vcu & 3;
    volatile LAS unsigned* FULL = (volatile LAS unsigned*)(F.lds + PB_FULL_OFF); volatile LAS unsigned* CONS = (volatile LAS unsigned*)(F.lds + PB_CONS_OFF);
    if (F.wave >= 1) {
        const int L = F.wave - 1;
        const char* PLR = (const char*)(F.ws + WS_PLR); const char* QM = (const char*)(F.ws + WS_QM); const float* GC = (const float*)(F.ws + WS_GC);
        int k = 0;
        for (int c = L; c < NCH; c += PB_NLD, ++k) {
            if (c >= PB_NST) { const unsigned need = (unsigned)(c - PB_NST + 1); unsigned sp = 0; while (CONS[0] < need) { __builtin_amdgcn_s_sleep(1); if (++sp > (1u << 22)) break; } }
            const size_t task = (size_t)c * 16 + h;
            LAS unsigned char* slot = F.lds + (c % PB_NST) * PB_STB;
            const char* pl = PLR + task * 8192 + lane * 16; const char* qm = QM + task * 16384 + rg * 4096 + lane * 16;
#pragma unroll
            for (int i = 0; i < 8; ++i) __builtin_amdgcn_global_load_lds((const unsigned*)(pl + i * 1024), (LAS unsigned*)(slot + i * 1024), 16, 0, 0);
#pragma unroll
            for (int i = 0; i < 4; ++i) __builtin_amdgcn_global_load_lds((const unsigned*)(qm + i * 1024), (LAS unsigned*)(slot + 8192 + i * 1024), 16, 0, 0);
            __builtin_amdgcn_global_load_lds((const unsigned*)(GC + (size_t)c * D + h * 64 + lane), (LAS unsigned*)(slot + 12288), 4, 0, 0);
            if (k >= 2) { asm volatile("s_waitcnt vmcnt(26)" ::: "memory"); const int cp = c - 2 * PB_NLD; FULL[cp % PB_NST] = (unsigned)(cp + 1); }
        }
        const int clast = L + PB_NLD * (k - 1);
        if (k >= 2) { asm volatile("s_waitcnt vmcnt(13)" ::: "memory"); const int cp = clast - PB_NLD; FULL[cp % PB_NST] = (unsigned)(cp + 1); }
        asm volatile("s_waitcnt vmcnt(0)" ::: "memory"); FULL[clast % PB_NST] = (unsigned)(clast + 1);
        return;
    }
    const int n16 = lane & 15, q4 = lane >> 4;
    bf16* S0 = (bf16*)(F.ws + WS_S0);
    f32x4 s[4];
#pragma unroll
    for (int m = 0; m < 4; ++m) s[m] = (f32x4){0.f, 0.f, 0.f, 0.f};
    for (int c = 0; c < NCH; ++c) {
        { const unsigned need = (unsigned)(c + 1); unsigned sp = 0; while (FULL[c % PB_NST] < need) { if (++sp > (1u << 24)) break; } }
        const LAS unsigned char* slot = F.lds + (c % PB_NST) * PB_STB;
        bf16x8 af[4][2]; f32x4 qv[4], gc[4];
#pragma unroll
        for (int m = 0; m < 4; ++m) {
#pragma unroll
            for (int kb = 0; kb < 2; ++kb) af[m][kb] = *(const LAS bf16x8*)(slot + ((m * 2 + kb) * 64 + lane) * 16);
            qv[m] = *(const LAS f32x4*)(slot + 8192 + (m * 64 + lane) * 16); gc[m] = *(const LAS f32x4*)(slot + 12288 + 64 * m + 16 * q4); }
        asm volatile("s_waitcnt lgkmcnt(0)" ::: "memory");
        CONS[0] = (unsigned)(c + 1);
        bf16* s0 = S0 + ((size_t)c * 16 + h) * 4096 + (16 * rg + n16) * 64;
        u32x2 sp2[4];
#pragma unroll
        for (int m = 0; m < 4; ++m) { sp2[m] = (u32x2){cvtpk(s[m][0], s[m][1]), cvtpk(s[m][2], s[m][3])}; *(u32x2*)(s0 + 16 * m + 4 * q4) = sp2[m]; }
        const bf16x8 B0 = __builtin_bit_cast(bf16x8, (u32x4){sp2[0].x, sp2[0].y, sp2[1].x, sp2[1].y}), B1 = __builtin_bit_cast(bf16x8, (u32x4){sp2[2].x, sp2[2].y, sp2[3].x, sp2[3].y});
#pragma unroll
        for (int m = 0; m < 4; ++m) { f32x4 acc = s[m] * gc[m] + qv[m];
            acc = __builtin_amdgcn_mfma_f32_16x16x32_bf16(af[m][0], B0, acc, 0, 0, 0);
            acc = __builtin_amdgcn_mfma_f32_16x16x32_bf16(af[m][1], B1, acc, 0, 0, 0);
            s[m] = acc; }
    }
}

__device__ __forceinline__ void pc_out(Frame& F) {
    const int lane = F.lane, c32 = lane & 31, hh = lane >> 5;
    const bf16* AT = (const bf16*)(F.ws + WS_AT); const bf16* RT = (const bf16*)(F.ws + WS_RT); const bf16* BH = (const bf16*)(F.ws + WS_BH); const bf16* KH = (const bf16*)(F.ws + WS_KH);
    const bf16* V16 = (const bf16*)(F.ws + WS_V16); const bf16* S0 = (const bf16*)(F.ws + WS_S0); float* Y = (float*)(F.ws + WS_Y);
    for (int task = F.gw; task < NCH * NH; task += F.NGW) {
        const int c = task >> 4, h = task & 15; const size_t o = (size_t)(64 * c) * D + h * 64;
        const bf16* at = AT + o; const bf16* rt = RT + o; const bf16* bh = BH + o; const bf16* kh = KH + o; const bf16* vv = V16 + o;
        const bf16* s0 = S0 + (size_t)task * 4096;
        const f32x16 z = {};
        auto s0frag = [&](int it, int ks) { return *(const bf16x8*)(s0 + (32 * it + c32) * 64 + 16 * ks + 8 * hh); };
        Pk Tm00, Tm01, Tm11;
        { const u32x4* tm = (const u32x4*)(F.ws + WS_TM) + (size_t)task * 6 * 64 + lane;
          Tm00.k0 = __builtin_bit_cast(bf16x8, tm[0]); Tm00.k1 = __builtin_bit_cast(bf16x8, tm[64]); Tm01.k0 = __builtin_bit_cast(bf16x8, tm[128]); Tm01.k1 = __builtin_bit_cast(bf16x8, tm[192]);
          Tm11.k0 = __builtin_bit_cast(bf16x8, tm[256]); Tm11.k1 = __builtin_bit_cast(bf16x8, tm[320]); }
        f32x16 e = nat(kh, 0, at, 0, lane, z); mask_lt(e, lane); const Pk K00 = pack_tile(e);
        e = nat(kh, 1, at, 1, lane, z); mask_lt(e, lane); const Pk K11 = pack_tile(e);
        const Pk K01 = pack_tile(nat(kh, 0, at, 1, lane, z));
#pragma unroll 1
        for (int b = 0; b < 2; ++b) {
            const Pk V0 = pack_tile(dl_copy(vv, 0, b, lane)), V1 = pack_tile(dl_copy(vv, 1, b, lane));
            f32x16 x0 = z, x1 = z;
#pragma unroll
            for (int ks = 0; ks < 4; ++ks) { const bf16x8 sf = s0frag(b, ks); x0 = MFMA32(nfrag(at, 0, ks, lane), sf, x0); x1 = MFMA32(nfrag(at, 1, ks, lane), sf, x1); }
            x0 = xt(K00, V0, x0);
            x1 = xt(K01, V0, x1); x1 = xt(K11, V1, x1);
            const Pk X0 = pack_tile(x0), X1 = pack_tile(x1);
            const Pk U0 = pack_tile(xt(Tm00, X0, z));
            f32x16 u1 = xt(Tm01, X0, z); u1 = xt(Tm11, X1, u1); const Pk U1 = pack_tile(u1);
            f32x16 y0 = z, y1 = z;
#pragma unroll
            for (int ks = 0; ks < 4; ++ks) { const bf16x8 sf = s0frag(b, ks); y0 = MFMA32(nfrag(rt, 0, ks, lane), sf, y0); y1 = MFMA32(nfrag(rt, 1, ks, lane), sf, y1); }
            { f32x16 m = nat(bh, 0, rt, 0, lane, z); mask_le(m, lane); const Pk R00 = pack_tile(m); y0 = xt(R00, U0, y0);
              const Pk R01 = pack_tile(nat(bh, 0, rt, 1, lane, z)); y1 = xt(R01, U0, y1);
              m = nat(bh, 1, rt, 1, lane, z); mask_le(m, lane); const Pk R11 = pack_tile(m); y1 = xt(R11, U1, y1); }
            { f32x16 m = nat(kh, 0, rt, 0, lane, z); mask_le(m, lane); const Pk R00 = pack_tile(m); y0 = xt(R00, V0, y0);
              const Pk R01 = pack_tile(nat(kh, 0, rt, 1, lane, z)); y1 = xt(R01, V0, y1);
              m = nat(kh, 1, rt, 1, lane, z); mask_le(m, lane); const Pk R11 = pack_tile(m); y1 = xt(R11, V1, y1); }
            float* yp = Y + (size_t)(64 * c) * D + h * 64 + 32 * b + c32;
#pragma unroll
            for (int r = 0; r < 16; ++r) { yp[(size_t)crow(r, hh) * D] = y0[r]; yp[(size_t)(32 + crow(r, hh)) * D] = y1[r]; }
        }
    }
}

__device__ __forceinline__ void p6_gn_rows(Frame& F, const Args& a) {
    const int lane = F.lane;
    const float* Y = (const float*)(F.ws + WS_Y); const bf16* V16 = (const bf16*)(F.ws + WS_V16); const float* G = (const float*)(F.ws + WS_G);
    const float* C3 = (const float*)(F.ws + WS_CS) + (size_t)2 * T * 16; bf16* Z = (bf16*)(F.ws + WS_Z);
    const Row gg = ld_row(a.in[16], lane), gb = ld_row(a.in[17], lane);
    for (int t = F.gw; t < T; t += F.NGW) {
        const size_t o = (size_t)t * D;
        const Row y = ld_row(Y + o, lane), g = ld_row(G + o, lane), v = ld_row_bf16(V16 + o, lane); Row zr;
#pragma unroll
        for (int j = 0; j < 4; ++j) {
            const float mean = row16_sum((y.v[j][0] + y.v[j][1]) + (y.v[j][2] + y.v[j][3])) * (1.f / 64.f);
            const f32x4 d = y.v[j] - mean;
            const float var = row16_sum((d[0] * d[0] + d[1] * d[1]) + (d[2] * d[2] + d[3] * d[3])) * (1.f / 64.f);
            const float rs = rsqrtf(var + GN_EPS), c3 = C3[(size_t)t * 16 + 4 * j + (lane >> 4)];
            zr.v[j] = (d * rs * gg.v[j] + gb.v[j] + c3 * v.v[j]) * g.v[j];
        }
        st_row_bf16(Z + o, lane, zr);
    }
}

__device__ __forceinline__ void p6_gn(Frame& F, const Args& a) {
    const int lane = F.lane, wave = F.wave;
    const float* YT = (const float*)(F.ws + WS_YT); const float* V = (const float*)(F.ws + WS_V); const float* G = (const float*)(F.ws + WS_G);
    const float* C3 = (const float*)(F.ws + WS_CS) + (size_t)2 * T * 16; bf16* Z = (bf16*)(F.ws + WS_Z);
    LAS float* tile = (LAS float*)F.lds;
    for (int unit = F.vcu; unit < NH * (T / 64); unit += F.G) {
        const int h = unit / (T / 64), t0 = (unit % (T / 64)) * 64;
        __syncthreads();
#pragma unroll
        for (int q = 0; q < 8; ++q) { const int i = wave * 8 + q; tile[i * 65 + lane] = YT[(size_t)(h * 64 + i) * T + t0 + lane]; }
        __syncthreads();
        const float gg = a.in[16][h * 64 + lane], gb = a.in[17][h * 64 + lane];
#pragma unroll
        for (int q = 0; q < 8; ++q) { const int tt = wave * 8 + q, t = t0 + tt;
            const float y = tile[lane * 65 + tt];
            const float mean = wave_sum(y) * (1.f / 64.f); const float dlt = y - mean; const float var = wave_sum(dlt * dlt) * (1.f / 64.f);
            const size_t o = (size_t)t * D + h * 64 + lane;
            const float z = (dlt * rsqrtf(var + GN_EPS) * gg + gb + C3[(size_t)t * 16 + h] * V[o]) * G[o];
            Z[o] = (bf16)f2bf(z); }
    }
    __syncthreads();
}

__device__ __forceinline__ void p8_norm(Frame& F, const float* g, bf16* U) {
    const float* Hs = (const float*)(F.ws + WS_H); const Row gr = ld_row(g, F.lane);
    for (int t = F.gw; t < T; t += F.NGW) st_row_bf16(U + (size_t)t * D, F.lane, rmsnorm_row(ld_row(Hs + (size_t)t * D, F.lane), gr));
}
__device__ __forceinline__ void p11_norm_forget(Frame& F, const Args& a) {
    const int lane = F.lane; const float* Hs = (const float*)(F.ws + WS_H); bf16* U = (bf16*)(F.ws + WS_U3); float* LF = (float*)(F.ws + WS_LF);
    LAS float* wf = (LAS float*)F.lds;
    __syncthreads();
    for (int i = F.tid; i < 16 * D; i += NTHREADS) { const int hh = i & 15, k = i >> 4; wf[hh * D + k] = a.in[19][(size_t)k * WIN_LD + 4 * D + hh]; }
    __syncthreads();
    const Row gr = ld_row(a.in[1] + 2 * D, lane);
    for (int t = F.gw; t < T; t += F.NGW) {
        const Row u = rmsnorm_row(ld_row(Hs + (size_t)t * D, lane), gr);
        st_row_bf16(U + (size_t)t * D, lane, u);
        float mine = 0.f;
#pragma unroll 2
        for (int hh = 0; hh < 16; ++hh) { float s = 0.f;
#pragma unroll
            for (int j = 0; j < 4; ++j) { const f32x4 w = *(const LAS f32x4*)(wf + hh * D + 256 * j + 4 * lane); s += (u.v[j][0] * w[0] + u.v[j][1] * w[1]) + (u.v[j][2] * w[2] + u.v[j][3] * w[3]); }
            s = wave_sum(s); if (lane == hh) mine = s; }
        if (lane < 16) { const float x = mine + a.in[20][lane]; LF[(size_t)t * 16 + lane] = fminf(x, 0.f) - log1pf(__expf(-fabsf(x))); }
    }
    __syncthreads();
}
__device__ __forceinline__ void p13_cumsum_qknorm(Frame& F, const Args& a) {
    const int lane = F.lane, tid = F.tid;
    const float* LF = (const float*)(F.ws + WS_LF); float* C2 = (float*)(F.ws + WS_C2); float* CB = (float*)(F.ws + WS_CB);
    if (F.vcu < NH) {
        const int h = F.vcu; LAS double* part = (LAS double*)F.lds;
        __syncthreads();
        const int tb = tid * 32; double s = 0.0;
        for (int i = 0; i < 32; ++i) s += (double)LF[(size_t)(tb + i) * 16 + h];
        part[tid] = s; __syncthreads();
        if (tid == 0) { double run = 0.0; for (int i = 0; i < NTHREADS; ++i) { const double v = part[i]; part[i] = run; run += v; } }
        __syncthreads();
        double run = part[tid];
        for (int i = 0; i < 32; ++i) { run += (double)LF[(size_t)(tb + i) * 16 + h]; const float c = (float)(run * 1.4426950408889634); C2[(size_t)h * T + tb + i] = c; if (((tb + i) & 63) == 63) CB[h * 256 + ((tb + i) >> 6)] = c; }
        __syncthreads();
    }
    bf16* Q = (bf16*)(F.ws + WS_QKVG);
    f32x4 gq[4], gk[4];
#pragma unroll
    for (int j = 0; j < 4; ++j) { const int c = (4 * lane + 256 * j) & 63; gq[j] = *(const f32x4*)(a.in[21] + c) * (0.125f * LOG2E); gk[j] = *(const f32x4*)(a.in[22] + c); }
    for (int t = F.gw; t < T; t += F.NGW) {
#pragma unroll
        for (int which = 0; which < 2; ++which) {
            bf16* p = Q + (size_t)t * 4096 + which * D;
            Row x = ld_row_bf16(p, lane);
#pragma unroll
            for (int j = 0; j < 4; ++j) { float ss = (x.v[j][0] * x.v[j][0] + x.v[j][1] * x.v[j][1]) + (x.v[j][2] * x.v[j][2] + x.v[j][3] * x.v[j][3]); ss = row16_sum(ss);
                const float rs = rsqrtf(ss * (1.f / 64.f) + RMS_EPS); x.v[j] = x.v[j] * rs * (which == 0 ? gq[j] : gk[j]); }
            st_row_bf16(p, lane, x);
        }
    }
}

#ifndef ATTN_STORE16
#define ATTN_STORE16(p,v) (*(u32x4*)(p)=(v))
#endif
namespace attn_body {
using bf16x8=__attribute__((ext_vector_type(8)))short;
using s16x4=__attribute__((ext_vector_type(4)))short;
using f32x16=__attribute__((ext_vector_type(16)))float;
using u32x4=__attribute__((ext_vector_type(4)))unsigned;
constexpr int NHEAD=16,SEQ=16384,D=64,DM=4096,OM=1024;
constexpr int NW=8,QBLK=32,QB=QBLK*NW,KVBLK=64,NQB=SEQ/QB;
constexpr int ATTN_UNIT_ROWS=QB;
__device__ __forceinline__ int crow(int r,int hi){return (r&3)+8*(r>>2)+4*hi;}
#define SBAR() __builtin_amdgcn_sched_barrier(0)
__device__ __forceinline__ void cmask(f32x16&p0,f32x16&p1,int jb,int qrel,int hi){
  const float NEG=-INFINITY; int kb=64*jb+4*hi;
  #pragma unroll
  for(int r=0;r<16;++r){int kv=kb+(r&3)+8*(r>>2); if(kv>qrel)p0[r]=NEG; if(kv+32>qrel)p1[r]=NEG;}
}

constexpr int NSLOT=3, SLOTB=8192;
constexpr int LDS_K=0, LDS_V=NSLOT*SLOTB, LDS_WS=2*NSLOT*SLOTB, LDS_OST=LDS_WS+NW*64*4, LDS_BYTES=LDS_OST+NW*4096;
constexpr float C2=0.125f*1.4426950408889634f;
__device__ __forceinline__ void glds16(const void*gsrc,unsigned lds_dst){unsigned keep;
  asm volatile("s_mov_b32 %0, m0\n\ts_mov_b32 m0, %2\n\ts_nop 0\n\tglobal_load_lds_dwordx4 %1, off\n\ts_mov_b32 m0, %0":"=&s"(keep):"v"(gsrc),"s"(lds_dst):"memory");}
__device__ __forceinline__ float max3f(float a,float b,float c){float r;asm("v_max3_f32 %0, %1, %2, %3":"=v"(r):"v"(a),"v"(b),"v"(c));return r;}
__device__ __forceinline__ float max2f(float a,float b){float r;asm("v_max_f32_e32 %0, %1, %2":"=v"(r):"v"(a),"v"(b));return r;}
__device__ __forceinline__ float fadd_s(float a,float b){float r;asm("v_add_f32_e32 %0, %1, %2":"=v"(r):"v"(a),"v"(b));return r;}
__device__ __forceinline__ float fsub_s(float a,float b){float r;asm("v_sub_f32_e32 %0, %1, %2":"=v"(r):"v"(a),"v"(b));return r;}
typedef float f32x2_t __attribute__((ext_vector_type(2))); typedef __bf16 bf16x2_t __attribute__((ext_vector_type(2)));
__device__ __forceinline__ unsigned cvtpk_s(float lo,float hi){f32x2_t v={lo,hi};bf16x2_t b=__builtin_convertvector(v,bf16x2_t);return __builtin_bit_cast(unsigned,b);}
#define WAIT_BAR(N) asm volatile("s_waitcnt vmcnt(" #N ") lgkmcnt(0)\n\ts_barrier":::"memory")

__device__ __forceinline__ void qkt(f32x16&p0,f32x16&p1,const char*Kslot,const __attribute__((address_space(3))) char*qst,const f32x16&cin0,const f32x16&cin1,int r32,int hi){
  #define QF_(i) (*(const __attribute__((address_space(3))) bf16x8*)(qst+(i)*1024))
  const char*kb=Kslot+hi*1024+r32*16;
  #pragma unroll
  for(int d0=0;d0<4;++d0){
    const bf16x8 b0=*reinterpret_cast<const bf16x8*>(kb+d0*2048);
    const bf16x8 b1=*reinterpret_cast<const bf16x8*>(kb+d0*2048+512);
    const bf16x8 qd=QF_(d0);
    if(d0==0){p0=__builtin_amdgcn_mfma_f32_32x32x16_bf16(b0,qd,cin0,0,0,0);p1=__builtin_amdgcn_mfma_f32_32x32x16_bf16(b1,qd,cin1,0,0,0);}
    else{p0=__builtin_amdgcn_mfma_f32_32x32x16_bf16(b0,qd,p0,0,0,0);p1=__builtin_amdgcn_mfma_f32_32x32x16_bf16(b1,qd,p1,0,0,0);}}
  #undef QF_
}
typedef __attribute__((address_space(3))) const char* lds_cptr;
typedef short v4i16_t __attribute__((ext_vector_type(4)));
__device__ __forceinline__ void kload8(bf16x8*kf,lds_cptr kp){
  kf[0]=*(const __attribute__((address_space(3))) bf16x8*)(kp);      kf[1]=*(const __attribute__((address_space(3))) bf16x8*)(kp+512);
  kf[2]=*(const __attribute__((address_space(3))) bf16x8*)(kp+2048); kf[3]=*(const __attribute__((address_space(3))) bf16x8*)(kp+2560);
  kf[4]=*(const __attribute__((address_space(3))) bf16x8*)(kp+4096); kf[5]=*(const __attribute__((address_space(3))) bf16x8*)(kp+4608);
  kf[6]=*(const __attribute__((address_space(3))) bf16x8*)(kp+6144); kf[7]=*(const __attribute__((address_space(3))) bf16x8*)(kp+6656);
}
__device__ __forceinline__ void kload2(bf16x8*kf,lds_cptr kp,int j){ kf[2*j]=*(const __attribute__((address_space(3))) bf16x8*)(kp+j*2048); kf[2*j+1]=*(const __attribute__((address_space(3))) bf16x8*)(kp+j*2048+512); }
__device__ __forceinline__ s16x4 vtr(lds_cptr p){ return __builtin_bit_cast(s16x4,__builtin_amdgcn_ds_read_tr16_b64_v4i16((__attribute__((address_space(3))) v4i16_t*)p)); }
__device__ __forceinline__ float rowmax(const f32x16&p0,const f32x16&p1){
  float a=max3f(p0[0],p0[1],p1[0]),b=max3f(p0[2],p0[3],p1[1]);a=max3f(a,p1[2],p1[3]);
  #pragma unroll
  for(int r=4;r<16;r+=4){a=max3f(a,p0[r],p0[r+1]);b=max3f(b,p0[r+2],p0[r+3]);a=max3f(a,p1[r],p1[r+1]);b=max3f(b,p1[r+2],p1[r+3]);}
  const float m=max2f(a,b);
  auto rr=__builtin_amdgcn_permlane32_swap(__float_as_uint(m),__float_as_uint(m),false,false);
  return max2f(__uint_as_float(rr[0]),__uint_as_float(rr[1]));
}
__device__ __forceinline__ void pv(f32x16*o,int vb,bf16x8 pa0,bf16x8 pa1,bf16x8 pa2,bf16x8 pa3){
  #pragma unroll
  for(int d0=0;d0<2;++d0){s16x4 lo[4],hi[4];
    #pragma unroll
    for(int ks=0;ks<4;++ks){
      asm volatile("ds_read_b64_tr_b16 %0,%1 offset:%c2":"=&v"(lo[ks]):"v"(vb),"i"(d0*4096+ks*1024):"memory");
      asm volatile("ds_read_b64_tr_b16 %0,%1 offset:%c2":"=&v"(hi[ks]):"v"(vb),"i"(d0*4096+ks*1024+512):"memory");}
    asm volatile("s_waitcnt lgkmcnt(0)":::"memory");SBAR();
    #define PK(k) (bf16x8){lo[k][0],lo[k][1],lo[k][2],lo[k][3],hi[k][0],hi[k][1],hi[k][2],hi[k][3]}
    o[d0]=__builtin_amdgcn_mfma_f32_32x32x16_bf16(pa0,PK(0),o[d0],0,0,0);
    o[d0]=__builtin_amdgcn_mfma_f32_32x32x16_bf16(pa1,PK(1),o[d0],0,0,0);
    o[d0]=__builtin_amdgcn_mfma_f32_32x32x16_bf16(pa2,PK(2),o[d0],0,0,0);
    o[d0]=__builtin_amdgcn_mfma_f32_32x32x16_bf16(pa3,PK(3),o[d0],0,0,0);
    #undef PK
  }
}

#ifndef ATTN_STORE16
#define ATTN_STORE16(p,v) (*(u32x4*)(p)=(v))
#endif
template<int THRL> __device__ __forceinline__ void attn_unit(int h,int qb,int jstart,const bf16*Q,const bf16*__restrict__ K,const bf16*__restrict__ V,const bf16*__restrict__ OG,bf16*O,const float*__restrict__ C2h,char*shm){
  const int tid=threadIdx.x,lane=tid&63,r32=lane&31,hi=lane>>5; const int wid=__builtin_amdgcn_readfirstlane(tid>>6);
  const long rowbase=0; const int q0=qb*QB;
  const bf16*Qw=Q+(rowbase+q0+wid*QBLK)*DM+h*D;
  const bf16*Kh=K+(rowbase+(long)jstart*KVBLK)*DM+h*D,*Vh=V+(rowbase+(long)jstart*KVBLK)*DM+h*D;
  const lds_cptr shm3=(lds_cptr)shm;
  const unsigned lds0=(unsigned)(uintptr_t)shm;
  float*wsf=(float*)(shm+LDS_WS)+wid*64;
  const bf16*ksrc=Kh+(long)lane*DM+wid*8;
  const bf16*vsrc=Vh+(long)(16*(wid&3)+(lane>>2))*DM+(wid>>2)*32+(lane&3)*8;
  const unsigned kdst=lds0+LDS_K+wid*1024, vdst=lds0+LDS_V+wid*1024;
  #define DMA_K(t,slot) glds16(ksrc+(long)(t)*KVBLK*DM,(unsigned)__builtin_amdgcn_readfirstlane(kdst+(slot)))
  #define DMA_V(t,slot) glds16(vsrc+(long)(t)*KVBLK*DM,(unsigned)__builtin_amdgcn_readfirstlane(vdst+(slot)))
  const int vb0=(int)(lds0+LDS_V)+((lane>>4)&1)*32+(lane&3)*8+(4*hi+((lane&15)>>2))*64;
  const char*Kbase=shm+LDS_K; bf16x8 kf[8];
  const lds_cptr kp0=shm3+LDS_K+hi*1024+r32*16; const lds_cptr vp0=shm3+LDS_V+((lane>>4)&1)*32+(lane&3)*8+(4*hi+((lane&15)>>2))*64;
  const int NT=(q0+QB)/KVBLK-jstart;
  DMA_K(0,0);DMA_V(0,0);DMA_K(1,SLOTB);
  typedef __attribute__((address_space(3))) u32x4* lds_rptr; const lds_rptr brec=(lds_rptr)(shm3+LDS_BYTES);
  { const float cref=C2h[q0]; const float*cs=C2h+(long)jstart*KVBLK;
    int tid_e=tid; asm volatile("":"+v"(tid_e));
    for(int i_=tid_e;i_<NT*KVBLK;i_+=NW*64){ const float x_=cref-cs[i_]; const unsigned a1_=f2bf(x_); const float r1_=x_-__uint_as_float(a1_<<16); const unsigned a2_=f2bf(r1_); const float r2_=r1_-__uint_as_float(a2_<<16); const unsigned a3_=f2bf(r2_);
      brec[i_]=(u32x4){a1_|(a2_<<16),a3_,0u,0u}; }
    if(tid==0)brec[NT*KVBLK]=(u32x4){0x3F803F80u,0x00003F80u,0u,0u}; }
  const lds_cptr abp=(lds_cptr)brec+(hi?NT*KVBLK*16:r32*16); const int ast=hi?0:KVBLK*16, ab1=hi?0:32*16;
  #define ABF(t,half) (*(const __attribute__((address_space(3))) bf16x8*)(abp+(t)*ast+(half)*ab1))
  const lds_cptr qst=shm3+LDS_OST+wid*4096+lane*16;
  #pragma unroll
  for(int d0=0;d0<4;++d0){ const u32x4 qv_=*reinterpret_cast<const u32x4*>(&Qw[(long)r32*DM+d0*16+hi*8]); *(__attribute__((address_space(3))) u32x4*)(const_cast<__attribute__((address_space(3))) char*>(qst)+d0*1024)=qv_; }
  #define QF(i) (*(const __attribute__((address_space(3))) bf16x8*)(qst+(i)*1024))
  float mhat=0.f,l_reg=0.f;f32x16 o[2];o[0]=f32x16{};o[1]=f32x16{};
  u32x4 bmw=hi?(u32x4){0u,0u,0u,0u}:(u32x4){0x3F803F80u,0x00003F80u,0u,0u};
  #define SETBM() do{ const float nm_=-mhat; const unsigned a1_=f2bf(nm_); const float r1_=nm_-__uint_as_float(a1_<<16); const unsigned a2_=f2bf(r1_); const float r2_=r1_-__uint_as_float(a2_<<16); const unsigned a3_=f2bf(r2_); if(hi){bmw[0]=a1_|(a2_<<16);bmw[1]=a3_;} }while(0)
  #define BMF() __builtin_bit_cast(bf16x8,bmw)
  const f32x16 zero16=f32x16{};
  const int qrel=wid*QBLK+r32;
  #define CMASK(P0,P1,t) do{int jb_=(t)-(NT-4); if(jb_>=0)cmask(P0,P1,jb_,qrel,hi);}while(0)
  bool resc=false;
  #define START(P0,P1) do{ const float rm=rowmax(P0,P1); resc=false; \
    { const float dl=rm; mhat=fadd_s(mhat,dl); \
      _Pragma("unroll") for(int r=0;r<16;++r){P0[r]=fsub_s(P0[r],dl);P1[r]=fsub_s(P1[r],dl);} \
      SETBM(); } \
    _Pragma("unroll") for(int r=0;r<16;++r)P0[r]=__builtin_amdgcn_exp2f(P0[r]); }while(0)
  #define RESC() do{ if(resc){ asm volatile("s_waitcnt lgkmcnt(0)":::"memory"); \
      _Pragma("unroll") for(int d_=0;d_<2;++d_) _Pragma("unroll") for(int r=0;r<16;++r)o[d_][r]*=wsf[crow(r,hi)]; } }while(0)
  f32x16 pA0,pA1,pB0,pB1;
  int sl_prev=0,sl_cur=0,sl_next=SLOTB;
  #define ROT() do{sl_prev=sl_cur;sl_cur=sl_next;sl_next=(sl_next==(NSLOT-1)*SLOTB)?0:sl_next+SLOTB;}while(0)
  DMA_K(2,2*SLOTB);
  WAIT_BAR(3);
  { const f32x16 c0_=__builtin_amdgcn_mfma_f32_32x32x16_bf16(ABF(0,0),BMF(),zero16,0,0,0), c1_=__builtin_amdgcn_mfma_f32_32x32x16_bf16(ABF(0,1),BMF(),zero16,0,0,0); qkt(pA0,pA1,Kbase,qst,c0_,c1_,r32,hi); }
  asm volatile("s_nop 15\n\ts_nop 7":"+v"(pA0),"+v"(pA1));CMASK(pA0,pA1,0);
  START(pA0,pA1);
  _Pragma("unroll") for(int r=0;r<16;++r)pA1[r]=__builtin_amdgcn_exp2f(pA1[r]);
  WAIT_BAR(0);
  DMA_K(3,0);DMA_V(1,SLOTB);
  ROT();
  kload8(kf,kp0+sl_cur);
  WAIT_BAR(2);
  s16x4 vlo[8],vhi[8]; u32x4 pw0,pw1,pw2,pw3;
  #define PKW(P,B) cvtpk_s(P[B],P[B+1])
  #define PAF(k) __builtin_bit_cast(bf16x8,pw##k)
  #define VFR(i) (bf16x8){vlo[i][0],vlo[i][1],vlo[i][2],vlo[i][3],vhi[i][0],vhi[i][1],vhi[i][2],vhi[i][3]}
  #define PIN(x) asm volatile("":"+v"(x))
  #define MX3(a,b,c) __builtin_fmaxf(__builtin_fmaxf((a),(b)),(c))
  #define GAPA(MF,A0,A1,A2,A3,W0,W1,PW) do{ MF; sacc+=A0; sacc+=A1; sacc+=A2; sacc+=A3; PIN(sacc); W0; W1; PIN(PW); SBAR(); }while(0)
  #define EX(v) __builtin_amdgcn_exp2f(v)
  #define GAPB(MF,X,B) do{ MF; X[B]=EX(X[B]); X[B+1]=EX(X[B+1]); X[B+2]=EX(X[B+2]); X[B+3]=EX(X[B+3]); PIN(X); SBAR(); }while(0)
  #define VRD(i) do{ vlo[i]=vtr(vp_+(((i)>>2)*4096+((i)&3)*1024)); vhi[i]=vtr(vp_+(((i)>>2)*4096+((i)&3)*1024+512)); }while(0)
  #define KRD(G,j) do{ if(G){ kload2(kf,kp0+sl_next,j); SBAR(); } }while(0)
  #define STEP(C0,C1,P0,P1,t,GK,GV,GL) do{ SBAR(); \
    const lds_cptr vp_=vp0+sl_prev; \
    VRD(0); SBAR(); float sacc=(P0[0]+P0[1]); \
    C0=__builtin_amdgcn_mfma_f32_32x32x16_bf16(ABF(t,0),BMF(),zero16,0,0,0); C1=__builtin_amdgcn_mfma_f32_32x32x16_bf16(ABF(t,1),BMF(),zero16,0,0,0); SBAR(); \
    GAPA(C0=__builtin_amdgcn_mfma_f32_32x32x16_bf16(kf[0],QF(0),C0,0,0,0), P0[2],P0[3],P0[4],P0[5],     pw0[0]=PKW(P0,0), pw0[1]=PKW(P0,2), pw0); \
    VRD(4); SBAR(); GAPA(C1=__builtin_amdgcn_mfma_f32_32x32x16_bf16(kf[1],QF(0),C1,0,0,0), P0[6],P0[7],P0[8],P0[9],     pw0[2]=PKW(P0,4), pw0[3]=PKW(P0,6), pw0); \
    VRD(1); SBAR(); GAPA(C0=__builtin_amdgcn_mfma_f32_32x32x16_bf16(kf[2],QF(1),C0,0,0,0),   P0[10],P0[11],P0[12],P0[13], pw1[0]=PKW(P0,8), pw1[1]=PKW(P0,10), pw1); \
    VRD(5); SBAR(); GAPA(C1=__builtin_amdgcn_mfma_f32_32x32x16_bf16(kf[3],QF(1),C1,0,0,0),   P0[14],P0[15],P1[0],P1[1],   pw1[2]=PKW(P0,12),pw1[3]=PKW(P0,14), pw1); \
    VRD(2); SBAR(); GAPA(C0=__builtin_amdgcn_mfma_f32_32x32x16_bf16(kf[4],QF(2),C0,0,0,0),   P1[2],P1[3],P1[4],P1[5],     pw2[0]=PKW(P1,0), pw2[1]=PKW(P1,2), pw2); \
    VRD(6); SBAR(); GAPA(C1=__builtin_amdgcn_mfma_f32_32x32x16_bf16(kf[5],QF(2),C1,0,0,0),   P1[6],P1[7],P1[8],P1[9],     pw2[2]=PKW(P1,4), pw2[3]=PKW(P1,6), pw2); \
    VRD(3); SBAR(); GAPA(C0=__builtin_amdgcn_mfma_f32_32x32x16_bf16(kf[6],QF(3),C0,0,0,0),   P1[10],P1[11],P1[12],P1[13], pw3[0]=PKW(P1,8), pw3[1]=PKW(P1,10), pw3); \
    VRD(7); SBAR(); GAPA(C1=__builtin_amdgcn_mfma_f32_32x32x16_bf16(kf[7],QF(3),C1,0,0,0),   P1[14],P1[15],0.f,0.f,       pw3[2]=PKW(P1,12),pw3[3]=PKW(P1,14), pw3); \
    l_reg+=sacc; \
    if(GK){DMA_K((t)+3,sl_cur);} if(GV){DMA_V((t)+1,sl_next);} \
    CMASK(C0,C1,t); \
    { float a=MX3(C0[0],C0[1],C1[0]),b=MX3(C0[2],C0[3],C1[1]); a=MX3(a,C1[2],C1[3]); \
      _Pragma("unroll") for(int r=4;r<16;r+=4){a=MX3(a,C0[r],C0[r+1]);b=MX3(b,C0[r+2],C0[r+3]);a=MX3(a,C1[r],C1[r+1]);b=MX3(b,C1[r+2],C1[r+3]);} \
      float rm=__builtin_fmaxf(a,b); { auto rr=__builtin_amdgcn_permlane32_swap(__float_as_uint(rm),__float_as_uint(rm),false,false); rm=__builtin_fmaxf(__uint_as_float(rr[0]),__uint_as_float(rr[1])); } \
      resc=false; \
      if(__builtin_expect(__any(rm>(float)THRL),0)){ const float dl=__builtin_fmaxf(rm,0.f); mhat+=dl; \
        _Pragma("unroll") for(int r=0;r<16;++r){C0[r]-=dl;C1[r]-=dl;} \
        SETBM(); \
        const float f=__builtin_amdgcn_exp2f(-dl); l_reg*=f; if(hi==0)wsf[r32]=f; resc=true; } } \
    SBAR(); \
    GAPB(o[0]=__builtin_amdgcn_mfma_f32_32x32x16_bf16(PAF(0),VFR(0),o[0],0,0,0), C0,0); \
    GAPB(o[1]=__builtin_amdgcn_mfma_f32_32x32x16_bf16(PAF(0),VFR(4),o[1],0,0,0), C0,4); \
    KRD(GL,0); GAPB(o[0]=__builtin_amdgcn_mfma_f32_32x32x16_bf16(PAF(1),VFR(1),o[0],0,0,0), C0,8); \
    KRD(GL,1); GAPB(o[1]=__builtin_amdgcn_mfma_f32_32x32x16_bf16(PAF(1),VFR(5),o[1],0,0,0), C0,12); \
    KRD(GL,2); GAPB(o[0]=__builtin_amdgcn_mfma_f32_32x32x16_bf16(PAF(2),VFR(2),o[0],0,0,0), C1,0); \
    KRD(GL,3); GAPB(o[1]=__builtin_amdgcn_mfma_f32_32x32x16_bf16(PAF(2),VFR(6),o[1],0,0,0), C1,4); \
    GAPB(o[0]=__builtin_amdgcn_mfma_f32_32x32x16_bf16(PAF(3),VFR(3),o[0],0,0,0), C1,8); \
    GAPB(o[1]=__builtin_amdgcn_mfma_f32_32x32x16_bf16(PAF(3),VFR(7),o[1],0,0,0), C1,12); \
    }while(0)
  int t=1;
  #undef CMASK
  #define CMASK(P0,P1,t) do{}while(0)
  for(;t+5<NT;t+=2){
    STEP(pB0,pB1,pA0,pA1,t,true,true,true);     WAIT_BAR(2); RESC(); ROT();
    STEP(pA0,pA1,pB0,pB1,t+1,true,true,true);   WAIT_BAR(2); RESC(); ROT();
  }
  #undef CMASK
  #define CMASK(P0,P1,t) do{int jb_=(t)-(NT-4); if(jb_>=0)cmask(P0,P1,jb_,qrel,hi);}while(0)
  #define ENDW(tt) do{ if((tt)+3<NT){WAIT_BAR(2);} else if((tt)+2<NT){WAIT_BAR(1);} else {WAIT_BAR(0);} }while(0)
  for(;t+1<NT;t+=2){
    STEP(pB0,pB1,pA0,pA1,t,(t+3<NT),(t+1<NT),(t+1<NT));       ENDW(t);   RESC(); ROT();
    STEP(pA0,pA1,pB0,pB1,t+1,(t+4<NT),(t+2<NT),(t+2<NT));     ENDW(t+1); RESC(); ROT();
  }
  STEP(pB0,pB1,pA0,pA1,NT-1,false,false,false); RESC();
  { float sacc=pB0[0]+pB0[1]; _Pragma("unroll") for(int r=2;r<16;++r)sacc+=pB0[r]; _Pragma("unroll") for(int r=0;r<16;++r)sacc+=pB1[r]; l_reg+=sacc;
    pw0=(u32x4){PKW(pB0,0),PKW(pB0,2),PKW(pB0,4),PKW(pB0,6)};pw1=(u32x4){PKW(pB0,8),PKW(pB0,10),PKW(pB0,12),PKW(pB0,14)};pw2=(u32x4){PKW(pB1,0),PKW(pB1,2),PKW(pB1,4),PKW(pB1,6)};pw3=(u32x4){PKW(pB1,8),PKW(pB1,10),PKW(pB1,12),PKW(pB1,14)};
    SBAR(); pv(o,vb0+sl_cur,PAF(0),PAF(1),PAF(2),PAF(3)); }
  #undef PKW
  #undef PAF
  #undef VFR
  #undef PIN
  #undef MX3
  #undef GAPA
  #undef GAPB
  #undef EX
  #undef VRD
  #undef KRD
  #undef STEP
  #undef ENDW
  {auto rr=__builtin_amdgcn_permlane32_swap(__float_as_uint(l_reg),__float_as_uint(l_reg),false,false);l_reg=__uint_as_float(rr[0])+__uint_as_float(rr[1]);}
  int lane_e=lane; asm volatile("":"+v"(lane_e));
  const int r32e=lane_e&31,hie=lane_e>>5;
  if(hie==0)wsf[32+r32e]=l_reg;asm volatile("s_waitcnt lgkmcnt(0)":::"memory");
  float rli[16];
  #pragma unroll
  for(int r=0;r<16;++r)rli[r]=__builtin_amdgcn_rcpf(wsf[32+crow(r,hie)]);
  bf16*Ow=O+(rowbase+q0+wid*QBLK)*OM+h*D; const bf16*OGw=OG+(rowbase+q0+wid*QBLK)*DM+h*D;
  { bf16*stg=(bf16*)(shm+LDS_OST)+wid*2048;
    #pragma unroll
    for(int r=0;r<16;++r){const int orow=crow(r,hie);
      #pragma unroll
      for(int d0=0;d0<2;++d0)stg[orow*64+d0*32+r32e]=(bf16)f2bf(o[d0][r]*rli[r]);}
    asm volatile("s_waitcnt lgkmcnt(0)":::"memory");
    #pragma unroll
    for(int i=0;i<4;++i){const int row=i*8+(lane_e>>3),ch=lane_e&7; const u32x4 v=*(const u32x4*)(stg+row*64+ch*8); const u32x4 g=*(const u32x4*)(OGw+(long)row*DM+ch*8); u32x4 w;
      #pragma unroll
      for(int e=0;e<4;++e){ const float lo=bflo(v[e])*sigmoidf_(bflo(g[e])), hh_=bfhi(v[e])*sigmoidf_(bfhi(g[e])); w[e]=pk2(lo,hh_); }
      ATTN_STORE16(Ow+(long)row*OM+ch*8,w);} }
  asm volatile("s_waitcnt lgkmcnt(0)\n\ts_barrier":::"memory");
  #undef QF
  #undef ABF
  #undef SETBM
  #undef BMF
  #undef DMA_K
  #undef DMA_V
  #undef CMASK
  #undef START
  #undef RESC
  #undef ROT
}
constexpr int ATTN_LDS_BYTES=LDS_BYTES;
#undef SBAR
#undef WAIT_BAR
}

constexpr int KP = 144;
__device__ __forceinline__ void p14_attention(Frame& F, const Args& a, int qword = CW_ATTQ) {
    const int tid0 = F.tid, lane0 = F.lane;
    const bf16* QKVG = (const bf16*)(F.ws + WS_QKVG); const float* C2 = (const float*)(F.ws + WS_C2); const float* CB = (const float*)(F.ws + WS_CB);
    bf16* Z2 = (bf16*)(F.ws + WS_Z2);
    LAS unsigned char* Ks = F.lds; LAS unsigned char* Vs = F.lds + 64 * KP; LAS float* bias = (LAS float*)(F.lds + 2 * 64 * KP); LAS int* uslot = (LAS int*)(F.lds + RING_BYTES + 192);
    constexpr int ATT_MAXT = (RING_BYTES - attn_body::ATTN_LDS_BYTES - 16) / 1024;
    float mq = 0.f, mk = 0.f;
    for (int i = 0; i < 64; ++i) { mq = fmaxf(mq, fabsf(a.in[21][i])); mk = fmaxf(mk, fabsf(a.in[22][i])); }
    const float THR2 = (2.f * 8.f * mq * mk * 1.01f + 30.f) * LOG2E;
    gu32* qctr = F.ctl + qword;
    for (;;) {
        __syncthreads();
        if (tid0 == 0) uslot[0] = (int)__hip_atomic_fetch_add(qctr, 1u, RLX_AGENT);
        __syncthreads();
        const int unit = uslot[0];
        if (unit >= NH * (T / 256)) break;
        const int h = unit & 15, qb = (T / 256 - 1) - (unit >> 4), q0 = qb * 256;
        const float ct0 = C2[(size_t)h * T + q0];
        int jstart = 0;
        { int tot = 0; for (int j0 = 0; j0 < 4 * qb; j0 += 64) { const int j = j0 + lane0; const bool skip = (j < 4 * qb) && ((ct0 - CB[h * 256 + j]) < -THR2); tot += __popcll(__ballot(skip)); } jstart = tot; }
        jstart &= ~1;
        if (4 * qb + 4 - jstart <= ATT_MAXT) {
            attn_body::attn_unit<8>(h, qb, jstart, QKVG, QKVG + D, QKVG + 2 * D, QKVG + 3 * D, Z2, C2 + (size_t)h * T, (char*)F.lds);
            continue;
        }
        int tid_s = F.tid; asm volatile("" : "+v"(tid_s));
        const int tid = tid_s, lane = tid & 63, wid = F.wave, r32 = lane & 31, hi = lane >> 5;
        const int jend = 4 * qb + 3;
        const int qrow = q0 + wid * 32 + r32;
        bf16x8 qr[4];
#pragma unroll
        for (int d0 = 0; d0 < 4; ++d0) qr[d0] = *(const bf16x8*)(QKVG + (size_t)qrow * 4096 + h * 64 + d0 * 16 + hi * 8);
        f32x16 o0 = {}, o1 = {}; float m = -INFINITY, l = 0.f;
        const int lrow = tid >> 3, lch = tid & 7;
        u32x4 kreg, vreg; float breg = 0.f;
        auto gload = [&](int j) { const size_t row = (size_t)(64 * j + lrow) * 4096 + h * 64 + lch * 8;
            kreg = *(const u32x4*)(QKVG + row + D); vreg = *(const u32x4*)(QKVG + row + 2 * D); if (tid < 64) breg = -C2[(size_t)h * T + 64 * j + tid]; };
        gload(jstart);
        for (int j = jstart; j <= jend; ++j) {
            __syncthreads();
            *(LAS u32x4*)(Ks + lrow * KP + lch * 16) = kreg;
            { const int s_ = lrow >> 4, x_ = lrow & 15, p_ = s_ * 16 + ((x_ >> 2) & 1) * 8 + (((x_ >> 3) << 2) | (x_ & 3));
                const unsigned w_[4] = {vreg.x, vreg.y, vreg.z, vreg.w};
#pragma unroll
                for (int e = 0; e < 8; ++e) *(LAS unsigned short*)(Vs + (lch * 8 + e) * KP + p_ * 2) = (unsigned short)(w_[e >> 1] >> ((e & 1) * 16)); }
            if (tid < 64) bias[tid] = breg;
            __syncthreads();
            if (j < jend) gload(j + 1);
            f32x16 p0 = {}, p1 = {};
#pragma unroll
            for (int d0 = 0; d0 < 4; ++d0) {
                const bf16x8 k0 = *(const LAS bf16x8*)(Ks + r32 * KP + d0 * 32 + hi * 16);
                const bf16x8 k1 = *(const LAS bf16x8*)(Ks + (32 + r32) * KP + d0 * 32 + hi * 16);
                p0 = __builtin_amdgcn_mfma_f32_32x32x16_bf16(k0, qr[d0], p0, 0, 0, 0);
                p1 = __builtin_amdgcn_mfma_f32_32x32x16_bf16(k1, qr[d0], p1, 0, 0, 0);
            }
#pragma unroll
            for (int g4 = 0; g4 < 4; ++g4) { const f32x4 b0 = *(const LAS f32x4*)(bias + 8 * g4 + 4 * hi), b1 = *(const LAS f32x4*)(bias + 32 + 8 * g4 + 4 * hi);
#pragma unroll
                for (int i = 0; i < 4; ++i) { p0[4 * g4 + i] += b0[i]; p1[4 * g4 + i] += b1[i]; } }
            if (j >= 4 * qb) {
                const int kb = 64 * j;
#pragma unroll
                for (int r = 0; r < 16; ++r) { const int kv = kb + crow(r, hi); if (kv > qrow) p0[r] = -INFINITY; if (kv + 32 > qrow) p1[r] = -INFINITY; }
            }
            float mloc = fmaxf(p0[0], p1[0]);
#pragma unroll
            for (int r = 1; r < 16; ++r) mloc = fmaxf(mloc, fmaxf(p0[r], p1[r]));
            mloc = fmaxf(mloc, __shfl_xor(mloc, 32));
            const float mnew = fmaxf(m, mloc);
            const float alpha = exp2f(m - mnew);
            float ls = 0.f;
#pragma unroll
            for (int r = 0; r < 16; ++r) { p0[r] = exp2f(p0[r] - mnew); p1[r] = exp2f(p1[r] - mnew); ls += p0[r] + p1[r]; }
            l = l * alpha + ls; m = mnew;
#pragma unroll
            for (int r = 0; r < 16; ++r) { o0[r] *= alpha; o1[r] *= alpha; }
#pragma unroll
            for (int s = 0; s < 4; ++s) {
                u32x4 pw;
                if (s == 0) pw = (u32x4){pk2(p0[0], p0[1]), pk2(p0[2], p0[3]), pk2(p0[4], p0[5]), pk2(p0[6], p0[7])};
                else if (s == 1) pw = (u32x4){pk2(p0[8], p0[9]), pk2(p0[10], p0[11]), pk2(p0[12], p0[13]), pk2(p0[14], p0[15])};
                else if (s == 2) pw = (u32x4){pk2(p1[0], p1[1]), pk2(p1[2], p1[3]), pk2(p1[4], p1[5]), pk2(p1[6], p1[7])};
                else pw = (u32x4){pk2(p1[8], p1[9]), pk2(p1[10], p1[11]), pk2(p1[12], p1[13]), pk2(p1[14], p1[15])};
                const bf16x8 pf = __builtin_bit_cast(bf16x8, pw);
                const bf16x8 v0 = *(const LAS bf16x8*)(Vs + r32 * KP + s * 32 + hi * 16);
                const bf16x8 v1 = *(const LAS bf16x8*)(Vs + (32 + r32) * KP + s * 32 + hi * 16);
                o0 = __builtin_amdgcn_mfma_f32_32x32x16_bf16(v0, pf, o0, 0, 0, 0);
                o1 = __builtin_amdgcn_mfma_f32_32x32x16_bf16(v1, pf, o1, 0, 0, 0);
            }
        }
        l += __shfl_xor(l, 32);
        const float rl = 1.f / l;
#pragma unroll
        for (int dt = 0; dt < 2; ++dt)
#pragma unroll
            for (int g4 = 0; g4 < 4; ++g4) { const int d = 32 * dt + 8 * g4 + 4 * hi; const size_t col = (size_t)h * 64 + d;
                const u32x2 ogw = *(const u32x2*)(QKVG + (size_t)qrow * 4096 + 3 * D + col);
                const float og[4] = {bflo(ogw.x), bfhi(ogw.x), bflo(ogw.y), bfhi(ogw.y)}; float ov[4];
#pragma unroll
                for (int i = 0; i < 4; ++i) ov[i] = (dt == 0 ? o0[4 * g4 + i] : o1[4 * g4 + i]) * rl * sigmoidf_(og[i]);
                u32x2 w; w.x = pk2(ov[0], ov[1]); w.y = pk2(ov[2], ov[3]);
                *(u32x2*)(Z2 + (size_t)qrow * D + col) = w; }
    }
}

struct TokInfo { int e0, e1, p0, p1; float g0, g1; int d0, d1; };
__device__ __forceinline__ void p16_router(Frame& F, const Args& a) {
    const int lane = F.lane, tid = F.tid; const float* Hs = (const float*)(F.ws + WS_H); bf16* U = (bf16*)(F.ws + WS_U4);
    TokInfo* TI = (TokInfo*)(F.ws + WS_TOK);
    LAS float* wr_ = (LAS float*)F.lds;
    LAS int* lcnt = (LAS int*)(F.lds + 32768);
    const Row gr = ld_row(a.in[1] + 3 * D, lane);
    __syncthreads();
    for (int i = tid; i < NE * D; i += NTHREADS) { const int e = i & 7, k = i >> 3; wr_[e * D + k] = a.in[26][(size_t)k * NE + e]; }
    for (int tb = F.vcu * 64; tb < T; tb += F.G * 64) {
        __syncthreads();
        if (tid < 16) lcnt[tid] = 0;
        __syncthreads();
        int e0s[8], e1s[8], p0s[8], p1s[8]; float g0s[8];
#pragma unroll
        for (int q = 0; q < 8; ++q) { const int t = tb + F.wave * 8 + q;
            const Row u = rmsnorm_row(ld_row(Hs + (size_t)t * D, lane), gr);
            st_row_bf16(U + (size_t)t * D, lane, u);
            float lg[NE];
#pragma unroll
            for (int e = 0; e < NE; ++e) { float s = 0.f;
#pragma unroll
                for (int j = 0; j < 4; ++j) { const f32x4 w = *(const LAS f32x4*)(wr_ + e * D + 256 * j + 4 * lane); s += (u.v[j][0] * w[0] + u.v[j][1] * w[1]) + (u.v[j][2] * w[2] + u.v[j][3] * w[3]); }
                lg[e] = wave_sum(s); }
            int b0 = 0; float v0 = lg[0];
#pragma unroll
            for (int e = 1; e < NE; ++e) if (lg[e] > v0) { v0 = lg[e]; b0 = e; }
            int b1 = -1; float v1 = -INFINITY;
#pragma unroll
            for (int e = 0; e < NE; ++e) if (e != b0 && lg[e] > v1) { v1 = lg[e]; b1 = e; }
            e0s[q] = b0; e1s[q] = b1; g0s[q] = 1.f / (1.f + __expf(v1 - v0));
            int pa = 0, pb = 0;
            if (lane == 0) { pa = atomicAdd((int*)&lcnt[b0], 1); pb = atomicAdd((int*)&lcnt[b1], 1); }
            p0s[q] = pa; p1s[q] = pb;
        }
        __syncthreads();
        if (tid < NE) lcnt[8 + tid] = (int)__hip_atomic_fetch_add(F.ctl + CW_CNT + 64 * tid, (unsigned)lcnt[tid], RLX_AGENT);
        __syncthreads();
        if (lane == 0) {
#pragma unroll
            for (int q = 0; q < 8; ++q) { const int t = tb + F.wave * 8 + q; TokInfo ti; ti.e0 = e0s[q]; ti.e1 = e1s[q]; ti.p0 = lcnt[8 + e0s[q]] + p0s[q]; ti.p1 = lcnt[8 + e1s[q]] + p1s[q];
                ti.g0 = g0s[q]; ti.g1 = 1.f - g0s[q]; ti.d0 = 0; ti.d1 = 0; TI[t] = ti; }
        }
    }
    __syncthreads();
}
__device__ __forceinline__ int moe_ends(Frame& F, LAS int* ends) {
    __syncthreads();
    if (F.tid == 0) { int run = 0; for (int e = 0; e < NE; ++e) { const int c = (int)__hip_atomic_load(F.ctl + CW_CNT + 64 * e, RLX_AGENT); run += (c + 255) >> 8; ends[e] = run; } }
    __syncthreads();
    return ends[NE - 1];
}
__device__ __forceinline__ void p17_gather(Frame& F) {
    LAS int* ends = (LAS int*)(F.lds + RING_BYTES);
    moe_ends(F, ends);
    const bf16* U = (const bf16*)(F.ws + WS_U4); bf16* AM = (bf16*)(F.ws + WS_AM); TokInfo* TI = (TokInfo*)(F.ws + WS_TOK);
    for (int t = F.gw; t < T; t += F.NGW) {
        const TokInfo ti = TI[t];
        const int d0 = (ti.e0 ? ends[ti.e0 - 1] : 0) * 256 + ti.p0, d1 = (ti.e1 ? ends[ti.e1 - 1] : 0) * 256 + ti.p1;
        const u32x4* src = (const u32x4*)(U + (size_t)t * D) + F.lane; const u32x4 x0 = src[0], x1 = src[64];
        u32x4* o0 = (u32x4*)(AM + (size_t)d0 * D) + F.lane; o0[0] = x0; o0[64] = x1;
        u32x4* o1 = (u32x4*)(AM + (size_t)d1 * D) + F.lane; o1[0] = x0; o1[64] = x1;
        if (F.lane == 0) { TI[t].d0 = d0; TI[t].d1 = d1; }
    }
}
__device__ __forceinline__ void p20_combine(Frame& F, const Args& a) {
    const int lane = F.lane; const float* Hs = (const float*)(F.ws + WS_H); const bf16* YS = (const bf16*)(F.ws + WS_YS); const TokInfo* TI = (const TokInfo*)(F.ws + WS_TOK);
    const Row gr = ld_row(a.in[2], lane);
    for (int t = F.gw; t < T; t += F.NGW) {
        const TokInfo ti = TI[t];
        Row hrow = ld_row(Hs + (size_t)t * D, lane); const Row y0 = ld_row_bf16(YS + (size_t)ti.d0 * D, lane), y1 = ld_row_bf16(YS + (size_t)ti.d1 * D, lane);
#pragma unroll
        for (int j = 0; j < 4; ++j) hrow.v[j] = hrow.v[j] + ti.g0 * y0.v[j] + ti.g1 * y1.v[j];
        st_row(a.out + (size_t)t * D, lane, rmsnorm_row(hrow, gr));
    }
}

constexpr int N_PHASES = 21;
__global__ void __launch_bounds__(NTHREADS, 2) trunk_fwd(Args args) {
    extern __shared__ __attribute__((aligned(16))) unsigned char lds_raw[];
    Frame F;
    F.lds = (LAS unsigned char*)lds_raw; F.ws = args.ws; F.ctl = (gu32*)(args.ws + WS_CTL);
    F.tid = threadIdx.x; F.lane = F.tid & 63; F.wave = __builtin_amdgcn_readfirstlane(F.tid >> 6);
    F.G = gridDim.x; { const int bx = blockIdx.x; F.vcu = (F.G % 8 == 0) ? (bx % 8) * (F.G / 8) + bx / 8 : bx; }
    F.gw = F.vcu * NWAVES + F.wave; F.NGW = F.G * NWAVES;
    volatile LAS unsigned* MISC = (volatile LAS unsigned*)(F.lds + MISC_OFF);
    for (int u = F.tid; u < (LDS_BYTES - RING_BYTES) / 4; u += NTHREADS) ((LAS unsigned*)(F.lds + RING_BYTES))[u] = 0u;
    __syncthreads();
    const int lo = args.ph_lo, hi = args.ph_hi;
    const bool use_bar = (hi - lo) > 1;
    XcdBarrier bar; bar.bar = (unsigned*)(F.ctl + CW_BAR); bar.x = 0; bar.st = nullptr;
    if (use_bar) bar = xcd_barrier_post((unsigned*)(F.ctl + CW_BAR), MISC + 8);
#ifdef ONLY_PHASE
#define IN(k) ((k) == ONLY_PHASE && lo <= (k) && (k) < hi)
#else
#define IN(k) (lo <= (k) && (k) < hi)
#endif
#define SEAM(k) do { if (IN((k) + 1)) xcd_barrier(bar); } while (0)
#define REP(k) for (int rep_ = 0; rep_ < ((DUP_PHASE == (k)) ? 2 : 1); ++rep_, (void)((rep_ < ((DUP_PHASE == (k)) ? 2 : 1)) ? (xcd_barrier(bar), 0) : 0))
    unsigned char* ws = args.ws;
    const int c = (int)blockIdx.x;
    LAS unsigned char* ring = F.lds;

    if (IN(0)) REP(0) { p0_prologue(F, args); p1_shift(F, args); } SEAM(0);
    if (IN(1)) REP(1) {
        { pg8::Gemm g{D, D, D}; pg8::SchedRKV S; S.o.init(T / 256, 12, F.G, c); S.A = (const char*)(ws + WS_XS); S.B = (const char*)(ws + WS_W_RKV); S.astep = (size_t)256 * D * 2; S.bstep = (size_t)256 * D * 2; S.azstride = (size_t)T * D * 2;
          pg8::EpiRKV E{(bf16*)(ws + WS_R), (size_t)(WS_K - WS_R) / 2};
          pg8::gemm_phase<pg8::EpiRKV, pg8::SchedRKV, true>(ring, g, S, E); }
        { pg8::Gemm g{D, 2 * D, 2 * D}; pg8::SchedPlain S; S.o.init(T / 256, 1, F.G, c); S.A = (const char*)(ws + WS_UB); S.B = (const char*)(ws + WS_W_L1); S.astep = (size_t)256 * D * 2; S.bstep = (size_t)256 * 2 * D * 2;
          pg8::EpiL1 E{(bf16*)(ws + WS_L1)};
          pg8::gemm_phase<pg8::EpiL1, pg8::SchedPlain, true>(ring, g, S, E); }
        } SEAM(1);
    if (IN(2)) REP(2) {
        pg8::Gemm g{256, 256, 256}; pg8::SchedPlain S; S.o.init(T / 256, 12, F.G, c); S.A = (const char*)(ws + WS_L1); S.B = (const char*)(ws + WS_W_L2); S.astep = (size_t)256 * 256 * 2; S.bstep = (size_t)256 * 256 * 2;
        static_assert(WS_AA - WS_LW == WS_G - WS_AA, "LW, AA, G evenly spaced");
        pg8::EpiL2 E{(float*)(ws + WS_LW), args.in[5], args.in[8]};
        pg8::gemm_phase<pg8::EpiL2, pg8::SchedPlain, true>(ring, g, S, E);
        } SEAM(2);
    if (IN(3)) REP(3) { p3_prep(F, args); } SEAM(3);
    if (IN(4)) REP(4) { pa_chunk(F); } SEAM(4);
    if (IN(5)) REP(5) { pb_chain(F); } SEAM(5);
    if (IN(6)) REP(6) { pc_out(F); } SEAM(6);
    if (IN(7)) REP(7) { p6_gn_rows(F, args); } SEAM(7);
    if (IN(8)) REP(8) {
        pg8::Gemm g{D, D, D}; pg8::SchedPlain S; S.o.init(T / 256, 4, F.G, c); S.A = (const char*)(ws + WS_Z); S.B = (const char*)(ws + WS_W_O0); S.astep = (size_t)256 * D * 2; S.bstep = (size_t)256 * D * 2;
        pg8::EpiRes E{args.in[0], (float*)(ws + WS_H)};
        pg8::gemm_phase<pg8::EpiRes, pg8::SchedPlain, true>(ring, g, S, E);
        } SEAM(8);
    if (IN(9)) REP(9) { p8_norm(F, args.in[1] + D, (bf16*)(ws + WS_U2)); } SEAM(9);
    if (IN(10)) REP(10) {
        pg8::Gemm g{D, D, D}; pg8::SchedPlain S; S.o.init(T / 256, 2 * FF / 256, F.G, c); S.A = (const char*)(ws + WS_U2); S.B = (const char*)(ws + WS_W_GU); S.astep = (size_t)256 * D * 2; S.bstep = (size_t)256 * D * 2;
        pg8::EpiSwiGLU E{(bf16*)(ws + WS_ACT)};
        pg8::gemm_phase<pg8::EpiSwiGLU, pg8::SchedPlain, true>(ring, g, S, E);
        } SEAM(10);
    if (IN(11)) REP(11) {
        pg8::Gemm g{FF, FF, FF}; pg8::SchedPlain S; S.o.init(T / 256, 4, F.G, c); S.A = (const char*)(ws + WS_ACT); S.B = (const char*)(ws + WS_W_DN); S.astep = (size_t)256 * FF * 2; S.bstep = (size_t)256 * FF * 2;
        pg8::EpiRes E{(const float*)(ws + WS_H), rep_ ? (float*)(ws + WS_Y) : (float*)(ws + WS_H)};
        pg8::gemm_phase<pg8::EpiRes, pg8::SchedPlain, true>(ring, g, S, E);
        } SEAM(11);
    if (IN(12)) REP(12) { p11_norm_forget(F, args); } SEAM(12);
    if (IN(13)) REP(13) {
        pg8::Gemm g{D, D, D}; pg8::SchedPlain S; S.o.init(T / 256, 16, F.G, c); S.A = (const char*)(ws + WS_U3); S.B = (const char*)(ws + WS_W_IN); S.astep = (size_t)256 * D * 2; S.bstep = (size_t)256 * D * 2;
        pg8::EpiBf16 E{(bf16*)(ws + WS_QKVG), 4096};
        pg8::gemm_phase<pg8::EpiBf16, pg8::SchedPlain, true>(ring, g, S, E);
        } SEAM(13);
    if (IN(14)) REP(14) { p13_cumsum_qknorm(F, args); } SEAM(14);
    if (IN(15)) REP(15) { p14_attention(F, args, CW_ATTQ + 64 * rep_); } SEAM(15);
    if (IN(16)) REP(16) {
        pg8::Gemm g{D, D, D}; pg8::SchedPlain S; S.o.init(T / 256, 4, F.G, c); S.A = (const char*)(ws + WS_Z2); S.B = (const char*)(ws + WS_W_FO); S.astep = (size_t)256 * D * 2; S.bstep = (size_t)256 * D * 2;
        pg8::EpiRes E{(const float*)(ws + WS_H), rep_ ? (float*)(ws + WS_Y) : (float*)(ws + WS_H)};
        pg8::gemm_phase<pg8::EpiRes, pg8::SchedPlain, true>(ring, g, S, E);
        } SEAM(16);
    if (IN(17)) REP(17) { p16_router(F, args); } SEAM(17);
    if (IN(18)) REP(18) { p17_gather(F); } SEAM(18);
    if (IN(19)) REP(19) {
        LAS int* ends = (LAS int*)(F.lds + RING_BYTES); const int nblk = moe_ends(F, ends);
        pg8::Gemm g{D, D, D}; pg8::SchedMoe S; S.o.init(nblk, 2 * FF / 256, F.G, c); S.A = (const char*)(ws + WS_AM); S.B = (const char*)(ws + WS_W_MGU); S.astep = (size_t)256 * D * 2; S.bstep = (size_t)256 * D * 2; S.bestride = (size_t)2 * FF * D * 2; S.ends = ends;
        pg8::EpiSwiGLU E{(bf16*)(ws + WS_ACT2)};
        pg8::gemm_phase<pg8::EpiSwiGLU, pg8::SchedMoe, true>(ring, g, S, E);
        } SEAM(19);
    if (IN(20)) REP(20) {
        LAS int* ends = (LAS int*)(F.lds + RING_BYTES); const int nblk = moe_ends(F, ends);
        pg8::Gemm g{FF, FF, FF}; pg8::SchedMoe S; S.o.init(nblk, 4, F.G, c); S.A = (const char*)(ws + WS_ACT2); S.B = (const char*)(ws + WS_W_MDN); S.astep = (size_t)256 * FF * 2; S.bstep = (size_t)256 * FF * 2; S.bestride = (size_t)D * FF * 2; S.ends = ends;
        pg8::EpiBf16 E{(bf16*)(ws + WS_YS), D};
        pg8::gemm_phase<pg8::EpiBf16, pg8::SchedMoe, true>(ring, g, S, E);
        } SEAM(20);
    if (IN(21)) REP(21) { p20_combine(F, args); }
#undef IN
#undef SEAM
#undef REP
}

extern "C" void kernel_launch(void* const* d_in, const int* in_sizes, int n_in, void* d_out, int out_size, void* d_ws, size_t ws_size, hipStream_t stream) {
    static int grid = 0;
    if (grid == 0) {
        if (n_in != 29 || out_size != T * D || ws_size < WS_END) { fprintf(stderr, "kernel_launch: unexpected problem (n_in %d out %d ws %zu)\n", n_in, out_size, ws_size); grid = -1; return; }
        int dev = 0, cus = 0;
        if (hipGetDevice(&dev) != hipSuccess || hipDeviceGetAttribute(&cus, hipDeviceAttributeMultiprocessorCount, dev) != hipSuccess) { grid = -1; return; }
        if (hipFuncSetAttribute((const void*)trunk_fwd, hipFuncAttributeMaxDynamicSharedMemorySize, LDS_BYTES) != hipSuccess) { fprintf(stderr, "kernel_launch: hipFuncSetAttribute failed\n"); grid = -1; return; }
        int per_cu = 0;
        if (hipOccupancyMaxActiveBlocksPerMultiprocessor(&per_cu, (const void*)trunk_fwd, NTHREADS, LDS_BYTES) != hipSuccess || per_cu < 1) fprintf(stderr, "kernel_launch: occupancy query says %d\n", per_cu);
        (void)hipGetLastError();
        grid = cus;
    }
    if (grid < 0) return;
    (void)hipMemsetAsync((char*)d_ws + WS_CTL, 0, CTL_ZERO_BYTES, stream);
    Args a{};
    for (int i = 0; i < 29; ++i) a.in[i] = (const float*)d_in[i];
    a.out = (float*)d_out; a.ws = (unsigned char*)d_ws;
    constexpr int NPH = 22;
    if (LAUNCH_MODE == 1) { a.ph_lo = 0; a.ph_hi = NPH; hipLaunchKernelGGL(trunk_fwd, dim3(grid), dim3(NTHREADS), LDS_BYTES, stream, a); }
    else for (int p = 0; p < NPH; ++p) { a.ph_lo = p; a.ph_hi = p + 1; hipLaunchKernelGGL(trunk_fwd, dim3(grid), dim3(NTHREADS), LDS_BYTES, stream, a); }
}
```

```cpp
#include <hip/hip_runtime.h>
#include <cstdio>
#include <cstdint>

#ifndef DUP_PHASE
#define DUP_PHASE -1
#endif
#ifndef LAUNCH_MODE
#define LAUNCH_MODE 1
#endif

#define GAS __attribute__((address_space(1)))
#define LAS __attribute__((address_space(3)))
typedef unsigned short bf16;
typedef short bf16x8 __attribute__((ext_vector_type(8)));
typedef float f32x4 __attribute__((ext_vector_type(4)));
typedef float f32x2 __attribute__((ext_vector_type(2)));
typedef float f32x16 __attribute__((ext_vector_type(16)));
typedef unsigned u32x4 __attribute__((ext_vector_type(4)));
typedef unsigned u32x2 __attribute__((ext_vector_type(2)));
typedef GAS unsigned gu32;
#define RLX_AGENT __ATOMIC_RELAXED, __HIP_MEMORY_SCOPE_AGENT

constexpr int T = 16384, D = 1024, NH = 16, HD = 64, FF = 3584, NE = 8, WIN_LD = 4 * D + NH;
constexpr int NWAVES = 8, NTHREADS = 512;
constexpr float RMS_EPS = 1e-6f, GN_EPS = 64e-5f;
constexpr int MOE_ROWS = (2 * T / 256 + NE) * 256;
constexpr float LOG2E = 1.4426950408889634f;

constexpr size_t MiB = 1u << 20;
constexpr size_t WS_CTL = 0, CTL_ZERO_BYTES = 1 * MiB;
constexpr size_t WS_W_RKV = 2 * MiB, WS_W_L1 = 8 * MiB, WS_W_L2 = 9 * MiB, WS_W_O0 = 11 * MiB, WS_W_GU = 13 * MiB, WS_W_DN = 27 * MiB,
                 WS_W_IN = 34 * MiB, WS_W_FO = 42 * MiB, WS_W_MGU = 44 * MiB, WS_W_MDN = 156 * MiB;
constexpr size_t WS_H = 216 * MiB;
constexpr size_t WS_UB = 280 * MiB, WS_XS = 313 * MiB;
constexpr size_t WS_KK = 280 * MiB, WS_BB = 344 * MiB;
constexpr size_t WS_Z = 410 * MiB  , WS_U2 = 344 * MiB;
constexpr size_t WS_U3 = 280 * MiB, WS_Z2 = 312 * MiB, WS_U4 = 280 * MiB, WS_AM = 312 * MiB;
constexpr size_t WS_R = 410 * MiB, WS_K = 474 * MiB, WS_V = 538 * MiB;
constexpr size_t WS_ACT = 410 * MiB;
constexpr size_t WS_QKVG = 410 * MiB;
constexpr size_t WS_ACT2 = 410 * MiB;
constexpr size_t WS_LW = 602 * MiB, WS_AA = 666 * MiB, WS_G = 730 * MiB;
constexpr size_t WS_YT = 666 * MiB;
constexpr size_t WS_YS = 666 * MiB;
constexpr size_t WS_L1 = 794 * MiB;
constexpr size_t WS_CS = 802 * MiB;
constexpr size_t WS_LF = 806 * MiB, WS_C2 = 807 * MiB, WS_CB = 808 * MiB, WS_TOK = 809 * MiB;
constexpr size_t WS_END = 810 * MiB;
constexpr size_t WS_AT = 280 * MiB, WS_RT = 312 * MiB, WS_BH = 344 * MiB, WS_KH = 376 * MiB;
constexpr size_t WS_V16 = 538 * MiB  , WS_GC = 248 * MiB;
constexpr size_t WS_QM = 410 * MiB, WS_PLR = 474 * MiB, WS_TM = 506 * MiB, WS_S0 = 570 * MiB;
constexpr size_t WS_Y = 602 * MiB;
constexpr int NCH = T / 64;
constexpr int CW_TMO = 0, CW_BAR = 4096, CW_CNT = 8192, CW_ATTQ = 9216;

constexpr int RING_BYTES = 131072, MISC_OFF = RING_BYTES + 320, LDS_BYTES = 147456;

__device__ __forceinline__ unsigned f2bf(float f) { unsigned u = __builtin_bit_cast(unsigned, f); return (u + 0x7fffu + ((u >> 16) & 1u)) >> 16; }
__device__ __forceinline__ unsigned pk2(float lo, float hi) { return f2bf(lo) | (f2bf(hi) << 16); }
__device__ __forceinline__ float bf2f(unsigned short b) { return __builtin_bit_cast(float, (unsigned)b << 16); }
__device__ __forceinline__ float bflo(unsigned w) { return __builtin_bit_cast(float, w << 16); }
__device__ __forceinline__ float bfhi(unsigned w) { return __builtin_bit_cast(float, w & 0xffff0000u); }
__device__ __forceinline__ float wave_sum(float v) {
#pragma unroll
    for (int o = 1; o < 64; o <<= 1) v += __shfl_xor(v, o);
    return v;
}
__device__ __forceinline__ float row16_sum(float v) {
#pragma unroll
    for (int o = 1; o < 16; o <<= 1) v += __shfl_xor(v, o);
    return v;
}
__device__ __forceinline__ float sigmoidf_(float x) { return 1.f / (1.f + __expf(-x)); }
#define LDS_WAIT() asm volatile("s_waitcnt lgkmcnt(0)" ::: "memory")
__device__ __forceinline__ int crow(int r, int hi) { return (r & 3) + 8 * (r >> 2) + 4 * hi; }

namespace pg8 {
constexpr int BM = 256, BK = 64, HALF = 128, HTB = HALF * BK * 2, STAGE_BYTES = 8 * HTB, NXCD = 8, WGM = 8;
__host__ __device__ __forceinline__ int lds_byte(int r, int c) { const int st = (r >> 4) * 2 + (c >> 5), rr = r & 15, cc = c & 31, ob = rr * 64 + cc * 2; return st * 1024 + (ob ^ (((ob >> 9) & 1) << 5)); }
__host__ __device__ __forceinline__ void stage_rc(int b, int& R, int& C) { const int st = b / 1024, sb = b % 1024, swz = sb ^ (((sb >> 9) & 1) << 5); R = (st >> 1) * 16 + swz / 64; C = (st & 1) * 32 + (swz % 64) / 2; }
__host__ __device__ __forceinline__ int perm32(int rho) { const int n = rho >> 4, i = rho & 15; return 8 * (i >> 2) + 4 * n + (i & 3); }

struct Unit { int pm, pn; };
struct Gemm { int lda, ldb, K; };

struct TileOrder {
    int nM, nN, nwg, G, c;
    __device__ __forceinline__ void init(int nM_, int nN_, int G_, int c_) { nM = nM_; nN = nN_; nwg = nM * nN; G = G_; c = c_; }
    __device__ __forceinline__ bool tile(int i, Unit& u) const {
        const long L = (long)i * G + c; if (L >= nwg) return false;
        int wgid = (int)L; { const int q = nwg / NXCD, r = nwg % NXCD, xcd = wgid % NXCD, off = wgid / NXCD; wgid = (xcd < r ? xcd * (q + 1) : r * (q + 1) + (xcd - r) * q) + off; }
        const int nig = WGM * nN, gid = wgid / nig, fm = gid * WGM, gsz = (nM - fm) < WGM ? (nM - fm) : WGM;
        u.pm = fm + ((wgid % nig) % gsz); u.pn = (wgid % nig) / gsz; return true;
    }
};

__device__ __forceinline__ unsigned cvt_pk_bf16(float lo, float hi) { unsigned r; asm volatile("v_cvt_pk_bf16_f32 %0, %1, %2" : "=v"(r) : "v"(lo), "v"(hi)); return r; }

template <class Epi, class Sched, bool ALIGN_EPI>
__device__ __forceinline__ void gemm_phase(LAS unsigned char* lds, const Gemm g, const Sched& S, const Epi& E) {
    const int tid = threadIdx.x, wid = __builtin_amdgcn_readfirstlane(tid >> 6), lane = tid & 63, wr = wid >> 2, wc = wid & 3, fr = lane & 15, fq = lane >> 4;
    const int K = g.K, nt = K / BK;
    unsigned voffA[2], voffB[2];
#pragma unroll
    for (int i = 0; i < 2; ++i) { int R, C; stage_rc(tid * 16 + i * 8192, R, C); const int Rb = Epi::PERM ? ((R & ~31) + perm32(R & 31)) : R;
        voffA[i] = (unsigned)(R * g.lda + C) * 2u; voffB[i] = (unsigned)(Rb * g.ldb + C) * 2u; }
    const size_t kstep = (size_t)(BK * 2);
    const size_t hstepA = (size_t)HALF * g.lda * 2, hstepB = (size_t)HALF * g.ldb * 2;
    const unsigned ldsw = (unsigned)wid * 1024u;
    const int aoff = lds_byte(wr * 64 + fr, fq * 8), boff = lds_byte(wc * 32 + fr, fq * 8);
#define PG8_SA(b, h) (((b) * 2 + (h)) * HTB)
#define PG8_SB(b, h) ((4 + (b) * 2 + (h)) * HTB)
#define PG8_STAGE(bufoff, gbase, voff) do { _Pragma("unroll") for (int _i = 0; _i < 2; ++_i) \
        __builtin_amdgcn_global_load_lds((const unsigned*)((const char*)(gbase) + (voff)[_i]), (LAS unsigned*)(lds + (bufoff) + ldsw + _i * 8192), 16, 0, 0); } while (0)
#define PG8_LDA(dst, b, h) do { _Pragma("unroll") for (int m = 0; m < 4; ++m) _Pragma("unroll") for (int k = 0; k < 2; ++k) dst[m][k] = *(const LAS bf16x8*)(lds + PG8_SA(b, h) + aoff + m * 2048 + k * 1024); } while (0)
#define PG8_LDB(dst, b, h) do { _Pragma("unroll") for (int n = 0; n < 2; ++n) _Pragma("unroll") for (int k = 0; k < 2; ++k) dst[n][k] = *(const LAS bf16x8*)(lds + PG8_SB(b, h) + boff + n * 2048 + k * 1024); } while (0)
#define PG8_MMA(ai, bj, At, Bt) do { __builtin_amdgcn_s_setprio(1); _Pragma("unroll") for (int m = 0; m < 4; ++m) _Pragma("unroll") for (int n = 0; n < 2; ++n) _Pragma("unroll") for (int k = 0; k < 2; ++k) \
        acc[ai][bj][m][n] = __builtin_amdgcn_mfma_f32_16x16x32_bf16(Bt[n][k], At[m][k], acc[ai][bj][m][n], 0, 0, 0); __builtin_amdgcn_s_setprio(0); } while (0)
#define PG8_WAIT_V(n) asm volatile("s_waitcnt vmcnt(" #n ")" ::: "memory")
#define PG8_WAIT_L(n) asm volatile("s_waitcnt lgkmcnt(" #n ")" ::: "memory")
#define PG8_BAR __builtin_amdgcn_s_barrier()
#define PG8_SCHED __builtin_amdgcn_sched_barrier(0)
    Unit cur, nxt; int ui = 0;
    if (!S.next(0, cur)) return;
    f32x4 acc[2][2][4][2];
#pragma unroll
    for (int a = 0; a < 2; ++a)
#pragma unroll
        for (int b = 0; b < 2; ++b)
#pragma unroll
            for (int m = 0; m < 4; ++m)
#pragma unroll
                for (int n = 0; n < 2; ++n) acc[a][b][m][n] = (f32x4){0.f, 0.f, 0.f, 0.f};
    bf16x8 At[4][2], B0[2][2], B1[2][2];
    const char* cA = S.pa(cur); const char* cB = S.pb(cur);
    PG8_STAGE(PG8_SB(0, 0), cB, voffB); PG8_STAGE(PG8_SB(0, 1), cB + hstepB, voffB); PG8_STAGE(PG8_SA(0, 0), cA, voffA); PG8_STAGE(PG8_SA(0, 1), cA + hstepA, voffA);
    if (wr == 1) PG8_BAR;
    PG8_WAIT_V(2); PG8_BAR;
    PG8_STAGE(PG8_SB(1, 0), cB + kstep, voffB); PG8_STAGE(PG8_SA(1, 0), cA + kstep, voffA); PG8_STAGE(PG8_SB(1, 1), cB + hstepB + kstep, voffB);
    PG8_WAIT_V(6); PG8_BAR;
    for (;;) {
        const bool has_next = S.next(ui + 1, nxt);
        const char* nA = has_next ? S.pa(nxt) : cA; const char* nB = has_next ? S.pb(nxt) : cB;
#pragma clang loop unroll(disable)
        for (int t = 0; t < nt; t += 2) {
            const bool last = (t == nt - 2);
            const char* a1 = cA + (size_t)(t + 1) * kstep;
            const char* a2 = last ? nA : cA + (size_t)(t + 2) * kstep; const char* b2 = last ? nB : cB + (size_t)(t + 2) * kstep;
            const char* a3 = a2 + kstep; const char* b3 = b2 + kstep;
            PG8_LDB(B0, 0, 0); PG8_LDB(B1, 0, 1); PG8_SCHED; PG8_LDA(At, 0, 0); PG8_STAGE(PG8_SA(1, 1), a1 + hstepA, voffA);
            PG8_WAIT_V(8); PG8_WAIT_L(0); PG8_BAR; PG8_MMA(0, 0, At, B0); PG8_MMA(0, 1, At, B1); PG8_BAR; PG8_SCHED;
            PG8_LDA(At, 0, 1); PG8_STAGE(PG8_SB(0, 0), b2, voffB); PG8_STAGE(PG8_SB(0, 1), b2 + hstepB, voffB); PG8_STAGE(PG8_SA(0, 0), a2, voffA);
            PG8_WAIT_V(8); PG8_WAIT_L(0); PG8_BAR; PG8_MMA(1, 0, At, B0); PG8_MMA(1, 1, At, B1); PG8_BAR; PG8_SCHED;
            PG8_LDB(B0, 1, 0); PG8_LDB(B1, 1, 1); PG8_SCHED; PG8_LDA(At, 1, 0); PG8_STAGE(PG8_SA(0, 1), a2 + hstepA, voffA);
            PG8_WAIT_V(8); PG8_WAIT_L(0); PG8_BAR; PG8_MMA(0, 0, At, B0); PG8_MMA(0, 1, At, B1); PG8_BAR; PG8_SCHED;
            PG8_LDA(At, 1, 1); PG8_STAGE(PG8_SB(1, 0), b3, voffB); PG8_STAGE(PG8_SB(1, 1), b3 + hstepB, voffB); PG8_STAGE(PG8_SA(1, 0), a3, voffA);
            PG8_WAIT_V(8); PG8_WAIT_L(0); PG8_BAR; PG8_MMA(1, 0, At, B0); PG8_MMA(1, 1, At, B1); PG8_BAR; PG8_SCHED;
        }
        if constexpr (ALIGN_EPI) { if (wr == 0) PG8_BAR; }
        E(acc, cur, wr, wc, fr, fq);
        if (!has_next) break;
#pragma unroll
        for (int a = 0; a < 2; ++a)
#pragma unroll
            for (int b = 0; b < 2; ++b)
#pragma unroll
                for (int m = 0; m < 4; ++m)
#pragma unroll
                    for (int n = 0; n < 2; ++n) acc[a][b][m][n] = (f32x4){0.f, 0.f, 0.f, 0.f};
        cur = nxt; cA = nA; cB = nB; ++ui;
        if constexpr (ALIGN_EPI) { if (wr == 1) PG8_BAR; }
    }
    PG8_WAIT_V(0);
    if constexpr (!ALIGN_EPI) { if (wr == 0) PG8_BAR; }
    PG8_BAR;
#undef PG8_SA
#undef PG8_SB
#undef PG8_STAGE
#undef PG8_LDA
#undef PG8_LDB
#undef PG8_MMA
#undef PG8_WAIT_V
#undef PG8_WAIT_L
#undef PG8_BAR
#undef PG8_SCHED
}

typedef const f32x4 (&AccRef)[2][2][4][2];

struct SchedPlain {
    TileOrder o; const char* A; const char* B; size_t astep, bstep;
    __device__ __forceinline__ bool next(int i, Unit& u) const { return o.tile(i, u); }
    __device__ __forceinline__ const char* pa(const Unit& u) const { return A + (size_t)u.pm * astep; }
    __device__ __forceinline__ const char* pb(const Unit& u) const { return B + (size_t)u.pn * bstep; }
};
struct SchedRKV {
    TileOrder o; const char* A; const char* B; size_t astep, bstep, azstride;
    __device__ __forceinline__ bool next(int i, Unit& u) const { return o.tile(i, u); }
    __device__ __forceinline__ const char* pa(const Unit& u) const { return A + (size_t)(u.pn >> 2) * azstride + (size_t)u.pm * astep; }
    __device__ __forceinline__ const char* pb(const Unit& u) const { return B + (size_t)u.pn * bstep; }
};
struct SchedMoe {
    TileOrder o; const char* A; const char* B; size_t astep, bstep, bestride; const LAS int* ends;
    __device__ __forceinline__ bool next(int i, Unit& u) const { return o.tile(i, u); }
    __device__ __forceinline__ int be(int pm) const { int e = 0;
#pragma unroll
        for (int j = 0; j < NE - 1; ++j) e += (pm >= ends[j]) ? 1 : 0; return e; }
    __device__ __forceinline__ const char* pa(const Unit& u) const { return A + (size_t)u.pm * astep; }
    __device__ __forceinline__ const char* pb(const Unit& u) const { return B + (size_t)be(u.pm) * bestride + (size_t)u.pn * bstep; }
};

struct EpiRKV {
    static constexpr bool PERM = true;
    bf16* C; size_t zstride;
    __device__ __forceinline__ void operator()(AccRef acc, const Unit& u, int wr, int wc, int fr, int fq) const {
        const int z = u.pn >> 2, pn = u.pn & 3; bf16* base = C + (size_t)z * zstride;
        const int row0 = u.pm * BM + wr * 64 + fr, col0 = pn * BM + wc * 32 + 8 * fq;
#pragma unroll
        for (int ai = 0; ai < 2; ++ai)
#pragma unroll
            for (int m = 0; m < 4; ++m) { bf16* rowp = base + (size_t)(row0 + ai * HALF + m * 16) * D + col0;
#pragma unroll
                for (int bj = 0; bj < 2; ++bj) { const f32x4 v0 = acc[ai][bj][m][0], v1 = acc[ai][bj][m][1];
                    u32x4 w; w.x = cvt_pk_bf16(v0[0], v0[1]); w.y = cvt_pk_bf16(v0[2], v0[3]); w.z = cvt_pk_bf16(v1[0], v1[1]); w.w = cvt_pk_bf16(v1[2], v1[3]);
                    *(u32x4*)(rowp + bj * HALF) = w; } }
    }
};
struct EpiRes {
    static constexpr bool PERM = false;
    const float* base; float* out;
    __device__ __forceinline__ void operator()(AccRef acc, const Unit& u, int wr, int wc, int fr, int fq) const {
        const int row0 = u.pm * BM + wr * 64 + fr, col0 = u.pn * BM + wc * 32 + 4 * fq;
#pragma unroll
        for (int ai = 0; ai < 2; ++ai)
#pragma unroll
            for (int m = 0; m < 4; ++m) { const size_t off = (size_t)(row0 + ai * HALF + m * 16) * D + col0;
#pragma unroll
                for (int bj = 0; bj < 2; ++bj)
#pragma unroll
                    for (int n = 0; n < 2; ++n) { const f32x4 b = *(const f32x4*)(base + off + bj * HALF + n * 16); *(f32x4*)(out + off + bj * HALF + n * 16) = b + acc[ai][bj][m][n]; } }
    }
};
struct EpiL1 {
    static constexpr bool PERM = true;
    bf16* O;
    __device__ __forceinline__ void operator()(AccRef acc, const Unit& u, int wr, int wc, int fr, int fq) const {
        const int row0 = u.pm * BM + wr * 64 + fr, col0 = wc * 32 + 8 * fq;
#pragma unroll
        for (int ai = 0; ai < 2; ++ai)
#pragma unroll
            for (int m = 0; m < 4; ++m) { bf16* rowp = O + (size_t)(row0 + ai * HALF + m * 16) * 256 + col0;
#pragma unroll
                for (int bj = 0; bj < 2; ++bj) { float v[8];
#pragma unroll
                    for (int i = 0; i < 4; ++i) { v[i] = acc[ai][bj][m][0][i]; v[4 + i] = acc[ai][bj][m][1][i]; }
#pragma unroll
                    for (int i = 0; i < 8; ++i) { if (bj == 1) v[i] = sigmoidf_(v[i]); else if (wc < 2) v[i] = tanhf(v[i]); }
                    u32x4 w; w.x = cvt_pk_bf16(v[0], v[1]); w.y = cvt_pk_bf16(v[2], v[3]); w.z = cvt_pk_bf16(v[4], v[5]); w.w = cvt_pk_bf16(v[6], v[7]);
                    *(u32x4*)(rowp + bj * HALF) = w; } }
    }
};
struct EpiL2 {
    static constexpr bool PERM = true;
    float* LW; bf16* AA; bf16* G; const float* w0; const float* a0;
    __device__ __forceinline__ void operator()(AccRef acc, const Unit& u, int wr, int wc, int fr, int fq) const {
        const int z = u.pn >> 2, pn = u.pn & 3;
        const int row0 = u.pm * BM + wr * 64 + fr, col0 = pn * BM + wc * 32 + 8 * fq;
        if (z == 0) {
#pragma unroll
            for (int bj = 0; bj < 2; ++bj) { const f32x4 b0 = *(const f32x4*)(w0 + col0 + bj * HALF), b1 = *(const f32x4*)(w0 + col0 + bj * HALF + 4);
#pragma unroll
                for (int ai = 0; ai < 2; ++ai)
#pragma unroll
                    for (int m = 0; m < 4; ++m) { f32x4 v0 = acc[ai][bj][m][0] + b0, v1 = acc[ai][bj][m][1] + b1;
#pragma unroll
                        for (int i = 0; i < 4; ++i) { v0[i] = -0.6065306597126334f * __builtin_amdgcn_rcpf(1.f + __expf(-v0[i])); v1[i] = -0.6065306597126334f * __builtin_amdgcn_rcpf(1.f + __expf(-v1[i])); }
                        float* p = LW + (size_t)(row0 + ai * HALF + m * 16) * D + col0 + bj * HALF; *(f32x4*)p = v0; *(f32x4*)(p + 4) = v1; } }
        } else {
            bf16* base = z == 1 ? AA : G;
#pragma unroll
            for (int bj = 0; bj < 2; ++bj) { f32x4 b0 = {0.f, 0.f, 0.f, 0.f}, b1 = b0; if (z == 1) { b0 = *(const f32x4*)(a0 + col0 + bj * HALF); b1 = *(const f32x4*)(a0 + col0 + bj * HALF + 4); }
#pragma unroll
                for (int ai = 0; ai < 2; ++ai)
#pragma unroll
                    for (int m = 0; m < 4; ++m) { f32x4 v0 = acc[ai][bj][m][0] + b0, v1 = acc[ai][bj][m][1] + b1;
                        if (z == 1) {
#pragma unroll
                            for (int i = 0; i < 4; ++i) { v0[i] = __builtin_amdgcn_rcpf(1.f + __expf(-v0[i])); v1[i] = __builtin_amdgcn_rcpf(1.f + __expf(-v1[i])); } }
                        u32x4 w; w.x = cvt_pk_bf16(v0[0], v0[1]); w.y = cvt_pk_bf16(v0[2], v0[3]); w.z = cvt_pk_bf16(v1[0], v1[1]); w.w = cvt_pk_bf16(v1[2], v1[3]);
                        *(u32x4*)(base + (size_t)(row0 + ai * HALF + m * 16) * D + col0 + bj * HALF) = w; } }
        }
    }
};
struct EpiSwiGLU {
    static constexpr bool PERM = true;
    bf16* O;
    __device__ __forceinline__ void operator()(AccRef acc, const Unit& u, int wr, int wc, int fr, int fq) const {
        const int row0 = u.pm * BM + wr * 64 + fr, col0 = u.pn * HALF + wc * 32 + 8 * fq;
#pragma unroll
        for (int ai = 0; ai < 2; ++ai)
#pragma unroll
            for (int m = 0; m < 4; ++m) { float v[8];
#pragma unroll
                for (int n = 0; n < 2; ++n)
#pragma unroll
                    for (int i = 0; i < 4; ++i) { const float gt = acc[ai][0][m][n][i], up = acc[ai][1][m][n][i]; v[4 * n + i] = gt * sigmoidf_(gt) * up; }
                u32x4 w; w.x = cvt_pk_bf16(v[0], v[1]); w.y = cvt_pk_bf16(v[2], v[3]); w.z = cvt_pk_bf16(v[4], v[5]); w.w = cvt_pk_bf16(v[6], v[7]);
                *(u32x4*)(O + (size_t)(row0 + ai * HALF + m * 16) * FF + col0) = w; }
    }
};
struct EpiBf16 {
    static constexpr bool PERM = true;
    bf16* O; int ldc;
    __device__ __forceinline__ void operator()(AccRef acc, const Unit& u, int wr, int wc, int fr, int fq) const {
        const int row0 = u.pm * BM + wr * 64 + fr, col0 = u.pn * BM + wc * 32 + 8 * fq;
#pragma unroll
        for (int ai = 0; ai < 2; ++ai)
#pragma unroll
            for (int m = 0; m < 4; ++m) { bf16* rowp = O + (size_t)(row0 + ai * HALF + m * 16) * ldc + col0;
#pragma unroll
                for (int bj = 0; bj < 2; ++bj) { const f32x4 v0 = acc[ai][bj][m][0], v1 = acc[ai][bj][m][1];
                    u32x4 w; w.x = cvt_pk_bf16(v0[0], v0[1]); w.y = cvt_pk_bf16(v0[2], v0[3]); w.z = cvt_pk_bf16(v1[0], v1[1]); w.w = cvt_pk_bf16(v1[2], v1[3]);
                    *(u32x4*)(rowp + bj * HALF) = w; } }
    }
};
}

#define XB_TMO      128
#define XB_XCNT(j)  (256  + 64 * (j))
#define XB_XSUB(j)  (1280 + 64 * (j))
#define XB_XGEN(j)  (2304 + 64 * (j))
#define XB_TOP      3328
#define XB_TOPGEN   3392
#define XCD_BAR_WORDS 3456
#define XB_SPIN_CAP (1u << 18)
__device__ __forceinline__ unsigned xb_ld(unsigned* p)              { return __hip_atomic_load(p, __ATOMIC_RELAXED, __HIP_MEMORY_SCOPE_AGENT); }
__device__ __forceinline__ unsigned xb_add(unsigned* p, unsigned v) { return __hip_atomic_fetch_add(p, v, __ATOMIC_RELAXED, __HIP_MEMORY_SCOPE_AGENT); }
__device__ __forceinline__ unsigned xb_xcc_id() { return (unsigned)__builtin_amdgcn_s_getreg((3 << 11) | 20) & 0xFu; }
#define XB_SPIN(cond, bar) do { unsigned _sp = 0; while (cond) { __builtin_amdgcn_s_sleep(1); \
    if ((++_sp & 255u) == 0u) { if (xb_ld(&(bar)[XB_TMO])) break; if (_sp > XB_SPIN_CAP) { atomicAdd(&(bar)[XB_TMO], 1u); break; } } } } while (0)
struct XcdBarrier { unsigned* bar; unsigned x; volatile LAS unsigned* st; };
__device__ __forceinline__ XcdBarrier xcd_barrier_post(unsigned* bar, volatile LAS unsigned* st) {
    XcdBarrier b; b.bar = bar; b.x = xb_xcc_id(); b.st = st;
    if (threadIdx.x == 0) (void)xb_add(&bar[XB_XCNT(b.x)], 1u);
    return b;
}
__device__ __forceinline__ void xcd_barrier_complete(unsigned* bar, unsigned x, unsigned& nloc, unsigned& nx) {
    const unsigned G = gridDim.x * gridDim.y * gridDim.z;
    unsigned sum, cnt, mine, sp = 0u;
    for (;;) {
        sum = 0u; cnt = 0u; mine = 0u;
#pragma unroll
        for (unsigned j = 0; j < 16; ++j) { const unsigned c = xb_ld(&bar[XB_XCNT(j)]); sum += c; cnt += (c > 0u) ? 1u : 0u; mine = (j == x) ? c : mine; }
        if (sum == G) break;
        __builtin_amdgcn_s_sleep(1);
        if ((++sp & 255u) == 0u) { if (xb_ld(&bar[XB_TMO])) break; if (sp > XB_SPIN_CAP) { atomicAdd(&bar[XB_TMO], 1u); break; } }
    }
    nloc = mine > 0u ? mine : 1u; nx = cnt > 0u ? cnt : 1u;
}
__device__ __forceinline__ void xcd_barrier(const XcdBarrier& b) {
    asm volatile("s_waitcnt vmcnt(0)" ::: "memory");
    __syncthreads();
    if (threadIdx.x == 0) {
        unsigned* bar = b.bar;
        __builtin_amdgcn_s_waitcnt(0);
        unsigned nloc = b.st[0], nx = b.st[1];
        if (nloc == 0u) { xcd_barrier_complete(bar, b.x, nloc, nx); b.st[0] = nloc; b.st[1] = nx; }
        const unsigned old = xb_add(&bar[XB_XSUB(b.x)], 1u);
        const unsigned gen = old / nloc;
        if (old + 1u == (gen + 1u) * nloc) {
            __builtin_amdgcn_fence(__ATOMIC_RELEASE, "agent");
            asm volatile("s_waitcnt vmcnt(0)" ::: "memory");
            const unsigned og = xb_add(&bar[XB_TOP], 1u);
            const unsigned tg = og / nx;
            if (og + 1u == (tg + 1u) * nx) xb_add(&bar[XB_TOPGEN], 1u);
            else XB_SPIN(xb_ld(&bar[XB_TOPGEN]) == tg, bar);
            __builtin_amdgcn_fence(__ATOMIC_ACQUIRE, "agent");
            xb_add(&bar[XB_XGEN(b.x)], 1u);
            asm volatile("s_waitcnt vmcnt(0)" ::: "memory");
        } else {
            XB_SPIN(xb_ld(&bar[XB_XGEN(b.x)]) == gen, bar);
            __builtin_amdgcn_fence(__ATOMIC_ACQUIRE, "agent");
            asm volatile("s_waitcnt vmcnt(0)" ::: "memory");
        }
    }
    __syncthreads();
}

struct Args { const float* in[29]; float* out; unsigned char* ws; int ph_lo, ph_hi; };
struct Frame {
    LAS unsigned char* lds; gu32* ctl; unsigned char* ws;
    int tid, lane, wave, vcu, G, gw, NGW;
};

struct Row { f32x4 v[4]; };
__device__ __forceinline__ Row ld_row(const float* p, int lane) { Row r; const f32x4* q = (const f32x4*)p + lane;
#pragma unroll
    for (int j = 0; j < 4; ++j) r.v[j] = q[64 * j]; return r; }
__device__ __forceinline__ void st_row(float* p, int lane, const Row& r) { f32x4* q = (f32x4*)p + lane;
#pragma unroll
    for (int j = 0; j < 4; ++j) q[64 * j] = r.v[j]; }
__device__ __forceinline__ void st_row_bf16(bf16* p, int lane, const Row& r) { u32x2* q = (u32x2*)p + lane;
#pragma unroll
    for (int j = 0; j < 4; ++j) { u32x2 w; w.x = pk2(r.v[j][0], r.v[j][1]); w.y = pk2(r.v[j][2], r.v[j][3]); q[64 * j] = w; } }
__device__ __forceinline__ Row ld_row_bf16(const bf16* p, int lane) { Row r; const u32x2* q = (const u32x2*)p + lane;
#pragma unroll
    for (int j = 0; j < 4; ++j) { const u32x2 w = q[64 * j]; r.v[j] = (f32x4){bflo(w.x), bfhi(w.x), bflo(w.y), bfhi(w.y)}; } return r; }
__device__ __forceinline__ float row_sumsq(const Row& r) { float s = 0.f;
#pragma unroll
    for (int j = 0; j < 4; ++j) s += (r.v[j][0] * r.v[j][0] + r.v[j][1] * r.v[j][1]) + (r.v[j][2] * r.v[j][2] + r.v[j][3] * r.v[j][3]); return wave_sum(s); }
__device__ __forceinline__ Row rmsnorm_row(const Row& x, const Row& g) { const float rs = rsqrtf(row_sumsq(x) * (1.f / D) + RMS_EPS); Row y;
#pragma unroll
    for (int j = 0; j < 4; ++j) y.v[j] = x.v[j] * rs * g.v[j]; return y; }

__device__ __forceinline__ void tr_item(const float* W, int ldw, int k0, int n0, bf16* WT, int ldt, int drow0, int dcol0, const float* sc, int scmode, LAS float* scr, int lane) {
#pragma unroll 8
    for (int i = 0; i < 32; ++i) { const int kk = 2 * i + (lane >> 5); float v = W[(size_t)(k0 + kk) * ldw + n0 + (lane & 31)];
        if (scmode == 1) v *= sc[k0 + kk]; else if (scmode == 2) v *= (1.f - sc[k0 + kk]);
        scr[kk * 33 + (lane & 31)] = v; }
    LDS_WAIT(); asm volatile("" ::: "memory");
    const int c = lane & 7;
#pragma unroll
    for (int j = 0; j < 4; ++j) { const int n = (lane >> 3) + 8 * j; const LAS float* s = scr + (8 * c) * 33 + n;
        u32x4 o; o.x = pk2(s[0 * 33], s[1 * 33]); o.y = pk2(s[2 * 33], s[3 * 33]); o.z = pk2(s[4 * 33], s[5 * 33]); o.w = pk2(s[6 * 33], s[7 * 33]);
        *(GAS u32x4*)(WT + (size_t)(drow0 + n0 + n) * ldt + dcol0 + k0 + 8 * c) = o; }
    LDS_WAIT(); asm volatile("" ::: "memory");
}
__device__ __forceinline__ int gu_row(int n) { return n < FF ? 256 * (n >> 7) + (n & 127) : 256 * ((n - FF) >> 7) + 128 + ((n - FF) & 127); }

__device__ __forceinline__ void p0_prologue(Frame& F, const Args& a) {
    LAS float* scr = (LAS float*)(F.lds + F.wave * 16384);
    unsigned char* ws = F.ws;
    constexpr int I_SQ = 16 * 32;
    constexpr int I_RKV = 3 * I_SQ, I_L1 = 2 * 16 * 8, I_L2 = 4 * 32, I_GU = 16 * 224, I_DN = 56 * 32, I_IN = 16 * 128;
    constexpr int NITEMS = I_RKV + I_L1 + I_L2 + I_SQ + I_GU + I_DN + I_IN + I_SQ + NE * I_GU + NE * I_DN;
    for (int it = F.gw; it < NITEMS; it += F.NGW) {
        int r = it;
        if (r < I_RKV) { const int z = r / I_SQ, q = r % I_SQ; tr_item(a.in[4] + (size_t)z * D * D, D, 64 * (q / 32), 32 * (q % 32), (bf16*)(ws + WS_W_RKV) + (size_t)z * D * D, D, 0, 0, nullptr, 0, scr, F.lane); continue; } r -= I_RKV;
        if (r < I_L1) {
            const int half = r / 128, q = r % 128, kb = q / 8, nb = q % 8, n0 = 32 * nb;
            const float* W; int ldw, nn0, mi;
            if (n0 < 64) { W = a.in[6]; ldw = 64; nn0 = n0; mi = 3; } else if (n0 < 128) { W = a.in[9]; ldw = 64; nn0 = n0 - 64; mi = 4; } else { W = a.in[11]; ldw = 128; nn0 = n0 - 128; mi = 5; }
            tr_item(W, ldw, 64 * kb, nn0, (bf16*)(ws + WS_W_L1), 2 * D, n0 - nn0, half * D, a.in[3] + mi * D, half == 0 ? 1 : 2, scr, F.lane); continue; } r -= I_L1;
        if (r < I_L2) {
            const int part = r / 32, nb = r % 32;
            if (part == 0) tr_item(a.in[7], D, 0, 32 * nb, (bf16*)(ws + WS_W_L2), 256, 0, 0, nullptr, 0, scr, F.lane);
            else if (part == 1) tr_item(a.in[10], D, 0, 32 * nb, (bf16*)(ws + WS_W_L2), 256, D, 64, nullptr, 0, scr, F.lane);
            else tr_item(a.in[12], D, 64 * (part - 2), 32 * nb, (bf16*)(ws + WS_W_L2), 256, 2 * D, 128, nullptr, 0, scr, F.lane);
            continue; } r -= I_L2;
        if (r < I_SQ) { tr_item(a.in[18], D, 64 * (r / 32), 32 * (r % 32), (bf16*)(ws + WS_W_O0), D, 0, 0, nullptr, 0, scr, F.lane); continue; } r -= I_SQ;
        if (r < I_GU) { const int kb = r / 224, nb = r % 224; tr_item(a.in[24], 2 * FF, 64 * kb, 32 * nb, (bf16*)(ws + WS_W_GU), D, gu_row(32 * nb) - 32 * nb, 0, nullptr, 0, scr, F.lane); continue; } r -= I_GU;
        if (r < I_DN) { tr_item(a.in[25], D, 64 * (r / 32), 32 * (r % 32), (bf16*)(ws + WS_W_DN), FF, 0, 0, nullptr, 0, scr, F.lane); continue; } r -= I_DN;
        if (r < I_IN) { tr_item(a.in[19], WIN_LD, 64 * (r / 128), 32 * (r % 128), (bf16*)(ws + WS_W_IN), D, 0, 0, nullptr, 0, scr, F.lane); continue; } r -= I_IN;
        if (r < I_SQ) { tr_item(a.in[23], D, 64 * (r / 32), 32 * (r % 32), (bf16*)(ws + WS_W_FO), D, 0, 0, nullptr, 0, scr, F.lane); continue; } r -= I_SQ;
        if (r < NE * I_GU) { const int e = r / I_GU, q = r % I_GU, kb = q / 224, nb = q % 224;
            tr_item(a.in[27] + (size_t)e * D * 2 * FF, 2 * FF, 64 * kb, 32 * nb, (bf16*)(ws + WS_W_MGU) + (size_t)e * 2 * FF * D, D, gu_row(32 * nb) - 32 * nb, 0, nullptr, 0, scr, F.lane); continue; } r -= NE * I_GU;
        { const int e = r / I_DN, q = r % I_DN; tr_item(a.in[28] + (size_t)e * FF * D, D, 64 * (q / 32), 32 * (q % 32), (bf16*)(ws + WS_W_MDN) + (size_t)e * D * FF, FF, 0, 0, nullptr, 0, scr, F.lane); }
    }
    for (int i = F.gw * 64 + F.lane; i < 3 * D * 32; i += F.NGW * 64) { const int row = i >> 5, ch = i & 31, part = row / D, k = ch * 8;
        const bool nz = part == 0 ? (k < 64) : (part == 1 ? (k >= 64 && k < 128) : (k >= 128));
        if (!nz) *(GAS u32x4*)((bf16*)(ws + WS_W_L2) + (size_t)row * 256 + k) = (u32x4){0u, 0u, 0u, 0u}; }
}

__device__ __forceinline__ void p1_shift(Frame& F, const Args& a) {
    const int lane = F.lane; const float* x = a.in[0];
    bf16* UB = (bf16*)(F.ws + WS_UB); bf16* XS = (bf16*)(F.ws + WS_XS);
    const Row g0 = ld_row(a.in[1], lane);
    const int RPW = T / (256 * NWAVES);
    for (int t0 = F.gw * RPW; t0 < T; t0 += F.NGW * RPW) {
        Row prev;
        if (t0 > 0) prev = rmsnorm_row(ld_row(x + (size_t)(t0 - 1) * D, lane), g0);
        else { for (int j = 0; j < 4; ++j) prev.v[j] = (f32x4){0.f, 0.f, 0.f, 0.f}; st_row_bf16(UB, lane, prev); }
        for (int t = t0; t < t0 + RPW; ++t) {
            const Row u = rmsnorm_row(ld_row(x + (size_t)t * D, lane), g0);
            st_row_bf16(UB + (size_t)(t + 1) * D, lane, u);
#pragma unroll
            for (int n = 0; n < 3; ++n) { const Row mu = ld_row(a.in[3] + n * D, lane); Row o;
#pragma unroll
                for (int j = 0; j < 4; ++j) o.v[j] = u.v[j] + (prev.v[j] - u.v[j]) * mu.v[j];
                st_row_bf16(XS + (size_t)n * T * D + (size_t)t * D, lane, o); }
            prev = u;
        }
    }
}

__device__ __forceinline__ void p4_derive(Frame& F, const Args& a) {
    const int lane = F.lane;
    float* R = (float*)(F.ws + WS_R); float* K = (float*)(F.ws + WS_K); float* LW = (float*)(F.ws + WS_LW); float* AA = (float*)(F.ws + WS_AA);
    float* KK = (float*)(F.ws + WS_KK); float* BB = (float*)(F.ws + WS_BB); float* CS = (float*)(F.ws + WS_CS);
    const Row k_k = ld_row(a.in[13], lane), k_a = ld_row(a.in[14], lane), r_k = ld_row(a.in[15], lane);
    for (int t = F.gw; t < T; t += F.NGW) {
        const size_t o = (size_t)t * D;
        Row r = ld_row(R + o, lane), k = ld_row(K + o, lane), lw = ld_row(LW + o, lane), aa = ld_row(AA + o, lane), kk, bb, km, dec;
        float c1[4], c2[4], c3[4];
#pragma unroll
        for (int j = 0; j < 4; ++j) {
            kk.v[j] = k.v[j] * k_k.v[j];
            float ss = (kk.v[j][0] * kk.v[j][0] + kk.v[j][1] * kk.v[j][1]) + (kk.v[j][2] * kk.v[j][2] + kk.v[j][3] * kk.v[j][3]);
            ss = row16_sum(ss);
            const float inv = 1.f / fmaxf(sqrtf(ss), 1e-12f);
            kk.v[j] = kk.v[j] * inv;
            bb.v[j] = kk.v[j] * aa.v[j];
            km.v[j] = k.v[j] * (1.f + (aa.v[j] - 1.f) * k_a.v[j]);
#pragma unroll
            for (int i = 0; i < 4; ++i) dec.v[j][i] = __expf(lw.v[j][i]);
            float s1 = 0.f, s2 = 0.f, s3 = 0.f;
#pragma unroll
            for (int i = 0; i < 4; ++i) { s1 += bb.v[j][i] * r.v[j][i]; const float kr = km.v[j][i] * r.v[j][i]; s2 += kr; s3 += kr * r_k.v[j][i]; }
            c1[j] = row16_sum(s1); c2[j] = row16_sum(s2); c3[j] = row16_sum(s3);
            r.v[j] = r.v[j] * dec.v[j];
        }
        st_row(R + o, lane, r); st_row(K + o, lane, km); st_row(LW + o, lane, dec); st_row(KK + o, lane, kk); st_row(BB + o, lane, bb);
        if ((lane & 15) == 0) {
#pragma unroll
            for (int j = 0; j < 4; ++j) { const int h = 4 * j + (lane >> 4); CS[(size_t)t * 16 + h] = c1[j]; CS[(size_t)T * 16 + (size_t)t * 16 + h] = c2[j]; CS[(size_t)2 * T * 16 + (size_t)t * 16 + h] = c3[j]; }
        }
    }
}

__device__ __forceinline__ float dpp_row_allsum(float x) {
    int v = __builtin_bit_cast(int, x);
    x += __builtin_bit_cast(float, __builtin_amdgcn_update_dpp(0, v, 0xB1, 0xF, 0xF, true)); v = __builtin_bit_cast(int, x);
    x += __builtin_bit_cast(float, __builtin_amdgcn_update_dpp(0, v, 0x4E, 0xF, 0xF, true)); v = __builtin_bit_cast(int, x);
    x += __builtin_bit_cast(float, __builtin_amdgcn_update_dpp(0, v, 0x141, 0xF, 0xF, true)); v = __builtin_bit_cast(int, x);
    x += __builtin_bit_cast(float, __builtin_amdgcn_update_dpp(0, v, 0x140, 0xF, 0xF, true));
    return x;
}
__device__ __forceinline__ float wave_allsum_fast(float x) {
    x = dpp_row_allsum(x);
    const int v = __builtin_bit_cast(int, x);
    const float a = __builtin_bit_cast(float, __builtin_amdgcn_readlane(v, 0)), b = __builtin_bit_cast(float, __builtin_amdgcn_readlane(v, 16)),
                c = __builtin_bit_cast(float, __builtin_amdgcn_readlane(v, 32)), d = __builtin_bit_cast(float, __builtin_amdgcn_readlane(v, 48));
    return (a + b) + (c + d);
}
__device__ __forceinline__ void p5_scan(Frame& F) {
    if (F.wave >= 4) return;
    const int lane = F.lane;
    const float* KK = (const float*)(F.ws + WS_KK); const float* RW = (const float*)(F.ws + WS_R); const float* DEC = (const float*)(F.ws + WS_LW);
    const float* BB = (const float*)(F.ws + WS_BB); const float* KM = (const float*)(F.ws + WS_K); const float* V = (const float*)(F.ws + WS_V);
    const float* CS = (const float*)(F.ws + WS_CS); float* YT = (float*)(F.ws + WS_YT);
    for (int rho = F.vcu * 4 + F.wave; rho < D; rho += F.G * 4) {
        const int h = rho >> 6;
        const size_t col = (size_t)h * 64 + lane;
        float s = 0.f, ybuf = 0.f;
        constexpr int U = 8;
        float ik[2][U], ir[2][U], iw[2][U], ib[2][U], im[2][U], iv[2][U], i1[2][U], i2[2][U];
#define SCAN_LOAD(buf, tb) do { _Pragma("unroll") for (int u_ = 0; u_ < U; ++u_) { const size_t o_ = (size_t)((tb) + u_) * D; \
            ik[buf][u_] = KK[o_ + col]; ir[buf][u_] = RW[o_ + col]; iw[buf][u_] = DEC[o_ + col]; ib[buf][u_] = BB[o_ + col]; im[buf][u_] = KM[o_ + col]; \
            iv[buf][u_] = V[o_ + rho]; i1[buf][u_] = CS[(size_t)((tb) + u_) * 16 + h]; i2[buf][u_] = CS[(size_t)T * 16 + (size_t)((tb) + u_) * 16 + h]; } } while (0)
#define SCAN_STEPS(buf, tb) do { _Pragma("unroll") for (int u_ = 0; u_ < U; ++u_) { \
            const float p1 = wave_allsum_fast(s * ik[buf][u_]); const float p2 = wave_allsum_fast(s * ir[buf][u_]); \
            const float sa = -p1; const float y = p2 + sa * i1[buf][u_] + iv[buf][u_] * i2[buf][u_]; \
            s = s * iw[buf][u_] + sa * ib[buf][u_] + iv[buf][u_] * im[buf][u_]; \
            if (lane == (((tb) + u_) & 63)) ybuf = y; } } while (0)
        SCAN_LOAD(0, 0);
        for (int t0 = 0; t0 < T; t0 += 2 * U) {
            SCAN_LOAD(1, t0 + U);
            SCAN_STEPS(0, t0);
            if (t0 + 2 * U < T) SCAN_LOAD(0, t0 + 2 * U);
            SCAN_STEPS(1, t0 + U);
            if (((t0 + 2 * U) & 63) == 0) YT[(size_t)rho * T + (t0 + 2 * U - 64) + lane] = ybuf;
        }
#undef SCAN_LOAD
#undef SCAN_STEPS
    }
}

typedef __bf16 bf16x2_t __attribute__((ext_vector_type(2)));
__device__ __forceinline__ unsigned cvtpk(float lo, float hi) { f32x2 v = {lo, hi}; bf16x2_t b = __builtin_convertvector(v, bf16x2_t); return __builtin_bit_cast(unsigned, b); }
struct Pk { bf16x8 k0, k1; };
__device__ __forceinline__ Pk pack_tile(const f32x16& t) {
    const u32x4 a = {cvtpk(t[0], t[1]), cvtpk(t[2], t[3]), cvtpk(t[4], t[5]), cvtpk(t[6], t[7])}, b = {cvtpk(t[8], t[9]), cvtpk(t[10], t[11]), cvtpk(t[12], t[13]), cvtpk(t[14], t[15])};
    Pk p; p.k0 = __builtin_bit_cast(bf16x8, a); p.k1 = __builtin_bit_cast(bf16x8, b); return p; }
#define MFMA32(a, b, c) __builtin_amdgcn_mfma_f32_32x32x16_bf16((a), (b), (c), 0, 0, 0)
__device__ __forceinline__ f32x16 xt(const Pk& X, const Pk& Z, f32x16 acc) { acc = MFMA32(X.k0, Z.k0, acc); acc = MFMA32(X.k1, Z.k1, acc); return acc; }
__device__ __forceinline__ bf16x8 nfrag(const bf16* m, int rt, int ks, int lane) { return *(const bf16x8*)(m + (size_t)(32 * rt + (lane & 31)) * D + 16 * ks + 8 * (lane >> 5)); }
__device__ __forceinline__ f32x16 nat(const bf16* am, int a, const bf16* bm, int b, int lane, f32x16 acc) {
#pragma unroll
    for (int ks = 0; ks < 4; ++ks) acc = MFMA32(nfrag(am, a, ks, lane), nfrag(bm, b, ks, lane), acc);
    return acc; }
__device__ __forceinline__ f32x16 dl_copy(const bf16* am, int a, int ct, int lane) {
    f32x16 acc = {};
#pragma unroll
    for (int kk2 = 0; kk2 < 2; ++kk2) { const int ks = 2 * ct + kk2; bf16x8 id;
#pragma unroll
        for (int e = 0; e < 8; ++e) id[e] = (32 * ct + (lane & 31) == 16 * ks + 8 * (lane >> 5) + e) ? (short)0x3F80 : (short)0;
        acc = MFMA32(nfrag(am, a, ks, lane), id, acc); }
    return acc; }
__device__ __forceinline__ void mask_lt(f32x16& t, int lane) {
#pragma unroll
    for (int r = 0; r < 16; ++r) if (!(crow(r, lane >> 5) < (lane & 31))) t[r] = 0.f; }
__device__ __forceinline__ void mask_gt(f32x16& t, int lane) {
#pragma unroll
    for (int r = 0; r < 16; ++r) if (!(crow(r, lane >> 5) > (lane & 31))) t[r] = 0.f; }
__device__ __forceinline__ void mask_le(f32x16& t, int lane) {
#pragma unroll
    for (int r = 0; r < 16; ++r) if (!(crow(r, lane >> 5) <= (lane & 31))) t[r] = 0.f; }
__device__ __forceinline__ void add_eye(f32x16& t, int lane) {
#pragma unroll
    for (int r = 0; r < 16; ++r) if (crow(r, lane >> 5) == (lane & 31)) t[r] += 1.f; }

__device__ __forceinline__ void p3_prep(Frame& F, const Args& a) {
    const int lane = F.lane;
    const bf16* R = (const bf16*)(F.ws + WS_R); const bf16* K = (const bf16*)(F.ws + WS_K); const bf16* V = (const bf16*)(F.ws + WS_V);
    const float* LW = (const float*)(F.ws + WS_LW); const bf16* AA = (const bf16*)(F.ws + WS_AA);
    bf16* AT = (bf16*)(F.ws + WS_AT); bf16* RT = (bf16*)(F.ws + WS_RT); bf16* BH = (bf16*)(F.ws + WS_BH); bf16* KH = (bf16*)(F.ws + WS_KH); bf16* V16 = (bf16*)(F.ws + WS_V16);
    float* GC = (float*)(F.ws + WS_GC); float* C3 = (float*)(F.ws + WS_CS) + (size_t)2 * T * 16;
    for (int task = F.gw; task < NCH * 4; task += F.NGW) {
        const int c = task >> 2, hg = task & 3, col = hg * 256 + 4 * lane;
        const f32x4 k_k = *(const f32x4*)(a.in[13] + col), k_a = *(const f32x4*)(a.in[14] + col), r_k = *(const f32x4*)(a.in[15] + col);
        f32x4 lg = {0.f, 0.f, 0.f, 0.f};
        constexpr int PF = 8;
        for (int tb = 0; tb < 64; tb += PF) {
            u32x2 rr[PF], kx[PF], ax[PF]; f32x4 lx[PF];
#pragma unroll
            for (int u = 0; u < PF; ++u) { const size_t o = (size_t)(64 * c + tb + u) * D + col;
                rr[u] = *(const u32x2*)(R + o); kx[u] = *(const u32x2*)(K + o); lx[u] = *(const f32x4*)(LW + o); ax[u] = *(const u32x2*)(AA + o); }
#pragma unroll
            for (int u = 0; u < PF; ++u) { const int tt = tb + u;
                const size_t o = (size_t)(64 * c + tt) * D + col;
                const f32x4 r = {bflo(rr[u].x), bfhi(rr[u].x), bflo(rr[u].y), bfhi(rr[u].y)}, k = {bflo(kx[u].x), bfhi(kx[u].x), bflo(kx[u].y), bfhi(kx[u].y)}, lw = lx[u], aa = {bflo(ax[u].x), bfhi(ax[u].x), bflo(ax[u].y), bfhi(ax[u].y)};
                f32x4 kk = k * k_k;
                float ss = (kk[0] * kk[0] + kk[1] * kk[1]) + (kk[2] * kk[2] + kk[3] * kk[3]); ss = row16_sum(ss);
                kk = kk * (1.f / fmaxf(sqrtf(ss), 1e-12f));
                const f32x4 b = kk * aa, km = k * (1.f + (aa - 1.f) * k_a);
                float s3 = (r[0] * km[0] * r_k[0] + r[1] * km[1] * r_k[1]) + (r[2] * km[2] * r_k[2] + r[3] * km[3] * r_k[3]); s3 = row16_sum(s3);
                if ((lane & 15) == 0) C3[(size_t)(64 * c + tt) * 16 + hg * 4 + (lane >> 4)] = s3;
                const f32x4 lgm1 = lg; lg = lg + lw;
                f32x4 at, rt, bh, kh;
#pragma unroll
                for (int i = 0; i < 4; ++i) { const float em = __expf(lgm1[i]), ep = __expf(lg[i]), en = __expf(-lg[i]); at[i] = -kk[i] * em; rt[i] = r[i] * ep; bh[i] = b[i] * en; kh[i] = km[i] * en; }
                *(u32x2*)(AT + o) = (u32x2){pk2(at[0], at[1]), pk2(at[2], at[3])}; *(u32x2*)(RT + o) = (u32x2){pk2(rt[0], rt[1]), pk2(rt[2], rt[3])};
                *(u32x2*)(BH + o) = (u32x2){pk2(bh[0], bh[1]), pk2(bh[2], bh[3])}; *(u32x2*)(KH + o) = (u32x2){pk2(kh[0], kh[1]), pk2(kh[2], kh[3])};
            }
        }
        f32x4 g; for (int i = 0; i < 4; ++i) g[i] = __expf(lg[i]);
        *(f32x4*)(GC + (size_t)c * D + col) = g;
    }
}

__device__ __forceinline__ void inv32(f32x16 N, f32x16 NT, f32x16& Tm, f32x16& TT, int lane) {
    Tm = N; TT = NT; add_eye(Tm, lane); add_eye(TT, lane);
    Pk Np = pack_tile(N), NTp = pack_tile(NT);
#pragma unroll
    for (int it = 0; it < 4; ++it) {
        const f32x16 z = {};
        const f32x16 N2 = xt(NTp, Np, z), N2T = xt(Np, NTp, z);
        const Pk N2p = pack_tile(N2), N2Tp = pack_tile(N2T), TTp = pack_tile(TT);
        Tm = xt(TTp, N2p, Tm);
        TT = xt(N2p, TTp, TT);
        Np = N2p; NTp = N2Tp;
    }
}

__device__ __forceinline__ void pa_chunk(Frame& F) {
    const int lane = F.lane, c32 = lane & 31, hh = lane >> 5;
    const bf16* AT = (const bf16*)(F.ws + WS_AT); const bf16* BH = (const bf16*)(F.ws + WS_BH); const bf16* KH = (const bf16*)(F.ws + WS_KH); const bf16* V16 = (const bf16*)(F.ws + WS_V16);
    const float* GC = (const float*)(F.ws + WS_GC);
    for (int task = F.gw; task < NCH * NH; task += F.NGW) {
        const int c = task >> 4, h = task & 15; const size_t o = (size_t)(64 * c) * D + h * 64;
        const bf16* at = AT + o; const bf16* bh = BH + o; const bf16* kh = KH + o; const bf16* vv = V16 + o;
        const f32x16 z = {};
        Pk T11, T22, T12, T11T, T22T, T12T;
        {
            f32x16 n = nat(bh, 0, at, 0, lane, z), nt = nat(at, 0, bh, 0, lane, z); mask_lt(n, lane); mask_gt(nt, lane);
            f32x16 t, tt; inv32(n, nt, t, tt, lane); T11 = pack_tile(t); T11T = pack_tile(tt);
            n = nat(bh, 1, at, 1, lane, z); nt = nat(at, 1, bh, 1, lane, z); mask_lt(n, lane); mask_gt(nt, lane);
            inv32(n, nt, t, tt, lane); T22 = pack_tile(t); T22T = pack_tile(tt);
            const Pk N12 = pack_tile(nat(bh, 0, at, 1, lane, z)), N12T = pack_tile(nat(at, 1, bh, 0, lane, z));
            const Pk Z1 = pack_tile(xt(N12T, T22, z));
            T12 = pack_tile(xt(T11T, Z1, z));
            const Pk Z2 = pack_tile(xt(N12, T11T, z));
            T12T = pack_tile(xt(T22, Z2, z));
        }
        {
            u32x4* tm = (u32x4*)(F.ws + WS_TM) + (size_t)task * 6 * 64 + lane;
            tm[0] = __builtin_bit_cast(u32x4, T11.k0); tm[64] = __builtin_bit_cast(u32x4, T11.k1); tm[128] = __builtin_bit_cast(u32x4, T12.k0); tm[192] = __builtin_bit_cast(u32x4, T12.k1);
            tm[256] = __builtin_bit_cast(u32x4, T22.k0); tm[320] = __builtin_bit_cast(u32x4, T22.k1);
        }
        const float g0 = GC[(size_t)c * D + h * 64 + c32], g1 = GC[(size_t)c * D + h * 64 + 32 + c32];
        Pk W1p[2][2];
#pragma unroll
        for (int b = 0; b < 2; ++b) { const float gcol = b == 0 ? g0 : g1;
            f32x16 bb0 = dl_copy(bh, 0, b, lane), bb1 = dl_copy(bh, 1, b, lane);
#pragma unroll
            for (int r = 0; r < 16; ++r) { bb0[r] *= gcol; bb1[r] *= gcol; }
            const Pk B0 = pack_tile(bb0), B1 = pack_tile(bb1);
            f32x16 w0 = xt(T11T, B0, z); w0 = xt(T12T, B1, w0);
            const f32x16 w1 = xt(T22T, B1, z);
            W1p[0][b] = pack_tile(w0); W1p[1][b] = pack_tile(w1); }
        {
            bf16* plr = (bf16*)(F.ws + WS_PLR) + (size_t)task * 4096;
#pragma unroll
            for (int a2 = 0; a2 < 2; ++a2) { const Pk A0 = pack_tile(dl_copy(at, 0, a2, lane)), A1 = pack_tile(dl_copy(at, 1, a2, lane));
#pragma unroll
                for (int b = 0; b < 2; ++b) { f32x16 p = xt(A0, W1p[0][b], z); p = xt(A1, W1p[1][b], p);
#pragma unroll
                    for (int g4 = 0; g4 < 4; ++g4) {
                        const int m_ = 2 * b + (c32 >> 4), lb_ = (c32 & 15) + 16 * (2 * (g4 & 1) + hh);
                        *(u32x2*)(plr + ((m_ * 2 + a2) * 64 + lb_) * 8 + 4 * (g4 >> 1)) = (u32x2){cvtpk(p[4 * g4], p[4 * g4 + 1]), cvtpk(p[4 * g4 + 2], p[4 * g4 + 3])}; } } }
        }
        Pk M2p[2][2];
        {
            f32x16 e = nat(at, 0, kh, 0, lane, z); mask_gt(e, lane); const Pk E00 = pack_tile(e);
            e = nat(at, 1, kh, 1, lane, z); mask_gt(e, lane); const Pk E11 = pack_tile(e);
            const Pk E10 = pack_tile(nat(at, 1, kh, 0, lane, z));
#pragma unroll
            for (int b = 0; b < 2; ++b) { const float gcol = b == 0 ? g0 : g1;
                f32x16 m0 = xt(E00, W1p[0][b], z); m0 = xt(E10, W1p[1][b], m0);
                f32x16 m1 = xt(E11, W1p[1][b], z);
                const f32x16 k0 = dl_copy(kh, 0, b, lane), k1 = dl_copy(kh, 1, b, lane);
#pragma unroll
                for (int r = 0; r < 16; ++r) { m0[r] += k0[r] * gcol; m1[r] += k1[r] * gcol; }
                M2p[0][b] = pack_tile(m0); M2p[1][b] = pack_tile(m1); }
        }
        {
            float* qm = (float*)(F.ws + WS_QM) + (size_t)task * 4096;
#pragma unroll
            for (int b = 0; b < 2; ++b) { const Pk V0 = pack_tile(dl_copy(vv, 0, b, lane)), V1 = pack_tile(dl_copy(vv, 1, b, lane));
#pragma unroll
                for (int a2 = 0; a2 < 2; ++a2) { f32x16 q = xt(M2p[0][a2], V0, z); q = xt(M2p[1][a2], V1, q);
#pragma unroll
                    for (int g4 = 0; g4 < 4; ++g4) {
                        const int rg_ = 2 * b + (c32 >> 4), m_ = 2 * a2 + (g4 >> 1), lb_ = (c32 & 15) + 16 * (2 * (g4 & 1) + hh);
                        *(f32x4*)(qm + rg_ * 1024 + (m_ * 64 + lb_) * 4) = (f32x4){q[4 * g4], q[4 * g4 + 1], q[4 * g4 + 2], q[4 * g4 + 3]}; } } }
        }
    }
}

constexpr int PB_NST = 10, PB_STB = 8192 + 4096 + 256, PB_NLD = 3;
constexpr int PB_FULL_OFF = RING_BYTES + 64, PB_CONS_OFF = RING_BYTES + 128;
static_assert(PB_NST * PB_STB <= RING_BYTES && PB_FULL_OFF + 4 * PB_NST <= PB_CONS_OFF && PB_CONS_OFF + 4 <= MISC_OFF, "phase-B LDS map");
__device__ __forceinline__ void pb_chain(Frame& F) {
    if ((F.vcu & 31) >= 8 || F.vcu >= 256 || F.wave > PB_NLD) return;
    const int lane = F.lane, h = 2 * (F.vcu >> 5) + ((F.vcu & 31) >> 2), rg = F.vcu & 3;
    volatile LAS unsigned* FULL = (volatile LAS unsigned*)(F.lds + PB_FULL_OFF); volatile LAS unsigned* CONS = (volatile LAS unsigned*)(F.lds + PB_CONS_OFF);
    if (F.wave >= 1) {
        const int L = F.wave - 1;
        const char* PLR = (const char*)(F.ws + WS_PLR); const char* QM = (const char*)(F.ws + WS_QM); const float* GC = (const float*)(F.ws + WS_GC);
        int k = 0;
        for (int c = L; c < NCH; c += PB_NLD, ++k) {
            if (c >= PB_NST) { const unsigned need = (unsigned)(c - PB_NST + 1); unsigned sp = 0; while (CONS[0] < need) { __builtin_amdgcn_s_sleep(1); if (++sp > (1u << 22)) break; } }
            const size_t task = (size_t)c * 16 + h;
            LAS unsigned char* slot = F.lds + (c % PB_NST) * PB_STB;
            const char* pl = PLR + task * 8192 + lane * 16; const char* qm = QM + task * 16384 + rg * 4096 + lane * 16;
#pragma unroll
            for (int i = 0; i < 8; ++i) __builtin_amdgcn_global_load_lds((const unsigned*)(pl + i * 1024), (LAS unsigned*)(slot + i * 1024), 16, 0, 0);
#pragma unroll
            for (int i = 0; i < 4; ++i) __builtin_amdgcn_global_load_lds((const unsigned*)(qm + i * 1024), (LAS unsigned*)(slot + 8192 + i * 1024), 16, 0, 0);
            __builtin_amdgcn_global_load_lds((const unsigned*)(GC + (size_t)c * D + h * 64 + lane), (LAS unsigned*)(slot + 12288), 4, 0, 0);
            if (k >= 2) { asm volatile("s_waitcnt vmcnt(26)" ::: "memory"); const int cp = c - 2 * PB_NLD; FULL[cp % PB_NST] = (unsigned)(cp + 1); }
        }
        const int clast = L + PB_NLD * (k - 1);
        if (k >= 2) { asm volatile("s_waitcnt vmcnt(13)" ::: "memory"); const int cp = clast - PB_NLD; FULL[cp % PB_NST] = (unsigned)(cp + 1); }
        asm volatile("s_waitcnt vmcnt(0)" ::: "memory"); FULL[clast % PB_NST] = (unsigned)(clast + 1);
        return;
    }
    const int n16 = lane & 15, q4 = lane >> 4;
    bf16* S0 = (bf16*)(F.ws + WS_S0);
    f32x4 s[4];
#pragma unroll
    for (int m = 0; m < 4; ++m) s[m] = (f32x4){0.f, 0.f, 0.f, 0.f};
    for (int c = 0; c < NCH; ++c) {
        { const unsigned need = (unsigned)(c + 1); unsigned sp = 0; while (FULL[c % PB_NST] < need) { if (++sp > (1u << 24)) break; } }
        const LAS unsigned char* slot = F.lds + (c % PB_NST) * PB_STB;
        bf16x8 af[4][2]; f32x4 qv[4], gc[4];
#pragma unroll
        for (int m = 0; m < 4; ++m) {
#pragma unroll
            for (int kb = 0; kb < 2; ++kb) af[m][kb] = *(const LAS bf16x8*)(slot + ((m * 2 + kb) * 64 + lane) * 16);
            qv[m] = *(const LAS f32x4*)(slot + 8192 + (m * 64 + lane) * 16); gc[m] = *(const LAS f32x4*)(slot + 12288 + 64 * m + 16 * q4); }
        asm volatile("s_waitcnt lgkmcnt(0)" ::: "memory");
        CONS[0] = (unsigned)(c + 1);
        bf16* s0 = S0 + ((size_t)c * 16 + h) * 4096 + (16 * rg + n16) * 64;
        u32x2 sp2[4];
#pragma unroll
        for (int m = 0; m < 4; ++m) { sp2[m] = (u32x2){cvtpk(s[m][0], s[m][1]), cvtpk(s[m][2], s[m][3])}; *(u32x2*)(s0 + 16 * m + 4 * q4) = sp2[m]; }
        const bf16x8 B0 = __builtin_bit_cast(bf16x8, (u32x4){sp2[0].x, sp2[0].y, sp2[1].x, sp2[1].y}), B1 = __builtin_bit_cast(bf16x8, (u32x4){sp2[2].x, sp2[2].y, sp2[3].x, sp2[3].y});
#pragma unroll
        for (int m = 0; m < 4; ++m) { f32x4 acc = s[m] * gc[m] + qv[m];
            acc = __builtin_amdgcn_mfma_f32_16x16x32_bf16(af[m][0], B0, acc, 0, 0, 0);
            acc = __builtin_amdgcn_mfma_f32_16x16x32_bf16(af[m][1], B1, acc, 0, 0, 0);
            s[m] = acc; }
    }
}

__device__ __forceinline__ void pc_out(Frame& F, const Args& a) {
    const int lane = F.lane, c32 = lane & 31, hh = lane >> 5;
    const bf16* AT = (const bf16*)(F.ws + WS_AT); const bf16* RT = (const bf16*)(F.ws + WS_RT); const bf16* BH = (const bf16*)(F.ws + WS_BH); const bf16* KH = (const bf16*)(F.ws + WS_KH);
    const bf16* V16 = (const bf16*)(F.ws + WS_V16); const bf16* S0 = (const bf16*)(F.ws + WS_S0);
    const bf16* G = (const bf16*)(F.ws + WS_G); const float* C3 = (const float*)(F.ws + WS_CS) + (size_t)2 * T * 16; bf16* Z = (bf16*)(F.ws + WS_Z);
    LAS float* ysc = (LAS float*)(F.lds + F.wave * 16384);
    for (int task = F.gw; task < NCH * NH; task += F.NGW) {
        const int c = task >> 4, h = task & 15; const size_t o = (size_t)(64 * c) * D + h * 64;
        const bf16* at = AT + o; const bf16* rt = RT + o; const bf16* bh = BH + o; const bf16* kh = KH + o; const bf16* vv = V16 + o;
        const bf16* s0 = S0 + (size_t)task * 4096;
        const f32x16 z = {};
        auto s0frag = [&](int it, int ks) { return *(const bf16x8*)(s0 + (32 * it + c32) * 64 + 16 * ks + 8 * hh); };
#pragma unroll 1
        for (int b = 0; b < 2; ++b) {
            f32x16 e = nat(kh, 0, at, 0, lane, z); mask_lt(e, lane); const Pk K00 = pack_tile(e);
            e = nat(kh, 1, at, 1, lane, z); mask_lt(e, lane); const Pk K11 = pack_tile(e);
            const Pk K01 = pack_tile(nat(kh, 0, at, 1, lane, z));
            __builtin_amdgcn_sched_barrier(0);
            const Pk V0 = pack_tile(dl_copy(vv, 0, b, lane)), V1 = pack_tile(dl_copy(vv, 1, b, lane));
            __builtin_amdgcn_sched_barrier(0);
            f32x16 x0 = z, x1 = z;
#pragma unroll
            for (int ks = 0; ks < 4; ++ks) { const bf16x8 sf = s0frag(b, ks); x0 = MFMA32(nfrag(at, 0, ks, lane), sf, x0); x1 = MFMA32(nfrag(at, 1, ks, lane), sf, x1); }
            x0 = xt(K00, V0, x0);
            x1 = xt(K01, V0, x1); x1 = xt(K11, V1, x1);
            const Pk X0 = pack_tile(x0), X1 = pack_tile(x1);
            __builtin_amdgcn_sched_barrier(0);
            Pk Tm00, Tm01, Tm11;
            { const u32x4* tm = (const u32x4*)(F.ws + WS_TM) + (size_t)task * 6 * 64 + lane;
              Tm00.k0 = __builtin_bit_cast(bf16x8, tm[0]); Tm00.k1 = __builtin_bit_cast(bf16x8, tm[64]); Tm01.k0 = __builtin_bit_cast(bf16x8, tm[128]); Tm01.k1 = __builtin_bit_cast(bf16x8, tm[192]);
              Tm11.k0 = __builtin_bit_cast(bf16x8, tm[256]); Tm11.k1 = __builtin_bit_cast(bf16x8, tm[320]); }
            const Pk U0 = pack_tile(xt(Tm00, X0, z));
            f32x16 u1 = xt(Tm01, X0, z); u1 = xt(Tm11, X1, u1); const Pk U1 = pack_tile(u1);
            __builtin_amdgcn_sched_barrier(0);
            f32x16 y0 = z, y1 = z;
#pragma unroll
            for (int ks = 0; ks < 4; ++ks) { const bf16x8 sf = s0frag(b, ks); y0 = MFMA32(nfrag(rt, 0, ks, lane), sf, y0); y1 = MFMA32(nfrag(rt, 1, ks, lane), sf, y1); }
            { f32x16 m = nat(bh, 0, rt, 0, lane, z); mask_le(m, lane); const Pk R00 = pack_tile(m); y0 = xt(R00, U0, y0);
              const Pk R01 = pack_tile(nat(bh, 0, rt, 1, lane, z)); y1 = xt(R01, U0, y1);
              m = nat(bh, 1, rt, 1, lane, z); mask_le(m, lane); const Pk R11 = pack_tile(m); y1 = xt(R11, U1, y1); }
            __builtin_amdgcn_sched_barrier(0);
            { f32x16 m = nat(kh, 0, rt, 0, lane, z); mask_le(m, lane); const Pk R00 = pack_tile(m); y0 = xt(R00, V0, y0);
              const Pk R01 = pack_tile(nat(kh, 0, rt, 1, lane, z)); y1 = xt(R01, V0, y1);
              m = nat(kh, 1, rt, 1, lane, z); mask_le(m, lane); const Pk R11 = pack_tile(m); y1 = xt(R11, V1, y1); }
            __builtin_amdgcn_sched_barrier(0);
#pragma unroll
            for (int r = 0; r < 16; ++r) { ysc[crow(r, hh) * 64 + 32 * b + c32] = y0[r]; ysc[(32 + crow(r, hh)) * 64 + 32 * b + c32] = y1[r]; }
        }
        LDS_WAIT();
        {
            int lane_e = lane; asm volatile("" : "+v"(lane_e));
            const int l16 = lane_e & 15, tq = lane_e >> 4, col = h * 64 + 4 * l16;
            const f32x4 gg = *(const f32x4*)(a.in[16] + col), gb = *(const f32x4*)(a.in[17] + col);
#pragma unroll 2
            for (int it = 0; it < 16; ++it) { const int tt = 4 * it + tq; const size_t row = (size_t)(64 * c + tt);
                const f32x4 y = *(const LAS f32x4*)(ysc + tt * 64 + 4 * l16);
                const u32x2 gw = *(const u32x2*)(G + row * D + col), vw = *(const u32x2*)(V16 + row * D + col); const float c3 = C3[row * 16 + h];
                const float mean = row16_sum((y[0] + y[1]) + (y[2] + y[3])) * (1.f / 64.f);
                const f32x4 d = y - mean;
                const float var = row16_sum((d[0] * d[0] + d[1] * d[1]) + (d[2] * d[2] + d[3] * d[3])) * (1.f / 64.f);
                const float rs = rsqrtf(var + GN_EPS);
                const f32x4 g = {bflo(gw.x), bfhi(gw.x), bflo(gw.y), bfhi(gw.y)}, v = {bflo(vw.x), bfhi(vw.x), bflo(vw.y), bfhi(vw.y)};
                const f32x4 zv = (d * rs * gg + gb + c3 * v) * g;
                *(u32x2*)(Z + row * D + col) = (u32x2){pk2(zv[0], zv[1]), pk2(zv[2], zv[3])}; }
        }
        LDS_WAIT();
    }
}

__device__ __forceinline__ void p6_gn_rows(Frame& F, const Args& a) {
    const int lane = F.lane;
    const float* Y = (const float*)(F.ws + WS_Y); const bf16* V16 = (const bf16*)(F.ws + WS_V16); const bf16* G = (const bf16*)(F.ws + WS_G);
    const float* C3 = (const float*)(F.ws + WS_CS) + (size_t)2 * T * 16; bf16* Z = (bf16*)(F.ws + WS_Z);
    const Row gg = ld_row(a.in[16], lane), gb = ld_row(a.in[17], lane);
    for (int t = F.gw; t < T; t += F.NGW) {
        const size_t o = (size_t)t * D;
        const Row y = ld_row(Y + o, lane), g = ld_row_bf16(G + o, lane), v = ld_row_bf16(V16 + o, lane); Row zr;
#pragma unroll
        for (int j = 0; j < 4; ++j) {
            const float mean = row16_sum((y.v[j][0] + y.v[j][1]) + (y.v[j][2] + y.v[j][3])) * (1.f / 64.f);
            const f32x4 d = y.v[j] - mean;
            const float var = row16_sum((d[0] * d[0] + d[1] * d[1]) + (d[2] * d[2] + d[3] * d[3])) * (1.f / 64.f);
            const float rs = rsqrtf(var + GN_EPS), c3 = C3[(size_t)t * 16 + 4 * j + (lane >> 4)];
            zr.v[j] = (d * rs * gg.v[j] + gb.v[j] + c3 * v.v[j]) * g.v[j];
        }
        st_row_bf16(Z + o, lane, zr);
    }
}

__device__ __forceinline__ void p6_gn(Frame& F, const Args& a) {
    const int lane = F.lane, wave = F.wave;
    const float* YT = (const float*)(F.ws + WS_YT); const float* V = (const float*)(F.ws + WS_V); const float* G = (const float*)(F.ws + WS_G);
    const float* C3 = (const float*)(F.ws + WS_CS) + (size_t)2 * T * 16; bf16* Z = (bf16*)(F.ws + WS_Z);
    LAS float* tile = (LAS float*)F.lds;
    for (int unit = F.vcu; unit < NH * (T / 64); unit += F.G) {
        const int h = unit / (T / 64), t0 = (unit % (T / 64)) * 64;
        __syncthreads();
#pragma unroll
        for (int q = 0; q < 8; ++q) { const int i = wave * 8 + q; tile[i * 65 + lane] = YT[(size_t)(h * 64 + i) * T + t0 + lane]; }
        __syncthreads();
        const float gg = a.in[16][h * 64 + lane], gb = a.in[17][h * 64 + lane];
#pragma unroll
        for (int q = 0; q < 8; ++q) { const int tt = wave * 8 + q, t = t0 + tt;
            const float y = tile[lane * 65 + tt];
            const float mean = wave_sum(y) * (1.f / 64.f); const float dlt = y - mean; const float var = wave_sum(dlt * dlt) * (1.f / 64.f);
            const size_t o = (size_t)t * D + h * 64 + lane;
            const float z = (dlt * rsqrtf(var + GN_EPS) * gg + gb + C3[(size_t)t * 16 + h] * V[o]) * G[o];
            Z[o] = (bf16)f2bf(z); }
    }
    __syncthreads();
}

__device__ __forceinline__ void p8_norm(Frame& F, const float* g, bf16* U) {
    const float* Hs = (const float*)(F.ws + WS_H); const Row gr = ld_row(g, F.lane);
    for (int t = F.gw; t < T; t += F.NGW) st_row_bf16(U + (size_t)t * D, F.lane, rmsnorm_row(ld_row(Hs + (size_t)t * D, F.lane), gr));
}
__device__ __forceinline__ void p11_norm_forget(Frame& F, const Args& a) {
    const int lane = F.lane; const float* Hs = (const float*)(F.ws + WS_H); bf16* U = (bf16*)(F.ws + WS_U3); float* LF = (float*)(F.ws + WS_LF);
    LAS float* wf = (LAS float*)F.lds;
    __syncthreads();
    for (int i = F.tid; i < 16 * D; i += NTHREADS) { const int hh = i & 15, k = i >> 4; wf[hh * D + k] = a.in[19][(size_t)k * WIN_LD + 4 * D + hh]; }
    __syncthreads();
    const Row gr = ld_row(a.in[1] + 2 * D, lane);
    for (int t = F.gw; t < T; t += F.NGW) {
        const Row u = rmsnorm_row(ld_row(Hs + (size_t)t * D, lane), gr);
        st_row_bf16(U + (size_t)t * D, lane, u);
        float mine = 0.f;
#pragma unroll 2
        for (int hh = 0; hh < 16; ++hh) { float s = 0.f;
#pragma unroll
            for (int j = 0; j < 4; ++j) { const f32x4 w = *(const LAS f32x4*)(wf + hh * D + 256 * j + 4 * lane); s += (u.v[j][0] * w[0] + u.v[j][1] * w[1]) + (u.v[j][2] * w[2] + u.v[j][3] * w[3]); }
            s = wave_sum(s); if (lane == hh) mine = s; }
        if (lane < 16) { const float x = mine + a.in[20][lane]; LF[(size_t)t * 16 + lane] = fminf(x, 0.f) - log1pf(__expf(-fabsf(x))); }
    }
    __syncthreads();
}
__device__ __forceinline__ void p13_cumsum_qknorm(Frame& F, const Args& a) {
    const int lane = F.lane, tid = F.tid;
    const float* LF = (const float*)(F.ws + WS_LF); float* C2 = (float*)(F.ws + WS_C2); float* CB = (float*)(F.ws + WS_CB);
    if (F.vcu < NH) {
        const int h = F.vcu; LAS double* part = (LAS double*)F.lds;
        __syncthreads();
        const int tb = tid * 32; double s = 0.0;
        for (int i = 0; i < 32; ++i) s += (double)LF[(size_t)(tb + i) * 16 + h];
        part[tid] = s; __syncthreads();
        if (tid == 0) { double run = 0.0; for (int i = 0; i < NTHREADS; ++i) { const double v = part[i]; part[i] = run; run += v; } }
        __syncthreads();
        double run = part[tid];
        for (int i = 0; i < 32; ++i) { run += (double)LF[(size_t)(tb + i) * 16 + h]; const float c = (float)(run * 1.4426950408889634); C2[(size_t)h * T + tb + i] = c; if (((tb + i) & 63) == 63) CB[h * 256 + ((tb + i) >> 6)] = c; }
        __syncthreads();
    }
    bf16* Q = (bf16*)(F.ws + WS_QKVG);
    f32x4 gq[4], gk[4];
#pragma unroll
    for (int j = 0; j < 4; ++j) { const int c = (4 * lane + 256 * j) & 63; gq[j] = *(const f32x4*)(a.in[21] + c) * (0.125f * LOG2E); gk[j] = *(const f32x4*)(a.in[22] + c); }
    for (int t = F.gw; t < T; t += F.NGW) {
#pragma unroll
        for (int which = 0; which < 2; ++which) {
            bf16* p = Q + (size_t)t * 4096 + which * D;
            Row x = ld_row_bf16(p, lane);
#pragma unroll
            for (int j = 0; j < 4; ++j) { float ss = (x.v[j][0] * x.v[j][0] + x.v[j][1] * x.v[j][1]) + (x.v[j][2] * x.v[j][2] + x.v[j][3] * x.v[j][3]); ss = row16_sum(ss);
                const float rs = rsqrtf(ss * (1.f / 64.f) + RMS_EPS); x.v[j] = x.v[j] * rs * (which == 0 ? gq[j] : gk[j]); }
            st_row_bf16(p, lane, x);
        }
    }
}

#ifndef ATTN_STORE16
#define ATTN_STORE16(p,v) (*(u32x4*)(p)=(v))
#endif
namespace attn_body {
using bf16x8=__attribute__((ext_vector_type(8)))short;
using s16x4=__attribute__((ext_vector_type(4)))short;
using f32x16=__attribute__((ext_vector_type(16)))float;
using u32x4=__attribute__((ext_vector_type(4)))unsigned;
constexpr int NHEAD=16,SEQ=16384,D=64,DM=4096,OM=1024;
constexpr int NW=8,QBLK=32,QB=QBLK*NW,KVBLK=64,NQB=SEQ/QB;
constexpr int ATTN_UNIT_ROWS=QB;
__device__ __forceinline__ int crow(int r,int hi){return (r&3)+8*(r>>2)+4*hi;}
#define SBAR() __builtin_amdgcn_sched_barrier(0)
__device__ __forceinline__ void cmask(f32x16&p0,f32x16&p1,int jb,int qrel,int hi){
  const float NEG=-INFINITY; int kb=64*jb+4*hi;
  #pragma unroll
  for(int r=0;r<16;++r){int kv=kb+(r&3)+8*(r>>2); if(kv>qrel)p0[r]=NEG; if(kv+32>qrel)p1[r]=NEG;}
}

constexpr int NSLOT=3, SLOTB=8192;
constexpr int LDS_K=0, LDS_V=NSLOT*SLOTB, LDS_WS=2*NSLOT*SLOTB, LDS_OST=LDS_WS+NW*64*4, LDS_BYTES=LDS_OST+NW*4096;
constexpr float C2=0.125f*1.4426950408889634f;
__device__ __forceinline__ void glds16(const void*gsrc,unsigned lds_dst){unsigned keep;
  asm volatile("s_mov_b32 %0, m0\n\ts_mov_b32 m0, %2\n\ts_nop 0\n\tglobal_load_lds_dwordx4 %1, off\n\ts_mov_b32 m0, %0":"=&s"(keep):"v"(gsrc),"s"(lds_dst):"memory");}
__device__ __forceinline__ float max3f(float a,float b,float c){float r;asm("v_max3_f32 %0, %1, %2, %3":"=v"(r):"v"(a),"v"(b),"v"(c));return r;}
__device__ __forceinline__ float max2f(float a,float b){float r;asm("v_max_f32_e32 %0, %1, %2":"=v"(r):"v"(a),"v"(b));return r;}
__device__ __forceinline__ float fadd_s(float a,float b){float r;asm("v_add_f32_e32 %0, %1, %2":"=v"(r):"v"(a),"v"(b));return r;}
__device__ __forceinline__ float fsub_s(float a,float b){float r;asm("v_sub_f32_e32 %0, %1, %2":"=v"(r):"v"(a),"v"(b));return r;}
typedef float f32x2_t __attribute__((ext_vector_type(2))); typedef __bf16 bf16x2_t __attribute__((ext_vector_type(2)));
__device__ __forceinline__ unsigned cvtpk_s(float lo,float hi){f32x2_t v={lo,hi};bf16x2_t b=__builtin_convertvector(v,bf16x2_t);return __builtin_bit_cast(unsigned,b);}
#define WAIT_BAR(N) asm volatile("s_waitcnt vmcnt(" #N ") lgkmcnt(0)\n\ts_barrier":::"memory")

__device__ __forceinline__ void qkt(f32x16&p0,f32x16&p1,const char*Kslot,const __attribute__((address_space(3))) char*qst,const f32x16&cin0,const f32x16&cin1,int r32,int hi){
  #define QF_(i) (*(const __attribute__((address_space(3))) bf16x8*)(qst+(i)*1024))
  const char*kb=Kslot+hi*1024+r32*16;
  #pragma unroll
  for(int d0=0;d0<4;++d0){
    const bf16x8 b0=*reinterpret_cast<const bf16x8*>(kb+d0*2048);
    const bf16x8 b1=*reinterpret_cast<const bf16x8*>(kb+d0*2048+512);
    const bf16x8 qd=QF_(d0);
    if(d0==0){p0=__builtin_amdgcn_mfma_f32_32x32x16_bf16(b0,qd,cin0,0,0,0);p1=__builtin_amdgcn_mfma_f32_32x32x16_bf16(b1,qd,cin1,0,0,0);}
    else{p0=__builtin_amdgcn_mfma_f32_32x32x16_bf16(b0,qd,p0,0,0,0);p1=__builtin_amdgcn_mfma_f32_32x32x16_bf16(b1,qd,p1,0,0,0);}}
  #undef QF_
}
typedef __attribute__((address_space(3))) const char* lds_cptr;
typedef short v4i16_t __attribute__((ext_vector_type(4)));
__device__ __forceinline__ void kload8(bf16x8*kf,lds_cptr kp){
  kf[0]=*(const __attribute__((address_space(3))) bf16x8*)(kp);      kf[1]=*(const __attribute__((address_space(3))) bf16x8*)(kp+512);
  kf[2]=*(const __attribute__((address_space(3))) bf16x8*)(kp+2048); kf[3]=*(const __attribute__((address_space(3))) bf16x8*)(kp+2560);
  kf[4]=*(const __attribute__((address_space(3))) bf16x8*)(kp+4096); kf[5]=*(const __attribute__((address_space(3))) bf16x8*)(kp+4608);
  kf[6]=*(const __attribute__((address_space(3))) bf16x8*)(kp+6144); kf[7]=*(const __attribute__((address_space(3))) bf16x8*)(kp+6656);
}
__device__ __forceinline__ void kload2(bf16x8*kf,lds_cptr kp,int j){ kf[2*j]=*(const __attribute__((address_space(3))) bf16x8*)(kp+j*2048); kf[2*j+1]=*(const __attribute__((address_space(3))) bf16x8*)(kp+j*2048+512); }
__device__ __forceinline__ s16x4 vtr(lds_cptr p){ return __builtin_bit_cast(s16x4,__builtin_amdgcn_ds_read_tr16_b64_v4i16((__attribute__((address_space(3))) v4i16_t*)p)); }
__device__ __forceinline__ float rowmax(const f32x16&p0,const f32x16&p1){
  float a=max3f(p0[0],p0[1],p1[0]),b=max3f(p0[2],p0[3],p1[1]);a=max3f(a,p1[2],p1[3]);
  #pragma unroll
  for(int r=4;r<16;r+=4){a=max3f(a,p0[r],p0[r+1]);b=max3f(b,p0[r+2],p0[r+3]);a=max3f(a,p1[r],p1[r+1]);b=max3f(b,p1[r+2],p1[r+3]);}
  const float m=max2f(a,b);
  auto rr=__builtin_amdgcn_permlane32_swap(__float_as_uint(m),__float_as_uint(m),false,false);
  return max2f(__uint_as_float(rr[0]),__uint_as_float(rr[1]));
}
__device__ __forceinline__ void pv(f32x16*o,int vb,bf16x8 pa0,bf16x8 pa1,bf16x8 pa2,bf16x8 pa3){
  #pragma unroll
  for(int d0=0;d0<2;++d0){s16x4 lo[4],hi[4];
    #pragma unroll
    for(int ks=0;ks<4;++ks){
      asm volatile("ds_read_b64_tr_b16 %0,%1 offset:%c2":"=&v"(lo[ks]):"v"(vb),"i"(d0*4096+ks*1024):"memory");
      asm volatile("ds_read_b64_tr_b16 %0,%1 offset:%c2":"=&v"(hi[ks]):"v"(vb),"i"(d0*4096+ks*1024+512):"memory");}
    asm volatile("s_waitcnt lgkmcnt(0)":::"memory");SBAR();
    #define PK(k) (bf16x8){lo[k][0],lo[k][1],lo[k][2],lo[k][3],hi[k][0],hi[k][1],hi[k][2],hi[k][3]}
    o[d0]=__builtin_amdgcn_mfma_f32_32x32x16_bf16(pa0,PK(0),o[d0],0,0,0);
    o[d0]=__builtin_amdgcn_mfma_f32_32x32x16_bf16(pa1,PK(1),o[d0],0,0,0);
    o[d0]=__builtin_amdgcn_mfma_f32_32x32x16_bf16(pa2,PK(2),o[d0],0,0,0);
    o[d0]=__builtin_amdgcn_mfma_f32_32x32x16_bf16(pa3,PK(3),o[d0],0,0,0);
    #undef PK
  }
}

#ifndef ATTN_STORE16
#define ATTN_STORE16(p,v) (*(u32x4*)(p)=(v))
#endif
template<int THRL> __device__ __forceinline__ void attn_unit(int h,int qb,int jstart,const bf16*Q,const bf16*__restrict__ K,const bf16*__restrict__ V,const bf16*__restrict__ OG,bf16*O,const float*__restrict__ C2h,char*shm){
  const int tid=threadIdx.x,lane=tid&63,r32=lane&31,hi=lane>>5; const int wid=__builtin_amdgcn_readfirstlane(tid>>6);
  const long rowbase=0; const int q0=qb*QB;
  const bf16*Qw=Q+(rowbase+q0+wid*QBLK)*DM+h*D;
  const bf16*Kh=K+(rowbase+(long)jstart*KVBLK)*DM+h*D,*Vh=V+(rowbase+(long)jstart*KVBLK)*DM+h*D;
  const lds_cptr shm3=(lds_cptr)shm;
  const unsigned lds0=(unsigned)(uintptr_t)shm;
  float*wsf=(float*)(shm+LDS_WS)+wid*64;
  const bf16*ksrc=Kh+(long)lane*DM+wid*8;
  const bf16*vsrc=Vh+(long)(16*(wid&3)+(lane>>2))*DM+(wid>>2)*32+(lane&3)*8;
  const unsigned kdst=lds0+LDS_K+wid*1024, vdst=lds0+LDS_V+wid*1024;
  #define DMA_K(t,slot) glds16(ksrc+(long)(t)*KVBLK*DM,(unsigned)__builtin_amdgcn_readfirstlane(kdst+(slot)))
  #define DMA_V(t,slot) glds16(vsrc+(long)(t)*KVBLK*DM,(unsigned)__builtin_amdgcn_readfirstlane(vdst+(slot)))
  const int vb0=(int)(lds0+LDS_V)+((lane>>4)&1)*32+(lane&3)*8+(4*hi+((lane&15)>>2))*64;
  const char*Kbase=shm+LDS_K; bf16x8 kf[8];
  const lds_cptr kp0=shm3+LDS_K+hi*1024+r32*16; const lds_cptr vp0=shm3+LDS_V+((lane>>4)&1)*32+(lane&3)*8+(4*hi+((lane&15)>>2))*64;
  const int NT=(q0+QB)/KVBLK-jstart;
  DMA_K(0,0);DMA_V(0,0);DMA_K(1,SLOTB);
  typedef __attribute__((address_space(3))) u32x4* lds_rptr; const lds_rptr brec=(lds_rptr)(shm3+LDS_BYTES);
  { const float cref=C2h[q0]; const float*cs=C2h+(long)jstart*KVBLK;
    int tid_e=tid; asm volatile("":"+v"(tid_e));
    for(int i_=tid_e;i_<NT*KVBLK;i_+=NW*64){ const float x_=cref-cs[i_]; const unsigned a1_=f2bf(x_); const float r1_=x_-__uint_as_float(a1_<<16); const unsigned a2_=f2bf(r1_); const float r2_=r1_-__uint_as_float(a2_<<16); const unsigned a3_=f2bf(r2_);
      brec[i_]=(u32x4){a1_|(a2_<<16),a3_,0u,0u}; }
    if(tid==0)brec[NT*KVBLK]=(u32x4){0x3F803F80u,0x00003F80u,0u,0u}; }
  const lds_cptr abp=(lds_cptr)brec+(hi?NT*KVBLK*16:r32*16); const int ast=hi?0:KVBLK*16, ab1=hi?0:32*16;
  #define ABF(t,half) (*(const __attribute__((address_space(3))) bf16x8*)(abp+(t)*ast+(half)*ab1))
  const lds_cptr qst=shm3+LDS_OST+wid*4096+lane*16;
  #pragma unroll
  for(int d0=0;d0<4;++d0){ const u32x4 qv_=*reinterpret_cast<const u32x4*>(&Qw[(long)r32*DM+d0*16+hi*8]); *(__attribute__((address_space(3))) u32x4*)(const_cast<__attribute__((address_space(3))) char*>(qst)+d0*1024)=qv_; }
  #define QF(i) (*(const __attribute__((address_space(3))) bf16x8*)(qst+(i)*1024))
  float mhat=0.f,l_reg=0.f;f32x16 o[2];o[0]=f32x16{};o[1]=f32x16{};
  u32x4 bmw=hi?(u32x4){0u,0u,0u,0u}:(u32x4){0x3F803F80u,0x00003F80u,0u,0u};
  #define SETBM() do{ const float nm_=-mhat; const unsigned a1_=f2bf(nm_); const float r1_=nm_-__uint_as_float(a1_<<16); const unsigned a2_=f2bf(r1_); const float r2_=r1_-__uint_as_float(a2_<<16); const unsigned a3_=f2bf(r2_); if(hi){bmw[0]=a1_|(a2_<<16);bmw[1]=a3_;} }while(0)
  #define BMF() __builtin_bit_cast(bf16x8,bmw)
  const f32x16 zero16=f32x16{};
  const int qrel=wid*QBLK+r32;
  #define CMASK(P0,P1,t) do{int jb_=(t)-(NT-4); if(jb_>=0)cmask(P0,P1,jb_,qrel,hi);}while(0)
  bool resc=false;
  #define START(P0,P1) do{ const float rm=rowmax(P0,P1); resc=false; \
    { const float dl=rm; mhat=fadd_s(mhat,dl); \
      _Pragma("unroll") for(int r=0;r<16;++r){P0[r]=fsub_s(P0[r],dl);P1[r]=fsub_s(P1[r],dl);} \
      SETBM(); } \
    _Pragma("unroll") for(int r=0;r<16;++r)P0[r]=__builtin_amdgcn_exp2f(P0[r]); }while(0)
  #define RESC() do{ if(resc){ asm volatile("s_waitcnt lgkmcnt(0)":::"memory"); \
      _Pragma("unroll") for(int d_=0;d_<2;++d_) _Pragma("unroll") for(int r=0;r<16;++r)o[d_][r]*=wsf[crow(r,hi)]; } }while(0)
  f32x16 pA0,pA1,pB0,pB1;
  int sl_prev=0,sl_cur=0,sl_next=SLOTB;
  #define ROT() do{sl_prev=sl_cur;sl_cur=sl_next;sl_next=(sl_next==(NSLOT-1)*SLOTB)?0:sl_next+SLOTB;}while(0)
  DMA_K(2,2*SLOTB);
  WAIT_BAR(3);
  { const f32x16 c0_=__builtin_amdgcn_mfma_f32_32x32x16_bf16(ABF(0,0),BMF(),zero16,0,0,0), c1_=__builtin_amdgcn_mfma_f32_32x32x16_bf16(ABF(0,1),BMF(),zero16,0,0,0); qkt(pA0,pA1,Kbase,qst,c0_,c1_,r32,hi); }
  asm volatile("s_nop 15\n\ts_nop 7":"+v"(pA0),"+v"(pA1));CMASK(pA0,pA1,0);
  START(pA0,pA1);
  _Pragma("unroll") for(int r=0;r<16;++r)pA1[r]=__builtin_amdgcn_exp2f(pA1[r]);
  WAIT_BAR(0);
  DMA_K(3,0);DMA_V(1,SLOTB);
  ROT();
  kload8(kf,kp0+sl_cur);
  WAIT_BAR(2);
  s16x4 vlo[8],vhi[8]; u32x4 pw0,pw1,pw2,pw3;
  #define PKW(P,B) cvtpk_s(P[B],P[B+1])
  #define PAF(k) __builtin_bit_cast(bf16x8,pw##k)
  #define VFR(i) (bf16x8){vlo[i][0],vlo[i][1],vlo[i][2],vlo[i][3],vhi[i][0],vhi[i][1],vhi[i][2],vhi[i][3]}
  #define PIN(x) asm volatile("":"+v"(x))
  #define MX3(a,b,c) __builtin_fmaxf(__builtin_fmaxf((a),(b)),(c))
  #define GAPA(MF,A0,A1,A2,A3,W0,W1,PW) do{ MF; sacc+=A0; sacc+=A1; sacc+=A2; sacc+=A3; PIN(sacc); W0; W1; PIN(PW); SBAR(); }while(0)
  #define EX(v) __builtin_amdgcn_exp2f(v)
  #define GAPB(MF,X,B) do{ MF; X[B]=EX(X[B]); X[B+1]=EX(X[B+1]); X[B+2]=EX(X[B+2]); X[B+3]=EX(X[B+3]); PIN(X); SBAR(); }while(0)
  #define VRD(i) do{ vlo[i]=vtr(vp_+(((i)>>2)*4096+((i)&3)*1024)); vhi[i]=vtr(vp_+(((i)>>2)*4096+((i)&3)*1024+512)); }while(0)
  #define KRD(G,j) do{ if(G){ kload2(kf,kp0+sl_next,j); SBAR(); } }while(0)
  #define STEP(C0,C1,P0,P1,t,GK,GV,GL) do{ SBAR(); \
    const lds_cptr vp_=vp0+sl_prev; \
    VRD(0); SBAR(); float sacc=(P0[0]+P0[1]); \
    C0=__builtin_amdgcn_mfma_f32_32x32x16_bf16(ABF(t,0),BMF(),zero16,0,0,0); C1=__builtin_amdgcn_mfma_f32_32x32x16_bf16(ABF(t,1),BMF(),zero16,0,0,0); SBAR(); \
    GAPA(C0=__builtin_amdgcn_mfma_f32_32x32x16_bf16(kf[0],QF(0),C0,0,0,0), P0[2],P0[3],P0[4],P0[5],     pw0[0]=PKW(P0,0), pw0[1]=PKW(P0,2), pw0); \
    VRD(4); SBAR(); GAPA(C1=__builtin_amdgcn_mfma_f32_32x32x16_bf16(kf[1],QF(0),C1,0,0,0), P0[6],P0[7],P0[8],P0[9],     pw0[2]=PKW(P0,4), pw0[3]=PKW(P0,6), pw0); \
    VRD(1); SBAR(); GAPA(C0=__builtin_amdgcn_mfma_f32_32x32x16_bf16(kf[2],QF(1),C0,0,0,0),   P0[10],P0[11],P0[12],P0[13], pw1[0]=PKW(P0,8), pw1[1]=PKW(P0,10), pw1); \
    VRD(5); SBAR(); GAPA(C1=__builtin_amdgcn_mfma_f32_32x32x16_bf16(kf[3],QF(1),C1,0,0,0),   P0[14],P0[15],P1[0],P1[1],   pw1[2]=PKW(P0,12),pw1[3]=PKW(P0,14), pw1); \
    VRD(2); SBAR(); GAPA(C0=__builtin_amdgcn_mfma_f32_32x32x16_bf16(kf[4],QF(2),C0,0,0,0),   P1[2],P1[3],P1[4],P1[5],     pw2[0]=PKW(P1,0), pw2[1]=PKW(P1,2), pw2); \
    VRD(6); SBAR(); GAPA(C1=__builtin_amdgcn_mfma_f32_32x32x16_bf16(kf[5],QF(2),C1,0,0,0),   P1[6],P1[7],P1[8],P1[9],     pw2[2]=PKW(P1,4), pw2[3]=PKW(P1,6), pw2); \
    VRD(3); SBAR(); GAPA(C0=__builtin_amdgcn_mfma_f32_32x32x16_bf16(kf[6],QF(3),C0,0,0,0),   P1[10],P1[11],P1[12],P1[13], pw3[0]=PKW(P1,8), pw3[1]=PKW(P1,10), pw3); \
    VRD(7); SBAR(); GAPA(C1=__builtin_amdgcn_mfma_f32_32x32x16_bf16(kf[7],QF(3),C1,0,0,0),   P1[14],P1[15],0.f,0.f,       pw3[2]=PKW(P1,12),pw3[3]=PKW(P1,14), pw3); \
    l_reg+=sacc; \
    if(GK){DMA_K((t)+3,sl_cur);} if(GV){DMA_V((t)+1,sl_next);} \
    CMASK(C0,C1,t); \
    { float a=MX3(C0[0],C0[1],C1[0]),b=MX3(C0[2],C0[3],C1[1]); a=MX3(a,C1[2],C1[3]); \
      _Pragma("unroll") for(int r=4;r<16;r+=4){a=MX3(a,C0[r],C0[r+1]);b=MX3(b,C0[r+2],C0[r+3]);a=MX3(a,C1[r],C1[r+1]);b=MX3(b,C1[r+2],C1[r+3]);} \
      float rm=__builtin_fmaxf(a,b); { auto rr=__builtin_amdgcn_permlane32_swap(__float_as_uint(rm),__float_as_uint(rm),false,false); rm=__builtin_fmaxf(__uint_as_float(rr[0]),__uint_as_float(rr[1])); } \
      resc=false; \
      if(__builtin_expect(__any(rm>(float)THRL),0)){ const float dl=__builtin_fmaxf(rm,0.f); mhat+=dl; \
        _Pragma("unroll") for(int r=0;r<16;++r){C0[r]-=dl;C1[r]-=dl;} \
        SETBM(); \
        const float f=__builtin_amdgcn_exp2f(-dl); l_reg*=f; if(hi==0)wsf[r32]=f; resc=true; } } \
    SBAR(); \
    GAPB(o[0]=__builtin_amdgcn_mfma_f32_32x32x16_bf16(PAF(0),VFR(0),o[0],0,0,0), C0,0); \
    GAPB(o[1]=__builtin_amdgcn_mfma_f32_32x32x16_bf16(PAF(0),VFR(4),o[1],0,0,0), C0,4); \
    KRD(GL,0); GAPB(o[0]=__builtin_amdgcn_mfma_f32_32x32x16_bf16(PAF(1),VFR(1),o[0],0,0,0), C0,8); \
    KRD(GL,1); GAPB(o[1]=__builtin_amdgcn_mfma_f32_32x32x16_bf16(PAF(1),VFR(5),o[1],0,0,0), C0,12); \
    KRD(GL,2); GAPB(o[0]=__builtin_amdgcn_mfma_f32_32x32x16_bf16(PAF(2),VFR(2),o[0],0,0,0), C1,0); \
    KRD(GL,3); GAPB(o[1]=__builtin_amdgcn_mfma_f32_32x32x16_bf16(PAF(2),VFR(6),o[1],0,0,0), C1,4); \
    GAPB(o[0]=__builtin_amdgcn_mfma_f32_32x32x16_bf16(PAF(3),VFR(3),o[0],0,0,0), C1,8); \
    GAPB(o[1]=__builtin_amdgcn_mfma_f32_32x32x16_bf16(PAF(3),VFR(7),o[1],0,0,0), C1,12); \
    }while(0)
  int t=1;
  #undef CMASK
  #define CMASK(P0,P1,t) do{}while(0)
  for(;t+5<NT;t+=2){
    STEP(pB0,pB1,pA0,pA1,t,true,true,true);     WAIT_BAR(2); RESC(); ROT();
    STEP(pA0,pA1,pB0,pB1,t+1,true,true,true);   WAIT_BAR(2); RESC(); ROT();
  }
  #undef CMASK
  #define CMASK(P0,P1,t) do{int jb_=(t)-(NT-4); if(jb_>=0)cmask(P0,P1,jb_,qrel,hi);}while(0)
  #define ENDW(tt) do{ if((tt)+3<NT){WAIT_BAR(2);} else if((tt)+2<NT){WAIT_BAR(1);} else {WAIT_BAR(0);} }while(0)
  for(;t+1<NT;t+=2){
    STEP(pB0,pB1,pA0,pA1,t,(t+3<NT),(t+1<NT),(t+1<NT));       ENDW(t);   RESC(); ROT();
    STEP(pA0,pA1,pB0,pB1,t+1,(t+4<NT),(t+2<NT),(t+2<NT));     ENDW(t+1); RESC(); ROT();
  }
  STEP(pB0,pB1,pA0,pA1,NT-1,false,false,false); RESC();
  { float sacc=pB0[0]+pB0[1]; _Pragma("unroll") for(int r=2;r<16;++r)sacc+=pB0[r]; _Pragma("unroll") for(int r=0;r<16;++r)sacc+=pB1[r]; l_reg+=sacc;
    pw0=(u32x4){PKW(pB0,0),PKW(pB0,2),PKW(pB0,4),PKW(pB0,6)};pw1=(u32x4){PKW(pB0,8),PKW(pB0,10),PKW(pB0,12),PKW(pB0,14)};pw2=(u32x4){PKW(pB1,0),PKW(pB1,2),PKW(pB1,4),PKW(pB1,6)};pw3=(u32x4){PKW(pB1,8),PKW(pB1,10),PKW(pB1,12),PKW(pB1,14)};
    SBAR(); pv(o,vb0+sl_cur,PAF(0),PAF(1),PAF(2),PAF(3)); }
  #undef PKW
  #undef PAF
  #undef VFR
  #undef PIN
  #undef MX3
  #undef GAPA
  #undef GAPB
  #undef EX
  #undef VRD
  #undef KRD
  #undef STEP
  #undef ENDW
  {auto rr=__builtin_amdgcn_permlane32_swap(__float_as_uint(l_reg),__float_as_uint(l_reg),false,false);l_reg=__uint_as_float(rr[0])+__uint_as_float(rr[1]);}
  int lane_e=lane; asm volatile("":"+v"(lane_e));
  const int r32e=lane_e&31,hie=lane_e>>5;
  if(hie==0)wsf[32+r32e]=l_reg;asm volatile("s_waitcnt lgkmcnt(0)":::"memory");
  float rli[16];
  #pragma unroll
  for(int r=0;r<16;++r)rli[r]=__builtin_amdgcn_rcpf(wsf[32+crow(r,hie)]);
  bf16*Ow=O+(rowbase+q0+wid*QBLK)*OM+h*D; const bf16*OGw=OG+(rowbase+q0+wid*QBLK)*DM+h*D;
  { bf16*stg=(bf16*)(shm+LDS_OST)+wid*2048;
    #pragma unroll
    for(int r=0;r<16;++r){const int orow=crow(r,hie);
      #pragma unroll
      for(int d0=0;d0<2;++d0)stg[orow*64+d0*32+r32e]=(bf16)f2bf(o[d0][r]*rli[r]);}
    asm volatile("s_waitcnt lgkmcnt(0)":::"memory");
    #pragma unroll
    for(int i=0;i<4;++i){const int row=i*8+(lane_e>>3),ch=lane_e&7; const u32x4 v=*(const u32x4*)(stg+row*64+ch*8); const u32x4 g=*(const u32x4*)(OGw+(long)row*DM+ch*8); u32x4 w;
      #pragma unroll
      for(int e=0;e<4;++e){ const float lo=bflo(v[e])*sigmoidf_(bflo(g[e])), hh_=bfhi(v[e])*sigmoidf_(bfhi(g[e])); w[e]=pk2(lo,hh_); }
      ATTN_STORE16(Ow+(long)row*OM+ch*8,w);} }
  asm volatile("s_waitcnt lgkmcnt(0)\n\ts_barrier":::"memory");
  #undef QF
  #undef ABF
  #undef SETBM
  #undef BMF
  #undef DMA_K
  #undef DMA_V
  #undef CMASK
  #undef START
  #undef RESC
  #undef ROT
}
constexpr int ATTN_LDS_BYTES=LDS_BYTES;
#undef SBAR
#undef WAIT_BAR
}

constexpr int KP = 144;
__device__ __forceinline__ void p14_attention(Frame& F, const Args& a, int qword = CW_ATTQ) {
    const int tid0 = F.tid, lane0 = F.lane;
    const bf16* QKVG = (const bf16*)(F.ws + WS_QKVG); const float* C2 = (const float*)(F.ws + WS_C2); const float* CB = (const float*)(F.ws + WS_CB);
    bf16* Z2 = (bf16*)(F.ws + WS_Z2);
    LAS unsigned char* Ks = F.lds; LAS unsigned char* Vs = F.lds + 64 * KP; LAS float* bias = (LAS float*)(F.lds + 2 * 64 * KP); LAS int* uslot = (LAS int*)(F.lds + RING_BYTES + 192);
    constexpr int ATT_MAXT = (RING_BYTES - attn_body::ATTN_LDS_BYTES - 16) / 1024;
    float mq = 0.f, mk = 0.f;
    for (int i = 0; i < 64; ++i) { mq = fmaxf(mq, fabsf(a.in[21][i])); mk = fmaxf(mk, fabsf(a.in[22][i])); }
    const float THR2 = (2.f * 8.f * mq * mk * 1.01f + 30.f) * LOG2E;
    gu32* qctr = F.ctl + qword;
    for (;;) {
        __syncthreads();
        if (tid0 == 0) uslot[0] = (int)__hip_atomic_fetch_add(qctr, 1u, RLX_AGENT);
        __syncthreads();
        const int unit = uslot[0];
        if (unit >= NH * (T / 256)) break;
        const int h = unit & 15, qb = (T / 256 - 1) - (unit >> 4), q0 = qb * 256;
        const float ct0 = C2[(size_t)h * T + q0];
        int jstart = 0;
        { int tot = 0; for (int j0 = 0; j0 < 4 * qb; j0 += 64) { const int j = j0 + lane0; const bool skip = (j < 4 * qb) && ((ct0 - CB[h * 256 + j]) < -THR2); tot += __popcll(__ballot(skip)); } jstart = tot; }
        jstart &= ~1;
        if (4 * qb + 4 - jstart <= ATT_MAXT) {
            attn_body::attn_unit<8>(h, qb, jstart, QKVG, QKVG + D, QKVG + 2 * D, QKVG + 3 * D, Z2, C2 + (size_t)h * T, (char*)F.lds);
            continue;
        }
        int tid_s = F.tid; asm volatile("" : "+v"(tid_s));
        const int tid = tid_s, lane = tid & 63, wid = F.wave, r32 = lane & 31, hi = lane >> 5;
        const int jend = 4 * qb + 3;
        const int qrow = q0 + wid * 32 + r32;
        bf16x8 qr[4];
#pragma unroll
        for (int d0 = 0; d0 < 4; ++d0) qr[d0] = *(const bf16x8*)(QKVG + (size_t)qrow * 4096 + h * 64 + d0 * 16 + hi * 8);
        f32x16 o0 = {}, o1 = {}; float m = -INFINITY, l = 0.f;
        const int lrow = tid >> 3, lch = tid & 7;
        u32x4 kreg, vreg; float breg = 0.f;
        auto gload = [&](int j) { const size_t row = (size_t)(64 * j + lrow) * 4096 + h * 64 + lch * 8;
            kreg = *(const u32x4*)(QKVG + row + D); vreg = *(const u32x4*)(QKVG + row + 2 * D); if (tid < 64) breg = -C2[(size_t)h * T + 64 * j + tid]; };
        gload(jstart);
        for (int j = jstart; j <= jend; ++j) {
            __syncthreads();
            *(LAS u32x4*)(Ks + lrow * KP + lch * 16) = kreg;
            { const int s_ = lrow >> 4, x_ = lrow & 15, p_ = s_ * 16 + ((x_ >> 2) & 1) * 8 + (((x_ >> 3) << 2) | (x_ & 3));
                const unsigned w_[4] = {vreg.x, vreg.y, vreg.z, vreg.w};
#pragma unroll
                for (int e = 0; e < 8; ++e) *(LAS unsigned short*)(Vs + (lch * 8 + e) * KP + p_ * 2) = (unsigned short)(w_[e >> 1] >> ((e & 1) * 16)); }
            if (tid < 64) bias[tid] = breg;
            __syncthreads();
            if (j < jend) gload(j + 1);
            f32x16 p0 = {}, p1 = {};
#pragma unroll
            for (int d0 = 0; d0 < 4; ++d0) {
                const bf16x8 k0 = *(const LAS bf16x8*)(Ks + r32 * KP + d0 * 32 + hi * 16);
                const bf16x8 k1 = *(const LAS bf16x8*)(Ks + (32 + r32) * KP + d0 * 32 + hi * 16);
                p0 = __builtin_amdgcn_mfma_f32_32x32x16_bf16(k0, qr[d0], p0, 0, 0, 0);
                p1 = __builtin_amdgcn_mfma_f32_32x32x16_bf16(k1, qr[d0], p1, 0, 0, 0);
            }
#pragma unroll
            for (int g4 = 0; g4 < 4; ++g4) { const f32x4 b0 = *(const LAS f32x4*)(bias + 8 * g4 + 4 * hi), b1 = *(const LAS f32x4*)(bias + 32 + 8 * g4 + 4 * hi);
#pragma unroll
                for (int i = 0; i < 4; ++i) { p0[4 * g4 + i] += b0[i]; p1[4 * g4 + i] += b1[i]; } }
            if (j >= 4 * qb) {
                const int kb = 64 * j;
#pragma unroll
                for (int r = 0; r < 16; ++r) { const int kv = kb + crow(r, hi); if (kv > qrow) p0[r] = -INFINITY; if (kv + 32 > qrow) p1[r] = -INFINITY; }
            }
            float mloc = fmaxf(p0[0], p1[0]);
#pragma unroll
            for (int r = 1; r < 16; ++r) mloc = fmaxf(mloc, fmaxf(p0[r], p1[r]));
            mloc = fmaxf(mloc, __shfl_xor(mloc, 32));
            const float mnew = fmaxf(m, mloc);
            const float alpha = exp2f(m - mnew);
            float ls = 0.f;
#pragma unroll
            for (int r = 0; r < 16; ++r) { p0[r] = exp2f(p0[r] - mnew); p1[r] = exp2f(p1[r] - mnew); ls += p0[r] + p1[r]; }
            l = l * alpha + ls; m = mnew;
#pragma unroll
            for (int r = 0; r < 16; ++r) { o0[r] *= alpha; o1[r] *= alpha; }
#pragma unroll
            for (int s = 0; s < 4; ++s) {
                u32x4 pw;
                if (s == 0) pw = (u32x4){pk2(p0[0], p0[1]), pk2(p0[2], p0[3]), pk2(p0[4], p0[5]), pk2(p0[6], p0[7])};
                else if (s == 1) pw = (u32x4){pk2(p0[8], p0[9]), pk2(p0[10], p0[11]), pk2(p0[12], p0[13]), pk2(p0[14], p0[15])};
                else if (s == 2) pw = (u32x4){pk2(p1[0], p1[1]), pk2(p1[2], p1[3]), pk2(p1[4], p1[5]), pk2(p1[6], p1[7])};
                else pw = (u32x4){pk2(p1[8], p1[9]), pk2(p1[10], p1[11]), pk2(p1[12], p1[13]), pk2(p1[14], p1[15])};
                const bf16x8 pf = __builtin_bit_cast(bf16x8, pw);
                const bf16x8 v0 = *(const LAS bf16x8*)(Vs + r32 * KP + s * 32 + hi * 16);
                const bf16x8 v1 = *(const LAS bf16x8*)(Vs + (32 + r32) * KP + s * 32 + hi * 16);
                o0 = __builtin_amdgcn_mfma_f32_32x32x16_bf16(v0, pf, o0, 0, 0, 0);
                o1 = __builtin_amdgcn_mfma_f32_32x32x16_bf16(v1, pf, o1, 0, 0, 0);
            }
        }
        l += __shfl_xor(l, 32);
        const float rl = 1.f / l;
#pragma unroll
        for (int dt = 0; dt < 2; ++dt)
#pragma unroll
            for (int g4 = 0; g4 < 4; ++g4) { const int d = 32 * dt + 8 * g4 + 4 * hi; const size_t col = (size_t)h * 64 + d;
                const u32x2 ogw = *(const u32x2*)(QKVG + (size_t)qrow * 4096 + 3 * D + col);
                const float og[4] = {bflo(ogw.x), bfhi(ogw.x), bflo(ogw.y), bfhi(ogw.y)}; float ov[4];
#pragma unroll
                for (int i = 0; i < 4; ++i) ov[i] = (dt == 0 ? o0[4 * g4 + i] : o1[4 * g4 + i]) * rl * sigmoidf_(og[i]);
                u32x2 w; w.x = pk2(ov[0], ov[1]); w.y = pk2(ov[2], ov[3]);
                *(u32x2*)(Z2 + (size_t)qrow * D + col) = w; }
    }
}

struct TokInfo { int e0, e1, p0, p1; float g0, g1; int d0, d1; };
__device__ __forceinline__ void p16_router(Frame& F, const Args& a) {
    const int lane = F.lane, tid = F.tid; const float* Hs = (const float*)(F.ws + WS_H); bf16* U = (bf16*)(F.ws + WS_U4);
    TokInfo* TI = (TokInfo*)(F.ws + WS_TOK);
    LAS float* wr_ = (LAS float*)F.lds;
    LAS int* lcnt = (LAS int*)(F.lds + 32768);
    const Row gr = ld_row(a.in[1] + 3 * D, lane);
    __syncthreads();
    for (int i = tid; i < NE * D; i += NTHREADS) { const int e = i & 7, k = i >> 3; wr_[e * D + k] = a.in[26][(size_t)k * NE + e]; }
    for (int tb = F.vcu * 64; tb < T; tb += F.G * 64) {
        __syncthreads();
        if (tid < 16) lcnt[tid] = 0;
        __syncthreads();
        int e0s[8], e1s[8], p0s[8], p1s[8]; float g0s[8];
#pragma unroll
        for (int q = 0; q < 8; ++q) { const int t = tb + F.wave * 8 + q;
            const Row u = rmsnorm_row(ld_row(Hs + (size_t)t * D, lane), gr);
            st_row_bf16(U + (size_t)t * D, lane, u);
            float lg[NE];
#pragma unroll
            for (int e = 0; e < NE; ++e) { float s = 0.f;
#pragma unroll
                for (int j = 0; j < 4; ++j) { const f32x4 w = *(const LAS f32x4*)(wr_ + e * D + 256 * j + 4 * lane); s += (u.v[j][0] * w[0] + u.v[j][1] * w[1]) + (u.v[j][2] * w[2] + u.v[j][3] * w[3]); }
                lg[e] = wave_sum(s); }
            int b0 = 0; float v0 = lg[0];
#pragma unroll
            for (int e = 1; e < NE; ++e) if (lg[e] > v0) { v0 = lg[e]; b0 = e; }
            int b1 = -1; float v1 = -INFINITY;
#pragma unroll
            for (int e = 0; e < NE; ++e) if (e != b0 && lg[e] > v1) { v1 = lg[e]; b1 = e; }
            e0s[q] = b0; e1s[q] = b1; g0s[q] = 1.f / (1.f + __expf(v1 - v0));
            int pa = 0, pb = 0;
            if (lane == 0) { pa = atomicAdd((int*)&lcnt[b0], 1); pb = atomicAdd((int*)&lcnt[b1], 1); }
            p0s[q] = pa; p1s[q] = pb;
        }
        __syncthreads();
        if (tid < NE) lcnt[8 + tid] = (int)__hip_atomic_fetch_add(F.ctl + CW_CNT + 64 * tid, (unsigned)lcnt[tid], RLX_AGENT);
        __syncthreads();
        if (lane == 0) {
#pragma unroll
            for (int q = 0; q < 8; ++q) { const int t = tb + F.wave * 8 + q; TokInfo ti; ti.e0 = e0s[q]; ti.e1 = e1s[q]; ti.p0 = lcnt[8 + e0s[q]] + p0s[q]; ti.p1 = lcnt[8 + e1s[q]] + p1s[q];
                ti.g0 = g0s[q]; ti.g1 = 1.f - g0s[q]; ti.d0 = 0; ti.d1 = 0; TI[t] = ti; }
        }
    }
    __syncthreads();
}
__device__ __forceinline__ int moe_ends(Frame& F, LAS int* ends) {
    __syncthreads();
    if (F.tid == 0) { int run = 0; for (int e = 0; e < NE; ++e) { const int c = (int)__hip_atomic_load(F.ctl + CW_CNT + 64 * e, RLX_AGENT); run += (c + 255) >> 8; ends[e] = run; } }
    __syncthreads();
    return ends[NE - 1];
}
__device__ __forceinline__ void p17_gather(Frame& F) {
    LAS int* ends = (LAS int*)(F.lds + RING_BYTES);
    moe_ends(F, ends);
    const bf16* U = (const bf16*)(F.ws + WS_U4); bf16* AM = (bf16*)(F.ws + WS_AM); TokInfo* TI = (TokInfo*)(F.ws + WS_TOK);
    for (int t = F.gw; t < T; t += F.NGW) {
        const TokInfo ti = TI[t];
        const int d0 = (ti.e0 ? ends[ti.e0 - 1] : 0) * 256 + ti.p0, d1 = (ti.e1 ? ends[ti.e1 - 1] : 0) * 256 + ti.p1;
        const u32x4* src = (const u32x4*)(U + (size_t)t * D) + F.lane; const u32x4 x0 = src[0], x1 = src[64];
        u32x4* o0 = (u32x4*)(AM + (size_t)d0 * D) + F.lane; o0[0] = x0; o0[64] = x1;
        u32x4* o1 = (u32x4*)(AM + (size_t)d1 * D) + F.lane; o1[0] = x0; o1[64] = x1;
        if (F.lane == 0) { TI[t].d0 = d0; TI[t].d1 = d1; }
    }
}
__device__ __forceinline__ void p20_combine(Frame& F, const Args& a) {
    const int lane = F.lane; const float* Hs = (const float*)(F.ws + WS_H); const bf16* YS = (const bf16*)(F.ws + WS_YS); const TokInfo* TI = (const TokInfo*)(F.ws + WS_TOK);
    const Row gr = ld_row(a.in[2], lane);
    for (int t = F.gw; t < T; t += F.NGW) {
        const TokInfo ti = TI[t];
        Row hrow = ld_row(Hs + (size_t)t * D, lane); const Row y0 = ld_row_bf16(YS + (size_t)ti.d0 * D, lane), y1 = ld_row_bf16(YS + (size_t)ti.d1 * D, lane);
#pragma unroll
        for (int j = 0; j < 4; ++j) hrow.v[j] = hrow.v[j] + ti.g0 * y0.v[j] + ti.g1 * y1.v[j];
        st_row(a.out + (size_t)t * D, lane, rmsnorm_row(hrow, gr));
    }
}

constexpr int N_PHASES = 21;
__global__ void __launch_bounds__(NTHREADS, 2) trunk_fwd(Args args) {
    extern __shared__ __attribute__((aligned(16))) unsigned char lds_raw[];
    Frame F;
    F.lds = (LAS unsigned char*)lds_raw; F.ws = args.ws; F.ctl = (gu32*)(args.ws + WS_CTL);
    F.tid = threadIdx.x; F.lane = F.tid & 63; F.wave = __builtin_amdgcn_readfirstlane(F.tid >> 6);
    F.G = gridDim.x; { const int bx = blockIdx.x; F.vcu = (F.G % 8 == 0) ? (bx % 8) * (F.G / 8) + bx / 8 : bx; }
    F.gw = F.vcu * NWAVES + F.wave; F.NGW = F.G * NWAVES;
    volatile LAS unsigned* MISC = (volatile LAS unsigned*)(F.lds + MISC_OFF);
    for (int u = F.tid; u < (LDS_BYTES - RING_BYTES) / 4; u += NTHREADS) ((LAS unsigned*)(F.lds + RING_BYTES))[u] = 0u;
    __syncthreads();
    const int lo = args.ph_lo, hi = args.ph_hi;
    const bool use_bar = (hi - lo) > 1;
    XcdBarrier bar; bar.bar = (unsigned*)(F.ctl + CW_BAR); bar.x = 0; bar.st = nullptr;
    if (use_bar) bar = xcd_barrier_post((unsigned*)(F.ctl + CW_BAR), MISC + 8);
#ifdef ONLY_PHASE
#define IN(k) ((k) == ONLY_PHASE && lo <= (k) && (k) < hi)
#else
#define IN(k) (lo <= (k) && (k) < hi)
#endif
#define SEAM(k) do { if (IN((k) + 1)) xcd_barrier(bar); } while (0)
#define REP(k) for (int rep_ = 0; rep_ < ((DUP_PHASE == (k)) ? 2 : 1); ++rep_, (void)((rep_ < ((DUP_PHASE == (k)) ? 2 : 1)) ? (xcd_barrier(bar), 0) : 0))
    unsigned char* ws = args.ws;
    const int c = (int)blockIdx.x;
    LAS unsigned char* ring = F.lds;

    if (IN(0)) REP(0) { p0_prologue(F, args); p1_shift(F, args); } SEAM(0);
    if (IN(1)) REP(1) {
        { pg8::Gemm g{D, D, D}; pg8::SchedRKV S; S.o.init(T / 256, 12, F.G, c); S.A = (const char*)(ws + WS_XS); S.B = (const char*)(ws + WS_W_RKV); S.astep = (size_t)256 * D * 2; S.bstep = (size_t)256 * D * 2; S.azstride = (size_t)T * D * 2;
          pg8::EpiRKV E{(bf16*)(ws + WS_R), (size_t)(WS_K - WS_R) / 2};
          pg8::gemm_phase<pg8::EpiRKV, pg8::SchedRKV, true>(ring, g, S, E); }
        { pg8::Gemm g{D, 2 * D, 2 * D}; pg8::SchedPlain S; S.o.init(T / 256, 1, F.G, c); S.A = (const char*)(ws + WS_UB); S.B = (const char*)(ws + WS_W_L1); S.astep = (size_t)256 * D * 2; S.bstep = (size_t)256 * 2 * D * 2;
          pg8::EpiL1 E{(bf16*)(ws + WS_L1)};
          pg8::gemm_phase<pg8::EpiL1, pg8::SchedPlain, true>(ring, g, S, E); }
        } SEAM(1);
    if (IN(2)) REP(2) {
        pg8::Gemm g{256, 256, 256}; pg8::SchedPlain S; S.o.init(T / 256, 12, F.G, c); S.A = (const char*)(ws + WS_L1); S.B = (const char*)(ws + WS_W_L2); S.astep = (size_t)256 * 256 * 2; S.bstep = (size_t)256 * 256 * 2;
        pg8::EpiL2 E{(float*)(ws + WS_LW), (bf16*)(ws + WS_AA), (bf16*)(ws + WS_G), args.in[5], args.in[8]};
        pg8::gemm_phase<pg8::EpiL2, pg8::SchedPlain, true>(ring, g, S, E);
        } SEAM(2);
    if (IN(3)) REP(3) { p3_prep(F, args); } SEAM(3);
    if (IN(4)) REP(4) { pa_chunk(F); } SEAM(4);
    if (IN(5)) REP(5) { pb_chain(F); } SEAM(5);
    if (IN(6)) REP(6) { pc_out(F, args); } SEAM(6);
    if (IN(7)) REP(7) {
        pg8::Gemm g{D, D, D}; pg8::SchedPlain S; S.o.init(T / 256, 4, F.G, c); S.A = (const char*)(ws + WS_Z); S.B = (const char*)(ws + WS_W_O0); S.astep = (size_t)256 * D * 2; S.bstep = (size_t)256 * D * 2;
        pg8::EpiRes E{args.in[0], (float*)(ws + WS_H)};
        pg8::gemm_phase<pg8::EpiRes, pg8::SchedPlain, true>(ring, g, S, E);
        } SEAM(7);
    if (IN(8)) REP(8) { p8_norm(F, args.in[1] + D, (bf16*)(ws + WS_U2)); } SEAM(8);
    if (IN(9)) REP(9) {
        pg8::Gemm g{D, D, D}; pg8::SchedPlain S; S.o.init(T / 256, 2 * FF / 256, F.G, c); S.A = (const char*)(ws + WS_U2); S.B = (const char*)(ws + WS_W_GU); S.astep = (size_t)256 * D * 2; S.bstep = (size_t)256 * D * 2;
        pg8::EpiSwiGLU E{(bf16*)(ws + WS_ACT)};
        pg8::gemm_phase<pg8::EpiSwiGLU, pg8::SchedPlain, true>(ring, g, S, E);
        } SEAM(9);
    if (IN(10)) REP(10) {
        pg8::Gemm g{FF, FF, FF}; pg8::SchedPlain S; S.o.init(T / 256, 4, F.G, c); S.A = (const char*)(ws + WS_ACT); S.B = (const char*)(ws + WS_W_DN); S.astep = (size_t)256 * FF * 2; S.bstep = (size_t)256 * FF * 2;
        pg8::EpiRes E{(const float*)(ws + WS_H), rep_ ? (float*)(ws + WS_Y) : (float*)(ws + WS_H)};
        pg8::gemm_phase<pg8::EpiRes, pg8::SchedPlain, true>(ring, g, S, E);
        } SEAM(10);
    if (IN(11)) REP(11) { p11_norm_forget(F, args); } SEAM(11);
    if (IN(12)) REP(12) {
        pg8::Gemm g{D, D, D}; pg8::SchedPlain S; S.o.init(T / 256, 16, F.G, c); S.A = (const char*)(ws + WS_U3); S.B = (const char*)(ws + WS_W_IN); S.astep = (size_t)256 * D * 2; S.bstep = (size_t)256 * D * 2;
        pg8::EpiBf16 E{(bf16*)(ws + WS_QKVG), 4096};
        pg8::gemm_phase<pg8::EpiBf16, pg8::SchedPlain, true>(ring, g, S, E);
        } SEAM(12);
    if (IN(13)) REP(13) { p13_cumsum_qknorm(F, args); } SEAM(13);
    if (IN(14)) REP(14) { p14_attention(F, args, CW_ATTQ + 64 * rep_); } SEAM(14);
    if (IN(15)) REP(15) {
        pg8::Gemm g{D, D, D}; pg8::SchedPlain S; S.o.init(T / 256, 4, F.G, c); S.A = (const char*)(ws + WS_Z2); S.B = (const char*)(ws + WS_W_FO); S.astep = (size_t)256 * D * 2; S.bstep = (size_t)256 * D * 2;
        pg8::EpiRes E{(const float*)(ws + WS_H), rep_ ? (float*)(ws + WS_Y) : (float*)(ws + WS_H)};
        pg8::gemm_phase<pg8::EpiRes, pg8::SchedPlain, true>(ring, g, S, E);
        } SEAM(15);
    if (IN(16)) REP(16) { p16_router(F, args); } SEAM(16);
    if (IN(17)) REP(17) { p17_gather(F); } SEAM(17);
    if (IN(18)) REP(18) {
        LAS int* ends = (LAS int*)(F.lds + RING_BYTES); const int nblk = moe_ends(F, ends);
        pg8::Gemm g{D, D, D}; pg8::SchedMoe S; S.o.init(nblk, 2 * FF / 256, F.G, c); S.A = (const char*)(ws + WS_AM); S.B = (const char*)(ws + WS_W_MGU); S.astep = (size_t)256 * D * 2; S.bstep = (size_t)256 * D * 2; S.bestride = (size_t)2 * FF * D * 2; S.ends = ends;
        pg8::EpiSwiGLU E{(bf16*)(ws + WS_ACT2)};
        pg8::gemm_phase<pg8::EpiSwiGLU, pg8::SchedMoe, true>(ring, g, S, E);
        } SEAM(18);
    if (IN(19)) REP(19) {
        LAS int* ends = (LAS int*)(F.lds + RING_BYTES); const int nblk = moe_ends(F, ends);
        pg8::Gemm g{FF, FF, FF}; pg8::SchedMoe S; S.o.init(nblk, 4, F.G, c); S.A = (const char*)(ws + WS_ACT2); S.B = (const char*)(ws + WS_W_MDN); S.astep = (size_t)256 * FF * 2; S.bstep = (size_t)256 * FF * 2; S.bestride = (size_t)D * FF * 2; S.ends = ends;
        pg8::EpiBf16 E{(bf16*)(ws + WS_YS), D};
        pg8::gemm_phase<pg8::EpiBf16, pg8::SchedMoe, true>(ring, g, S, E);
        } SEAM(19);
    if (IN(20)) REP(20) { p20_combine(F, args); }
#undef IN
#undef SEAM
#undef REP
}

extern "C" void kernel_launch(void* const* d_in, const int* in_sizes, int n_in, void* d_out, int out_size, void* d_ws, size_t ws_size, hipStream_t stream) {
    static int grid = 0;
    if (grid == 0) {
        if (n_in != 29 || out_size != T * D || ws_size < WS_END) { fprintf(stderr, "kernel_launch: unexpected problem (n_in %d out %d ws %zu)\n", n_in, out_size, ws_size); grid = -1; return; }
        int dev = 0, cus = 0;
        if (hipGetDevice(&dev) != hipSuccess || hipDeviceGetAttribute(&cus, hipDeviceAttributeMultiprocessorCount, dev) != hipSuccess) { grid = -1; return; }
        if (hipFuncSetAttribute((const void*)trunk_fwd, hipFuncAttributeMaxDynamicSharedMemorySize, LDS_BYTES) != hipSuccess) { fprintf(stderr, "kernel_launch: hipFuncSetAttribute failed\n"); grid = -1; return; }
        int per_cu = 0;
        if (hipOccupancyMaxActiveBlocksPerMultiprocessor(&per_cu, (const void*)trunk_fwd, NTHREADS, LDS_BYTES) != hipSuccess || per_cu < 1) fprintf(stderr, "kernel_launch: occupancy query says %d\n", per_cu);
        (void)hipGetLastError();
        grid = cus;
    }
    if (grid < 0) return;
    (void)hipMemsetAsync((char*)d_ws + WS_CTL, 0, CTL_ZERO_BYTES, stream);
    Args a{};
    for (int i = 0; i < 29; ++i) a.in[i] = (const float*)d_in[i];
    a.out = (float*)d_out; a.ws = (unsigned char*)d_ws;
    constexpr int NPH = 21;
    if (LAUNCH_MODE == 1) { a.ph_lo = 0; a.ph_hi = NPH; hipLaunchKernelGGL(trunk_fwd, dim3(grid), dim3(NTHREADS), LDS_BYTES, stream, a); }
    else for (int p = 0; p < NPH; ++p) { a.ph_lo = p; a.ph_hi = p + 1; hipLaunchKernelGGL(trunk_fwd, dim3(grid), dim3(NTHREADS), LDS_BYTES, stream, a); }
}
```

```cpp
#include <hip/hip_runtime.h>
#include <cstdio>
#include <cstdint>

#ifndef DUP_PHASE
#define DUP_PHASE -1
#endif
#ifndef GEXP
#define GEXP -1
#endif
#ifndef LAUNCH_MODE
#define LAUNCH_MODE 1
#endif

#define GAS __attribute__((address_space(1)))
#define LAS __attribute__((address_space(3)))
typedef unsigned short bf16;
typedef short bf16x8 __attribute__((ext_vector_type(8)));
typedef float f32x4 __attribute__((ext_vector_type(4)));
typedef float f32x2 __attribute__((ext_vector_type(2)));
typedef float f32x16 __attribute__((ext_vector_type(16)));
typedef unsigned u32x4 __attribute__((ext_vector_type(4)));
typedef unsigned u32x2 __attribute__((ext_vector_type(2)));
typedef GAS unsigned gu32;
#define RLX_AGENT __ATOMIC_RELAXED, __HIP_MEMORY_SCOPE_AGENT

constexpr int T = 16384, D = 1024, NH = 16, HD = 64, FF = 3584, NE = 8, WIN_LD = 4 * D + NH;
constexpr int NWAVES = 8, NTHREADS = 512;
constexpr float RMS_EPS = 1e-6f, GN_EPS = 64e-5f;
constexpr int MOE_ROWS = (2 * T / 256 + NE) * 256;
constexpr float LOG2E = 1.4426950408889634f;

constexpr size_t MiB = 1u << 20;
constexpr size_t WS_CTL = 0, CTL_ZERO_BYTES = 1 * MiB;
constexpr size_t WS_W_RKV = 2 * MiB, WS_W_L1 = 8 * MiB, WS_W_L2 = 9 * MiB, WS_W_O0 = 11 * MiB, WS_W_GU = 13 * MiB, WS_W_DN = 27 * MiB,
                 WS_W_IN = 34 * MiB, WS_W_FO = 42 * MiB, WS_W_MGU = 44 * MiB, WS_W_MDN = 156 * MiB;
constexpr size_t WS_H = 216 * MiB;
constexpr size_t WS_UB = 280 * MiB, WS_XS = 313 * MiB;
constexpr size_t WS_KK = 280 * MiB, WS_BB = 344 * MiB;
constexpr size_t WS_Z = 410 * MiB  , WS_U2 = 344 * MiB;
constexpr size_t WS_U3 = 280 * MiB, WS_Z2 = 312 * MiB, WS_U4 = 280 * MiB, WS_AM = 312 * MiB;
constexpr size_t WS_R = 410 * MiB, WS_K = 474 * MiB, WS_V = 538 * MiB;
constexpr size_t WS_ACT = 410 * MiB;
constexpr size_t WS_QKVG = 410 * MiB;
constexpr size_t WS_ACT2 = 410 * MiB;
constexpr size_t WS_LW = 602 * MiB, WS_AA = 666 * MiB, WS_G = 730 * MiB;
constexpr size_t WS_YT = 666 * MiB;
constexpr size_t WS_YS = 666 * MiB;
constexpr size_t WS_L1 = 794 * MiB;
constexpr size_t WS_CS = 802 * MiB;
constexpr size_t WS_LF = 806 * MiB, WS_C2 = 807 * MiB, WS_CB = 808 * MiB, WS_TOK = 809 * MiB;
constexpr size_t WS_END = 810 * MiB;
constexpr size_t WS_AT = 280 * MiB, WS_RT = 312 * MiB, WS_BH = 344 * MiB, WS_KH = 376 * MiB;
constexpr size_t WS_V16 = 538 * MiB  , WS_GC = 248 * MiB;
constexpr size_t WS_QM = 410 * MiB, WS_PLR = 474 * MiB, WS_TM = 506 * MiB, WS_S0 = 570 * MiB;
constexpr size_t WS_Y = 602 * MiB;
constexpr int NCH = T / 64;
constexpr int CW_TMO = 0, CW_BAR = 4096, CW_CNT = 8192, CW_ATTQ = 9216;

constexpr int RING_BYTES = 131072, MISC_OFF = RING_BYTES + 320, LDS_BYTES = 147456;

__device__ __forceinline__ unsigned f2bf(float f) { unsigned u = __builtin_bit_cast(unsigned, f); return (u + 0x7fffu + ((u >> 16) & 1u)) >> 16; }
__device__ __forceinline__ unsigned pk2(float lo, float hi) { return f2bf(lo) | (f2bf(hi) << 16); }
__device__ __forceinline__ float bf2f(unsigned short b) { return __builtin_bit_cast(float, (unsigned)b << 16); }
__device__ __forceinline__ float bflo(unsigned w) { return __builtin_bit_cast(float, w << 16); }
__device__ __forceinline__ float bfhi(unsigned w) { return __builtin_bit_cast(float, w & 0xffff0000u); }
template <int CTRL> __device__ __forceinline__ float dpp_mov(float x) {
    return __builtin_bit_cast(float, __builtin_amdgcn_mov_dpp(__builtin_bit_cast(int, x), CTRL, 0xf, 0xf, true)); }
__device__ __forceinline__ float row16_sum(float v) {
    v += dpp_mov<0xB1>(v); v += dpp_mov<0x4E>(v); v += dpp_mov<0x124>(v); v += dpp_mov<0x128>(v); return v; }
__device__ __forceinline__ float wave_sum(float v) {
    v = row16_sum(v); v += __shfl_xor(v, 16); v += __shfl_xor(v, 32); return v; }
__device__ __forceinline__ float sigmoidf_(float x) { return __builtin_amdgcn_rcpf(1.f + __builtin_amdgcn_exp2f(x * -1.4426950408889634f)); }
__device__ __forceinline__ float tanhf_(float x) { const float e = __builtin_amdgcn_exp2f(fminf(x * 2.8853900817779268f, 60.f)); return (e - 1.f) * __builtin_amdgcn_rcpf(e + 1.f); }
#define LDS_WAIT() asm volatile("s_waitcnt lgkmcnt(0)" ::: "memory")
__device__ __forceinline__ int crow(int r, int hi) { return (r & 3) + 8 * (r >> 2) + 4 * hi; }

namespace pg8 {
constexpr int BM = 256, BK = 64, HALF = 128, HTB = HALF * BK * 2, STAGE_BYTES = 8 * HTB, NXCD = 8, WGM = 8;
__host__ __device__ __forceinline__ int lds_byte(int r, int c) { const int st = (r >> 4) * 2 + (c >> 5), rr = r & 15, cc = c & 31, ob = rr * 64 + cc * 2; return st * 1024 + (ob ^ (((ob >> 9) & 1) << 5)); }
__host__ __device__ __forceinline__ void stage_rc(int b, int& R, int& C) { const int st = b / 1024, sb = b % 1024, swz = sb ^ (((sb >> 9) & 1) << 5); R = (st >> 1) * 16 + swz / 64; C = (st & 1) * 32 + (swz % 64) / 2; }
__host__ __device__ __forceinline__ int perm32(int rho) { const int n = rho >> 4, i = rho & 15; return 8 * (i >> 2) + 4 * n + (i & 3); }

struct Unit { int pm, pn; };
struct Gemm { int lda, ldb, K; };

struct TileOrder {
    int nM, nN, nwg, G, c;
    __device__ __forceinline__ void init(int nM_, int nN_, int G_, int c_) { nM = nM_; nN = nN_; nwg = nM * nN; G = G_; c = c_; }
    __device__ __forceinline__ bool tile(int i, Unit& u) const {
        const long L = (long)i * G + c; if (L >= nwg) return false;
        int wgid = (int)L; { const int q = nwg / NXCD, r = nwg % NXCD, xcd = wgid % NXCD, off = wgid / NXCD; wgid = (xcd < r ? xcd * (q + 1) : r * (q + 1) + (xcd - r) * q) + off; }
        const int nig = WGM * nN, gid = wgid / nig, fm = gid * WGM, gsz = (nM - fm) < WGM ? (nM - fm) : WGM;
        u.pm = fm + ((wgid % nig) % gsz); u.pn = (wgid % nig) / gsz; return true;
    }
};

__device__ __forceinline__ unsigned cvt_pk_bf16(float lo, float hi) { unsigned r; asm volatile("v_cvt_pk_bf16_f32 %0, %1, %2" : "=v"(r) : "v"(lo), "v"(hi)); return r; }

template <class Epi, class Sched, bool ALIGN_EPI>
__device__ __forceinline__ void gemm_phase(LAS unsigned char* lds, const Gemm g, const Sched& S, const Epi& E) {
    const int tid = threadIdx.x, wid = __builtin_amdgcn_readfirstlane(tid >> 6), lane = tid & 63, wr = wid >> 2, wc = wid & 3, fr = lane & 15, fq = lane >> 4;
    const int K = g.K, nt = K / BK;
    unsigned voffA[2], voffB[2];
#pragma unroll
    for (int i = 0; i < 2; ++i) { int R, C; stage_rc(tid * 16 + i * 8192, R, C); const int Rb = Epi::PERM ? ((R & ~31) + perm32(R & 31)) : R;
        voffA[i] = (unsigned)(R * g.lda + C) * 2u; voffB[i] = (unsigned)(Rb * g.ldb + C) * 2u; }
    const size_t kstep = (size_t)(BK * 2);
    const size_t hstepA = (size_t)HALF * g.lda * 2, hstepB = (size_t)HALF * g.ldb * 2;
    const unsigned ldsw = (unsigned)wid * 1024u;
    const int aoff = lds_byte(wr * 64 + fr, fq * 8), boff = lds_byte(wc * 32 + fr, fq * 8);
#define PG8_SA(b, h) (((b) * 2 + (h)) * HTB)
#define PG8_SB(b, h) ((4 + (b) * 2 + (h)) * HTB)
#define PG8_STAGE(bufoff, gbase, voff) do { _Pragma("unroll") for (int _i = 0; _i < 2; ++_i) \
        __builtin_amdgcn_global_load_lds((const unsigned*)((const char*)(gbase) + (voff)[_i]), (LAS unsigned*)(lds + (bufoff) + ldsw + _i * 8192), 16, 0, 0); } while (0)
#define PG8_LDA(dst, b, h) do { _Pragma("unroll") for (int m = 0; m < 4; ++m) _Pragma("unroll") for (int k = 0; k < 2; ++k) dst[m][k] = *(const LAS bf16x8*)(lds + PG8_SA(b, h) + aoff + m * 2048 + k * 1024); } while (0)
#define PG8_LDB(dst, b, h) do { _Pragma("unroll") for (int n = 0; n < 2; ++n) _Pragma("unroll") for (int k = 0; k < 2; ++k) dst[n][k] = *(const LAS bf16x8*)(lds + PG8_SB(b, h) + boff + n * 2048 + k * 1024); } while (0)
#define PG8_MMA(ai, bj, At, Bt) do { __builtin_amdgcn_s_setprio(1); _Pragma("unroll") for (int m = 0; m < 4; ++m) _Pragma("unroll") for (int n = 0; n < 2; ++n) _Pragma("unroll") for (int k = 0; k < 2; ++k) \
        acc[ai][bj][m][n] = __builtin_amdgcn_mfma_f32_16x16x32_bf16(Bt[n][k], At[m][k], acc[ai][bj][m][n], 0, 0, 0); __builtin_amdgcn_s_setprio(0); } while (0)
#define PG8_WAIT_V(n) asm volatile("s_waitcnt vmcnt(" #n ")" ::: "memory")
#define PG8_WAIT_L(n) asm volatile("s_waitcnt lgkmcnt(" #n ")" ::: "memory")
#define PG8_BAR __builtin_amdgcn_s_barrier()
#define PG8_SCHED __builtin_amdgcn_sched_barrier(0)
    Unit cur, nxt; int ui = 0;
    if (!S.next(0, cur)) return;
    f32x4 acc[2][2][4][2];
#pragma unroll
    for (int a = 0; a < 2; ++a)
#pragma unroll
        for (int b = 0; b < 2; ++b)
#pragma unroll
            for (int m = 0; m < 4; ++m)
#pragma unroll
                for (int n = 0; n < 2; ++n) acc[a][b][m][n] = (f32x4){0.f, 0.f, 0.f, 0.f};
    bf16x8 At[4][2], B0[2][2], B1[2][2];
    const char* cA = S.pa(cur); const char* cB = S.pb(cur);
    PG8_STAGE(PG8_SB(0, 0), cB, voffB); PG8_STAGE(PG8_SB(0, 1), cB + hstepB, voffB); PG8_STAGE(PG8_SA(0, 0), cA, voffA); PG8_STAGE(PG8_SA(0, 1), cA + hstepA, voffA);
    if (wr == 1) PG8_BAR;
    PG8_WAIT_V(2); PG8_BAR;
    PG8_STAGE(PG8_SB(1, 0), cB + kstep, voffB); PG8_STAGE(PG8_SA(1, 0), cA + kstep, voffA); PG8_STAGE(PG8_SB(1, 1), cB + hstepB + kstep, voffB);
    PG8_WAIT_V(6); PG8_BAR;
    for (;;) {
        const bool has_next = S.next(ui + 1, nxt);
        const char* nA = has_next ? S.pa(nxt) : cA; const char* nB = has_next ? S.pb(nxt) : cB;
#pragma clang loop unroll(disable)
        for (int t = 0; t < nt; t += 2) {
            const bool last = (t == nt - 2);
            const char* a1 = cA + (size_t)(t + 1) * kstep;
            const char* a2 = last ? nA : cA + (size_t)(t + 2) * kstep; const char* b2 = last ? nB : cB + (size_t)(t + 2) * kstep;
            const char* a3 = a2 + kstep; const char* b3 = b2 + kstep;
            PG8_LDB(B0, 0, 0); PG8_LDB(B1, 0, 1); PG8_SCHED; PG8_LDA(At, 0, 0); PG8_STAGE(PG8_SA(1, 1), a1 + hstepA, voffA);
            PG8_WAIT_V(8); PG8_WAIT_L(0); PG8_BAR; PG8_MMA(0, 0, At, B0); PG8_MMA(0, 1, At, B1); PG8_BAR; PG8_SCHED;
            PG8_LDA(At, 0, 1); PG8_STAGE(PG8_SB(0, 0), b2, voffB); PG8_STAGE(PG8_SB(0, 1), b2 + hstepB, voffB); PG8_STAGE(PG8_SA(0, 0), a2, voffA);
            PG8_WAIT_V(8); PG8_WAIT_L(0); PG8_BAR; PG8_MMA(1, 0, At, B0); PG8_MMA(1, 1, At, B1); PG8_BAR; PG8_SCHED;
            PG8_LDB(B0, 1, 0); PG8_LDB(B1, 1, 1); PG8_SCHED; PG8_LDA(At, 1, 0); PG8_STAGE(PG8_SA(0, 1), a2 + hstepA, voffA);
            PG8_WAIT_V(8); PG8_WAIT_L(0); PG8_BAR; PG8_MMA(0, 0, At, B0); PG8_MMA(0, 1, At, B1); PG8_BAR; PG8_SCHED;
            PG8_LDA(At, 1, 1); PG8_STAGE(PG8_SB(1, 0), b3, voffB); PG8_STAGE(PG8_SB(1, 1), b3 + hstepB, voffB); PG8_STAGE(PG8_SA(1, 0), a3, voffA);
            PG8_WAIT_V(8); PG8_WAIT_L(0); PG8_BAR; PG8_MMA(1, 0, At, B0); PG8_MMA(1, 1, At, B1); PG8_BAR; PG8_SCHED;
        }
        if constexpr (ALIGN_EPI) { if (wr == 0) PG8_BAR; }
        E(acc, cur, wr, wc, fr, fq);
        if (!has_next) break;
#pragma unroll
        for (int a = 0; a < 2; ++a)
#pragma unroll
            for (int b = 0; b < 2; ++b)
#pragma unroll
                for (int m = 0; m < 4; ++m)
#pragma unroll
                    for (int n = 0; n < 2; ++n) acc[a][b][m][n] = (f32x4){0.f, 0.f, 0.f, 0.f};
        cur = nxt; cA = nA; cB = nB; ++ui;
        if constexpr (ALIGN_EPI) { if (wr == 1) PG8_BAR; }
    }
    PG8_WAIT_V(0);
    if constexpr (!ALIGN_EPI) { if (wr == 0) PG8_BAR; }
    PG8_BAR;
#undef PG8_SA
#undef PG8_SB
#undef PG8_STAGE
#undef PG8_LDA
#undef PG8_LDB
#undef PG8_MMA
#undef PG8_WAIT_V
#undef PG8_WAIT_L
#undef PG8_BAR
#undef PG8_SCHED
}

typedef const f32x4 (&AccRef)[2][2][4][2];

struct SchedPlain {
    TileOrder o; const char* A; const char* B; size_t astep, bstep;
    __device__ __forceinline__ bool next(int i, Unit& u) const { return o.tile(i, u); }
    __device__ __forceinline__ const char* pa(const Unit& u) const { return A + (size_t)u.pm * astep; }
    __device__ __forceinline__ const char* pb(const Unit& u) const { return B + (size_t)u.pn * bstep; }
};
struct SchedRKV {
    TileOrder o; const char* A; const char* B; size_t astep, bstep, azstride;
    __device__ __forceinline__ bool next(int i, Unit& u) const { return o.tile(i, u); }
    __device__ __forceinline__ const char* pa(const Unit& u) const { return A + (size_t)(u.pn >> 2) * azstride + (size_t)u.pm * astep; }
    __device__ __forceinline__ const char* pb(const Unit& u) const { return B + (size_t)u.pn * bstep; }
};
struct SchedMoe {
    TileOrder o; const char* A; const char* B; size_t astep, bstep, bestride; const LAS int* ends;
    __device__ __forceinline__ bool next(int i, Unit& u) const { return o.tile(i, u); }
    __device__ __forceinline__ int be(int pm) const { int e = 0;
#pragma unroll
        for (int j = 0; j < NE - 1; ++j) e += (pm >= ends[j]) ? 1 : 0; return e; }
    __device__ __forceinline__ const char* pa(const Unit& u) const { return A + (size_t)u.pm * astep; }
    __device__ __forceinline__ const char* pb(const Unit& u) const { return B + (size_t)be(u.pm) * bestride + (size_t)u.pn * bstep; }
};

struct EpiRKV {
    static constexpr bool PERM = true;
    bf16* C; size_t zstride;
    __device__ __forceinline__ void operator()(AccRef acc, const Unit& u, int wr, int wc, int fr, int fq) const {
        const int z = u.pn >> 2, pn = u.pn & 3; bf16* base = C + (size_t)z * zstride;
        const int row0 = u.pm * BM + wr * 64 + fr, col0 = pn * BM + wc * 32 + 8 * fq;
#pragma unroll
        for (int ai = 0; ai < 2; ++ai)
#pragma unroll
            for (int m = 0; m < 4; ++m) { bf16* rowp = base + (size_t)(row0 + ai * HALF + m * 16) * D + col0;
#pragma unroll
                for (int bj = 0; bj < 2; ++bj) { const f32x4 v0 = acc[ai][bj][m][0], v1 = acc[ai][bj][m][1];
                    u32x4 w; w.x = cvt_pk_bf16(v0[0], v0[1]); w.y = cvt_pk_bf16(v0[2], v0[3]); w.z = cvt_pk_bf16(v1[0], v1[1]); w.w = cvt_pk_bf16(v1[2], v1[3]);
                    *(u32x4*)(rowp + bj * HALF) = w; } }
    }
};
struct EpiRes {
    static constexpr bool PERM = false;
    const float* base; float* out;
    __device__ __forceinline__ void operator()(AccRef acc, const Unit& u, int wr, int wc, int fr, int fq) const {
        const int row0 = u.pm * BM + wr * 64 + fr, col0 = u.pn * BM + wc * 32 + 4 * fq;
#pragma unroll
        for (int ai = 0; ai < 2; ++ai)
#pragma unroll
            for (int m = 0; m < 4; ++m) { const size_t off = (size_t)(row0 + ai * HALF + m * 16) * D + col0;
#pragma unroll
                for (int bj = 0; bj < 2; ++bj)
#pragma unroll
                    for (int n = 0; n < 2; ++n) { const f32x4 b = *(const f32x4*)(base + off + bj * HALF + n * 16); *(f32x4*)(out + off + bj * HALF + n * 16) = b + acc[ai][bj][m][n]; } }
    }
};
struct EpiL1 {
    static constexpr bool PERM = true;
    bf16* O;
    __device__ __forceinline__ void operator()(AccRef acc, const Unit& u, int wr, int wc, int fr, int fq) const {
        const int row0 = u.pm * BM + wr * 64 + fr, col0 = wc * 32 + 8 * fq;
#pragma unroll
        for (int ai = 0; ai < 2; ++ai)
#pragma unroll
            for (int m = 0; m < 4; ++m) { bf16* rowp = O + (size_t)(row0 + ai * HALF + m * 16) * 256 + col0;
#pragma unroll
                for (int bj = 0; bj < 2; ++bj) { float v[8];
#pragma unroll
                    for (int i = 0; i < 4; ++i) { v[i] = acc[ai][bj][m][0][i]; v[4 + i] = acc[ai][bj][m][1][i]; }
#pragma unroll
                    for (int i = 0; i < 8; ++i) { if (bj == 1) v[i] = sigmoidf_(v[i]); else if (wc < 2) v[i] = tanhf_(v[i]); }
                    u32x4 w; w.x = cvt_pk_bf16(v[0], v[1]); w.y = cvt_pk_bf16(v[2], v[3]); w.z = cvt_pk_bf16(v[4], v[5]); w.w = cvt_pk_bf16(v[6], v[7]);
                    *(u32x4*)(rowp + bj * HALF) = w; } }
    }
};
struct EpiL2 {
    static constexpr bool PERM = true;
    float* LW; bf16* AA; bf16* G; const float* w0; const float* a0;
    __device__ __forceinline__ void operator()(AccRef acc, const Unit& u, int wr, int wc, int fr, int fq) const {
        const int z = u.pn >> 2, pn = u.pn & 3;
        const int row0 = u.pm * BM + wr * 64 + fr, col0 = pn * BM + wc * 32 + 8 * fq;
        if (z == 0) {
#pragma unroll
            for (int bj = 0; bj < 2; ++bj) { const f32x4 b0 = *(const f32x4*)(w0 + col0 + bj * HALF), b1 = *(const f32x4*)(w0 + col0 + bj * HALF + 4);
#pragma unroll
                for (int ai = 0; ai < 2; ++ai)
#pragma unroll
                    for (int m = 0; m < 4; ++m) { f32x4 v0 = acc[ai][bj][m][0] + b0, v1 = acc[ai][bj][m][1] + b1;
#pragma unroll
                        for (int i = 0; i < 4; ++i) { v0[i] = -0.6065306597126334f * sigmoidf_(v0[i]); v1[i] = -0.6065306597126334f * sigmoidf_(v1[i]); }
                        float* p = LW + (size_t)(row0 + ai * HALF + m * 16) * D + col0 + bj * HALF; *(f32x4*)p = v0; *(f32x4*)(p + 4) = v1; } }
        } else {
            bf16* base = z == 1 ? AA : G;
#pragma unroll
            for (int bj = 0; bj < 2; ++bj) { f32x4 b0 = {0.f, 0.f, 0.f, 0.f}, b1 = b0; if (z == 1) { b0 = *(const f32x4*)(a0 + col0 + bj * HALF); b1 = *(const f32x4*)(a0 + col0 + bj * HALF + 4); }
#pragma unroll
                for (int ai = 0; ai < 2; ++ai)
#pragma unroll
                    for (int m = 0; m < 4; ++m) { f32x4 v0 = acc[ai][bj][m][0] + b0, v1 = acc[ai][bj][m][1] + b1;
                        if (z == 1) {
#pragma unroll
                            for (int i = 0; i < 4; ++i) { v0[i] = sigmoidf_(v0[i]); v1[i] = sigmoidf_(v1[i]); } }
                        u32x4 w; w.x = cvt_pk_bf16(v0[0], v0[1]); w.y = cvt_pk_bf16(v0[2], v0[3]); w.z = cvt_pk_bf16(v1[0], v1[1]); w.w = cvt_pk_bf16(v1[2], v1[3]);
                        *(u32x4*)(base + (size_t)(row0 + ai * HALF + m * 16) * D + col0 + bj * HALF) = w; } }
        }
    }
};
struct EpiSwiGLU {
    static constexpr bool PERM = true;
    bf16* O;
    __device__ __forceinline__ void operator()(AccRef acc, const Unit& u, int wr, int wc, int fr, int fq) const {
        const int row0 = u.pm * BM + wr * 64 + fr, col0 = u.pn * HALF + wc * 32 + 8 * fq;
#pragma unroll
        for (int ai = 0; ai < 2; ++ai)
#pragma unroll
            for (int m = 0; m < 4; ++m) { float v[8];
#pragma unroll
                for (int n = 0; n < 2; ++n)
#pragma unroll
                    for (int i = 0; i < 4; ++i) { const float gt = acc[ai][0][m][n][i], up = acc[ai][1][m][n][i];
                        v[4 * n + i] = gt * up * __builtin_amdgcn_rcpf(1.f + __builtin_amdgcn_exp2f(gt * -1.4426950408889634f)); }
                u32x4 w; w.x = cvt_pk_bf16(v[0], v[1]); w.y = cvt_pk_bf16(v[2], v[3]); w.z = cvt_pk_bf16(v[4], v[5]); w.w = cvt_pk_bf16(v[6], v[7]);
                *(u32x4*)(O + (size_t)(row0 + ai * HALF + m * 16) * FF + col0) = w; }
    }
};
struct EpiBf16 {
    static constexpr bool PERM = true;
    bf16* O; int ldc;
    __device__ __forceinline__ void operator()(AccRef acc, const Unit& u, int wr, int wc, int fr, int fq) const {
        const int row0 = u.pm * BM + wr * 64 + fr, col0 = u.pn * BM + wc * 32 + 8 * fq;
#pragma unroll
        for (int ai = 0; ai < 2; ++ai)
#pragma unroll
            for (int m = 0; m < 4; ++m) { bf16* rowp = O + (size_t)(row0 + ai * HALF + m * 16) * ldc + col0;
#pragma unroll
                for (int bj = 0; bj < 2; ++bj) { const f32x4 v0 = acc[ai][bj][m][0], v1 = acc[ai][bj][m][1];
                    u32x4 w; w.x = cvt_pk_bf16(v0[0], v0[1]); w.y = cvt_pk_bf16(v0[2], v0[3]); w.z = cvt_pk_bf16(v1[0], v1[1]); w.w = cvt_pk_bf16(v1[2], v1[3]);
                    *(u32x4*)(rowp + bj * HALF) = w; } }
    }
};
struct SchedExp {
    TileOrder o; const char* A; const char* B; size_t astep, bstep; int mode;
    __device__ __forceinline__ bool next(int i, Unit& u) const { return o.tile(i, u); }
    __device__ __forceinline__ const char* pa(const Unit& u) const { return A + (size_t)(mode == 3 ? (u.pm & 7) : u.pm) * astep; }
    __device__ __forceinline__ const char* pb(const Unit& u) const { return B + (size_t)(mode == 1 ? 0 : u.pn) * bstep; }
};
struct EpiExpStore { static constexpr bool PERM = true; bf16* O;
    __device__ __forceinline__ void operator()(AccRef acc, const Unit& u, int wr, int wc, int fr, int fq) const {
        const int row0 = u.pm * BM + wr * 64 + fr, col0 = u.pn * HALF + wc * 32 + 8 * fq;
#pragma unroll
        for (int ai = 0; ai < 2; ++ai)
#pragma unroll
            for (int m = 0; m < 4; ++m) { const f32x4 v0 = acc[ai][0][m][0] + acc[ai][1][m][0], v1 = acc[ai][0][m][1] + acc[ai][1][m][1];
                u32x4 w; w.x = cvt_pk_bf16(v0[0], v0[1]); w.y = cvt_pk_bf16(v0[2], v0[3]); w.z = cvt_pk_bf16(v1[0], v1[1]); w.w = cvt_pk_bf16(v1[2], v1[3]);
                *(u32x4*)(O + (size_t)(row0 + ai * HALF + m * 16) * FF + col0) = w; }
    } };
struct EpiExpMath { static constexpr bool PERM = true; bf16* O;
    __device__ __forceinline__ void operator()(AccRef acc, const Unit& u, int wr, int wc, int fr, int fq) const {
        float sacc = 0.f;
#pragma unroll
        for (int ai = 0; ai < 2; ++ai)
#pragma unroll
            for (int m = 0; m < 4; ++m)
#pragma unroll
                for (int n = 0; n < 2; ++n)
#pragma unroll
                    for (int i = 0; i < 4; ++i) { const float gt = acc[ai][0][m][n][i], up = acc[ai][1][m][n][i]; sacc += gt * sigmoidf_(gt) * up; }
        if (sacc == 123.456f) O[0] = 1;
    } };
struct EpiNone { static constexpr bool PERM = true; bf16* O;
    __device__ __forceinline__ void operator()(AccRef acc, const Unit& u, int wr, int wc, int fr, int fq) const {
        float sacc = 0.f;
#pragma unroll
        for (int ai = 0; ai < 2; ++ai)
#pragma unroll
            for (int m = 0; m < 4; ++m)
#pragma unroll
                for (int bj = 0; bj < 2; ++bj)
#pragma unroll
                    for (int n = 0; n < 2; ++n) sacc += (acc[ai][bj][m][n][0] + acc[ai][bj][m][n][1]) + (acc[ai][bj][m][n][2] + acc[ai][bj][m][n][3]);
        if (sacc == 123.456f) O[0] = 1;
    } };
}

#define XB_TMO      128
#define XB_XCNT(j)  (256  + 64 * (j))
#define XB_XSUB(j)  (1280 + 64 * (j))
#define XB_XGEN(j)  (2304 + 64 * (j))
#define XB_TOP      3328
#define XB_TOPGEN   3392
#define XCD_BAR_WORDS 3456
#define XB_SPIN_CAP (1u << 18)
__device__ __forceinline__ unsigned xb_ld(unsigned* p)              { return __hip_atomic_load(p, __ATOMIC_RELAXED, __HIP_MEMORY_SCOPE_AGENT); }
__device__ __forceinline__ unsigned xb_add(unsigned* p, unsigned v) { return __hip_atomic_fetch_add(p, v, __ATOMIC_RELAXED, __HIP_MEMORY_SCOPE_AGENT); }
__device__ __forceinline__ unsigned xb_xcc_id() { return (unsigned)__builtin_amdgcn_s_getreg((3 << 11) | 20) & 0xFu; }
#define XB_SPIN(cond, bar) do { unsigned _sp = 0; while (cond) { __builtin_amdgcn_s_sleep(1); \
    if ((++_sp & 255u) == 0u) { if (xb_ld(&(bar)[XB_TMO])) break; if (_sp > XB_SPIN_CAP) { atomicAdd(&(bar)[XB_TMO], 1u); break; } } } } while (0)
struct XcdBarrier { unsigned* bar; unsigned x; volatile LAS unsigned* st; };
__device__ __forceinline__ XcdBarrier xcd_barrier_post(unsigned* bar, volatile LAS unsigned* st) {
    XcdBarrier b; b.bar = bar; b.x = xb_xcc_id(); b.st = st;
    if (threadIdx.x == 0) (void)xb_add(&bar[XB_XCNT(b.x)], 1u);
    return b;
}
__device__ __forceinline__ void xcd_barrier_complete(unsigned* bar, unsigned x, unsigned& nloc, unsigned& nx) {
    const unsigned G = gridDim.x * gridDim.y * gridDim.z;
    unsigned sum, cnt, mine, sp = 0u;
    for (;;) {
        sum = 0u; cnt = 0u; mine = 0u;
#pragma unroll
        for (unsigned j = 0; j < 16; ++j) { const unsigned c = xb_ld(&bar[XB_XCNT(j)]); sum += c; cnt += (c > 0u) ? 1u : 0u; mine = (j == x) ? c : mine; }
        if (sum == G) break;
        __builtin_amdgcn_s_sleep(1);
        if ((++sp & 255u) == 0u) { if (xb_ld(&bar[XB_TMO])) break; if (sp > XB_SPIN_CAP) { atomicAdd(&bar[XB_TMO], 1u); break; } }
    }
    nloc = mine > 0u ? mine : 1u; nx = cnt > 0u ? cnt : 1u;
}
__device__ __forceinline__ void xcd_barrier(const XcdBarrier& b) {
    asm volatile("s_waitcnt vmcnt(0)" ::: "memory");
    __syncthreads();
    if (threadIdx.x == 0) {
        unsigned* bar = b.bar;
        __builtin_amdgcn_s_waitcnt(0);
        unsigned nloc = b.st[0], nx = b.st[1];
        if (nloc == 0u) { xcd_barrier_complete(bar, b.x, nloc, nx); b.st[0] = nloc; b.st[1] = nx; }
        const unsigned old = xb_add(&bar[XB_XSUB(b.x)], 1u);
        const unsigned gen = old / nloc;
        if (old + 1u == (gen + 1u) * nloc) {
            __builtin_amdgcn_fence(__ATOMIC_RELEASE, "agent");
            asm volatile("s_waitcnt vmcnt(0)" ::: "memory");
            const unsigned og = xb_add(&bar[XB_TOP], 1u);
            const unsigned tg = og / nx;
            if (og + 1u == (tg + 1u) * nx) xb_add(&bar[XB_TOPGEN], 1u);
            else XB_SPIN(xb_ld(&bar[XB_TOPGEN]) == tg, bar);
            __builtin_amdgcn_fence(__ATOMIC_ACQUIRE, "agent");
            xb_add(&bar[XB_XGEN(b.x)], 1u);
            asm volatile("s_waitcnt vmcnt(0)" ::: "memory");
        } else {
            XB_SPIN(xb_ld(&bar[XB_XGEN(b.x)]) == gen, bar);
            __builtin_amdgcn_fence(__ATOMIC_ACQUIRE, "agent");
            asm volatile("s_waitcnt vmcnt(0)" ::: "memory");
        }
    }
    __syncthreads();
}

struct Args { const float* in[29]; float* out; unsigned char* ws; int ph_lo, ph_hi; };
struct Frame {
    LAS unsigned char* lds; gu32* ctl; unsigned char* ws;
    int tid, lane, wave, vcu, G, gw, NGW;
};

struct Row { f32x4 v[4]; };
__device__ __forceinline__ Row ld_row(const float* p, int lane) { Row r; const f32x4* q = (const f32x4*)p + lane;
#pragma unroll
    for (int j = 0; j < 4; ++j) r.v[j] = q[64 * j]; return r; }
__device__ __forceinline__ void st_row(float* p, int lane, const Row& r) { f32x4* q = (f32x4*)p + lane;
#pragma unroll
    for (int j = 0; j < 4; ++j) q[64 * j] = r.v[j]; }
__device__ __forceinline__ void st_row_bf16(bf16* p, int lane, const Row& r) { u32x2* q = (u32x2*)p + lane;
#pragma unroll
    for (int j = 0; j < 4; ++j) { u32x2 w; w.x = pk2(r.v[j][0], r.v[j][1]); w.y = pk2(r.v[j][2], r.v[j][3]); q[64 * j] = w; } }
__device__ __forceinline__ Row ld_row_bf16(const bf16* p, int lane) { Row r; const u32x2* q = (const u32x2*)p + lane;
#pragma unroll
    for (int j = 0; j < 4; ++j) { const u32x2 w = q[64 * j]; r.v[j] = (f32x4){bflo(w.x), bfhi(w.x), bflo(w.y), bfhi(w.y)}; } return r; }
__device__ __forceinline__ float row_sumsq(const Row& r) { float s = 0.f;
#pragma unroll
    for (int j = 0; j < 4; ++j) s += (r.v[j][0] * r.v[j][0] + r.v[j][1] * r.v[j][1]) + (r.v[j][2] * r.v[j][2] + r.v[j][3] * r.v[j][3]); return wave_sum(s); }
__device__ __forceinline__ Row rmsnorm_row(const Row& x, const Row& g) { const float rs = rsqrtf(row_sumsq(x) * (1.f / D) + RMS_EPS); Row y;
#pragma unroll
    for (int j = 0; j < 4; ++j) y.v[j] = x.v[j] * rs * g.v[j]; return y; }

__device__ __forceinline__ void tr_item(const float* W, int ldw, int k0, int n0, bf16* WT, int ldt, int drow0, int dcol0, const float* sc, int scmode, LAS float* scr, int lane) {
#pragma unroll 8
    for (int i = 0; i < 32; ++i) { const int kk = 2 * i + (lane >> 5); float v = W[(size_t)(k0 + kk) * ldw + n0 + (lane & 31)];
        if (scmode == 1) v *= sc[k0 + kk]; else if (scmode == 2) v *= (1.f - sc[k0 + kk]);
        scr[kk * 33 + (lane & 31)] = v; }
    LDS_WAIT(); asm volatile("" ::: "memory");
    const int c = lane & 7;
#pragma unroll
    for (int j = 0; j < 4; ++j) { const int n = (lane >> 3) + 8 * j; const LAS float* s = scr + (8 * c) * 33 + n;
        u32x4 o; o.x = pk2(s[0 * 33], s[1 * 33]); o.y = pk2(s[2 * 33], s[3 * 33]); o.z = pk2(s[4 * 33], s[5 * 33]); o.w = pk2(s[6 * 33], s[7 * 33]);
        *(GAS u32x4*)(WT + (size_t)(drow0 + n0 + n) * ldt + dcol0 + k0 + 8 * c) = o; }
    LDS_WAIT(); asm volatile("" ::: "memory");
}
__device__ __forceinline__ int gu_row(int n) { return n < FF ? 256 * (n >> 7) + (n & 127) : 256 * ((n - FF) >> 7) + 128 + ((n - FF) & 127); }

__device__ __forceinline__ void p0_prologue(Frame& F, const Args& a) {
    LAS float* scr = (LAS float*)(F.lds + F.wave * 16384);
    unsigned char* ws = F.ws;
    constexpr int I_SQ = 16 * 32;
    constexpr int I_RKV = 3 * I_SQ, I_L1 = 2 * 16 * 8, I_L2 = 4 * 32, I_GU = 16 * 224, I_DN = 56 * 32, I_IN = 16 * 128;
    constexpr int NITEMS = I_RKV + I_L1 + I_L2 + I_SQ + I_GU + I_DN + I_IN + I_SQ + NE * I_GU + NE * I_DN;
    for (int it = F.gw; it < NITEMS; it += F.NGW) {
        int r = it;
        if (r < I_RKV) { const int z = r / I_SQ, q = r % I_SQ; tr_item(a.in[4] + (size_t)z * D * D, D, 64 * (q / 32), 32 * (q % 32), (bf16*)(ws + WS_W_RKV) + (size_t)z * D * D, D, 0, 0, nullptr, 0, scr, F.lane); continue; } r -= I_RKV;
        if (r < I_L1) {
            const int half = r / 128, q = r % 128, kb = q / 8, nb = q % 8, n0 = 32 * nb;
            const float* W; int ldw, nn0, mi;
            if (n0 < 64) { W = a.in[6]; ldw = 64; nn0 = n0; mi = 3; } else if (n0 < 128) { W = a.in[9]; ldw = 64; nn0 = n0 - 64; mi = 4; } else { W = a.in[11]; ldw = 128; nn0 = n0 - 128; mi = 5; }
            tr_item(W, ldw, 64 * kb, nn0, (bf16*)(ws + WS_W_L1), 2 * D, n0 - nn0, half * D, a.in[3] + mi * D, half == 0 ? 1 : 2, scr, F.lane); continue; } r -= I_L1;
        if (r < I_L2) {
            const int part = r / 32, nb = r % 32;
            if (part == 0) tr_item(a.in[7], D, 0, 32 * nb, (bf16*)(ws + WS_W_L2), 256, 0, 0, nullptr, 0, scr, F.lane);
            else if (part == 1) tr_item(a.in[10], D, 0, 32 * nb, (bf16*)(ws + WS_W_L2), 256, D, 64, nullptr, 0, scr, F.lane);
            else tr_item(a.in[12], D, 64 * (part - 2), 32 * nb, (bf16*)(ws + WS_W_L2), 256, 2 * D, 128, nullptr, 0, scr, F.lane);
            continue; } r -= I_L2;
        if (r < I_SQ) { tr_item(a.in[18], D, 64 * (r / 32), 32 * (r % 32), (bf16*)(ws + WS_W_O0), D, 0, 0, nullptr, 0, scr, F.lane); continue; } r -= I_SQ;
        if (r < I_GU) { const int kb = r / 224, nb = r % 224; tr_item(a.in[24], 2 * FF, 64 * kb, 32 * nb, (bf16*)(ws + WS_W_GU), D, gu_row(32 * nb) - 32 * nb, 0, nullptr, 0, scr, F.lane); continue; } r -= I_GU;
        if (r < I_DN) { tr_item(a.in[25], D, 64 * (r / 32), 32 * (r % 32), (bf16*)(ws + WS_W_DN), FF, 0, 0, nullptr, 0, scr, F.lane); continue; } r -= I_DN;
        if (r < I_IN) { tr_item(a.in[19], WIN_LD, 64 * (r / 128), 32 * (r % 128), (bf16*)(ws + WS_W_IN), D, 0, 0, nullptr, 0, scr, F.lane); continue; } r -= I_IN;
        if (r < I_SQ) { tr_item(a.in[23], D, 64 * (r / 32), 32 * (r % 32), (bf16*)(ws + WS_W_FO), D, 0, 0, nullptr, 0, scr, F.lane); continue; } r -= I_SQ;
        if (r < NE * I_GU) { const int e = r / I_GU, q = r % I_GU, kb = q / 224, nb = q % 224;
            tr_item(a.in[27] + (size_t)e * D * 2 * FF, 2 * FF, 64 * kb, 32 * nb, (bf16*)(ws + WS_W_MGU) + (size_t)e * 2 * FF * D, D, gu_row(32 * nb) - 32 * nb, 0, nullptr, 0, scr, F.lane); continue; } r -= NE * I_GU;
        { const int e = r / I_DN, q = r % I_DN; tr_item(a.in[28] + (size_t)e * FF * D, D, 64 * (q / 32), 32 * (q % 32), (bf16*)(ws + WS_W_MDN) + (size_t)e * D * FF, FF, 0, 0, nullptr, 0, scr, F.lane); }
    }
    for (int i = F.gw * 64 + F.lane; i < 3 * D * 32; i += F.NGW * 64) { const int row = i >> 5, ch = i & 31, part = row / D, k = ch * 8;
        const bool nz = part == 0 ? (k < 64) : (part == 1 ? (k >= 64 && k < 128) : (k >= 128));
        if (!nz) *(GAS u32x4*)((bf16*)(ws + WS_W_L2) + (size_t)row * 256 + k) = (u32x4){0u, 0u, 0u, 0u}; }
}

__device__ __forceinline__ void p1_shift(Frame& F, const Args& a) {
    const int lane = F.lane; const float* x = a.in[0];
    bf16* UB = (bf16*)(F.ws + WS_UB); bf16* XS = (bf16*)(F.ws + WS_XS);
    const Row g0 = ld_row(a.in[1], lane);
    const int RPW = T / (256 * NWAVES);
    for (int t0 = F.gw * RPW; t0 < T; t0 += F.NGW * RPW) {
        Row prev;
        if (t0 > 0) prev = rmsnorm_row(ld_row(x + (size_t)(t0 - 1) * D, lane), g0);
        else { for (int j = 0; j < 4; ++j) prev.v[j] = (f32x4){0.f, 0.f, 0.f, 0.f}; st_row_bf16(UB, lane, prev); }
        for (int t = t0; t < t0 + RPW; ++t) {
            const Row u = rmsnorm_row(ld_row(x + (size_t)t * D, lane), g0);
            st_row_bf16(UB + (size_t)(t + 1) * D, lane, u);
#pragma unroll
            for (int n = 0; n < 3; ++n) { const Row mu = ld_row(a.in[3] + n * D, lane); Row o;
#pragma unroll
                for (int j = 0; j < 4; ++j) o.v[j] = u.v[j] + (prev.v[j] - u.v[j]) * mu.v[j];
                st_row_bf16(XS + (size_t)n * T * D + (size_t)t * D, lane, o); }
            prev = u;
        }
    }
}

__device__ __forceinline__ void p4_derive(Frame& F, const Args& a) {
    const int lane = F.lane;
    float* R = (float*)(F.ws + WS_R); float* K = (float*)(F.ws + WS_K); float* LW = (float*)(F.ws + WS_LW); float* AA = (float*)(F.ws + WS_AA);
    float* KK = (float*)(F.ws + WS_KK); float* BB = (float*)(F.ws + WS_BB); float* CS = (float*)(F.ws + WS_CS);
    const Row k_k = ld_row(a.in[13], lane), k_a = ld_row(a.in[14], lane), r_k = ld_row(a.in[15], lane);
    for (int t = F.gw; t < T; t += F.NGW) {
        const size_t o = (size_t)t * D;
        Row r = ld_row(R + o, lane), k = ld_row(K + o, lane), lw = ld_row(LW + o, lane), aa = ld_row(AA + o, lane), kk, bb, km, dec;
        float c1[4], c2[4], c3[4];
#pragma unroll
        for (int j = 0; j < 4; ++j) {
            kk.v[j] = k.v[j] * k_k.v[j];
            float ss = (kk.v[j][0] * kk.v[j][0] + kk.v[j][1] * kk.v[j][1]) + (kk.v[j][2] * kk.v[j][2] + kk.v[j][3] * kk.v[j][3]);
            ss = row16_sum(ss);
            const float inv = 1.f / fmaxf(sqrtf(ss), 1e-12f);
            kk.v[j] = kk.v[j] * inv;
            bb.v[j] = kk.v[j] * aa.v[j];
            km.v[j] = k.v[j] * (1.f + (aa.v[j] - 1.f) * k_a.v[j]);
#pragma unroll
            for (int i = 0; i < 4; ++i) dec.v[j][i] = __expf(lw.v[j][i]);
            float s1 = 0.f, s2 = 0.f, s3 = 0.f;
#pragma unroll
            for (int i = 0; i < 4; ++i) { s1 += bb.v[j][i] * r.v[j][i]; const float kr = km.v[j][i] * r.v[j][i]; s2 += kr; s3 += kr * r_k.v[j][i]; }
            c1[j] = row16_sum(s1); c2[j] = row16_sum(s2); c3[j] = row16_sum(s3);
            r.v[j] = r.v[j] * dec.v[j];
        }
        st_row(R + o, lane, r); st_row(K + o, lane, km); st_row(LW + o, lane, dec); st_row(KK + o, lane, kk); st_row(BB + o, lane, bb);
        if ((lane & 15) == 0) {
#pragma unroll
            for (int j = 0; j < 4; ++j) { const int h = 4 * j + (lane >> 4); CS[(size_t)t * 16 + h] = c1[j]; CS[(size_t)T * 16 + (size_t)t * 16 + h] = c2[j]; CS[(size_t)2 * T * 16 + (size_t)t * 16 + h] = c3[j]; }
        }
    }
}

__device__ __forceinline__ float dpp_row_allsum(float x) {
    int v = __builtin_bit_cast(int, x);
    x += __builtin_bit_cast(float, __builtin_amdgcn_update_dpp(0, v, 0xB1, 0xF, 0xF, true)); v = __builtin_bit_cast(int, x);
    x += __builtin_bit_cast(float, __builtin_amdgcn_update_dpp(0, v, 0x4E, 0xF, 0xF, true)); v = __builtin_bit_cast(int, x);
    x += __builtin_bit_cast(float, __builtin_amdgcn_update_dpp(0, v, 0x141, 0xF, 0xF, true)); v = __builtin_bit_cast(int, x);
    x += __builtin_bit_cast(float, __builtin_amdgcn_update_dpp(0, v, 0x140, 0xF, 0xF, true));
    return x;
}
__device__ __forceinline__ float wave_allsum_fast(float x) {
    x = dpp_row_allsum(x);
    const int v = __builtin_bit_cast(int, x);
    const float a = __builtin_bit_cast(float, __builtin_amdgcn_readlane(v, 0)), b = __builtin_bit_cast(float, __builtin_amdgcn_readlane(v, 16)),
                c = __builtin_bit_cast(float, __builtin_amdgcn_readlane(v, 32)), d = __builtin_bit_cast(float, __builtin_amdgcn_readlane(v, 48));
    return (a + b) + (c + d);
}
__device__ __forceinline__ void p5_scan(Frame& F) {
    if (F.wave >= 4) return;
    const int lane = F.lane;
    const float* KK = (const float*)(F.ws + WS_KK); const float* RW = (const float*)(F.ws + WS_R); const float* DEC = (const float*)(F.ws + WS_LW);
    const float* BB = (const float*)(F.ws + WS_BB); const float* KM = (const float*)(F.ws + WS_K); const float* V = (const float*)(F.ws + WS_V);
    const float* CS = (const float*)(F.ws + WS_CS); float* YT = (float*)(F.ws + WS_YT);
    for (int rho = F.vcu * 4 + F.wave; rho < D; rho += F.G * 4) {
        const int h = rho >> 6;
        const size_t col = (size_t)h * 64 + lane;
        float s = 0.f, ybuf = 0.f;
        constexpr int U = 8;
        float ik[2][U], ir[2][U], iw[2][U], ib[2][U], im[2][U], iv[2][U], i1[2][U], i2[2][U];
#define SCAN_LOAD(buf, tb) do { _Pragma("unroll") for (int u_ = 0; u_ < U; ++u_) { const size_t o_ = (size_t)((tb) + u_) * D; \
            ik[buf][u_] = KK[o_ + col]; ir[buf][u_] = RW[o_ + col]; iw[buf][u_] = DEC[o_ + col]; ib[buf][u_] = BB[o_ + col]; im[buf][u_] = KM[o_ + col]; \
            iv[buf][u_] = V[o_ + rho]; i1[buf][u_] = CS[(size_t)((tb) + u_) * 16 + h]; i2[buf][u_] = CS[(size_t)T * 16 + (size_t)((tb) + u_) * 16 + h]; } } while (0)
#define SCAN_STEPS(buf, tb) do { _Pragma("unroll") for (int u_ = 0; u_ < U; ++u_) { \
            const float p1 = wave_allsum_fast(s * ik[buf][u_]); const float p2 = wave_allsum_fast(s * ir[buf][u_]); \
            const float sa = -p1; const float y = p2 + sa * i1[buf][u_] + iv[buf][u_] * i2[buf][u_]; \
            s = s * iw[buf][u_] + sa * ib[buf][u_] + iv[buf][u_] * im[buf][u_]; \
            if (lane == (((tb) + u_) & 63)) ybuf = y; } } while (0)
        SCAN_LOAD(0, 0);
        for (int t0 = 0; t0 < T; t0 += 2 * U) {
            SCAN_LOAD(1, t0 + U);
            SCAN_STEPS(0, t0);
            if (t0 + 2 * U < T) SCAN_LOAD(0, t0 + 2 * U);
            SCAN_STEPS(1, t0 + U);
            if (((t0 + 2 * U) & 63) == 0) YT[(size_t)rho * T + (t0 + 2 * U - 64) + lane] = ybuf;
        }
#undef SCAN_LOAD
#undef SCAN_STEPS
    }
}

typedef __bf16 bf16x2_t __attribute__((ext_vector_type(2)));
__device__ __forceinline__ unsigned cvtpk(float lo, float hi) { f32x2 v = {lo, hi}; bf16x2_t b = __builtin_convertvector(v, bf16x2_t); return __builtin_bit_cast(unsigned, b); }
struct Pk { bf16x8 k0, k1; };
__device__ __forceinline__ Pk pack_tile(const f32x16& t) {
    const u32x4 a = {cvtpk(t[0], t[1]), cvtpk(t[2], t[3]), cvtpk(t[4], t[5]), cvtpk(t[6], t[7])}, b = {cvtpk(t[8], t[9]), cvtpk(t[10], t[11]), cvtpk(t[12], t[13]), cvtpk(t[14], t[15])};
    Pk p; p.k0 = __builtin_bit_cast(bf16x8, a); p.k1 = __builtin_bit_cast(bf16x8, b); return p; }
#define MFMA32(a, b, c) __builtin_amdgcn_mfma_f32_32x32x16_bf16((a), (b), (c), 0, 0, 0)
__device__ __forceinline__ f32x16 xt(const Pk& X, const Pk& Z, f32x16 acc) { acc = MFMA32(X.k0, Z.k0, acc); acc = MFMA32(X.k1, Z.k1, acc); return acc; }
__device__ __forceinline__ bf16x8 nfrag(const bf16* m, int rt, int ks, int lane) { return *(const bf16x8*)(m + (size_t)(32 * rt + (lane & 31)) * D + 16 * ks + 8 * (lane >> 5)); }
__device__ __forceinline__ f32x16 nat(const bf16* am, int a, const bf16* bm, int b, int lane, f32x16 acc) {
#pragma unroll
    for (int ks = 0; ks < 4; ++ks) acc = MFMA32(nfrag(am, a, ks, lane), nfrag(bm, b, ks, lane), acc);
    return acc; }
__device__ __forceinline__ f32x16 dl_copy(const bf16* am, int a, int ct, int lane) {
    f32x16 acc = {};
#pragma unroll
    for (int kk2 = 0; kk2 < 2; ++kk2) { const int ks = 2 * ct + kk2; bf16x8 id;
#pragma unroll
        for (int e = 0; e < 8; ++e) id[e] = (32 * ct + (lane & 31) == 16 * ks + 8 * (lane >> 5) + e) ? (short)0x3F80 : (short)0;
        acc = MFMA32(nfrag(am, a, ks, lane), id, acc); }
    return acc; }
__device__ __forceinline__ void mask_lt(f32x16& t, int lane) {
#pragma unroll
    for (int r = 0; r < 16; ++r) if (!(crow(r, lane >> 5) < (lane & 31))) t[r] = 0.f; }
__device__ __forceinline__ void mask_gt(f32x16& t, int lane) {
#pragma unroll
    for (int r = 0; r < 16; ++r) if (!(crow(r, lane >> 5) > (lane & 31))) t[r] = 0.f; }
__device__ __forceinline__ void mask_le(f32x16& t, int lane) {
#pragma unroll
    for (int r = 0; r < 16; ++r) if (!(crow(r, lane >> 5) <= (lane & 31))) t[r] = 0.f; }
__device__ __forceinline__ void add_eye(f32x16& t, int lane) {
#pragma unroll
    for (int r = 0; r < 16; ++r) if (crow(r, lane >> 5) == (lane & 31)) t[r] += 1.f; }

__device__ __forceinline__ void p3_prep(Frame& F, const Args& a) {
    const int lane = F.lane;
    const bf16* R = (const bf16*)(F.ws + WS_R); const bf16* K = (const bf16*)(F.ws + WS_K); const bf16* V = (const bf16*)(F.ws + WS_V);
    const float* LW = (const float*)(F.ws + WS_LW); const bf16* AA = (const bf16*)(F.ws + WS_AA);
    bf16* AT = (bf16*)(F.ws + WS_AT); bf16* RT = (bf16*)(F.ws + WS_RT); bf16* BH = (bf16*)(F.ws + WS_BH); bf16* KH = (bf16*)(F.ws + WS_KH); bf16* V16 = (bf16*)(F.ws + WS_V16);
    float* GC = (float*)(F.ws + WS_GC); float* C3 = (float*)(F.ws + WS_CS) + (size_t)2 * T * 16;
    for (int task = F.gw; task < NCH * 4; task += F.NGW) {
        const int c = task >> 2, hg = task & 3, col = hg * 256 + 4 * lane;
        const f32x4 k_k = *(const f32x4*)(a.in[13] + col), k_a = *(const f32x4*)(a.in[14] + col), r_k = *(const f32x4*)(a.in[15] + col);
        f32x4 lg = {0.f, 0.f, 0.f, 0.f};
        constexpr int PF = 8;
        for (int tb = 0; tb < 64; tb += PF) {
            u32x2 rr[PF], kx[PF], ax[PF]; f32x4 lx[PF];
#pragma unroll
            for (int u = 0; u < PF; ++u) { const size_t o = (size_t)(64 * c + tb + u) * D + col;
                rr[u] = *(const u32x2*)(R + o); kx[u] = *(const u32x2*)(K + o); lx[u] = *(const f32x4*)(LW + o); ax[u] = *(const u32x2*)(AA + o); }
#pragma unroll
            for (int u = 0; u < PF; ++u) { const int tt = tb + u;
                const size_t o = (size_t)(64 * c + tt) * D + col;
                const f32x4 r = {bflo(rr[u].x), bfhi(rr[u].x), bflo(rr[u].y), bfhi(rr[u].y)}, k = {bflo(kx[u].x), bfhi(kx[u].x), bflo(kx[u].y), bfhi(kx[u].y)}, lw = lx[u], aa = {bflo(ax[u].x), bfhi(ax[u].x), bflo(ax[u].y), bfhi(ax[u].y)};
                f32x4 kk = k * k_k;
                float ss = (kk[0] * kk[0] + kk[1] * kk[1]) + (kk[2] * kk[2] + kk[3] * kk[3]); ss = row16_sum(ss);
                kk = kk * (1.f / fmaxf(sqrtf(ss), 1e-12f));
                const f32x4 b = kk * aa, km = k * (1.f + (aa - 1.f) * k_a);
                float s3 = (r[0] * km[0] * r_k[0] + r[1] * km[1] * r_k[1]) + (r[2] * km[2] * r_k[2] + r[3] * km[3] * r_k[3]); s3 = row16_sum(s3);
                if ((lane & 15) == 0) C3[(size_t)(64 * c + tt) * 16 + hg * 4 + (lane >> 4)] = s3;
                const f32x4 lgm1 = lg; lg = lg + lw;
                f32x4 at, rt, bh, kh;
#pragma unroll
                for (int i = 0; i < 4; ++i) { const float em = __expf(lgm1[i]), ep = __expf(lg[i]), en = __expf(-lg[i]); at[i] = -kk[i] * em; rt[i] = r[i] * ep; bh[i] = b[i] * en; kh[i] = km[i] * en; }
                *(u32x2*)(AT + o) = (u32x2){pk2(at[0], at[1]), pk2(at[2], at[3])}; *(u32x2*)(RT + o) = (u32x2){pk2(rt[0], rt[1]), pk2(rt[2], rt[3])};
                *(u32x2*)(BH + o) = (u32x2){pk2(bh[0], bh[1]), pk2(bh[2], bh[3])}; *(u32x2*)(KH + o) = (u32x2){pk2(kh[0], kh[1]), pk2(kh[2], kh[3])};
            }
        }
        f32x4 g; for (int i = 0; i < 4; ++i) g[i] = __expf(lg[i]);
        *(f32x4*)(GC + (size_t)c * D + col) = g;
    }
}

__device__ __forceinline__ void inv32(f32x16 N, f32x16 NT, f32x16& Tm, f32x16& TT, int lane) {
    Tm = N; TT = NT; add_eye(Tm, lane); add_eye(TT, lane);
    Pk Np = pack_tile(N), NTp = pack_tile(NT);
#pragma unroll
    for (int it = 0; it < 4; ++it) {
        const f32x16 z = {};
        const f32x16 N2 = xt(NTp, Np, z), N2T = xt(Np, NTp, z);
        const Pk N2p = pack_tile(N2), N2Tp = pack_tile(N2T), TTp = pack_tile(TT);
        Tm = xt(TTp, N2p, Tm);
        TT = xt(N2p, TTp, TT);
        Np = N2p; NTp = N2Tp;
    }
}

__device__ __forceinline__ void pa_chunk(Frame& F) {
    const int lane = F.lane, c32 = lane & 31, hh = lane >> 5;
    const bf16* AT = (const bf16*)(F.ws + WS_AT); const bf16* BH = (const bf16*)(F.ws + WS_BH); const bf16* KH = (const bf16*)(F.ws + WS_KH); const bf16* V16 = (const bf16*)(F.ws + WS_V16);
    const float* GC = (const float*)(F.ws + WS_GC);
    for (int task = F.gw; task < NCH * NH; task += F.NGW) {
        const int c = task >> 4, h = task & 15; const size_t o = (size_t)(64 * c) * D + h * 64;
        const bf16* at = AT + o; const bf16* bh = BH + o; const bf16* kh = KH + o; const bf16* vv = V16 + o;
        const f32x16 z = {};
        Pk T11, T22, T12, T11T, T22T, T12T;
        {
            f32x16 n = nat(bh, 0, at, 0, lane, z), nt = nat(at, 0, bh, 0, lane, z); mask_lt(n, lane); mask_gt(nt, lane);
            f32x16 t, tt; inv32(n, nt, t, tt, lane); T11 = pack_tile(t); T11T = pack_tile(tt);
            n = nat(bh, 1, at, 1, lane, z); nt = nat(at, 1, bh, 1, lane, z); mask_lt(n, lane); mask_gt(nt, lane);
            inv32(n, nt, t, tt, lane); T22 = pack_tile(t); T22T = pack_tile(tt);
            const Pk N12 = pack_tile(nat(bh, 0, at, 1, lane, z)), N12T = pack_tile(nat(at, 1, bh, 0, lane, z));
            const Pk Z1 = pack_tile(xt(N12T, T22, z));
            T12 = pack_tile(xt(T11T, Z1, z));
            const Pk Z2 = pack_tile(xt(N12, T11T, z));
            T12T = pack_tile(xt(T22, Z2, z));
        }
        {
            u32x4* tm = (u32x4*)(F.ws + WS_TM) + (size_t)task * 6 * 64 + lane;
            tm[0] = __builtin_bit_cast(u32x4, T11.k0); tm[64] = __builtin_bit_cast(u32x4, T11.k1); tm[128] = __builtin_bit_cast(u32x4, T12.k0); tm[192] = __builtin_bit_cast(u32x4, T12.k1);
            tm[256] = __builtin_bit_cast(u32x4, T22.k0); tm[320] = __builtin_bit_cast(u32x4, T22.k1);
        }
        const float g0 = GC[(size_t)c * D + h * 64 + c32], g1 = GC[(size_t)c * D + h * 64 + 32 + c32];
        Pk W1p[2][2];
#pragma unroll
        for (int b = 0; b < 2; ++b) { const float gcol = b == 0 ? g0 : g1;
            f32x16 bb0 = dl_copy(bh, 0, b, lane), bb1 = dl_copy(bh, 1, b, lane);
#pragma unroll
            for (int r = 0; r < 16; ++r) { bb0[r] *= gcol; bb1[r] *= gcol; }
            const Pk B0 = pack_tile(bb0), B1 = pack_tile(bb1);
            f32x16 w0 = xt(T11T, B0, z); w0 = xt(T12T, B1, w0);
            const f32x16 w1 = xt(T22T, B1, z);
            W1p[0][b] = pack_tile(w0); W1p[1][b] = pack_tile(w1); }
        {
            bf16* plr = (bf16*)(F.ws + WS_PLR) + (size_t)task * 4096;
#pragma unroll
            for (int a2 = 0; a2 < 2; ++a2) { const Pk A0 = pack_tile(dl_copy(at, 0, a2, lane)), A1 = pack_tile(dl_copy(at, 1, a2, lane));
#pragma unroll
                for (int b = 0; b < 2; ++b) { f32x16 p = xt(A0, W1p[0][b], z); p = xt(A1, W1p[1][b], p);
#pragma unroll
                    for (int g4 = 0; g4 < 4; ++g4) {
                        const int m_ = 2 * b + (c32 >> 4), lb_ = (c32 & 15) + 16 * (2 * (g4 & 1) + hh);
                        *(u32x2*)(plr + ((m_ * 2 + a2) * 64 + lb_) * 8 + 4 * (g4 >> 1)) = (u32x2){cvtpk(p[4 * g4], p[4 * g4 + 1]), cvtpk(p[4 * g4 + 2], p[4 * g4 + 3])}; } } }
        }
        Pk M2p[2][2];
        {
            f32x16 e = nat(at, 0, kh, 0, lane, z); mask_gt(e, lane); const Pk E00 = pack_tile(e);
            e = nat(at, 1, kh, 1, lane, z); mask_gt(e, lane); const Pk E11 = pack_tile(e);
            const Pk E10 = pack_tile(nat(at, 1, kh, 0, lane, z));
#pragma unroll
            for (int b = 0; b < 2; ++b) { const float gcol = b == 0 ? g0 : g1;
                f32x16 m0 = xt(E00, W1p[0][b], z); m0 = xt(E10, W1p[1][b], m0);
                f32x16 m1 = xt(E11, W1p[1][b], z);
                const f32x16 k0 = dl_copy(kh, 0, b, lane), k1 = dl_copy(kh, 1, b, lane);
#pragma unroll
                for (int r = 0; r < 16; ++r) { m0[r] += k0[r] * gcol; m1[r] += k1[r] * gcol; }
                M2p[0][b] = pack_tile(m0); M2p[1][b] = pack_tile(m1); }
        }
        {
            float* qm = (float*)(F.ws + WS_QM) + (size_t)task * 4096;
#pragma unroll
            for (int b = 0; b < 2; ++b) { const Pk V0 = pack_tile(dl_copy(vv, 0, b, lane)), V1 = pack_tile(dl_copy(vv, 1, b, lane));
#pragma unroll
                for (int a2 = 0; a2 < 2; ++a2) { f32x16 q = xt(M2p[0][a2], V0, z); q = xt(M2p[1][a2], V1, q);
#pragma unroll
                    for (int g4 = 0; g4 < 4; ++g4) {
                        const int rg_ = 2 * b + (c32 >> 4), m_ = 2 * a2 + (g4 >> 1), lb_ = (c32 & 15) + 16 * (2 * (g4 & 1) + hh);
                        *(f32x4*)(qm + rg_ * 1024 + (m_ * 64 + lb_) * 4) = (f32x4){q[4 * g4], q[4 * g4 + 1], q[4 * g4 + 2], q[4 * g4 + 3]}; } } }
        }
    }
}

constexpr int PB_NST = 10, PB_STB = 8192 + 4096 + 256, PB_NLD = 3;
constexpr int PB_FULL_OFF = RING_BYTES + 64, PB_CONS_OFF = RING_BYTES + 128;
static_assert(PB_NST * PB_STB <= RING_BYTES && PB_FULL_OFF + 4 * PB_NST <= PB_CONS_OFF && PB_CONS_OFF + 4 <= MISC_OFF, "phase-B LDS map");
__device__ __forceinline__ void pb_chain(Frame& F) {
    if ((F.vcu & 31) >= 8 || F.vcu >= 256 || F.wave > PB_NLD) return;
    const int lane = F.lane, h = 2 * (F.vcu >> 5) + ((F.vcu & 31) >> 2), rg = F.vcu & 3;
    volatile LAS unsigned* FULL = (volatile LAS unsigned*)(F.lds + PB_FULL_OFF); volatile LAS unsigned* CONS = (volatile LAS unsigned*)(F.lds + PB_CONS_OFF);
    if (F.wave >= 1) {
        const int L = F.wave - 1;
        const char* PLR = (const char*)(F.ws + WS_PLR); const char* QM = (const char*)(F.ws + WS_QM); const float* GC = (const float*)(F.ws + WS_GC);
        int k = 0;
        for (int c = L; c < NCH; c += PB_NLD, ++k) {
            if (c >= PB_NST) { const unsigned need = (unsigned)(c - PB_NST + 1); unsigned sp = 0; while (CONS[0] < need) { __builtin_amdgcn_s_sleep(1); if (++sp > (1u << 22)) break; } }
            const size_t task = (size_t)c * 16 + h;
            LAS unsigned char* slot = F.lds + (c % PB_NST) * PB_STB;
            const char* pl = PLR + task * 8192 + lane * 16; const char* qm = QM + task * 16384 + rg * 4096 + lane * 16;
#pragma unroll
            for (int i = 0; i < 8; ++i) __builtin_amdgcn_global_load_lds((const unsigned*)(pl + i * 1024), (LAS unsigned*)(slot + i * 1024), 16, 0, 0);
#pragma unroll
            for (int i = 0; i < 4; ++i) __builtin_amdgcn_global_load_lds((const unsigned*)(qm + i * 1024), (LAS unsigned*)(slot + 8192 + i * 1024), 16, 0, 0);
            __builtin_amdgcn_global_load_lds((const unsigned*)(GC + (size_t)c * D + h * 64 + lane), (LAS unsigned*)(slot + 12288), 4, 0, 0);
            if (k >= 2) { asm volatile("s_waitcnt vmcnt(26)" ::: "memory"); const int cp = c - 2 * PB_NLD; FULL[cp % PB_NST] = (unsigned)(cp + 1); }
        }
        const int clast = L + PB_NLD * (k - 1);
        if (k >= 2) { asm volatile("s_waitcnt vmcnt(13)" ::: "memory"); const int cp = clast - PB_NLD; FULL[cp % PB_NST] = (unsigned)(cp + 1); }
        asm volatile("s_waitcnt vmcnt(0)" ::: "memory"); FULL[clast % PB_NST] = (unsigned)(clast + 1);
        return;
    }
    const int n16 = lane & 15, q4 = lane >> 4;
    bf16* S0 = (bf16*)(F.ws + WS_S0);
    f32x4 s[4];
#pragma unroll
    for (int m = 0; m < 4; ++m) s[m] = (f32x4){0.f, 0.f, 0.f, 0.f};
    for (int c = 0; c < NCH; ++c) {
        { const unsigned need = (unsigned)(c + 1); unsigned sp = 0; while (FULL[c % PB_NST] < need) { if (++sp > (1u << 24)) break; } }
        const LAS unsigned char* slot = F.lds + (c % PB_NST) * PB_STB;
        bf16x8 af[4][2]; f32x4 qv[4], gc[4];
#pragma unroll
        for (int m = 0; m < 4; ++m) {
#pragma unroll
            for (int kb = 0; kb < 2; ++kb) af[m][kb] = *(const LAS bf16x8*)(slot + ((m * 2 + kb) * 64 + lane) * 16);
            qv[m] = *(const LAS f32x4*)(slot + 8192 + (m * 64 + lane) * 16); gc[m] = *(const LAS f32x4*)(slot + 12288 + 64 * m + 16 * q4); }
        asm volatile("s_waitcnt lgkmcnt(0)" ::: "memory");
        CONS[0] = (unsigned)(c + 1);
        bf16* s0 = S0 + ((size_t)c * 16 + h) * 4096 + (16 * rg + n16) * 64;
        u32x2 sp2[4];
#pragma unroll
        for (int m = 0; m < 4; ++m) { sp2[m] = (u32x2){cvtpk(s[m][0], s[m][1]), cvtpk(s[m][2], s[m][3])}; *(u32x2*)(s0 + 16 * m + 4 * q4) = sp2[m]; }
        const bf16x8 B0 = __builtin_bit_cast(bf16x8, (u32x4){sp2[0].x, sp2[0].y, sp2[1].x, sp2[1].y}), B1 = __builtin_bit_cast(bf16x8, (u32x4){sp2[2].x, sp2[2].y, sp2[3].x, sp2[3].y});
#pragma unroll
        for (int m = 0; m < 4; ++m) { f32x4 acc = s[m] * gc[m] + qv[m];
            acc = __builtin_amdgcn_mfma_f32_16x16x32_bf16(af[m][0], B0, acc, 0, 0, 0);
            acc = __builtin_amdgcn_mfma_f32_16x16x32_bf16(af[m][1], B1, acc, 0, 0, 0);
            s[m] = acc; }
    }
}

__device__ __forceinline__ void pc_out(Frame& F, const Args& a) {
    const int lane = F.lane, c32 = lane & 31, hh = lane >> 5;
    const bf16* AT = (const bf16*)(F.ws + WS_AT); const bf16* RT = (const bf16*)(F.ws + WS_RT); const bf16* BH = (const bf16*)(F.ws + WS_BH); const bf16* KH = (const bf16*)(F.ws + WS_KH);
    const bf16* V16 = (const bf16*)(F.ws + WS_V16); const bf16* S0 = (const bf16*)(F.ws + WS_S0);
    const bf16* G = (const bf16*)(F.ws + WS_G); const float* C3 = (const float*)(F.ws + WS_CS) + (size_t)2 * T * 16; bf16* Z = (bf16*)(F.ws + WS_Z);
    LAS float* ysc = (LAS float*)(F.lds + F.wave * 16384);
    for (int task = F.gw; task < NCH * NH; task += F.NGW) {
        const int c = task >> 4, h = task & 15; const size_t o = (size_t)(64 * c) * D + h * 64;
        const bf16* at = AT + o; const bf16* rt = RT + o; const bf16* bh = BH + o; const bf16* kh = KH + o; const bf16* vv = V16 + o;
        const bf16* s0 = S0 + (size_t)task * 4096;
        const f32x16 z = {};
        auto s0frag = [&](int it, int ks) { return *(const bf16x8*)(s0 + (32 * it + c32) * 64 + 16 * ks + 8 * hh); };
#pragma unroll 1
        for (int b = 0; b < 2; ++b) {
            f32x16 e = nat(kh, 0, at, 0, lane, z); mask_lt(e, lane); const Pk K00 = pack_tile(e);
            e = nat(kh, 1, at, 1, lane, z); mask_lt(e, lane); const Pk K11 = pack_tile(e);
            const Pk K01 = pack_tile(nat(kh, 0, at, 1, lane, z));
            __builtin_amdgcn_sched_barrier(0);
            const Pk V0 = pack_tile(dl_copy(vv, 0, b, lane)), V1 = pack_tile(dl_copy(vv, 1, b, lane));
            __builtin_amdgcn_sched_barrier(0);
            f32x16 x0 = z, x1 = z;
#pragma unroll
            for (int ks = 0; ks < 4; ++ks) { const bf16x8 sf = s0frag(b, ks); x0 = MFMA32(nfrag(at, 0, ks, lane), sf, x0); x1 = MFMA32(nfrag(at, 1, ks, lane), sf, x1); }
            x0 = xt(K00, V0, x0);
            x1 = xt(K01, V0, x1); x1 = xt(K11, V1, x1);
            const Pk X0 = pack_tile(x0), X1 = pack_tile(x1);
            __builtin_amdgcn_sched_barrier(0);
            Pk Tm00, Tm01, Tm11;
            { const u32x4* tm = (const u32x4*)(F.ws + WS_TM) + (size_t)task * 6 * 64 + lane;
              Tm00.k0 = __builtin_bit_cast(bf16x8, tm[0]); Tm00.k1 = __builtin_bit_cast(bf16x8, tm[64]); Tm01.k0 = __builtin_bit_cast(bf16x8, tm[128]); Tm01.k1 = __builtin_bit_cast(bf16x8, tm[192]);
              Tm11.k0 = __builtin_bit_cast(bf16x8, tm[256]); Tm11.k1 = __builtin_bit_cast(bf16x8, tm[320]); }
            const Pk U0 = pack_tile(xt(Tm00, X0, z));
            f32x16 u1 = xt(Tm01, X0, z); u1 = xt(Tm11, X1, u1); const Pk U1 = pack_tile(u1);
            __builtin_amdgcn_sched_barrier(0);
            f32x16 y0 = z, y1 = z;
#pragma unroll
            for (int ks = 0; ks < 4; ++ks) { const bf16x8 sf = s0frag(b, ks); y0 = MFMA32(nfrag(rt, 0, ks, lane), sf, y0); y1 = MFMA32(nfrag(rt, 1, ks, lane), sf, y1); }
            { f32x16 m = nat(bh, 0, rt, 0, lane, z); mask_le(m, lane); const Pk R00 = pack_tile(m); y0 = xt(R00, U0, y0);
              const Pk R01 = pack_tile(nat(bh, 0, rt, 1, lane, z)); y1 = xt(R01, U0, y1);
              m = nat(bh, 1, rt, 1, lane, z); mask_le(m, lane); const Pk R11 = pack_tile(m); y1 = xt(R11, U1, y1); }
            __builtin_amdgcn_sched_barrier(0);
            { f32x16 m = nat(kh, 0, rt, 0, lane, z); mask_le(m, lane); const Pk R00 = pack_tile(m); y0 = xt(R00, V0, y0);
              const Pk R01 = pack_tile(nat(kh, 0, rt, 1, lane, z)); y1 = xt(R01, V0, y1);
              m = nat(kh, 1, rt, 1, lane, z); mask_le(m, lane); const Pk R11 = pack_tile(m); y1 = xt(R11, V1, y1); }
            __builtin_amdgcn_sched_barrier(0);
#pragma unroll
            for (int r = 0; r < 16; ++r) { ysc[crow(r, hh) * 64 + 32 * b + c32] = y0[r]; ysc[(32 + crow(r, hh)) * 64 + 32 * b + c32] = y1[r]; }
        }
        LDS_WAIT();
        {
            int lane_e = lane; asm volatile("" : "+v"(lane_e));
            const int l16 = lane_e & 15, tq = lane_e >> 4, col = h * 64 + 4 * l16;
            const f32x4 gg = *(const f32x4*)(a.in[16] + col), gb = *(const f32x4*)(a.in[17] + col);
#pragma unroll 2
            for (int it = 0; it < 16; ++it) { const int tt = 4 * it + tq; const size_t row = (size_t)(64 * c + tt);
                const f32x4 y = *(const LAS f32x4*)(ysc + tt * 64 + 4 * l16);
                const u32x2 gw = *(const u32x2*)(G + row * D + col), vw = *(const u32x2*)(V16 + row * D + col); const float c3 = C3[row * 16 + h];
                const float mean = row16_sum((y[0] + y[1]) + (y[2] + y[3])) * (1.f / 64.f);
                const f32x4 d = y - mean;
                const float var = row16_sum((d[0] * d[0] + d[1] * d[1]) + (d[2] * d[2] + d[3] * d[3])) * (1.f / 64.f);
                const float rs = rsqrtf(var + GN_EPS);
                const f32x4 g = {bflo(gw.x), bfhi(gw.x), bflo(gw.y), bfhi(gw.y)}, v = {bflo(vw.x), bfhi(vw.x), bflo(vw.y), bfhi(vw.y)};
                const f32x4 zv = (d * rs * gg + gb + c3 * v) * g;
                *(u32x2*)(Z + row * D + col) = (u32x2){pk2(zv[0], zv[1]), pk2(zv[2], zv[3])}; }
        }
        LDS_WAIT();
    }
}

__device__ __forceinline__ void p6_gn_rows(Frame& F, const Args& a) {
    const int lane = F.lane;
    const float* Y = (const float*)(F.ws + WS_Y); const bf16* V16 = (const bf16*)(F.ws + WS_V16); const bf16* G = (const bf16*)(F.ws + WS_G);
    const float* C3 = (const float*)(F.ws + WS_CS) + (size_t)2 * T * 16; bf16* Z = (bf16*)(F.ws + WS_Z);
    const Row gg = ld_row(a.in[16], lane), gb = ld_row(a.in[17], lane);
    for (int t = F.gw; t < T; t += F.NGW) {
        const size_t o = (size_t)t * D;
        const Row y = ld_row(Y + o, lane), g = ld_row_bf16(G + o, lane), v = ld_row_bf16(V16 + o, lane); Row zr;
#pragma unroll
        for (int j = 0; j < 4; ++j) {
            const float mean = row16_sum((y.v[j][0] + y.v[j][1]) + (y.v[j][2] + y.v[j][3])) * (1.f / 64.f);
            const f32x4 d = y.v[j] - mean;
            const float var = row16_sum((d[0] * d[0] + d[1] * d[1]) + (d[2] * d[2] + d[3] * d[3])) * (1.f / 64.f);
            const float rs = rsqrtf(var + GN_EPS), c3 = C3[(size_t)t * 16 + 4 * j + (lane >> 4)];
            zr.v[j] = (d * rs * gg.v[j] + gb.v[j] + c3 * v.v[j]) * g.v[j];
        }
        st_row_bf16(Z + o, lane, zr);
    }
}

__device__ __forceinline__ void p6_gn(Frame& F, const Args& a) {
    const int lane = F.lane, wave = F.wave;
    const float* YT = (const float*)(F.ws + WS_YT); const float* V = (const float*)(F.ws + WS_V); const float* G = (const float*)(F.ws + WS_G);
    const float* C3 = (const float*)(F.ws + WS_CS) + (size_t)2 * T * 16; bf16* Z = (bf16*)(F.ws + WS_Z);
    LAS float* tile = (LAS float*)F.lds;
    for (int unit = F.vcu; unit < NH * (T / 64); unit += F.G) {
        const int h = unit / (T / 64), t0 = (unit % (T / 64)) * 64;
        __syncthreads();
#pragma unroll
        for (int q = 0; q < 8; ++q) { const int i = wave * 8 + q; tile[i * 65 + lane] = YT[(size_t)(h * 64 + i) * T + t0 + lane]; }
        __syncthreads();
        const float gg = a.in[16][h * 64 + lane], gb = a.in[17][h * 64 + lane];
#pragma unroll
        for (int q = 0; q < 8; ++q) { const int tt = wave * 8 + q, t = t0 + tt;
            const float y = tile[lane * 65 + tt];
            const float mean = wave_sum(y) * (1.f / 64.f); const float dlt = y - mean; const float var = wave_sum(dlt * dlt) * (1.f / 64.f);
            const size_t o = (size_t)t * D + h * 64 + lane;
            const float z = (dlt * rsqrtf(var + GN_EPS) * gg + gb + C3[(size_t)t * 16 + h] * V[o]) * G[o];
            Z[o] = (bf16)f2bf(z); }
    }
    __syncthreads();
}

__device__ __forceinline__ void p8_norm(Frame& F, const float* g, bf16* U) {
    const float* Hs = (const float*)(F.ws + WS_H); const Row gr = ld_row(g, F.lane);
    for (int t = F.gw; t < T; t += F.NGW) st_row_bf16(U + (size_t)t * D, F.lane, rmsnorm_row(ld_row(Hs + (size_t)t * D, F.lane), gr));
}
__device__ __forceinline__ void p11_norm_forget(Frame& F, const Args& a) {
    const int lane = F.lane; const float* Hs = (const float*)(F.ws + WS_H); bf16* U = (bf16*)(F.ws + WS_U3); float* LF = (float*)(F.ws + WS_LF);
    LAS float* wf = (LAS float*)F.lds;
    __syncthreads();
    for (int i = F.tid; i < 16 * D; i += NTHREADS) { const int hh = i & 15, k = i >> 4; wf[hh * D + k] = a.in[19][(size_t)k * WIN_LD + 4 * D + hh]; }
    __syncthreads();
    const Row gr = ld_row(a.in[1] + 2 * D, lane);
    for (int t = F.gw; t < T; t += F.NGW) {
        const Row u = rmsnorm_row(ld_row(Hs + (size_t)t * D, lane), gr);
        st_row_bf16(U + (size_t)t * D, lane, u);
        float mine = 0.f;
#pragma unroll 2
        for (int hh = 0; hh < 16; ++hh) { float s = 0.f;
#pragma unroll
            for (int j = 0; j < 4; ++j) { const f32x4 w = *(const LAS f32x4*)(wf + hh * D + 256 * j + 4 * lane); s += (u.v[j][0] * w[0] + u.v[j][1] * w[1]) + (u.v[j][2] * w[2] + u.v[j][3] * w[3]); }
            s = wave_sum(s); if (lane == hh) mine = s; }
        if (lane < 16) { const float x = mine + a.in[20][lane]; LF[(size_t)t * 16 + lane] = fminf(x, 0.f) - log1pf(__expf(-fabsf(x))); }
    }
    __syncthreads();
}
__device__ __forceinline__ void p13_cumsum_qknorm(Frame& F, const Args& a) {
    const int lane = F.lane, tid = F.tid;
    const float* LF = (const float*)(F.ws + WS_LF); float* C2 = (float*)(F.ws + WS_C2); float* CB = (float*)(F.ws + WS_CB);
    if (F.vcu < NH) {
        const int h = F.vcu; LAS double* part = (LAS double*)F.lds;
        __syncthreads();
        const int tb = tid * 32; double s = 0.0;
        for (int i = 0; i < 32; ++i) s += (double)LF[(size_t)(tb + i) * 16 + h];
        part[tid] = s; __syncthreads();
        if (tid == 0) { double run = 0.0; for (int i = 0; i < NTHREADS; ++i) { const double v = part[i]; part[i] = run; run += v; } }
        __syncthreads();
        double run = part[tid];
        for (int i = 0; i < 32; ++i) { run += (double)LF[(size_t)(tb + i) * 16 + h]; const float c = (float)(run * 1.4426950408889634); C2[(size_t)h * T + tb + i] = c; if (((tb + i) & 63) == 63) CB[h * 256 + ((tb + i) >> 6)] = c; }
        __syncthreads();
    }
    bf16* Q = (bf16*)(F.ws + WS_QKVG);
    f32x4 gq[4], gk[4];
#pragma unroll
    for (int j = 0; j < 4; ++j) { const int c = (4 * lane + 256 * j) & 63; gq[j] = *(const f32x4*)(a.in[21] + c) * (0.125f * LOG2E); gk[j] = *(const f32x4*)(a.in[22] + c); }
    for (int t = F.gw; t < T; t += F.NGW) {
#pragma unroll
        for (int which = 0; which < 2; ++which) {
            bf16* p = Q + (size_t)t * 4096 + which * D;
            Row x = ld_row_bf16(p, lane);
#pragma unroll
            for (int j = 0; j < 4; ++j) { float ss = (x.v[j][0] * x.v[j][0] + x.v[j][1] * x.v[j][1]) + (x.v[j][2] * x.v[j][2] + x.v[j][3] * x.v[j][3]); ss = row16_sum(ss);
                const float rs = rsqrtf(ss * (1.f / 64.f) + RMS_EPS); x.v[j] = x.v[j] * rs * (which == 0 ? gq[j] : gk[j]); }
            st_row_bf16(p, lane, x);
        }
    }
}

#ifndef ATTN_STORE16
#define ATTN_STORE16(p,v) (*(u32x4*)(p)=(v))
#endif
namespace attn_body {
using bf16x8=__attribute__((ext_vector_type(8)))short;
using s16x4=__attribute__((ext_vector_type(4)))short;
using f32x16=__attribute__((ext_vector_type(16)))float;
using u32x4=__attribute__((ext_vector_type(4)))unsigned;
constexpr int NHEAD=16,SEQ=16384,D=64,DM=4096,OM=1024;
constexpr int NW=8,QBLK=32,QB=QBLK*NW,KVBLK=64,NQB=SEQ/QB;
constexpr int ATTN_UNIT_ROWS=QB;
__device__ __forceinline__ int crow(int r,int hi){return (r&3)+8*(r>>2)+4*hi;}
#define SBAR() __builtin_amdgcn_sched_barrier(0)
__device__ __forceinline__ void cmask(f32x16&p0,f32x16&p1,int jb,int qrel,int hi){
  const float NEG=-INFINITY; int kb=64*jb+4*hi;
  #pragma unroll
  for(int r=0;r<16;++r){int kv=kb+(r&3)+8*(r>>2); if(kv>qrel)p0[r]=NEG; if(kv+32>qrel)p1[r]=NEG;}
}

constexpr int NSLOT=3, SLOTB=8192;
constexpr int LDS_K=0, LDS_V=NSLOT*SLOTB, LDS_WS=2*NSLOT*SLOTB, LDS_OST=LDS_WS+NW*64*4, LDS_BYTES=LDS_OST+NW*4096;
constexpr float C2=0.125f*1.4426950408889634f;
__device__ __forceinline__ void glds16(const void*gsrc,unsigned lds_dst){unsigned keep;
  asm volatile("s_mov_b32 %0, m0\n\ts_mov_b32 m0, %2\n\ts_nop 0\n\tglobal_load_lds_dwordx4 %1, off\n\ts_mov_b32 m0, %0":"=&s"(keep):"v"(gsrc),"s"(lds_dst):"memory");}
__device__ __forceinline__ float max3f(float a,float b,float c){float r;asm("v_max3_f32 %0, %1, %2, %3":"=v"(r):"v"(a),"v"(b),"v"(c));return r;}
__device__ __forceinline__ float max2f(float a,float b){float r;asm("v_max_f32_e32 %0, %1, %2":"=v"(r):"v"(a),"v"(b));return r;}
__device__ __forceinline__ float fadd_s(float a,float b){float r;asm("v_add_f32_e32 %0, %1, %2":"=v"(r):"v"(a),"v"(b));return r;}
__device__ __forceinline__ float fsub_s(float a,float b){float r;asm("v_sub_f32_e32 %0, %1, %2":"=v"(r):"v"(a),"v"(b));return r;}
typedef float f32x2_t __attribute__((ext_vector_type(2))); typedef __bf16 bf16x2_t __attribute__((ext_vector_type(2)));
__device__ __forceinline__ unsigned cvtpk_s(float lo,float hi){f32x2_t v={lo,hi};bf16x2_t b=__builtin_convertvector(v,bf16x2_t);return __builtin_bit_cast(unsigned,b);}
#define WAIT_BAR(N) asm volatile("s_waitcnt vmcnt(" #N ") lgkmcnt(0)\n\ts_barrier":::"memory")

__device__ __forceinline__ void qkt(f32x16&p0,f32x16&p1,const char*Kslot,const __attribute__((address_space(3))) char*qst,const f32x16&cin0,const f32x16&cin1,int r32,int hi){
  #define QF_(i) (*(const __attribute__((address_space(3))) bf16x8*)(qst+(i)*1024))
  const char*kb=Kslot+hi*1024+r32*16;
  #pragma unroll
  for(int d0=0;d0<4;++d0){
    const bf16x8 b0=*reinterpret_cast<const bf16x8*>(kb+d0*2048);
    const bf16x8 b1=*reinterpret_cast<const bf16x8*>(kb+d0*2048+512);
    const bf16x8 qd=QF_(d0);
    if(d0==0){p0=__builtin_amdgcn_mfma_f32_32x32x16_bf16(b0,qd,cin0,0,0,0);p1=__builtin_amdgcn_mfma_f32_32x32x16_bf16(b1,qd,cin1,0,0,0);}
    else{p0=__builtin_amdgcn_mfma_f32_32x32x16_bf16(b0,qd,p0,0,0,0);p1=__builtin_amdgcn_mfma_f32_32x32x16_bf16(b1,qd,p1,0,0,0);}}
  #undef QF_
}
typedef __attribute__((address_space(3))) const char* lds_cptr;
typedef short v4i16_t __attribute__((ext_vector_type(4)));
__device__ __forceinline__ void kload8(bf16x8*kf,lds_cptr kp){
  kf[0]=*(const __attribute__((address_space(3))) bf16x8*)(kp);      kf[1]=*(const __attribute__((address_space(3))) bf16x8*)(kp+512);
  kf[2]=*(const __attribute__((address_space(3))) bf16x8*)(kp+2048); kf[3]=*(const __attribute__((address_space(3))) bf16x8*)(kp+2560);
  kf[4]=*(const __attribute__((address_space(3))) bf16x8*)(kp+4096); kf[5]=*(const __attribute__((address_space(3))) bf16x8*)(kp+4608);
  kf[6]=*(const __attribute__((address_space(3))) bf16x8*)(kp+6144); kf[7]=*(const __attribute__((address_space(3))) bf16x8*)(kp+6656);
}
__device__ __forceinline__ void kload2(bf16x8*kf,lds_cptr kp,int j){ kf[2*j]=*(const __attribute__((address_space(3))) bf16x8*)(kp+j*2048); kf[2*j+1]=*(const __attribute__((address_space(3))) bf16x8*)(kp+j*2048+512); }
__device__ __forceinline__ s16x4 vtr(lds_cptr p){ return __builtin_bit_cast(s16x4,__builtin_amdgcn_ds_read_tr16_b64_v4i16((__attribute__((address_space(3))) v4i16_t*)p)); }
__device__ __forceinline__ float rowmax(const f32x16&p0,const f32x16&p1){
  float a=max3f(p0[0],p0[1],p1[0]),b=max3f(p0[2],p0[3],p1[1]);a=max3f(a,p1[2],p1[3]);
  #pragma unroll
  for(int r=4;r<16;r+=4){a=max3f(a,p0[r],p0[r+1]);b=max3f(b,p0[r+2],p0[r+3]);a=max3f(a,p1[r],p1[r+1]);b=max3f(b,p1[r+2],p1[r+3]);}
  const float m=max2f(a,b);
  auto rr=__builtin_amdgcn_permlane32_swap(__float_as_uint(m),__float_as_uint(m),false,false);
  return max2f(__uint_as_float(rr[0]),__uint_as_float(rr[1]));
}
__device__ __forceinline__ void pv(f32x16*o,int vb,bf16x8 pa0,bf16x8 pa1,bf16x8 pa2,bf16x8 pa3){
  #pragma unroll
  for(int d0=0;d0<2;++d0){s16x4 lo[4],hi[4];
    #pragma unroll
    for(int ks=0;ks<4;++ks){
      asm volatile("ds_read_b64_tr_b16 %0,%1 offset:%c2":"=&v"(lo[ks]):"v"(vb),"i"(d0*4096+ks*1024):"memory");
      asm volatile("ds_read_b64_tr_b16 %0,%1 offset:%c2":"=&v"(hi[ks]):"v"(vb),"i"(d0*4096+ks*1024+512):"memory");}
    asm volatile("s_waitcnt lgkmcnt(0)":::"memory");SBAR();
    #define PK(k) (bf16x8){lo[k][0],lo[k][1],lo[k][2],lo[k][3],hi[k][0],hi[k][1],hi[k][2],hi[k][3]}
    o[d0]=__builtin_amdgcn_mfma_f32_32x32x16_bf16(pa0,PK(0),o[d0],0,0,0);
    o[d0]=__builtin_amdgcn_mfma_f32_32x32x16_bf16(pa1,PK(1),o[d0],0,0,0);
    o[d0]=__builtin_amdgcn_mfma_f32_32x32x16_bf16(pa2,PK(2),o[d0],0,0,0);
    o[d0]=__builtin_amdgcn_mfma_f32_32x32x16_bf16(pa3,PK(3),o[d0],0,0,0);
    #undef PK
  }
}

#ifndef ATTN_STORE16
#define ATTN_STORE16(p,v) (*(u32x4*)(p)=(v))
#endif
template<int THRL> __device__ __forceinline__ void attn_unit(int h,int qb,int jstart,const bf16*Q,const bf16*__restrict__ K,const bf16*__restrict__ V,const bf16*__restrict__ OG,bf16*O,const float*__restrict__ C2h,char*shm){
  const int tid=threadIdx.x,lane=tid&63,r32=lane&31,hi=lane>>5; const int wid=__builtin_amdgcn_readfirstlane(tid>>6);
  const long rowbase=0; const int q0=qb*QB;
  const bf16*Qw=Q+(rowbase+q0+wid*QBLK)*DM+h*D;
  const bf16*Kh=K+(rowbase+(long)jstart*KVBLK)*DM+h*D,*Vh=V+(rowbase+(long)jstart*KVBLK)*DM+h*D;
  const lds_cptr shm3=(lds_cptr)shm;
  const unsigned lds0=(unsigned)(uintptr_t)shm;
  float*wsf=(float*)(shm+LDS_WS)+wid*64;
  const bf16*ksrc=Kh+(long)lane*DM+wid*8;
  const bf16*vsrc=Vh+(long)(16*(wid&3)+(lane>>2))*DM+(wid>>2)*32+(lane&3)*8;
  const unsigned kdst=lds0+LDS_K+wid*1024, vdst=lds0+LDS_V+wid*1024;
  #define DMA_K(t,slot) glds16(ksrc+(long)(t)*KVBLK*DM,(unsigned)__builtin_amdgcn_readfirstlane(kdst+(slot)))
  #define DMA_V(t,slot) glds16(vsrc+(long)(t)*KVBLK*DM,(unsigned)__builtin_amdgcn_readfirstlane(vdst+(slot)))
  const int vb0=(int)(lds0+LDS_V)+((lane>>4)&1)*32+(lane&3)*8+(4*hi+((lane&15)>>2))*64;
  const char*Kbase=shm+LDS_K; bf16x8 kf[8];
  const lds_cptr kp0=shm3+LDS_K+hi*1024+r32*16; const lds_cptr vp0=shm3+LDS_V+((lane>>4)&1)*32+(lane&3)*8+(4*hi+((lane&15)>>2))*64;
  const int NT=(q0+QB)/KVBLK-jstart;
  DMA_K(0,0);DMA_V(0,0);DMA_K(1,SLOTB);
  typedef __attribute__((address_space(3))) u32x4* lds_rptr; const lds_rptr brec=(lds_rptr)(shm3+LDS_BYTES);
  { const float cref=C2h[q0]; const float*cs=C2h+(long)jstart*KVBLK;
    int tid_e=tid; asm volatile("":"+v"(tid_e));
    for(int i_=tid_e;i_<NT*KVBLK;i_+=NW*64){ const float x_=cref-cs[i_]; const unsigned a1_=f2bf(x_); const float r1_=x_-__uint_as_float(a1_<<16); const unsigned a2_=f2bf(r1_); const float r2_=r1_-__uint_as_float(a2_<<16); const unsigned a3_=f2bf(r2_);
      brec[i_]=(u32x4){a1_|(a2_<<16),a3_,0u,0u}; }
    if(tid==0)brec[NT*KVBLK]=(u32x4){0x3F803F80u,0x00003F80u,0u,0u}; }
  const lds_cptr abp=(lds_cptr)brec+(hi?NT*KVBLK*16:r32*16); const int ast=hi?0:KVBLK*16, ab1=hi?0:32*16;
  #define ABF(t,half) (*(const __attribute__((address_space(3))) bf16x8*)(abp+(t)*ast+(half)*ab1))
  const lds_cptr qst=shm3+LDS_OST+wid*4096+lane*16;
  #pragma unroll
  for(int d0=0;d0<4;++d0){ const u32x4 qv_=*reinterpret_cast<const u32x4*>(&Qw[(long)r32*DM+d0*16+hi*8]); *(__attribute__((address_space(3))) u32x4*)(const_cast<__attribute__((address_space(3))) char*>(qst)+d0*1024)=qv_; }
  #define QF(i) (*(const __attribute__((address_space(3))) bf16x8*)(qst+(i)*1024))
  float mhat=0.f,l_reg=0.f;f32x16 o[2];o[0]=f32x16{};o[1]=f32x16{};
  u32x4 bmw=hi?(u32x4){0u,0u,0u,0u}:(u32x4){0x3F803F80u,0x00003F80u,0u,0u};
  #define SETBM() do{ const float nm_=-mhat; const unsigned a1_=f2bf(nm_); const float r1_=nm_-__uint_as_float(a1_<<16); const unsigned a2_=f2bf(r1_); const float r2_=r1_-__uint_as_float(a2_<<16); const unsigned a3_=f2bf(r2_); if(hi){bmw[0]=a1_|(a2_<<16);bmw[1]=a3_;} }while(0)
  #define BMF() __builtin_bit_cast(bf16x8,bmw)
  const f32x16 zero16=f32x16{};
  const int qrel=wid*QBLK+r32;
  #define CMASK(P0,P1,t) do{int jb_=(t)-(NT-4); if(jb_>=0)cmask(P0,P1,jb_,qrel,hi);}while(0)
  bool resc=false;
  #define START(P0,P1) do{ const float rm=rowmax(P0,P1); resc=false; \
    { const float dl=rm; mhat=fadd_s(mhat,dl); \
      _Pragma("unroll") for(int r=0;r<16;++r){P0[r]=fsub_s(P0[r],dl);P1[r]=fsub_s(P1[r],dl);} \
      SETBM(); } \
    _Pragma("unroll") for(int r=0;r<16;++r)P0[r]=__builtin_amdgcn_exp2f(P0[r]); }while(0)
  #define RESC() do{ if(resc){ asm volatile("s_waitcnt lgkmcnt(0)":::"memory"); \
      _Pragma("unroll") for(int d_=0;d_<2;++d_) _Pragma("unroll") for(int r=0;r<16;++r)o[d_][r]*=wsf[crow(r,hi)]; } }while(0)
  f32x16 pA0,pA1,pB0,pB1;
  int sl_prev=0,sl_cur=0,sl_next=SLOTB;
  #define ROT() do{sl_prev=sl_cur;sl_cur=sl_next;sl_next=(sl_next==(NSLOT-1)*SLOTB)?0:sl_next+SLOTB;}while(0)
  DMA_K(2,2*SLOTB);
  WAIT_BAR(3);
  { const f32x16 c0_=__builtin_amdgcn_mfma_f32_32x32x16_bf16(ABF(0,0),BMF(),zero16,0,0,0), c1_=__builtin_amdgcn_mfma_f32_32x32x16_bf16(ABF(0,1),BMF(),zero16,0,0,0); qkt(pA0,pA1,Kbase,qst,c0_,c1_,r32,hi); }
  asm volatile("s_nop 15\n\ts_nop 7":"+v"(pA0),"+v"(pA1));CMASK(pA0,pA1,0);
  START(pA0,pA1);
  _Pragma("unroll") for(int r=0;r<16;++r)pA1[r]=__builtin_amdgcn_exp2f(pA1[r]);
  WAIT_BAR(0);
  DMA_K(3,0);DMA_V(1,SLOTB);
  ROT();
  kload8(kf,kp0+sl_cur);
  WAIT_BAR(2);
  s16x4 vlo[8],vhi[8]; u32x4 pw0,pw1,pw2,pw3;
  #define PKW(P,B) cvtpk_s(P[B],P[B+1])
  #define PAF(k) __builtin_bit_cast(bf16x8,pw##k)
  #define VFR(i) (bf16x8){vlo[i][0],vlo[i][1],vlo[i][2],vlo[i][3],vhi[i][0],vhi[i][1],vhi[i][2],vhi[i][3]}
  #define PIN(x) asm volatile("":"+v"(x))
  #define MX3(a,b,c) __builtin_fmaxf(__builtin_fmaxf((a),(b)),(c))
  #define GAPA(MF,A0,A1,A2,A3,W0,W1,PW) do{ MF; sacc+=A0; sacc+=A1; sacc+=A2; sacc+=A3; PIN(sacc); W0; W1; PIN(PW); SBAR(); }while(0)
  #define EX(v) __builtin_amdgcn_exp2f(v)
  #define GAPB(MF,X,B) do{ MF; X[B]=EX(X[B]); X[B+1]=EX(X[B+1]); X[B+2]=EX(X[B+2]); X[B+3]=EX(X[B+3]); PIN(X); SBAR(); }while(0)
  #define VRD(i) do{ vlo[i]=vtr(vp_+(((i)>>2)*4096+((i)&3)*1024)); vhi[i]=vtr(vp_+(((i)>>2)*4096+((i)&3)*1024+512)); }while(0)
  #define KRD(G,j) do{ if(G){ kload2(kf,kp0+sl_next,j); SBAR(); } }while(0)
  #define STEP(C0,C1,P0,P1,t,GK,GV,GL) do{ SBAR(); \
    const lds_cptr vp_=vp0+sl_prev; \
    VRD(0); SBAR(); float sacc=(P0[0]+P0[1]); \
    C0=__builtin_amdgcn_mfma_f32_32x32x16_bf16(ABF(t,0),BMF(),zero16,0,0,0); C1=__builtin_amdgcn_mfma_f32_32x32x16_bf16(ABF(t,1),BMF(),zero16,0,0,0); SBAR(); \
    GAPA(C0=__builtin_amdgcn_mfma_f32_32x32x16_bf16(kf[0],QF(0),C0,0,0,0), P0[2],P0[3],P0[4],P0[5],     pw0[0]=PKW(P0,0), pw0[1]=PKW(P0,2), pw0); \
    VRD(4); SBAR(); GAPA(C1=__builtin_amdgcn_mfma_f32_32x32x16_bf16(kf[1],QF(0),C1,0,0,0), P0[6],P0[7],P0[8],P0[9],     pw0[2]=PKW(P0,4), pw0[3]=PKW(P0,6), pw0); \
    VRD(1); SBAR(); GAPA(C0=__builtin_amdgcn_mfma_f32_32x32x16_bf16(kf[2],QF(1),C0,0,0,0),   P0[10],P0[11],P0[12],P0[13], pw1[0]=PKW(P0,8), pw1[1]=PKW(P0,10), pw1); \
    VRD(5); SBAR(); GAPA(C1=__builtin_amdgcn_mfma_f32_32x32x16_bf16(kf[3],QF(1),C1,0,0,0),   P0[14],P0[15],P1[0],P1[1],   pw1[2]=PKW(P0,12),pw1[3]=PKW(P0,14), pw1); \
    VRD(2); SBAR(); GAPA(C0=__builtin_amdgcn_mfma_f32_32x32x16_bf16(kf[4],QF(2),C0,0,0,0),   P1[2],P1[3],P1[4],P1[5],     pw2[0]=PKW(P1,0), pw2[1]=PKW(P1,2), pw2); \
    VRD(6); SBAR(); GAPA(C1=__builtin_amdgcn_mfma_f32_32x32x16_bf16(kf[5],QF(2),C1,0,0,0),   P1[6],P1[7],P1[8],P1[9],     pw2[2]=PKW(P1,4), pw2[3]=PKW(P1,6), pw2); \
    VRD(3); SBAR(); GAPA(C0=__builtin_amdgcn_mfma_f32_32x32x16_bf16(kf[6],QF(3),C0,0,0,0),   P1[10],P1[11],P1[12],P1[13], pw3[0]=PKW(P1,8), pw3[1]=PKW(P1,10), pw3); \
    VRD(7); SBAR(); GAPA(C1=__builtin_amdgcn_mfma_f32_32x32x16_bf16(kf[7],QF(3),C1,0,0,0),   P1[14],P1[15],0.f,0.f,       pw3[2]=PKW(P1,12),pw3[3]=PKW(P1,14), pw3); \
    l_reg+=sacc; \
    if(GK){DMA_K((t)+3,sl_cur);} if(GV){DMA_V((t)+1,sl_next);} \
    CMASK(C0,C1,t); \
    { float a=MX3(C0[0],C0[1],C1[0]),b=MX3(C0[2],C0[3],C1[1]); a=MX3(a,C1[2],C1[3]); \
      _Pragma("unroll") for(int r=4;r<16;r+=4){a=MX3(a,C0[r],C0[r+1]);b=MX3(b,C0[r+2],C0[r+3]);a=MX3(a,C1[r],C1[r+1]);b=MX3(b,C1[r+2],C1[r+3]);} \
      float rm=__builtin_fmaxf(a,b); { auto rr=__builtin_amdgcn_permlane32_swap(__float_as_uint(rm),__float_as_uint(rm),false,false); rm=__builtin_fmaxf(__uint_as_float(rr[0]),__uint_as_float(rr[1])); } \
      resc=false; \
      if(__builtin_expect(__any(rm>(float)THRL),0)){ const float dl=__builtin_fmaxf(rm,0.f); mhat+=dl; \
        _Pragma("unroll") for(int r=0;r<16;++r){C0[r]-=dl;C1[r]-=dl;} \
        SETBM(); \
        const float f=__builtin_amdgcn_exp2f(-dl); l_reg*=f; if(hi==0)wsf[r32]=f; resc=true; } } \
    SBAR(); \
    GAPB(o[0]=__builtin_amdgcn_mfma_f32_32x32x16_bf16(PAF(0),VFR(0),o[0],0,0,0), C0,0); \
    GAPB(o[1]=__builtin_amdgcn_mfma_f32_32x32x16_bf16(PAF(0),VFR(4),o[1],0,0,0), C0,4); \
    KRD(GL,0); GAPB(o[0]=__builtin_amdgcn_mfma_f32_32x32x16_bf16(PAF(1),VFR(1),o[0],0,0,0), C0,8); \
    KRD(GL,1); GAPB(o[1]=__builtin_amdgcn_mfma_f32_32x32x16_bf16(PAF(1),VFR(5),o[1],0,0,0), C0,12); \
    KRD(GL,2); GAPB(o[0]=__builtin_amdgcn_mfma_f32_32x32x16_bf16(PAF(2),VFR(2),o[0],0,0,0), C1,0); \
    KRD(GL,3); GAPB(o[1]=__builtin_amdgcn_mfma_f32_32x32x16_bf16(PAF(2),VFR(6),o[1],0,0,0), C1,4); \
    GAPB(o[0]=__builtin_amdgcn_mfma_f32_32x32x16_bf16(PAF(3),VFR(3),o[0],0,0,0), C1,8); \
    GAPB(o[1]=__builtin_amdgcn_mfma_f32_32x32x16_bf16(PAF(3),VFR(7),o[1],0,0,0), C1,12); \
    }while(0)
  int t=1;
  #undef CMASK
  #define CMASK(P0,P1,t) do{}while(0)
  for(;t+5<NT;t+=2){
    STEP(pB0,pB1,pA0,pA1,t,true,true,true);     WAIT_BAR(2); RESC(); ROT();
    STEP(pA0,pA1,pB0,pB1,t+1,true,true,true);   WAIT_BAR(2); RESC(); ROT();
  }
  #undef CMASK
  #define CMASK(P0,P1,t) do{int jb_=(t)-(NT-4); if(jb_>=0)cmask(P0,P1,jb_,qrel,hi);}while(0)
  #define ENDW(tt) do{ if((tt)+3<NT){WAIT_BAR(2);} else if((tt)+2<NT){WAIT_BAR(1);} else {WAIT_BAR(0);} }while(0)
  for(;t+1<NT;t+=2){
    STEP(pB0,pB1,pA0,pA1,t,(t+3<NT),(t+1<NT),(t+1<NT));       ENDW(t);   RESC(); ROT();
    STEP(pA0,pA1,pB0,pB1,t+1,(t+4<NT),(t+2<NT),(t+2<NT));     ENDW(t+1); RESC(); ROT();
  }
  STEP(pB0,pB1,pA0,pA1,NT-1,false,false,false); RESC();
  { float sacc=pB0[0]+pB0[1]; _Pragma("unroll") for(int r=2;r<16;++r)sacc+=pB0[r]; _Pragma("unroll") for(int r=0;r<16;++r)sacc+=pB1[r]; l_reg+=sacc;
    pw0=(u32x4){PKW(pB0,0),PKW(pB0,2),PKW(pB0,4),PKW(pB0,6)};pw1=(u32x4){PKW(pB0,8),PKW(pB0,10),PKW(pB0,12),PKW(pB0,14)};pw2=(u32x4){PKW(pB1,0),PKW(pB1,2),PKW(pB1,4),PKW(pB1,6)};pw3=(u32x4){PKW(pB1,8),PKW(pB1,10),PKW(pB1,12),PKW(pB1,14)};
    SBAR(); pv(o,vb0+sl_cur,PAF(0),PAF(1),PAF(2),PAF(3)); }
  #undef PKW
  #undef PAF
  #undef VFR
  #undef PIN
  #undef MX3
  #undef GAPA
  #undef GAPB
  #undef EX
  #undef VRD
  #undef KRD
  #undef STEP
  #undef ENDW
  {auto rr=__builtin_amdgcn_permlane32_swap(__float_as_uint(l_reg),__float_as_uint(l_reg),false,false);l_reg=__uint_as_float(rr[0])+__uint_as_float(rr[1]);}
  int lane_e=lane; asm volatile("":"+v"(lane_e));
  const int r32e=lane_e&31,hie=lane_e>>5;
  if(hie==0)wsf[32+r32e]=l_reg;asm volatile("s_waitcnt lgkmcnt(0)":::"memory");
  float rli[16];
  #pragma unroll
  for(int r=0;r<16;++r)rli[r]=__builtin_amdgcn_rcpf(wsf[32+crow(r,hie)]);
  bf16*Ow=O+(rowbase+q0+wid*QBLK)*OM+h*D; const bf16*OGw=OG+(rowbase+q0+wid*QBLK)*DM+h*D;
  { bf16*stg=(bf16*)(shm+LDS_OST)+wid*2048;
    #pragma unroll
    for(int r=0;r<16;++r){const int orow=crow(r,hie);
      #pragma unroll
      for(int d0=0;d0<2;++d0)stg[orow*64+d0*32+r32e]=(bf16)f2bf(o[d0][r]*rli[r]);}
    asm volatile("s_waitcnt lgkmcnt(0)":::"memory");
    #pragma unroll
    for(int i=0;i<4;++i){const int row=i*8+(lane_e>>3),ch=lane_e&7; const u32x4 v=*(const u32x4*)(stg+row*64+ch*8); const u32x4 g=*(const u32x4*)(OGw+(long)row*DM+ch*8); u32x4 w;
      #pragma unroll
      for(int e=0;e<4;++e){ const float lo=bflo(v[e])*sigmoidf_(bflo(g[e])), hh_=bfhi(v[e])*sigmoidf_(bfhi(g[e])); w[e]=pk2(lo,hh_); }
      ATTN_STORE16(Ow+(long)row*OM+ch*8,w);} }
  asm volatile("s_waitcnt lgkmcnt(0)\n\ts_barrier":::"memory");
  #undef QF
  #undef ABF
  #undef SETBM
  #undef BMF
  #undef DMA_K
  #undef DMA_V
  #undef CMASK
  #undef START
  #undef RESC
  #undef ROT
}
constexpr int ATTN_LDS_BYTES=LDS_BYTES;
#undef SBAR
#undef WAIT_BAR
}

constexpr int KP = 144;
__device__ __forceinline__ void p14_attention(Frame& F, const Args& a, int qword = CW_ATTQ) {
    const int tid0 = F.tid, lane0 = F.lane;
    const bf16* QKVG = (const bf16*)(F.ws + WS_QKVG); const float* C2 = (const float*)(F.ws + WS_C2); const float* CB = (const float*)(F.ws + WS_CB);
    bf16* Z2 = (bf16*)(F.ws + WS_Z2);
    LAS unsigned char* Ks = F.lds; LAS unsigned char* Vs = F.lds + 64 * KP; LAS float* bias = (LAS float*)(F.lds + 2 * 64 * KP); LAS int* uslot = (LAS int*)(F.lds + RING_BYTES + 192);
    constexpr int ATT_MAXT = (RING_BYTES - attn_body::ATTN_LDS_BYTES - 16) / 1024;
    float mq = 0.f, mk = 0.f;
    for (int i = 0; i < 64; ++i) { mq = fmaxf(mq, fabsf(a.in[21][i])); mk = fmaxf(mk, fabsf(a.in[22][i])); }
    const float THR2 = (2.f * 8.f * mq * mk * 1.01f + 30.f) * LOG2E;
    gu32* qctr = F.ctl + qword;
    for (;;) {
        __syncthreads();
        if (tid0 == 0) uslot[0] = (int)__hip_atomic_fetch_add(qctr, 1u, RLX_AGENT);
        __syncthreads();
        const int unit = uslot[0];
        if (unit >= NH * (T / 256)) break;
        const int h = unit & 15, qb = (T / 256 - 1) - (unit >> 4), q0 = qb * 256;
        const float ct0 = C2[(size_t)h * T + q0];
        int jstart = 0;
        { int tot = 0; for (int j0 = 0; j0 < 4 * qb; j0 += 64) { const int j = j0 + lane0; const bool skip = (j < 4 * qb) && ((ct0 - CB[h * 256 + j]) < -THR2); tot += __popcll(__ballot(skip)); } jstart = tot; }
        jstart &= ~1;
        if (4 * qb + 4 - jstart <= ATT_MAXT) {
            attn_body::attn_unit<8>(h, qb, jstart, QKVG, QKVG + D, QKVG + 2 * D, QKVG + 3 * D, Z2, C2 + (size_t)h * T, (char*)F.lds);
            continue;
        }
        int tid_s = F.tid; asm volatile("" : "+v"(tid_s));
        const int tid = tid_s, lane = tid & 63, wid = F.wave, r32 = lane & 31, hi = lane >> 5;
        const int jend = 4 * qb + 3;
        const int qrow = q0 + wid * 32 + r32;
        bf16x8 qr[4];
#pragma unroll
        for (int d0 = 0; d0 < 4; ++d0) qr[d0] = *(const bf16x8*)(QKVG + (size_t)qrow * 4096 + h * 64 + d0 * 16 + hi * 8);
        f32x16 o0 = {}, o1 = {}; float m = -INFINITY, l = 0.f;
        const int lrow = tid >> 3, lch = tid & 7;
        u32x4 kreg, vreg; float breg = 0.f;
        auto gload = [&](int j) { const size_t row = (size_t)(64 * j + lrow) * 4096 + h * 64 + lch * 8;
            kreg = *(const u32x4*)(QKVG + row + D); vreg = *(const u32x4*)(QKVG + row + 2 * D); if (tid < 64) breg = -C2[(size_t)h * T + 64 * j + tid]; };
        gload(jstart);
        for (int j = jstart; j <= jend; ++j) {
            __syncthreads();
            *(LAS u32x4*)(Ks + lrow * KP + lch * 16) = kreg;
            { const int s_ = lrow >> 4, x_ = lrow & 15, p_ = s_ * 16 + ((x_ >> 2) & 1) * 8 + (((x_ >> 3) << 2) | (x_ & 3));
                const unsigned w_[4] = {vreg.x, vreg.y, vreg.z, vreg.w};
#pragma unroll
                for (int e = 0; e < 8; ++e) *(LAS unsigned short*)(Vs + (lch * 8 + e) * KP + p_ * 2) = (unsigned short)(w_[e >> 1] >> ((e & 1) * 16)); }
            if (tid < 64) bias[tid] = breg;
            __syncthreads();
            if (j < jend) gload(j + 1);
            f32x16 p0 = {}, p1 = {};
#pragma unroll
            for (int d0 = 0; d0 < 4; ++d0) {
                const bf16x8 k0 = *(const LAS bf16x8*)(Ks + r32 * KP + d0 * 32 + hi * 16);
                const bf16x8 k1 = *(const LAS bf16x8*)(Ks + (32 + r32) * KP + d0 * 32 + hi * 16);
                p0 = __builtin_amdgcn_mfma_f32_32x32x16_bf16(k0, qr[d0], p0, 0, 0, 0);
                p1 = __builtin_amdgcn_mfma_f32_32x32x16_bf16(k1, qr[d0], p1, 0, 0, 0);
            }
#pragma unroll
            for (int g4 = 0; g4 < 4; ++g4) { const f32x4 b0 = *(const LAS f32x4*)(bias + 8 * g4 + 4 * hi), b1 = *(const LAS f32x4*)(bias + 32 + 8 * g4 + 4 * hi);
#pragma unroll
                for (int i = 0; i < 4; ++i) { p0[4 * g4 + i] += b0[i]; p1[4 * g4 + i] += b1[i]; } }
            if (j >= 4 * qb) {
                const int kb = 64 * j;
#pragma unroll
                for (int r = 0; r < 16; ++r) { const int kv = kb + crow(r, hi); if (kv > qrow) p0[r] = -INFINITY; if (kv + 32 > qrow) p1[r] = -INFINITY; }
            }
            float mloc = fmaxf(p0[0], p1[0]);
#pragma unroll
            for (int r = 1; r < 16; ++r) mloc = fmaxf(mloc, fmaxf(p0[r], p1[r]));
            mloc = fmaxf(mloc, __shfl_xor(mloc, 32));
            const float mnew = fmaxf(m, mloc);
            const float alpha = exp2f(m - mnew);
            float ls = 0.f;
#pragma unroll
            for (int r = 0; r < 16; ++r) { p0[r] = exp2f(p0[r] - mnew); p1[r] = exp2f(p1[r] - mnew); ls += p0[r] + p1[r]; }
            l = l * alpha + ls; m = mnew;
#pragma unroll
            for (int r = 0; r < 16; ++r) { o0[r] *= alpha; o1[r] *= alpha; }
#pragma unroll
            for (int s = 0; s < 4; ++s) {
                u32x4 pw;
                if (s == 0) pw = (u32x4){pk2(p0[0], p0[1]), pk2(p0[2], p0[3]), pk2(p0[4], p0[5]), pk2(p0[6], p0[7])};
                else if (s == 1) pw = (u32x4){pk2(p0[8], p0[9]), pk2(p0[10], p0[11]), pk2(p0[12], p0[13]), pk2(p0[14], p0[15])};
                else if (s == 2) pw = (u32x4){pk2(p1[0], p1[1]), pk2(p1[2], p1[3]), pk2(p1[4], p1[5]), pk2(p1[6], p1[7])};
                else pw = (u32x4){pk2(p1[8], p1[9]), pk2(p1[10], p1[11]), pk2(p1[12], p1[13]), pk2(p1[14], p1[15])};
                const bf16x8 pf = __builtin_bit_cast(bf16x8, pw);
                const bf16x8 v0 = *(const LAS bf16x8*)(Vs + r32 * KP + s * 32 + hi * 16);
                const bf16x8 v1 = *(const LAS bf16x8*)(Vs + (32 + r32) * KP + s * 32 + hi * 16);
                o0 = __builtin_amdgcn_mfma_f32_32x32x16_bf16(v0, pf, o0, 0, 0, 0);
                o1 = __builtin_amdgcn_mfma_f32_32x32x16_bf16(v1, pf, o1, 0, 0, 0);
            }
        }
        l += __shfl_xor(l, 32);
        const float rl = 1.f / l;
#pragma unroll
        for (int dt = 0; dt < 2; ++dt)
#pragma unroll
            for (int g4 = 0; g4 < 4; ++g4) { const int d = 32 * dt + 8 * g4 + 4 * hi; const size_t col = (size_t)h * 64 + d;
                const u32x2 ogw = *(const u32x2*)(QKVG + (size_t)qrow * 4096 + 3 * D + col);
                const float og[4] = {bflo(ogw.x), bfhi(ogw.x), bflo(ogw.y), bfhi(ogw.y)}; float ov[4];
#pragma unroll
                for (int i = 0; i < 4; ++i) ov[i] = (dt == 0 ? o0[4 * g4 + i] : o1[4 * g4 + i]) * rl * sigmoidf_(og[i]);
                u32x2 w; w.x = pk2(ov[0], ov[1]); w.y = pk2(ov[2], ov[3]);
                *(u32x2*)(Z2 + (size_t)qrow * D + col) = w; }
    }
}

struct TokInfo { int e0, e1, p0, p1; float g0, g1; int d0, d1; };
__device__ __forceinline__ void p16_router(Frame& F, const Args& a) {
    const int lane = F.lane, tid = F.tid; const float* Hs = (const float*)(F.ws + WS_H); bf16* U = (bf16*)(F.ws + WS_U4);
    TokInfo* TI = (TokInfo*)(F.ws + WS_TOK);
    LAS float* wr_ = (LAS float*)F.lds;
    LAS int* lcnt = (LAS int*)(F.lds + 32768);
    const Row gr = ld_row(a.in[1] + 3 * D, lane);
    __syncthreads();
    for (int i = tid; i < NE * D; i += NTHREADS) { const int e = i & 7, k = i >> 3; wr_[e * D + k] = a.in[26][(size_t)k * NE + e]; }
    for (int tb = F.vcu * 64; tb < T; tb += F.G * 64) {
        __syncthreads();
        if (tid < 16) lcnt[tid] = 0;
        __syncthreads();
        int e0s[8], e1s[8], p0s[8], p1s[8]; float g0s[8];
#pragma unroll
        for (int q = 0; q < 8; ++q) { const int t = tb + F.wave * 8 + q;
            const Row u = rmsnorm_row(ld_row(Hs + (size_t)t * D, lane), gr);
            st_row_bf16(U + (size_t)t * D, lane, u);
            float lg[NE];
#pragma unroll
            for (int e = 0; e < NE; ++e) { float s = 0.f;
#pragma unroll
                for (int j = 0; j < 4; ++j) { const f32x4 w = *(const LAS f32x4*)(wr_ + e * D + 256 * j + 4 * lane); s += (u.v[j][0] * w[0] + u.v[j][1] * w[1]) + (u.v[j][2] * w[2] + u.v[j][3] * w[3]); }
                lg[e] = wave_sum(s); }
            int b0 = 0; float v0 = lg[0];
#pragma unroll
            for (int e = 1; e < NE; ++e) if (lg[e] > v0) { v0 = lg[e]; b0 = e; }
            int b1 = -1; float v1 = -INFINITY;
#pragma unroll
            for (int e = 0; e < NE; ++e) if (e != b0 && lg[e] > v1) { v1 = lg[e]; b1 = e; }
            e0s[q] = b0; e1s[q] = b1; g0s[q] = 1.f / (1.f + __expf(v1 - v0));
            int pa = 0, pb = 0;
            if (lane == 0) { pa = atomicAdd((int*)&lcnt[b0], 1); pb = atomicAdd((int*)&lcnt[b1], 1); }
            p0s[q] = pa; p1s[q] = pb;
        }
        __syncthreads();
        if (tid < NE) lcnt[8 + tid] = (int)__hip_atomic_fetch_add(F.ctl + CW_CNT + 64 * tid, (unsigned)lcnt[tid], RLX_AGENT);
        __syncthreads();
        if (lane == 0) {
#pragma unroll
            for (int q = 0; q < 8; ++q) { const int t = tb + F.wave * 8 + q; TokInfo ti; ti.e0 = e0s[q]; ti.e1 = e1s[q]; ti.p0 = lcnt[8 + e0s[q]] + p0s[q]; ti.p1 = lcnt[8 + e1s[q]] + p1s[q];
                ti.g0 = g0s[q]; ti.g1 = 1.f - g0s[q]; ti.d0 = 0; ti.d1 = 0; TI[t] = ti; }
        }
    }
    __syncthreads();
}
__device__ __forceinline__ int moe_ends(Frame& F, LAS int* ends) {
    __syncthreads();
    if (F.tid == 0) { int run = 0; for (int e = 0; e < NE; ++e) { const int c = (int)__hip_atomic_load(F.ctl + CW_CNT + 64 * e, RLX_AGENT); run += (c + 255) >> 8; ends[e] = run; } }
    __syncthreads();
    return ends[NE - 1];
}
__device__ __forceinline__ void p17_gather(Frame& F) {
    LAS int* ends = (LAS int*)(F.lds + RING_BYTES);
    moe_ends(F, ends);
    const bf16* U = (const bf16*)(F.ws + WS_U4); bf16* AM = (bf16*)(F.ws + WS_AM); TokInfo* TI = (TokInfo*)(F.ws + WS_TOK);
    for (int t = F.gw; t < T; t += F.NGW) {
        const TokInfo ti = TI[t];
        const int d0 = (ti.e0 ? ends[ti.e0 - 1] : 0) * 256 + ti.p0, d1 = (ti.e1 ? ends[ti.e1 - 1] : 0) * 256 + ti.p1;
        const u32x4* src = (const u32x4*)(U + (size_t)t * D) + F.lane; const u32x4 x0 = src[0], x1 = src[64];
        u32x4* o0 = (u32x4*)(AM + (size_t)d0 * D) + F.lane; o0[0] = x0; o0[64] = x1;
        u32x4* o1 = (u32x4*)(AM + (size_t)d1 * D) + F.lane; o1[0] = x0; o1[64] = x1;
        if (F.lane == 0) { TI[t].d0 = d0; TI[t].d1 = d1; }
    }
}
__device__ __forceinline__ void p20_combine(Frame& F, const Args& a) {
    const int lane = F.lane; const float* Hs = (const float*)(F.ws + WS_H); const bf16* YS = (const bf16*)(F.ws + WS_YS); const TokInfo* TI = (const TokInfo*)(F.ws + WS_TOK);
    const Row gr = ld_row(a.in[2], lane);
    for (int t = F.gw; t < T; t += F.NGW) {
        const TokInfo ti = TI[t];
        Row hrow = ld_row(Hs + (size_t)t * D, lane); const Row y0 = ld_row_bf16(YS + (size_t)ti.d0 * D, lane), y1 = ld_row_bf16(YS + (size_t)ti.d1 * D, lane);
#pragma unroll
        for (int j = 0; j < 4; ++j) hrow.v[j] = hrow.v[j] + ti.g0 * y0.v[j] + ti.g1 * y1.v[j];
        st_row(a.out + (size_t)t * D, lane, rmsnorm_row(hrow, gr));
    }
}

constexpr int N_PHASES = 21;
__global__ void __launch_bounds__(NTHREADS, 2) trunk_fwd(Args args) {
    extern __shared__ __attribute__((aligned(16))) unsigned char lds_raw[];
    Frame F;
    F.lds = (LAS unsigned char*)lds_raw; F.ws = args.ws; F.ctl = (gu32*)(args.ws + WS_CTL);
    F.tid = threadIdx.x; F.lane = F.tid & 63; F.wave = __builtin_amdgcn_readfirstlane(F.tid >> 6);
    F.G = gridDim.x; { const int bx = blockIdx.x; F.vcu = (F.G % 8 == 0) ? (bx % 8) * (F.G / 8) + bx / 8 : bx; }
    F.gw = F.vcu * NWAVES + F.wave; F.NGW = F.G * NWAVES;
    volatile LAS unsigned* MISC = (volatile LAS unsigned*)(F.lds + MISC_OFF);
    for (int u = F.tid; u < (LDS_BYTES - RING_BYTES) / 4; u += NTHREADS) ((LAS unsigned*)(F.lds + RING_BYTES))[u] = 0u;
    __syncthreads();
    const int lo = args.ph_lo, hi = args.ph_hi;
    const bool use_bar = (hi - lo) > 1;
    XcdBarrier bar; bar.bar = (unsigned*)(F.ctl + CW_BAR); bar.x = 0; bar.st = nullptr;
    if (use_bar) bar = xcd_barrier_post((unsigned*)(F.ctl + CW_BAR), MISC + 8);
#ifdef ONLY_PHASE
#define IN(k) ((k) == ONLY_PHASE && lo <= (k) && (k) < hi)
#else
#define IN(k) (lo <= (k) && (k) < hi)
#endif
#define SEAM(k) do { if (IN((k) + 1)) xcd_barrier(bar); } while (0)
#define REP(k) for (int rep_ = 0; rep_ < ((DUP_PHASE == (k)) ? 2 : 1); ++rep_, (void)((rep_ < ((DUP_PHASE == (k)) ? 2 : 1)) ? (xcd_barrier(bar), 0) : 0))
    unsigned char* ws = args.ws;
    const int c = (int)blockIdx.x;
    LAS unsigned char* ring = F.lds;

    if (IN(0)) REP(0) { p0_prologue(F, args); p1_shift(F, args); } SEAM(0);
    if (IN(1)) REP(1) {
        { pg8::Gemm g{D, D, D}; pg8::SchedRKV S; S.o.init(T / 256, 12, F.G, c); S.A = (const char*)(ws + WS_XS); S.B = (const char*)(ws + WS_W_RKV); S.astep = (size_t)256 * D * 2; S.bstep = (size_t)256 * D * 2; S.azstride = (size_t)T * D * 2;
          pg8::EpiRKV E{(bf16*)(ws + WS_R), (size_t)(WS_K - WS_R) / 2};
          pg8::gemm_phase<pg8::EpiRKV, pg8::SchedRKV, true>(ring, g, S, E); }
        { pg8::Gemm g{D, 2 * D, 2 * D}; pg8::SchedPlain S; S.o.init(T / 256, 1, F.G, c); S.A = (const char*)(ws + WS_UB); S.B = (const char*)(ws + WS_W_L1); S.astep = (size_t)256 * D * 2; S.bstep = (size_t)256 * 2 * D * 2;
          pg8::EpiL1 E{(bf16*)(ws + WS_L1)};
          pg8::gemm_phase<pg8::EpiL1, pg8::SchedPlain, true>(ring, g, S, E); }
        } SEAM(1);
    if (IN(2)) REP(2) {
        pg8::Gemm g{256, 256, 256}; pg8::SchedPlain S; S.o.init(T / 256, 12, F.G, c); S.A = (const char*)(ws + WS_L1); S.B = (const char*)(ws + WS_W_L2); S.astep = (size_t)256 * 256 * 2; S.bstep = (size_t)256 * 256 * 2;
        pg8::EpiL2 E{(float*)(ws + WS_LW), (bf16*)(ws + WS_AA), (bf16*)(ws + WS_G), args.in[5], args.in[8]};
        pg8::gemm_phase<pg8::EpiL2, pg8::SchedPlain, true>(ring, g, S, E);
        } SEAM(2);
    if (IN(3)) REP(3) { p3_prep(F, args); } SEAM(3);
    if (IN(4)) REP(4) { pa_chunk(F); } SEAM(4);
    if (IN(5)) REP(5) { pb_chain(F); } SEAM(5);
    if (IN(6)) REP(6) { pc_out(F, args); } SEAM(6);
    if (IN(7)) REP(7) {
        pg8::Gemm g{D, D, D}; pg8::SchedPlain S; S.o.init(T / 256, 4, F.G, c); S.A = (const char*)(ws + WS_Z); S.B = (const char*)(ws + WS_W_O0); S.astep = (size_t)256 * D * 2; S.bstep = (size_t)256 * D * 2;
        pg8::EpiRes E{args.in[0], (float*)(ws + WS_H)};
        pg8::gemm_phase<pg8::EpiRes, pg8::SchedPlain, true>(ring, g, S, E);
        } SEAM(7);
    if (IN(8)) REP(8) { p8_norm(F, args.in[1] + D, (bf16*)(ws + WS_U2)); } SEAM(8);
    if (IN(9)) REP(9) {
        pg8::Gemm g{D, D, D}; pg8::SchedPlain S; S.o.init(T / 256, 2 * FF / 256, F.G, c); S.A = (const char*)(ws + WS_U2); S.B = (const char*)(ws + WS_W_GU); S.astep = (size_t)256 * D * 2; S.bstep = (size_t)256 * D * 2;
        pg8::EpiSwiGLU E{(bf16*)(ws + WS_ACT)};
        pg8::gemm_phase<pg8::EpiSwiGLU, pg8::SchedPlain, true>(ring, g, S, E);
        }
    if (IN(9) && GEXP >= 0) {
        xcd_barrier(bar);
        pg8::Gemm g{D, D, D}; pg8::SchedExp S; S.o.init(T / 256, 2 * FF / 256, F.G, c); S.A = (const char*)(ws + WS_U2); S.B = (const char*)(ws + WS_W_GU); S.astep = (size_t)256 * D * 2; S.bstep = (size_t)256 * D * 2; S.mode = GEXP;
        if (GEXP == 2) { pg8::EpiNone E{(bf16*)(ws + WS_LW)}; pg8::gemm_phase<pg8::EpiNone, pg8::SchedExp, true>(ring, g, S, E); }
        else if (GEXP == 4) { pg8::EpiExpStore E{(bf16*)(ws + WS_LW)}; pg8::gemm_phase<pg8::EpiExpStore, pg8::SchedExp, true>(ring, g, S, E); }
        else if (GEXP == 5) { pg8::EpiExpMath E{(bf16*)(ws + WS_LW)}; pg8::gemm_phase<pg8::EpiExpMath, pg8::SchedExp, true>(ring, g, S, E); }
        else { pg8::EpiSwiGLU E{(bf16*)(ws + WS_LW)}; pg8::gemm_phase<pg8::EpiSwiGLU, pg8::SchedExp, true>(ring, g, S, E); }
    }
    SEAM(9);
    if (IN(10)) REP(10) {
        pg8::Gemm g{FF, FF, FF}; pg8::SchedPlain S; S.o.init(T / 256, 4, F.G, c); S.A = (const char*)(ws + WS_ACT); S.B = (const char*)(ws + WS_W_DN); S.astep = (size_t)256 * FF * 2; S.bstep = (size_t)256 * FF * 2;
        pg8::EpiRes E{(const float*)(ws + WS_H), rep_ ? (float*)(ws + WS_Y) : (float*)(ws + WS_H)};
        pg8::gemm_phase<pg8::EpiRes, pg8::SchedPlain, true>(ring, g, S, E);
        } SEAM(10);
    if (IN(11)) REP(11) { p11_norm_forget(F, args); } SEAM(11);
    if (IN(12)) REP(12) {
        pg8::Gemm g{D, D, D}; pg8::SchedPlain S; S.o.init(T / 256, 16, F.G, c); S.A = (const char*)(ws + WS_U3); S.B = (const char*)(ws + WS_W_IN); S.astep = (size_t)256 * D * 2; S.bstep = (size_t)256 * D * 2;
        pg8::EpiBf16 E{(bf16*)(ws + WS_QKVG), 4096};
        pg8::gemm_phase<pg8::EpiBf16, pg8::SchedPlain, true>(ring, g, S, E);
        } SEAM(12);
    if (IN(13)) REP(13) { p13_cumsum_qknorm(F, args); } SEAM(13);
    if (IN(14)) REP(14) { p14_attention(F, args, CW_ATTQ + 64 * rep_); } SEAM(14);
    if (IN(15)) REP(15) {
        pg8::Gemm g{D, D, D}; pg8::SchedPlain S; S.o.init(T / 256, 4, F.G, c); S.A = (const char*)(ws + WS_Z2); S.B = (const char*)(ws + WS_W_FO); S.astep = (size_t)256 * D * 2; S.bstep = (size_t)256 * D * 2;
        pg8::EpiRes E{(const float*)(ws + WS_H), rep_ ? (float*)(ws + WS_Y) : (float*)(ws + WS_H)};
        pg8::gemm_phase<pg8::EpiRes, pg8::SchedPlain, true>(ring, g, S, E);
        } SEAM(15);
    if (IN(16)) REP(16) { p16_router(F, args); } SEAM(16);
    if (IN(17)) REP(17) { p17_gather(F); } SEAM(17);
    if (IN(18)) REP(18) {
        LAS int* ends = (LAS int*)(F.lds + RING_BYTES); const int nblk = moe_ends(F, ends);
        pg8::Gemm g{D, D, D}; pg8::SchedMoe S; S.o.init(nblk, 2 * FF / 256, F.G, c); S.A = (const char*)(ws + WS_AM); S.B = (const char*)(ws + WS_W_MGU); S.astep = (size_t)256 * D * 2; S.bstep = (size_t)256 * D * 2; S.bestride = (size_t)2 * FF * D * 2; S.ends = ends;
        pg8::EpiSwiGLU E{(bf16*)(ws + WS_ACT2)};
        pg8::gemm_phase<pg8::EpiSwiGLU, pg8::SchedMoe, true>(ring, g, S, E);
        } SEAM(18);
    if (IN(19)) REP(19) {
        LAS int* ends = (LAS int*)(F.lds + RING_BYTES); const int nblk = moe_ends(F, ends);
        pg8::Gemm g{FF, FF, FF}; pg8::SchedMoe S; S.o.init(nblk, 4, F.G, c); S.A = (const char*)(ws + WS_ACT2); S.B = (const char*)(ws + WS_W_MDN); S.astep = (size_t)256 * FF * 2; S.bstep = (size_t)256 * FF * 2; S.bestride = (size_t)D * FF * 2; S.ends = ends;
        pg8::EpiBf16 E{(bf16*)(ws + WS_YS), D};
        pg8::gemm_phase<pg8::EpiBf16, pg8::SchedMoe, true>(ring, g, S, E);
        } SEAM(19);
    if (IN(20)) REP(20) { p20_combine(F, args); }
#undef IN
#undef SEAM
#undef REP
}

extern "C" void kernel_launch(void* const* d_in, const int* in_sizes, int n_in, void* d_out, int out_size, void* d_ws, size_t ws_size, hipStream_t stream) {
    static int grid = 0;
    if (grid == 0) {
        if (n_in != 29 || out_size != T * D || ws_size < WS_END) { fprintf(stderr, "kernel_launch: unexpected problem (n_in %d out %d ws %zu)\n", n_in, out_size, ws_size); grid = -1; return; }
        int dev = 0, cus = 0;
        if (hipGetDevice(&dev) != hipSuccess || hipDeviceGetAttribute(&cus, hipDeviceAttributeMultiprocessorCount, dev) != hipSuccess) { grid = -1; return; }
        if (hipFuncSetAttribute((const void*)trunk_fwd, hipFuncAttributeMaxDynamicSharedMemorySize, LDS_BYTES) != hipSuccess) { fprintf(stderr, "kernel_launch: hipFuncSetAttribute failed\n"); grid = -1; return; }
        int per_cu = 0;
        if (hipOccupancyMaxActiveBlocksPerMultiprocessor(&per_cu, (const void*)trunk_fwd, NTHREADS, LDS_BYTES) != hipSuccess || per_cu < 1) fprintf(stderr, "kernel_launch: occupancy query says %d\n", per_cu);
        (void)hipGetLastError();
        grid = cus;
    }
    if (grid < 0) return;
    (void)hipMemsetAsync((char*)d_ws + WS_CTL, 0, CTL_ZERO_BYTES, stream);
    Args a{};
    for (int i = 0; i < 29; ++i) a.in[i] = (const float*)d_in[i];
    a.out = (float*)d_out; a.ws = (unsigned char*)d_ws;
    constexpr int NPH = 21;
    if (LAUNCH_MODE == 1) { a.ph_lo = 0; a.ph_hi = NPH; hipLaunchKernelGGL(trunk_fwd, dim3(grid), dim3(NTHREADS), LDS_BYTES, stream, a); }
    else for (int p = 0; p < NPH; ++p) { a.ph_lo = p; a.ph_hi = p + 1; hipLaunchKernelGGL(trunk_fwd, dim3(grid), dim3(NTHREADS), LDS_BYTES, stream, a); }
}
```

```cpp
#include <hip/hip_runtime.h>
#include <cstdio>
#include <cstdint>

#ifndef LAUNCH_MODE
#define LAUNCH_MODE 1
#endif

#define GAS __attribute__((address_space(1)))
#define LAS __attribute__((address_space(3)))
typedef unsigned short bf16;
typedef short bf16x8 __attribute__((ext_vector_type(8)));
typedef float f32x4 __attribute__((ext_vector_type(4)));
typedef float f32x2 __attribute__((ext_vector_type(2)));
typedef float f32x16 __attribute__((ext_vector_type(16)));
typedef unsigned u32x4 __attribute__((ext_vector_type(4)));
typedef unsigned u32x2 __attribute__((ext_vector_type(2)));
typedef GAS unsigned gu32;
#define RLX_AGENT __ATOMIC_RELAXED, __HIP_MEMORY_SCOPE_AGENT

constexpr int T = 16384, D = 1024, NH = 16, HD = 64, FF = 3584, NE = 8, WIN_LD = 4 * D + NH;
constexpr int NWAVES = 8, NTHREADS = 512;
constexpr float RMS_EPS = 1e-6f, GN_EPS = 64e-5f;
constexpr int MOE_ROWS = (2 * T / 256 + NE) * 256;
constexpr int MOE_RB1 = 128, MOE_TKS = 7, MOE_TROWS = (MOE_ROWS / 256 - MOE_RB1) * 256;
constexpr int MOE_KS = 1;
constexpr float LOG2E = 1.4426950408889634f;

constexpr size_t MiB = 1u << 20;
constexpr size_t WS_CTL = 0, CTL_ZERO_BYTES = 1 * MiB;
constexpr size_t WS_W_RKV = 2 * MiB, WS_W_L1 = 8 * MiB, WS_W_L2 = 9 * MiB, WS_W_O0 = 11 * MiB, WS_W_GU = 13 * MiB, WS_W_DN = 27 * MiB,
                 WS_W_IN = 34 * MiB, WS_W_FO = 42 * MiB, WS_W_MGU = 44 * MiB, WS_W_MDN = 156 * MiB;
constexpr size_t WS_H = 216 * MiB;
constexpr size_t WS_UB = 280 * MiB, WS_XS = 313 * MiB;
constexpr size_t WS_KK = 280 * MiB, WS_BB = 344 * MiB;
constexpr size_t WS_Z = 410 * MiB  , WS_U2 = 344 * MiB;
constexpr size_t WS_U3 = 280 * MiB, WS_Z2 = 312 * MiB, WS_U4 = 280 * MiB, WS_AM = 312 * MiB;
constexpr size_t WS_R = 410 * MiB, WS_K = 474 * MiB, WS_V = 538 * MiB;
constexpr size_t WS_ACT = 410 * MiB;
constexpr size_t WS_QKVG = 410 * MiB;
constexpr size_t WS_ACT2 = 410 * MiB;
constexpr size_t WS_LW = 602 * MiB, WS_AA = 666 * MiB, WS_G = 730 * MiB;
constexpr size_t WS_YT = 666 * MiB;
constexpr size_t WS_YS = 666 * MiB;
constexpr size_t WS_YSK = 736 * MiB;
constexpr size_t WS_L1 = 794 * MiB;
constexpr size_t WS_CS = 802 * MiB;
constexpr size_t WS_LF = 806 * MiB, WS_C2 = 807 * MiB, WS_CB = 808 * MiB, WS_TOK = 809 * MiB;
constexpr size_t WS_END = 810 * MiB;
constexpr size_t WS_AT = 280 * MiB, WS_RT = 312 * MiB, WS_BH = 344 * MiB, WS_KH = 376 * MiB;
constexpr size_t WS_V16 = 538 * MiB  , WS_GC = 248 * MiB;
constexpr size_t WS_QM = 410 * MiB, WS_PLR = 474 * MiB, WS_TM = 506 * MiB, WS_S0 = 570 * MiB;
constexpr size_t WS_Y = 602 * MiB;
constexpr int NCH = T / 64;
constexpr int CW_TMO = 0, CW_BAR = 4096, CW_CNT = 8192, CW_ATTQ = 9216;

constexpr int RING_BYTES = 131072, MISC_OFF = RING_BYTES + 320, LDS_BYTES = 147456;

__device__ __forceinline__ unsigned f2bf(float f) { unsigned u = __builtin_bit_cast(unsigned, f); return (u + 0x7fffu + ((u >> 16) & 1u)) >> 16; }
__device__ __forceinline__ unsigned pk2(float lo, float hi) { return f2bf(lo) | (f2bf(hi) << 16); }
__device__ __forceinline__ float bf2f(unsigned short b) { return __builtin_bit_cast(float, (unsigned)b << 16); }
__device__ __forceinline__ float bflo(unsigned w) { return __builtin_bit_cast(float, w << 16); }
__device__ __forceinline__ float bfhi(unsigned w) { return __builtin_bit_cast(float, w & 0xffff0000u); }
template <int CTRL> __device__ __forceinline__ float dpp_mov(float x) {
    return __builtin_bit_cast(float, __builtin_amdgcn_mov_dpp(__builtin_bit_cast(int, x), CTRL, 0xf, 0xf, true)); }
__device__ __forceinline__ float row16_sum(float v) {
    v += dpp_mov<0xB1>(v); v += dpp_mov<0x4E>(v); v += dpp_mov<0x124>(v); v += dpp_mov<0x128>(v); return v; }
__device__ __forceinline__ float wave_sum(float v) {
    v = row16_sum(v); v += __shfl_xor(v, 16); v += __shfl_xor(v, 32); return v; }
__device__ __forceinline__ float sigmoidf_(float x) { return __builtin_amdgcn_rcpf(1.f + __builtin_amdgcn_exp2f(x * -1.4426950408889634f)); }
__device__ __forceinline__ float tanhf_(float x) { const float e = __builtin_amdgcn_exp2f(fminf(x * 2.8853900817779268f, 60.f)); return (e - 1.f) * __builtin_amdgcn_rcpf(e + 1.f); }
#define LDS_WAIT() asm volatile("s_waitcnt lgkmcnt(0)" ::: "memory")
__device__ __forceinline__ int crow(int r, int hi) { return (r & 3) + 8 * (r >> 2) + 4 * hi; }

namespace pg8 {
constexpr int BM = 256, BK = 64, HALF = 128, HTB = HALF * BK * 2, STAGE_BYTES = 8 * HTB, NXCD = 8, WGM = 8;
__host__ __device__ __forceinline__ int lds_byte(int r, int c) { const int st = (r >> 4) * 2 + (c >> 5), rr = r & 15, cc = c & 31, ob = rr * 64 + cc * 2; return st * 1024 + (ob ^ (((ob >> 9) & 1) << 5)); }
__host__ __device__ __forceinline__ void stage_rc(int b, int& R, int& C) { const int st = b / 1024, sb = b % 1024, swz = sb ^ (((sb >> 9) & 1) << 5); R = (st >> 1) * 16 + swz / 64; C = (st & 1) * 32 + (swz % 64) / 2; }
__host__ __device__ __forceinline__ int perm32(int rho) { const int n = rho >> 4, i = rho & 15; return 8 * (i >> 2) + 4 * n + (i & 3); }

struct Unit { int pm, pn; };
struct Gemm { int lda, ldb, K; };

struct TileOrder {
    int nM, nN, nwg, G, c, nlo, klo;
    __device__ __forceinline__ void init(int nM_, int nN_, int G_, int c_, int nlo_ = 0, int klo_ = 0) { nM = nM_; nN = nN_; nwg = nM * nN; G = G_; c = c_; nlo = nlo_; klo = klo_; }
    __device__ __forceinline__ bool tile(int i, Unit& u) const {
        long L;
        if (c < nlo) { if (i >= klo) return false; L = (long)(nwg - nlo * klo) + c + (long)nlo * i; }
        else { L = (long)i * (G - nlo) + (c - nlo); if (L >= nwg - nlo * klo) return false; }
        int wgid = (int)L; { const int q = nwg / NXCD, r = nwg % NXCD, xcd = wgid % NXCD, off = wgid / NXCD; wgid = (xcd < r ? xcd * (q + 1) : r * (q + 1) + (xcd - r) * q) + off; }
        const int nig = WGM * nN, gid = wgid / nig, fm = gid * WGM, gsz = (nM - fm) < WGM ? (nM - fm) : WGM;
        u.pm = fm + ((wgid % nig) % gsz); u.pn = (wgid % nig) / gsz; return true;
    }
};

__device__ __forceinline__ unsigned cvt_pk_bf16(float lo, float hi) { unsigned r; asm volatile("v_cvt_pk_bf16_f32 %0, %1, %2" : "=v"(r) : "v"(lo), "v"(hi)); return r; }

template <class Epi, class Sched, bool ALIGN_EPI>
__device__ __forceinline__ void gemm_phase(LAS unsigned char* lds, const Gemm g, const Sched& S, const Epi& E) {
    const int tid = threadIdx.x, wid = __builtin_amdgcn_readfirstlane(tid >> 6), lane = tid & 63, wr = wid >> 2, wc = wid & 3, fr = lane & 15, fq = lane >> 4;
    const int K = g.K, nt = K / BK;
    unsigned voffA[2], voffB[2];
#pragma unroll
    for (int i = 0; i < 2; ++i) { int R, C; stage_rc(tid * 16 + i * 8192, R, C); const int Rb = Epi::PERM ? ((R & ~31) + perm32(R & 31)) : R;
        voffA[i] = (unsigned)(R * g.lda + C) * 2u; voffB[i] = (unsigned)(Rb * g.ldb + C) * 2u; }
    const size_t kstep = (size_t)(BK * 2);
    const size_t hstepA = (size_t)HALF * g.lda * 2, hstepB = (size_t)HALF * g.ldb * 2;
    const unsigned ldsw = (unsigned)wid * 1024u;
    const int aoff = lds_byte(wr * 64 + fr, fq * 8), boff = lds_byte(wc * 32 + fr, fq * 8);
#define PG8_SA(b, h) (((b) * 2 + (h)) * HTB)
#define PG8_SB(b, h) ((4 + (b) * 2 + (h)) * HTB)
#define PG8_STAGE(bufoff, gbase, voff) do { _Pragma("unroll") for (int _i = 0; _i < 2; ++_i) \
        __builtin_amdgcn_global_load_lds((const unsigned*)((const char*)(gbase) + (voff)[_i]), (LAS unsigned*)(lds + (bufoff) + ldsw + _i * 8192), 16, 0, 0); } while (0)
#define PG8_LDA(dst, b, h) do { _Pragma("unroll") for (int m = 0; m < 4; ++m) _Pragma("unroll") for (int k = 0; k < 2; ++k) dst[m][k] = *(const LAS bf16x8*)(lds + PG8_SA(b, h) + aoff + m * 2048 + k * 1024); } while (0)
#define PG8_LDB(dst, b, h) do { _Pragma("unroll") for (int n = 0; n < 2; ++n) _Pragma("unroll") for (int k = 0; k < 2; ++k) dst[n][k] = *(const LAS bf16x8*)(lds + PG8_SB(b, h) + boff + n * 2048 + k * 1024); } while (0)
#define PG8_MMA(ai, bj, At, Bt) do { __builtin_amdgcn_s_setprio(1); _Pragma("unroll") for (int m = 0; m < 4; ++m) _Pragma("unroll") for (int n = 0; n < 2; ++n) _Pragma("unroll") for (int k = 0; k < 2; ++k) \
        acc[ai][bj][m][n] = __builtin_amdgcn_mfma_f32_16x16x32_bf16(Bt[n][k], At[m][k], acc[ai][bj][m][n], 0, 0, 0); __builtin_amdgcn_s_setprio(0); } while (0)
#define PG8_WAIT_V(n) asm volatile("s_waitcnt vmcnt(" #n ")" ::: "memory")
#define PG8_WAIT_L(n) asm volatile("s_waitcnt lgkmcnt(" #n ")" ::: "memory")
#define PG8_BAR __builtin_amdgcn_s_barrier()
#define PG8_SCHED __builtin_amdgcn_sched_barrier(0)
    Unit cur, nxt; int ui = 0;
    if (!S.next(0, cur)) return;
    f32x4 acc[2][2][4][2];
#pragma unroll
    for (int a = 0; a < 2; ++a)
#pragma unroll
        for (int b = 0; b < 2; ++b)
#pragma unroll
            for (int m = 0; m < 4; ++m)
#pragma unroll
                for (int n = 0; n < 2; ++n) acc[a][b][m][n] = (f32x4){0.f, 0.f, 0.f, 0.f};
    bf16x8 At[4][2], B0[2][2], B1[2][2];
    const char* cA = S.pa(cur); const char* cB = S.pb(cur);
    PG8_STAGE(PG8_SB(0, 0), cB, voffB); PG8_STAGE(PG8_SB(0, 1), cB + hstepB, voffB); PG8_STAGE(PG8_SA(0, 0), cA, voffA); PG8_STAGE(PG8_SA(0, 1), cA + hstepA, voffA);
    if (wr == 1) PG8_BAR;
    PG8_WAIT_V(2); PG8_BAR;
    PG8_STAGE(PG8_SB(1, 0), cB + kstep, voffB); PG8_STAGE(PG8_SA(1, 0), cA + kstep, voffA); PG8_STAGE(PG8_SB(1, 1), cB + hstepB + kstep, voffB);
    PG8_WAIT_V(6); PG8_BAR;
    for (;;) {
        const bool has_next = S.next(ui + 1, nxt);
        const char* nA = has_next ? S.pa(nxt) : cA; const char* nB = has_next ? S.pb(nxt) : cB;
#pragma clang loop unroll(disable)
        for (int t = 0; t < nt; t += 2) {
            const bool last = (t == nt - 2);
            const char* a1 = cA + (size_t)(t + 1) * kstep;
            const char* a2 = last ? nA : cA + (size_t)(t + 2) * kstep; const char* b2 = last ? nB : cB + (size_t)(t + 2) * kstep;
            const char* a3 = a2 + kstep; const char* b3 = b2 + kstep;
            PG8_LDB(B0, 0, 0); PG8_LDB(B1, 0, 1); PG8_SCHED; PG8_LDA(At, 0, 0); PG8_STAGE(PG8_SA(1, 1), a1 + hstepA, voffA);
            PG8_WAIT_V(8); PG8_WAIT_L(0); PG8_BAR; PG8_MMA(0, 0, At, B0); PG8_MMA(0, 1, At, B1); PG8_BAR; PG8_SCHED;
            PG8_LDA(At, 0, 1); PG8_STAGE(PG8_SB(0, 0), b2, voffB); PG8_STAGE(PG8_SB(0, 1), b2 + hstepB, voffB); PG8_STAGE(PG8_SA(0, 0), a2, voffA);
            PG8_WAIT_V(8); PG8_WAIT_L(0); PG8_BAR; PG8_MMA(1, 0, At, B0); PG8_MMA(1, 1, At, B1); PG8_BAR; PG8_SCHED;
            PG8_LDB(B0, 1, 0); PG8_LDB(B1, 1, 1); PG8_SCHED; PG8_LDA(At, 1, 0); PG8_STAGE(PG8_SA(0, 1), a2 + hstepA, voffA);
            PG8_WAIT_V(8); PG8_WAIT_L(0); PG8_BAR; PG8_MMA(0, 0, At, B0); PG8_MMA(0, 1, At, B1); PG8_BAR; PG8_SCHED;
            PG8_LDA(At, 1, 1); PG8_STAGE(PG8_SB(1, 0), b3, voffB); PG8_STAGE(PG8_SB(1, 1), b3 + hstepB, voffB); PG8_STAGE(PG8_SA(1, 0), a3, voffA);
            PG8_WAIT_V(8); PG8_WAIT_L(0); PG8_BAR; PG8_MMA(1, 0, At, B0); PG8_MMA(1, 1, At, B1); PG8_BAR; PG8_SCHED;
        }
        if constexpr (ALIGN_EPI) { if (wr == 0) PG8_BAR; }
        E(acc, cur, wr, wc, fr, fq);
        if (!has_next) break;
#pragma unroll
        for (int a = 0; a < 2; ++a)
#pragma unroll
            for (int b = 0; b < 2; ++b)
#pragma unroll
                for (int m = 0; m < 4; ++m)
#pragma unroll
                    for (int n = 0; n < 2; ++n) acc[a][b][m][n] = (f32x4){0.f, 0.f, 0.f, 0.f};
        cur = nxt; cA = nA; cB = nB; ++ui;
        if constexpr (ALIGN_EPI) { if (wr == 1) PG8_BAR; }
    }
    PG8_WAIT_V(0);
    if constexpr (!ALIGN_EPI) { if (wr == 0) PG8_BAR; }
    PG8_BAR;
#undef PG8_SA
#undef PG8_SB
#undef PG8_STAGE
#undef PG8_LDA
#undef PG8_LDB
#undef PG8_MMA
#undef PG8_WAIT_V
#undef PG8_WAIT_L
#undef PG8_BAR
#undef PG8_SCHED
}

typedef const f32x4 (&AccRef)[2][2][4][2];

struct SchedPlain {
    TileOrder o; const char* A; const char* B; size_t astep, bstep;
    __device__ __forceinline__ bool next(int i, Unit& u) const { return o.tile(i, u); }
    __device__ __forceinline__ const char* pa(const Unit& u) const { return A + (size_t)u.pm * astep; }
    __device__ __forceinline__ const char* pb(const Unit& u) const { return B + (size_t)u.pn * bstep; }
};
struct SchedRKV {
    TileOrder o; const char* A; const char* B; size_t astep, bstep, azstride;
    __device__ __forceinline__ bool next(int i, Unit& u) const { return o.tile(i, u); }
    __device__ __forceinline__ const char* pa(const Unit& u) const { return A + (size_t)(u.pn >> 2) * azstride + (size_t)u.pm * astep; }
    __device__ __forceinline__ const char* pb(const Unit& u) const { return B + (size_t)u.pn * bstep; }
};
struct SchedMoe {
    TileOrder o; const char* A; const char* B; size_t astep, bstep, bestride; const LAS int* ends;
    __device__ __forceinline__ bool next(int i, Unit& u) const { return o.tile(i, u); }
    __device__ __forceinline__ int be(int pm) const { int e = 0;
#pragma unroll
        for (int j = 0; j < NE - 1; ++j) e += (pm >= ends[j]) ? 1 : 0; return e; }
    __device__ __forceinline__ const char* pa(const Unit& u) const { return A + (size_t)u.pm * astep; }
    __device__ __forceinline__ const char* pb(const Unit& u) const { return B + (size_t)be(u.pm) * bestride + (size_t)u.pn * bstep; }
};

struct SchedMoeK {
    TileOrder o; const char* A; const char* B; size_t astep, bstep, bestride, kbytes; const LAS int* ends; int pm0;
    __device__ __forceinline__ bool next(int i, Unit& u) const { return o.tile(i, u); }
    __device__ __forceinline__ int be(int pm) const { int e = 0;
#pragma unroll
        for (int j = 0; j < NE - 1; ++j) e += (pm >= ends[j]) ? 1 : 0; return e; }
    __device__ __forceinline__ const char* pa(const Unit& u) const { return A + (size_t)(pm0 + u.pm) * astep + (size_t)(u.pn >> 2) * kbytes; }
    __device__ __forceinline__ const char* pb(const Unit& u) const { return B + (size_t)be(pm0 + u.pm) * bestride + (size_t)(u.pn & 3) * bstep + (size_t)(u.pn >> 2) * kbytes; }
};

struct EpiRKV {
    static constexpr bool PERM = true;
    bf16* C; size_t zstride;
    __device__ __forceinline__ void operator()(AccRef acc, const Unit& u, int wr, int wc, int fr, int fq) const {
        const int z = u.pn >> 2, pn = u.pn & 3; bf16* base = C + (size_t)z * zstride;
        const int row0 = u.pm * BM + wr * 64 + fr, col0 = pn * BM + wc * 32 + 8 * fq;
#pragma unroll
        for (int ai = 0; ai < 2; ++ai)
#pragma unroll
            for (int m = 0; m < 4; ++m) { bf16* rowp = base + (size_t)(row0 + ai * HALF + m * 16) * D + col0;
#pragma unroll
                for (int bj = 0; bj < 2; ++bj) { const f32x4 v0 = acc[ai][bj][m][0], v1 = acc[ai][bj][m][1];
                    u32x4 w; w.x = cvt_pk_bf16(v0[0], v0[1]); w.y = cvt_pk_bf16(v0[2], v0[3]); w.z = cvt_pk_bf16(v1[0], v1[1]); w.w = cvt_pk_bf16(v1[2], v1[3]);
                    *(u32x4*)(rowp + bj * HALF) = w; } }
    }
};
struct EpiRes {
    static constexpr bool PERM = false;
    const float* base; float* out;
    __device__ __forceinline__ void operator()(AccRef acc, const Unit& u, int wr, int wc, int fr, int fq) const {
        const int row0 = u.pm * BM + wr * 64 + fr, col0 = u.pn * BM + wc * 32 + 4 * fq;
#pragma unroll
        for (int ai = 0; ai < 2; ++ai)
#pragma unroll
            for (int m = 0; m < 4; ++m) { const size_t off = (size_t)(row0 + ai * HALF + m * 16) * D + col0;
#pragma unroll
                for (int bj = 0; bj < 2; ++bj)
#pragma unroll
                    for (int n = 0; n < 2; ++n) { const f32x4 b = *(const f32x4*)(base + off + bj * HALF + n * 16); *(f32x4*)(out + off + bj * HALF + n * 16) = b + acc[ai][bj][m][n]; } }
    }
};
struct EpiL1 {
    static constexpr bool PERM = true;
    bf16* O;
    __device__ __forceinline__ void operator()(AccRef acc, const Unit& u, int wr, int wc, int fr, int fq) const {
        const int row0 = u.pm * BM + wr * 64 + fr, col0 = wc * 32 + 8 * fq;
#pragma unroll
        for (int ai = 0; ai < 2; ++ai)
#pragma unroll
            for (int m = 0; m < 4; ++m) { bf16* rowp = O + (size_t)(row0 + ai * HALF + m * 16) * 256 + col0;
#pragma unroll
                for (int bj = 0; bj < 2; ++bj) { float v[8];
#pragma unroll
                    for (int i = 0; i < 4; ++i) { v[i] = acc[ai][bj][m][0][i]; v[4 + i] = acc[ai][bj][m][1][i]; }
#pragma unroll
                    for (int i = 0; i < 8; ++i) { if (bj == 1) v[i] = sigmoidf_(v[i]); else if (wc < 2) v[i] = tanhf_(v[i]); }
                    u32x4 w; w.x = cvt_pk_bf16(v[0], v[1]); w.y = cvt_pk_bf16(v[2], v[3]); w.z = cvt_pk_bf16(v[4], v[5]); w.w = cvt_pk_bf16(v[6], v[7]);
                    *(u32x4*)(rowp + bj * HALF) = w; } }
    }
};
struct EpiL2 {
    static constexpr bool PERM = true;
    float* LW; bf16* AA; bf16* G; const float* w0; const float* a0;
    __device__ __forceinline__ void operator()(AccRef acc, const Unit& u, int wr, int wc, int fr, int fq) const {
        const int z = u.pn >> 2, pn = u.pn & 3;
        const int row0 = u.pm * BM + wr * 64 + fr, col0 = pn * BM + wc * 32 + 8 * fq;
        if (z == 0) {
#pragma unroll
            for (int bj = 0; bj < 2; ++bj) { const f32x4 b0 = *(const f32x4*)(w0 + col0 + bj * HALF), b1 = *(const f32x4*)(w0 + col0 + bj * HALF + 4);
#pragma unroll
                for (int ai = 0; ai < 2; ++ai)
#pragma unroll
                    for (int m = 0; m < 4; ++m) { f32x4 v0 = acc[ai][bj][m][0] + b0, v1 = acc[ai][bj][m][1] + b1;
#pragma unroll
                        for (int i = 0; i < 4; ++i) { v0[i] = -0.6065306597126334f * sigmoidf_(v0[i]); v1[i] = -0.6065306597126334f * sigmoidf_(v1[i]); }
                        float* p = LW + (size_t)(row0 + ai * HALF + m * 16) * D + col0 + bj * HALF; *(f32x4*)p = v0; *(f32x4*)(p + 4) = v1; } }
        } else {
            bf16* base = z == 1 ? AA : G;
#pragma unroll
            for (int bj = 0; bj < 2; ++bj) { f32x4 b0 = {0.f, 0.f, 0.f, 0.f}, b1 = b0; if (z == 1) { b0 = *(const f32x4*)(a0 + col0 + bj * HALF); b1 = *(const f32x4*)(a0 + col0 + bj * HALF + 4); }
#pragma unroll
                for (int ai = 0; ai < 2; ++ai)
#pragma unroll
                    for (int m = 0; m < 4; ++m) { f32x4 v0 = acc[ai][bj][m][0] + b0, v1 = acc[ai][bj][m][1] + b1;
                        if (z == 1) {
#pragma unroll
                            for (int i = 0; i < 4; ++i) { v0[i] = sigmoidf_(v0[i]); v1[i] = sigmoidf_(v1[i]); } }
                        u32x4 w; w.x = cvt_pk_bf16(v0[0], v0[1]); w.y = cvt_pk_bf16(v0[2], v0[3]); w.z = cvt_pk_bf16(v1[0], v1[1]); w.w = cvt_pk_bf16(v1[2], v1[3]);
                        *(u32x4*)(base + (size_t)(row0 + ai * HALF + m * 16) * D + col0 + bj * HALF) = w; } }
        }
    }
};
struct EpiSwiGLU {
    static constexpr bool PERM = true;
    bf16* O;
    __device__ __forceinline__ void operator()(AccRef acc, const Unit& u, int wr, int wc, int fr, int fq) const {
        const int row0 = u.pm * BM + wr * 64 + fr, col0 = u.pn * HALF + wc * 32 + 8 * fq;
#pragma unroll
        for (int ai = 0; ai < 2; ++ai)
#pragma unroll
            for (int m = 0; m < 4; ++m) { float v[8];
#pragma unroll
                for (int n = 0; n < 2; ++n)
#pragma unroll
                    for (int i = 0; i < 4; ++i) { const float gt = acc[ai][0][m][n][i], up = acc[ai][1][m][n][i];
                        v[4 * n + i] = gt * up * __builtin_amdgcn_rcpf(1.f + __builtin_amdgcn_exp2f(gt * -1.4426950408889634f)); }
                u32x4 w; w.x = cvt_pk_bf16(v[0], v[1]); w.y = cvt_pk_bf16(v[2], v[3]); w.z = cvt_pk_bf16(v[4], v[5]); w.w = cvt_pk_bf16(v[6], v[7]);
                *(u32x4*)(O + (size_t)(row0 + ai * HALF + m * 16) * FF + col0) = w; }
    }
};
struct EpiBf16K {
    static constexpr bool PERM = true;
    bf16* O; size_t slab;
    __device__ __forceinline__ void operator()(AccRef acc, const Unit& u, int wr, int wc, int fr, int fq) const {
        bf16* base = O + (size_t)(u.pn >> 2) * slab;
        const int row0 = u.pm * BM + wr * 64 + fr, col0 = (u.pn & 3) * BM + wc * 32 + 8 * fq;
#pragma unroll
        for (int ai = 0; ai < 2; ++ai)
#pragma unroll
            for (int m = 0; m < 4; ++m) { bf16* rowp = base + (size_t)(row0 + ai * HALF + m * 16) * D + col0;
#pragma unroll
                for (int bj = 0; bj < 2; ++bj) { const f32x4 v0 = acc[ai][bj][m][0], v1 = acc[ai][bj][m][1];
                    u32x4 w; w.x = cvt_pk_bf16(v0[0], v0[1]); w.y = cvt_pk_bf16(v0[2], v0[3]); w.z = cvt_pk_bf16(v1[0], v1[1]); w.w = cvt_pk_bf16(v1[2], v1[3]);
                    *(u32x4*)(rowp + bj * HALF) = w; } }
    }
};
struct EpiQKVG {
    static constexpr bool PERM = true;
    bf16* O; const float* gq; const float* gk;
    __device__ __forceinline__ void operator()(AccRef acc, const Unit& u, int wr, int wc, int fr, int fq) const {
        const int row0 = u.pm * BM + wr * 64 + fr;
        if (u.pn < 8) {
            const float* gp = u.pn < 4 ? gq : gk; const float sc = u.pn < 4 ? 0.125f * LOG2E : 1.f;
            f32x4 gn[2][2];
#pragma unroll
            for (int bj = 0; bj < 2; ++bj)
#pragma unroll
                for (int n = 0; n < 2; ++n) gn[bj][n] = *(const f32x4*)(gp + 32 * bj + 8 * fq + 4 * n) * sc;
            const int colb = 256 * u.pn + 64 * wc + 8 * fq;
#pragma unroll
            for (int ai = 0; ai < 2; ++ai)
#pragma unroll
                for (int m = 0; m < 4; ++m) { float ss = 0.f;
#pragma unroll
                    for (int bj = 0; bj < 2; ++bj)
#pragma unroll
                        for (int n = 0; n < 2; ++n) { const f32x4 v = acc[ai][bj][m][n]; ss += (v[0] * v[0] + v[1] * v[1]) + (v[2] * v[2] + v[3] * v[3]); }
                    ss += __shfl_xor(ss, 16); ss += __shfl_xor(ss, 32);
                    const float rs = rsqrtf(ss * (1.f / 64.f) + RMS_EPS);
                    bf16* rowp = O + (size_t)(row0 + ai * HALF + m * 16) * 4096 + colb;
#pragma unroll
                    for (int bj = 0; bj < 2; ++bj) { const f32x4 v0 = acc[ai][bj][m][0] * rs * gn[bj][0], v1 = acc[ai][bj][m][1] * rs * gn[bj][1];
                        u32x4 w; w.x = cvt_pk_bf16(v0[0], v0[1]); w.y = cvt_pk_bf16(v0[2], v0[3]); w.z = cvt_pk_bf16(v1[0], v1[1]); w.w = cvt_pk_bf16(v1[2], v1[3]);
                        *(u32x4*)(rowp + 32 * bj) = w; } }
        } else {
            const int col0 = u.pn * BM + wc * 32 + 8 * fq;
#pragma unroll
            for (int ai = 0; ai < 2; ++ai)
#pragma unroll
                for (int m = 0; m < 4; ++m) { bf16* rowp = O + (size_t)(row0 + ai * HALF + m * 16) * 4096 + col0;
#pragma unroll
                    for (int bj = 0; bj < 2; ++bj) { const f32x4 v0 = acc[ai][bj][m][0], v1 = acc[ai][bj][m][1];
                        u32x4 w; w.x = cvt_pk_bf16(v0[0], v0[1]); w.y = cvt_pk_bf16(v0[2], v0[3]); w.z = cvt_pk_bf16(v1[0], v1[1]); w.w = cvt_pk_bf16(v1[2], v1[3]);
                        *(u32x4*)(rowp + bj * HALF) = w; } }
        }
    }
};
struct EpiBf16 {
    static constexpr bool PERM = true;
    bf16* O; int ldc;
    __device__ __forceinline__ void operator()(AccRef acc, const Unit& u, int wr, int wc, int fr, int fq) const {
        const int row0 = u.pm * BM + wr * 64 + fr, col0 = u.pn * BM + wc * 32 + 8 * fq;
#pragma unroll
        for (int ai = 0; ai < 2; ++ai)
#pragma unroll
            for (int m = 0; m < 4; ++m) { bf16* rowp = O + (size_t)(row0 + ai * HALF + m * 16) * ldc + col0;
#pragma unroll
                for (int bj = 0; bj < 2; ++bj) { const f32x4 v0 = acc[ai][bj][m][0], v1 = acc[ai][bj][m][1];
                    u32x4 w; w.x = cvt_pk_bf16(v0[0], v0[1]); w.y = cvt_pk_bf16(v0[2], v0[3]); w.z = cvt_pk_bf16(v1[0], v1[1]); w.w = cvt_pk_bf16(v1[2], v1[3]);
                    *(u32x4*)(rowp + bj * HALF) = w; } }
    }
};
}

#define XB_TMO      128
#define XB_XCNT(j)  (256  + 64 * (j))
#define XB_XSUB(j)  (1280 + 64 * (j))
#define XB_XGEN(j)  (2304 + 64 * (j))
#define XB_TOP      3328
#define XB_TOPGEN   3392
#define XCD_BAR_WORDS 3456
#define XB_SPIN_CAP (1u << 18)
__device__ __forceinline__ unsigned xb_ld(unsigned* p)              { return __hip_atomic_load(p, __ATOMIC_RELAXED, __HIP_MEMORY_SCOPE_AGENT); }
__device__ __forceinline__ unsigned xb_add(unsigned* p, unsigned v) { return __hip_atomic_fetch_add(p, v, __ATOMIC_RELAXED, __HIP_MEMORY_SCOPE_AGENT); }
__device__ __forceinline__ unsigned xb_xcc_id() { return (unsigned)__builtin_amdgcn_s_getreg((3 << 11) | 20) & 0xFu; }
#define XB_SPIN(cond, bar) do { unsigned _sp = 0; while (cond) { __builtin_amdgcn_s_sleep(1); \
    if ((++_sp & 255u) == 0u) { if (xb_ld(&(bar)[XB_TMO])) break; if (_sp > XB_SPIN_CAP) { atomicAdd(&(bar)[XB_TMO], 1u); break; } } } } while (0)
struct XcdBarrier { unsigned* bar; unsigned x; volatile LAS unsigned* st; };
__device__ __forceinline__ XcdBarrier xcd_barrier_post(unsigned* bar, volatile LAS unsigned* st) {
    XcdBarrier b; b.bar = bar; b.x = xb_xcc_id(); b.st = st;
    if (threadIdx.x == 0) (void)xb_add(&bar[XB_XCNT(b.x)], 1u);
    return b;
}
__device__ __forceinline__ void xcd_barrier_complete(unsigned* bar, unsigned x, unsigned& nloc, unsigned& nx) {
    const unsigned G = gridDim.x * gridDim.y * gridDim.z;
    unsigned sum, cnt, mine, sp = 0u;
    for (;;) {
        sum = 0u; cnt = 0u; mine = 0u;
#pragma unroll
        for (unsigned j = 0; j < 16; ++j) { const unsigned c = xb_ld(&bar[XB_XCNT(j)]); sum += c; cnt += (c > 0u) ? 1u : 0u; mine = (j == x) ? c : mine; }
        if (sum == G) break;
        __builtin_amdgcn_s_sleep(1);
        if ((++sp & 255u) == 0u) { if (xb_ld(&bar[XB_TMO])) break; if (sp > XB_SPIN_CAP) { atomicAdd(&bar[XB_TMO], 1u); break; } }
    }
    nloc = mine > 0u ? mine : 1u; nx = cnt > 0u ? cnt : 1u;
}
__device__ __forceinline__ void xcd_barrier(const XcdBarrier& b) {
    asm volatile("s_waitcnt vmcnt(0)" ::: "memory");
    __syncthreads();
    if (threadIdx.x == 0) {
        unsigned* bar = b.bar;
        __builtin_amdgcn_s_waitcnt(0);
        unsigned nloc = b.st[0], nx = b.st[1];
        if (nloc == 0u) { xcd_barrier_complete(bar, b.x, nloc, nx); b.st[0] = nloc; b.st[1] = nx; }
        const unsigned old = xb_add(&bar[XB_XSUB(b.x)], 1u);
        const unsigned gen = old / nloc;
        if (old + 1u == (gen + 1u) * nloc) {
            __builtin_amdgcn_fence(__ATOMIC_RELEASE, "agent");
            asm volatile("s_waitcnt vmcnt(0)" ::: "memory");
            const unsigned og = xb_add(&bar[XB_TOP], 1u);
            const unsigned tg = og / nx;
            if (og + 1u == (tg + 1u) * nx) xb_add(&bar[XB_TOPGEN], 1u);
            else XB_SPIN(xb_ld(&bar[XB_TOPGEN]) == tg, bar);
            __builtin_amdgcn_fence(__ATOMIC_ACQUIRE, "agent");
            xb_add(&bar[XB_XGEN(b.x)], 1u);
            asm volatile("s_waitcnt vmcnt(0)" ::: "memory");
        } else {
            XB_SPIN(xb_ld(&bar[XB_XGEN(b.x)]) == gen, bar);
            __builtin_amdgcn_fence(__ATOMIC_ACQUIRE, "agent");
            asm volatile("s_waitcnt vmcnt(0)" ::: "memory");
        }
    }
    __syncthreads();
}

struct Args { const float* in[29]; float* out; unsigned char* ws; int ph_lo, ph_hi; };
struct Frame {
    LAS unsigned char* lds; gu32* ctl; unsigned char* ws;
    int tid, lane, wave, vcu, G, gw, NGW;
};

struct Row { f32x4 v[4]; };
__device__ __forceinline__ Row ld_row(const float* p, int lane) { Row r; const f32x4* q = (const f32x4*)p + lane;
#pragma unroll
    for (int j = 0; j < 4; ++j) r.v[j] = q[64 * j]; return r; }
__device__ __forceinline__ void st_row(float* p, int lane, const Row& r) { f32x4* q = (f32x4*)p + lane;
#pragma unroll
    for (int j = 0; j < 4; ++j) q[64 * j] = r.v[j]; }
__device__ __forceinline__ void st_row_bf16(bf16* p, int lane, const Row& r) { u32x2* q = (u32x2*)p + lane;
#pragma unroll
    for (int j = 0; j < 4; ++j) { u32x2 w; w.x = pk2(r.v[j][0], r.v[j][1]); w.y = pk2(r.v[j][2], r.v[j][3]); q[64 * j] = w; } }
__device__ __forceinline__ Row ld_row_bf16(const bf16* p, int lane) { Row r; const u32x2* q = (const u32x2*)p + lane;
#pragma unroll
    for (int j = 0; j < 4; ++j) { const u32x2 w = q[64 * j]; r.v[j] = (f32x4){bflo(w.x), bfhi(w.x), bflo(w.y), bfhi(w.y)}; } return r; }
__device__ __forceinline__ float row_sumsq(const Row& r) { float s = 0.f;
#pragma unroll
    for (int j = 0; j < 4; ++j) s += (r.v[j][0] * r.v[j][0] + r.v[j][1] * r.v[j][1]) + (r.v[j][2] * r.v[j][2] + r.v[j][3] * r.v[j][3]); return wave_sum(s); }
__device__ __forceinline__ Row rmsnorm_row(const Row& x, const Row& g) { const float rs = rsqrtf(row_sumsq(x) * (1.f / D) + RMS_EPS); Row y;
#pragma unroll
    for (int j = 0; j < 4; ++j) y.v[j] = x.v[j] * rs * g.v[j]; return y; }

__device__ __forceinline__ void tr_item(const float* W, int ldw, int k0, int n0, bf16* WT, int ldt, int drow0, int dcol0, const float* sc, int scmode, LAS float* scr, int lane) {
#pragma unroll 8
    for (int i = 0; i < 32; ++i) { const int kk = 2 * i + (lane >> 5); float v = W[(size_t)(k0 + kk) * ldw + n0 + (lane & 31)];
        if (scmode == 1) v *= sc[k0 + kk]; else if (scmode == 2) v *= (1.f - sc[k0 + kk]);
        scr[kk * 33 + (lane & 31)] = v; }
    LDS_WAIT(); asm volatile("" ::: "memory");
    const int c = lane & 7;
#pragma unroll
    for (int j = 0; j < 4; ++j) { const int n = (lane >> 3) + 8 * j; const LAS float* s = scr + (8 * c) * 33 + n;
        u32x4 o; o.x = pk2(s[0 * 33], s[1 * 33]); o.y = pk2(s[2 * 33], s[3 * 33]); o.z = pk2(s[4 * 33], s[5 * 33]); o.w = pk2(s[6 * 33], s[7 * 33]);
        *(GAS u32x4*)(WT + (size_t)(drow0 + n0 + n) * ldt + dcol0 + k0 + 8 * c) = o; }
    LDS_WAIT(); asm volatile("" ::: "memory");
}
__device__ __forceinline__ int gu_row(int n) { return n < FF ? 256 * (n >> 7) + (n & 127) : 256 * ((n - FF) >> 7) + 128 + ((n - FF) & 127); }

__device__ __forceinline__ void p0_prologue(Frame& F, const Args& a) {
    LAS float* scr = (LAS float*)(F.lds + F.wave * 16384);
    unsigned char* ws = F.ws;
    constexpr int I_SQ = 16 * 32;
    constexpr int I_RKV = 3 * I_SQ, I_L1 = 2 * 16 * 8, I_L2 = 4 * 32, I_GU = 16 * 224, I_DN = 56 * 32, I_IN = 16 * 128;
    constexpr int NITEMS = I_RKV + I_L1 + I_L2 + I_SQ + I_GU + I_DN + I_IN + I_SQ;
    for (int it = F.gw; it < NITEMS; it += F.NGW) {
        int r = it;
        if (r < I_RKV) { const int z = r / I_SQ, q = r % I_SQ; tr_item(a.in[4] + (size_t)z * D * D, D, 64 * (q / 32), 32 * (q % 32), (bf16*)(ws + WS_W_RKV) + (size_t)z * D * D, D, 0, 0, nullptr, 0, scr, F.lane); continue; } r -= I_RKV;
        if (r < I_L1) {
            const int half = r / 128, q = r % 128, kb = q / 8, nb = q % 8, n0 = 32 * nb;
            const float* W; int ldw, nn0, mi;
            if (n0 < 64) { W = a.in[6]; ldw = 64; nn0 = n0; mi = 3; } else if (n0 < 128) { W = a.in[9]; ldw = 64; nn0 = n0 - 64; mi = 4; } else { W = a.in[11]; ldw = 128; nn0 = n0 - 128; mi = 5; }
            tr_item(W, ldw, 64 * kb, nn0, (bf16*)(ws + WS_W_L1), 2 * D, n0 - nn0, half * D, a.in[3] + mi * D, half == 0 ? 1 : 2, scr, F.lane); continue; } r -= I_L1;
        if (r < I_L2) {
            const int part = r / 32, nb = r % 32;
            if (part == 0) tr_item(a.in[7], D, 0, 32 * nb, (bf16*)(ws + WS_W_L2), 256, 0, 0, nullptr, 0, scr, F.lane);
            else if (part == 1) tr_item(a.in[10], D, 0, 32 * nb, (bf16*)(ws + WS_W_L2), 256, D, 64, nullptr, 0, scr, F.lane);
            else tr_item(a.in[12], D, 64 * (part - 2), 32 * nb, (bf16*)(ws + WS_W_L2), 256, 2 * D, 128, nullptr, 0, scr, F.lane);
            continue; } r -= I_L2;
        if (r < I_SQ) { tr_item(a.in[18], D, 64 * (r / 32), 32 * (r % 32), (bf16*)(ws + WS_W_O0), D, 0, 0, nullptr, 0, scr, F.lane); continue; } r -= I_SQ;
        if (r < I_GU) { const int kb = r / 224, nb = r % 224; tr_item(a.in[24], 2 * FF, 64 * kb, 32 * nb, (bf16*)(ws + WS_W_GU), D, gu_row(32 * nb) - 32 * nb, 0, nullptr, 0, scr, F.lane); continue; } r -= I_GU;
        if (r < I_DN) { tr_item(a.in[25], D, 64 * (r / 32), 32 * (r % 32), (bf16*)(ws + WS_W_DN), FF, 0, 0, nullptr, 0, scr, F.lane); continue; } r -= I_DN;
        if (r < I_IN) { const int n0 = 32 * (r % 128);
            const int drow = n0 < 2 * D ? 256 * (n0 / 256) + 128 * ((n0 % 64) / 32) + 32 * ((n0 % 256) / 64) : n0;
            tr_item(a.in[19], WIN_LD, 64 * (r / 128), n0, (bf16*)(ws + WS_W_IN), D, drow - n0, 0, nullptr, 0, scr, F.lane); continue; } r -= I_IN;
        { tr_item(a.in[23], D, 64 * (r / 32), 32 * (r % 32), (bf16*)(ws + WS_W_FO), D, 0, 0, nullptr, 0, scr, F.lane); }
    }
    for (int i = F.gw * 64 + F.lane; i < 3 * D * 32; i += F.NGW * 64) { const int row = i >> 5, ch = i & 31, part = row / D, k = ch * 8;
        const bool nz = part == 0 ? (k < 64) : (part == 1 ? (k >= 64 && k < 128) : (k >= 128));
        if (!nz) *(GAS u32x4*)((bf16*)(ws + WS_W_L2) + (size_t)row * 256 + k) = (u32x4){0u, 0u, 0u, 0u}; }
}

__device__ __forceinline__ void p0_moe_weights(Frame& F, const Args& a, int wi, int nw, int part) {
    LAS float* scr = (LAS float*)(F.lds + F.wave * 16384);
    unsigned char* ws = F.ws;
    constexpr int I_GU = 16 * 224, I_DN = 56 * 32;
    constexpr int NIT = NE * (I_GU + I_DN), MOE_CUT = NIT;
    for (int it = (part ? MOE_CUT : 0) + wi * NWAVES + F.wave; it < (part ? NIT : MOE_CUT); it += nw * NWAVES) {
        int r = it;
        if (r < NE * I_GU) { const int e = r / I_GU, q = r % I_GU, kb = q / 224, nb = q % 224;
            tr_item(a.in[27] + (size_t)e * D * 2 * FF, 2 * FF, 64 * kb, 32 * nb, (bf16*)(ws + WS_W_MGU) + (size_t)e * 2 * FF * D, D, gu_row(32 * nb) - 32 * nb, 0, nullptr, 0, scr, F.lane); continue; } r -= NE * I_GU;
        { const int e = r / I_DN, q = r % I_DN; tr_item(a.in[28] + (size_t)e * FF * D, D, 64 * (q / 32), 32 * (q % 32), (bf16*)(ws + WS_W_MDN) + (size_t)e * D * FF, FF, 0, 0, nullptr, 0, scr, F.lane); }
    }
}

__device__ __forceinline__ void p1_shift(Frame& F, const Args& a) {
    const int lane = F.lane; const float* x = a.in[0];
    bf16* UB = (bf16*)(F.ws + WS_UB); bf16* XS = (bf16*)(F.ws + WS_XS);
    const Row g0 = ld_row(a.in[1], lane);
    const int RPW = T / (256 * NWAVES);
    for (int t0 = F.gw * RPW; t0 < T; t0 += F.NGW * RPW) {
        Row prev;
        if (t0 > 0) prev = rmsnorm_row(ld_row(x + (size_t)(t0 - 1) * D, lane), g0);
        else { for (int j = 0; j < 4; ++j) prev.v[j] = (f32x4){0.f, 0.f, 0.f, 0.f}; st_row_bf16(UB, lane, prev); }
        for (int t = t0; t < t0 + RPW; ++t) {
            const Row u = rmsnorm_row(ld_row(x + (size_t)t * D, lane), g0);
            st_row_bf16(UB + (size_t)(t + 1) * D, lane, u);
#pragma unroll
            for (int n = 0; n < 3; ++n) { const Row mu = ld_row(a.in[3] + n * D, lane); Row o;
#pragma unroll
                for (int j = 0; j < 4; ++j) o.v[j] = u.v[j] + (prev.v[j] - u.v[j]) * mu.v[j];
                st_row_bf16(XS + (size_t)n * T * D + (size_t)t * D, lane, o); }
            prev = u;
        }
    }
}

typedef __bf16 bf16x2_t __attribute__((ext_vector_type(2)));
__device__ __forceinline__ unsigned cvtpk(float lo, float hi) { f32x2 v = {lo, hi}; bf16x2_t b = __builtin_convertvector(v, bf16x2_t); return __builtin_bit_cast(unsigned, b); }
struct Pk { bf16x8 k0, k1; };
__device__ __forceinline__ Pk pack_tile(const f32x16& t) {
    const u32x4 a = {cvtpk(t[0], t[1]), cvtpk(t[2], t[3]), cvtpk(t[4], t[5]), cvtpk(t[6], t[7])}, b = {cvtpk(t[8], t[9]), cvtpk(t[10], t[11]), cvtpk(t[12], t[13]), cvtpk(t[14], t[15])};
    Pk p; p.k0 = __builtin_bit_cast(bf16x8, a); p.k1 = __builtin_bit_cast(bf16x8, b); return p; }
#define MFMA32(a, b, c) __builtin_amdgcn_mfma_f32_32x32x16_bf16((a), (b), (c), 0, 0, 0)
__device__ __forceinline__ f32x16 xt(const Pk& X, const Pk& Z, f32x16 acc) { acc = MFMA32(X.k0, Z.k0, acc); acc = MFMA32(X.k1, Z.k1, acc); return acc; }
__device__ __forceinline__ bf16x8 nfrag(const bf16* m, int rt, int ks, int lane) { return *(const bf16x8*)(m + (size_t)(32 * rt + (lane & 31)) * D + 16 * ks + 8 * (lane >> 5)); }
__device__ __forceinline__ f32x16 nat(const bf16* am, int a, const bf16* bm, int b, int lane, f32x16 acc) {
#pragma unroll
    for (int ks = 0; ks < 4; ++ks) acc = MFMA32(nfrag(am, a, ks, lane), nfrag(bm, b, ks, lane), acc);
    return acc; }
__device__ __forceinline__ f32x16 dl_copy(const bf16* am, int a, int ct, int lane) {
    f32x16 acc = {};
#pragma unroll
    for (int kk2 = 0; kk2 < 2; ++kk2) { const int ks = 2 * ct + kk2; bf16x8 id;
#pragma unroll
        for (int e = 0; e < 8; ++e) id[e] = (32 * ct + (lane & 31) == 16 * ks + 8 * (lane >> 5) + e) ? (short)0x3F80 : (short)0;
        acc = MFMA32(nfrag(am, a, ks, lane), id, acc); }
    return acc; }
__device__ __forceinline__ void mask_lt(f32x16& t, int lane) {
#pragma unroll
    for (int r = 0; r < 16; ++r) if (!(crow(r, lane >> 5) < (lane & 31))) t[r] = 0.f; }
__device__ __forceinline__ void mask_gt(f32x16& t, int lane) {
#pragma unroll
    for (int r = 0; r < 16; ++r) if (!(crow(r, lane >> 5) > (lane & 31))) t[r] = 0.f; }
__device__ __forceinline__ void mask_le(f32x16& t, int lane) {
#pragma unroll
    for (int r = 0; r < 16; ++r) if (!(crow(r, lane >> 5) <= (lane & 31))) t[r] = 0.f; }
__device__ __forceinline__ void add_eye(f32x16& t, int lane) {
#pragma unroll
    for (int r = 0; r < 16; ++r) if (crow(r, lane >> 5) == (lane & 31)) t[r] += 1.f; }

__device__ __forceinline__ void p3_prep(Frame& F, const Args& a) {
    const int lane = F.lane;
    const bf16* R = (const bf16*)(F.ws + WS_R); const bf16* K = (const bf16*)(F.ws + WS_K); const bf16* V = (const bf16*)(F.ws + WS_V);
    const float* LW = (const float*)(F.ws + WS_LW); const bf16* AA = (const bf16*)(F.ws + WS_AA);
    bf16* AT = (bf16*)(F.ws + WS_AT); bf16* RT = (bf16*)(F.ws + WS_RT); bf16* BH = (bf16*)(F.ws + WS_BH); bf16* KH = (bf16*)(F.ws + WS_KH); bf16* V16 = (bf16*)(F.ws + WS_V16);
    float* GC = (float*)(F.ws + WS_GC); float* C3 = (float*)(F.ws + WS_CS) + (size_t)2 * T * 16;
    for (int task = F.gw; task < NCH * 8; task += F.NGW) {
        const int c = task >> 3, hg = (task >> 1) & 3, half = task & 1, col = hg * 256 + 4 * lane;
        const f32x4 k_k = *(const f32x4*)(a.in[13] + col), k_a = *(const f32x4*)(a.in[14] + col), r_k = *(const f32x4*)(a.in[15] + col);
        f32x4 lg = {0.f, 0.f, 0.f, 0.f};
        if (half) {
            f32x4 l32[32];
#pragma unroll
            for (int u = 0; u < 32; ++u) l32[u] = *(const f32x4*)(LW + (size_t)(64 * c + u) * D + col);
#pragma unroll
            for (int u = 0; u < 32; ++u) lg = lg + l32[u];
        }
        constexpr int PF = 8;
        for (int tb = 32 * half; tb < 32 * half + 32; tb += PF) {
            u32x2 rr[PF], kx[PF], ax[PF]; f32x4 lx[PF];
#pragma unroll
            for (int u = 0; u < PF; ++u) { const size_t o = (size_t)(64 * c + tb + u) * D + col;
                rr[u] = *(const u32x2*)(R + o); kx[u] = *(const u32x2*)(K + o); lx[u] = *(const f32x4*)(LW + o); ax[u] = *(const u32x2*)(AA + o); }
#pragma unroll
            for (int u = 0; u < PF; ++u) { const int tt = tb + u;
                const size_t o = (size_t)(64 * c + tt) * D + col;
                const f32x4 r = {bflo(rr[u].x), bfhi(rr[u].x), bflo(rr[u].y), bfhi(rr[u].y)}, k = {bflo(kx[u].x), bfhi(kx[u].x), bflo(kx[u].y), bfhi(kx[u].y)}, lw = lx[u], aa = {bflo(ax[u].x), bfhi(ax[u].x), bflo(ax[u].y), bfhi(ax[u].y)};
                f32x4 kk = k * k_k;
                float ss = (kk[0] * kk[0] + kk[1] * kk[1]) + (kk[2] * kk[2] + kk[3] * kk[3]); ss = row16_sum(ss);
                kk = kk * (1.f / fmaxf(sqrtf(ss), 1e-12f));
                const f32x4 b = kk * aa, km = k * (1.f + (aa - 1.f) * k_a);
                float s3 = (r[0] * km[0] * r_k[0] + r[1] * km[1] * r_k[1]) + (r[2] * km[2] * r_k[2] + r[3] * km[3] * r_k[3]); s3 = row16_sum(s3);
                if ((lane & 15) == 0) C3[(size_t)(64 * c + tt) * 16 + hg * 4 + (lane >> 4)] = s3;
                const f32x4 lgm1 = lg; lg = lg + lw;
                f32x4 at, rt, bh, kh;
#pragma unroll
                for (int i = 0; i < 4; ++i) { const float em = __expf(lgm1[i]), ep = __expf(lg[i]), en = __expf(-lg[i]); at[i] = -kk[i] * em; rt[i] = r[i] * ep; bh[i] = b[i] * en; kh[i] = km[i] * en; }
                *(u32x2*)(AT + o) = (u32x2){pk2(at[0], at[1]), pk2(at[2], at[3])}; *(u32x2*)(RT + o) = (u32x2){pk2(rt[0], rt[1]), pk2(rt[2], rt[3])};
                *(u32x2*)(BH + o) = (u32x2){pk2(bh[0], bh[1]), pk2(bh[2], bh[3])}; *(u32x2*)(KH + o) = (u32x2){pk2(kh[0], kh[1]), pk2(kh[2], kh[3])};
            }
        }
        if (half) { f32x4 g; for (int i = 0; i < 4; ++i) g[i] = __expf(lg[i]);
            *(f32x4*)(GC + (size_t)c * D + col) = g; }
    }
}

__device__ __forceinline__ void inv32(f32x16 N, f32x16 NT, f32x16& Tm, f32x16& TT, int lane) {
    Tm = N; TT = NT; add_eye(Tm, lane); add_eye(TT, lane);
    Pk Np = pack_tile(N), NTp = pack_tile(NT);
#pragma unroll
    for (int it = 0; it < 4; ++it) {
        const f32x16 z = {};
        const f32x16 N2 = xt(NTp, Np, z), N2T = xt(Np, NTp, z);
        const Pk N2p = pack_tile(N2), N2Tp = pack_tile(N2T), TTp = pack_tile(TT);
        Tm = xt(TTp, N2p, Tm);
        TT = xt(N2p, TTp, TT);
        Np = N2p; NTp = N2Tp;
    }
}

__device__ __forceinline__ void pa_chunk(Frame& F) {
    const int lane = F.lane, c32 = lane & 31, hh = lane >> 5;
    const bf16* AT = (const bf16*)(F.ws + WS_AT); const bf16* BH = (const bf16*)(F.ws + WS_BH); const bf16* KH = (const bf16*)(F.ws + WS_KH); const bf16* V16 = (const bf16*)(F.ws + WS_V16);
    const float* GC = (const float*)(F.ws + WS_GC);
    for (int task = F.gw; task < NCH * NH; task += F.NGW) {
        const int c = task >> 4, h = task & 15; const size_t o = (size_t)(64 * c) * D + h * 64;
        const bf16* at = AT + o; const bf16* bh = BH + o; const bf16* kh = KH + o; const bf16* vv = V16 + o;
        const f32x16 z = {};
        bf16x8 atf[2][4], bhf[2][4], khf[2][4], vvf[2][4];
#pragma unroll
        for (int r2 = 0; r2 < 2; ++r2)
#pragma unroll
            for (int ks = 0; ks < 4; ++ks) { atf[r2][ks] = nfrag(at, r2, ks, lane); bhf[r2][ks] = nfrag(bh, r2, ks, lane); }
        const float g0 = GC[(size_t)c * D + h * 64 + c32], g1 = GC[(size_t)c * D + h * 64 + 32 + c32];
#define NATR(Af, a_, Bf, b_, acc_) do { _Pragma("unroll") for (int ks_ = 0; ks_ < 4; ++ks_) acc_ = MFMA32(Af[a_][ks_], Bf[b_][ks_], acc_); } while (0)
#define DLR(Af, a_, ct_, acc_) do { _Pragma("unroll") for (int k2_ = 0; k2_ < 2; ++k2_) { const int ks_ = 2 * (ct_) + k2_; bf16x8 id_; \
            _Pragma("unroll") for (int e_ = 0; e_ < 8; ++e_) id_[e_] = (32 * (ct_) + c32 == 16 * ks_ + 8 * hh + e_) ? (short)0x3F80 : (short)0; acc_ = MFMA32(Af[a_][ks_], id_, acc_); } } while (0)
        Pk T11T, T22T, T12T;
        {
            Pk T11, T22, T12;
            f32x16 n = z, nt = z; NATR(bhf, 0, atf, 0, n); NATR(atf, 0, bhf, 0, nt); mask_lt(n, lane); mask_gt(nt, lane);
            f32x16 t, tt; inv32(n, nt, t, tt, lane); T11 = pack_tile(t); T11T = pack_tile(tt);
            n = z; nt = z; NATR(bhf, 1, atf, 1, n); NATR(atf, 1, bhf, 1, nt); mask_lt(n, lane); mask_gt(nt, lane);
            inv32(n, nt, t, tt, lane); T22 = pack_tile(t); T22T = pack_tile(tt);
            n = z; nt = z; NATR(bhf, 0, atf, 1, n); NATR(atf, 1, bhf, 0, nt);
            const Pk N12 = pack_tile(n), N12T = pack_tile(nt);
            const Pk Z1 = pack_tile(xt(N12T, T22, z));
            T12 = pack_tile(xt(T11T, Z1, z));
            const Pk Z2 = pack_tile(xt(N12, T11T, z));
            T12T = pack_tile(xt(T22, Z2, z));
            u32x4* tm = (u32x4*)(F.ws + WS_TM) + (size_t)task * 6 * 64 + lane;
            tm[0] = __builtin_bit_cast(u32x4, T11.k0); tm[64] = __builtin_bit_cast(u32x4, T11.k1); tm[128] = __builtin_bit_cast(u32x4, T12.k0); tm[192] = __builtin_bit_cast(u32x4, T12.k1);
            tm[256] = __builtin_bit_cast(u32x4, T22.k0); tm[320] = __builtin_bit_cast(u32x4, T22.k1);
        }
        __builtin_amdgcn_sched_barrier(0);
#pragma unroll
        for (int r2 = 0; r2 < 2; ++r2)
#pragma unroll
            for (int ks = 0; ks < 4; ++ks) khf[r2][ks] = nfrag(kh, r2, ks, lane);
        Pk W1p[2][2];
#pragma unroll
        for (int b = 0; b < 2; ++b) { const float gcol = b == 0 ? g0 : g1;
            f32x16 bb0 = z, bb1 = z; DLR(bhf, 0, b, bb0); DLR(bhf, 1, b, bb1);
#pragma unroll
            for (int r = 0; r < 16; ++r) { bb0[r] *= gcol; bb1[r] *= gcol; }
            const Pk B0 = pack_tile(bb0), B1 = pack_tile(bb1);
            f32x16 w0 = xt(T11T, B0, z); w0 = xt(T12T, B1, w0);
            const f32x16 w1 = xt(T22T, B1, z);
            W1p[0][b] = pack_tile(w0); W1p[1][b] = pack_tile(w1); }
        __builtin_amdgcn_sched_barrier(0);
        {
            bf16* plr = (bf16*)(F.ws + WS_PLR) + (size_t)task * 4096;
#pragma unroll
            for (int a2 = 0; a2 < 2; ++a2) { f32x16 d0 = z, d1 = z; DLR(atf, 0, a2, d0); DLR(atf, 1, a2, d1); const Pk A0 = pack_tile(d0), A1 = pack_tile(d1);
#pragma unroll
                for (int b = 0; b < 2; ++b) { f32x16 p = xt(A0, W1p[0][b], z); p = xt(A1, W1p[1][b], p);
#pragma unroll
                    for (int g4 = 0; g4 < 4; ++g4) {
                        const int m_ = 2 * b + (c32 >> 4), lb_ = (c32 & 15) + 16 * (2 * (g4 & 1) + hh);
                        *(u32x2*)(plr + ((m_ * 2 + a2) * 64 + lb_) * 8 + 4 * (g4 >> 1)) = (u32x2){cvtpk(p[4 * g4], p[4 * g4 + 1]), cvtpk(p[4 * g4 + 2], p[4 * g4 + 3])}; } } }
        }
        __builtin_amdgcn_sched_barrier(0);
#pragma unroll
        for (int r2 = 0; r2 < 2; ++r2)
#pragma unroll
            for (int ks = 0; ks < 4; ++ks) vvf[r2][ks] = nfrag(vv, r2, ks, lane);
        Pk M2p[2][2];
        {
            f32x16 e = z; NATR(atf, 0, khf, 0, e); mask_gt(e, lane); const Pk E00 = pack_tile(e);
            e = z; NATR(atf, 1, khf, 1, e); mask_gt(e, lane); const Pk E11 = pack_tile(e);
            e = z; NATR(atf, 1, khf, 0, e); const Pk E10 = pack_tile(e);
#pragma unroll
            for (int b = 0; b < 2; ++b) { const float gcol = b == 0 ? g0 : g1;
                f32x16 m0 = xt(E00, W1p[0][b], z); m0 = xt(E10, W1p[1][b], m0);
                f32x16 m1 = xt(E11, W1p[1][b], z);
                f32x16 k0 = z, k1 = z; DLR(khf, 0, b, k0); DLR(khf, 1, b, k1);
#pragma unroll
                for (int r = 0; r < 16; ++r) { m0[r] += k0[r] * gcol; m1[r] += k1[r] * gcol; }
                M2p[0][b] = pack_tile(m0); M2p[1][b] = pack_tile(m1); }
        }
        __builtin_amdgcn_sched_barrier(0);
        {
            bf16* qm = (bf16*)(F.ws + WS_QM) + (size_t)task * 4096;
#pragma unroll
            for (int b = 0; b < 2; ++b) { f32x16 d0 = z, d1 = z; DLR(vvf, 0, b, d0); DLR(vvf, 1, b, d1); const Pk V0 = pack_tile(d0), V1 = pack_tile(d1);
#pragma unroll
                for (int a2 = 0; a2 < 2; ++a2) { f32x16 q = xt(M2p[0][a2], V0, z); q = xt(M2p[1][a2], V1, q);
#pragma unroll
                    for (int g4 = 0; g4 < 4; ++g4) {
                        const int rg_ = 2 * b + (c32 >> 4), m_ = 2 * a2 + (g4 >> 1), lb_ = (c32 & 15) + 16 * (2 * (g4 & 1) + hh);
                        *(u32x2*)(qm + rg_ * 1024 + (m_ * 64 + lb_) * 4) = (u32x2){cvtpk(q[4 * g4], q[4 * g4 + 1]), cvtpk(q[4 * g4 + 2], q[4 * g4 + 3])}; } } }
        }
#undef NATR
#undef DLR
    }
}

constexpr int PB_NST = 12, PB_QOFF = 8192, PB_GOFF = 8192 + 2048, PB_STB = 8192 + 2048 + 256, PB_NLD = 4, PB_NDMA = 11;
constexpr int PB_FULL_OFF = RING_BYTES + 64, PB_CONS_OFF = RING_BYTES + 128, PB_DUMP_OFF = RING_BYTES + 2048;
static_assert(PB_NST * PB_STB <= RING_BYTES && PB_FULL_OFF + 4 * PB_NST <= PB_CONS_OFF && PB_CONS_OFF + 4 <= MISC_OFF, "phase-B LDS map");
__device__ __forceinline__ void pb_chain(Frame& F) {
    if ((F.vcu & 31) >= 8 || F.vcu >= 256 || F.wave > PB_NLD) return;
    static_assert(PB_NLD == 4 && PB_NDMA == 11 && 2 * PB_NLD < PB_NST, "the counted waits below assume 11 LDS-DMA instructions per stage and publish two of a loader's stages behind");
    const int lane = F.lane, h = 2 * (F.vcu >> 5) + ((F.vcu & 31) >> 2), rg = F.vcu & 3;
    volatile LAS unsigned* FULL = (volatile LAS unsigned*)(F.lds + PB_FULL_OFF); volatile LAS unsigned* CONS = (volatile LAS unsigned*)(F.lds + PB_CONS_OFF);
    if (F.wave >= 1) {
        const int L = F.wave - 1;
        const char* PLR = (const char*)(F.ws + WS_PLR); const char* QM = (const char*)(F.ws + WS_QM); const float* GC = (const float*)(F.ws + WS_GC);
        int k = 0;
        for (int c = L; c < NCH; c += PB_NLD, ++k) {
            if (c >= PB_NST) { const unsigned need = (unsigned)(c - PB_NST + 1); unsigned sp = 0; while (CONS[0] < need) { __builtin_amdgcn_s_sleep(1); if (++sp > (1u << 22)) break; } }
            const size_t task = (size_t)c * 16 + h;
            LAS unsigned char* slot = F.lds + (c % PB_NST) * PB_STB;
            const char* pl = PLR + task * 8192 + lane * 16; const char* qm = QM + task * 8192 + rg * 2048 + lane * 16;
#pragma unroll
            for (int i = 0; i < 8; ++i) __builtin_amdgcn_global_load_lds((const unsigned*)(pl + i * 1024), (LAS unsigned*)(slot + i * 1024), 16, 0, 0);
#pragma unroll
            for (int i = 0; i < 2; ++i) __builtin_amdgcn_global_load_lds((const unsigned*)(qm + i * 1024), (LAS unsigned*)(slot + PB_QOFF + i * 1024), 16, 0, 0);
            __builtin_amdgcn_global_load_lds((const unsigned*)(GC + (size_t)c * D + h * 64 + lane), (LAS unsigned*)(slot + PB_GOFF), 4, 0, 0);
            if (k >= 2) { asm volatile("s_waitcnt vmcnt(22)" ::: "memory"); const int cp = c - 2 * PB_NLD; FULL[cp % PB_NST] = (unsigned)(cp + 1); }
        }
        const int clast = L + PB_NLD * (k - 1);
        if (k >= 2) { asm volatile("s_waitcnt vmcnt(11)" ::: "memory"); const int cp = clast - PB_NLD; FULL[cp % PB_NST] = (unsigned)(cp + 1); }
        asm volatile("s_waitcnt vmcnt(0)" ::: "memory"); FULL[clast % PB_NST] = (unsigned)(clast + 1);
        return;
    }
    const int n16 = lane & 15, q4 = lane >> 4;
    bf16* S0 = (bf16*)(F.ws + WS_S0);
    f32x4 s[4];
#pragma unroll
    for (int m = 0; m < 4; ++m) s[m] = (f32x4){0.f, 0.f, 0.f, 0.f};
    bf16x8 af[4][2]; u32x2 qv[4]; f32x4 gc[4];
#define PB_TAKE(cc) do { { const unsigned need_ = (unsigned)((cc) + 1); unsigned sp_ = 0; while (FULL[(cc) % PB_NST] < need_) { if (++sp_ > (1u << 24)) break; } } \
        const LAS unsigned char* slot_ = F.lds + ((cc) % PB_NST) * PB_STB; \
        _Pragma("unroll") for (int m = 0; m < 4; ++m) { _Pragma("unroll") for (int kb = 0; kb < 2; ++kb) af[m][kb] = *(const LAS bf16x8*)(slot_ + ((m * 2 + kb) * 64 + lane) * 16); \
            qv[m] = *(const LAS u32x2*)(slot_ + PB_QOFF + (m * 64 + lane) * 8); gc[m] = *(const LAS f32x4*)(slot_ + PB_GOFF + 64 * m + 16 * q4); } \
        asm volatile("s_waitcnt lgkmcnt(0)" ::: "memory"); CONS[0] = (unsigned)((cc) + 1); } while (0)
    PB_TAKE(0);
    for (int c = 0; c < NCH; ++c) {
        bf16* s0 = S0 + ((size_t)c * 16 + h) * 4096 + (16 * rg + n16) * 64;
        u32x2 sp2[4];
#pragma unroll
        for (int m = 0; m < 4; ++m) { sp2[m] = (u32x2){cvtpk(s[m][0], s[m][1]), cvtpk(s[m][2], s[m][3])}; *(u32x2*)(s0 + 16 * m + 4 * q4) = sp2[m]; }
        const bf16x8 B0 = __builtin_bit_cast(bf16x8, (u32x4){sp2[0].x, sp2[0].y, sp2[1].x, sp2[1].y}), B1 = __builtin_bit_cast(bf16x8, (u32x4){sp2[2].x, sp2[2].y, sp2[3].x, sp2[3].y});
        f32x4 acc[4];
#pragma unroll
        for (int m = 0; m < 4; ++m) { acc[m] = s[m] * gc[m] + (f32x4){bflo(qv[m].x), bfhi(qv[m].x), bflo(qv[m].y), bfhi(qv[m].y)};
            acc[m] = __builtin_amdgcn_mfma_f32_16x16x32_bf16(af[m][0], B0, acc[m], 0, 0, 0);
            acc[m] = __builtin_amdgcn_mfma_f32_16x16x32_bf16(af[m][1], B1, acc[m], 0, 0, 0); }
        if (c + 1 < NCH) PB_TAKE(c + 1);
#pragma unroll
        for (int m = 0; m < 4; ++m) s[m] = acc[m];
    }
#undef PB_TAKE
}

__device__ __forceinline__ void pc_out(Frame& F, const Args& a) {
    const int lane = F.lane, c32 = lane & 31, hh = lane >> 5;
    const bf16* AT = (const bf16*)(F.ws + WS_AT); const bf16* RT = (const bf16*)(F.ws + WS_RT); const bf16* BH = (const bf16*)(F.ws + WS_BH); const bf16* KH = (const bf16*)(F.ws + WS_KH);
    const bf16* V16 = (const bf16*)(F.ws + WS_V16); const bf16* S0 = (const bf16*)(F.ws + WS_S0);
    const bf16* G = (const bf16*)(F.ws + WS_G); const float* C3 = (const float*)(F.ws + WS_CS) + (size_t)2 * T * 16; bf16* Z = (bf16*)(F.ws + WS_Z);
    LAS float* ysc = (LAS float*)(F.lds + F.wave * 16384);
    for (int task = F.gw; task < NCH * NH; task += F.NGW) {
        const int c = task >> 4, h = task & 15; const size_t o = (size_t)(64 * c) * D + h * 64;
        const bf16* at = AT + o; const bf16* rt = RT + o; const bf16* bh = BH + o; const bf16* kh = KH + o; const bf16* vv = V16 + o;
        const bf16* s0 = S0 + (size_t)task * 4096;
        const f32x16 z = {};
#define NATR(Af, a_, Bf, b_, acc_) do { _Pragma("unroll") for (int ks_ = 0; ks_ < 4; ++ks_) acc_ = MFMA32(Af[a_][ks_], Bf[b_][ks_], acc_); } while (0)
        Pk K00, K01, K11, B00, B01, B11, R00, R01, R11, Tm00, Tm01, Tm11;
        {
            bf16x8 atf[2][4], khf[2][4], rtf[2][4], bhf[2][4];
#pragma unroll
            for (int r2 = 0; r2 < 2; ++r2)
#pragma unroll
                for (int ks = 0; ks < 4; ++ks) { atf[r2][ks] = nfrag(at, r2, ks, lane); khf[r2][ks] = nfrag(kh, r2, ks, lane); rtf[r2][ks] = nfrag(rt, r2, ks, lane); bhf[r2][ks] = nfrag(bh, r2, ks, lane); }
            { const u32x4* tm = (const u32x4*)(F.ws + WS_TM) + (size_t)task * 6 * 64 + lane;
              Tm00.k0 = __builtin_bit_cast(bf16x8, tm[0]); Tm00.k1 = __builtin_bit_cast(bf16x8, tm[64]); Tm01.k0 = __builtin_bit_cast(bf16x8, tm[128]); Tm01.k1 = __builtin_bit_cast(bf16x8, tm[192]);
              Tm11.k0 = __builtin_bit_cast(bf16x8, tm[256]); Tm11.k1 = __builtin_bit_cast(bf16x8, tm[320]); }
            f32x16 e;
            e = z; NATR(khf, 0, atf, 0, e); mask_lt(e, lane); K00 = pack_tile(e);
            e = z; NATR(khf, 1, atf, 1, e); mask_lt(e, lane); K11 = pack_tile(e);
            e = z; NATR(khf, 0, atf, 1, e); K01 = pack_tile(e);
            e = z; NATR(bhf, 0, rtf, 0, e); mask_le(e, lane); B00 = pack_tile(e);
            e = z; NATR(bhf, 1, rtf, 1, e); mask_le(e, lane); B11 = pack_tile(e);
            e = z; NATR(bhf, 0, rtf, 1, e); B01 = pack_tile(e);
            e = z; NATR(khf, 0, rtf, 0, e); mask_le(e, lane); R00 = pack_tile(e);
            e = z; NATR(khf, 1, rtf, 1, e); mask_le(e, lane); R11 = pack_tile(e);
            e = z; NATR(khf, 0, rtf, 1, e); R01 = pack_tile(e);
        }
        __builtin_amdgcn_sched_barrier(0);
#pragma unroll 1
        for (int b = 0; b < 2; ++b) {
            bf16x8 vvf[2][2], sf[4], atf[2][4], rtf[2][4];
#pragma unroll
            for (int r2 = 0; r2 < 2; ++r2)
#pragma unroll
                for (int k2 = 0; k2 < 2; ++k2) vvf[r2][k2] = nfrag(vv, r2, 2 * b + k2, lane);
#pragma unroll
            for (int ks = 0; ks < 4; ++ks) sf[ks] = *(const bf16x8*)(s0 + (32 * b + c32) * 64 + 16 * ks + 8 * hh);
#pragma unroll
            for (int r2 = 0; r2 < 2; ++r2)
#pragma unroll
                for (int ks = 0; ks < 4; ++ks) { atf[r2][ks] = nfrag(at, r2, ks, lane); rtf[r2][ks] = nfrag(rt, r2, ks, lane); }
            Pk V0, V1;
            { f32x16 v0 = z, v1 = z;
#pragma unroll
              for (int k2 = 0; k2 < 2; ++k2) { const int ks = 2 * b + k2; bf16x8 id;
#pragma unroll
                  for (int e2 = 0; e2 < 8; ++e2) id[e2] = (32 * b + c32 == 16 * ks + 8 * hh + e2) ? (short)0x3F80 : (short)0;
                  v0 = MFMA32(vvf[0][k2], id, v0); v1 = MFMA32(vvf[1][k2], id, v1); }
              V0 = pack_tile(v0); V1 = pack_tile(v1); }
            f32x16 x0 = z, x1 = z;
#pragma unroll
            for (int ks = 0; ks < 4; ++ks) { x0 = MFMA32(atf[0][ks], sf[ks], x0); x1 = MFMA32(atf[1][ks], sf[ks], x1); }
            x0 = xt(K00, V0, x0);
            x1 = xt(K01, V0, x1); x1 = xt(K11, V1, x1);
            const Pk X0 = pack_tile(x0), X1 = pack_tile(x1);
            __builtin_amdgcn_sched_barrier(0);
            const Pk U0 = pack_tile(xt(Tm00, X0, z));
            f32x16 u1 = xt(Tm01, X0, z); u1 = xt(Tm11, X1, u1); const Pk U1 = pack_tile(u1);
            __builtin_amdgcn_sched_barrier(0);
            f32x16 y0 = z, y1 = z;
#pragma unroll
            for (int ks = 0; ks < 4; ++ks) { y0 = MFMA32(rtf[0][ks], sf[ks], y0); y1 = MFMA32(rtf[1][ks], sf[ks], y1); }
            y0 = xt(B00, U0, y0); y1 = xt(B01, U0, y1); y1 = xt(B11, U1, y1);
            y0 = xt(R00, V0, y0); y1 = xt(R01, V0, y1); y1 = xt(R11, V1, y1);
            __builtin_amdgcn_sched_barrier(0);
#pragma unroll
            for (int r = 0; r < 16; ++r) { ysc[crow(r, hh) * 64 + 32 * b + c32] = y0[r]; ysc[(32 + crow(r, hh)) * 64 + 32 * b + c32] = y1[r]; }
        }
#undef NATR
        LDS_WAIT();
        {
            int lane_e = lane; asm volatile("" : "+v"(lane_e));
            const int l16 = lane_e & 15, tq = lane_e >> 4, col = h * 64 + 4 * l16;
            const f32x4 gg = *(const f32x4*)(a.in[16] + col), gb = *(const f32x4*)(a.in[17] + col);
            u32x2 gwv[16], vwv[16]; float c3v[16];
#pragma unroll
            for (int it = 0; it < 16; ++it) { const size_t row = (size_t)(64 * c + 4 * it + tq); gwv[it] = *(const u32x2*)(G + row * D + col); vwv[it] = *(const u32x2*)(V16 + row * D + col); c3v[it] = C3[row * 16 + h]; }
#pragma unroll
            for (int it = 0; it < 16; ++it) { const int tt = 4 * it + tq; const size_t row = (size_t)(64 * c + tt);
                const f32x4 y = *(const LAS f32x4*)(ysc + tt * 64 + 4 * l16);
                const u32x2 gw = gwv[it], vw = vwv[it]; const float c3 = c3v[it];
                const float mean = row16_sum((y[0] + y[1]) + (y[2] + y[3])) * (1.f / 64.f);
                const f32x4 d = y - mean;
                const float var = row16_sum((d[0] * d[0] + d[1] * d[1]) + (d[2] * d[2] + d[3] * d[3])) * (1.f / 64.f);
                const float rs = rsqrtf(var + GN_EPS);
                const f32x4 g = {bflo(gw.x), bfhi(gw.x), bflo(gw.y), bfhi(gw.y)}, v = {bflo(vw.x), bfhi(vw.x), bflo(vw.y), bfhi(vw.y)};
                const f32x4 zv = (d * rs * gg + gb + c3 * v) * g;
                *(u32x2*)(Z + row * D + col) = (u32x2){pk2(zv[0], zv[1]), pk2(zv[2], zv[3])}; }
        }
        LDS_WAIT();
    }
}

__device__ __forceinline__ void p8_norm(Frame& F, const float* g, bf16* U) {
    const float* Hs = (const float*)(F.ws + WS_H); const Row gr = ld_row(g, F.lane);
    for (int t = F.gw; t < T; t += F.NGW) st_row_bf16(U + (size_t)t * D, F.lane, rmsnorm_row(ld_row(Hs + (size_t)t * D, F.lane), gr));
}
__device__ __forceinline__ void p11_norm_forget(Frame& F, const Args& a) {
    const int lane = F.lane; const float* Hs = (const float*)(F.ws + WS_H); bf16* U = (bf16*)(F.ws + WS_U3); float* LF = (float*)(F.ws + WS_LF);
    LAS float* wf = (LAS float*)F.lds;
    __syncthreads();
    for (int i = F.tid; i < 16 * D; i += NTHREADS) { const int hh = i & 15, k = i >> 4; wf[hh * D + k] = a.in[19][(size_t)k * WIN_LD + 4 * D + hh]; }
    __syncthreads();
    const Row gr = ld_row(a.in[1] + 2 * D, lane);
    for (int tg = F.gw; tg < T / 4; tg += F.NGW) {
        Row u[4];
#pragma unroll
        for (int r = 0; r < 4; ++r) { u[r] = rmsnorm_row(ld_row(Hs + (size_t)(4 * tg + r) * D, lane), gr); st_row_bf16(U + (size_t)(4 * tg + r) * D, lane, u[r]); }
        float mine[4] = {0.f, 0.f, 0.f, 0.f};
#pragma unroll 2
        for (int hh = 0; hh < 16; ++hh) { float s4[4] = {0.f, 0.f, 0.f, 0.f};
#pragma unroll
            for (int j = 0; j < 4; ++j) { const f32x4 w = *(const LAS f32x4*)(wf + hh * D + 256 * j + 4 * lane);
#pragma unroll
                for (int r = 0; r < 4; ++r) s4[r] += (u[r].v[j][0] * w[0] + u[r].v[j][1] * w[1]) + (u[r].v[j][2] * w[2] + u[r].v[j][3] * w[3]); }
#pragma unroll
            for (int r = 0; r < 4; ++r) { const float t_ = wave_sum(s4[r]); if (lane == hh) mine[r] = t_; } }
        if (lane < 16) { const float bf_ = a.in[20][lane];
#pragma unroll
            for (int r = 0; r < 4; ++r) { const float x = mine[r] + bf_; LF[(size_t)(4 * tg + r) * 16 + lane] = fminf(x, 0.f) - log1pf(__expf(-fabsf(x))); } }
    }
    __syncthreads();
}
__device__ __forceinline__ void p12_cumsum(Frame& F) {
    if (F.vcu >= NH) return;
    const int tid = F.tid, h = F.vcu;
    const float* LF = (const float*)(F.ws + WS_LF); float* C2 = (float*)(F.ws + WS_C2); float* CB = (float*)(F.ws + WS_CB);
    LAS double* part = (LAS double*)F.lds;
    __syncthreads();
    const int tb = tid * 32; float lf[32]; double s = 0.0;
#pragma unroll
    for (int i = 0; i < 32; ++i) lf[i] = LF[(size_t)(tb + i) * 16 + h];
#pragma unroll
    for (int i = 0; i < 32; ++i) s += (double)lf[i];
    part[tid] = s; __syncthreads();
    if (tid < 64) {
        double v[8], run = 0.0;
#pragma unroll
        for (int i = 0; i < 8; ++i) { v[i] = part[tid * 8 + i]; run += v[i]; }
        double inc = run;
#pragma unroll
        for (int o = 1; o < 64; o <<= 1) { const double nb = __shfl_up(inc, o); if (tid >= o) inc += nb; }
        double ex = inc - run;
#pragma unroll
        for (int i = 0; i < 8; ++i) { part[tid * 8 + i] = ex; ex += v[i]; }
    }
    __syncthreads();
    double run = part[tid];
#pragma unroll
    for (int i = 0; i < 32; ++i) { run += (double)lf[i]; const float c = (float)(run * 1.4426950408889634); C2[(size_t)h * T + tb + i] = c; if (((tb + i) & 63) == 63) CB[h * 256 + ((tb + i) >> 6)] = c; }
    __syncthreads();
}

#ifndef ATTN_STORE16
#define ATTN_STORE16(p,v) (*(u32x4*)(p)=(v))
#endif
namespace attn_body {
using bf16x8=__attribute__((ext_vector_type(8)))short;
using s16x4=__attribute__((ext_vector_type(4)))short;
using f32x16=__attribute__((ext_vector_type(16)))float;
using u32x4=__attribute__((ext_vector_type(4)))unsigned;
constexpr int NHEAD=16,SEQ=16384,D=64,DM=4096,OM=1024;
constexpr int NW=8,QBLK=32,QB=QBLK*NW,KVBLK=64,NQB=SEQ/QB;
constexpr int ATTN_UNIT_ROWS=QB;
__device__ __forceinline__ int crow(int r,int hi){return (r&3)+8*(r>>2)+4*hi;}
#define SBAR() __builtin_amdgcn_sched_barrier(0)
__device__ __forceinline__ void cmask(f32x16&p0,f32x16&p1,int jb,int qrel,int hi){
  const float NEG=-INFINITY; int kb=64*jb+4*hi;
  #pragma unroll
  for(int r=0;r<16;++r){int kv=kb+(r&3)+8*(r>>2); if(kv>qrel)p0[r]=NEG; if(kv+32>qrel)p1[r]=NEG;}
}

constexpr int NSLOT=3, SLOTB=8192;
constexpr int LDS_K=0, LDS_V=NSLOT*SLOTB, LDS_WS=2*NSLOT*SLOTB, LDS_OST=LDS_WS+NW*64*4, LDS_BYTES=LDS_OST+NW*4096;
constexpr float C2=0.125f*1.4426950408889634f;
__device__ __forceinline__ void glds16(const void*gsrc,unsigned lds_dst){unsigned keep;
  asm volatile("s_mov_b32 %0, m0\n\ts_mov_b32 m0, %2\n\ts_nop 0\n\tglobal_load_lds_dwordx4 %1, off\n\ts_mov_b32 m0, %0":"=&s"(keep):"v"(gsrc),"s"(lds_dst):"memory");}
__device__ __forceinline__ float max3f(float a,float b,float c){float r;asm("v_max3_f32 %0, %1, %2, %3":"=v"(r):"v"(a),"v"(b),"v"(c));return r;}
__device__ __forceinline__ float max2f(float a,float b){float r;asm("v_max_f32_e32 %0, %1, %2":"=v"(r):"v"(a),"v"(b));return r;}
__device__ __forceinline__ float fadd_s(float a,float b){float r;asm("v_add_f32_e32 %0, %1, %2":"=v"(r):"v"(a),"v"(b));return r;}
__device__ __forceinline__ float fsub_s(float a,float b){float r;asm("v_sub_f32_e32 %0, %1, %2":"=v"(r):"v"(a),"v"(b));return r;}
typedef float f32x2_t __attribute__((ext_vector_type(2))); typedef __bf16 bf16x2_t __attribute__((ext_vector_type(2)));
__device__ __forceinline__ unsigned cvtpk_s(float lo,float hi){f32x2_t v={lo,hi};bf16x2_t b=__builtin_convertvector(v,bf16x2_t);return __builtin_bit_cast(unsigned,b);}
#define WAIT_BAR(N) asm volatile("s_waitcnt vmcnt(" #N ") lgkmcnt(0)\n\ts_barrier":::"memory")

__device__ __forceinline__ void qkt(f32x16&p0,f32x16&p1,const char*Kslot,const __attribute__((address_space(3))) char*qst,const f32x16&cin0,const f32x16&cin1,int r32,int hi){
  #define QF_(i) (*(const __attribute__((address_space(3))) bf16x8*)(qst+(i)*1024))
  const char*kb=Kslot+hi*1024+r32*16;
  #pragma unroll
  for(int d0=0;d0<4;++d0){
    const bf16x8 b0=*reinterpret_cast<const bf16x8*>(kb+d0*2048);
    const bf16x8 b1=*reinterpret_cast<const bf16x8*>(kb+d0*2048+512);
    const bf16x8 qd=QF_(d0);
    if(d0==0){p0=__builtin_amdgcn_mfma_f32_32x32x16_bf16(b0,qd,cin0,0,0,0);p1=__builtin_amdgcn_mfma_f32_32x32x16_bf16(b1,qd,cin1,0,0,0);}
    else{p0=__builtin_amdgcn_mfma_f32_32x32x16_bf16(b0,qd,p0,0,0,0);p1=__builtin_amdgcn_mfma_f32_32x32x16_bf16(b1,qd,p1,0,0,0);}}
  #undef QF_
}
typedef __attribute__((address_space(3))) const char* lds_cptr;
typedef short v4i16_t __attribute__((ext_vector_type(4)));
__device__ __forceinline__ void kload8(bf16x8*kf,lds_cptr kp){
  kf[0]=*(const __attribute__((address_space(3))) bf16x8*)(kp);      kf[1]=*(const __attribute__((address_space(3))) bf16x8*)(kp+512);
  kf[2]=*(const __attribute__((address_space(3))) bf16x8*)(kp+2048); kf[3]=*(const __attribute__((address_space(3))) bf16x8*)(kp+2560);
  kf[4]=*(const __attribute__((address_space(3))) bf16x8*)(kp+4096); kf[5]=*(const __attribute__((address_space(3))) bf16x8*)(kp+4608);
  kf[6]=*(const __attribute__((address_space(3))) bf16x8*)(kp+6144); kf[7]=*(const __attribute__((address_space(3))) bf16x8*)(kp+6656);
}
__device__ __forceinline__ void kload2(bf16x8*kf,lds_cptr kp,int j){ kf[2*j]=*(const __attribute__((address_space(3))) bf16x8*)(kp+j*2048); kf[2*j+1]=*(const __attribute__((address_space(3))) bf16x8*)(kp+j*2048+512); }
__device__ __forceinline__ s16x4 vtr(lds_cptr p){ return __builtin_bit_cast(s16x4,__builtin_amdgcn_ds_read_tr16_b64_v4i16((__attribute__((address_space(3))) v4i16_t*)p)); }
__device__ __forceinline__ float rowmax(const f32x16&p0,const f32x16&p1){
  float a=max3f(p0[0],p0[1],p1[0]),b=max3f(p0[2],p0[3],p1[1]);a=max3f(a,p1[2],p1[3]);
  #pragma unroll
  for(int r=4;r<16;r+=4){a=max3f(a,p0[r],p0[r+1]);b=max3f(b,p0[r+2],p0[r+3]);a=max3f(a,p1[r],p1[r+1]);b=max3f(b,p1[r+2],p1[r+3]);}
  const float m=max2f(a,b);
  auto rr=__builtin_amdgcn_permlane32_swap(__float_as_uint(m),__float_as_uint(m),false,false);
  return max2f(__uint_as_float(rr[0]),__uint_as_float(rr[1]));
}
__device__ __forceinline__ void pv(f32x16*o,int vb,bf16x8 pa0,bf16x8 pa1,bf16x8 pa2,bf16x8 pa3){
  #pragma unroll
  for(int d0=0;d0<2;++d0){s16x4 lo[4],hi[4];
    #pragma unroll
    for(int ks=0;ks<4;++ks){
      asm volatile("ds_read_b64_tr_b16 %0,%1 offset:%c2":"=&v"(lo[ks]):"v"(vb),"i"(d0*4096+ks*1024):"memory");
      asm volatile("ds_read_b64_tr_b16 %0,%1 offset:%c2":"=&v"(hi[ks]):"v"(vb),"i"(d0*4096+ks*1024+512):"memory");}
    asm volatile("s_waitcnt lgkmcnt(0)":::"memory");SBAR();
    #define PK(k) (bf16x8){lo[k][0],lo[k][1],lo[k][2],lo[k][3],hi[k][0],hi[k][1],hi[k][2],hi[k][3]}
    o[d0]=__builtin_amdgcn_mfma_f32_32x32x16_bf16(pa0,PK(0),o[d0],0,0,0);
    o[d0]=__builtin_amdgcn_mfma_f32_32x32x16_bf16(pa1,PK(1),o[d0],0,0,0);
    o[d0]=__builtin_amdgcn_mfma_f32_32x32x16_bf16(pa2,PK(2),o[d0],0,0,0);
    o[d0]=__builtin_amdgcn_mfma_f32_32x32x16_bf16(pa3,PK(3),o[d0],0,0,0);
    #undef PK
  }
}

#ifndef ATTN_STORE16
#define ATTN_STORE16(p,v) (*(u32x4*)(p)=(v))
#endif
template<int THRL> __device__ __forceinline__ void attn_unit(int h,int qb,int jstart,const bf16*Q,const bf16*__restrict__ K,const bf16*__restrict__ V,const bf16*__restrict__ OG,bf16*O,const float*__restrict__ C2h,char*shm){
  const int tid=threadIdx.x,lane=tid&63,r32=lane&31,hi=lane>>5; const int wid=__builtin_amdgcn_readfirstlane(tid>>6);
  const long rowbase=0; const int q0=qb*QB;
  const bf16*Qw=Q+(rowbase+q0+wid*QBLK)*DM+h*D;
  const bf16*Kh=K+(rowbase+(long)jstart*KVBLK)*DM+h*D,*Vh=V+(rowbase+(long)jstart*KVBLK)*DM+h*D;
  const lds_cptr shm3=(lds_cptr)shm;
  const unsigned lds0=(unsigned)(uintptr_t)shm;
  float*wsf=(float*)(shm+LDS_WS)+wid*64;
  const bf16*ksrc=Kh+(long)lane*DM+wid*8;
  const bf16*vsrc=Vh+(long)(16*(wid&3)+(lane>>2))*DM+(wid>>2)*32+(lane&3)*8;
  const unsigned kdst=lds0+LDS_K+wid*1024, vdst=lds0+LDS_V+wid*1024;
  #define DMA_K(t,slot) glds16(ksrc+(long)(t)*KVBLK*DM,(unsigned)__builtin_amdgcn_readfirstlane(kdst+(slot)))
  #define DMA_V(t,slot) glds16(vsrc+(long)(t)*KVBLK*DM,(unsigned)__builtin_amdgcn_readfirstlane(vdst+(slot)))
  const int vb0=(int)(lds0+LDS_V)+((lane>>4)&1)*32+(lane&3)*8+(4*hi+((lane&15)>>2))*64;
  const char*Kbase=shm+LDS_K; bf16x8 kf[8];
  const lds_cptr kp0=shm3+LDS_K+hi*1024+r32*16; const lds_cptr vp0=shm3+LDS_V+((lane>>4)&1)*32+(lane&3)*8+(4*hi+((lane&15)>>2))*64;
  const int NT=(q0+QB)/KVBLK-jstart;
  DMA_K(0,0);DMA_V(0,0);DMA_K(1,SLOTB);
  typedef __attribute__((address_space(3))) u32x4* lds_rptr; const lds_rptr brec=(lds_rptr)(shm3+LDS_BYTES);
  { const float cref=C2h[q0]; const float*cs=C2h+(long)jstart*KVBLK;
    int tid_e=tid; asm volatile("":"+v"(tid_e));
    for(int i_=tid_e;i_<NT*KVBLK;i_+=NW*64){ const float x_=cref-cs[i_]; const unsigned a1_=f2bf(x_); const float r1_=x_-__uint_as_float(a1_<<16); const unsigned a2_=f2bf(r1_); const float r2_=r1_-__uint_as_float(a2_<<16); const unsigned a3_=f2bf(r2_);
      brec[i_]=(u32x4){a1_|(a2_<<16),a3_,0u,0u}; }
    if(tid==0)brec[NT*KVBLK]=(u32x4){0x3F803F80u,0x00003F80u,0u,0u}; }
  const lds_cptr abp=(lds_cptr)brec+(hi?NT*KVBLK*16:r32*16); const int ast=hi?0:KVBLK*16, ab1=hi?0:32*16;
  #define ABF(t,half) (*(const __attribute__((address_space(3))) bf16x8*)(abp+(t)*ast+(half)*ab1))
  const lds_cptr qst=shm3+LDS_OST+wid*4096+lane*16;
  #pragma unroll
  for(int d0=0;d0<4;++d0){ const u32x4 qv_=*reinterpret_cast<const u32x4*>(&Qw[(long)r32*DM+d0*16+hi*8]); *(__attribute__((address_space(3))) u32x4*)(const_cast<__attribute__((address_space(3))) char*>(qst)+d0*1024)=qv_; }
  #define QF(i) (*(const __attribute__((address_space(3))) bf16x8*)(qst+(i)*1024))
  float mhat=0.f,l_reg=0.f;f32x16 o[2];o[0]=f32x16{};o[1]=f32x16{};
  u32x4 bmw=hi?(u32x4){0u,0u,0u,0u}:(u32x4){0x3F803F80u,0x00003F80u,0u,0u};
  #define SETBM() do{ const float nm_=-mhat; const unsigned a1_=f2bf(nm_); const float r1_=nm_-__uint_as_float(a1_<<16); const unsigned a2_=f2bf(r1_); const float r2_=r1_-__uint_as_float(a2_<<16); const unsigned a3_=f2bf(r2_); if(hi){bmw[0]=a1_|(a2_<<16);bmw[1]=a3_;} }while(0)
  #define BMF() __builtin_bit_cast(bf16x8,bmw)
  const f32x16 zero16=f32x16{};
  const int qrel=wid*QBLK+r32;
  #define CMASK(P0,P1,t) do{int jb_=(t)-(NT-4); if(jb_>=0)cmask(P0,P1,jb_,qrel,hi);}while(0)
  bool resc=false;
  #define START(P0,P1) do{ const float rm=rowmax(P0,P1); resc=false; \
    { const float dl=rm; mhat=fadd_s(mhat,dl); \
      _Pragma("unroll") for(int r=0;r<16;++r){P0[r]=fsub_s(P0[r],dl);P1[r]=fsub_s(P1[r],dl);} \
      SETBM(); } \
    _Pragma("unroll") for(int r=0;r<16;++r)P0[r]=__builtin_amdgcn_exp2f(P0[r]); }while(0)
  #define RESC() do{ if(resc){ asm volatile("s_waitcnt lgkmcnt(0)":::"memory"); \
      _Pragma("unroll") for(int d_=0;d_<2;++d_) _Pragma("unroll") for(int r=0;r<16;++r)o[d_][r]*=wsf[crow(r,hi)]; } }while(0)
  f32x16 pA0,pA1,pB0,pB1;
  int sl_prev=0,sl_cur=0,sl_next=SLOTB;
  #define ROT() do{sl_prev=sl_cur;sl_cur=sl_next;sl_next=(sl_next==(NSLOT-1)*SLOTB)?0:sl_next+SLOTB;}while(0)
  DMA_K(2,2*SLOTB);
  WAIT_BAR(3);
  { const f32x16 c0_=__builtin_amdgcn_mfma_f32_32x32x16_bf16(ABF(0,0),BMF(),zero16,0,0,0), c1_=__builtin_amdgcn_mfma_f32_32x32x16_bf16(ABF(0,1),BMF(),zero16,0,0,0); qkt(pA0,pA1,Kbase,qst,c0_,c1_,r32,hi); }
  asm volatile("s_nop 15\n\ts_nop 7":"+v"(pA0),"+v"(pA1));CMASK(pA0,pA1,0);
  START(pA0,pA1);
  _Pragma("unroll") for(int r=0;r<16;++r)pA1[r]=__builtin_amdgcn_exp2f(pA1[r]);
  WAIT_BAR(0);
  DMA_K(3,0);DMA_V(1,SLOTB);
  ROT();
  kload8(kf,kp0+sl_cur);
  WAIT_BAR(2);
  s16x4 vlo[8],vhi[8]; u32x4 pw0,pw1,pw2,pw3;
  #define PKW(P,B) cvtpk_s(P[B],P[B+1])
  #define PAF(k) __builtin_bit_cast(bf16x8,pw##k)
  #define VFR(i) (bf16x8){vlo[i][0],vlo[i][1],vlo[i][2],vlo[i][3],vhi[i][0],vhi[i][1],vhi[i][2],vhi[i][3]}
  #define PIN(x) asm volatile("":"+v"(x))
  #define MX3(a,b,c) __builtin_fmaxf(__builtin_fmaxf((a),(b)),(c))
  #define GAPA(MF,A0,A1,A2,A3,W0,W1,PW) do{ MF; sacc+=A0; sacc+=A1; sacc+=A2; sacc+=A3; PIN(sacc); W0; W1; PIN(PW); SBAR(); }while(0)
  #define EX(v) __builtin_amdgcn_exp2f(v)
  #define GAPB(MF,X,B) do{ MF; X[B]=EX(X[B]); X[B+1]=EX(X[B+1]); X[B+2]=EX(X[B+2]); X[B+3]=EX(X[B+3]); PIN(X); SBAR(); }while(0)
  #define VRD(i) do{ vlo[i]=vtr(vp_+(((i)>>2)*4096+((i)&3)*1024)); vhi[i]=vtr(vp_+(((i)>>2)*4096+((i)&3)*1024+512)); }while(0)
  #define KRD(G,j) do{ if(G){ kload2(kf,kp0+sl_next,j); SBAR(); } }while(0)
  #define STEP(C0,C1,P0,P1,t,GK,GV,GL) do{ SBAR(); \
    const lds_cptr vp_=vp0+sl_prev; \
    VRD(0); SBAR(); float sacc=(P0[0]+P0[1]); \
    C0=__builtin_amdgcn_mfma_f32_32x32x16_bf16(ABF(t,0),BMF(),zero16,0,0,0); C1=__builtin_amdgcn_mfma_f32_32x32x16_bf16(ABF(t,1),BMF(),zero16,0,0,0); SBAR(); \
    GAPA(C0=__builtin_amdgcn_mfma_f32_32x32x16_bf16(kf[0],QF(0),C0,0,0,0), P0[2],P0[3],P0[4],P0[5],     pw0[0]=PKW(P0,0), pw0[1]=PKW(P0,2), pw0); \
    VRD(4); SBAR(); GAPA(C1=__builtin_amdgcn_mfma_f32_32x32x16_bf16(kf[1],QF(0),C1,0,0,0), P0[6],P0[7],P0[8],P0[9],     pw0[2]=PKW(P0,4), pw0[3]=PKW(P0,6), pw0); \
    VRD(1); SBAR(); GAPA(C0=__builtin_amdgcn_mfma_f32_32x32x16_bf16(kf[2],QF(1),C0,0,0,0),   P0[10],P0[11],P0[12],P0[13], pw1[0]=PKW(P0,8), pw1[1]=PKW(P0,10), pw1); \
    VRD(5); SBAR(); GAPA(C1=__builtin_amdgcn_mfma_f32_32x32x16_bf16(kf[3],QF(1),C1,0,0,0),   P0[14],P0[15],P1[0],P1[1],   pw1[2]=PKW(P0,12),pw1[3]=PKW(P0,14), pw1); \
    VRD(2); SBAR(); GAPA(C0=__builtin_amdgcn_mfma_f32_32x32x16_bf16(kf[4],QF(2),C0,0,0,0),   P1[2],P1[3],P1[4],P1[5],     pw2[0]=PKW(P1,0), pw2[1]=PKW(P1,2), pw2); \
    VRD(6); SBAR(); GAPA(C1=__builtin_amdgcn_mfma_f32_32x32x16_bf16(kf[5],QF(2),C1,0,0,0),   P1[6],P1[7],P1[8],P1[9],     pw2[2]=PKW(P1,4), pw2[3]=PKW(P1,6), pw2); \
    VRD(3); SBAR(); GAPA(C0=__builtin_amdgcn_mfma_f32_32x32x16_bf16(kf[6],QF(3),C0,0,0,0),   P1[10],P1[11],P1[12],P1[13], pw3[0]=PKW(P1,8), pw3[1]=PKW(P1,10), pw3); \
    VRD(7); SBAR(); GAPA(C1=__builtin_amdgcn_mfma_f32_32x32x16_bf16(kf[7],QF(3),C1,0,0,0),   P1[14],P1[15],0.f,0.f,       pw3[2]=PKW(P1,12),pw3[3]=PKW(P1,14), pw3); \
    l_reg+=sacc; \
    if(GK){DMA_K((t)+3,sl_cur);} if(GV){DMA_V((t)+1,sl_next);} \
    CMASK(C0,C1,t); \
    { float a=MX3(C0[0],C0[1],C1[0]),b=MX3(C0[2],C0[3],C1[1]); a=MX3(a,C1[2],C1[3]); \
      _Pragma("unroll") for(int r=4;r<16;r+=4){a=MX3(a,C0[r],C0[r+1]);b=MX3(b,C0[r+2],C0[r+3]);a=MX3(a,C1[r],C1[r+1]);b=MX3(b,C1[r+2],C1[r+3]);} \
      float rm=__builtin_fmaxf(a,b); { auto rr=__builtin_amdgcn_permlane32_swap(__float_as_uint(rm),__float_as_uint(rm),false,false); rm=__builtin_fmaxf(__uint_as_float(rr[0]),__uint_as_float(rr[1])); } \
      resc=false; \
      if(__builtin_expect(__any(rm>(float)THRL),0)){ const float dl=__builtin_fmaxf(rm,0.f); mhat+=dl; \
        _Pragma("unroll") for(int r=0;r<16;++r){C0[r]-=dl;C1[r]-=dl;} \
        SETBM(); \
        const float f=__builtin_amdgcn_exp2f(-dl); l_reg*=f; if(hi==0)wsf[r32]=f; resc=true; } } \
    SBAR(); \
    GAPB(o[0]=__builtin_amdgcn_mfma_f32_32x32x16_bf16(PAF(0),VFR(0),o[0],0,0,0), C0,0); \
    GAPB(o[1]=__builtin_amdgcn_mfma_f32_32x32x16_bf16(PAF(0),VFR(4),o[1],0,0,0), C0,4); \
    KRD(GL,0); GAPB(o[0]=__builtin_amdgcn_mfma_f32_32x32x16_bf16(PAF(1),VFR(1),o[0],0,0,0), C0,8); \
    KRD(GL,1); GAPB(o[1]=__builtin_amdgcn_mfma_f32_32x32x16_bf16(PAF(1),VFR(5),o[1],0,0,0), C0,12); \
    KRD(GL,2); GAPB(o[0]=__builtin_amdgcn_mfma_f32_32x32x16_bf16(PAF(2),VFR(2),o[0],0,0,0), C1,0); \
    KRD(GL,3); GAPB(o[1]=__builtin_amdgcn_mfma_f32_32x32x16_bf16(PAF(2),VFR(6),o[1],0,0,0), C1,4); \
    GAPB(o[0]=__builtin_amdgcn_mfma_f32_32x32x16_bf16(PAF(3),VFR(3),o[0],0,0,0), C1,8); \
    GAPB(o[1]=__builtin_amdgcn_mfma_f32_32x32x16_bf16(PAF(3),VFR(7),o[1],0,0,0), C1,12); \
    }while(0)
  int t=1;
  #undef CMASK
  #define CMASK(P0,P1,t) do{}while(0)
  for(;t+5<NT;t+=2){
    STEP(pB0,pB1,pA0,pA1,t,true,true,true);     WAIT_BAR(2); RESC(); ROT();
    STEP(pA0,pA1,pB0,pB1,t+1,true,true,true);   WAIT_BAR(2); RESC(); ROT();
  }
  #undef CMASK
  #define CMASK(P0,P1,t) do{int jb_=(t)-(NT-4); if(jb_>=0)cmask(P0,P1,jb_,qrel,hi);}while(0)
  #define ENDW(tt) do{ if((tt)+3<NT){WAIT_BAR(2);} else if((tt)+2<NT){WAIT_BAR(1);} else {WAIT_BAR(0);} }while(0)
  for(;t+1<NT;t+=2){
    STEP(pB0,pB1,pA0,pA1,t,(t+3<NT),(t+1<NT),(t+1<NT));       ENDW(t);   RESC(); ROT();
    STEP(pA0,pA1,pB0,pB1,t+1,(t+4<NT),(t+2<NT),(t+2<NT));     ENDW(t+1); RESC(); ROT();
  }
  STEP(pB0,pB1,pA0,pA1,NT-1,false,false,false); RESC();
  { float sacc=pB0[0]+pB0[1]; _Pragma("unroll") for(int r=2;r<16;++r)sacc+=pB0[r]; _Pragma("unroll") for(int r=0;r<16;++r)sacc+=pB1[r]; l_reg+=sacc;
    pw0=(u32x4){PKW(pB0,0),PKW(pB0,2),PKW(pB0,4),PKW(pB0,6)};pw1=(u32x4){PKW(pB0,8),PKW(pB0,10),PKW(pB0,12),PKW(pB0,14)};pw2=(u32x4){PKW(pB1,0),PKW(pB1,2),PKW(pB1,4),PKW(pB1,6)};pw3=(u32x4){PKW(pB1,8),PKW(pB1,10),PKW(pB1,12),PKW(pB1,14)};
    SBAR(); pv(o,vb0+sl_cur,PAF(0),PAF(1),PAF(2),PAF(3)); }
  #undef PKW
  #undef PAF
  #undef VFR
  #undef PIN
  #undef MX3
  #undef GAPA
  #undef GAPB
  #undef EX
  #undef VRD
  #undef KRD
  #undef STEP
  #undef ENDW
  {auto rr=__builtin_amdgcn_permlane32_swap(__float_as_uint(l_reg),__float_as_uint(l_reg),false,false);l_reg=__uint_as_float(rr[0])+__uint_as_float(rr[1]);}
  int lane_e=lane; asm volatile("":"+v"(lane_e));
  const int r32e=lane_e&31,hie=lane_e>>5;
  if(hie==0)wsf[32+r32e]=l_reg;asm volatile("s_waitcnt lgkmcnt(0)":::"memory");
  float rli[16];
  #pragma unroll
  for(int r=0;r<16;++r)rli[r]=__builtin_amdgcn_rcpf(wsf[32+crow(r,hie)]);
  bf16*Ow=O+(rowbase+q0+wid*QBLK)*OM+h*D; const bf16*OGw=OG+(rowbase+q0+wid*QBLK)*DM+h*D;
  { bf16*stg=(bf16*)(shm+LDS_OST)+wid*2048;
    #pragma unroll
    for(int r=0;r<16;++r){const int orow=crow(r,hie);
      #pragma unroll
      for(int d0=0;d0<2;++d0)stg[orow*64+d0*32+r32e]=(bf16)f2bf(o[d0][r]*rli[r]);}
    asm volatile("s_waitcnt lgkmcnt(0)":::"memory");
    #pragma unroll
    for(int i=0;i<4;++i){const int row=i*8+(lane_e>>3),ch=lane_e&7; const u32x4 v=*(const u32x4*)(stg+row*64+ch*8); const u32x4 g=*(const u32x4*)(OGw+(long)row*DM+ch*8); u32x4 w;
      #pragma unroll
      for(int e=0;e<4;++e){ const float lo=bflo(v[e])*sigmoidf_(bflo(g[e])), hh_=bfhi(v[e])*sigmoidf_(bfhi(g[e])); w[e]=pk2(lo,hh_); }
      ATTN_STORE16(Ow+(long)row*OM+ch*8,w);} }
  asm volatile("s_waitcnt lgkmcnt(0)\n\ts_barrier":::"memory");
  #undef QF
  #undef ABF
  #undef SETBM
  #undef BMF
  #undef DMA_K
  #undef DMA_V
  #undef CMASK
  #undef START
  #undef RESC
  #undef ROT
}
constexpr int ATTN_LDS_BYTES=LDS_BYTES;
#undef SBAR
#undef WAIT_BAR
}

constexpr int KP = 144;
__device__ __forceinline__ void p14_attention(Frame& F, const Args& a, int qword = CW_ATTQ) {
    const int tid0 = F.tid, lane0 = F.lane;
    const bf16* QKVG = (const bf16*)(F.ws + WS_QKVG); const float* C2 = (const float*)(F.ws + WS_C2); const float* CB = (const float*)(F.ws + WS_CB);
    bf16* Z2 = (bf16*)(F.ws + WS_Z2);
    LAS unsigned char* Ks = F.lds; LAS unsigned char* Vs = F.lds + 64 * KP; LAS float* bias = (LAS float*)(F.lds + 2 * 64 * KP); LAS int* uslot = (LAS int*)(F.lds + RING_BYTES + 192);
    constexpr int ATT_MAXT = (RING_BYTES - attn_body::ATTN_LDS_BYTES - 16) / 1024;
    float mq = 0.f, mk = 0.f;
    for (int i = 0; i < 64; ++i) { mq = fmaxf(mq, fabsf(a.in[21][i])); mk = fmaxf(mk, fabsf(a.in[22][i])); }
    const float THR2 = (2.f * 8.f * mq * mk * 1.01f + 30.f) * LOG2E;
    gu32* qctr = F.ctl + qword;
    LAS int* horder = (LAS int*)(F.lds + RING_BYTES + 256);
    __syncthreads();
    if (tid0 < NH) { const float mine = C2[(size_t)tid0 * T + T - 1]; int rank = 0;
        for (int o = 0; o < NH; ++o) { const float other = C2[(size_t)o * T + T - 1]; rank += (other > mine || (other == mine && o < tid0)) ? 1 : 0; }
        horder[rank] = tid0; }
    __syncthreads();
    for (;;) {
        __syncthreads();
        if (tid0 == 0) uslot[0] = (int)__hip_atomic_fetch_add(qctr, 1u, RLX_AGENT);
        __syncthreads();
        const int unit = uslot[0];
        if (unit >= NH * (T / 256)) break;
        const int h = horder[unit >> 6], qb = (T / 256 - 1) - (unit & 63), q0 = qb * 256;
        const float ct0 = C2[(size_t)h * T + q0];
        int jstart = 0;
        { int tot = 0; for (int j0 = 0; j0 < 4 * qb; j0 += 64) { const int j = j0 + lane0; const bool skip = (j < 4 * qb) && ((ct0 - CB[h * 256 + j]) < -THR2); tot += __popcll(__ballot(skip)); } jstart = tot; }
        jstart &= ~1;
        if (4 * qb + 4 - jstart <= ATT_MAXT) {
            attn_body::attn_unit<8>(h, qb, jstart, QKVG, QKVG + D, QKVG + 2 * D, QKVG + 3 * D, Z2, C2 + (size_t)h * T, (char*)F.lds);
            continue;
        }
        int tid_s = F.tid; asm volatile("" : "+v"(tid_s));
        const int tid = tid_s, lane = tid & 63, wid = F.wave, r32 = lane & 31, hi = lane >> 5;
        const int jend = 4 * qb + 3;
        const int qrow = q0 + wid * 32 + r32;
        bf16x8 qr[4];
#pragma unroll
        for (int d0 = 0; d0 < 4; ++d0) qr[d0] = *(const bf16x8*)(QKVG + (size_t)qrow * 4096 + h * 64 + d0 * 16 + hi * 8);
        f32x16 o0 = {}, o1 = {}; float m = -INFINITY, l = 0.f;
        const int lrow = tid >> 3, lch = tid & 7;
        u32x4 kreg, vreg; float breg = 0.f;
        auto gload = [&](int j) { const size_t row = (size_t)(64 * j + lrow) * 4096 + h * 64 + lch * 8;
            kreg = *(const u32x4*)(QKVG + row + D); vreg = *(const u32x4*)(QKVG + row + 2 * D); if (tid < 64) breg = -C2[(size_t)h * T + 64 * j + tid]; };
        gload(jstart);
        for (int j = jstart; j <= jend; ++j) {
            __syncthreads();
            *(LAS u32x4*)(Ks + lrow * KP + lch * 16) = kreg;
            { const int s_ = lrow >> 4, x_ = lrow & 15, p_ = s_ * 16 + ((x_ >> 2) & 1) * 8 + (((x_ >> 3) << 2) | (x_ & 3));
                const unsigned w_[4] = {vreg.x, vreg.y, vreg.z, vreg.w};
#pragma unroll
                for (int e = 0; e < 8; ++e) *(LAS unsigned short*)(Vs + (lch * 8 + e) * KP + p_ * 2) = (unsigned short)(w_[e >> 1] >> ((e & 1) * 16)); }
            if (tid < 64) bias[tid] = breg;
            __syncthreads();
            if (j < jend) gload(j + 1);
            f32x16 p0 = {}, p1 = {};
#pragma unroll
            for (int d0 = 0; d0 < 4; ++d0) {
                const bf16x8 k0 = *(const LAS bf16x8*)(Ks + r32 * KP + d0 * 32 + hi * 16);
                const bf16x8 k1 = *(const LAS bf16x8*)(Ks + (32 + r32) * KP + d0 * 32 + hi * 16);
                p0 = __builtin_amdgcn_mfma_f32_32x32x16_bf16(k0, qr[d0], p0, 0, 0, 0);
                p1 = __builtin_amdgcn_mfma_f32_32x32x16_bf16(k1, qr[d0], p1, 0, 0, 0);
            }
#pragma unroll
            for (int g4 = 0; g4 < 4; ++g4) { const f32x4 b0 = *(const LAS f32x4*)(bias + 8 * g4 + 4 * hi), b1 = *(const LAS f32x4*)(bias + 32 + 8 * g4 + 4 * hi);
#pragma unroll
                for (int i = 0; i < 4; ++i) { p0[4 * g4 + i] += b0[i]; p1[4 * g4 + i] += b1[i]; } }
            if (j >= 4 * qb) {
                const int kb = 64 * j;
#pragma unroll
                for (int r = 0; r < 16; ++r) { const int kv = kb + crow(r, hi); if (kv > qrow) p0[r] = -INFINITY; if (kv + 32 > qrow) p1[r] = -INFINITY; }
            }
            float mloc = fmaxf(p0[0], p1[0]);
#pragma unroll
            for (int r = 1; r < 16; ++r) mloc = fmaxf(mloc, fmaxf(p0[r], p1[r]));
            mloc = fmaxf(mloc, __shfl_xor(mloc, 32));
            const float mnew = fmaxf(m, mloc);
            const float alpha = exp2f(m - mnew);
            float ls = 0.f;
#pragma unroll
            for (int r = 0; r < 16; ++r) { p0[r] = exp2f(p0[r] - mnew); p1[r] = exp2f(p1[r] - mnew); ls += p0[r] + p1[r]; }
            l = l * alpha + ls; m = mnew;
#pragma unroll
            for (int r = 0; r < 16; ++r) { o0[r] *= alpha; o1[r] *= alpha; }
#pragma unroll
            for (int s = 0; s < 4; ++s) {
                u32x4 pw;
                if (s == 0) pw = (u32x4){pk2(p0[0], p0[1]), pk2(p0[2], p0[3]), pk2(p0[4], p0[5]), pk2(p0[6], p0[7])};
                else if (s == 1) pw = (u32x4){pk2(p0[8], p0[9]), pk2(p0[10], p0[11]), pk2(p0[12], p0[13]), pk2(p0[14], p0[15])};
                else if (s == 2) pw = (u32x4){pk2(p1[0], p1[1]), pk2(p1[2], p1[3]), pk2(p1[4], p1[5]), pk2(p1[6], p1[7])};
                else pw = (u32x4){pk2(p1[8], p1[9]), pk2(p1[10], p1[11]), pk2(p1[12], p1[13]), pk2(p1[14], p1[15])};
                const bf16x8 pf = __builtin_bit_cast(bf16x8, pw);
                const bf16x8 v0 = *(const LAS bf16x8*)(Vs + r32 * KP + s * 32 + hi * 16);
                const bf16x8 v1 = *(const LAS bf16x8*)(Vs + (32 + r32) * KP + s * 32 + hi * 16);
                o0 = __builtin_amdgcn_mfma_f32_32x32x16_bf16(v0, pf, o0, 0, 0, 0);
                o1 = __builtin_amdgcn_mfma_f32_32x32x16_bf16(v1, pf, o1, 0, 0, 0);
            }
        }
        l += __shfl_xor(l, 32);
        const float rl = 1.f / l;
#pragma unroll
        for (int dt = 0; dt < 2; ++dt)
#pragma unroll
            for (int g4 = 0; g4 < 4; ++g4) { const int d = 32 * dt + 8 * g4 + 4 * hi; const size_t col = (size_t)h * 64 + d;
                const u32x2 ogw = *(const u32x2*)(QKVG + (size_t)qrow * 4096 + 3 * D + col);
                const float og[4] = {bflo(ogw.x), bfhi(ogw.x), bflo(ogw.y), bfhi(ogw.y)}; float ov[4];
#pragma unroll
                for (int i = 0; i < 4; ++i) ov[i] = (dt == 0 ? o0[4 * g4 + i] : o1[4 * g4 + i]) * rl * sigmoidf_(og[i]);
                u32x2 w; w.x = pk2(ov[0], ov[1]); w.y = pk2(ov[2], ov[3]);
                *(u32x2*)(Z2 + (size_t)qrow * D + col) = w; }
    }
}

struct TokInfo { int e0, e1, p0, p1; float g0, g1; int d0, d1; };
__device__ __forceinline__ void p16_router(Frame& F, const Args& a) {
    const int lane = F.lane, tid = F.tid; const float* Hs = (const float*)(F.ws + WS_H); bf16* U = (bf16*)(F.ws + WS_U4);
    TokInfo* TI = (TokInfo*)(F.ws + WS_TOK);
    LAS float* wr_ = (LAS float*)F.lds;
    LAS int* lcnt = (LAS int*)(F.lds + 32768);
    const Row gr = ld_row(a.in[1] + 3 * D, lane);
    __syncthreads();
    for (int i = tid; i < NE * D; i += NTHREADS) { const int e = i & 7, k = i >> 3; wr_[e * D + k] = a.in[26][(size_t)k * NE + e]; }
    for (int tb = F.vcu * 64; tb < T; tb += F.G * 64) {
        __syncthreads();
        if (tid < 16) lcnt[tid] = 0;
        __syncthreads();
        int e0s[8], e1s[8], p0s[8], p1s[8]; float g0s[8];
#pragma unroll
        for (int qq = 0; qq < 2; ++qq) {
            Row u[4];
#pragma unroll
            for (int r = 0; r < 4; ++r) { const int t = tb + F.wave * 8 + 4 * qq + r; u[r] = rmsnorm_row(ld_row(Hs + (size_t)t * D, lane), gr); st_row_bf16(U + (size_t)t * D, lane, u[r]); }
            float lg[4][NE];
#pragma unroll
            for (int e = 0; e < NE; ++e) { float s4[4] = {0.f, 0.f, 0.f, 0.f};
#pragma unroll
                for (int j = 0; j < 4; ++j) { const f32x4 w = *(const LAS f32x4*)(wr_ + e * D + 256 * j + 4 * lane);
#pragma unroll
                    for (int r = 0; r < 4; ++r) s4[r] += (u[r].v[j][0] * w[0] + u[r].v[j][1] * w[1]) + (u[r].v[j][2] * w[2] + u[r].v[j][3] * w[3]); }
#pragma unroll
                for (int r = 0; r < 4; ++r) lg[r][e] = wave_sum(s4[r]); }
#pragma unroll
            for (int r = 0; r < 4; ++r) { const int q = 4 * qq + r;
                int b0 = 0; float v0 = lg[r][0];
#pragma unroll
                for (int e = 1; e < NE; ++e) if (lg[r][e] > v0) { v0 = lg[r][e]; b0 = e; }
                int b1 = -1; float v1 = -INFINITY;
#pragma unroll
                for (int e = 0; e < NE; ++e) if (e != b0 && lg[r][e] > v1) { v1 = lg[r][e]; b1 = e; }
                e0s[q] = b0; e1s[q] = b1; g0s[q] = 1.f / (1.f + __expf(v1 - v0));
                int pa = 0, pb = 0;
                if (lane == 0) { pa = atomicAdd((int*)&lcnt[b0], 1); pb = atomicAdd((int*)&lcnt[b1], 1); }
                p0s[q] = pa; p1s[q] = pb; }
        }
        __syncthreads();
        if (tid < NE) lcnt[8 + tid] = (int)__hip_atomic_fetch_add(F.ctl + CW_CNT + 64 * tid, (unsigned)lcnt[tid], RLX_AGENT);
        __syncthreads();
        if (lane == 0) {
#pragma unroll
            for (int q = 0; q < 8; ++q) { const int t = tb + F.wave * 8 + q; TokInfo ti; ti.e0 = e0s[q]; ti.e1 = e1s[q]; ti.p0 = lcnt[8 + e0s[q]] + p0s[q]; ti.p1 = lcnt[8 + e1s[q]] + p1s[q];
                ti.g0 = g0s[q]; ti.g1 = 1.f - g0s[q]; ti.d0 = 0; ti.d1 = 0; TI[t] = ti; }
        }
    }
    __syncthreads();
}
__device__ __forceinline__ int moe_ends(Frame& F, LAS int* ends) {
    __syncthreads();
    if (F.tid == 0) { int run = 0; for (int e = 0; e < NE; ++e) { const int c = (int)__hip_atomic_load(F.ctl + CW_CNT + 64 * e, RLX_AGENT); run += (c + 255) >> 8; ends[e] = run; } }
    __syncthreads();
    return ends[NE - 1];
}
__device__ __forceinline__ void p17_gather(Frame& F) {
    LAS int* ends = (LAS int*)(F.lds + RING_BYTES);
    moe_ends(F, ends);
    const bf16* U = (const bf16*)(F.ws + WS_U4); bf16* AM = (bf16*)(F.ws + WS_AM); TokInfo* TI = (TokInfo*)(F.ws + WS_TOK);
    for (int t = F.gw; t < T; t += F.NGW) {
        const TokInfo ti = TI[t];
        const int d0 = (ti.e0 ? ends[ti.e0 - 1] : 0) * 256 + ti.p0, d1 = (ti.e1 ? ends[ti.e1 - 1] : 0) * 256 + ti.p1;
        const u32x4* src = (const u32x4*)(U + (size_t)t * D) + F.lane; const u32x4 x0 = src[0], x1 = src[64];
        u32x4* o0 = (u32x4*)(AM + (size_t)d0 * D) + F.lane; o0[0] = x0; o0[64] = x1;
        u32x4* o1 = (u32x4*)(AM + (size_t)d1 * D) + F.lane; o1[0] = x0; o1[64] = x1;
        if (F.lane == 0) { TI[t].d0 = d0; TI[t].d1 = d1; }
    }
}
__device__ __forceinline__ void p20_combine(Frame& F, const Args& a) {
    const int lane = F.lane; const float* Hs = (const float*)(F.ws + WS_H); const bf16* YS = (const bf16*)(F.ws + WS_YS); const bf16* YSK = (const bf16*)(F.ws + WS_YSK); const TokInfo* TI = (const TokInfo*)(F.ws + WS_TOK);
    const Row gr = ld_row(a.in[2], lane);
    for (int t = F.gw; t < T; t += F.NGW) {
        const TokInfo ti = TI[t];
        Row hrow = ld_row(Hs + (size_t)t * D, lane);
#pragma unroll
        for (int which = 0; which < 2; ++which) { const int d = which ? ti.d1 : ti.d0; const float gw = which ? ti.g1 : ti.g0;
            if (d < MOE_RB1 * 256) { const Row y = ld_row_bf16(YS + (size_t)d * D, lane);
#pragma unroll
                for (int j = 0; j < 4; ++j) hrow.v[j] = hrow.v[j] + gw * y.v[j]; }
            else {
#pragma unroll
                for (int ks = 0; ks < MOE_TKS; ++ks) { const Row y = ld_row_bf16(YSK + ((size_t)ks * MOE_TROWS + (size_t)(d - MOE_RB1 * 256)) * D, lane);
#pragma unroll
                    for (int j = 0; j < 4; ++j) hrow.v[j] = hrow.v[j] + gw * y.v[j]; } } }
        st_row(a.out + (size_t)t * D, lane, rmsnorm_row(hrow, gr));
    }
}

constexpr int N_PHASES = 21;
__global__ void __launch_bounds__(NTHREADS, 2) trunk_fwd(Args args) {
    extern __shared__ __attribute__((aligned(16))) unsigned char lds_raw[];
    Frame F;
    F.lds = (LAS unsigned char*)lds_raw; F.ws = args.ws; F.ctl = (gu32*)(args.ws + WS_CTL);
    F.tid = threadIdx.x; F.lane = F.tid & 63; F.wave = __builtin_amdgcn_readfirstlane(F.tid >> 6);
    F.G = gridDim.x; { const int bx = blockIdx.x; F.vcu = (F.G % 8 == 0) ? (bx % 8) * (F.G / 8) + bx / 8 : bx; }
    F.gw = F.vcu * NWAVES + F.wave; F.NGW = F.G * NWAVES;
    volatile LAS unsigned* MISC = (volatile LAS unsigned*)(F.lds + MISC_OFF);
    for (int u = F.tid; u < (LDS_BYTES - RING_BYTES) / 4; u += NTHREADS) ((LAS unsigned*)(F.lds + RING_BYTES))[u] = 0u;
    __syncthreads();
    const int lo = args.ph_lo, hi = args.ph_hi;
    const bool use_bar = (hi - lo) > 1;
    XcdBarrier bar; bar.bar = (unsigned*)(F.ctl + CW_BAR); bar.x = 0; bar.st = nullptr;
    if (use_bar) bar = xcd_barrier_post((unsigned*)(F.ctl + CW_BAR), MISC + 8);
#ifdef ONLY_PHASE
#define IN(k) ((k) == ONLY_PHASE && lo <= (k) && (k) < hi)
#else
#define IN(k) (lo <= (k) && (k) < hi)
#endif
#define SEAM(k) do { if (IN((k) + 1)) xcd_barrier(bar); } while (0)
    unsigned char* ws = args.ws;
    const int c = (int)blockIdx.x;
    LAS unsigned char* ring = F.lds;

    if (IN(0)) { p0_prologue(F, args); p1_shift(F, args); p0_moe_weights(F, args, F.vcu, F.G, 1); } SEAM(0);
    if (IN(1)) {
        { pg8::Gemm g{D, 2 * D, 2 * D}; pg8::SchedPlain S; S.o.init(T / 256, 1, F.G, c); S.A = (const char*)(ws + WS_UB); S.B = (const char*)(ws + WS_W_L1); S.astep = (size_t)256 * D * 2; S.bstep = (size_t)256 * 2 * D * 2;
          pg8::EpiL1 E{(bf16*)(ws + WS_L1)};
          pg8::gemm_phase<pg8::EpiL1, pg8::SchedPlain, true>(ring, g, S, E); }
        { pg8::Gemm g{D, D, D}; pg8::SchedRKV S; S.o.init(T / 256, 12, F.G, c, F.G == 256 ? 64 : 0, 1); S.A = (const char*)(ws + WS_XS); S.B = (const char*)(ws + WS_W_RKV); S.astep = (size_t)256 * D * 2; S.bstep = (size_t)256 * D * 2; S.azstride = (size_t)T * D * 2;
          pg8::EpiRKV E{(bf16*)(ws + WS_R), (size_t)(WS_K - WS_R) / 2};
          pg8::gemm_phase<pg8::EpiRKV, pg8::SchedRKV, true>(ring, g, S, E); }
        } SEAM(1);
    if (IN(2)) {
        pg8::Gemm g{256, 256, 256}; pg8::SchedPlain S; S.o.init(T / 256, 12, F.G, c); S.A = (const char*)(ws + WS_L1); S.B = (const char*)(ws + WS_W_L2); S.astep = (size_t)256 * 256 * 2; S.bstep = (size_t)256 * 256 * 2;
        pg8::EpiL2 E{(float*)(ws + WS_LW), (bf16*)(ws + WS_AA), (bf16*)(ws + WS_G), args.in[5], args.in[8]};
        pg8::gemm_phase<pg8::EpiL2, pg8::SchedPlain, true>(ring, g, S, E);
        } SEAM(2);
    if (IN(3)) { p3_prep(F, args); } SEAM(3);
    if (IN(4)) { pa_chunk(F); } SEAM(4);
    if (IN(5)) { pb_chain(F);
        if (F.G == 256 && (F.vcu & 31) >= 8) p0_moe_weights(F, args, (F.vcu >> 5) * 24 + (F.vcu & 31) - 8, 192, 0);
        else if (F.G != 256) p0_moe_weights(F, args, F.vcu, F.G, 0); } SEAM(5);
    if (IN(6)) { pc_out(F, args); } SEAM(6);
    if (IN(7)) {
        pg8::Gemm g{D, D, D}; pg8::SchedPlain S; S.o.init(T / 256, 4, F.G, c); S.A = (const char*)(ws + WS_Z); S.B = (const char*)(ws + WS_W_O0); S.astep = (size_t)256 * D * 2; S.bstep = (size_t)256 * D * 2;
        pg8::EpiRes E{args.in[0], (float*)(ws + WS_H)};
        pg8::gemm_phase<pg8::EpiRes, pg8::SchedPlain, true>(ring, g, S, E);
        } SEAM(7);
    if (IN(8)) { p8_norm(F, args.in[1] + D, (bf16*)(ws + WS_U2)); } SEAM(8);
    if (IN(9)) {
        pg8::Gemm g{D, D, D}; pg8::SchedPlain S; S.o.init(T / 256, 2 * FF / 256, F.G, c); S.A = (const char*)(ws + WS_U2); S.B = (const char*)(ws + WS_W_GU); S.astep = (size_t)256 * D * 2; S.bstep = (size_t)256 * D * 2;
        pg8::EpiSwiGLU E{(bf16*)(ws + WS_ACT)};
        pg8::gemm_phase<pg8::EpiSwiGLU, pg8::SchedPlain, true>(ring, g, S, E);
        }
    SEAM(9);
    if (IN(10)) {
        pg8::Gemm g{FF, FF, FF}; pg8::SchedPlain S; S.o.init(T / 256, 4, F.G, c); S.A = (const char*)(ws + WS_ACT); S.B = (const char*)(ws + WS_W_DN); S.astep = (size_t)256 * FF * 2; S.bstep = (size_t)256 * FF * 2;
        pg8::EpiRes E{(const float*)(ws + WS_H), (float*)(ws + WS_H)};
        pg8::gemm_phase<pg8::EpiRes, pg8::SchedPlain, true>(ring, g, S, E);
        } SEAM(10);
    if (IN(11)) { p11_norm_forget(F, args); } SEAM(11);
    if (IN(12)) {
        pg8::Gemm g{D, D, D}; pg8::SchedPlain S; S.o.init(T / 256, 16, F.G, c); S.A = (const char*)(ws + WS_U3); S.B = (const char*)(ws + WS_W_IN); S.astep = (size_t)256 * D * 2; S.bstep = (size_t)256 * D * 2;
        p12_cumsum(F);
        pg8::EpiQKVG E{(bf16*)(ws + WS_QKVG), args.in[21], args.in[22]};
        pg8::gemm_phase<pg8::EpiQKVG, pg8::SchedPlain, true>(ring, g, S, E);
        } SEAM(12);
    if (IN(13)) { p14_attention(F, args, CW_ATTQ); } SEAM(13);
    if (IN(14)) {
        pg8::Gemm g{D, D, D}; pg8::SchedPlain S; S.o.init(T / 256, 4, F.G, c); S.A = (const char*)(ws + WS_Z2); S.B = (const char*)(ws + WS_W_FO); S.astep = (size_t)256 * D * 2; S.bstep = (size_t)256 * D * 2;
        pg8::EpiRes E{(const float*)(ws + WS_H), (float*)(ws + WS_H)};
        pg8::gemm_phase<pg8::EpiRes, pg8::SchedPlain, true>(ring, g, S, E);
        } SEAM(14);
    if (IN(15)) { p16_router(F, args); } SEAM(15);
    if (IN(16)) { p17_gather(F); } SEAM(16);
    if (IN(17)) {
        LAS int* ends = (LAS int*)(F.lds + RING_BYTES); const int nblk = moe_ends(F, ends);
        pg8::Gemm g{D, D, D}; pg8::SchedMoe S; S.o.init(nblk, 2 * FF / 256, F.G, c); S.A = (const char*)(ws + WS_AM); S.B = (const char*)(ws + WS_W_MGU); S.astep = (size_t)256 * D * 2; S.bstep = (size_t)256 * D * 2; S.bestride = (size_t)2 * FF * D * 2; S.ends = ends;
        pg8::EpiSwiGLU E{(bf16*)(ws + WS_ACT2)};
        pg8::gemm_phase<pg8::EpiSwiGLU, pg8::SchedMoe, true>(ring, g, S, E);
        } SEAM(17);
    if (IN(18)) {
        LAS int* ends = (LAS int*)(F.lds + RING_BYTES); const int nblk = moe_ends(F, ends);
        { pg8::Gemm g{FF, FF, FF}; pg8::SchedMoeK S; S.o.init(nblk < MOE_RB1 ? nblk : MOE_RB1, 4, F.G, c); S.A = (const char*)(ws + WS_ACT2); S.B = (const char*)(ws + WS_W_MDN); S.astep = (size_t)256 * FF * 2; S.bstep = (size_t)256 * FF * 2; S.bestride = (size_t)D * FF * 2;
          S.kbytes = 0; S.ends = ends; S.pm0 = 0;
          pg8::EpiBf16K E{(bf16*)(ws + WS_YS), 0};
          pg8::gemm_phase<pg8::EpiBf16K, pg8::SchedMoeK, true>(ring, g, S, E); }
        if (nblk > MOE_RB1) { pg8::Gemm g{FF, FF, FF / MOE_TKS}; pg8::SchedMoeK S; S.o.init(nblk - MOE_RB1, 4 * MOE_TKS, F.G, c); S.A = (const char*)(ws + WS_ACT2); S.B = (const char*)(ws + WS_W_MDN); S.astep = (size_t)256 * FF * 2; S.bstep = (size_t)256 * FF * 2; S.bestride = (size_t)D * FF * 2;
          S.kbytes = (size_t)(FF / MOE_TKS) * 2; S.ends = ends; S.pm0 = MOE_RB1;
          pg8::EpiBf16K E{(bf16*)(ws + WS_YSK), (size_t)MOE_TROWS * D};
          pg8::gemm_phase<pg8::EpiBf16K, pg8::SchedMoeK, true>(ring, g, S, E); }
        } SEAM(18);
    if (IN(19)) { p20_combine(F, args); }
#undef IN
#undef SEAM
}

extern "C" void kernel_launch(void* const* d_in, const int* in_sizes, int n_in, void* d_out, int out_size, void* d_ws, size_t ws_size, hipStream_t stream) {
    static int grid = 0;
    if (grid == 0) {
        if (n_in != 29 || out_size != T * D || ws_size < WS_END) { fprintf(stderr, "kernel_launch: unexpected problem (n_in %d out %d ws %zu)\n", n_in, out_size, ws_size); grid = -1; return; }
        int dev = 0, cus = 0;
        if (hipGetDevice(&dev) != hipSuccess || hipDeviceGetAttribute(&cus, hipDeviceAttributeMultiprocessorCount, dev) != hipSuccess) { grid = -1; return; }
        if (hipFuncSetAttribute((const void*)trunk_fwd, hipFuncAttributeMaxDynamicSharedMemorySize, LDS_BYTES) != hipSuccess) { fprintf(stderr, "kernel_launch: hipFuncSetAttribute failed\n"); grid = -1; return; }
        int per_cu = 0;
        if (hipOccupancyMaxActiveBlocksPerMultiprocessor(&per_cu, (const void*)trunk_fwd, NTHREADS, LDS_BYTES) != hipSuccess || per_cu < 1) fprintf(stderr, "kernel_launch: occupancy query says %d\n", per_cu);
        (void)hipGetLastError();
        grid = cus;
    }
    if (grid < 0) return;
    (void)hipMemsetAsync((char*)d_ws + WS_CTL, 0, CTL_ZERO_BYTES, stream);
    Args a{};
    for (int i = 0; i < 29; ++i) a.in[i] = (const float*)d_in[i];
    a.out = (float*)d_out; a.ws = (unsigned char*)d_ws;
    constexpr int NPH = 20;
    if (LAUNCH_MODE == 1) { a.ph_lo = 0; a.ph_hi = NPH; hipLaunchKernelGGL(trunk_fwd, dim3(grid), dim3(NTHREADS), LDS_BYTES, stream, a); }
    else for (int p = 0; p < NPH; ++p) { a.ph_lo = p; a.ph_hi = p + 1; hipLaunchKernelGGL(trunk_fwd, dim3(grid), dim3(NTHREADS), LDS_BYTES, stream, a); }
}
```

```cpp
#include <hip/hip_runtime.h>
#include <cstdio>
#include <cstdint>

#ifndef LAUNCH_MODE
#define LAUNCH_MODE 1
#endif

#define GAS __attribute__((address_space(1)))
#define LAS __attribute__((address_space(3)))
typedef unsigned short bf16;
typedef short bf16x8 __attribute__((ext_vector_type(8)));
typedef float f32x4 __attribute__((ext_vector_type(4)));
typedef float f32x2 __attribute__((ext_vector_type(2)));
typedef float f32x16 __attribute__((ext_vector_type(16)));
typedef unsigned u32x4 __attribute__((ext_vector_type(4)));
typedef unsigned u32x2 __attribute__((ext_vector_type(2)));
typedef GAS unsigned gu32;
#define RLX_AGENT __ATOMIC_RELAXED, __HIP_MEMORY_SCOPE_AGENT

constexpr int T = 16384, D = 1024, NH = 16, HD = 64, FF = 3584, NE = 8, WIN_LD = 4 * D + NH;
constexpr int NWAVES = 8, NTHREADS = 512;
constexpr float RMS_EPS = 1e-6f, GN_EPS = 64e-5f;
constexpr int MOE_ROWS = (2 * T / 256 + NE) * 256;
constexpr int MOE_RB1 = 128, MOE_TKS = 7, MOE_TROWS = (MOE_ROWS / 256 - MOE_RB1) * 256;
constexpr int MOE_KS = 1;
constexpr float LOG2E = 1.4426950408889634f;

constexpr size_t MiB = 1u << 20;
constexpr size_t WS_CTL = 0, CTL_ZERO_BYTES = 64 * 1024;
constexpr size_t WS_W_RKV = 2 * MiB, WS_W_L1 = 8 * MiB, WS_W_L2 = 9 * MiB, WS_W_O0 = 11 * MiB, WS_W_GU = 13 * MiB, WS_W_DN = 27 * MiB,
                 WS_W_IN = 34 * MiB, WS_W_FO = 42 * MiB, WS_W_MGU = 44 * MiB, WS_W_MDN = 156 * MiB;
constexpr size_t WS_H = 216 * MiB;
constexpr size_t WS_UB = 280 * MiB, WS_XS = 313 * MiB;
constexpr size_t WS_KK = 280 * MiB, WS_BB = 344 * MiB;
constexpr size_t WS_Z = 410 * MiB  , WS_U2 = 344 * MiB;
constexpr size_t WS_U3 = 280 * MiB, WS_Z2 = 312 * MiB, WS_U4 = 280 * MiB, WS_AM = 312 * MiB;
constexpr size_t WS_R = 410 * MiB, WS_K = 474 * MiB, WS_V = 538 * MiB;
constexpr size_t WS_ACT = 410 * MiB;
constexpr size_t WS_QKVG = 410 * MiB;
constexpr size_t WS_ACT2 = 410 * MiB;
constexpr size_t WS_LW = 602 * MiB, WS_AA = 666 * MiB, WS_G = 730 * MiB;
constexpr size_t WS_YT = 666 * MiB;
constexpr size_t WS_YS = 666 * MiB;
constexpr size_t WS_YSK = 736 * MiB;
constexpr size_t WS_L1 = 794 * MiB;
constexpr size_t WS_CS = 802 * MiB;
constexpr size_t WS_LF = 806 * MiB, WS_C2 = 807 * MiB, WS_CB = 808 * MiB, WS_TOK = 809 * MiB;
constexpr size_t WS_END = 810 * MiB;
constexpr size_t WS_AT = 280 * MiB, WS_RT = 312 * MiB, WS_BH = 344 * MiB, WS_KH = 376 * MiB;
constexpr size_t WS_V16 = 538 * MiB  , WS_GC = 248 * MiB;
constexpr size_t WS_QM = 410 * MiB, WS_PLR = 474 * MiB, WS_TM = 506 * MiB, WS_S0 = 570 * MiB;
constexpr size_t WS_Y = 602 * MiB;
constexpr int NCH = T / 64;
constexpr int CW_TMO = 0, CW_BAR = 4096, CW_CNT = 8192, CW_ATTQ = 9216;
static_assert((CW_ATTQ + 128) * 4 <= (int)CTL_ZERO_BYTES && CW_BAR + 3456 <= CW_CNT && CW_CNT + 64 * NE <= CW_ATTQ, "control words inside the per-call memset");

constexpr int RING_BYTES = 131072, MISC_OFF = RING_BYTES + 320, LDS_BYTES = 147456;

__device__ __forceinline__ unsigned f2bf(float f) { unsigned u = __builtin_bit_cast(unsigned, f); return (u + 0x7fffu + ((u >> 16) & 1u)) >> 16; }
__device__ __forceinline__ unsigned pk2(float lo, float hi) { return f2bf(lo) | (f2bf(hi) << 16); }
__device__ __forceinline__ float bf2f(unsigned short b) { return __builtin_bit_cast(float, (unsigned)b << 16); }
__device__ __forceinline__ float bflo(unsigned w) { return __builtin_bit_cast(float, w << 16); }
__device__ __forceinline__ float bfhi(unsigned w) { return __builtin_bit_cast(float, w & 0xffff0000u); }
template <int CTRL> __device__ __forceinline__ float dpp_mov(float x) {
    return __builtin_bit_cast(float, __builtin_amdgcn_mov_dpp(__builtin_bit_cast(int, x), CTRL, 0xf, 0xf, true)); }
__device__ __forceinline__ float row16_sum(float v) {
    v += dpp_mov<0xB1>(v); v += dpp_mov<0x4E>(v); v += dpp_mov<0x124>(v); v += dpp_mov<0x128>(v); return v; }
__device__ __forceinline__ float wave_sum(float v) {
    v = row16_sum(v); v += __shfl_xor(v, 16); v += __shfl_xor(v, 32); return v; }
__device__ __forceinline__ float sigmoidf_(float x) { return __builtin_amdgcn_rcpf(1.f + __builtin_amdgcn_exp2f(x * -1.4426950408889634f)); }
__device__ __forceinline__ float tanhf_(float x) { const float e = __builtin_amdgcn_exp2f(fminf(x * 2.8853900817779268f, 60.f)); return (e - 1.f) * __builtin_amdgcn_rcpf(e + 1.f); }
#define LDS_WAIT() asm volatile("s_waitcnt lgkmcnt(0)" ::: "memory")
__device__ __forceinline__ int crow(int r, int hi) { return (r & 3) + 8 * (r >> 2) + 4 * hi; }

namespace pg8 {
constexpr int BM = 256, BK = 64, HALF = 128, HTB = HALF * BK * 2, STAGE_BYTES = 8 * HTB, NXCD = 8, WGM = 4;
__host__ __device__ __forceinline__ int lds_byte(int r, int c) { const int st = (r >> 4) * 2 + (c >> 5), rr = r & 15, cc = c & 31, ob = rr * 64 + cc * 2; return st * 1024 + (ob ^ (((ob >> 9) & 1) << 5)); }
__host__ __device__ __forceinline__ void stage_rc(int b, int& R, int& C) { const int st = b / 1024, sb = b % 1024, swz = sb ^ (((sb >> 9) & 1) << 5); R = (st >> 1) * 16 + swz / 64; C = (st & 1) * 32 + (swz % 64) / 2; }
__host__ __device__ __forceinline__ int perm32(int rho) { const int n = rho >> 4, i = rho & 15; return 8 * (i >> 2) + 4 * n + (i & 3); }

struct Unit { int pm, pn; };
struct Gemm { int lda, ldb, K; };

struct TileOrder {
    int nM, nN, nwg, G, c, nlo, klo;
    __device__ __forceinline__ void init(int nM_, int nN_, int G_, int c_, int nlo_ = 0, int klo_ = 0) { nM = nM_; nN = nN_; nwg = nM * nN; G = G_; c = c_; nlo = nlo_; klo = klo_; }
    __device__ __forceinline__ bool tile(int i, Unit& u) const {
        long L;
        if (c < nlo) { if (i >= klo) return false; L = (long)(nwg - nlo * klo) + c + (long)nlo * i; }
        else { L = (long)i * (G - nlo) + (c - nlo); if (L >= nwg - nlo * klo) return false; }
        int wgid = (int)L; { const int q = nwg / NXCD, r = nwg % NXCD, xcd = wgid % NXCD, off = wgid / NXCD; wgid = (xcd < r ? xcd * (q + 1) : r * (q + 1) + (xcd - r) * q) + off; }
        const int nig = WGM * nN, gid = wgid / nig, fm = gid * WGM, gsz = (nM - fm) < WGM ? (nM - fm) : WGM;
        u.pm = fm + ((wgid % nig) % gsz); u.pn = (wgid % nig) / gsz; return true;
    }
};

__device__ __forceinline__ unsigned cvt_pk_bf16(float lo, float hi) { unsigned r; asm volatile("v_cvt_pk_bf16_f32 %0, %1, %2" : "=v"(r) : "v"(lo), "v"(hi)); return r; }

template <class Epi, class Sched, bool ALIGN_EPI>
__device__ __forceinline__ void gemm_phase(LAS unsigned char* lds, const Gemm g, const Sched& S, const Epi& E) {
    const int tid = threadIdx.x, wid = __builtin_amdgcn_readfirstlane(tid >> 6), lane = tid & 63, wr = wid >> 2, wc = wid & 3, fr = lane & 15, fq = lane >> 4;
    const int K = g.K, nt = K / BK;
    unsigned voffA[2], voffB[2];
#pragma unroll
    for (int i = 0; i < 2; ++i) { int R, C; stage_rc(tid * 16 + i * 8192, R, C); const int Rb = Epi::PERM ? ((R & ~31) + perm32(R & 31)) : R;
        voffA[i] = (unsigned)(R * g.lda + C) * 2u; voffB[i] = (unsigned)(Rb * g.ldb + C) * 2u; }
    const size_t kstep = (size_t)(BK * 2);
    const size_t hstepA = (size_t)HALF * g.lda * 2, hstepB = (size_t)HALF * g.ldb * 2;
    const unsigned ldsw = (unsigned)wid * 1024u;
    const int aoff = lds_byte(wr * 64 + fr, fq * 8), boff = lds_byte(wc * 32 + fr, fq * 8);
#define PG8_SA(b, h) (((b) * 2 + (h)) * HTB)
#define PG8_SB(b, h) ((4 + (b) * 2 + (h)) * HTB)
#define PG8_STAGE(bufoff, gbase, voff) do { _Pragma("unroll") for (int _i = 0; _i < 2; ++_i) \
        __builtin_amdgcn_global_load_lds((const unsigned*)((const char*)(gbase) + (voff)[_i]), (LAS unsigned*)(lds + (bufoff) + ldsw + _i * 8192), 16, 0, 0); } while (0)
#define PG8_LDA(dst, b, h) do { _Pragma("unroll") for (int m = 0; m < 4; ++m) _Pragma("unroll") for (int k = 0; k < 2; ++k) dst[m][k] = *(const LAS bf16x8*)(lds + PG8_SA(b, h) + aoff + m * 2048 + k * 1024); } while (0)
#define PG8_LDB(dst, b, h) do { _Pragma("unroll") for (int n = 0; n < 2; ++n) _Pragma("unroll") for (int k = 0; k < 2; ++k) dst[n][k] = *(const LAS bf16x8*)(lds + PG8_SB(b, h) + boff + n * 2048 + k * 1024); } while (0)
#define PG8_MMA(ai, bj, At, Bt) do { __builtin_amdgcn_s_setprio(1); _Pragma("unroll") for (int m = 0; m < 4; ++m) _Pragma("unroll") for (int n = 0; n < 2; ++n) _Pragma("unroll") for (int k = 0; k < 2; ++k) \
        acc[ai][bj][m][n] = __builtin_amdgcn_mfma_f32_16x16x32_bf16(Bt[n][k], At[m][k], acc[ai][bj][m][n], 0, 0, 0); __builtin_amdgcn_s_setprio(0); } while (0)
#define PG8_WAIT_V(n) asm volatile("s_waitcnt vmcnt(" #n ")" ::: "memory")
#define PG8_WAIT_L(n) asm volatile("s_waitcnt lgkmcnt(" #n ")" ::: "memory")
#define PG8_BAR __builtin_amdgcn_s_barrier()
#define PG8_SCHED __builtin_amdgcn_sched_barrier(0)
    Unit cur, nxt; int ui = 0;
    if (!S.next(0, cur)) return;
    f32x4 acc[2][2][4][2];
#pragma unroll
    for (int a = 0; a < 2; ++a)
#pragma unroll
        for (int b = 0; b < 2; ++b)
#pragma unroll
            for (int m = 0; m < 4; ++m)
#pragma unroll
                for (int n = 0; n < 2; ++n) acc[a][b][m][n] = (f32x4){0.f, 0.f, 0.f, 0.f};
    bf16x8 At[4][2], B0[2][2], B1[2][2];
    const char* cA = S.pa(cur); const char* cB = S.pb(cur);
    PG8_STAGE(PG8_SB(0, 0), cB, voffB); PG8_STAGE(PG8_SB(0, 1), cB + hstepB, voffB); PG8_STAGE(PG8_SA(0, 0), cA, voffA); PG8_STAGE(PG8_SA(0, 1), cA + hstepA, voffA);
    if (wr == 1) PG8_BAR;
    PG8_WAIT_V(2); PG8_BAR;
    PG8_STAGE(PG8_SB(1, 0), cB + kstep, voffB); PG8_STAGE(PG8_SA(1, 0), cA + kstep, voffA); PG8_STAGE(PG8_SB(1, 1), cB + hstepB + kstep, voffB);
    PG8_WAIT_V(6); PG8_BAR;
    for (;;) {
        const bool has_next = S.next(ui + 1, nxt);
        const char* nA = has_next ? S.pa(nxt) : cA; const char* nB = has_next ? S.pb(nxt) : cB;
        asm volatile(".p2align 8" ::: "memory");
#pragma clang loop unroll(disable)
        for (int t = 0; t < nt; t += 2) {
            const bool last = (t == nt - 2);
            const char* a1 = cA + (size_t)(t + 1) * kstep;
            const char* a2 = last ? nA : cA + (size_t)(t + 2) * kstep; const char* b2 = last ? nB : cB + (size_t)(t + 2) * kstep;
            const char* a3 = a2 + kstep; const char* b3 = b2 + kstep;
            PG8_LDB(B0, 0, 0); PG8_LDB(B1, 0, 1); PG8_SCHED; PG8_LDA(At, 0, 0); PG8_STAGE(PG8_SA(1, 1), a1 + hstepA, voffA);
            PG8_WAIT_V(8); PG8_WAIT_L(0); PG8_BAR; PG8_MMA(0, 0, At, B0); PG8_MMA(0, 1, At, B1); PG8_BAR; PG8_SCHED;
            PG8_LDA(At, 0, 1); PG8_STAGE(PG8_SB(0, 0), b2, voffB); PG8_STAGE(PG8_SB(0, 1), b2 + hstepB, voffB); PG8_STAGE(PG8_SA(0, 0), a2, voffA);
            PG8_WAIT_V(8); PG8_WAIT_L(0); PG8_BAR; PG8_MMA(1, 0, At, B0); PG8_MMA(1, 1, At, B1); PG8_BAR; PG8_SCHED;
            PG8_LDB(B0, 1, 0); PG8_LDB(B1, 1, 1); PG8_SCHED; PG8_LDA(At, 1, 0); PG8_STAGE(PG8_SA(0, 1), a2 + hstepA, voffA);
            PG8_WAIT_V(8); PG8_WAIT_L(0); PG8_BAR; PG8_MMA(0, 0, At, B0); PG8_MMA(0, 1, At, B1); PG8_BAR; PG8_SCHED;
            PG8_LDA(At, 1, 1); PG8_STAGE(PG8_SB(1, 0), b3, voffB); PG8_STAGE(PG8_SB(1, 1), b3 + hstepB, voffB); PG8_STAGE(PG8_SA(1, 0), a3, voffA);
            PG8_WAIT_V(8); PG8_WAIT_L(0); PG8_BAR; PG8_MMA(1, 0, At, B0); PG8_MMA(1, 1, At, B1); PG8_BAR; PG8_SCHED;
        }
        if constexpr (ALIGN_EPI) { if (wr == 0) PG8_BAR; }
        E(acc, cur, wr, wc, fr, fq);
        if (!has_next) break;
#pragma unroll
        for (int a = 0; a < 2; ++a)
#pragma unroll
            for (int b = 0; b < 2; ++b)
#pragma unroll
                for (int m = 0; m < 4; ++m)
#pragma unroll
                    for (int n = 0; n < 2; ++n) acc[a][b][m][n] = (f32x4){0.f, 0.f, 0.f, 0.f};
        cur = nxt; cA = nA; cB = nB; ++ui;
        if constexpr (ALIGN_EPI) { if (wr == 1) PG8_BAR; }
    }
    PG8_WAIT_V(0);
    if constexpr (!ALIGN_EPI) { if (wr == 0) PG8_BAR; }
    PG8_BAR;
#undef PG8_SA
#undef PG8_SB
#undef PG8_STAGE
#undef PG8_LDA
#undef PG8_LDB
#undef PG8_MMA
#undef PG8_WAIT_V
#undef PG8_WAIT_L
#undef PG8_BAR
#undef PG8_SCHED
}

typedef const f32x4 (&AccRef)[2][2][4][2];

struct SchedPlain {
    TileOrder o; const char* A; const char* B; size_t astep, bstep;
    __device__ __forceinline__ bool next(int i, Unit& u) const { return o.tile(i, u); }
    __device__ __forceinline__ const char* pa(const Unit& u) const { return A + (size_t)u.pm * astep; }
    __device__ __forceinline__ const char* pb(const Unit& u) const { return B + (size_t)u.pn * bstep; }
};
struct SchedL2F {
    const char* A; const char* B; size_t astep, bstep; int v;
    __device__ __forceinline__ bool next(int i, Unit& u) const { if (i >= 3) return false; u.pm = v >> 2; u.pn = 4 * i + (v & 3); return true; }
    __device__ __forceinline__ const char* pa(const Unit& u) const { return A + (size_t)u.pm * astep; }
    __device__ __forceinline__ const char* pb(const Unit& u) const { return B + (size_t)u.pn * bstep; }
};
struct SchedRKV {
    TileOrder o; const char* A; const char* B; size_t astep, bstep, azstride;
    __device__ __forceinline__ bool next(int i, Unit& u) const { return o.tile(i, u); }
    __device__ __forceinline__ const char* pa(const Unit& u) const { return A + (size_t)(u.pn >> 2) * azstride + (size_t)u.pm * astep; }
    __device__ __forceinline__ const char* pb(const Unit& u) const { return B + (size_t)u.pn * bstep; }
};
struct SchedMoe {
    TileOrder o; const char* A; const char* B; size_t astep, bstep, bestride; const LAS int* ends;
    __device__ __forceinline__ bool next(int i, Unit& u) const { return o.tile(i, u); }
    __device__ __forceinline__ int be(int pm) const { int e = 0;
#pragma unroll
        for (int j = 0; j < NE - 1; ++j) e += (pm >= ends[j]) ? 1 : 0; return e; }
    __device__ __forceinline__ const char* pa(const Unit& u) const { return A + (size_t)u.pm * astep; }
    __device__ __forceinline__ const char* pb(const Unit& u) const { return B + (size_t)be(u.pm) * bestride + (size_t)u.pn * bstep; }
};

struct SchedMoeK {
    TileOrder o; const char* A; const char* B; size_t astep, bstep, bestride, kbytes; const LAS int* ends; int pm0;
    __device__ __forceinline__ bool next(int i, Unit& u) const { return o.tile(i, u); }
    __device__ __forceinline__ int be(int pm) const { int e = 0;
#pragma unroll
        for (int j = 0; j < NE - 1; ++j) e += (pm >= ends[j]) ? 1 : 0; return e; }
    __device__ __forceinline__ const char* pa(const Unit& u) const { return A + (size_t)(pm0 + u.pm) * astep + (size_t)(u.pn >> 2) * kbytes; }
    __device__ __forceinline__ const char* pb(const Unit& u) const { return B + (size_t)be(pm0 + u.pm) * bestride + (size_t)(u.pn & 3) * bstep + (size_t)(u.pn >> 2) * kbytes; }
};

struct EpiRKV {
    static constexpr bool PERM = true;
    bf16* C; size_t zstride;
    __device__ __forceinline__ void operator()(AccRef acc, const Unit& u, int wr, int wc, int fr, int fq) const {
        const int z = u.pn >> 2, pn = u.pn & 3; bf16* base = C + (size_t)z * zstride;
        const int row0 = u.pm * BM + wr * 64 + fr, col0 = pn * BM + wc * 32 + 8 * fq;
#pragma unroll
        for (int ai = 0; ai < 2; ++ai)
#pragma unroll
            for (int m = 0; m < 4; ++m) { bf16* rowp = base + (size_t)(row0 + ai * HALF + m * 16) * D + col0;
#pragma unroll
                for (int bj = 0; bj < 2; ++bj) { const f32x4 v0 = acc[ai][bj][m][0], v1 = acc[ai][bj][m][1];
                    u32x4 w; w.x = cvt_pk_bf16(v0[0], v0[1]); w.y = cvt_pk_bf16(v0[2], v0[3]); w.z = cvt_pk_bf16(v1[0], v1[1]); w.w = cvt_pk_bf16(v1[2], v1[3]);
                    *(u32x4*)(rowp + bj * HALF) = w; } }
    }
};
struct EpiRes {
    static constexpr bool PERM = false;
    const float* base; float* out;
    __device__ __forceinline__ void operator()(AccRef acc, const Unit& u, int wr, int wc, int fr, int fq) const {
        const int row0 = u.pm * BM + wr * 64 + fr, col0 = u.pn * BM + wc * 32 + 4 * fq;
#pragma unroll
        for (int ai = 0; ai < 2; ++ai)
#pragma unroll
            for (int m = 0; m < 4; ++m) { const size_t off = (size_t)(row0 + ai * HALF + m * 16) * D + col0;
#pragma unroll
                for (int bj = 0; bj < 2; ++bj)
#pragma unroll
                    for (int n = 0; n < 2; ++n) { const f32x4 b = *(const f32x4*)(base + off + bj * HALF + n * 16); *(f32x4*)(out + off + bj * HALF + n * 16) = b + acc[ai][bj][m][n]; } }
    }
};
struct EpiL1 {
    static constexpr bool PERM = true;
    bf16* O;
    __device__ __forceinline__ void operator()(AccRef acc, const Unit& u, int wr, int wc, int fr, int fq) const {
        const int row0 = u.pm * BM + wr * 64 + fr, col0 = wc * 32 + 8 * fq;
#pragma unroll
        for (int ai = 0; ai < 2; ++ai)
#pragma unroll
            for (int m = 0; m < 4; ++m) { bf16* rowp = O + (size_t)(row0 + ai * HALF + m * 16) * 256 + col0;
#pragma unroll
                for (int bj = 0; bj < 2; ++bj) { float v[8];
#pragma unroll
                    for (int i = 0; i < 4; ++i) { v[i] = acc[ai][bj][m][0][i]; v[4 + i] = acc[ai][bj][m][1][i]; }
#pragma unroll
                    for (int i = 0; i < 8; ++i) { if (bj == 1) v[i] = sigmoidf_(v[i]); else if (wc < 2) v[i] = tanhf_(v[i]); }
                    u32x4 w; w.x = cvt_pk_bf16(v[0], v[1]); w.y = cvt_pk_bf16(v[2], v[3]); w.z = cvt_pk_bf16(v[4], v[5]); w.w = cvt_pk_bf16(v[6], v[7]);
                    *(u32x4*)(rowp + bj * HALF) = w; } }
    }
};
struct EpiL2 {
    static constexpr bool PERM = true;
    float* LW; bf16* AA; bf16* G; const float* w0; const float* a0;
    __device__ __forceinline__ void operator()(AccRef acc, const Unit& u, int wr, int wc, int fr, int fq) const {
        const int z = u.pn >> 2, pn = u.pn & 3;
        const int row0 = u.pm * BM + wr * 64 + fr, col0 = pn * BM + wc * 32 + 8 * fq;
        if (z == 0) {
#pragma unroll
            for (int bj = 0; bj < 2; ++bj) { const f32x4 b0 = *(const f32x4*)(w0 + col0 + bj * HALF), b1 = *(const f32x4*)(w0 + col0 + bj * HALF + 4);
#pragma unroll
                for (int ai = 0; ai < 2; ++ai)
#pragma unroll
                    for (int m = 0; m < 4; ++m) { f32x4 v0 = acc[ai][bj][m][0] + b0, v1 = acc[ai][bj][m][1] + b1;
#pragma unroll
                        for (int i = 0; i < 4; ++i) { v0[i] = -0.6065306597126334f * sigmoidf_(v0[i]); v1[i] = -0.6065306597126334f * sigmoidf_(v1[i]); }
                        float* p = LW + (size_t)(row0 + ai * HALF + m * 16) * D + col0 + bj * HALF; *(f32x4*)p = v0; *(f32x4*)(p + 4) = v1; } }
        } else {
            bf16* base = z == 1 ? AA : G;
#pragma unroll
            for (int bj = 0; bj < 2; ++bj) { f32x4 b0 = {0.f, 0.f, 0.f, 0.f}, b1 = b0; if (z == 1) { b0 = *(const f32x4*)(a0 + col0 + bj * HALF); b1 = *(const f32x4*)(a0 + col0 + bj * HALF + 4); }
#pragma unroll
                for (int ai = 0; ai < 2; ++ai)
#pragma unroll
                    for (int m = 0; m < 4; ++m) { f32x4 v0 = acc[ai][bj][m][0] + b0, v1 = acc[ai][bj][m][1] + b1;
                        if (z == 1) {
#pragma unroll
                            for (int i = 0; i < 4; ++i) { v0[i] = sigmoidf_(v0[i]); v1[i] = sigmoidf_(v1[i]); } }
                        u32x4 w; w.x = cvt_pk_bf16(v0[0], v0[1]); w.y = cvt_pk_bf16(v0[2], v0[3]); w.z = cvt_pk_bf16(v1[0], v1[1]); w.w = cvt_pk_bf16(v1[2], v1[3]);
                        *(u32x4*)(base + (size_t)(row0 + ai * HALF + m * 16) * D + col0 + bj * HALF) = w; } }
        }
    }
};
struct EpiSwiGLU {
    static constexpr bool PERM = true;
    bf16* O;
    __device__ __forceinline__ void operator()(AccRef acc, const Unit& u, int wr, int wc, int fr, int fq) const {
        const int row0 = u.pm * BM + wr * 64 + fr, col0 = u.pn * HALF + wc * 32 + 8 * fq;
#pragma unroll
        for (int ai = 0; ai < 2; ++ai)
#pragma unroll
            for (int m = 0; m < 4; ++m) { float v[8];
#pragma unroll
                for (int n = 0; n < 2; ++n)
#pragma unroll
                    for (int i = 0; i < 4; ++i) { const float gt = acc[ai][0][m][n][i], up = acc[ai][1][m][n][i];
                        v[4 * n + i] = gt * up * __builtin_amdgcn_rcpf(1.f + __builtin_amdgcn_exp2f(gt * -1.4426950408889634f)); }
                u32x4 w; w.x = cvt_pk_bf16(v[0], v[1]); w.y = cvt_pk_bf16(v[2], v[3]); w.z = cvt_pk_bf16(v[4], v[5]); w.w = cvt_pk_bf16(v[6], v[7]);
                *(u32x4*)(O + (size_t)(row0 + ai * HALF + m * 16) * FF + col0) = w; }
    }
};
struct EpiBf16K {
    static constexpr bool PERM = true;
    bf16* O; size_t slab;
    __device__ __forceinline__ void operator()(AccRef acc, const Unit& u, int wr, int wc, int fr, int fq) const {
        bf16* base = O + (size_t)(u.pn >> 2) * slab;
        const int row0 = u.pm * BM + wr * 64 + fr, col0 = (u.pn & 3) * BM + wc * 32 + 8 * fq;
#pragma unroll
        for (int ai = 0; ai < 2; ++ai)
#pragma unroll
            for (int m = 0; m < 4; ++m) { bf16* rowp = base + (size_t)(row0 + ai * HALF + m * 16) * D + col0;
#pragma unroll
                for (int bj = 0; bj < 2; ++bj) { const f32x4 v0 = acc[ai][bj][m][0], v1 = acc[ai][bj][m][1];
                    u32x4 w; w.x = cvt_pk_bf16(v0[0], v0[1]); w.y = cvt_pk_bf16(v0[2], v0[3]); w.z = cvt_pk_bf16(v1[0], v1[1]); w.w = cvt_pk_bf16(v1[2], v1[3]);
                    *(u32x4*)(rowp + bj * HALF) = w; } }
    }
};
struct EpiQKVG {
    static constexpr bool PERM = true;
    bf16* O; const float* gq; const float* gk;
    __device__ __forceinline__ void operator()(AccRef acc, const Unit& u, int wr, int wc, int fr, int fq) const {
        const int row0 = u.pm * BM + wr * 64 + fr;
        if (u.pn < 8) {
            const float* gp = u.pn < 4 ? gq : gk; const float sc = u.pn < 4 ? 0.125f * LOG2E : 1.f;
            f32x4 gn[2][2];
#pragma unroll
            for (int bj = 0; bj < 2; ++bj)
#pragma unroll
                for (int n = 0; n < 2; ++n) gn[bj][n] = *(const f32x4*)(gp + 32 * bj + 8 * fq + 4 * n) * sc;
            const int colb = 256 * u.pn + 64 * wc + 8 * fq;
#pragma unroll
            for (int ai = 0; ai < 2; ++ai)
#pragma unroll
                for (int m = 0; m < 4; ++m) { float ss = 0.f;
#pragma unroll
                    for (int bj = 0; bj < 2; ++bj)
#pragma unroll
                        for (int n = 0; n < 2; ++n) { const f32x4 v = acc[ai][bj][m][n]; ss += (v[0] * v[0] + v[1] * v[1]) + (v[2] * v[2] + v[3] * v[3]); }
                    ss += __shfl_xor(ss, 16); ss += __shfl_xor(ss, 32);
                    const float rs = rsqrtf(ss * (1.f / 64.f) + RMS_EPS);
                    bf16* rowp = O + (size_t)(row0 + ai * HALF + m * 16) * 4096 + colb;
#pragma unroll
                    for (int bj = 0; bj < 2; ++bj) { const f32x4 v0 = acc[ai][bj][m][0] * rs * gn[bj][0], v1 = acc[ai][bj][m][1] * rs * gn[bj][1];
                        u32x4 w; w.x = cvt_pk_bf16(v0[0], v0[1]); w.y = cvt_pk_bf16(v0[2], v0[3]); w.z = cvt_pk_bf16(v1[0], v1[1]); w.w = cvt_pk_bf16(v1[2], v1[3]);
                        *(u32x4*)(rowp + 32 * bj) = w; } }
        } else {
            const int col0 = u.pn * BM + wc * 32 + 8 * fq;
#pragma unroll
            for (int ai = 0; ai < 2; ++ai)
#pragma unroll
                for (int m = 0; m < 4; ++m) { bf16* rowp = O + (size_t)(row0 + ai * HALF + m * 16) * 4096 + col0;
#pragma unroll
                    for (int bj = 0; bj < 2; ++bj) { const f32x4 v0 = acc[ai][bj][m][0], v1 = acc[ai][bj][m][1];
                        u32x4 w; w.x = cvt_pk_bf16(v0[0], v0[1]); w.y = cvt_pk_bf16(v0[2], v0[3]); w.z = cvt_pk_bf16(v1[0], v1[1]); w.w = cvt_pk_bf16(v1[2], v1[3]);
                        *(u32x4*)(rowp + bj * HALF) = w; } }
        }
    }
};
struct EpiBf16 {
    static constexpr bool PERM = true;
    bf16* O; int ldc;
    __device__ __forceinline__ void operator()(AccRef acc, const Unit& u, int wr, int wc, int fr, int fq) const {
        const int row0 = u.pm * BM + wr * 64 + fr, col0 = u.pn * BM + wc * 32 + 8 * fq;
#pragma unroll
        for (int ai = 0; ai < 2; ++ai)
#pragma unroll
            for (int m = 0; m < 4; ++m) { bf16* rowp = O + (size_t)(row0 + ai * HALF + m * 16) * ldc + col0;
#pragma unroll
                for (int bj = 0; bj < 2; ++bj) { const f32x4 v0 = acc[ai][bj][m][0], v1 = acc[ai][bj][m][1];
                    u32x4 w; w.x = cvt_pk_bf16(v0[0], v0[1]); w.y = cvt_pk_bf16(v0[2], v0[3]); w.z = cvt_pk_bf16(v1[0], v1[1]); w.w = cvt_pk_bf16(v1[2], v1[3]);
                    *(u32x4*)(rowp + bj * HALF) = w; } }
    }
};
}

#define XB_TMO      128
#define XB_XCNT(j)  (256  + 64 * (j))
#define XB_XSUB(j)  (1280 + 64 * (j))
#define XB_XGEN(j)  (2304 + 64 * (j))
#define XB_TOP      3328
#define XB_TOPGEN   3392
#define XCD_BAR_WORDS 3456
#define XB_SPIN_CAP (1u << 18)
__device__ __forceinline__ unsigned xb_ld(unsigned* p)              { return __hip_atomic_load(p, __ATOMIC_RELAXED, __HIP_MEMORY_SCOPE_AGENT); }
__device__ __forceinline__ unsigned xb_add(unsigned* p, unsigned v) { return __hip_atomic_fetch_add(p, v, __ATOMIC_RELAXED, __HIP_MEMORY_SCOPE_AGENT); }
__device__ __forceinline__ unsigned xb_xcc_id() { return (unsigned)__builtin_amdgcn_s_getreg((3 << 11) | 20) & 0xFu; }
#define XB_SPIN(cond, bar) do { unsigned _sp = 0; while (cond) { __builtin_amdgcn_s_sleep(1); \
    if ((++_sp & 255u) == 0u) { if (xb_ld(&(bar)[XB_TMO])) break; if (_sp > XB_SPIN_CAP) { atomicAdd(&(bar)[XB_TMO], 1u); break; } } } } while (0)
struct XcdBarrier { unsigned* bar; unsigned x; volatile LAS unsigned* st; };
__device__ __forceinline__ XcdBarrier xcd_barrier_post(unsigned* bar, volatile LAS unsigned* st) {
    XcdBarrier b; b.bar = bar; b.x = xb_xcc_id(); b.st = st;
    if (threadIdx.x == 0) (void)xb_add(&bar[XB_XCNT(b.x)], 1u);
    return b;
}
__device__ __forceinline__ void xcd_barrier_complete(unsigned* bar, unsigned x, unsigned& nloc, unsigned& nx) {
    const unsigned G = gridDim.x * gridDim.y * gridDim.z;
    unsigned sum, cnt, mine, sp = 0u;
    for (;;) {
        sum = 0u; cnt = 0u; mine = 0u;
#pragma unroll
        for (unsigned j = 0; j < 16; ++j) { const unsigned c = xb_ld(&bar[XB_XCNT(j)]); sum += c; cnt += (c > 0u) ? 1u : 0u; mine = (j == x) ? c : mine; }
        if (sum == G) break;
        __builtin_amdgcn_s_sleep(1);
        if ((++sp & 255u) == 0u) { if (xb_ld(&bar[XB_TMO])) break; if (sp > XB_SPIN_CAP) { atomicAdd(&bar[XB_TMO], 1u); break; } }
    }
    nloc = mine > 0u ? mine : 1u; nx = cnt > 0u ? cnt : 1u;
}
__device__ __forceinline__ void xcd_barrier(const XcdBarrier& b) {
    asm volatile("s_waitcnt vmcnt(0)" ::: "memory");
    __syncthreads();
    if (threadIdx.x == 0) {
        unsigned* bar = b.bar;
        __builtin_amdgcn_s_waitcnt(0);
        unsigned nloc = b.st[0], nx = b.st[1];
        if (nloc == 0u) { xcd_barrier_complete(bar, b.x, nloc, nx); b.st[0] = nloc; b.st[1] = nx; }
        const unsigned old = xb_add(&bar[XB_XSUB(b.x)], 1u);
        const unsigned gen = old / nloc;
        if (old + 1u == (gen + 1u) * nloc) {
            __builtin_amdgcn_fence(__ATOMIC_RELEASE, "agent");
            asm volatile("s_waitcnt vmcnt(0)" ::: "memory");
            const unsigned og = xb_add(&bar[XB_TOP], 1u);
            const unsigned tg = og / nx;
            if (og + 1u == (tg + 1u) * nx) xb_add(&bar[XB_TOPGEN], 1u);
            else XB_SPIN(xb_ld(&bar[XB_TOPGEN]) == tg, bar);
            __builtin_amdgcn_fence(__ATOMIC_ACQUIRE, "agent");
            xb_add(&bar[XB_XGEN(b.x)], 1u);
            asm volatile("s_waitcnt vmcnt(0)" ::: "memory");
        } else {
            XB_SPIN(xb_ld(&bar[XB_XGEN(b.x)]) == gen, bar);
            __builtin_amdgcn_fence(__ATOMIC_ACQUIRE, "agent");
            asm volatile("s_waitcnt vmcnt(0)" ::: "memory");
        }
    }
    __syncthreads();
}

struct Args { const float* in[29]; float* out; unsigned char* ws; int ph_lo, ph_hi; };
struct Frame {
    LAS unsigned char* lds; gu32* ctl; unsigned char* ws;
    int tid, lane, wave, vcu, G, gw, NGW;
};

struct Row { f32x4 v[4]; };
__device__ __forceinline__ Row ld_row(const float* p, int lane) { Row r; const f32x4* q = (const f32x4*)p + lane;
#pragma unroll
    for (int j = 0; j < 4; ++j) r.v[j] = q[64 * j]; return r; }
__device__ __forceinline__ void st_row(float* p, int lane, const Row& r) { f32x4* q = (f32x4*)p + lane;
#pragma unroll
    for (int j = 0; j < 4; ++j) q[64 * j] = r.v[j]; }
__device__ __forceinline__ void st_row_bf16(bf16* p, int lane, const Row& r) { u32x2* q = (u32x2*)p + lane;
#pragma unroll
    for (int j = 0; j < 4; ++j) { u32x2 w; w.x = pk2(r.v[j][0], r.v[j][1]); w.y = pk2(r.v[j][2], r.v[j][3]); q[64 * j] = w; } }
__device__ __forceinline__ Row ld_row_bf16(const bf16* p, int lane) { Row r; const u32x2* q = (const u32x2*)p + lane;
#pragma unroll
    for (int j = 0; j < 4; ++j) { const u32x2 w = q[64 * j]; r.v[j] = (f32x4){bflo(w.x), bfhi(w.x), bflo(w.y), bfhi(w.y)}; } return r; }
__device__ __forceinline__ float row_sumsq(const Row& r) { float s = 0.f;
#pragma unroll
    for (int j = 0; j < 4; ++j) s += (r.v[j][0] * r.v[j][0] + r.v[j][1] * r.v[j][1]) + (r.v[j][2] * r.v[j][2] + r.v[j][3] * r.v[j][3]); return wave_sum(s); }
__device__ __forceinline__ Row rmsnorm_row(const Row& x, const Row& g) { const float rs = rsqrtf(row_sumsq(x) * (1.f / D) + RMS_EPS); Row y;
#pragma unroll
    for (int j = 0; j < 4; ++j) y.v[j] = x.v[j] * rs * g.v[j]; return y; }

__device__ __forceinline__ void tr_item(const float* W, int ldw, int k0, int n0, bf16* WT, int ldt, int drow0, int dcol0, const float* sc, int scmode, LAS float* scr, int lane) {
#pragma unroll 8
    for (int i = 0; i < 32; ++i) { const int kk = 2 * i + (lane >> 5); float v = W[(size_t)(k0 + kk) * ldw + n0 + (lane & 31)];
        if (scmode == 1) v *= sc[k0 + kk]; else if (scmode == 2) v *= (1.f - sc[k0 + kk]);
        scr[kk * 33 + (lane & 31)] = v; }
    LDS_WAIT(); asm volatile("" ::: "memory");
    const int c = lane & 7;
#pragma unroll
    for (int j = 0; j < 4; ++j) { const int n = (lane >> 3) + 8 * j; const LAS float* s = scr + (8 * c) * 33 + n;
        u32x4 o; o.x = pk2(s[0 * 33], s[1 * 33]); o.y = pk2(s[2 * 33], s[3 * 33]); o.z = pk2(s[4 * 33], s[5 * 33]); o.w = pk2(s[6 * 33], s[7 * 33]);
        *(GAS u32x4*)(WT + (size_t)(drow0 + n0 + n) * ldt + dcol0 + k0 + 8 * c) = o; }
    LDS_WAIT(); asm volatile("" ::: "memory");
}
__device__ __forceinline__ int gu_row(int n) { return n < FF ? 256 * (n >> 7) + (n & 127) : 256 * ((n - FF) >> 7) + 128 + ((n - FF) & 127); }

__device__ __forceinline__ void p0_prologue(Frame& F, const Args& a) {
    LAS float* scr = (LAS float*)(F.lds + F.wave * 16384);
    unsigned char* ws = F.ws;
    constexpr int I_SQ = 16 * 32;
    constexpr int I_RKV = 3 * I_SQ, I_L1 = 2 * 16 * 8, I_L2 = 4 * 32, I_GU = 16 * 224, I_DN = 56 * 32, I_IN = 16 * 128;
    constexpr int NITEMS = I_RKV + I_L1 + I_L2 + I_SQ + I_GU + I_DN + I_IN + I_SQ;
    for (int it = F.gw; it < NITEMS; it += F.NGW) {
        int r = it;
        if (r < I_RKV) { const int z = r / I_SQ, q = r % I_SQ; tr_item(a.in[4] + (size_t)z * D * D, D, 64 * (q / 32), 32 * (q % 32), (bf16*)(ws + WS_W_RKV) + (size_t)z * D * D, D, 0, 0, nullptr, 0, scr, F.lane); continue; } r -= I_RKV;
        if (r < I_L1) {
            const int half = r / 128, q = r % 128, kb = q / 8, nb = q % 8, n0 = 32 * nb;
            const float* W; int ldw, nn0, mi;
            if (n0 < 64) { W = a.in[6]; ldw = 64; nn0 = n0; mi = 3; } else if (n0 < 128) { W = a.in[9]; ldw = 64; nn0 = n0 - 64; mi = 4; } else { W = a.in[11]; ldw = 128; nn0 = n0 - 128; mi = 5; }
            tr_item(W, ldw, 64 * kb, nn0, (bf16*)(ws + WS_W_L1), 2 * D, n0 - nn0, half * D, a.in[3] + mi * D, half == 0 ? 1 : 2, scr, F.lane); continue; } r -= I_L1;
        if (r < I_L2) {
            const int part = r / 32, nb = r % 32;
            if (part == 0) tr_item(a.in[7], D, 0, 32 * nb, (bf16*)(ws + WS_W_L2), 256, 0, 0, nullptr, 0, scr, F.lane);
            else if (part == 1) tr_item(a.in[10], D, 0, 32 * nb, (bf16*)(ws + WS_W_L2), 256, D, 64, nullptr, 0, scr, F.lane);
            else tr_item(a.in[12], D, 64 * (part - 2), 32 * nb, (bf16*)(ws + WS_W_L2), 256, 2 * D, 128, nullptr, 0, scr, F.lane);
            continue; } r -= I_L2;
        if (r < I_SQ) { tr_item(a.in[18], D, 64 * (r / 32), 32 * (r % 32), (bf16*)(ws + WS_W_O0), D, 0, 0, nullptr, 0, scr, F.lane); continue; } r -= I_SQ;
        if (r < I_GU) { const int kb = r / 224, nb = r % 224; tr_item(a.in[24], 2 * FF, 64 * kb, 32 * nb, (bf16*)(ws + WS_W_GU), D, gu_row(32 * nb) - 32 * nb, 0, nullptr, 0, scr, F.lane); continue; } r -= I_GU;
        if (r < I_DN) { tr_item(a.in[25], D, 64 * (r / 32), 32 * (r % 32), (bf16*)(ws + WS_W_DN), FF, 0, 0, nullptr, 0, scr, F.lane); continue; } r -= I_DN;
        if (r < I_IN) { const int n0 = 32 * (r % 128);
            const int drow = n0 < 2 * D ? 256 * (n0 / 256) + 128 * ((n0 % 64) / 32) + 32 * ((n0 % 256) / 64) : n0;
            tr_item(a.in[19], WIN_LD, 64 * (r / 128), n0, (bf16*)(ws + WS_W_IN), D, drow - n0, 0, nullptr, 0, scr, F.lane); continue; } r -= I_IN;
        { tr_item(a.in[23], D, 64 * (r / 32), 32 * (r % 32), (bf16*)(ws + WS_W_FO), D, 0, 0, nullptr, 0, scr, F.lane); }
    }
    for (int i = F.gw * 64 + F.lane; i < 3 * D * 32; i += F.NGW * 64) { const int row = i >> 5, ch = i & 31, part = row / D, k = ch * 8;
        const bool nz = part == 0 ? (k < 64) : (part == 1 ? (k >= 64 && k < 128) : (k >= 128));
        if (!nz) *(GAS u32x4*)((bf16*)(ws + WS_W_L2) + (size_t)row * 256 + k) = (u32x4){0u, 0u, 0u, 0u}; }
}

__device__ __forceinline__ void p0_moe_weights(Frame& F, const Args& a, int wi, int nw, int part) {
    LAS float* scr = (LAS float*)(F.lds + F.wave * 16384);
    unsigned char* ws = F.ws;
    constexpr int I_GU = 16 * 224, I_DN = 56 * 32;
    constexpr int NIT = NE * (I_GU + I_DN), MOE_CUT = NIT;
    for (int it = (part ? MOE_CUT : 0) + wi * NWAVES + F.wave; it < (part ? NIT : MOE_CUT); it += nw * NWAVES) {
        int r = it;
        if (r < NE * I_GU) { const int e = r / I_GU, q = r % I_GU, kb = q / 224, nb = q % 224;
            tr_item(a.in[27] + (size_t)e * D * 2 * FF, 2 * FF, 64 * kb, 32 * nb, (bf16*)(ws + WS_W_MGU) + (size_t)e * 2 * FF * D, D, gu_row(32 * nb) - 32 * nb, 0, nullptr, 0, scr, F.lane); continue; } r -= NE * I_GU;
        { const int e = r / I_DN, q = r % I_DN; tr_item(a.in[28] + (size_t)e * FF * D, D, 64 * (q / 32), 32 * (q % 32), (bf16*)(ws + WS_W_MDN) + (size_t)e * D * FF, FF, 0, 0, nullptr, 0, scr, F.lane); }
    }
}

__device__ __forceinline__ void p1_shift(Frame& F, const Args& a) {
    const int lane = F.lane; const float* x = a.in[0];
    bf16* UB = (bf16*)(F.ws + WS_UB); bf16* XS = (bf16*)(F.ws + WS_XS);
    const Row g0 = ld_row(a.in[1], lane);
    const int RPW = T / (256 * NWAVES);
    for (int t0 = F.gw * RPW; t0 < T; t0 += F.NGW * RPW) {
        Row prev;
        if (t0 > 0) prev = rmsnorm_row(ld_row(x + (size_t)(t0 - 1) * D, lane), g0);
        else { for (int j = 0; j < 4; ++j) prev.v[j] = (f32x4){0.f, 0.f, 0.f, 0.f}; st_row_bf16(UB, lane, prev); }
        for (int t = t0; t < t0 + RPW; ++t) {
            const Row u = rmsnorm_row(ld_row(x + (size_t)t * D, lane), g0);
            st_row_bf16(UB + (size_t)(t + 1) * D, lane, u);
#pragma unroll
            for (int n = 0; n < 3; ++n) { const Row mu = ld_row(a.in[3] + n * D, lane); Row o;
#pragma unroll
                for (int j = 0; j < 4; ++j) o.v[j] = u.v[j] + (prev.v[j] - u.v[j]) * mu.v[j];
                st_row_bf16(XS + (size_t)n * T * D + (size_t)t * D, lane, o); }
            prev = u;
        }
    }
}

typedef __bf16 bf16x2_t __attribute__((ext_vector_type(2)));
__device__ __forceinline__ unsigned cvtpk(float lo, float hi) { f32x2 v = {lo, hi}; bf16x2_t b = __builtin_convertvector(v, bf16x2_t); return __builtin_bit_cast(unsigned, b); }
struct Pk { bf16x8 k0, k1; };
__device__ __forceinline__ Pk pack_tile(const f32x16& t) {
    const u32x4 a = {cvtpk(t[0], t[1]), cvtpk(t[2], t[3]), cvtpk(t[4], t[5]), cvtpk(t[6], t[7])}, b = {cvtpk(t[8], t[9]), cvtpk(t[10], t[11]), cvtpk(t[12], t[13]), cvtpk(t[14], t[15])};
    Pk p; p.k0 = __builtin_bit_cast(bf16x8, a); p.k1 = __builtin_bit_cast(bf16x8, b); return p; }
#define MFMA32(a, b, c) __builtin_amdgcn_mfma_f32_32x32x16_bf16((a), (b), (c), 0, 0, 0)
__device__ __forceinline__ f32x16 xt(const Pk& X, const Pk& Z, f32x16 acc) { acc = MFMA32(X.k0, Z.k0, acc); acc = MFMA32(X.k1, Z.k1, acc); return acc; }
__device__ __forceinline__ bf16x8 nfrag(const bf16* m, int rt, int ks, int lane) { return *(const bf16x8*)(m + (size_t)(32 * rt + (lane & 31)) * D + 16 * ks + 8 * (lane >> 5)); }
__device__ __forceinline__ f32x16 nat(const bf16* am, int a, const bf16* bm, int b, int lane, f32x16 acc) {
#pragma unroll
    for (int ks = 0; ks < 4; ++ks) acc = MFMA32(nfrag(am, a, ks, lane), nfrag(bm, b, ks, lane), acc);
    return acc; }
__device__ __forceinline__ f32x16 dl_copy(const bf16* am, int a, int ct, int lane) {
    f32x16 acc = {};
#pragma unroll
    for (int kk2 = 0; kk2 < 2; ++kk2) { const int ks = 2 * ct + kk2; bf16x8 id;
#pragma unroll
        for (int e = 0; e < 8; ++e) id[e] = (32 * ct + (lane & 31) == 16 * ks + 8 * (lane >> 5) + e) ? (short)0x3F80 : (short)0;
        acc = MFMA32(nfrag(am, a, ks, lane), id, acc); }
    return acc; }
__device__ __forceinline__ void mask_lt(f32x16& t, int lane) {
#pragma unroll
    for (int r = 0; r < 16; ++r) if (!(crow(r, lane >> 5) < (lane & 31))) t[r] = 0.f; }
__device__ __forceinline__ void mask_gt(f32x16& t, int lane) {
#pragma unroll
    for (int r = 0; r < 16; ++r) if (!(crow(r, lane >> 5) > (lane & 31))) t[r] = 0.f; }
__device__ __forceinline__ void mask_le(f32x16& t, int lane) {
#pragma unroll
    for (int r = 0; r < 16; ++r) if (!(crow(r, lane >> 5) <= (lane & 31))) t[r] = 0.f; }
__device__ __forceinline__ void add_eye(f32x16& t, int lane) {
#pragma unroll
    for (int r = 0; r < 16; ++r) if (crow(r, lane >> 5) == (lane & 31)) t[r] += 1.f; }

__device__ __forceinline__ void p3_prep(Frame& F, const Args& a, int only_task = -1) {
    const int lane = F.lane;
    const bf16* R = (const bf16*)(F.ws + WS_R); const bf16* K = (const bf16*)(F.ws + WS_K); const bf16* V = (const bf16*)(F.ws + WS_V);
    const float* LW = (const float*)(F.ws + WS_LW); const bf16* AA = (const bf16*)(F.ws + WS_AA);
    bf16* AT = (bf16*)(F.ws + WS_AT); bf16* RT = (bf16*)(F.ws + WS_RT); bf16* BH = (bf16*)(F.ws + WS_BH); bf16* KH = (bf16*)(F.ws + WS_KH); bf16* V16 = (bf16*)(F.ws + WS_V16);
    float* GC = (float*)(F.ws + WS_GC); float* C3 = (float*)(F.ws + WS_CS) + (size_t)2 * T * 16;
    for (int task = only_task >= 0 ? only_task : F.gw; task < NCH * 8; task += (only_task >= 0 ? NCH * 8 : F.NGW)) {
        const int c = task >> 3, hg = (task >> 1) & 3, half = task & 1, col = hg * 256 + 4 * lane;
        const f32x4 k_k = *(const f32x4*)(a.in[13] + col), k_a = *(const f32x4*)(a.in[14] + col), r_k = *(const f32x4*)(a.in[15] + col);
        f32x4 lg = {0.f, 0.f, 0.f, 0.f};
        if (half) {
            f32x4 l32[32];
#pragma unroll
            for (int u = 0; u < 32; ++u) l32[u] = *(const f32x4*)(LW + (size_t)(64 * c + u) * D + col);
#pragma unroll
            for (int u = 0; u < 32; ++u) lg = lg + l32[u];
        }
        constexpr int PF = 8;
        for (int tb = 32 * half; tb < 32 * half + 32; tb += PF) {
            u32x2 rr[PF], kx[PF], ax[PF]; f32x4 lx[PF];
#pragma unroll
            for (int u = 0; u < PF; ++u) { const size_t o = (size_t)(64 * c + tb + u) * D + col;
                rr[u] = *(const u32x2*)(R + o); kx[u] = *(const u32x2*)(K + o); lx[u] = *(const f32x4*)(LW + o); ax[u] = *(const u32x2*)(AA + o); }
#pragma unroll
            for (int u = 0; u < PF; ++u) { const int tt = tb + u;
                const size_t o = (size_t)(64 * c + tt) * D + col;
                const f32x4 r = {bflo(rr[u].x), bfhi(rr[u].x), bflo(rr[u].y), bfhi(rr[u].y)}, k = {bflo(kx[u].x), bfhi(kx[u].x), bflo(kx[u].y), bfhi(kx[u].y)}, lw = lx[u], aa = {bflo(ax[u].x), bfhi(ax[u].x), bflo(ax[u].y), bfhi(ax[u].y)};
                f32x4 kk = k * k_k;
                float ss = (kk[0] * kk[0] + kk[1] * kk[1]) + (kk[2] * kk[2] + kk[3] * kk[3]); ss = row16_sum(ss);
                kk = kk * (1.f / fmaxf(sqrtf(ss), 1e-12f));
                const f32x4 b = kk * aa, km = k * (1.f + (aa - 1.f) * k_a);
                float s3 = (r[0] * km[0] * r_k[0] + r[1] * km[1] * r_k[1]) + (r[2] * km[2] * r_k[2] + r[3] * km[3] * r_k[3]); s3 = row16_sum(s3);
                if ((lane & 15) == 0) C3[(size_t)(64 * c + tt) * 16 + hg * 4 + (lane >> 4)] = s3;
                const f32x4 lgm1 = lg; lg = lg + lw;
                f32x4 at, rt, bh, kh;
#pragma unroll
                for (int i = 0; i < 4; ++i) { const float em = __expf(lgm1[i]), ep = __expf(lg[i]), en = __expf(-lg[i]); at[i] = -kk[i] * em; rt[i] = r[i] * ep; bh[i] = b[i] * en; kh[i] = km[i] * en; }
                *(u32x2*)(AT + o) = (u32x2){pk2(at[0], at[1]), pk2(at[2], at[3])}; *(u32x2*)(RT + o) = (u32x2){pk2(rt[0], rt[1]), pk2(rt[2], rt[3])};
                *(u32x2*)(BH + o) = (u32x2){pk2(bh[0], bh[1]), pk2(bh[2], bh[3])}; *(u32x2*)(KH + o) = (u32x2){pk2(kh[0], kh[1]), pk2(kh[2], kh[3])};
            }
        }
        if (half) { f32x4 g; for (int i = 0; i < 4; ++i) g[i] = __expf(lg[i]);
            *(f32x4*)(GC + (size_t)c * D + col) = g; }
    }
}

__device__ __forceinline__ void inv32(f32x16 N, f32x16 NT, f32x16& Tm, f32x16& TT, int lane) {
    Tm = N; TT = NT; add_eye(Tm, lane); add_eye(TT, lane);
    Pk Np = pack_tile(N), NTp = pack_tile(NT);
#pragma unroll
    for (int it = 0; it < 4; ++it) {
        const f32x16 z = {};
        const f32x16 N2 = xt(NTp, Np, z), N2T = xt(Np, NTp, z);
        const Pk N2p = pack_tile(N2), N2Tp = pack_tile(N2T), TTp = pack_tile(TT);
        Tm = xt(TTp, N2p, Tm);
        TT = xt(N2p, TTp, TT);
        Np = N2p; NTp = N2Tp;
    }
}

__device__ __forceinline__ void pa_chunk(Frame& F) {
    const int lane = F.lane, c32 = lane & 31, hh = lane >> 5;
    const bf16* AT = (const bf16*)(F.ws + WS_AT); const bf16* BH = (const bf16*)(F.ws + WS_BH); const bf16* KH = (const bf16*)(F.ws + WS_KH); const bf16* V16 = (const bf16*)(F.ws + WS_V16);
    const float* GC = (const float*)(F.ws + WS_GC);
    for (int task = F.gw; task < NCH * NH; task += F.NGW) {
        const int c = task >> 4, h = task & 15; const size_t o = (size_t)(64 * c) * D + h * 64;
        const bf16* at = AT + o; const bf16* bh = BH + o; const bf16* kh = KH + o; const bf16* vv = V16 + o;
        const f32x16 z = {};
        bf16x8 atf[2][4], bhf[2][4], khf[2][4], vvf[2][4];
#pragma unroll
        for (int r2 = 0; r2 < 2; ++r2)
#pragma unroll
            for (int ks = 0; ks < 4; ++ks) { atf[r2][ks] = nfrag(at, r2, ks, lane); bhf[r2][ks] = nfrag(bh, r2, ks, lane); }
        const float g0 = GC[(size_t)c * D + h * 64 + c32], g1 = GC[(size_t)c * D + h * 64 + 32 + c32];
#define NATR(Af, a_, Bf, b_, acc_) do { _Pragma("unroll") for (int ks_ = 0; ks_ < 4; ++ks_) acc_ = MFMA32(Af[a_][ks_], Bf[b_][ks_], acc_); } while (0)
#define DLR(Af, a_, ct_, acc_) do { _Pragma("unroll") for (int k2_ = 0; k2_ < 2; ++k2_) { const int ks_ = 2 * (ct_) + k2_; bf16x8 id_; \
            _Pragma("unroll") for (int e_ = 0; e_ < 8; ++e_) id_[e_] = (32 * (ct_) + c32 == 16 * ks_ + 8 * hh + e_) ? (short)0x3F80 : (short)0; acc_ = MFMA32(Af[a_][ks_], id_, acc_); } } while (0)
        Pk T11T, T22T, T12T;
        {
            Pk T11, T22, T12;
            f32x16 n = z, nt = z; NATR(bhf, 0, atf, 0, n); NATR(atf, 0, bhf, 0, nt); mask_lt(n, lane); mask_gt(nt, lane);
            f32x16 t, tt; inv32(n, nt, t, tt, lane); T11 = pack_tile(t); T11T = pack_tile(tt);
            n = z; nt = z; NATR(bhf, 1, atf, 1, n); NATR(atf, 1, bhf, 1, nt); mask_lt(n, lane); mask_gt(nt, lane);
            inv32(n, nt, t, tt, lane); T22 = pack_tile(t); T22T = pack_tile(tt);
            n = z; nt = z; NATR(bhf, 0, atf, 1, n); NATR(atf, 1, bhf, 0, nt);
            const Pk N12 = pack_tile(n), N12T = pack_tile(nt);
            const Pk Z1 = pack_tile(xt(N12T, T22, z));
            T12 = pack_tile(xt(T11T, Z1, z));
            const Pk Z2 = pack_tile(xt(N12, T11T, z));
            T12T = pack_tile(xt(T22, Z2, z));
            u32x4* tm = (u32x4*)(F.ws + WS_TM) + (size_t)task * 6 * 64 + lane;
            tm[0] = __builtin_bit_cast(u32x4, T11.k0); tm[64] = __builtin_bit_cast(u32x4, T11.k1); tm[128] = __builtin_bit_cast(u32x4, T12.k0); tm[192] = __builtin_bit_cast(u32x4, T12.k1);
            tm[256] = __builtin_bit_cast(u32x4, T22.k0); tm[320] = __builtin_bit_cast(u32x4, T22.k1);
        }
        __builtin_amdgcn_sched_barrier(0);
#pragma unroll
        for (int r2 = 0; r2 < 2; ++r2)
#pragma unroll
            for (int ks = 0; ks < 4; ++ks) khf[r2][ks] = nfrag(kh, r2, ks, lane);
        Pk W1p[2][2];
#pragma unroll
        for (int b = 0; b < 2; ++b) { const float gcol = b == 0 ? g0 : g1;
            f32x16 bb0 = z, bb1 = z; DLR(bhf, 0, b, bb0); DLR(bhf, 1, b, bb1);
#pragma unroll
            for (int r = 0; r < 16; ++r) { bb0[r] *= gcol; bb1[r] *= gcol; }
            const Pk B0 = pack_tile(bb0), B1 = pack_tile(bb1);
            f32x16 w0 = xt(T11T, B0, z); w0 = xt(T12T, B1, w0);
            const f32x16 w1 = xt(T22T, B1, z);
            W1p[0][b] = pack_tile(w0); W1p[1][b] = pack_tile(w1); }
        __builtin_amdgcn_sched_barrier(0);
        {
            bf16* plr = (bf16*)(F.ws + WS_PLR) + (size_t)task * 4096;
#pragma unroll
            for (int a2 = 0; a2 < 2; ++a2) { f32x16 d0 = z, d1 = z; DLR(atf, 0, a2, d0); DLR(atf, 1, a2, d1); const Pk A0 = pack_tile(d0), A1 = pack_tile(d1);
#pragma unroll
                for (int b = 0; b < 2; ++b) { f32x16 p = xt(A0, W1p[0][b], z); p = xt(A1, W1p[1][b], p);
#pragma unroll
                    for (int g4 = 0; g4 < 4; ++g4) {
                        const int m_ = 2 * b + (c32 >> 4), lb_ = (c32 & 15) + 16 * (2 * (g4 & 1) + hh);
                        *(u32x2*)(plr + ((m_ * 2 + a2) * 64 + lb_) * 8 + 4 * (g4 >> 1)) = (u32x2){cvtpk(p[4 * g4], p[4 * g4 + 1]), cvtpk(p[4 * g4 + 2], p[4 * g4 + 3])}; } } }
        }
        __builtin_amdgcn_sched_barrier(0);
#pragma unroll
        for (int r2 = 0; r2 < 2; ++r2)
#pragma unroll
            for (int ks = 0; ks < 4; ++ks) vvf[r2][ks] = nfrag(vv, r2, ks, lane);
        Pk M2p[2][2];
        {
            f32x16 e = z; NATR(atf, 0, khf, 0, e); mask_gt(e, lane); const Pk E00 = pack_tile(e);
            e = z; NATR(atf, 1, khf, 1, e); mask_gt(e, lane); const Pk E11 = pack_tile(e);
            e = z; NATR(atf, 1, khf, 0, e); const Pk E10 = pack_tile(e);
#pragma unroll
            for (int b = 0; b < 2; ++b) { const float gcol = b == 0 ? g0 : g1;
                f32x16 m0 = xt(E00, W1p[0][b], z); m0 = xt(E10, W1p[1][b], m0);
                f32x16 m1 = xt(E11, W1p[1][b], z);
                f32x16 k0 = z, k1 = z; DLR(khf, 0, b, k0); DLR(khf, 1, b, k1);
#pragma unroll
                for (int r = 0; r < 16; ++r) { m0[r] += k0[r] * gcol; m1[r] += k1[r] * gcol; }
                M2p[0][b] = pack_tile(m0); M2p[1][b] = pack_tile(m1); }
        }
        __builtin_amdgcn_sched_barrier(0);
        {
            bf16* qm = (bf16*)(F.ws + WS_QM) + (size_t)task * 4096;
#pragma unroll
            for (int b = 0; b < 2; ++b) { f32x16 d0 = z, d1 = z; DLR(vvf, 0, b, d0); DLR(vvf, 1, b, d1); const Pk V0 = pack_tile(d0), V1 = pack_tile(d1);
#pragma unroll
                for (int a2 = 0; a2 < 2; ++a2) { f32x16 q = xt(M2p[0][a2], V0, z); q = xt(M2p[1][a2], V1, q);
#pragma unroll
                    for (int g4 = 0; g4 < 4; ++g4) {
                        const int rg_ = 2 * b + (c32 >> 4), m_ = 2 * a2 + (g4 >> 1), lb_ = (c32 & 15) + 16 * (2 * (g4 & 1) + hh);
                        *(u32x2*)(qm + rg_ * 1024 + (m_ * 64 + lb_) * 4) = (u32x2){cvtpk(q[4 * g4], q[4 * g4 + 1]), cvtpk(q[4 * g4 + 2], q[4 * g4 + 3])}; } } }
        }
#undef NATR
#undef DLR
    }
}

constexpr int PB_NST = 12, PB_QOFF = 8192, PB_GOFF = 8192 + 2048, PB_STB = 8192 + 2048 + 256, PB_NLD = 4, PB_NDMA = 11;
constexpr int PB_FULL_OFF = RING_BYTES + 64, PB_CONS_OFF = RING_BYTES + 128, PB_DUMP_OFF = RING_BYTES + 2048;
static_assert(PB_NST * PB_STB <= RING_BYTES && PB_FULL_OFF + 4 * PB_NST <= PB_CONS_OFF && PB_CONS_OFF + 4 <= MISC_OFF, "phase-B LDS map");
__device__ __forceinline__ void pb_chain(Frame& F) {
    if ((F.vcu & 31) >= 8 || F.vcu >= 256 || F.wave > PB_NLD) return;
    static_assert(PB_NLD == 4 && PB_NDMA == 11 && 2 * PB_NLD < PB_NST, "the counted waits below assume 11 LDS-DMA instructions per stage and publish two of a loader's stages behind");
    const int lane = F.lane, h = 2 * (F.vcu >> 5) + ((F.vcu & 31) >> 2), rg = F.vcu & 3;
    volatile LAS unsigned* FULL = (volatile LAS unsigned*)(F.lds + PB_FULL_OFF); volatile LAS unsigned* CONS = (volatile LAS unsigned*)(F.lds + PB_CONS_OFF);
    if (F.wave >= 1) {
        const int L = F.wave - 1;
        const char* PLR = (const char*)(F.ws + WS_PLR); const char* QM = (const char*)(F.ws + WS_QM); const float* GC = (const float*)(F.ws + WS_GC);
        int k = 0;
        for (int c = L; c < NCH; c += PB_NLD, ++k) {
            if (c >= PB_NST) { const unsigned need = (unsigned)(c - PB_NST + 1); unsigned sp = 0; while (CONS[0] < need) { __builtin_amdgcn_s_sleep(1); if (++sp > (1u << 22)) break; } }
            const size_t task = (size_t)c * 16 + h;
            LAS unsigned char* slot = F.lds + (c % PB_NST) * PB_STB;
            const char* pl = PLR + task * 8192 + lane * 16; const char* qm = QM + task * 8192 + rg * 2048 + lane * 16;
#pragma unroll
            for (int i = 0; i < 8; ++i) __builtin_amdgcn_global_load_lds((const unsigned*)(pl + i * 1024), (LAS unsigned*)(slot + i * 1024), 16, 0, 0);
#pragma unroll
            for (int i = 0; i < 2; ++i) __builtin_amdgcn_global_load_lds((const unsigned*)(qm + i * 1024), (LAS unsigned*)(slot + PB_QOFF + i * 1024), 16, 0, 0);
            __builtin_amdgcn_global_load_lds((const unsigned*)(GC + (size_t)c * D + h * 64 + lane), (LAS unsigned*)(slot + PB_GOFF), 4, 0, 0);
            if (k >= 2) { asm volatile("s_waitcnt vmcnt(22)" ::: "memory"); const int cp = c - 2 * PB_NLD; FULL[cp % PB_NST] = (unsigned)(cp + 1); }
        }
        const int clast = L + PB_NLD * (k - 1);
        if (k >= 2) { asm volatile("s_waitcnt vmcnt(11)" ::: "memory"); const int cp = clast - PB_NLD; FULL[cp % PB_NST] = (unsigned)(cp + 1); }
        asm volatile("s_waitcnt vmcnt(0)" ::: "memory"); FULL[clast % PB_NST] = (unsigned)(clast + 1);
        return;
    }
    const int n16 = lane & 15, q4 = lane >> 4;
    bf16* S0 = (bf16*)(F.ws + WS_S0);
    f32x4 s[4];
#pragma unroll
    for (int m = 0; m < 4; ++m) s[m] = (f32x4){0.f, 0.f, 0.f, 0.f};
    bf16x8 af[4][2]; u32x2 qv[4]; f32x4 gc[4];
#define PB_TAKE(cc) do { { const unsigned need_ = (unsigned)((cc) + 1); unsigned sp_ = 0; while (FULL[(cc) % PB_NST] < need_) { if (++sp_ > (1u << 24)) break; } } \
        const LAS unsigned char* slot_ = F.lds + ((cc) % PB_NST) * PB_STB; \
        _Pragma("unroll") for (int m = 0; m < 4; ++m) { _Pragma("unroll") for (int kb = 0; kb < 2; ++kb) af[m][kb] = *(const LAS bf16x8*)(slot_ + ((m * 2 + kb) * 64 + lane) * 16); \
            qv[m] = *(const LAS u32x2*)(slot_ + PB_QOFF + (m * 64 + lane) * 8); gc[m] = *(const LAS f32x4*)(slot_ + PB_GOFF + 64 * m + 16 * q4); } \
        asm volatile("s_waitcnt lgkmcnt(0)" ::: "memory"); CONS[0] = (unsigned)((cc) + 1); } while (0)
    PB_TAKE(0);
    for (int c = 0; c < NCH; ++c) {
        bf16* s0 = S0 + ((size_t)c * 16 + h) * 4096 + (16 * rg + n16) * 64;
        u32x2 sp2[4];
#pragma unroll
        for (int m = 0; m < 4; ++m) { sp2[m] = (u32x2){cvtpk(s[m][0], s[m][1]), cvtpk(s[m][2], s[m][3])}; *(u32x2*)(s0 + 16 * m + 4 * q4) = sp2[m]; }
        const bf16x8 B0 = __builtin_bit_cast(bf16x8, (u32x4){sp2[0].x, sp2[0].y, sp2[1].x, sp2[1].y}), B1 = __builtin_bit_cast(bf16x8, (u32x4){sp2[2].x, sp2[2].y, sp2[3].x, sp2[3].y});
        f32x4 acc[4];
#pragma unroll
        for (int m = 0; m < 4; ++m) { acc[m] = s[m] * gc[m] + (f32x4){bflo(qv[m].x), bfhi(qv[m].x), bflo(qv[m].y), bfhi(qv[m].y)};
            acc[m] = __builtin_amdgcn_mfma_f32_16x16x32_bf16(af[m][0], B0, acc[m], 0, 0, 0);
            acc[m] = __builtin_amdgcn_mfma_f32_16x16x32_bf16(af[m][1], B1, acc[m], 0, 0, 0); }
        if (c + 1 < NCH) PB_TAKE(c + 1);
#pragma unroll
        for (int m = 0; m < 4; ++m) s[m] = acc[m];
    }
#undef PB_TAKE
}

__device__ __forceinline__ void pc_out(Frame& F, const Args& a) {
    const int lane = F.lane, c32 = lane & 31, hh = lane >> 5;
    const bf16* AT = (const bf16*)(F.ws + WS_AT); const bf16* RT = (const bf16*)(F.ws + WS_RT); const bf16* BH = (const bf16*)(F.ws + WS_BH); const bf16* KH = (const bf16*)(F.ws + WS_KH);
    const bf16* V16 = (const bf16*)(F.ws + WS_V16); const bf16* S0 = (const bf16*)(F.ws + WS_S0);
    const bf16* G = (const bf16*)(F.ws + WS_G); const float* C3 = (const float*)(F.ws + WS_CS) + (size_t)2 * T * 16; bf16* Z = (bf16*)(F.ws + WS_Z);
    LAS float* ysc = (LAS float*)(F.lds + F.wave * 16384);
    for (int task = F.gw; task < NCH * NH; task += F.NGW) {
        const int c = task >> 4, h = task & 15; const size_t o = (size_t)(64 * c) * D + h * 64;
        const bf16* at = AT + o; const bf16* rt = RT + o; const bf16* bh = BH + o; const bf16* kh = KH + o; const bf16* vv = V16 + o;
        const bf16* s0 = S0 + (size_t)task * 4096;
        const f32x16 z = {};
#define NATR(Af, a_, Bf, b_, acc_) do { _Pragma("unroll") for (int ks_ = 0; ks_ < 4; ++ks_) acc_ = MFMA32(Af[a_][ks_], Bf[b_][ks_], acc_); } while (0)
        Pk K00, K01, K11, B00, B01, B11, R00, R01, R11, Tm00, Tm01, Tm11;
        {
            bf16x8 atf[2][4], khf[2][4], rtf[2][4], bhf[2][4];
#pragma unroll
            for (int r2 = 0; r2 < 2; ++r2)
#pragma unroll
                for (int ks = 0; ks < 4; ++ks) { atf[r2][ks] = nfrag(at, r2, ks, lane); khf[r2][ks] = nfrag(kh, r2, ks, lane); rtf[r2][ks] = nfrag(rt, r2, ks, lane); bhf[r2][ks] = nfrag(bh, r2, ks, lane); }
            { const u32x4* tm = (const u32x4*)(F.ws + WS_TM) + (size_t)task * 6 * 64 + lane;
              Tm00.k0 = __builtin_bit_cast(bf16x8, tm[0]); Tm00.k1 = __builtin_bit_cast(bf16x8, tm[64]); Tm01.k0 = __builtin_bit_cast(bf16x8, tm[128]); Tm01.k1 = __builtin_bit_cast(bf16x8, tm[192]);
              Tm11.k0 = __builtin_bit_cast(bf16x8, tm[256]); Tm11.k1 = __builtin_bit_cast(bf16x8, tm[320]); }
            f32x16 e;
            e = z; NATR(khf, 0, atf, 0, e); mask_lt(e, lane); K00 = pack_tile(e);
            e = z; NATR(khf, 1, atf, 1, e); mask_lt(e, lane); K11 = pack_tile(e);
            e = z; NATR(khf, 0, atf, 1, e); K01 = pack_tile(e);
            e = z; NATR(bhf, 0, rtf, 0, e); mask_le(e, lane); B00 = pack_tile(e);
            e = z; NATR(bhf, 1, rtf, 1, e); mask_le(e, lane); B11 = pack_tile(e);
            e = z; NATR(bhf, 0, rtf, 1, e); B01 = pack_tile(e);
            e = z; NATR(khf, 0, rtf, 0, e); mask_le(e, lane); R00 = pack_tile(e);
            e = z; NATR(khf, 1, rtf, 1, e); mask_le(e, lane); R11 = pack_tile(e);
            e = z; NATR(khf, 0, rtf, 1, e); R01 = pack_tile(e);
        }
        __builtin_amdgcn_sched_barrier(0);
#pragma unroll 1
        for (int b = 0; b < 2; ++b) {
            bf16x8 vvf[2][2], sf[4], atf[2][4], rtf[2][4];
#pragma unroll
            for (int r2 = 0; r2 < 2; ++r2)
#pragma unroll
                for (int k2 = 0; k2 < 2; ++k2) vvf[r2][k2] = nfrag(vv, r2, 2 * b + k2, lane);
#pragma unroll
            for (int ks = 0; ks < 4; ++ks) sf[ks] = *(const bf16x8*)(s0 + (32 * b + c32) * 64 + 16 * ks + 8 * hh);
#pragma unroll
            for (int r2 = 0; r2 < 2; ++r2)
#pragma unroll
                for (int ks = 0; ks < 4; ++ks) { atf[r2][ks] = nfrag(at, r2, ks, lane); rtf[r2][ks] = nfrag(rt, r2, ks, lane); }
            Pk V0, V1;
            { f32x16 v0 = z, v1 = z;
#pragma unroll
              for (int k2 = 0; k2 < 2; ++k2) { const int ks = 2 * b + k2; bf16x8 id;
#pragma unroll
                  for (int e2 = 0; e2 < 8; ++e2) id[e2] = (32 * b + c32 == 16 * ks + 8 * hh + e2) ? (short)0x3F80 : (short)0;
                  v0 = MFMA32(vvf[0][k2], id, v0); v1 = MFMA32(vvf[1][k2], id, v1); }
              V0 = pack_tile(v0); V1 = pack_tile(v1); }
            f32x16 x0 = z, x1 = z;
#pragma unroll
            for (int ks = 0; ks < 4; ++ks) { x0 = MFMA32(atf[0][ks], sf[ks], x0); x1 = MFMA32(atf[1][ks], sf[ks], x1); }
            x0 = xt(K00, V0, x0);
            x1 = xt(K01, V0, x1); x1 = xt(K11, V1, x1);
            const Pk X0 = pack_tile(x0), X1 = pack_tile(x1);
            __builtin_amdgcn_sched_barrier(0);
            const Pk U0 = pack_tile(xt(Tm00, X0, z));
            f32x16 u1 = xt(Tm01, X0, z); u1 = xt(Tm11, X1, u1); const Pk U1 = pack_tile(u1);
            __builtin_amdgcn_sched_barrier(0);
            f32x16 y0 = z, y1 = z;
#pragma unroll
            for (int ks = 0; ks < 4; ++ks) { y0 = MFMA32(rtf[0][ks], sf[ks], y0); y1 = MFMA32(rtf[1][ks], sf[ks], y1); }
            y0 = xt(B00, U0, y0); y1 = xt(B01, U0, y1); y1 = xt(B11, U1, y1);
            y0 = xt(R00, V0, y0); y1 = xt(R01, V0, y1); y1 = xt(R11, V1, y1);
            __builtin_amdgcn_sched_barrier(0);
#pragma unroll
            for (int r = 0; r < 16; ++r) { ysc[crow(r, hh) * 64 + 32 * b + c32] = y0[r]; ysc[(32 + crow(r, hh)) * 64 + 32 * b + c32] = y1[r]; }
        }
#undef NATR
        LDS_WAIT();
        {
            int lane_e = lane; asm volatile("" : "+v"(lane_e));
            const int l16 = lane_e & 15, tq = lane_e >> 4, col = h * 64 + 4 * l16;
            const f32x4 gg = *(const f32x4*)(a.in[16] + col), gb = *(const f32x4*)(a.in[17] + col);
            u32x2 gwv[16], vwv[16]; float c3v[16];
#pragma unroll
            for (int it = 0; it < 16; ++it) { const size_t row = (size_t)(64 * c + 4 * it + tq); gwv[it] = *(const u32x2*)(G + row * D + col); vwv[it] = *(const u32x2*)(V16 + row * D + col); c3v[it] = C3[row * 16 + h]; }
#pragma unroll
            for (int it = 0; it < 16; ++it) { const int tt = 4 * it + tq; const size_t row = (size_t)(64 * c + tt);
                const f32x4 y = *(const LAS f32x4*)(ysc + tt * 64 + 4 * l16);
                const u32x2 gw = gwv[it], vw = vwv[it]; const float c3 = c3v[it];
                const float mean = row16_sum((y[0] + y[1]) + (y[2] + y[3])) * (1.f / 64.f);
                const f32x4 d = y - mean;
                const float var = row16_sum((d[0] * d[0] + d[1] * d[1]) + (d[2] * d[2] + d[3] * d[3])) * (1.f / 64.f);
                const float rs = rsqrtf(var + GN_EPS);
                const f32x4 g = {bflo(gw.x), bfhi(gw.x), bflo(gw.y), bfhi(gw.y)}, v = {bflo(vw.x), bfhi(vw.x), bflo(vw.y), bfhi(vw.y)};
                const f32x4 zv = (d * rs * gg + gb + c3 * v) * g;
                *(u32x2*)(Z + row * D + col) = (u32x2){pk2(zv[0], zv[1]), pk2(zv[2], zv[3])}; }
        }
        LDS_WAIT();
    }
}

__device__ __forceinline__ void p8_norm(Frame& F, const float* g, bf16* U) {
    const float* Hs = (const float*)(F.ws + WS_H); const Row gr = ld_row(g, F.lane);
    for (int t = F.gw; t < T; t += F.NGW) st_row_bf16(U + (size_t)t * D, F.lane, rmsnorm_row(ld_row(Hs + (size_t)t * D, F.lane), gr));
}
__device__ __forceinline__ void p11_norm_forget(Frame& F, const Args& a) {
    const int lane = F.lane; const float* Hs = (const float*)(F.ws + WS_H); bf16* U = (bf16*)(F.ws + WS_U3); float* LF = (float*)(F.ws + WS_LF);
    LAS float* wf = (LAS float*)F.lds;
    __syncthreads();
    for (int i = F.tid; i < 16 * D; i += NTHREADS) { const int hh = i & 15, k = i >> 4; wf[hh * D + k] = a.in[19][(size_t)k * WIN_LD + 4 * D + hh]; }
    __syncthreads();
    const Row gr = ld_row(a.in[1] + 2 * D, lane);
    for (int tg = F.gw; tg < T / 4; tg += F.NGW) {
        Row u[4];
#pragma unroll
        for (int r = 0; r < 4; ++r) { u[r] = rmsnorm_row(ld_row(Hs + (size_t)(4 * tg + r) * D, lane), gr); st_row_bf16(U + (size_t)(4 * tg + r) * D, lane, u[r]); }
        float mine[4] = {0.f, 0.f, 0.f, 0.f};
#pragma unroll 2
        for (int hh = 0; hh < 16; ++hh) { float s4[4] = {0.f, 0.f, 0.f, 0.f};
#pragma unroll
            for (int j = 0; j < 4; ++j) { const f32x4 w = *(const LAS f32x4*)(wf + hh * D + 256 * j + 4 * lane);
#pragma unroll
                for (int r = 0; r < 4; ++r) s4[r] += (u[r].v[j][0] * w[0] + u[r].v[j][1] * w[1]) + (u[r].v[j][2] * w[2] + u[r].v[j][3] * w[3]); }
#pragma unroll
            for (int r = 0; r < 4; ++r) { const float t_ = wave_sum(s4[r]); if (lane == hh) mine[r] = t_; } }
        if (lane < 16) { const float bf_ = a.in[20][lane];
#pragma unroll
            for (int r = 0; r < 4; ++r) { const float x = mine[r] + bf_; LF[(size_t)(4 * tg + r) * 16 + lane] = fminf(x, 0.f) - log1pf(__expf(-fabsf(x))); } }
    }
    __syncthreads();
}
__device__ __forceinline__ void p12_cumsum(Frame& F) {
    if (F.vcu >= NH) return;
    const int tid = F.tid, h = F.vcu;
    const float* LF = (const float*)(F.ws + WS_LF); float* C2 = (float*)(F.ws + WS_C2); float* CB = (float*)(F.ws + WS_CB);
    LAS double* part = (LAS double*)F.lds;
    __syncthreads();
    const int tb = tid * 32; float lf[32]; double s = 0.0;
#pragma unroll
    for (int i = 0; i < 32; ++i) lf[i] = LF[(size_t)(tb + i) * 16 + h];
#pragma unroll
    for (int i = 0; i < 32; ++i) s += (double)lf[i];
    part[tid] = s; __syncthreads();
    if (tid < 64) {
        double v[8], run = 0.0;
#pragma unroll
        for (int i = 0; i < 8; ++i) { v[i] = part[tid * 8 + i]; run += v[i]; }
        double inc = run;
#pragma unroll
        for (int o = 1; o < 64; o <<= 1) { const double nb = __shfl_up(inc, o); if (tid >= o) inc += nb; }
        double ex = inc - run;
#pragma unroll
        for (int i = 0; i < 8; ++i) { part[tid * 8 + i] = ex; ex += v[i]; }
    }
    __syncthreads();
    double run = part[tid];
#pragma unroll
    for (int i = 0; i < 32; ++i) { run += (double)lf[i]; const float c = (float)(run * 1.4426950408889634); C2[(size_t)h * T + tb + i] = c; if (((tb + i) & 63) == 63) CB[h * 256 + ((tb + i) >> 6)] = c; }
    __syncthreads();
}

#ifndef ATTN_STORE16
#define ATTN_STORE16(p,v) (*(u32x4*)(p)=(v))
#endif
namespace attn_body {
using bf16x8=__attribute__((ext_vector_type(8)))short;
using s16x4=__attribute__((ext_vector_type(4)))short;
using f32x16=__attribute__((ext_vector_type(16)))float;
using u32x4=__attribute__((ext_vector_type(4)))unsigned;
constexpr int NHEAD=16,SEQ=16384,D=64,DM=4096,OM=1024;
constexpr int NW=8,QBLK=32,QB=QBLK*NW,KVBLK=64,NQB=SEQ/QB;
constexpr int ATTN_UNIT_ROWS=QB;
__device__ __forceinline__ int crow(int r,int hi){return (r&3)+8*(r>>2)+4*hi;}
#define SBAR() __builtin_amdgcn_sched_barrier(0)
__device__ __forceinline__ void cmask(f32x16&p0,f32x16&p1,int jb,int qrel,int hi){
  const float NEG=-INFINITY; int kb=64*jb+4*hi;
  #pragma unroll
  for(int r=0;r<16;++r){int kv=kb+(r&3)+8*(r>>2); if(kv>qrel)p0[r]=NEG; if(kv+32>qrel)p1[r]=NEG;}
}

constexpr int NSLOT=3, SLOTB=8192;
constexpr int LDS_K=0, LDS_V=NSLOT*SLOTB, LDS_WS=2*NSLOT*SLOTB, LDS_OST=LDS_WS+NW*64*4, LDS_BYTES=LDS_OST+NW*4096;
constexpr float C2=0.125f*1.4426950408889634f;
__device__ __forceinline__ void glds16(const void*gsrc,unsigned lds_dst){unsigned keep;
  asm volatile("s_mov_b32 %0, m0\n\ts_mov_b32 m0, %2\n\ts_nop 0\n\tglobal_load_lds_dwordx4 %1, off\n\ts_mov_b32 m0, %0":"=&s"(keep):"v"(gsrc),"s"(lds_dst):"memory");}
__device__ __forceinline__ float max3f(float a,float b,float c){float r;asm("v_max3_f32 %0, %1, %2, %3":"=v"(r):"v"(a),"v"(b),"v"(c));return r;}
__device__ __forceinline__ float max2f(float a,float b){float r;asm("v_max_f32_e32 %0, %1, %2":"=v"(r):"v"(a),"v"(b));return r;}
__device__ __forceinline__ float fadd_s(float a,float b){float r;asm("v_add_f32_e32 %0, %1, %2":"=v"(r):"v"(a),"v"(b));return r;}
__device__ __forceinline__ float fsub_s(float a,float b){float r;asm("v_sub_f32_e32 %0, %1, %2":"=v"(r):"v"(a),"v"(b));return r;}
typedef float f32x2_t __attribute__((ext_vector_type(2))); typedef __bf16 bf16x2_t __attribute__((ext_vector_type(2)));
__device__ __forceinline__ unsigned cvtpk_s(float lo,float hi){f32x2_t v={lo,hi};bf16x2_t b=__builtin_convertvector(v,bf16x2_t);return __builtin_bit_cast(unsigned,b);}
#define WAIT_BAR(N) asm volatile("s_waitcnt vmcnt(" #N ") lgkmcnt(0)\n\ts_barrier":::"memory")

__device__ __forceinline__ void qkt(f32x16&p0,f32x16&p1,const char*Kslot,const __attribute__((address_space(3))) char*qst,const f32x16&cin0,const f32x16&cin1,int r32,int hi){
  #define QF_(i) (*(const __attribute__((address_space(3))) bf16x8*)(qst+(i)*1024))
  const char*kb=Kslot+hi*1024+r32*16;
  #pragma unroll
  for(int d0=0;d0<4;++d0){
    const bf16x8 b0=*reinterpret_cast<const bf16x8*>(kb+d0*2048);
    const bf16x8 b1=*reinterpret_cast<const bf16x8*>(kb+d0*2048+512);
    const bf16x8 qd=QF_(d0);
    if(d0==0){p0=__builtin_amdgcn_mfma_f32_32x32x16_bf16(b0,qd,cin0,0,0,0);p1=__builtin_amdgcn_mfma_f32_32x32x16_bf16(b1,qd,cin1,0,0,0);}
    else{p0=__builtin_amdgcn_mfma_f32_32x32x16_bf16(b0,qd,p0,0,0,0);p1=__builtin_amdgcn_mfma_f32_32x32x16_bf16(b1,qd,p1,0,0,0);}}
  #undef QF_
}
typedef __attribute__((address_space(3))) const char* lds_cptr;
typedef short v4i16_t __attribute__((ext_vector_type(4)));
__device__ __forceinline__ void kload8(bf16x8*kf,lds_cptr kp){
  kf[0]=*(const __attribute__((address_space(3))) bf16x8*)(kp);      kf[1]=*(const __attribute__((address_space(3))) bf16x8*)(kp+512);
  kf[2]=*(const __attribute__((address_space(3))) bf16x8*)(kp+2048); kf[3]=*(const __attribute__((address_space(3))) bf16x8*)(kp+2560);
  kf[4]=*(const __attribute__((address_space(3))) bf16x8*)(kp+4096); kf[5]=*(const __attribute__((address_space(3))) bf16x8*)(kp+4608);
  kf[6]=*(const __attribute__((address_space(3))) bf16x8*)(kp+6144); kf[7]=*(const __attribute__((address_space(3))) bf16x8*)(kp+6656);
}
__device__ __forceinline__ void kload2(bf16x8*kf,lds_cptr kp,int j){ kf[2*j]=*(const __attribute__((address_space(3))) bf16x8*)(kp+j*2048); kf[2*j+1]=*(const __attribute__((address_space(3))) bf16x8*)(kp+j*2048+512); }
__device__ __forceinline__ s16x4 vtr(lds_cptr p){ return __builtin_bit_cast(s16x4,__builtin_amdgcn_ds_read_tr16_b64_v4i16((__attribute__((address_space(3))) v4i16_t*)p)); }
__device__ __forceinline__ float rowmax(const f32x16&p0,const f32x16&p1){
  float a=max3f(p0[0],p0[1],p1[0]),b=max3f(p0[2],p0[3],p1[1]);a=max3f(a,p1[2],p1[3]);
  #pragma unroll
  for(int r=4;r<16;r+=4){a=max3f(a,p0[r],p0[r+1]);b=max3f(b,p0[r+2],p0[r+3]);a=max3f(a,p1[r],p1[r+1]);b=max3f(b,p1[r+2],p1[r+3]);}
  const float m=max2f(a,b);
  auto rr=__builtin_amdgcn_permlane32_swap(__float_as_uint(m),__float_as_uint(m),false,false);
  return max2f(__uint_as_float(rr[0]),__uint_as_float(rr[1]));
}
__device__ __forceinline__ void pv(f32x16*o,int vb,bf16x8 pa0,bf16x8 pa1,bf16x8 pa2,bf16x8 pa3){
  #pragma unroll
  for(int d0=0;d0<2;++d0){s16x4 lo[4],hi[4];
    #pragma unroll
    for(int ks=0;ks<4;++ks){
      asm volatile("ds_read_b64_tr_b16 %0,%1 offset:%c2":"=&v"(lo[ks]):"v"(vb),"i"(d0*4096+ks*1024):"memory");
      asm volatile("ds_read_b64_tr_b16 %0,%1 offset:%c2":"=&v"(hi[ks]):"v"(vb),"i"(d0*4096+ks*1024+512):"memory");}
    asm volatile("s_waitcnt lgkmcnt(0)":::"memory");SBAR();
    #define PK(k) (bf16x8){lo[k][0],lo[k][1],lo[k][2],lo[k][3],hi[k][0],hi[k][1],hi[k][2],hi[k][3]}
    o[d0]=__builtin_amdgcn_mfma_f32_32x32x16_bf16(pa0,PK(0),o[d0],0,0,0);
    o[d0]=__builtin_amdgcn_mfma_f32_32x32x16_bf16(pa1,PK(1),o[d0],0,0,0);
    o[d0]=__builtin_amdgcn_mfma_f32_32x32x16_bf16(pa2,PK(2),o[d0],0,0,0);
    o[d0]=__builtin_amdgcn_mfma_f32_32x32x16_bf16(pa3,PK(3),o[d0],0,0,0);
    #undef PK
  }
}

#ifndef ATTN_STORE16
#define ATTN_STORE16(p,v) (*(u32x4*)(p)=(v))
#endif
template<int THRL> __device__ __forceinline__ void attn_unit(int h,int qb,int jstart,const bf16*Q,const bf16*__restrict__ K,const bf16*__restrict__ V,const bf16*__restrict__ OG,bf16*O,const float*__restrict__ C2h,char*shm){
  const int tid=threadIdx.x,lane=tid&63,r32=lane&31,hi=lane>>5; const int wid=__builtin_amdgcn_readfirstlane(tid>>6);
  const long rowbase=0; const int q0=qb*QB;
  const bf16*Qw=Q+(rowbase+q0+wid*QBLK)*DM+h*D;
  const bf16*Kh=K+(rowbase+(long)jstart*KVBLK)*DM+h*D,*Vh=V+(rowbase+(long)jstart*KVBLK)*DM+h*D;
  const lds_cptr shm3=(lds_cptr)shm;
  const unsigned lds0=(unsigned)(uintptr_t)shm;
  float*wsf=(float*)(shm+LDS_WS)+wid*64;
  const bf16*ksrc=Kh+(long)lane*DM+wid*8;
  const bf16*vsrc=Vh+(long)(16*(wid&3)+(lane>>2))*DM+(wid>>2)*32+(lane&3)*8;
  const unsigned kdst=lds0+LDS_K+wid*1024, vdst=lds0+LDS_V+wid*1024;
  #define DMA_K(t,slot) glds16(ksrc+(long)(t)*KVBLK*DM,(unsigned)__builtin_amdgcn_readfirstlane(kdst+(slot)))
  #define DMA_V(t,slot) glds16(vsrc+(long)(t)*KVBLK*DM,(unsigned)__builtin_amdgcn_readfirstlane(vdst+(slot)))
  const int vb0=(int)(lds0+LDS_V)+((lane>>4)&1)*32+(lane&3)*8+(4*hi+((lane&15)>>2))*64;
  const char*Kbase=shm+LDS_K; bf16x8 kf[8];
  const lds_cptr kp0=shm3+LDS_K+hi*1024+r32*16; const lds_cptr vp0=shm3+LDS_V+((lane>>4)&1)*32+(lane&3)*8+(4*hi+((lane&15)>>2))*64;
  const int NT=(q0+QB)/KVBLK-jstart;
  DMA_K(0,0);DMA_V(0,0);DMA_K(1,SLOTB);
  typedef __attribute__((address_space(3))) u32x4* lds_rptr; const lds_rptr brec=(lds_rptr)(shm3+LDS_BYTES);
  { const float cref=C2h[q0]; const float*cs=C2h+(long)jstart*KVBLK;
    int tid_e=tid; asm volatile("":"+v"(tid_e));
    for(int i_=tid_e;i_<NT*KVBLK;i_+=NW*64){ const float x_=cref-cs[i_]; const unsigned a1_=f2bf(x_); const float r1_=x_-__uint_as_float(a1_<<16); const unsigned a2_=f2bf(r1_); const float r2_=r1_-__uint_as_float(a2_<<16); const unsigned a3_=f2bf(r2_);
      brec[i_]=(u32x4){a1_|(a2_<<16),a3_,0u,0u}; }
    if(tid==0)brec[NT*KVBLK]=(u32x4){0x3F803F80u,0x00003F80u,0u,0u}; }
  const lds_cptr abp=(lds_cptr)brec+(hi?NT*KVBLK*16:r32*16); const int ast=hi?0:KVBLK*16, ab1=hi?0:32*16;
  #define ABF(t,half) (*(const __attribute__((address_space(3))) bf16x8*)(abp+(t)*ast+(half)*ab1))
  const lds_cptr qst=shm3+LDS_OST+wid*4096+lane*16;
  #pragma unroll
  for(int d0=0;d0<4;++d0){ const u32x4 qv_=*reinterpret_cast<const u32x4*>(&Qw[(long)r32*DM+d0*16+hi*8]); *(__attribute__((address_space(3))) u32x4*)(const_cast<__attribute__((address_space(3))) char*>(qst)+d0*1024)=qv_; }
  #define QF(i) (*(const __attribute__((address_space(3))) bf16x8*)(qst+(i)*1024))
  float mhat=0.f,l_reg=0.f;f32x16 o[2];o[0]=f32x16{};o[1]=f32x16{};
  u32x4 bmw=hi?(u32x4){0u,0u,0u,0u}:(u32x4){0x3F803F80u,0x00003F80u,0u,0u};
  #define SETBM() do{ const float nm_=-mhat; const unsigned a1_=f2bf(nm_); const float r1_=nm_-__uint_as_float(a1_<<16); const unsigned a2_=f2bf(r1_); const float r2_=r1_-__uint_as_float(a2_<<16); const unsigned a3_=f2bf(r2_); if(hi){bmw[0]=a1_|(a2_<<16);bmw[1]=a3_;} }while(0)
  #define BMF() __builtin_bit_cast(bf16x8,bmw)
  const f32x16 zero16=f32x16{};
  const int qrel=wid*QBLK+r32;
  #define CMASK(P0,P1,t) do{int jb_=(t)-(NT-4); if(jb_>=0)cmask(P0,P1,jb_,qrel,hi);}while(0)
  bool resc=false;
  #define START(P0,P1) do{ const float rm=rowmax(P0,P1); resc=false; \
    { const float dl=rm; mhat=fadd_s(mhat,dl); \
      _Pragma("unroll") for(int r=0;r<16;++r){P0[r]=fsub_s(P0[r],dl);P1[r]=fsub_s(P1[r],dl);} \
      SETBM(); } \
    _Pragma("unroll") for(int r=0;r<16;++r)P0[r]=__builtin_amdgcn_exp2f(P0[r]); }while(0)
  #define RESC() do{ if(resc){ asm volatile("s_waitcnt lgkmcnt(0)":::"memory"); \
      _Pragma("unroll") for(int d_=0;d_<2;++d_) _Pragma("unroll") for(int r=0;r<16;++r)o[d_][r]*=wsf[crow(r,hi)]; } }while(0)
  f32x16 pA0,pA1,pB0,pB1;
  int sl_prev=0,sl_cur=0,sl_next=SLOTB;
  #define ROT() do{sl_prev=sl_cur;sl_cur=sl_next;sl_next=(sl_next==(NSLOT-1)*SLOTB)?0:sl_next+SLOTB;}while(0)
  DMA_K(2,2*SLOTB);
  WAIT_BAR(3);
  { const f32x16 c0_=__builtin_amdgcn_mfma_f32_32x32x16_bf16(ABF(0,0),BMF(),zero16,0,0,0), c1_=__builtin_amdgcn_mfma_f32_32x32x16_bf16(ABF(0,1),BMF(),zero16,0,0,0); qkt(pA0,pA1,Kbase,qst,c0_,c1_,r32,hi); }
  asm volatile("s_nop 15\n\ts_nop 7":"+v"(pA0),"+v"(pA1));CMASK(pA0,pA1,0);
  START(pA0,pA1);
  _Pragma("unroll") for(int r=0;r<16;++r)pA1[r]=__builtin_amdgcn_exp2f(pA1[r]);
  WAIT_BAR(0);
  DMA_K(3,0);DMA_V(1,SLOTB);
  ROT();
  kload8(kf,kp0+sl_cur);
  WAIT_BAR(2);
  s16x4 vlo[8],vhi[8]; u32x4 pw0,pw1,pw2,pw3;
  #define PKW(P,B) cvtpk_s(P[B],P[B+1])
  #define PAF(k) __builtin_bit_cast(bf16x8,pw##k)
  #define VFR(i) (bf16x8){vlo[i][0],vlo[i][1],vlo[i][2],vlo[i][3],vhi[i][0],vhi[i][1],vhi[i][2],vhi[i][3]}
  #define PIN(x) asm volatile("":"+v"(x))
  #define MX3(a,b,c) __builtin_fmaxf(__builtin_fmaxf((a),(b)),(c))
  #define GAPA(MF,A0,A1,A2,A3,W0,W1,PW) do{ MF; sacc+=A0; sacc+=A1; sacc+=A2; sacc+=A3; PIN(sacc); W0; W1; PIN(PW); SBAR(); }while(0)
  #define EX(v) __builtin_amdgcn_exp2f(v)
  #define GAPB(MF,X,B) do{ MF; X[B]=EX(X[B]); X[B+1]=EX(X[B+1]); X[B+2]=EX(X[B+2]); X[B+3]=EX(X[B+3]); PIN(X); SBAR(); }while(0)
  #define VRD(i) do{ vlo[i]=vtr(vp_+(((i)>>2)*4096+((i)&3)*1024)); vhi[i]=vtr(vp_+(((i)>>2)*4096+((i)&3)*1024+512)); }while(0)
  #define KRD(G,j) do{ if(G){ kload2(kf,kp0+sl_next,j); SBAR(); } }while(0)
  #define STEP(C0,C1,P0,P1,t,GK,GV,GL) do{ SBAR(); \
    const lds_cptr vp_=vp0+sl_prev; \
    VRD(0); SBAR(); float sacc=(P0[0]+P0[1]); \
    bf16x8 qa_=QF(0); C0=__builtin_amdgcn_mfma_f32_32x32x16_bf16(ABF(t,0),BMF(),zero16,0,0,0); C1=__builtin_amdgcn_mfma_f32_32x32x16_bf16(ABF(t,1),BMF(),zero16,0,0,0); SBAR(); \
    bf16x8 qb_=QF(1); \
    GAPA(C0=__builtin_amdgcn_mfma_f32_32x32x16_bf16(kf[0],qa_,C0,0,0,0), P0[2],P0[3],P0[4],P0[5],     pw0[0]=PKW(P0,0), pw0[1]=PKW(P0,2), pw0); \
    VRD(4); SBAR(); GAPA(C1=__builtin_amdgcn_mfma_f32_32x32x16_bf16(kf[1],qa_,C1,0,0,0), P0[6],P0[7],P0[8],P0[9],     pw0[2]=PKW(P0,4), pw0[3]=PKW(P0,6), pw0); \
    VRD(1); qa_=QF(2); SBAR(); GAPA(C0=__builtin_amdgcn_mfma_f32_32x32x16_bf16(kf[2],qb_,C0,0,0,0),   P0[10],P0[11],P0[12],P0[13], pw1[0]=PKW(P0,8), pw1[1]=PKW(P0,10), pw1); \
    VRD(5); SBAR(); GAPA(C1=__builtin_amdgcn_mfma_f32_32x32x16_bf16(kf[3],qb_,C1,0,0,0),   P0[14],P0[15],P1[0],P1[1],   pw1[2]=PKW(P0,12),pw1[3]=PKW(P0,14), pw1); \
    VRD(2); qb_=QF(3); SBAR(); GAPA(C0=__builtin_amdgcn_mfma_f32_32x32x16_bf16(kf[4],qa_,C0,0,0,0),   P1[2],P1[3],P1[4],P1[5],     pw2[0]=PKW(P1,0), pw2[1]=PKW(P1,2), pw2); \
    VRD(6); SBAR(); GAPA(C1=__builtin_amdgcn_mfma_f32_32x32x16_bf16(kf[5],qa_,C1,0,0,0),   P1[6],P1[7],P1[8],P1[9],     pw2[2]=PKW(P1,4), pw2[3]=PKW(P1,6), pw2); \
    VRD(3); SBAR(); GAPA(C0=__builtin_amdgcn_mfma_f32_32x32x16_bf16(kf[6],qb_,C0,0,0,0),   P1[10],P1[11],P1[12],P1[13], pw3[0]=PKW(P1,8), pw3[1]=PKW(P1,10), pw3); \
    VRD(7); SBAR(); GAPA(C1=__builtin_amdgcn_mfma_f32_32x32x16_bf16(kf[7],qb_,C1,0,0,0),   P1[14],P1[15],0.f,0.f,       pw3[2]=PKW(P1,12),pw3[3]=PKW(P1,14), pw3); \
    l_reg+=sacc; \
    if(GK){DMA_K((t)+3,sl_cur);} if(GV){DMA_V((t)+1,sl_next);} \
    CMASK(C0,C1,t); \
    { float a=MX3(C0[0],C0[1],C1[0]),b=MX3(C0[2],C0[3],C1[1]); a=MX3(a,C1[2],C1[3]); \
      _Pragma("unroll") for(int r=4;r<16;r+=4){a=MX3(a,C0[r],C0[r+1]);b=MX3(b,C0[r+2],C0[r+3]);a=MX3(a,C1[r],C1[r+1]);b=MX3(b,C1[r+2],C1[r+3]);} \
      float rm=__builtin_fmaxf(a,b); { auto rr=__builtin_amdgcn_permlane32_swap(__float_as_uint(rm),__float_as_uint(rm),false,false); rm=__builtin_fmaxf(__uint_as_float(rr[0]),__uint_as_float(rr[1])); } \
      resc=false; \
      if(__builtin_expect(__any(rm>(float)THRL),0)){ const float dl=__builtin_fmaxf(rm,0.f); mhat+=dl; \
        _Pragma("unroll") for(int r=0;r<16;++r){C0[r]-=dl;C1[r]-=dl;} \
        SETBM(); \
        const float f=__builtin_amdgcn_exp2f(-dl); l_reg*=f; if(hi==0)wsf[r32]=f; resc=true; } } \
    SBAR(); \
    GAPB(o[0]=__builtin_amdgcn_mfma_f32_32x32x16_bf16(PAF(0),VFR(0),o[0],0,0,0), C0,0); \
    GAPB(o[1]=__builtin_amdgcn_mfma_f32_32x32x16_bf16(PAF(0),VFR(4),o[1],0,0,0), C0,4); \
    KRD(GL,0); GAPB(o[0]=__builtin_amdgcn_mfma_f32_32x32x16_bf16(PAF(1),VFR(1),o[0],0,0,0), C0,8); \
    KRD(GL,1); GAPB(o[1]=__builtin_amdgcn_mfma_f32_32x32x16_bf16(PAF(1),VFR(5),o[1],0,0,0), C0,12); \
    KRD(GL,2); GAPB(o[0]=__builtin_amdgcn_mfma_f32_32x32x16_bf16(PAF(2),VFR(2),o[0],0,0,0), C1,0); \
    KRD(GL,3); GAPB(o[1]=__builtin_amdgcn_mfma_f32_32x32x16_bf16(PAF(2),VFR(6),o[1],0,0,0), C1,4); \
    GAPB(o[0]=__builtin_amdgcn_mfma_f32_32x32x16_bf16(PAF(3),VFR(3),o[0],0,0,0), C1,8); \
    GAPB(o[1]=__builtin_amdgcn_mfma_f32_32x32x16_bf16(PAF(3),VFR(7),o[1],0,0,0), C1,12); \
    }while(0)
  int t=1;
  #undef CMASK
  #define CMASK(P0,P1,t) do{}while(0)
  for(;t+5<NT;t+=2){
    STEP(pB0,pB1,pA0,pA1,t,true,true,true);     WAIT_BAR(2); RESC(); ROT();
    STEP(pA0,pA1,pB0,pB1,t+1,true,true,true);   WAIT_BAR(2); RESC(); ROT();
  }
  #undef CMASK
  #define CMASK(P0,P1,t) do{int jb_=(t)-(NT-4); if(jb_>=0)cmask(P0,P1,jb_,qrel,hi);}while(0)
  #define ENDW(tt) do{ if((tt)+3<NT){WAIT_BAR(2);} else if((tt)+2<NT){WAIT_BAR(1);} else {WAIT_BAR(0);} }while(0)
  for(;t+1<NT;t+=2){
    STEP(pB0,pB1,pA0,pA1,t,(t+3<NT),(t+1<NT),(t+1<NT));       ENDW(t);   RESC(); ROT();
    STEP(pA0,pA1,pB0,pB1,t+1,(t+4<NT),(t+2<NT),(t+2<NT));     ENDW(t+1); RESC(); ROT();
  }
  STEP(pB0,pB1,pA0,pA1,NT-1,false,false,false); RESC();
  { float sacc=pB0[0]+pB0[1]; _Pragma("unroll") for(int r=2;r<16;++r)sacc+=pB0[r]; _Pragma("unroll") for(int r=0;r<16;++r)sacc+=pB1[r]; l_reg+=sacc;
    pw0=(u32x4){PKW(pB0,0),PKW(pB0,2),PKW(pB0,4),PKW(pB0,6)};pw1=(u32x4){PKW(pB0,8),PKW(pB0,10),PKW(pB0,12),PKW(pB0,14)};pw2=(u32x4){PKW(pB1,0),PKW(pB1,2),PKW(pB1,4),PKW(pB1,6)};pw3=(u32x4){PKW(pB1,8),PKW(pB1,10),PKW(pB1,12),PKW(pB1,14)};
    SBAR(); pv(o,vb0+sl_cur,PAF(0),PAF(1),PAF(2),PAF(3)); }
  #undef PKW
  #undef PAF
  #undef VFR
  #undef PIN
  #undef MX3
  #undef GAPA
  #undef GAPB
  #undef EX
  #undef VRD
  #undef KRD
  #undef STEP
  #undef ENDW
  {auto rr=__builtin_amdgcn_permlane32_swap(__float_as_uint(l_reg),__float_as_uint(l_reg),false,false);l_reg=__uint_as_float(rr[0])+__uint_as_float(rr[1]);}
  int lane_e=lane; asm volatile("":"+v"(lane_e));
  const int r32e=lane_e&31,hie=lane_e>>5;
  if(hie==0)wsf[32+r32e]=l_reg;asm volatile("s_waitcnt lgkmcnt(0)":::"memory");
  float rli[16];
  #pragma unroll
  for(int r=0;r<16;++r)rli[r]=__builtin_amdgcn_rcpf(wsf[32+crow(r,hie)]);
  bf16*Ow=O+(rowbase+q0+wid*QBLK)*OM+h*D; const bf16*OGw=OG+(rowbase+q0+wid*QBLK)*DM+h*D;
  { bf16*stg=(bf16*)(shm+LDS_OST)+wid*2048;
    #pragma unroll
    for(int r=0;r<16;++r){const int orow=crow(r,hie);
      #pragma unroll
      for(int d0=0;d0<2;++d0)stg[orow*64+d0*32+r32e]=(bf16)f2bf(o[d0][r]*rli[r]);}
    asm volatile("s_waitcnt lgkmcnt(0)":::"memory");
    #pragma unroll
    for(int i=0;i<4;++i){const int row=i*8+(lane_e>>3),ch=lane_e&7; const u32x4 v=*(const u32x4*)(stg+row*64+ch*8); const u32x4 g=*(const u32x4*)(OGw+(long)row*DM+ch*8); u32x4 w;
      #pragma unroll
      for(int e=0;e<4;++e){ const float lo=bflo(v[e])*sigmoidf_(bflo(g[e])), hh_=bfhi(v[e])*sigmoidf_(bfhi(g[e])); w[e]=pk2(lo,hh_); }
      ATTN_STORE16(Ow+(long)row*OM+ch*8,w);} }
  asm volatile("s_waitcnt lgkmcnt(0)\n\ts_barrier":::"memory");
  #undef QF
  #undef ABF
  #undef SETBM
  #undef BMF
  #undef DMA_K
  #undef DMA_V
  #undef CMASK
  #undef START
  #undef RESC
  #undef ROT
}
constexpr int ATTN_LDS_BYTES=LDS_BYTES;
#undef SBAR
#undef WAIT_BAR
}

constexpr int KP = 144;
__device__ __forceinline__ void p14_attention(Frame& F, const Args& a, int qword = CW_ATTQ) {
    const int tid0 = F.tid, lane0 = F.lane;
    const bf16* QKVG = (const bf16*)(F.ws + WS_QKVG); const float* C2 = (const float*)(F.ws + WS_C2); const float* CB = (const float*)(F.ws + WS_CB);
    bf16* Z2 = (bf16*)(F.ws + WS_Z2);
    LAS unsigned char* Ks = F.lds; LAS unsigned char* Vs = F.lds + 64 * KP; LAS float* bias = (LAS float*)(F.lds + 2 * 64 * KP); LAS int* uslot = (LAS int*)(F.lds + RING_BYTES + 192);
    constexpr int ATT_MAXT = (RING_BYTES - attn_body::ATTN_LDS_BYTES - 16) / 1024;
    float mq = 0.f, mk = 0.f;
    for (int i = 0; i < 64; ++i) { mq = fmaxf(mq, fabsf(a.in[21][i])); mk = fmaxf(mk, fabsf(a.in[22][i])); }
    const float THR2 = (2.f * 8.f * mq * mk * 1.01f + 30.f) * LOG2E;
    gu32* qctr = F.ctl + qword;
    LAS int* horder = (LAS int*)(F.lds + RING_BYTES + 256);
    __syncthreads();
    if (tid0 < NH) { const float mine = C2[(size_t)tid0 * T + T - 1]; int rank = 0;
        for (int o = 0; o < NH; ++o) { const float other = C2[(size_t)o * T + T - 1]; rank += (other > mine || (other == mine && o < tid0)) ? 1 : 0; }
        horder[rank] = tid0; }
    __syncthreads();
    for (;;) {
        __syncthreads();
        if (tid0 == 0) uslot[0] = (int)__hip_atomic_fetch_add(qctr, 1u, RLX_AGENT);
        __syncthreads();
        const int unit = uslot[0];
        if (unit >= NH * (T / 256)) break;
        const int h = horder[unit >> 6], qb = (T / 256 - 1) - (unit & 63), q0 = qb * 256;
        const float ct0 = C2[(size_t)h * T + q0];
        int jstart = 0;
        { int tot = 0; for (int j0 = 0; j0 < 4 * qb; j0 += 64) { const int j = j0 + lane0; const bool skip = (j < 4 * qb) && ((ct0 - CB[h * 256 + j]) < -THR2); tot += __popcll(__ballot(skip)); } jstart = tot; }
        jstart &= ~1;
        if (4 * qb + 4 - jstart <= ATT_MAXT) {
            attn_body::attn_unit<8>(h, qb, jstart, QKVG, QKVG + D, QKVG + 2 * D, QKVG + 3 * D, Z2, C2 + (size_t)h * T, (char*)F.lds);
            continue;
        }
        int tid_s = F.tid; asm volatile("" : "+v"(tid_s));
        const int tid = tid_s, lane = tid & 63, wid = F.wave, r32 = lane & 31, hi = lane >> 5;
        const int jend = 4 * qb + 3;
        const int qrow = q0 + wid * 32 + r32;
        bf16x8 qr[4];
#pragma unroll
        for (int d0 = 0; d0 < 4; ++d0) qr[d0] = *(const bf16x8*)(QKVG + (size_t)qrow * 4096 + h * 64 + d0 * 16 + hi * 8);
        f32x16 o0 = {}, o1 = {}; float m = -INFINITY, l = 0.f;
        const int lrow = tid >> 3, lch = tid & 7;
        u32x4 kreg, vreg; float breg = 0.f;
        auto gload = [&](int j) { const size_t row = (size_t)(64 * j + lrow) * 4096 + h * 64 + lch * 8;
            kreg = *(const u32x4*)(QKVG + row + D); vreg = *(const u32x4*)(QKVG + row + 2 * D); if (tid < 64) breg = -C2[(size_t)h * T + 64 * j + tid]; };
        gload(jstart);
        for (int j = jstart; j <= jend; ++j) {
            __syncthreads();
            *(LAS u32x4*)(Ks + lrow * KP + lch * 16) = kreg;
            { const int s_ = lrow >> 4, x_ = lrow & 15, p_ = s_ * 16 + ((x_ >> 2) & 1) * 8 + (((x_ >> 3) << 2) | (x_ & 3));
                const unsigned w_[4] = {vreg.x, vreg.y, vreg.z, vreg.w};
#pragma unroll
                for (int e = 0; e < 8; ++e) *(LAS unsigned short*)(Vs + (lch * 8 + e) * KP + p_ * 2) = (unsigned short)(w_[e >> 1] >> ((e & 1) * 16)); }
            if (tid < 64) bias[tid] = breg;
            __syncthreads();
            if (j < jend) gload(j + 1);
            f32x16 p0 = {}, p1 = {};
#pragma unroll
            for (int d0 = 0; d0 < 4; ++d0) {
                const bf16x8 k0 = *(const LAS bf16x8*)(Ks + r32 * KP + d0 * 32 + hi * 16);
                const bf16x8 k1 = *(const LAS bf16x8*)(Ks + (32 + r32) * KP + d0 * 32 + hi * 16);
                p0 = __builtin_amdgcn_mfma_f32_32x32x16_bf16(k0, qr[d0], p0, 0, 0, 0);
                p1 = __builtin_amdgcn_mfma_f32_32x32x16_bf16(k1, qr[d0], p1, 0, 0, 0);
            }
#pragma unroll
            for (int g4 = 0; g4 < 4; ++g4) { const f32x4 b0 = *(const LAS f32x4*)(bias + 8 * g4 + 4 * hi), b1 = *(const LAS f32x4*)(bias + 32 + 8 * g4 + 4 * hi);
#pragma unroll
                for (int i = 0; i < 4; ++i) { p0[4 * g4 + i] += b0[i]; p1[4 * g4 + i] += b1[i]; } }
            if (j >= 4 * qb) {
                const int kb = 64 * j;
#pragma unroll
                for (int r = 0; r < 16; ++r) { const int kv = kb + crow(r, hi); if (kv > qrow) p0[r] = -INFINITY; if (kv + 32 > qrow) p1[r] = -INFINITY; }
            }
            float mloc = fmaxf(p0[0], p1[0]);
#pragma unroll
            for (int r = 1; r < 16; ++r) mloc = fmaxf(mloc, fmaxf(p0[r], p1[r]));
            mloc = fmaxf(mloc, __shfl_xor(mloc, 32));
            const float mnew = fmaxf(m, mloc);
            const float alpha = exp2f(m - mnew);
            float ls = 0.f;
#pragma unroll
            for (int r = 0; r < 16; ++r) { p0[r] = exp2f(p0[r] - mnew); p1[r] = exp2f(p1[r] - mnew); ls += p0[r] + p1[r]; }
            l = l * alpha + ls; m = mnew;
#pragma unroll
            for (int r = 0; r < 16; ++r) { o0[r] *= alpha; o1[r] *= alpha; }
#pragma unroll
            for (int s = 0; s < 4; ++s) {
                u32x4 pw;
                if (s == 0) pw = (u32x4){pk2(p0[0], p0[1]), pk2(p0[2], p0[3]), pk2(p0[4], p0[5]), pk2(p0[6], p0[7])};
                else if (s == 1) pw = (u32x4){pk2(p0[8], p0[9]), pk2(p0[10], p0[11]), pk2(p0[12], p0[13]), pk2(p0[14], p0[15])};
                else if (s == 2) pw = (u32x4){pk2(p1[0], p1[1]), pk2(p1[2], p1[3]), pk2(p1[4], p1[5]), pk2(p1[6], p1[7])};
                else pw = (u32x4){pk2(p1[8], p1[9]), pk2(p1[10], p1[11]), pk2(p1[12], p1[13]), pk2(p1[14], p1[15])};
                const bf16x8 pf = __builtin_bit_cast(bf16x8, pw);
                const bf16x8 v0 = *(const LAS bf16x8*)(Vs + r32 * KP + s * 32 + hi * 16);
                const bf16x8 v1 = *(const LAS bf16x8*)(Vs + (32 + r32) * KP + s * 32 + hi * 16);
                o0 = __builtin_amdgcn_mfma_f32_32x32x16_bf16(v0, pf, o0, 0, 0, 0);
                o1 = __builtin_amdgcn_mfma_f32_32x32x16_bf16(v1, pf, o1, 0, 0, 0);
            }
        }
        l += __shfl_xor(l, 32);
        const float rl = 1.f / l;
#pragma unroll
        for (int dt = 0; dt < 2; ++dt)
#pragma unroll
            for (int g4 = 0; g4 < 4; ++g4) { const int d = 32 * dt + 8 * g4 + 4 * hi; const size_t col = (size_t)h * 64 + d;
                const u32x2 ogw = *(const u32x2*)(QKVG + (size_t)qrow * 4096 + 3 * D + col);
                const float og[4] = {bflo(ogw.x), bfhi(ogw.x), bflo(ogw.y), bfhi(ogw.y)}; float ov[4];
#pragma unroll
                for (int i = 0; i < 4; ++i) ov[i] = (dt == 0 ? o0[4 * g4 + i] : o1[4 * g4 + i]) * rl * sigmoidf_(og[i]);
                u32x2 w; w.x = pk2(ov[0], ov[1]); w.y = pk2(ov[2], ov[3]);
                *(u32x2*)(Z2 + (size_t)qrow * D + col) = w; }
    }
}

struct TokInfo { int e0, e1, p0, p1; float g0, g1; int d0, d1; };
__device__ __forceinline__ void p16_router(Frame& F, const Args& a) {
    int tid_o = F.tid; asm volatile("" : "+v"(tid_o));
    const int tid = tid_o, lane = tid & 63; const float* Hs = (const float*)(F.ws + WS_H); bf16* U = (bf16*)(F.ws + WS_U4);
    TokInfo* TI = (TokInfo*)(F.ws + WS_TOK);
    LAS float* wr_ = (LAS float*)F.lds;
    LAS int* lcnt = (LAS int*)(F.lds + 32768);
    const Row gr = ld_row(a.in[1] + 3 * D, lane);
    __syncthreads();
    for (int i = tid; i < NE * D; i += NTHREADS) { const int e = i & 7, k = i >> 3; wr_[e * D + k] = a.in[26][(size_t)k * NE + e]; }
    for (int tb = F.vcu * 64; tb < T; tb += F.G * 64) {
        __syncthreads();
        if (tid < 16) lcnt[tid] = 0;
        __syncthreads();
        int e0s[8], e1s[8], p0s[8], p1s[8]; float g0s[8];
#pragma unroll
        for (int qq = 0; qq < 2; ++qq) {
            Row u[4];
#pragma unroll
            for (int r = 0; r < 4; ++r) { const int t = tb + F.wave * 8 + 4 * qq + r; u[r] = rmsnorm_row(ld_row(Hs + (size_t)t * D, lane), gr); st_row_bf16(U + (size_t)t * D, lane, u[r]); }
            float lg[4][NE];
#pragma unroll
            for (int e = 0; e < NE; ++e) { float s4[4] = {0.f, 0.f, 0.f, 0.f};
#pragma unroll
                for (int j = 0; j < 4; ++j) { const f32x4 w = *(const LAS f32x4*)(wr_ + e * D + 256 * j + 4 * lane);
#pragma unroll
                    for (int r = 0; r < 4; ++r) s4[r] += (u[r].v[j][0] * w[0] + u[r].v[j][1] * w[1]) + (u[r].v[j][2] * w[2] + u[r].v[j][3] * w[3]); }
#pragma unroll
                for (int r = 0; r < 4; ++r) lg[r][e] = wave_sum(s4[r]); }
#pragma unroll
            for (int r = 0; r < 4; ++r) { const int q = 4 * qq + r;
                int b0 = 0; float v0 = lg[r][0];
#pragma unroll
                for (int e = 1; e < NE; ++e) if (lg[r][e] > v0) { v0 = lg[r][e]; b0 = e; }
                int b1 = -1; float v1 = -INFINITY;
#pragma unroll
                for (int e = 0; e < NE; ++e) if (e != b0 && lg[r][e] > v1) { v1 = lg[r][e]; b1 = e; }
                e0s[q] = b0; e1s[q] = b1; g0s[q] = 1.f / (1.f + __expf(v1 - v0));
                int pa = 0, pb = 0;
                if (lane == 0) { pa = atomicAdd((int*)&lcnt[b0], 1); pb = atomicAdd((int*)&lcnt[b1], 1); }
                p0s[q] = pa; p1s[q] = pb; }
        }
        __syncthreads();
        if (tid < NE) lcnt[8 + tid] = (int)__hip_atomic_fetch_add(F.ctl + CW_CNT + 64 * tid, (unsigned)lcnt[tid], RLX_AGENT);
        __syncthreads();
        if (lane == 0) {
#pragma unroll
            for (int q = 0; q < 8; ++q) { const int t = tb + F.wave * 8 + q; TokInfo ti; ti.e0 = e0s[q]; ti.e1 = e1s[q]; ti.p0 = lcnt[8 + e0s[q]] + p0s[q]; ti.p1 = lcnt[8 + e1s[q]] + p1s[q];
                ti.g0 = g0s[q]; ti.g1 = 1.f - g0s[q]; ti.d0 = 0; ti.d1 = 0; TI[t] = ti; }
        }
    }
    __syncthreads();
}
__device__ __forceinline__ int moe_ends(Frame& F, LAS int* ends) {
    __syncthreads();
    if (F.tid == 0) { int run = 0; for (int e = 0; e < NE; ++e) { const int c = (int)__hip_atomic_load(F.ctl + CW_CNT + 64 * e, RLX_AGENT); run += (c + 255) >> 8; ends[e] = run; } }
    __syncthreads();
    return ends[NE - 1];
}
__device__ __forceinline__ void p17_gather(Frame& F) {
    LAS int* ends = (LAS int*)(F.lds + RING_BYTES);
    moe_ends(F, ends);
    const bf16* U = (const bf16*)(F.ws + WS_U4); bf16* AM = (bf16*)(F.ws + WS_AM); TokInfo* TI = (TokInfo*)(F.ws + WS_TOK);
    for (int t = F.gw; t < T; t += F.NGW) {
        const TokInfo ti = TI[t];
        const int d0 = (ti.e0 ? ends[ti.e0 - 1] : 0) * 256 + ti.p0, d1 = (ti.e1 ? ends[ti.e1 - 1] : 0) * 256 + ti.p1;
        const u32x4* src = (const u32x4*)(U + (size_t)t * D) + F.lane; const u32x4 x0 = src[0], x1 = src[64];
        u32x4* o0 = (u32x4*)(AM + (size_t)d0 * D) + F.lane; o0[0] = x0; o0[64] = x1;
        u32x4* o1 = (u32x4*)(AM + (size_t)d1 * D) + F.lane; o1[0] = x0; o1[64] = x1;
        if (F.lane == 0) { TI[t].d0 = d0; TI[t].d1 = d1; }
    }
}
__device__ __forceinline__ void p20_combine(Frame& F, const Args& a) {
    const int lane = F.lane; const float* Hs = (const float*)(F.ws + WS_H); const bf16* YS = (const bf16*)(F.ws + WS_YS); const bf16* YSK = (const bf16*)(F.ws + WS_YSK); const TokInfo* TI = (const TokInfo*)(F.ws + WS_TOK);
    const Row gr = ld_row(a.in[2], lane);
    for (int t = F.gw; t < T; t += F.NGW) {
        const TokInfo ti = TI[t];
        Row hrow = ld_row(Hs + (size_t)t * D, lane);
#pragma unroll
        for (int which = 0; which < 2; ++which) { const int d = which ? ti.d1 : ti.d0; const float gw = which ? ti.g1 : ti.g0;
            if (d < MOE_RB1 * 256) { const Row y = ld_row_bf16(YS + (size_t)d * D, lane);
#pragma unroll
                for (int j = 0; j < 4; ++j) hrow.v[j] = hrow.v[j] + gw * y.v[j]; }
            else {
#pragma unroll
                for (int ks = 0; ks < MOE_TKS; ++ks) { const Row y = ld_row_bf16(YSK + ((size_t)ks * MOE_TROWS + (size_t)(d - MOE_RB1 * 256)) * D, lane);
#pragma unroll
                    for (int j = 0; j < 4; ++j) hrow.v[j] = hrow.v[j] + gw * y.v[j]; } } }
        st_row(a.out + (size_t)t * D, lane, rmsnorm_row(hrow, gr));
    }
}

constexpr int N_PHASES = 21;
__global__ void __launch_bounds__(NTHREADS, 2) trunk_fwd(Args args) {
    extern __shared__ __attribute__((aligned(16))) unsigned char lds_raw[];
    Frame F;
    F.lds = (LAS unsigned char*)lds_raw; F.ws = args.ws; F.ctl = (gu32*)(args.ws + WS_CTL);
    F.tid = threadIdx.x; F.lane = F.tid & 63; F.wave = __builtin_amdgcn_readfirstlane(F.tid >> 6);
    F.G = gridDim.x; { const int bx = blockIdx.x; F.vcu = (F.G % 8 == 0) ? (bx % 8) * (F.G / 8) + bx / 8 : bx; }
    F.gw = F.vcu * NWAVES + F.wave; F.NGW = F.G * NWAVES;
    volatile LAS unsigned* MISC = (volatile LAS unsigned*)(F.lds + MISC_OFF);
    for (int u = F.tid; u < (LDS_BYTES - RING_BYTES) / 4; u += NTHREADS) ((LAS unsigned*)(F.lds + RING_BYTES))[u] = 0u;
    __syncthreads();
    const int lo = args.ph_lo, hi = args.ph_hi;
    const bool use_bar = (hi - lo) > 1;
    XcdBarrier bar; bar.bar = (unsigned*)(F.ctl + CW_BAR); bar.x = 0; bar.st = nullptr;
    if (use_bar) bar = xcd_barrier_post((unsigned*)(F.ctl + CW_BAR), MISC + 8);
#ifdef ONLY_PHASE
#define IN(k) ((k) == ONLY_PHASE && lo <= (k) && (k) < hi)
#else
#define IN(k) (lo <= (k) && (k) < hi)
#endif
#define SEAM(k) do { if (IN((k) + 1)) xcd_barrier(bar); } while (0)
    unsigned char* ws = args.ws;
    const int c = (int)blockIdx.x;
    LAS unsigned char* ring = F.lds;

    if (IN(0)) { p0_prologue(F, args); p1_shift(F, args); p0_moe_weights(F, args, F.vcu, F.G, 1); } SEAM(0);
    if (IN(1)) {
        { pg8::Gemm g{D, 2 * D, 2 * D}; pg8::SchedPlain S; S.o.init(T / 256, 1, F.G, c); S.A = (const char*)(ws + WS_UB); S.B = (const char*)(ws + WS_W_L1); S.astep = (size_t)256 * D * 2; S.bstep = (size_t)256 * 2 * D * 2;
          pg8::EpiL1 E{(bf16*)(ws + WS_L1)};
          pg8::gemm_phase<pg8::EpiL1, pg8::SchedPlain, true>(ring, g, S, E); }
        { pg8::Gemm g{D, D, D}; pg8::SchedRKV S; S.o.init(T / 256, 12, F.G, c, F.G == 256 ? 64 : 0, 1); S.A = (const char*)(ws + WS_XS); S.B = (const char*)(ws + WS_W_RKV); S.astep = (size_t)256 * D * 2; S.bstep = (size_t)256 * D * 2; S.azstride = (size_t)T * D * 2;
          pg8::EpiRKV E{(bf16*)(ws + WS_R), (size_t)(WS_K - WS_R) / 2};
          pg8::gemm_phase<pg8::EpiRKV, pg8::SchedRKV, true>(ring, g, S, E); }
        } SEAM(1);
    if (IN(2)) {
        pg8::Gemm g{256, 256, 256}; pg8::EpiL2 E{(float*)(ws + WS_LW), (bf16*)(ws + WS_AA), (bf16*)(ws + WS_G), args.in[5], args.in[8]};
        if (F.G == 256) {
            pg8::SchedL2F S; S.A = (const char*)(ws + WS_L1); S.B = (const char*)(ws + WS_W_L2); S.astep = (size_t)256 * 256 * 2; S.bstep = (size_t)256 * 256 * 2; S.v = F.vcu;
            pg8::gemm_phase<pg8::EpiL2, pg8::SchedL2F, true>(ring, g, S, E);
            p3_prep(F, args, ((4 * (F.vcu >> 2) + (F.wave >> 1)) << 3) | ((F.vcu & 3) << 1) | (F.wave & 1));
        } else {
            pg8::SchedPlain S; S.o.init(T / 256, 12, F.G, c); S.A = (const char*)(ws + WS_L1); S.B = (const char*)(ws + WS_W_L2); S.astep = (size_t)256 * 256 * 2; S.bstep = (size_t)256 * 256 * 2;
            pg8::gemm_phase<pg8::EpiL2, pg8::SchedPlain, true>(ring, g, S, E);
            xcd_barrier(bar); p3_prep(F, args);
        }
        } SEAM(2);
    if (IN(3)) { pa_chunk(F); } SEAM(3);
    if (IN(4)) { pb_chain(F);
        if (F.G == 256 && (F.vcu & 31) >= 8) p0_moe_weights(F, args, (F.vcu >> 5) * 24 + (F.vcu & 31) - 8, 192, 0);
        else if (F.G != 256) p0_moe_weights(F, args, F.vcu, F.G, 0); } SEAM(4);
    if (IN(5)) { pc_out(F, args); } SEAM(5);
    if (IN(6)) {
        pg8::Gemm g{D, D, D}; pg8::SchedPlain S; S.o.init(T / 256, 4, F.G, c); S.A = (const char*)(ws + WS_Z); S.B = (const char*)(ws + WS_W_O0); S.astep = (size_t)256 * D * 2; S.bstep = (size_t)256 * D * 2;
        pg8::EpiRes E{args.in[0], (float*)(ws + WS_H)};
        pg8::gemm_phase<pg8::EpiRes, pg8::SchedPlain, true>(ring, g, S, E);
        } SEAM(6);
    if (IN(7)) { p8_norm(F, args.in[1] + D, (bf16*)(ws + WS_U2)); } SEAM(7);
    if (IN(8)) {
        pg8::Gemm g{D, D, D}; pg8::SchedPlain S; S.o.init(T / 256, 2 * FF / 256, F.G, c); S.A = (const char*)(ws + WS_U2); S.B = (const char*)(ws + WS_W_GU); S.astep = (size_t)256 * D * 2; S.bstep = (size_t)256 * D * 2;
        pg8::EpiSwiGLU E{(bf16*)(ws + WS_ACT)};
        pg8::gemm_phase<pg8::EpiSwiGLU, pg8::SchedPlain, true>(ring, g, S, E);
        }
    SEAM(8);
    if (IN(9)) {
        pg8::Gemm g{FF, FF, FF}; pg8::SchedPlain S; S.o.init(T / 256, 4, F.G, c); S.A = (const char*)(ws + WS_ACT); S.B = (const char*)(ws + WS_W_DN); S.astep = (size_t)256 * FF * 2; S.bstep = (size_t)256 * FF * 2;
        pg8::EpiRes E{(const float*)(ws + WS_H), (float*)(ws + WS_H)};
        pg8::gemm_phase<pg8::EpiRes, pg8::SchedPlain, true>(ring, g, S, E);
        } SEAM(9);
    if (IN(10)) { p11_norm_forget(F, args); } SEAM(10);
    if (IN(11)) {
        pg8::Gemm g{D, D, D}; pg8::SchedPlain S; S.o.init(T / 256, 16, F.G, c); S.A = (const char*)(ws + WS_U3); S.B = (const char*)(ws + WS_W_IN); S.astep = (size_t)256 * D * 2; S.bstep = (size_t)256 * D * 2;
        p12_cumsum(F);
        pg8::EpiQKVG E{(bf16*)(ws + WS_QKVG), args.in[21], args.in[22]};
        pg8::gemm_phase<pg8::EpiQKVG, pg8::SchedPlain, true>(ring, g, S, E);
        } SEAM(11);
    if (IN(12)) { p14_attention(F, args, CW_ATTQ); } SEAM(12);
    if (IN(13)) {
        pg8::Gemm g{D, D, D}; pg8::SchedPlain S; S.o.init(T / 256, 4, F.G, c); S.A = (const char*)(ws + WS_Z2); S.B = (const char*)(ws + WS_W_FO); S.astep = (size_t)256 * D * 2; S.bstep = (size_t)256 * D * 2;
        pg8::EpiRes E{(const float*)(ws + WS_H), (float*)(ws + WS_H)};
        pg8::gemm_phase<pg8::EpiRes, pg8::SchedPlain, true>(ring, g, S, E);
        } SEAM(13);
    if (IN(14)) { p16_router(F, args); } SEAM(14);
    if (IN(15)) { p17_gather(F); } SEAM(15);
    if (IN(16)) {
        LAS int* ends = (LAS int*)(F.lds + RING_BYTES); const int nblk = moe_ends(F, ends);
        pg8::Gemm g{D, D, D}; pg8::SchedMoe S; S.o.init(nblk, 2 * FF / 256, F.G, c); S.A = (const char*)(ws + WS_AM); S.B = (const char*)(ws + WS_W_MGU); S.astep = (size_t)256 * D * 2; S.bstep = (size_t)256 * D * 2; S.bestride = (size_t)2 * FF * D * 2; S.ends = ends;
        pg8::EpiSwiGLU E{(bf16*)(ws + WS_ACT2)};
        pg8::gemm_phase<pg8::EpiSwiGLU, pg8::SchedMoe, true>(ring, g, S, E);
        } SEAM(16);
    if (IN(17)) {
        LAS int* ends = (LAS int*)(F.lds + RING_BYTES); const int nblk = moe_ends(F, ends);
        { pg8::Gemm g{FF, FF, FF}; pg8::SchedMoeK S; S.o.init(nblk < MOE_RB1 ? nblk : MOE_RB1, 4, F.G, c); S.A = (const char*)(ws + WS_ACT2); S.B = (const char*)(ws + WS_W_MDN); S.astep = (size_t)256 * FF * 2; S.bstep = (size_t)256 * FF * 2; S.bestride = (size_t)D * FF * 2;
          S.kbytes = 0; S.ends = ends; S.pm0 = 0;
          pg8::EpiBf16K E{(bf16*)(ws + WS_YS), 0};
          pg8::gemm_phase<pg8::EpiBf16K, pg8::SchedMoeK, true>(ring, g, S, E); }
        if (nblk > MOE_RB1) { pg8::Gemm g{FF, FF, FF / MOE_TKS}; pg8::SchedMoeK S; S.o.init(nblk - MOE_RB1, 4 * MOE_TKS, F.G, c); S.A = (const char*)(ws + WS_ACT2); S.B = (const char*)(ws + WS_W_MDN); S.astep = (size_t)256 * FF * 2; S.bstep = (size_t)256 * FF * 2; S.bestride = (size_t)D * FF * 2;
          S.kbytes = (size_t)(FF / MOE_TKS) * 2; S.ends = ends; S.pm0 = MOE_RB1;
          pg8::EpiBf16K E{(bf16*)(ws + WS_YSK), (size_t)MOE_TROWS * D};
          pg8::gemm_phase<pg8::EpiBf16K, pg8::SchedMoeK, true>(ring, g, S, E); }
        } SEAM(17);
    if (IN(18)) { p20_combine(F, args); }
#undef IN
#undef SEAM
}

extern "C" void kernel_launch(void* const* d_in, const int* in_sizes, int n_in, void* d_out, int out_size, void* d_ws, size_t ws_size, hipStream_t stream) {
    static int grid = 0;
    if (grid == 0) {
        if (n_in != 29 || out_size != T * D || ws_size < WS_END) { fprintf(stderr, "kernel_launch: unexpected problem (n_in %d out %d ws %zu)\n", n_in, out_size, ws_size); grid = -1; return; }
        int dev = 0, cus = 0;
        if (hipGetDevice(&dev) != hipSuccess || hipDeviceGetAttribute(&cus, hipDeviceAttributeMultiprocessorCount, dev) != hipSuccess) { grid = -1; return; }
        if (hipFuncSetAttribute((const void*)trunk_fwd, hipFuncAttributeMaxDynamicSharedMemorySize, LDS_BYTES) != hipSuccess) { fprintf(stderr, "kernel_launch: hipFuncSetAttribute failed\n"); grid = -1; return; }
        int per_cu = 0;
        if (hipOccupancyMaxActiveBlocksPerMultiprocessor(&per_cu, (const void*)trunk_fwd, NTHREADS, LDS_BYTES) != hipSuccess || per_cu < 1) fprintf(stderr, "kernel_launch: occupancy query says %d\n", per_cu);
        (void)hipGetLastError();
        grid = cus;
    }
    if (grid < 0) return;
    (void)hipMemsetAsync((char*)d_ws + WS_CTL, 0, CTL_ZERO_BYTES, stream);
    Args a{};
    for (int i = 0; i < 29; ++i) a.in[i] = (const float*)d_in[i];
    a.out = (float*)d_out; a.ws = (unsigned char*)d_ws;
    constexpr int NPH = 19;
    if (LAUNCH_MODE == 1) { a.ph_lo = 0; a.ph_hi = NPH; hipLaunchKernelGGL(trunk_fwd, dim3(grid), dim3(NTHREADS), LDS_BYTES, stream, a); }
    else for (int p = 0; p < NPH; ++p) { a.ph_lo = p; a.ph_hi = p + 1; hipLaunchKernelGGL(trunk_fwd, dim3(grid), dim3(NTHREADS), LDS_BYTES, stream, a); }
}
```

```cpp
#include <hip/hip_runtime.h>
#include <cstdio>
#include <cstdint>

#ifndef LAUNCH_MODE
#define LAUNCH_MODE 1
#endif

#define GAS __attribute__((address_space(1)))
#define LAS __attribute__((address_space(3)))
typedef unsigned short bf16;
typedef short bf16x8 __attribute__((ext_vector_type(8)));
typedef float f32x4 __attribute__((ext_vector_type(4)));
typedef float f32x2 __attribute__((ext_vector_type(2)));
typedef float f32x16 __attribute__((ext_vector_type(16)));
typedef unsigned u32x4 __attribute__((ext_vector_type(4)));
typedef unsigned u32x2 __attribute__((ext_vector_type(2)));
typedef GAS unsigned gu32;
#define RLX_AGENT __ATOMIC_RELAXED, __HIP_MEMORY_SCOPE_AGENT

constexpr int T = 16384, D = 1024, NH = 16, HD = 64, FF = 3584, NE = 8, WIN_LD = 4 * D + NH;
constexpr int NWAVES = 8, NTHREADS = 512;
constexpr float RMS_EPS = 1e-6f, GN_EPS = 64e-5f;
constexpr int MOE_ROWS = (2 * T / 256 + NE) * 256;
constexpr int MOE_RB1 = 128, MOE_TKS = 7, MOE_TROWS = (MOE_ROWS / 256 - MOE_RB1) * 256;
constexpr int MOE_KS = 1;
constexpr float LOG2E = 1.4426950408889634f;

constexpr size_t MiB = 1u << 20;
constexpr size_t WS_CTL = 0, CTL_ZERO_BYTES = 64 * 1024;
constexpr size_t WS_W_RKV = 2 * MiB, WS_W_L1 = 8 * MiB, WS_W_L2 = 9 * MiB, WS_W_O0 = 11 * MiB, WS_W_GU = 13 * MiB, WS_W_DN = 27 * MiB,
                 WS_W_IN = 34 * MiB, WS_W_FO = 42 * MiB, WS_W_MGU = 44 * MiB, WS_W_MDN = 156 * MiB;
constexpr size_t WS_H = 216 * MiB;
constexpr size_t WS_UB = 280 * MiB, WS_XS = 313 * MiB;
constexpr size_t WS_KK = 280 * MiB, WS_BB = 344 * MiB;
constexpr size_t WS_Z = 410 * MiB  , WS_U2 = 344 * MiB;
constexpr size_t WS_U3 = 280 * MiB, WS_Z2 = 312 * MiB, WS_U4 = 280 * MiB, WS_AM = 312 * MiB;
constexpr size_t WS_R = 410 * MiB, WS_K = 474 * MiB, WS_V = 538 * MiB;
constexpr size_t WS_ACT = 410 * MiB;
constexpr size_t WS_QKVG = 410 * MiB;
constexpr size_t WS_ACT2 = 410 * MiB;
constexpr size_t WS_LW = 602 * MiB, WS_AA = 666 * MiB, WS_G = 730 * MiB;
constexpr size_t WS_YT = 666 * MiB;
constexpr size_t WS_YS = 666 * MiB;
constexpr size_t WS_YSK = 736 * MiB;
constexpr size_t WS_L1 = 794 * MiB;
constexpr size_t WS_CS = 802 * MiB;
constexpr size_t WS_LF = 806 * MiB, WS_C2 = 807 * MiB, WS_CB = 808 * MiB, WS_TOK = 809 * MiB;
constexpr size_t WS_END = 810 * MiB;
constexpr size_t WS_AT = 280 * MiB, WS_RT = 312 * MiB, WS_BH = 344 * MiB, WS_KH = 376 * MiB;
constexpr size_t WS_V16 = 538 * MiB  , WS_GC = 248 * MiB;
constexpr size_t WS_QM = 410 * MiB, WS_PLR = 474 * MiB, WS_TM = 506 * MiB, WS_S0 = 570 * MiB;
constexpr size_t WS_Y = 602 * MiB;
constexpr int NCH = T / 64;
constexpr int CW_TMO = 0, CW_BAR = 4096, CW_CNT = 8192, CW_ATTQ = 9216;
static_assert((CW_ATTQ + 128) * 4 <= (int)CTL_ZERO_BYTES && CW_BAR + 3456 <= CW_CNT && CW_CNT + 64 * NE <= CW_ATTQ, "control words inside the per-call memset");

constexpr int RING_BYTES = 131072, MISC_OFF = RING_BYTES + 320, LDS_BYTES = 147456;

__device__ __forceinline__ unsigned f2bf(float f) { unsigned u = __builtin_bit_cast(unsigned, f); return (u + 0x7fffu + ((u >> 16) & 1u)) >> 16; }
typedef __bf16 bf16x2_t __attribute__((ext_vector_type(2)));
__device__ __forceinline__ unsigned cvtpk(float lo, float hi) { f32x2 v = {lo, hi}; bf16x2_t b = __builtin_convertvector(v, bf16x2_t); return __builtin_bit_cast(unsigned, b); }
__device__ __forceinline__ unsigned pk2(float lo, float hi) { return cvtpk(lo, hi); }
__device__ __forceinline__ float bf2f(unsigned short b) { return __builtin_bit_cast(float, (unsigned)b << 16); }
__device__ __forceinline__ float bflo(unsigned w) { return __builtin_bit_cast(float, w << 16); }
__device__ __forceinline__ float bfhi(unsigned w) { return __builtin_bit_cast(float, w & 0xffff0000u); }
template <int CTRL> __device__ __forceinline__ float dpp_mov(float x) {
    return __builtin_bit_cast(float, __builtin_amdgcn_mov_dpp(__builtin_bit_cast(int, x), CTRL, 0xf, 0xf, true)); }
__device__ __forceinline__ float row16_sum(float v) {
    v += dpp_mov<0xB1>(v); v += dpp_mov<0x4E>(v); v += dpp_mov<0x124>(v); v += dpp_mov<0x128>(v); return v; }
__device__ __forceinline__ float wave_sum(float v) {
    v = row16_sum(v); v += __shfl_xor(v, 16); v += __shfl_xor(v, 32); return v; }
__device__ __forceinline__ float sigmoidf_(float x) { return __builtin_amdgcn_rcpf(1.f + __builtin_amdgcn_exp2f(x * -1.4426950408889634f)); }
__device__ __forceinline__ float tanhf_(float x) { const float e = __builtin_amdgcn_exp2f(fminf(x * 2.8853900817779268f, 60.f)); return (e - 1.f) * __builtin_amdgcn_rcpf(e + 1.f); }
#define LDS_WAIT() asm volatile("s_waitcnt lgkmcnt(0)" ::: "memory")
__device__ __forceinline__ int crow(int r, int hi) { return (r & 3) + 8 * (r >> 2) + 4 * hi; }

namespace pg8 {
constexpr int BM = 256, BK = 64, HALF = 128, HTB = HALF * BK * 2, STAGE_BYTES = 8 * HTB, NXCD = 8, WGM = 4;
__host__ __device__ __forceinline__ int lds_byte(int r, int c) { const int st = (r >> 4) * 2 + (c >> 5), rr = r & 15, cc = c & 31, ob = rr * 64 + cc * 2; return st * 1024 + (ob ^ (((ob >> 9) & 1) << 5)); }
__host__ __device__ __forceinline__ void stage_rc(int b, int& R, int& C) { const int st = b / 1024, sb = b % 1024, swz = sb ^ (((sb >> 9) & 1) << 5); R = (st >> 1) * 16 + swz / 64; C = (st & 1) * 32 + (swz % 64) / 2; }
__host__ __device__ __forceinline__ int perm32(int rho) { const int n = rho >> 4, i = rho & 15; return 8 * (i >> 2) + 4 * n + (i & 3); }

struct Unit { int pm, pn; };
struct Gemm { int lda, ldb, K; };

struct TileOrder {
    int nM, nN, nwg, G, c, nlo, klo;
    __device__ __forceinline__ void init(int nM_, int nN_, int G_, int c_, int nlo_ = 0, int klo_ = 0) { nM = nM_; nN = nN_; nwg = nM * nN; G = G_; c = c_; nlo = nlo_; klo = klo_; }
    __device__ __forceinline__ bool tile(int i, Unit& u) const {
        long L;
        if (c < nlo) { if (i >= klo) return false; L = (long)(nwg - nlo * klo) + c + (long)nlo * i; }
        else { L = (long)i * (G - nlo) + (c - nlo); if (L >= nwg - nlo * klo) return false; }
        int wgid = (int)L; { const int q = nwg / NXCD, r = nwg % NXCD, xcd = wgid % NXCD, off = wgid / NXCD; wgid = (xcd < r ? xcd * (q + 1) : r * (q + 1) + (xcd - r) * q) + off; }
        const int nig = WGM * nN, gid = wgid / nig, fm = gid * WGM, gsz = (nM - fm) < WGM ? (nM - fm) : WGM;
        u.pm = fm + ((wgid % nig) % gsz); u.pn = (wgid % nig) / gsz; return true;
    }
};

__device__ __forceinline__ unsigned cvt_pk_bf16(float lo, float hi) { unsigned r; asm volatile("v_cvt_pk_bf16_f32 %0, %1, %2" : "=v"(r) : "v"(lo), "v"(hi)); return r; }

template <class Epi, class Sched, bool ALIGN_EPI>
__device__ __forceinline__ void gemm_phase(LAS unsigned char* lds, const Gemm g, const Sched& S, const Epi& E) {
    const int tid = threadIdx.x, wid = __builtin_amdgcn_readfirstlane(tid >> 6), lane = tid & 63, wr = wid >> 2, wc = wid & 3, fr = lane & 15, fq = lane >> 4;
    const int K = g.K, nt = K / BK;
    unsigned voffA[2], voffB[2];
#pragma unroll
    for (int i = 0; i < 2; ++i) { int R, C; stage_rc(tid * 16 + i * 8192, R, C); const int Rb = Epi::PERM ? ((R & ~31) + perm32(R & 31)) : R;
        voffA[i] = (unsigned)(R * g.lda + C) * 2u; voffB[i] = (unsigned)(Rb * g.ldb + C) * 2u; }
    const size_t kstep = (size_t)(BK * 2);
    const size_t hstepA = (size_t)HALF * g.lda * 2, hstepB = (size_t)HALF * g.ldb * 2;
    const unsigned ldsw = (unsigned)wid * 1024u;
    const int aoff = lds_byte(wr * 64 + fr, fq * 8), boff = lds_byte(wc * 32 + fr, fq * 8);
#define PG8_SA(b, h) (((b) * 2 + (h)) * HTB)
#define PG8_SB(b, h) ((4 + (b) * 2 + (h)) * HTB)
#define PG8_STAGE(bufoff, gbase, voff) do { _Pragma("unroll") for (int _i = 0; _i < 2; ++_i) \
        __builtin_amdgcn_global_load_lds((const unsigned*)((const char*)(gbase) + (voff)[_i]), (LAS unsigned*)(lds + (bufoff) + ldsw + _i * 8192), 16, 0, 0); } while (0)
#define PG8_LDA(dst, b, h) do { _Pragma("unroll") for (int m = 0; m < 4; ++m) _Pragma("unroll") for (int k = 0; k < 2; ++k) dst[m][k] = *(const LAS bf16x8*)(lds + PG8_SA(b, h) + aoff + m * 2048 + k * 1024); } while (0)
#define PG8_LDB(dst, b, h) do { _Pragma("unroll") for (int n = 0; n < 2; ++n) _Pragma("unroll") for (int k = 0; k < 2; ++k) dst[n][k] = *(const LAS bf16x8*)(lds + PG8_SB(b, h) + boff + n * 2048 + k * 1024); } while (0)
#define PG8_MMA(ai, bj, At, Bt) do { __builtin_amdgcn_s_setprio(1); _Pragma("unroll") for (int m = 0; m < 4; ++m) _Pragma("unroll") for (int n = 0; n < 2; ++n) _Pragma("unroll") for (int k = 0; k < 2; ++k) \
        acc[ai][bj][m][n] = __builtin_amdgcn_mfma_f32_16x16x32_bf16(Bt[n][k], At[m][k], acc[ai][bj][m][n], 0, 0, 0); __builtin_amdgcn_s_setprio(0); } while (0)
#define PG8_WAIT_V(n) asm volatile("s_waitcnt vmcnt(" #n ")" ::: "memory")
#define PG8_WAIT_L(n) asm volatile("s_waitcnt lgkmcnt(" #n ")" ::: "memory")
#define PG8_BAR __builtin_amdgcn_s_barrier()
#define PG8_SCHED __builtin_amdgcn_sched_barrier(0)
    Unit cur, nxt; int ui = 0;
    if (!S.next(0, cur)) return;
    f32x4 acc[2][2][4][2];
#pragma unroll
    for (int a = 0; a < 2; ++a)
#pragma unroll
        for (int b = 0; b < 2; ++b)
#pragma unroll
            for (int m = 0; m < 4; ++m)
#pragma unroll
                for (int n = 0; n < 2; ++n) acc[a][b][m][n] = (f32x4){0.f, 0.f, 0.f, 0.f};
    bf16x8 At[4][2], B0[2][2], B1[2][2];
    const char* cA = S.pa(cur); const char* cB = S.pb(cur);
    PG8_STAGE(PG8_SB(0, 0), cB, voffB); PG8_STAGE(PG8_SB(0, 1), cB + hstepB, voffB); PG8_STAGE(PG8_SA(0, 0), cA, voffA); PG8_STAGE(PG8_SA(0, 1), cA + hstepA, voffA);
    if (wr == 1) PG8_BAR;
    PG8_WAIT_V(2); PG8_BAR;
    PG8_STAGE(PG8_SB(1, 0), cB + kstep, voffB); PG8_STAGE(PG8_SA(1, 0), cA + kstep, voffA); PG8_STAGE(PG8_SB(1, 1), cB + hstepB + kstep, voffB);
    PG8_WAIT_V(6); PG8_BAR;
    for (;;) {
        const bool has_next = S.next(ui + 1, nxt);
        const char* nA = has_next ? S.pa(nxt) : cA; const char* nB = has_next ? S.pb(nxt) : cB;
        asm volatile(".p2align 8" ::: "memory");
#pragma clang loop unroll(disable)
        for (int t = 0; t < nt; t += 2) {
            const bool last = (t == nt - 2);
            const char* a1 = cA + (size_t)(t + 1) * kstep;
            const char* a2 = last ? nA : cA + (size_t)(t + 2) * kstep; const char* b2 = last ? nB : cB + (size_t)(t + 2) * kstep;
            const char* a3 = a2 + kstep; const char* b3 = b2 + kstep;
            PG8_LDB(B0, 0, 0); PG8_LDB(B1, 0, 1); PG8_SCHED; PG8_LDA(At, 0, 0); PG8_STAGE(PG8_SA(1, 1), a1 + hstepA, voffA);
            PG8_WAIT_V(8); PG8_WAIT_L(0); PG8_BAR; PG8_MMA(0, 0, At, B0); PG8_MMA(0, 1, At, B1); PG8_BAR; PG8_SCHED;
            PG8_LDA(At, 0, 1); PG8_STAGE(PG8_SB(0, 0), b2, voffB); PG8_STAGE(PG8_SB(0, 1), b2 + hstepB, voffB); PG8_STAGE(PG8_SA(0, 0), a2, voffA);
            PG8_WAIT_V(8); PG8_WAIT_L(0); PG8_BAR; PG8_MMA(1, 0, At, B0); PG8_MMA(1, 1, At, B1); PG8_BAR; PG8_SCHED;
            PG8_LDB(B0, 1, 0); PG8_LDB(B1, 1, 1); PG8_SCHED; PG8_LDA(At, 1, 0); PG8_STAGE(PG8_SA(0, 1), a2 + hstepA, voffA);
            PG8_WAIT_V(8); PG8_WAIT_L(0); PG8_BAR; PG8_MMA(0, 0, At, B0); PG8_MMA(0, 1, At, B1); PG8_BAR; PG8_SCHED;
            PG8_LDA(At, 1, 1); PG8_STAGE(PG8_SB(1, 0), b3, voffB); PG8_STAGE(PG8_SB(1, 1), b3 + hstepB, voffB); PG8_STAGE(PG8_SA(1, 0), a3, voffA);
            PG8_WAIT_V(8); PG8_WAIT_L(0); PG8_BAR; PG8_MMA(1, 0, At, B0); PG8_MMA(1, 1, At, B1); PG8_BAR; PG8_SCHED;
        }
        if constexpr (ALIGN_EPI) { if (wr == 0) PG8_BAR; }
        E(acc, cur, wr, wc, fr, fq);
        if (!has_next) break;
#pragma unroll
        for (int a = 0; a < 2; ++a)
#pragma unroll
            for (int b = 0; b < 2; ++b)
#pragma unroll
                for (int m = 0; m < 4; ++m)
#pragma unroll
                    for (int n = 0; n < 2; ++n) acc[a][b][m][n] = (f32x4){0.f, 0.f, 0.f, 0.f};
        cur = nxt; cA = nA; cB = nB; ++ui;
        if constexpr (ALIGN_EPI) { if (wr == 1) PG8_BAR; }
    }
    PG8_WAIT_V(0);
    if constexpr (!ALIGN_EPI) { if (wr == 0) PG8_BAR; }
    PG8_BAR;
#undef PG8_SA
#undef PG8_SB
#undef PG8_STAGE
#undef PG8_LDA
#undef PG8_LDB
#undef PG8_MMA
#undef PG8_WAIT_V
#undef PG8_WAIT_L
#undef PG8_BAR
#undef PG8_SCHED
}

typedef const f32x4 (&AccRef)[2][2][4][2];

struct SchedPlain {
    TileOrder o; const char* A; const char* B; size_t astep, bstep;
    __device__ __forceinline__ bool next(int i, Unit& u) const { return o.tile(i, u); }
    __device__ __forceinline__ const char* pa(const Unit& u) const { return A + (size_t)u.pm * astep; }
    __device__ __forceinline__ const char* pb(const Unit& u) const { return B + (size_t)u.pn * bstep; }
};
struct SchedRKV {
    TileOrder o; const char* A; const char* B; size_t astep, bstep, azstride;
    __device__ __forceinline__ bool next(int i, Unit& u) const { return o.tile(i, u); }
    __device__ __forceinline__ const char* pa(const Unit& u) const { return A + (size_t)(u.pn >> 2) * azstride + (size_t)u.pm * astep; }
    __device__ __forceinline__ const char* pb(const Unit& u) const { return B + (size_t)u.pn * bstep; }
};
struct SchedMoe {
    TileOrder o; const char* A; const char* B; size_t astep, bstep, bestride; const LAS int* ends;
    __device__ __forceinline__ bool next(int i, Unit& u) const { return o.tile(i, u); }
    __device__ __forceinline__ int be(int pm) const { int e = 0;
#pragma unroll
        for (int j = 0; j < NE - 1; ++j) e += (pm >= ends[j]) ? 1 : 0; return e; }
    __device__ __forceinline__ const char* pa(const Unit& u) const { return A + (size_t)u.pm * astep; }
    __device__ __forceinline__ const char* pb(const Unit& u) const { return B + (size_t)be(u.pm) * bestride + (size_t)u.pn * bstep; }
};

struct SchedMoeK {
    TileOrder o; const char* A; const char* B; size_t astep, bstep, bestride, kbytes; const LAS int* ends; int pm0;
    __device__ __forceinline__ bool next(int i, Unit& u) const { return o.tile(i, u); }
    __device__ __forceinline__ int be(int pm) const { int e = 0;
#pragma unroll
        for (int j = 0; j < NE - 1; ++j) e += (pm >= ends[j]) ? 1 : 0; return e; }
    __device__ __forceinline__ const char* pa(const Unit& u) const { return A + (size_t)(pm0 + u.pm) * astep + (size_t)(u.pn >> 2) * kbytes; }
    __device__ __forceinline__ const char* pb(const Unit& u) const { return B + (size_t)be(pm0 + u.pm) * bestride + (size_t)(u.pn & 3) * bstep + (size_t)(u.pn >> 2) * kbytes; }
};

struct EpiRKV {
    static constexpr bool PERM = true;
    bf16* C; size_t zstride;
    __device__ __forceinline__ void operator()(AccRef acc, const Unit& u, int wr, int wc, int fr, int fq) const {
        const int z = u.pn >> 2, pn = u.pn & 3; bf16* base = C + (size_t)z * zstride;
        const int row0 = u.pm * BM + wr * 64 + fr, col0 = pn * BM + wc * 32 + 8 * fq;
#pragma unroll
        for (int ai = 0; ai < 2; ++ai)
#pragma unroll
            for (int m = 0; m < 4; ++m) { bf16* rowp = base + (size_t)(row0 + ai * HALF + m * 16) * D + col0;
#pragma unroll
                for (int bj = 0; bj < 2; ++bj) { const f32x4 v0 = acc[ai][bj][m][0], v1 = acc[ai][bj][m][1];
                    u32x4 w; w.x = cvt_pk_bf16(v0[0], v0[1]); w.y = cvt_pk_bf16(v0[2], v0[3]); w.z = cvt_pk_bf16(v1[0], v1[1]); w.w = cvt_pk_bf16(v1[2], v1[3]);
                    *(u32x4*)(rowp + bj * HALF) = w; } }
    }
};
struct EpiRes {
    static constexpr bool PERM = false;
    const float* base; float* out;
    __device__ __forceinline__ void operator()(AccRef acc, const Unit& u, int wr, int wc, int fr, int fq) const {
        const int row0 = u.pm * BM + wr * 64 + fr, col0 = u.pn * BM + wc * 32 + 4 * fq;
#pragma unroll
        for (int ai = 0; ai < 2; ++ai)
#pragma unroll
            for (int m = 0; m < 4; ++m) { const size_t off = (size_t)(row0 + ai * HALF + m * 16) * D + col0;
#pragma unroll
                for (int bj = 0; bj < 2; ++bj)
#pragma unroll
                    for (int n = 0; n < 2; ++n) { const f32x4 b = *(const f32x4*)(base + off + bj * HALF + n * 16); *(f32x4*)(out + off + bj * HALF + n * 16) = b + acc[ai][bj][m][n]; } }
    }
};
struct EpiL1 {
    static constexpr bool PERM = true;
    bf16* O;
    __device__ __forceinline__ void operator()(AccRef acc, const Unit& u, int wr, int wc, int fr, int fq) const {
        const int row0 = u.pm * BM + wr * 64 + fr, col0 = wc * 32 + 8 * fq;
#pragma unroll
        for (int ai = 0; ai < 2; ++ai)
#pragma unroll
            for (int m = 0; m < 4; ++m) { bf16* rowp = O + (size_t)(row0 + ai * HALF + m * 16) * 256 + col0;
#pragma unroll
                for (int bj = 0; bj < 2; ++bj) { float v[8];
#pragma unroll
                    for (int i = 0; i < 4; ++i) { v[i] = acc[ai][bj][m][0][i]; v[4 + i] = acc[ai][bj][m][1][i]; }
#pragma unroll
                    for (int i = 0; i < 8; ++i) { if (bj == 1) v[i] = sigmoidf_(v[i]); else if (wc < 2) v[i] = tanhf_(v[i]); }
                    u32x4 w; w.x = cvt_pk_bf16(v[0], v[1]); w.y = cvt_pk_bf16(v[2], v[3]); w.z = cvt_pk_bf16(v[4], v[5]); w.w = cvt_pk_bf16(v[6], v[7]);
                    *(u32x4*)(rowp + bj * HALF) = w; } }
    }
};
struct EpiL2 {
    static constexpr bool PERM = true;
    float* LW; bf16* AA; bf16* G; const float* w0; const float* a0;
    __device__ __forceinline__ void operator()(AccRef acc, const Unit& u, int wr, int wc, int fr, int fq) const {
        const int z = u.pn >> 2, pn = u.pn & 3;
        const int row0 = u.pm * BM + wr * 64 + fr, col0 = pn * BM + wc * 32 + 8 * fq;
        if (z == 0) {
#pragma unroll
            for (int bj = 0; bj < 2; ++bj) { const f32x4 b0 = *(const f32x4*)(w0 + col0 + bj * HALF), b1 = *(const f32x4*)(w0 + col0 + bj * HALF + 4);
#pragma unroll
                for (int ai = 0; ai < 2; ++ai)
#pragma unroll
                    for (int m = 0; m < 4; ++m) { f32x4 v0 = acc[ai][bj][m][0] + b0, v1 = acc[ai][bj][m][1] + b1;
#pragma unroll
                        for (int i = 0; i < 4; ++i) { v0[i] = -0.6065306597126334f * sigmoidf_(v0[i]); v1[i] = -0.6065306597126334f * sigmoidf_(v1[i]); }
                        float* p = LW + (size_t)(row0 + ai * HALF + m * 16) * D + col0 + bj * HALF; *(f32x4*)p = v0; *(f32x4*)(p + 4) = v1; } }
        } else {
            bf16* base = z == 1 ? AA : G;
#pragma unroll
            for (int bj = 0; bj < 2; ++bj) { f32x4 b0 = {0.f, 0.f, 0.f, 0.f}, b1 = b0; if (z == 1) { b0 = *(const f32x4*)(a0 + col0 + bj * HALF); b1 = *(const f32x4*)(a0 + col0 + bj * HALF + 4); }
#pragma unroll
                for (int ai = 0; ai < 2; ++ai)
#pragma unroll
                    for (int m = 0; m < 4; ++m) { f32x4 v0 = acc[ai][bj][m][0] + b0, v1 = acc[ai][bj][m][1] + b1;
                        if (z == 1) {
#pragma unroll
                            for (int i = 0; i < 4; ++i) { v0[i] = sigmoidf_(v0[i]); v1[i] = sigmoidf_(v1[i]); } }
                        u32x4 w; w.x = cvt_pk_bf16(v0[0], v0[1]); w.y = cvt_pk_bf16(v0[2], v0[3]); w.z = cvt_pk_bf16(v1[0], v1[1]); w.w = cvt_pk_bf16(v1[2], v1[3]);
                        *(u32x4*)(base + (size_t)(row0 + ai * HALF + m * 16) * D + col0 + bj * HALF) = w; } }
        }
    }
};
struct EpiSwiGLU {
    static constexpr bool PERM = true;
    bf16* O;
    __device__ __forceinline__ void operator()(AccRef acc, const Unit& u, int wr, int wc, int fr, int fq) const {
        const int row0 = u.pm * BM + wr * 64 + fr, col0 = u.pn * HALF + wc * 32 + 8 * fq;
#pragma unroll
        for (int ai = 0; ai < 2; ++ai)
#pragma unroll
            for (int m = 0; m < 4; ++m) { float v[8];
#pragma unroll
                for (int n = 0; n < 2; ++n)
#pragma unroll
                    for (int i = 0; i < 4; ++i) { const float gt = acc[ai][0][m][n][i], up = acc[ai][1][m][n][i];
                        v[4 * n + i] = gt * up * __builtin_amdgcn_rcpf(1.f + __builtin_amdgcn_exp2f(gt * -1.4426950408889634f)); }
                u32x4 w; w.x = cvt_pk_bf16(v[0], v[1]); w.y = cvt_pk_bf16(v[2], v[3]); w.z = cvt_pk_bf16(v[4], v[5]); w.w = cvt_pk_bf16(v[6], v[7]);
                *(u32x4*)(O + (size_t)(row0 + ai * HALF + m * 16) * FF + col0) = w; }
    }
};
struct EpiBf16K {
    static constexpr bool PERM = true;
    bf16* O; size_t slab;
    __device__ __forceinline__ void operator()(AccRef acc, const Unit& u, int wr, int wc, int fr, int fq) const {
        bf16* base = O + (size_t)(u.pn >> 2) * slab;
        const int row0 = u.pm * BM + wr * 64 + fr, col0 = (u.pn & 3) * BM + wc * 32 + 8 * fq;
#pragma unroll
        for (int ai = 0; ai < 2; ++ai)
#pragma unroll
            for (int m = 0; m < 4; ++m) { bf16* rowp = base + (size_t)(row0 + ai * HALF + m * 16) * D + col0;
#pragma unroll
                for (int bj = 0; bj < 2; ++bj) { const f32x4 v0 = acc[ai][bj][m][0], v1 = acc[ai][bj][m][1];
                    u32x4 w; w.x = cvt_pk_bf16(v0[0], v0[1]); w.y = cvt_pk_bf16(v0[2], v0[3]); w.z = cvt_pk_bf16(v1[0], v1[1]); w.w = cvt_pk_bf16(v1[2], v1[3]);
                    *(u32x4*)(rowp + bj * HALF) = w; } }
    }
};
struct EpiQKVG {
    static constexpr bool PERM = true;
    bf16* O; const float* gq; const float* gk;
    __device__ __forceinline__ void operator()(AccRef acc, const Unit& u, int wr, int wc, int fr, int fq) const {
        const int row0 = u.pm * BM + wr * 64 + fr;
        if (u.pn < 8) {
            const float* gp = u.pn < 4 ? gq : gk; const float sc = u.pn < 4 ? 0.125f * LOG2E : 1.f;
            f32x4 gn[2][2];
#pragma unroll
            for (int bj = 0; bj < 2; ++bj)
#pragma unroll
                for (int n = 0; n < 2; ++n) gn[bj][n] = *(const f32x4*)(gp + 32 * bj + 8 * fq + 4 * n) * sc;
            const int colb = 256 * u.pn + 64 * wc + 8 * fq;
#pragma unroll
            for (int ai = 0; ai < 2; ++ai)
#pragma unroll
                for (int m = 0; m < 4; ++m) { float ss = 0.f;
#pragma unroll
                    for (int bj = 0; bj < 2; ++bj)
#pragma unroll
                        for (int n = 0; n < 2; ++n) { const f32x4 v = acc[ai][bj][m][n]; ss += (v[0] * v[0] + v[1] * v[1]) + (v[2] * v[2] + v[3] * v[3]); }
                    ss += __shfl_xor(ss, 16); ss += __shfl_xor(ss, 32);
                    const float rs = rsqrtf(ss * (1.f / 64.f) + RMS_EPS);
                    bf16* rowp = O + (size_t)(row0 + ai * HALF + m * 16) * 4096 + colb;
#pragma unroll
                    for (int bj = 0; bj < 2; ++bj) { const f32x4 v0 = acc[ai][bj][m][0] * rs * gn[bj][0], v1 = acc[ai][bj][m][1] * rs * gn[bj][1];
                        u32x4 w; w.x = cvt_pk_bf16(v0[0], v0[1]); w.y = cvt_pk_bf16(v0[2], v0[3]); w.z = cvt_pk_bf16(v1[0], v1[1]); w.w = cvt_pk_bf16(v1[2], v1[3]);
                        *(u32x4*)(rowp + 32 * bj) = w; } }
        } else {
            const int col0 = u.pn * BM + wc * 32 + 8 * fq;
#pragma unroll
            for (int ai = 0; ai < 2; ++ai)
#pragma unroll
                for (int m = 0; m < 4; ++m) { bf16* rowp = O + (size_t)(row0 + ai * HALF + m * 16) * 4096 + col0;
#pragma unroll
                    for (int bj = 0; bj < 2; ++bj) { const f32x4 v0 = acc[ai][bj][m][0], v1 = acc[ai][bj][m][1];
                        u32x4 w; w.x = cvt_pk_bf16(v0[0], v0[1]); w.y = cvt_pk_bf16(v0[2], v0[3]); w.z = cvt_pk_bf16(v1[0], v1[1]); w.w = cvt_pk_bf16(v1[2], v1[3]);
                        *(u32x4*)(rowp + bj * HALF) = w; } }
        }
    }
};
struct EpiBf16 {
    static constexpr bool PERM = true;
    bf16* O; int ldc;
    __device__ __forceinline__ void operator()(AccRef acc, const Unit& u, int wr, int wc, int fr, int fq) const {
        const int row0 = u.pm * BM + wr * 64 + fr, col0 = u.pn * BM + wc * 32 + 8 * fq;
#pragma unroll
        for (int ai = 0; ai < 2; ++ai)
#pragma unroll
            for (int m = 0; m < 4; ++m) { bf16* rowp = O + (size_t)(row0 + ai * HALF + m * 16) * ldc + col0;
#pragma unroll
                for (int bj = 0; bj < 2; ++bj) { const f32x4 v0 = acc[ai][bj][m][0], v1 = acc[ai][bj][m][1];
                    u32x4 w; w.x = cvt_pk_bf16(v0[0], v0[1]); w.y = cvt_pk_bf16(v0[2], v0[3]); w.z = cvt_pk_bf16(v1[0], v1[1]); w.w = cvt_pk_bf16(v1[2], v1[3]);
                    *(u32x4*)(rowp + bj * HALF) = w; } }
    }
};
}

#define XB_TMO      128
#define XB_XCNT(j)  (256  + 64 * (j))
#define XB_XSUB(j)  (1280 + 64 * (j))
#define XB_XGEN(j)  (2304 + 64 * (j))
#define XB_TOP      3328
#define XB_TOPGEN   3392
#define XCD_BAR_WORDS 3456
#define XB_SPIN_CAP (1u << 18)
__device__ __forceinline__ unsigned xb_ld(unsigned* p)              { return __hip_atomic_load(p, __ATOMIC_RELAXED, __HIP_MEMORY_SCOPE_AGENT); }
__device__ __forceinline__ unsigned xb_add(unsigned* p, unsigned v) { return __hip_atomic_fetch_add(p, v, __ATOMIC_RELAXED, __HIP_MEMORY_SCOPE_AGENT); }
__device__ __forceinline__ unsigned xb_xcc_id() { return (unsigned)__builtin_amdgcn_s_getreg((3 << 11) | 20) & 0xFu; }
#define XB_SPIN(cond, bar) do { unsigned _sp = 0; while (cond) { __builtin_amdgcn_s_sleep(1); \
    if ((++_sp & 255u) == 0u) { if (xb_ld(&(bar)[XB_TMO])) break; if (_sp > XB_SPIN_CAP) { atomicAdd(&(bar)[XB_TMO], 1u); break; } } } } while (0)
struct XcdBarrier { unsigned* bar; unsigned x; volatile LAS unsigned* st; };
__device__ __forceinline__ XcdBarrier xcd_barrier_post(unsigned* bar, volatile LAS unsigned* st) {
    XcdBarrier b; b.bar = bar; b.x = xb_xcc_id(); b.st = st;
    if (threadIdx.x == 0) (void)xb_add(&bar[XB_XCNT(b.x)], 1u);
    return b;
}
__device__ __forceinline__ void xcd_barrier_complete(unsigned* bar, unsigned x, unsigned& nloc, unsigned& nx) {
    const unsigned G = gridDim.x * gridDim.y * gridDim.z;
    unsigned sum, cnt, mine, sp = 0u;
    for (;;) {
        sum = 0u; cnt = 0u; mine = 0u;
#pragma unroll
        for (unsigned j = 0; j < 16; ++j) { const unsigned c = xb_ld(&bar[XB_XCNT(j)]); sum += c; cnt += (c > 0u) ? 1u : 0u; mine = (j == x) ? c : mine; }
        if (sum == G) break;
        __builtin_amdgcn_s_sleep(1);
        if ((++sp & 255u) == 0u) { if (xb_ld(&bar[XB_TMO])) break; if (sp > XB_SPIN_CAP) { atomicAdd(&bar[XB_TMO], 1u); break; } }
    }
    nloc = mine > 0u ? mine : 1u; nx = cnt > 0u ? cnt : 1u;
}
__device__ __forceinline__ void xcd_barrier(const XcdBarrier& b) {
    asm volatile("s_waitcnt vmcnt(0)" ::: "memory");
    __syncthreads();
    if (threadIdx.x == 0) {
        unsigned* bar = b.bar;
        __builtin_amdgcn_s_waitcnt(0);
        unsigned nloc = b.st[0], nx = b.st[1];
        if (nloc == 0u) { xcd_barrier_complete(bar, b.x, nloc, nx); b.st[0] = nloc; b.st[1] = nx; }
        const unsigned old = xb_add(&bar[XB_XSUB(b.x)], 1u);
        const unsigned gen = old / nloc;
        if (old + 1u == (gen + 1u) * nloc) {
            __builtin_amdgcn_fence(__ATOMIC_RELEASE, "agent");
            asm volatile("s_waitcnt vmcnt(0)" ::: "memory");
            const unsigned og = xb_add(&bar[XB_TOP], 1u);
            const unsigned tg = og / nx;
            if (og + 1u == (tg + 1u) * nx) xb_add(&bar[XB_TOPGEN], 1u);
            else XB_SPIN(xb_ld(&bar[XB_TOPGEN]) == tg, bar);
            __builtin_amdgcn_fence(__ATOMIC_ACQUIRE, "agent");
            xb_add(&bar[XB_XGEN(b.x)], 1u);
            asm volatile("s_waitcnt vmcnt(0)" ::: "memory");
        } else {
            XB_SPIN(xb_ld(&bar[XB_XGEN(b.x)]) == gen, bar);
            __builtin_amdgcn_fence(__ATOMIC_ACQUIRE, "agent");
            asm volatile("s_waitcnt vmcnt(0)" ::: "memory");
        }
    }
    __syncthreads();
}

struct Args { const float* in[29]; float* out; unsigned char* ws; int ph_lo, ph_hi; };
struct Frame {
    LAS unsigned char* lds; gu32* ctl; unsigned char* ws;
    int tid, lane, wave, vcu, G, gw, NGW;
};

struct Row { f32x4 v[4]; };
__device__ __forceinline__ Row ld_row(const float* p, int lane) { Row r; const f32x4* q = (const f32x4*)p + lane;
#pragma unroll
    for (int j = 0; j < 4; ++j) r.v[j] = q[64 * j]; return r; }
__device__ __forceinline__ void st_row(float* p, int lane, const Row& r) { f32x4* q = (f32x4*)p + lane;
#pragma unroll
    for (int j = 0; j < 4; ++j) q[64 * j] = r.v[j]; }
__device__ __forceinline__ void st_row_bf16(bf16* p, int lane, const Row& r) { u32x2* q = (u32x2*)p + lane;
#pragma unroll
    for (int j = 0; j < 4; ++j) { u32x2 w; w.x = pk2(r.v[j][0], r.v[j][1]); w.y = pk2(r.v[j][2], r.v[j][3]); q[64 * j] = w; } }
__device__ __forceinline__ Row ld_row_bf16(const bf16* p, int lane) { Row r; const u32x2* q = (const u32x2*)p + lane;
#pragma unroll
    for (int j = 0; j < 4; ++j) { const u32x2 w = q[64 * j]; r.v[j] = (f32x4){bflo(w.x), bfhi(w.x), bflo(w.y), bfhi(w.y)}; } return r; }
__device__ __forceinline__ float row_sumsq(const Row& r) { float s = 0.f;
#pragma unroll
    for (int j = 0; j < 4; ++j) s += (r.v[j][0] * r.v[j][0] + r.v[j][1] * r.v[j][1]) + (r.v[j][2] * r.v[j][2] + r.v[j][3] * r.v[j][3]); return wave_sum(s); }
__device__ __forceinline__ Row rmsnorm_row(const Row& x, const Row& g) { const float rs = rsqrtf(row_sumsq(x) * (1.f / D) + RMS_EPS); Row y;
#pragma unroll
    for (int j = 0; j < 4; ++j) y.v[j] = x.v[j] * rs * g.v[j]; return y; }

__device__ __forceinline__ void tr_item(const float* W, int ldw, int k0, int n0, bf16* WT, int ldt, int drow0, int dcol0, const float* sc, int scmode, LAS float* scr, int lane) {
#pragma unroll 8
    for (int i = 0; i < 32; ++i) { const int kk = 2 * i + (lane >> 5); float v = W[(size_t)(k0 + kk) * ldw + n0 + (lane & 31)];
        if (scmode == 1) v *= sc[k0 + kk]; else if (scmode == 2) v *= (1.f - sc[k0 + kk]);
        scr[kk * 33 + (lane & 31)] = v; }
    LDS_WAIT(); asm volatile("" ::: "memory");
    const int c = lane & 7;
#pragma unroll
    for (int j = 0; j < 4; ++j) { const int n = (lane >> 3) + 8 * j; const LAS float* s = scr + (8 * c) * 33 + n;
        u32x4 o; o.x = pk2(s[0 * 33], s[1 * 33]); o.y = pk2(s[2 * 33], s[3 * 33]); o.z = pk2(s[4 * 33], s[5 * 33]); o.w = pk2(s[6 * 33], s[7 * 33]);
        *(GAS u32x4*)(WT + (size_t)(drow0 + n0 + n) * ldt + dcol0 + k0 + 8 * c) = o; }
    LDS_WAIT(); asm volatile("" ::: "memory");
}
__device__ __forceinline__ int gu_row(int n) { return n < FF ? 256 * (n >> 7) + (n & 127) : 256 * ((n - FF) >> 7) + 128 + ((n - FF) & 127); }

__device__ __forceinline__ void p0_prologue(Frame& F, const Args& a) {
    LAS float* scr = (LAS float*)(F.lds + F.wave * 16384);
    unsigned char* ws = F.ws;
    constexpr int I_SQ = 16 * 32;
    constexpr int I_RKV = 3 * I_SQ, I_L1 = 2 * 16 * 8, I_L2 = 4 * 32, I_GU = 16 * 224, I_DN = 56 * 32, I_IN = 16 * 128;
    constexpr int NITEMS = I_RKV + I_L1 + I_L2 + I_SQ + I_GU + I_DN + I_IN + I_SQ;
    for (int it = F.gw; it < NITEMS; it += F.NGW) {
        int r = it;
        if (r < I_RKV) { const int z = r / I_SQ, q = r % I_SQ; tr_item(a.in[4] + (size_t)z * D * D, D, 64 * (q / 32), 32 * (q % 32), (bf16*)(ws + WS_W_RKV) + (size_t)z * D * D, D, 0, 0, nullptr, 0, scr, F.lane); continue; } r -= I_RKV;
        if (r < I_L1) {
            const int half = r / 128, q = r % 128, kb = q / 8, nb = q % 8, n0 = 32 * nb;
            const float* W; int ldw, nn0, mi;
            if (n0 < 64) { W = a.in[6]; ldw = 64; nn0 = n0; mi = 3; } else if (n0 < 128) { W = a.in[9]; ldw = 64; nn0 = n0 - 64; mi = 4; } else { W = a.in[11]; ldw = 128; nn0 = n0 - 128; mi = 5; }
            tr_item(W, ldw, 64 * kb, nn0, (bf16*)(ws + WS_W_L1), 2 * D, n0 - nn0, half * D, a.in[3] + mi * D, half == 0 ? 1 : 2, scr, F.lane); continue; } r -= I_L1;
        if (r < I_L2) {
            const int part = r / 32, nb = r % 32;
            if (part == 0) tr_item(a.in[7], D, 0, 32 * nb, (bf16*)(ws + WS_W_L2), 256, 0, 0, nullptr, 0, scr, F.lane);
            else if (part == 1) tr_item(a.in[10], D, 0, 32 * nb, (bf16*)(ws + WS_W_L2), 256, D, 64, nullptr, 0, scr, F.lane);
            else tr_item(a.in[12], D, 64 * (part - 2), 32 * nb, (bf16*)(ws + WS_W_L2), 256, 2 * D, 128, nullptr, 0, scr, F.lane);
            continue; } r -= I_L2;
        if (r < I_SQ) { tr_item(a.in[18], D, 64 * (r / 32), 32 * (r % 32), (bf16*)(ws + WS_W_O0), D, 0, 0, nullptr, 0, scr, F.lane); continue; } r -= I_SQ;
        if (r < I_GU) { const int kb = r / 224, nb = r % 224; tr_item(a.in[24], 2 * FF, 64 * kb, 32 * nb, (bf16*)(ws + WS_W_GU), D, gu_row(32 * nb) - 32 * nb, 0, nullptr, 0, scr, F.lane); continue; } r -= I_GU;
        if (r < I_DN) { tr_item(a.in[25], D, 64 * (r / 32), 32 * (r % 32), (bf16*)(ws + WS_W_DN), FF, 0, 0, nullptr, 0, scr, F.lane); continue; } r -= I_DN;
        if (r < I_IN) { const int n0 = 32 * (r % 128);
            const int drow = n0 < 2 * D ? 256 * (n0 / 256) + 128 * ((n0 % 64) / 32) + 32 * ((n0 % 256) / 64) : n0;
            tr_item(a.in[19], WIN_LD, 64 * (r / 128), n0, (bf16*)(ws + WS_W_IN), D, drow - n0, 0, nullptr, 0, scr, F.lane); continue; } r -= I_IN;
        { tr_item(a.in[23], D, 64 * (r / 32), 32 * (r % 32), (bf16*)(ws + WS_W_FO), D, 0, 0, nullptr, 0, scr, F.lane); }
    }
    for (int i = F.gw * 64 + F.lane; i < 3 * D * 32; i += F.NGW * 64) { const int row = i >> 5, ch = i & 31, part = row / D, k = ch * 8;
        const bool nz = part == 0 ? (k < 64) : (part == 1 ? (k >= 64 && k < 128) : (k >= 128));
        if (!nz) *(GAS u32x4*)((bf16*)(ws + WS_W_L2) + (size_t)row * 256 + k) = (u32x4){0u, 0u, 0u, 0u}; }
}

__device__ __forceinline__ void p0_moe_weights(Frame& F, const Args& a, int wi, int nw, int part) {
    LAS float* scr = (LAS float*)(F.lds + F.wave * 16384);
    unsigned char* ws = F.ws;
    constexpr int I_GU = 16 * 224, I_DN = 56 * 32;
    constexpr int NIT = NE * (I_GU + I_DN), MOE_CUT = NIT;
    for (int it = (part ? MOE_CUT : 0) + wi * NWAVES + F.wave; it < (part ? NIT : MOE_CUT); it += nw * NWAVES) {
        int r = it;
        if (r < NE * I_GU) { const int e = r / I_GU, q = r % I_GU, kb = q / 224, nb = q % 224;
            tr_item(a.in[27] + (size_t)e * D * 2 * FF, 2 * FF, 64 * kb, 32 * nb, (bf16*)(ws + WS_W_MGU) + (size_t)e * 2 * FF * D, D, gu_row(32 * nb) - 32 * nb, 0, nullptr, 0, scr, F.lane); continue; } r -= NE * I_GU;
        { const int e = r / I_DN, q = r % I_DN; tr_item(a.in[28] + (size_t)e * FF * D, D, 64 * (q / 32), 32 * (q % 32), (bf16*)(ws + WS_W_MDN) + (size_t)e * D * FF, FF, 0, 0, nullptr, 0, scr, F.lane); }
    }
}

__device__ __forceinline__ void p1_shift(Frame& F, const Args& a) {
    const int lane = F.lane; const float* x = a.in[0];
    bf16* UB = (bf16*)(F.ws + WS_UB); bf16* XS = (bf16*)(F.ws + WS_XS);
    const Row g0 = ld_row(a.in[1], lane);
    const int RPW = T / (256 * NWAVES);
    for (int t0 = F.gw * RPW; t0 < T; t0 += F.NGW * RPW) {
        Row prev;
        if (t0 > 0) prev = rmsnorm_row(ld_row(x + (size_t)(t0 - 1) * D, lane), g0);
        else { for (int j = 0; j < 4; ++j) prev.v[j] = (f32x4){0.f, 0.f, 0.f, 0.f}; st_row_bf16(UB, lane, prev); }
        for (int t = t0; t < t0 + RPW; ++t) {
            const Row u = rmsnorm_row(ld_row(x + (size_t)t * D, lane), g0);
            st_row_bf16(UB + (size_t)(t + 1) * D, lane, u);
#pragma unroll
            for (int n = 0; n < 3; ++n) { const Row mu = ld_row(a.in[3] + n * D, lane); Row o;
#pragma unroll
                for (int j = 0; j < 4; ++j) o.v[j] = u.v[j] + (prev.v[j] - u.v[j]) * mu.v[j];
                st_row_bf16(XS + (size_t)n * T * D + (size_t)t * D, lane, o); }
            prev = u;
        }
    }
}

struct Pk { bf16x8 k0, k1; };
__device__ __forceinline__ Pk pack_tile(const f32x16& t) {
    const u32x4 a = {cvtpk(t[0], t[1]), cvtpk(t[2], t[3]), cvtpk(t[4], t[5]), cvtpk(t[6], t[7])}, b = {cvtpk(t[8], t[9]), cvtpk(t[10], t[11]), cvtpk(t[12], t[13]), cvtpk(t[14], t[15])};
    Pk p; p.k0 = __builtin_bit_cast(bf16x8, a); p.k1 = __builtin_bit_cast(bf16x8, b); return p; }
#define MFMA32(a, b, c) __builtin_amdgcn_mfma_f32_32x32x16_bf16((a), (b), (c), 0, 0, 0)
__device__ __forceinline__ f32x16 xt(const Pk& X, const Pk& Z, f32x16 acc) { acc = MFMA32(X.k0, Z.k0, acc); acc = MFMA32(X.k1, Z.k1, acc); return acc; }
__device__ __forceinline__ bf16x8 nfrag(const bf16* m, int rt, int ks, int lane) { return *(const bf16x8*)(m + (size_t)(32 * rt + (lane & 31)) * D + 16 * ks + 8 * (lane >> 5)); }
__device__ __forceinline__ f32x16 nat(const bf16* am, int a, const bf16* bm, int b, int lane, f32x16 acc) {
#pragma unroll
    for (int ks = 0; ks < 4; ++ks) acc = MFMA32(nfrag(am, a, ks, lane), nfrag(bm, b, ks, lane), acc);
    return acc; }
__device__ __forceinline__ f32x16 dl_copy(const bf16* am, int a, int ct, int lane) {
    f32x16 acc = {};
#pragma unroll
    for (int kk2 = 0; kk2 < 2; ++kk2) { const int ks = 2 * ct + kk2; bf16x8 id;
#pragma unroll
        for (int e = 0; e < 8; ++e) id[e] = (32 * ct + (lane & 31) == 16 * ks + 8 * (lane >> 5) + e) ? (short)0x3F80 : (short)0;
        acc = MFMA32(nfrag(am, a, ks, lane), id, acc); }
    return acc; }
__device__ __forceinline__ void mask_lt(f32x16& t, int lane) {
#pragma unroll
    for (int r = 0; r < 16; ++r) if (!(crow(r, lane >> 5) < (lane & 31))) t[r] = 0.f; }
__device__ __forceinline__ void mask_gt(f32x16& t, int lane) {
#pragma unroll
    for (int r = 0; r < 16; ++r) if (!(crow(r, lane >> 5) > (lane & 31))) t[r] = 0.f; }
__device__ __forceinline__ void mask_le(f32x16& t, int lane) {
#pragma unroll
    for (int r = 0; r < 16; ++r) if (!(crow(r, lane >> 5) <= (lane & 31))) t[r] = 0.f; }
__device__ __forceinline__ void add_eye(f32x16& t, int lane) {
#pragma unroll
    for (int r = 0; r < 16; ++r) if (crow(r, lane >> 5) == (lane & 31)) t[r] += 1.f; }

__device__ __forceinline__ void p3_prep(Frame& F, const Args& a) {
    const int lane = F.lane;
    const bf16* R = (const bf16*)(F.ws + WS_R); const bf16* K = (const bf16*)(F.ws + WS_K); const bf16* V = (const bf16*)(F.ws + WS_V);
    const float* LW = (const float*)(F.ws + WS_LW); const bf16* AA = (const bf16*)(F.ws + WS_AA);
    bf16* AT = (bf16*)(F.ws + WS_AT); bf16* RT = (bf16*)(F.ws + WS_RT); bf16* BH = (bf16*)(F.ws + WS_BH); bf16* KH = (bf16*)(F.ws + WS_KH); bf16* V16 = (bf16*)(F.ws + WS_V16);
    float* GC = (float*)(F.ws + WS_GC); float* C3 = (float*)(F.ws + WS_CS) + (size_t)2 * T * 16;
    for (int task = F.gw; task < NCH * 8; task += F.NGW) {
        const int c = task >> 3, hg = (task >> 1) & 3, half = task & 1, col = hg * 256 + 4 * lane;
        const f32x4 k_k = *(const f32x4*)(a.in[13] + col), k_a = *(const f32x4*)(a.in[14] + col), r_k = *(const f32x4*)(a.in[15] + col);
        f32x4 lg = {0.f, 0.f, 0.f, 0.f};
        if (half) {
            f32x4 l32[32];
#pragma unroll
            for (int u = 0; u < 32; ++u) l32[u] = *(const f32x4*)(LW + (size_t)(64 * c + u) * D + col);
#pragma unroll
            for (int u = 0; u < 32; ++u) lg = lg + l32[u];
        }
        f32x4 eprev; for (int i = 0; i < 4; ++i) eprev[i] = __builtin_amdgcn_exp2f(lg[i] * LOG2E);
        constexpr int PF = 8;
        for (int tb = 32 * half; tb < 32 * half + 32; tb += PF) {
            u32x2 rr[PF], kx[PF], ax[PF]; f32x4 lx[PF];
#pragma unroll
            for (int u = 0; u < PF; ++u) { const size_t o = (size_t)(64 * c + tb + u) * D + col;
                rr[u] = *(const u32x2*)(R + o); kx[u] = *(const u32x2*)(K + o); lx[u] = *(const f32x4*)(LW + o); ax[u] = *(const u32x2*)(AA + o); }
#pragma unroll
            for (int u = 0; u < PF; ++u) { const int tt = tb + u;
                const size_t o = (size_t)(64 * c + tt) * D + col;
                const f32x4 r = {bflo(rr[u].x), bfhi(rr[u].x), bflo(rr[u].y), bfhi(rr[u].y)}, k = {bflo(kx[u].x), bfhi(kx[u].x), bflo(kx[u].y), bfhi(kx[u].y)}, lw = lx[u], aa = {bflo(ax[u].x), bfhi(ax[u].x), bflo(ax[u].y), bfhi(ax[u].y)};
                f32x4 kk = k * k_k;
                float ss = (kk[0] * kk[0] + kk[1] * kk[1]) + (kk[2] * kk[2] + kk[3] * kk[3]); ss = row16_sum(ss);
                kk = kk * (1.f / fmaxf(sqrtf(ss), 1e-12f));
                const f32x4 b = kk * aa, km = k * (1.f + (aa - 1.f) * k_a);
                float s3 = (r[0] * km[0] * r_k[0] + r[1] * km[1] * r_k[1]) + (r[2] * km[2] * r_k[2] + r[3] * km[3] * r_k[3]); s3 = row16_sum(s3);
                if ((lane & 15) == 0) C3[(size_t)(64 * c + tt) * 16 + hg * 4 + (lane >> 4)] = s3;
                lg = lg + lw;
                f32x4 at, rt, bh, kh;
#pragma unroll
                for (int i = 0; i < 4; ++i) { const float em = eprev[i], ep = __builtin_amdgcn_exp2f(lg[i] * LOG2E), en = __builtin_amdgcn_rcpf(ep);
                    eprev[i] = ep; at[i] = -kk[i] * em; rt[i] = r[i] * ep; bh[i] = b[i] * en; kh[i] = km[i] * en; }
                *(u32x2*)(AT + o) = (u32x2){pk2(at[0], at[1]), pk2(at[2], at[3])}; *(u32x2*)(RT + o) = (u32x2){pk2(rt[0], rt[1]), pk2(rt[2], rt[3])};
                *(u32x2*)(BH + o) = (u32x2){pk2(bh[0], bh[1]), pk2(bh[2], bh[3])}; *(u32x2*)(KH + o) = (u32x2){pk2(kh[0], kh[1]), pk2(kh[2], kh[3])};
            }
        }
        if (half) { f32x4 g; for (int i = 0; i < 4; ++i) g[i] = eprev[i];
            *(f32x4*)(GC + (size_t)c * D + col) = g; }
    }
}

__device__ __forceinline__ void inv32(f32x16 N, f32x16 NT, f32x16& Tm, f32x16& TT, int lane) {
    Tm = N; TT = NT; add_eye(Tm, lane); add_eye(TT, lane);
    Pk Np = pack_tile(N), NTp = pack_tile(NT);
#pragma unroll
    for (int it = 0; it < 4; ++it) {
        const f32x16 z = {};
        const f32x16 N2 = xt(NTp, Np, z), N2T = xt(Np, NTp, z);
        const Pk N2p = pack_tile(N2), N2Tp = pack_tile(N2T), TTp = pack_tile(TT);
        Tm = xt(TTp, N2p, Tm);
        TT = xt(N2p, TTp, TT);
        Np = N2p; NTp = N2Tp;
    }
}

__device__ __forceinline__ void pa_chunk(Frame& F) {
    const int lane = F.lane, c32 = lane & 31, hh = lane >> 5;
    const bf16* AT = (const bf16*)(F.ws + WS_AT); const bf16* BH = (const bf16*)(F.ws + WS_BH); const bf16* KH = (const bf16*)(F.ws + WS_KH); const bf16* V16 = (const bf16*)(F.ws + WS_V16);
    const float* GC = (const float*)(F.ws + WS_GC);
    for (int task = F.gw; task < NCH * NH; task += F.NGW) {
        const int c = task >> 4, h = task & 15; const size_t o = (size_t)(64 * c) * D + h * 64;
        const bf16* at = AT + o; const bf16* bh = BH + o; const bf16* kh = KH + o; const bf16* vv = V16 + o;
        const f32x16 z = {};
        bf16x8 atf[2][4], bhf[2][4], khf[2][4], vvf[2][4];
#pragma unroll
        for (int r2 = 0; r2 < 2; ++r2)
#pragma unroll
            for (int ks = 0; ks < 4; ++ks) { atf[r2][ks] = nfrag(at, r2, ks, lane); bhf[r2][ks] = nfrag(bh, r2, ks, lane); }
        const float g0 = GC[(size_t)c * D + h * 64 + c32], g1 = GC[(size_t)c * D + h * 64 + 32 + c32];
#define NATR(Af, a_, Bf, b_, acc_) do { _Pragma("unroll") for (int ks_ = 0; ks_ < 4; ++ks_) acc_ = MFMA32(Af[a_][ks_], Bf[b_][ks_], acc_); } while (0)
#define DLR(Af, a_, ct_, acc_) do { _Pragma("unroll") for (int k2_ = 0; k2_ < 2; ++k2_) { const int ks_ = 2 * (ct_) + k2_; bf16x8 id_; \
            _Pragma("unroll") for (int e_ = 0; e_ < 8; ++e_) id_[e_] = (32 * (ct_) + c32 == 16 * ks_ + 8 * hh + e_) ? (short)0x3F80 : (short)0; acc_ = MFMA32(Af[a_][ks_], id_, acc_); } } while (0)
        Pk T11T, T22T, T12T;
        {
            Pk T11, T22, T12;
            f32x16 n = z, nt = z; NATR(bhf, 0, atf, 0, n); NATR(atf, 0, bhf, 0, nt); mask_lt(n, lane); mask_gt(nt, lane);
            f32x16 t, tt; inv32(n, nt, t, tt, lane); T11 = pack_tile(t); T11T = pack_tile(tt);
            n = z; nt = z; NATR(bhf, 1, atf, 1, n); NATR(atf, 1, bhf, 1, nt); mask_lt(n, lane); mask_gt(nt, lane);
            inv32(n, nt, t, tt, lane); T22 = pack_tile(t); T22T = pack_tile(tt);
            n = z; nt = z; NATR(bhf, 0, atf, 1, n); NATR(atf, 1, bhf, 0, nt);
            const Pk N12 = pack_tile(n), N12T = pack_tile(nt);
            const Pk Z1 = pack_tile(xt(N12T, T22, z));
            T12 = pack_tile(xt(T11T, Z1, z));
            const Pk Z2 = pack_tile(xt(N12, T11T, z));
            T12T = pack_tile(xt(T22, Z2, z));
            u32x4* tm = (u32x4*)(F.ws + WS_TM) + (size_t)task * 6 * 64 + lane;
            tm[0] = __builtin_bit_cast(u32x4, T11.k0); tm[64] = __builtin_bit_cast(u32x4, T11.k1); tm[128] = __builtin_bit_cast(u32x4, T12.k0); tm[192] = __builtin_bit_cast(u32x4, T12.k1);
            tm[256] = __builtin_bit_cast(u32x4, T22.k0); tm[320] = __builtin_bit_cast(u32x4, T22.k1);
        }
        __builtin_amdgcn_sched_barrier(0);
#pragma unroll
        for (int r2 = 0; r2 < 2; ++r2)
#pragma unroll
            for (int ks = 0; ks < 4; ++ks) khf[r2][ks] = nfrag(kh, r2, ks, lane);
        Pk W1p[2][2];
#pragma unroll
        for (int b = 0; b < 2; ++b) { const float gcol = b == 0 ? g0 : g1;
            f32x16 bb0 = z, bb1 = z; DLR(bhf, 0, b, bb0); DLR(bhf, 1, b, bb1);
#pragma unroll
            for (int r = 0; r < 16; ++r) { bb0[r] *= gcol; bb1[r] *= gcol; }
            const Pk B0 = pack_tile(bb0), B1 = pack_tile(bb1);
            f32x16 w0 = xt(T11T, B0, z); w0 = xt(T12T, B1, w0);
            const f32x16 w1 = xt(T22T, B1, z);
            W1p[0][b] = pack_tile(w0); W1p[1][b] = pack_tile(w1); }
        __builtin_amdgcn_sched_barrier(0);
        {
            bf16* plr = (bf16*)(F.ws + WS_PLR) + (size_t)task * 4096;
#pragma unroll
            for (int a2 = 0; a2 < 2; ++a2) { f32x16 d0 = z, d1 = z; DLR(atf, 0, a2, d0); DLR(atf, 1, a2, d1); const Pk A0 = pack_tile(d0), A1 = pack_tile(d1);
#pragma unroll
                for (int b = 0; b < 2; ++b) { f32x16 p = xt(A0, W1p[0][b], z); p = xt(A1, W1p[1][b], p);
#pragma unroll
                    for (int g4 = 0; g4 < 4; ++g4) {
                        const int m_ = 2 * b + (c32 >> 4), lb_ = (c32 & 15) + 16 * (2 * (g4 & 1) + hh);
                        *(u32x2*)(plr + ((m_ * 2 + a2) * 64 + lb_) * 8 + 4 * (g4 >> 1)) = (u32x2){cvtpk(p[4 * g4], p[4 * g4 + 1]), cvtpk(p[4 * g4 + 2], p[4 * g4 + 3])}; } } }
        }
        __builtin_amdgcn_sched_barrier(0);
#pragma unroll
        for (int r2 = 0; r2 < 2; ++r2)
#pragma unroll
            for (int ks = 0; ks < 4; ++ks) vvf[r2][ks] = nfrag(vv, r2, ks, lane);
        Pk M2p[2][2];
        {
            f32x16 e = z; NATR(atf, 0, khf, 0, e); mask_gt(e, lane); const Pk E00 = pack_tile(e);
            e = z; NATR(atf, 1, khf, 1, e); mask_gt(e, lane); const Pk E11 = pack_tile(e);
            e = z; NATR(atf, 1, khf, 0, e); const Pk E10 = pack_tile(e);
#pragma unroll
            for (int b = 0; b < 2; ++b) { const float gcol = b == 0 ? g0 : g1;
                f32x16 m0 = xt(E00, W1p[0][b], z); m0 = xt(E10, W1p[1][b], m0);
                f32x16 m1 = xt(E11, W1p[1][b], z);
                f32x16 k0 = z, k1 = z; DLR(khf, 0, b, k0); DLR(khf, 1, b, k1);
#pragma unroll
                for (int r = 0; r < 16; ++r) { m0[r] += k0[r] * gcol; m1[r] += k1[r] * gcol; }
                M2p[0][b] = pack_tile(m0); M2p[1][b] = pack_tile(m1); }
        }
        __builtin_amdgcn_sched_barrier(0);
        {
            bf16* qm = (bf16*)(F.ws + WS_QM) + (size_t)task * 4096;
#pragma unroll
            for (int b = 0; b < 2; ++b) { f32x16 d0 = z, d1 = z; DLR(vvf, 0, b, d0); DLR(vvf, 1, b, d1); const Pk V0 = pack_tile(d0), V1 = pack_tile(d1);
#pragma unroll
                for (int a2 = 0; a2 < 2; ++a2) { f32x16 q = xt(M2p[0][a2], V0, z); q = xt(M2p[1][a2], V1, q);
#pragma unroll
                    for (int g4 = 0; g4 < 4; ++g4) {
                        const int rg_ = 2 * b + (c32 >> 4), m_ = 2 * a2 + (g4 >> 1), lb_ = (c32 & 15) + 16 * (2 * (g4 & 1) + hh);
                        *(u32x2*)(qm + rg_ * 1024 + (m_ * 64 + lb_) * 4) = (u32x2){cvtpk(q[4 * g4], q[4 * g4 + 1]), cvtpk(q[4 * g4 + 2], q[4 * g4 + 3])}; } } }
        }
#undef NATR
#undef DLR
    }
}

constexpr int PB_NST = 12, PB_QOFF = 8192, PB_GOFF = 8192 + 2048, PB_STB = 8192 + 2048 + 256, PB_NLD = 4, PB_NDMA = 11;
constexpr int PB_FULL_OFF = RING_BYTES + 64, PB_CONS_OFF = RING_BYTES + 128, PB_DUMP_OFF = RING_BYTES + 2048;
static_assert(PB_NST * PB_STB <= RING_BYTES && PB_FULL_OFF + 4 * PB_NST <= PB_CONS_OFF && PB_CONS_OFF + 4 <= MISC_OFF, "phase-B LDS map");
__device__ __forceinline__ void pb_chain(Frame& F) {
    if ((F.vcu & 31) >= 8 || F.vcu >= 256 || F.wave > PB_NLD) return;
    static_assert(PB_NLD == 4 && PB_NDMA == 11 && 2 * PB_NLD < PB_NST, "the counted waits below assume 11 LDS-DMA instructions per stage and publish two of a loader's stages behind");
    const int lane = F.lane, h = 2 * (F.vcu >> 5) + ((F.vcu & 31) >> 2), rg = F.vcu & 3;
    volatile LAS unsigned* FULL = (volatile LAS unsigned*)(F.lds + PB_FULL_OFF); volatile LAS unsigned* CONS = (volatile LAS unsigned*)(F.lds + PB_CONS_OFF);
    if (F.wave >= 1) {
        const int L = F.wave - 1;
        const char* PLR = (const char*)(F.ws + WS_PLR); const char* QM = (const char*)(F.ws + WS_QM); const float* GC = (const float*)(F.ws + WS_GC);
        int k = 0;
        for (int c = L; c < NCH; c += PB_NLD, ++k) {
            if (c >= PB_NST) { const unsigned need = (unsigned)(c - PB_NST + 1); unsigned sp = 0; while (CONS[0] < need) { __builtin_amdgcn_s_sleep(1); if (++sp > (1u << 22)) break; } }
            const size_t task = (size_t)c * 16 + h;
            LAS unsigned char* slot = F.lds + (c % PB_NST) * PB_STB;
            const char* pl = PLR + task * 8192 + lane * 16; const char* qm = QM + task * 8192 + rg * 2048 + lane * 16;
#pragma unroll
            for (int i = 0; i < 8; ++i) __builtin_amdgcn_global_load_lds((const unsigned*)(pl + i * 1024), (LAS unsigned*)(slot + i * 1024), 16, 0, 0);
#pragma unroll
            for (int i = 0; i < 2; ++i) __builtin_amdgcn_global_load_lds((const unsigned*)(qm + i * 1024), (LAS unsigned*)(slot + PB_QOFF + i * 1024), 16, 0, 0);
            __builtin_amdgcn_global_load_lds((const unsigned*)(GC + (size_t)c * D + h * 64 + lane), (LAS unsigned*)(slot + PB_GOFF), 4, 0, 0);
            if (k >= 2) { asm volatile("s_waitcnt vmcnt(22)" ::: "memory"); const int cp = c - 2 * PB_NLD; FULL[cp % PB_NST] = (unsigned)(cp + 1); }
        }
        const int clast = L + PB_NLD * (k - 1);
        if (k >= 2) { asm volatile("s_waitcnt vmcnt(11)" ::: "memory"); const int cp = clast - PB_NLD; FULL[cp % PB_NST] = (unsigned)(cp + 1); }
        asm volatile("s_waitcnt vmcnt(0)" ::: "memory"); FULL[clast % PB_NST] = (unsigned)(clast + 1);
        return;
    }
    const int n16 = lane & 15, q4 = lane >> 4;
    bf16* S0 = (bf16*)(F.ws + WS_S0);
    f32x4 s[4];
#pragma unroll
    for (int m = 0; m < 4; ++m) s[m] = (f32x4){0.f, 0.f, 0.f, 0.f};
    bf16x8 af[4][2]; u32x2 qv[4]; f32x4 gc[4];
#define PB_TAKE(cc) do { { const unsigned need_ = (unsigned)((cc) + 1); unsigned sp_ = 0; while (FULL[(cc) % PB_NST] < need_) { if (++sp_ > (1u << 24)) break; } } \
        const LAS unsigned char* slot_ = F.lds + ((cc) % PB_NST) * PB_STB; \
        _Pragma("unroll") for (int m = 0; m < 4; ++m) { _Pragma("unroll") for (int kb = 0; kb < 2; ++kb) af[m][kb] = *(const LAS bf16x8*)(slot_ + ((m * 2 + kb) * 64 + lane) * 16); \
            qv[m] = *(const LAS u32x2*)(slot_ + PB_QOFF + (m * 64 + lane) * 8); gc[m] = *(const LAS f32x4*)(slot_ + PB_GOFF + 64 * m + 16 * q4); } \
        asm volatile("s_waitcnt lgkmcnt(0)" ::: "memory"); CONS[0] = (unsigned)((cc) + 1); } while (0)
    PB_TAKE(0);
    for (int c = 0; c < NCH; ++c) {
        bf16* s0 = S0 + ((size_t)c * 16 + h) * 4096 + (16 * rg + n16) * 64;
        u32x2 sp2[4];
#pragma unroll
        for (int m = 0; m < 4; ++m) { sp2[m] = (u32x2){cvtpk(s[m][0], s[m][1]), cvtpk(s[m][2], s[m][3])}; *(u32x2*)(s0 + 16 * m + 4 * q4) = sp2[m]; }
        const bf16x8 B0 = __builtin_bit_cast(bf16x8, (u32x4){sp2[0].x, sp2[0].y, sp2[1].x, sp2[1].y}), B1 = __builtin_bit_cast(bf16x8, (u32x4){sp2[2].x, sp2[2].y, sp2[3].x, sp2[3].y});
        f32x4 acc[4];
#pragma unroll
        for (int m = 0; m < 4; ++m) { acc[m] = s[m] * gc[m] + (f32x4){bflo(qv[m].x), bfhi(qv[m].x), bflo(qv[m].y), bfhi(qv[m].y)};
            acc[m] = __builtin_amdgcn_mfma_f32_16x16x32_bf16(af[m][0], B0, acc[m], 0, 0, 0);
            acc[m] = __builtin_amdgcn_mfma_f32_16x16x32_bf16(af[m][1], B1, acc[m], 0, 0, 0); }
        if (c + 1 < NCH) PB_TAKE(c + 1);
#pragma unroll
        for (int m = 0; m < 4; ++m) s[m] = acc[m];
    }
#undef PB_TAKE
}

__device__ __forceinline__ void pc_out(Frame& F, const Args& a) {
    const int lane = F.lane, c32 = lane & 31, hh = lane >> 5;
    const bf16* AT = (const bf16*)(F.ws + WS_AT); const bf16* RT = (const bf16*)(F.ws + WS_RT); const bf16* BH = (const bf16*)(F.ws + WS_BH); const bf16* KH = (const bf16*)(F.ws + WS_KH);
    const bf16* V16 = (const bf16*)(F.ws + WS_V16); const bf16* S0 = (const bf16*)(F.ws + WS_S0);
    const bf16* G = (const bf16*)(F.ws + WS_G); const float* C3 = (const float*)(F.ws + WS_CS) + (size_t)2 * T * 16; bf16* Z = (bf16*)(F.ws + WS_Z);
    LAS float* ysc = (LAS float*)(F.lds + F.wave * 16384);
    for (int task = F.gw; task < NCH * NH; task += F.NGW) {
        const int c = task >> 4, h = task & 15; const size_t o = (size_t)(64 * c) * D + h * 64;
        const bf16* at = AT + o; const bf16* rt = RT + o; const bf16* bh = BH + o; const bf16* kh = KH + o; const bf16* vv = V16 + o;
        const bf16* s0 = S0 + (size_t)task * 4096;
        const f32x16 z = {};
#define NATR(Af, a_, Bf, b_, acc_) do { _Pragma("unroll") for (int ks_ = 0; ks_ < 4; ++ks_) acc_ = MFMA32(Af[a_][ks_], Bf[b_][ks_], acc_); } while (0)
        Pk K00, K01, K11, B00, B01, B11, R00, R01, R11, Tm00, Tm01, Tm11;
        {
            bf16x8 atf[2][4], khf[2][4], rtf[2][4], bhf[2][4];
#pragma unroll
            for (int r2 = 0; r2 < 2; ++r2)
#pragma unroll
                for (int ks = 0; ks < 4; ++ks) { atf[r2][ks] = nfrag(at, r2, ks, lane); khf[r2][ks] = nfrag(kh, r2, ks, lane); rtf[r2][ks] = nfrag(rt, r2, ks, lane); bhf[r2][ks] = nfrag(bh, r2, ks, lane); }
            { const u32x4* tm = (const u32x4*)(F.ws + WS_TM) + (size_t)task * 6 * 64 + lane;
              Tm00.k0 = __builtin_bit_cast(bf16x8, tm[0]); Tm00.k1 = __builtin_bit_cast(bf16x8, tm[64]); Tm01.k0 = __builtin_bit_cast(bf16x8, tm[128]); Tm01.k1 = __builtin_bit_cast(bf16x8, tm[192]);
              Tm11.k0 = __builtin_bit_cast(bf16x8, tm[256]); Tm11.k1 = __builtin_bit_cast(bf16x8, tm[320]); }
            f32x16 e;
            e = z; NATR(khf, 0, atf, 0, e); mask_lt(e, lane); K00 = pack_tile(e);
            e = z; NATR(khf, 1, atf, 1, e); mask_lt(e, lane); K11 = pack_tile(e);
            e = z; NATR(khf, 0, atf, 1, e); K01 = pack_tile(e);
            e = z; NATR(bhf, 0, rtf, 0, e); mask_le(e, lane); B00 = pack_tile(e);
            e = z; NATR(bhf, 1, rtf, 1, e); mask_le(e, lane); B11 = pack_tile(e);
            e = z; NATR(bhf, 0, rtf, 1, e); B01 = pack_tile(e);
            e = z; NATR(khf, 0, rtf, 0, e); mask_le(e, lane); R00 = pack_tile(e);
            e = z; NATR(khf, 1, rtf, 1, e); mask_le(e, lane); R11 = pack_tile(e);
            e = z; NATR(khf, 0, rtf, 1, e); R01 = pack_tile(e);
        }
        __builtin_amdgcn_sched_barrier(0);
#pragma unroll 1
        for (int b = 0; b < 2; ++b) {
            bf16x8 vvf[2][2], sf[4], atf[2][4], rtf[2][4];
#pragma unroll
            for (int r2 = 0; r2 < 2; ++r2)
#pragma unroll
                for (int k2 = 0; k2 < 2; ++k2) vvf[r2][k2] = nfrag(vv, r2, 2 * b + k2, lane);
#pragma unroll
            for (int ks = 0; ks < 4; ++ks) sf[ks] = *(const bf16x8*)(s0 + (32 * b + c32) * 64 + 16 * ks + 8 * hh);
#pragma unroll
            for (int r2 = 0; r2 < 2; ++r2)
#pragma unroll
                for (int ks = 0; ks < 4; ++ks) { atf[r2][ks] = nfrag(at, r2, ks, lane); rtf[r2][ks] = nfrag(rt, r2, ks, lane); }
            Pk V0, V1;
            { f32x16 v0 = z, v1 = z;
#pragma unroll
              for (int k2 = 0; k2 < 2; ++k2) { const int ks = 2 * b + k2; bf16x8 id;
#pragma unroll
                  for (int e2 = 0; e2 < 8; ++e2) id[e2] = (32 * b + c32 == 16 * ks + 8 * hh + e2) ? (short)0x3F80 : (short)0;
                  v0 = MFMA32(vvf[0][k2], id, v0); v1 = MFMA32(vvf[1][k2], id, v1); }
              V0 = pack_tile(v0); V1 = pack_tile(v1); }
            f32x16 x0 = z, x1 = z;
#pragma unroll
            for (int ks = 0; ks < 4; ++ks) { x0 = MFMA32(atf[0][ks], sf[ks], x0); x1 = MFMA32(atf[1][ks], sf[ks], x1); }
            x0 = xt(K00, V0, x0);
            x1 = xt(K01, V0, x1); x1 = xt(K11, V1, x1);
            const Pk X0 = pack_tile(x0), X1 = pack_tile(x1);
            __builtin_amdgcn_sched_barrier(0);
            const Pk U0 = pack_tile(xt(Tm00, X0, z));
            f32x16 u1 = xt(Tm01, X0, z); u1 = xt(Tm11, X1, u1); const Pk U1 = pack_tile(u1);
            __builtin_amdgcn_sched_barrier(0);
            f32x16 y0 = z, y1 = z;
#pragma unroll
            for (int ks = 0; ks < 4; ++ks) { y0 = MFMA32(rtf[0][ks], sf[ks], y0); y1 = MFMA32(rtf[1][ks], sf[ks], y1); }
            y0 = xt(B00, U0, y0); y1 = xt(B01, U0, y1); y1 = xt(B11, U1, y1);
            y0 = xt(R00, V0, y0); y1 = xt(R01, V0, y1); y1 = xt(R11, V1, y1);
            __builtin_amdgcn_sched_barrier(0);
#pragma unroll
            for (int r = 0; r < 16; ++r) { ysc[crow(r, hh) * 64 + 32 * b + c32] = y0[r]; ysc[(32 + crow(r, hh)) * 64 + 32 * b + c32] = y1[r]; }
        }
#undef NATR
        LDS_WAIT();
        {
            int lane_e = lane; asm volatile("" : "+v"(lane_e));
            const int l16 = lane_e & 15, tq = lane_e >> 4, col = h * 64 + 4 * l16;
            const f32x4 gg = *(const f32x4*)(a.in[16] + col), gb = *(const f32x4*)(a.in[17] + col);
            u32x2 gwv[16], vwv[16]; float c3v[16];
#pragma unroll
            for (int it = 0; it < 16; ++it) { const size_t row = (size_t)(64 * c + 4 * it + tq); gwv[it] = *(const u32x2*)(G + row * D + col); vwv[it] = *(const u32x2*)(V16 + row * D + col); c3v[it] = C3[row * 16 + h]; }
#pragma unroll
            for (int it = 0; it < 16; ++it) { const int tt = 4 * it + tq; const size_t row = (size_t)(64 * c + tt);
                const f32x4 y = *(const LAS f32x4*)(ysc + tt * 64 + 4 * l16);
                const u32x2 gw = gwv[it], vw = vwv[it]; const float c3 = c3v[it];
                const float mean = row16_sum((y[0] + y[1]) + (y[2] + y[3])) * (1.f / 64.f);
                const f32x4 d = y - mean;
                const float var = row16_sum((d[0] * d[0] + d[1] * d[1]) + (d[2] * d[2] + d[3] * d[3])) * (1.f / 64.f);
                const float rs = rsqrtf(var + GN_EPS);
                const f32x4 g = {bflo(gw.x), bfhi(gw.x), bflo(gw.y), bfhi(gw.y)}, v = {bflo(vw.x), bfhi(vw.x), bflo(vw.y), bfhi(vw.y)};
                const f32x4 zv = (d * rs * gg + gb + c3 * v) * g;
                *(u32x2*)(Z + row * D + col) = (u32x2){pk2(zv[0], zv[1]), pk2(zv[2], zv[3])}; }
        }
        LDS_WAIT();
    }
}

__device__ __forceinline__ void p8_norm(Frame& F, const float* g, bf16* U) {
    const float* Hs = (const float*)(F.ws + WS_H); const Row gr = ld_row(g, F.lane);
    for (int t = F.gw; t < T; t += F.NGW) st_row_bf16(U + (size_t)t * D, F.lane, rmsnorm_row(ld_row(Hs + (size_t)t * D, F.lane), gr));
}
__device__ __forceinline__ void p11_norm_forget(Frame& F, const Args& a) {
    const int lane = F.lane; const float* Hs = (const float*)(F.ws + WS_H); bf16* U = (bf16*)(F.ws + WS_U3); float* LF = (float*)(F.ws + WS_LF);
    LAS float* wf = (LAS float*)F.lds;
    __syncthreads();
    for (int i = F.tid; i < 16 * D; i += NTHREADS) { const int hh = i & 15, k = i >> 4; wf[hh * D + k] = a.in[19][(size_t)k * WIN_LD + 4 * D + hh]; }
    __syncthreads();
    const Row gr = ld_row(a.in[1] + 2 * D, lane);
    for (int tg = F.gw; tg < T / 4; tg += F.NGW) {
        Row u[4];
#pragma unroll
        for (int r = 0; r < 4; ++r) { u[r] = rmsnorm_row(ld_row(Hs + (size_t)(4 * tg + r) * D, lane), gr); st_row_bf16(U + (size_t)(4 * tg + r) * D, lane, u[r]); }
        float mine[4] = {0.f, 0.f, 0.f, 0.f};
#pragma unroll 2
        for (int hh = 0; hh < 16; ++hh) { float s4[4] = {0.f, 0.f, 0.f, 0.f};
#pragma unroll
            for (int j = 0; j < 4; ++j) { const f32x4 w = *(const LAS f32x4*)(wf + hh * D + 256 * j + 4 * lane);
#pragma unroll
                for (int r = 0; r < 4; ++r) s4[r] += (u[r].v[j][0] * w[0] + u[r].v[j][1] * w[1]) + (u[r].v[j][2] * w[2] + u[r].v[j][3] * w[3]); }
#pragma unroll
            for (int r = 0; r < 4; ++r) { const float t_ = wave_sum(s4[r]); if (lane == hh) mine[r] = t_; } }
        if (lane < 16) { const float bf_ = a.in[20][lane];
#pragma unroll
            for (int r = 0; r < 4; ++r) { const float x = mine[r] + bf_; LF[(size_t)(4 * tg + r) * 16 + lane] = fminf(x, 0.f) - log1pf(__expf(-fabsf(x))); } }
    }
    __syncthreads();
}
__device__ __forceinline__ void p12_cumsum(Frame& F) {
    if (F.vcu >= NH) return;
    const int tid = F.tid, h = F.vcu;
    const float* LF = (const float*)(F.ws + WS_LF); float* C2 = (float*)(F.ws + WS_C2); float* CB = (float*)(F.ws + WS_CB);
    LAS double* part = (LAS double*)F.lds;
    __syncthreads();
    const int tb = tid * 32; float lf[32]; double s = 0.0;
#pragma unroll
    for (int i = 0; i < 32; ++i) lf[i] = LF[(size_t)(tb + i) * 16 + h];
#pragma unroll
    for (int i = 0; i < 32; ++i) s += (double)lf[i];
    part[tid] = s; __syncthreads();
    if (tid < 64) {
        double v[8], run = 0.0;
#pragma unroll
        for (int i = 0; i < 8; ++i) { v[i] = part[tid * 8 + i]; run += v[i]; }
        double inc = run;
#pragma unroll
        for (int o = 1; o < 64; o <<= 1) { const double nb = __shfl_up(inc, o); if (tid >= o) inc += nb; }
        double ex = inc - run;
#pragma unroll
        for (int i = 0; i < 8; ++i) { part[tid * 8 + i] = ex; ex += v[i]; }
    }
    __syncthreads();
    double run = part[tid];
#pragma unroll
    for (int i = 0; i < 32; ++i) { run += (double)lf[i]; const float c = (float)(run * 1.4426950408889634); C2[(size_t)h * T + tb + i] = c; if (((tb + i) & 63) == 63) CB[h * 256 + ((tb + i) >> 6)] = c; }
    __syncthreads();
}

#ifndef ATTN_STORE16
#define ATTN_STORE16(p,v) (*(u32x4*)(p)=(v))
#endif
namespace attn_body {
using bf16x8=__attribute__((ext_vector_type(8)))short;
using s16x4=__attribute__((ext_vector_type(4)))short;
using f32x16=__attribute__((ext_vector_type(16)))float;
using u32x4=__attribute__((ext_vector_type(4)))unsigned;
constexpr int NHEAD=16,SEQ=16384,D=64,DM=4096,OM=1024;
constexpr int NW=8,QBLK=32,QB=QBLK*NW,KVBLK=64,NQB=SEQ/QB;
constexpr int ATTN_UNIT_ROWS=QB;
__device__ __forceinline__ int crow(int r,int hi){return (r&3)+8*(r>>2)+4*hi;}
#define SBAR() __builtin_amdgcn_sched_barrier(0)
__device__ __forceinline__ void cmask(f32x16&p0,f32x16&p1,int jb,int qrel,int hi){
  const float NEG=-INFINITY; int kb=64*jb+4*hi;
  #pragma unroll
  for(int r=0;r<16;++r){int kv=kb+(r&3)+8*(r>>2); if(kv>qrel)p0[r]=NEG; if(kv+32>qrel)p1[r]=NEG;}
}

constexpr int NSLOT=3, SLOTB=8192;
constexpr int LDS_K=0, LDS_V=NSLOT*SLOTB, LDS_WS=2*NSLOT*SLOTB, LDS_OST=LDS_WS+NW*64*4, LDS_BYTES=LDS_OST+NW*4096;
constexpr float C2=0.125f*1.4426950408889634f;
__device__ __forceinline__ void glds16(const void*gsrc,unsigned lds_dst){unsigned keep;
  asm volatile("s_mov_b32 %0, m0\n\ts_mov_b32 m0, %2\n\ts_nop 0\n\tglobal_load_lds_dwordx4 %1, off\n\ts_mov_b32 m0, %0":"=&s"(keep):"v"(gsrc),"s"(lds_dst):"memory");}
__device__ __forceinline__ float max3f(float a,float b,float c){float r;asm("v_max3_f32 %0, %1, %2, %3":"=v"(r):"v"(a),"v"(b),"v"(c));return r;}
__device__ __forceinline__ float max2f(float a,float b){float r;asm("v_max_f32_e32 %0, %1, %2":"=v"(r):"v"(a),"v"(b));return r;}
__device__ __forceinline__ float fadd_s(float a,float b){float r;asm("v_add_f32_e32 %0, %1, %2":"=v"(r):"v"(a),"v"(b));return r;}
__device__ __forceinline__ float fsub_s(float a,float b){float r;asm("v_sub_f32_e32 %0, %1, %2":"=v"(r):"v"(a),"v"(b));return r;}
typedef float f32x2_t __attribute__((ext_vector_type(2))); typedef __bf16 bf16x2_t __attribute__((ext_vector_type(2)));
__device__ __forceinline__ unsigned cvtpk_s(float lo,float hi){f32x2_t v={lo,hi};bf16x2_t b=__builtin_convertvector(v,bf16x2_t);return __builtin_bit_cast(unsigned,b);}
#define WAIT_BAR(N) asm volatile("s_waitcnt vmcnt(" #N ") lgkmcnt(0)\n\ts_barrier":::"memory")

__device__ __forceinline__ void qkt(f32x16&p0,f32x16&p1,const char*Kslot,const __attribute__((address_space(3))) char*qst,const f32x16&cin0,const f32x16&cin1,int r32,int hi){
  #define QF_(i) (*(const __attribute__((address_space(3))) bf16x8*)(qst+(i)*1024))
  const char*kb=Kslot+hi*1024+r32*16;
  #pragma unroll
  for(int d0=0;d0<4;++d0){
    const bf16x8 b0=*reinterpret_cast<const bf16x8*>(kb+d0*2048);
    const bf16x8 b1=*reinterpret_cast<const bf16x8*>(kb+d0*2048+512);
    const bf16x8 qd=QF_(d0);
    if(d0==0){p0=__builtin_amdgcn_mfma_f32_32x32x16_bf16(b0,qd,cin0,0,0,0);p1=__builtin_amdgcn_mfma_f32_32x32x16_bf16(b1,qd,cin1,0,0,0);}
    else{p0=__builtin_amdgcn_mfma_f32_32x32x16_bf16(b0,qd,p0,0,0,0);p1=__builtin_amdgcn_mfma_f32_32x32x16_bf16(b1,qd,p1,0,0,0);}}
  #undef QF_
}
typedef __attribute__((address_space(3))) const char* lds_cptr;
typedef short v4i16_t __attribute__((ext_vector_type(4)));
__device__ __forceinline__ void kload8(bf16x8*kf,lds_cptr kp){
  kf[0]=*(const __attribute__((address_space(3))) bf16x8*)(kp);      kf[1]=*(const __attribute__((address_space(3))) bf16x8*)(kp+512);
  kf[2]=*(const __attribute__((address_space(3))) bf16x8*)(kp+2048); kf[3]=*(const __attribute__((address_space(3))) bf16x8*)(kp+2560);
  kf[4]=*(const __attribute__((address_space(3))) bf16x8*)(kp+4096); kf[5]=*(const __attribute__((address_space(3))) bf16x8*)(kp+4608);
  kf[6]=*(const __attribute__((address_space(3))) bf16x8*)(kp+6144); kf[7]=*(const __attribute__((address_space(3))) bf16x8*)(kp+6656);
}
__device__ __forceinline__ void kload2(bf16x8*kf,lds_cptr kp,int j){ kf[2*j]=*(const __attribute__((address_space(3))) bf16x8*)(kp+j*2048); kf[2*j+1]=*(const __attribute__((address_space(3))) bf16x8*)(kp+j*2048+512); }
__device__ __forceinline__ s16x4 vtr(lds_cptr p){ return __builtin_bit_cast(s16x4,__builtin_amdgcn_ds_read_tr16_b64_v4i16((__attribute__((address_space(3))) v4i16_t*)p)); }
__device__ __forceinline__ float rowmax(const f32x16&p0,const f32x16&p1){
  float a=max3f(p0[0],p0[1],p1[0]),b=max3f(p0[2],p0[3],p1[1]);a=max3f(a,p1[2],p1[3]);
  #pragma unroll
  for(int r=4;r<16;r+=4){a=max3f(a,p0[r],p0[r+1]);b=max3f(b,p0[r+2],p0[r+3]);a=max3f(a,p1[r],p1[r+1]);b=max3f(b,p1[r+2],p1[r+3]);}
  const float m=max2f(a,b);
  auto rr=__builtin_amdgcn_permlane32_swap(__float_as_uint(m),__float_as_uint(m),false,false);
  return max2f(__uint_as_float(rr[0]),__uint_as_float(rr[1]));
}
__device__ __forceinline__ void pv(f32x16*o,int vb,bf16x8 pa0,bf16x8 pa1,bf16x8 pa2,bf16x8 pa3){
  #pragma unroll
  for(int d0=0;d0<2;++d0){s16x4 lo[4],hi[4];
    #pragma unroll
    for(int ks=0;ks<4;++ks){
      asm volatile("ds_read_b64_tr_b16 %0,%1 offset:%c2":"=&v"(lo[ks]):"v"(vb),"i"(d0*4096+ks*1024):"memory");
      asm volatile("ds_read_b64_tr_b16 %0,%1 offset:%c2":"=&v"(hi[ks]):"v"(vb),"i"(d0*4096+ks*1024+512):"memory");}
    asm volatile("s_waitcnt lgkmcnt(0)":::"memory");SBAR();
    #define PK(k) (bf16x8){lo[k][0],lo[k][1],lo[k][2],lo[k][3],hi[k][0],hi[k][1],hi[k][2],hi[k][3]}
    o[d0]=__builtin_amdgcn_mfma_f32_32x32x16_bf16(pa0,PK(0),o[d0],0,0,0);
    o[d0]=__builtin_amdgcn_mfma_f32_32x32x16_bf16(pa1,PK(1),o[d0],0,0,0);
    o[d0]=__builtin_amdgcn_mfma_f32_32x32x16_bf16(pa2,PK(2),o[d0],0,0,0);
    o[d0]=__builtin_amdgcn_mfma_f32_32x32x16_bf16(pa3,PK(3),o[d0],0,0,0);
    #undef PK
  }
}

#ifndef ATTN_STORE16
#define ATTN_STORE16(p,v) (*(u32x4*)(p)=(v))
#endif
template<int THRL> __device__ __forceinline__ void attn_unit(int h,int qb,int jstart,const bf16*Q,const bf16*__restrict__ K,const bf16*__restrict__ V,const bf16*__restrict__ OG,bf16*O,const float*__restrict__ C2h,char*shm){
  const int tid=threadIdx.x,lane=tid&63,r32=lane&31,hi=lane>>5; const int wid=__builtin_amdgcn_readfirstlane(tid>>6);
  const long rowbase=0; const int q0=qb*QB;
  const bf16*Qw=Q+(rowbase+q0+wid*QBLK)*DM+h*D;
  const bf16*Kh=K+(rowbase+(long)jstart*KVBLK)*DM+h*D,*Vh=V+(rowbase+(long)jstart*KVBLK)*DM+h*D;
  const lds_cptr shm3=(lds_cptr)shm;
  const unsigned lds0=(unsigned)(uintptr_t)shm;
  float*wsf=(float*)(shm+LDS_WS)+wid*64;
  const bf16*ksrc=Kh+(long)lane*DM+wid*8;
  const bf16*vsrc=Vh+(long)(16*(wid&3)+(lane>>2))*DM+(wid>>2)*32+(lane&3)*8;
  const unsigned kdst=lds0+LDS_K+wid*1024, vdst=lds0+LDS_V+wid*1024;
  #define DMA_K(t,slot) glds16(ksrc+(long)(t)*KVBLK*DM,(unsigned)__builtin_amdgcn_readfirstlane(kdst+(slot)))
  #define DMA_V(t,slot) glds16(vsrc+(long)(t)*KVBLK*DM,(unsigned)__builtin_amdgcn_readfirstlane(vdst+(slot)))
  const int vb0=(int)(lds0+LDS_V)+((lane>>4)&1)*32+(lane&3)*8+(4*hi+((lane&15)>>2))*64;
  const char*Kbase=shm+LDS_K; bf16x8 kf[8];
  const lds_cptr kp0=shm3+LDS_K+hi*1024+r32*16; const lds_cptr vp0=shm3+LDS_V+((lane>>4)&1)*32+(lane&3)*8+(4*hi+((lane&15)>>2))*64;
  const int NT=(q0+QB)/KVBLK-jstart;
  DMA_K(0,0);DMA_V(0,0);DMA_K(1,SLOTB);
  typedef __attribute__((address_space(3))) u32x4* lds_rptr; const lds_rptr brec=(lds_rptr)(shm3+LDS_BYTES);
  { const float cref=C2h[q0]; const float*cs=C2h+(long)jstart*KVBLK;
    int tid_e=tid; asm volatile("":"+v"(tid_e));
    for(int i_=tid_e;i_<NT*KVBLK;i_+=NW*64){ const float x_=cref-cs[i_]; const unsigned a1_=f2bf(x_); const float r1_=x_-__uint_as_float(a1_<<16); const unsigned a2_=f2bf(r1_); const float r2_=r1_-__uint_as_float(a2_<<16); const unsigned a3_=f2bf(r2_);
      brec[i_]=(u32x4){a1_|(a2_<<16),a3_,0u,0u}; }
    if(tid==0)brec[NT*KVBLK]=(u32x4){0x3F803F80u,0x00003F80u,0u,0u}; }
  const lds_cptr abp=(lds_cptr)brec+(hi?NT*KVBLK*16:r32*16); const int ast=hi?0:KVBLK*16, ab1=hi?0:32*16;
  #define ABF(t,half) (*(const __attribute__((address_space(3))) bf16x8*)(abp+(t)*ast+(half)*ab1))
  const lds_cptr qst=shm3+LDS_OST+wid*4096+lane*16;
  #pragma unroll
  for(int d0=0;d0<4;++d0){ const u32x4 qv_=*reinterpret_cast<const u32x4*>(&Qw[(long)r32*DM+d0*16+hi*8]); *(__attribute__((address_space(3))) u32x4*)(const_cast<__attribute__((address_space(3))) char*>(qst)+d0*1024)=qv_; }
  #define QF(i) (*(const __attribute__((address_space(3))) bf16x8*)(qst+(i)*1024))
  float mhat=0.f,l_reg=0.f;f32x16 o[2];o[0]=f32x16{};o[1]=f32x16{};
  u32x4 bmw=hi?(u32x4){0u,0u,0u,0u}:(u32x4){0x3F803F80u,0x00003F80u,0u,0u};
  #define SETBM() do{ const float nm_=-mhat; const unsigned a1_=f2bf(nm_); const float r1_=nm_-__uint_as_float(a1_<<16); const unsigned a2_=f2bf(r1_); const float r2_=r1_-__uint_as_float(a2_<<16); const unsigned a3_=f2bf(r2_); if(hi){bmw[0]=a1_|(a2_<<16);bmw[1]=a3_;} }while(0)
  #define BMF() __builtin_bit_cast(bf16x8,bmw)
  const f32x16 zero16=f32x16{};
  const int qrel=wid*QBLK+r32;
  #define CMASK(P0,P1,t) do{int jb_=(t)-(NT-4); if(jb_>=0)cmask(P0,P1,jb_,qrel,hi);}while(0)
  bool resc=false;
  #define START(P0,P1) do{ const float rm=rowmax(P0,P1); resc=false; \
    { const float dl=rm; mhat=fadd_s(mhat,dl); \
      _Pragma("unroll") for(int r=0;r<16;++r){P0[r]=fsub_s(P0[r],dl);P1[r]=fsub_s(P1[r],dl);} \
      SETBM(); } \
    _Pragma("unroll") for(int r=0;r<16;++r)P0[r]=__builtin_amdgcn_exp2f(P0[r]); }while(0)
  #define RESC() do{ if(resc){ asm volatile("s_waitcnt lgkmcnt(0)":::"memory"); \
      _Pragma("unroll") for(int d_=0;d_<2;++d_) _Pragma("unroll") for(int r=0;r<16;++r)o[d_][r]*=wsf[crow(r,hi)]; } }while(0)
  f32x16 pA0,pA1,pB0,pB1;
  int sl_prev=0,sl_cur=0,sl_next=SLOTB;
  #define ROT() do{sl_prev=sl_cur;sl_cur=sl_next;sl_next=(sl_next==(NSLOT-1)*SLOTB)?0:sl_next+SLOTB;}while(0)
  DMA_K(2,2*SLOTB);
  WAIT_BAR(3);
  { const f32x16 c0_=__builtin_amdgcn_mfma_f32_32x32x16_bf16(ABF(0,0),BMF(),zero16,0,0,0), c1_=__builtin_amdgcn_mfma_f32_32x32x16_bf16(ABF(0,1),BMF(),zero16,0,0,0); qkt(pA0,pA1,Kbase,qst,c0_,c1_,r32,hi); }
  asm volatile("s_nop 15\n\ts_nop 7":"+v"(pA0),"+v"(pA1));CMASK(pA0,pA1,0);
  START(pA0,pA1);
  _Pragma("unroll") for(int r=0;r<16;++r)pA1[r]=__builtin_amdgcn_exp2f(pA1[r]);
  WAIT_BAR(0);
  DMA_K(3,0);DMA_V(1,SLOTB);
  ROT();
  kload8(kf,kp0+sl_cur);
  WAIT_BAR(2);
  s16x4 vlo[8],vhi[8]; u32x4 pw0,pw1,pw2,pw3;
  #define PKW(P,B) cvtpk_s(P[B],P[B+1])
  #define PAF(k) __builtin_bit_cast(bf16x8,pw##k)
  #define VFR(i) (bf16x8){vlo[i][0],vlo[i][1],vlo[i][2],vlo[i][3],vhi[i][0],vhi[i][1],vhi[i][2],vhi[i][3]}
  #define PIN(x) asm volatile("":"+v"(x))
  #define MX3(a,b,c) __builtin_fmaxf(__builtin_fmaxf((a),(b)),(c))
  #define GAPA(MF,A0,A1,A2,A3,W0,W1,PW) do{ MF; sacc+=A0; sacc+=A1; sacc+=A2; sacc+=A3; PIN(sacc); W0; W1; PIN(PW); SBAR(); }while(0)
  #define EX(v) __builtin_amdgcn_exp2f(v)
  #define GAPB(MF,X,B) do{ MF; X[B]=EX(X[B]); X[B+1]=EX(X[B+1]); X[B+2]=EX(X[B+2]); X[B+3]=EX(X[B+3]); PIN(X); SBAR(); }while(0)
  #define VRD(i) do{ vlo[i]=vtr(vp_+(((i)>>2)*4096+((i)&3)*1024)); vhi[i]=vtr(vp_+(((i)>>2)*4096+((i)&3)*1024+512)); }while(0)
  #define KRD(G,j) do{ if(G){ kload2(kf,kp0+sl_next,j); SBAR(); } }while(0)
  #define STEP(C0,C1,P0,P1,t,GK,GV,GL) do{ SBAR(); \
    const lds_cptr vp_=vp0+sl_prev; \
    VRD(0); SBAR(); float sacc=(P0[0]+P0[1]); \
    bf16x8 qa_=QF(0); C0=__builtin_amdgcn_mfma_f32_32x32x16_bf16(ABF(t,0),BMF(),zero16,0,0,0); C1=__builtin_amdgcn_mfma_f32_32x32x16_bf16(ABF(t,1),BMF(),zero16,0,0,0); SBAR(); \
    bf16x8 qb_=QF(1); \
    GAPA(C0=__builtin_amdgcn_mfma_f32_32x32x16_bf16(kf[0],qa_,C0,0,0,0), P0[2],P0[3],P0[4],P0[5],     pw0[0]=PKW(P0,0), pw0[1]=PKW(P0,2), pw0); \
    VRD(4); SBAR(); GAPA(C1=__builtin_amdgcn_mfma_f32_32x32x16_bf16(kf[1],qa_,C1,0,0,0), P0[6],P0[7],P0[8],P0[9],     pw0[2]=PKW(P0,4), pw0[3]=PKW(P0,6), pw0); \
    VRD(1); qa_=QF(2); SBAR(); GAPA(C0=__builtin_amdgcn_mfma_f32_32x32x16_bf16(kf[2],qb_,C0,0,0,0),   P0[10],P0[11],P0[12],P0[13], pw1[0]=PKW(P0,8), pw1[1]=PKW(P0,10), pw1); \
    VRD(5); SBAR(); GAPA(C1=__builtin_amdgcn_mfma_f32_32x32x16_bf16(kf[3],qb_,C1,0,0,0),   P0[14],P0[15],P1[0],P1[1],   pw1[2]=PKW(P0,12),pw1[3]=PKW(P0,14), pw1); \
    VRD(2); qb_=QF(3); SBAR(); GAPA(C0=__builtin_amdgcn_mfma_f32_32x32x16_bf16(kf[4],qa_,C0,0,0,0),   P1[2],P1[3],P1[4],P1[5],     pw2[0]=PKW(P1,0), pw2[1]=PKW(P1,2), pw2); \
    VRD(6); SBAR(); GAPA(C1=__builtin_amdgcn_mfma_f32_32x32x16_bf16(kf[5],qa_,C1,0,0,0),   P1[6],P1[7],P1[8],P1[9],     pw2[2]=PKW(P1,4), pw2[3]=PKW(P1,6), pw2); \
    VRD(3); SBAR(); GAPA(C0=__builtin_amdgcn_mfma_f32_32x32x16_bf16(kf[6],qb_,C0,0,0,0),   P1[10],P1[11],P1[12],P1[13], pw3[0]=PKW(P1,8), pw3[1]=PKW(P1,10), pw3); \
    VRD(7); SBAR(); GAPA(C1=__builtin_amdgcn_mfma_f32_32x32x16_bf16(kf[7],qb_,C1,0,0,0),   P1[14],P1[15],0.f,0.f,       pw3[2]=PKW(P1,12),pw3[3]=PKW(P1,14), pw3); \
    l_reg+=sacc; \
    if(GK){DMA_K((t)+3,sl_cur);} if(GV){DMA_V((t)+1,sl_next);} \
    CMASK(C0,C1,t); \
    { float a=MX3(C0[0],C0[1],C1[0]),b=MX3(C0[2],C0[3],C1[1]); a=MX3(a,C1[2],C1[3]); \
      _Pragma("unroll") for(int r=4;r<16;r+=4){a=MX3(a,C0[r],C0[r+1]);b=MX3(b,C0[r+2],C0[r+3]);a=MX3(a,C1[r],C1[r+1]);b=MX3(b,C1[r+2],C1[r+3]);} \
      float rm=__builtin_fmaxf(a,b); { auto rr=__builtin_amdgcn_permlane32_swap(__float_as_uint(rm),__float_as_uint(rm),false,false); rm=__builtin_fmaxf(__uint_as_float(rr[0]),__uint_as_float(rr[1])); } \
      resc=false; \
      if(__builtin_expect(__any(rm>(float)THRL),0)){ const float dl=__builtin_fmaxf(rm,0.f); mhat+=dl; \
        _Pragma("unroll") for(int r=0;r<16;++r){C0[r]-=dl;C1[r]-=dl;} \
        SETBM(); \
        const float f=__builtin_amdgcn_exp2f(-dl); l_reg*=f; if(hi==0)wsf[r32]=f; resc=true; } } \
    SBAR(); \
    GAPB(o[0]=__builtin_amdgcn_mfma_f32_32x32x16_bf16(PAF(0),VFR(0),o[0],0,0,0), C0,0); \
    GAPB(o[1]=__builtin_amdgcn_mfma_f32_32x32x16_bf16(PAF(0),VFR(4),o[1],0,0,0), C0,4); \
    KRD(GL,0); GAPB(o[0]=__builtin_amdgcn_mfma_f32_32x32x16_bf16(PAF(1),VFR(1),o[0],0,0,0), C0,8); \
    KRD(GL,1); GAPB(o[1]=__builtin_amdgcn_mfma_f32_32x32x16_bf16(PAF(1),VFR(5),o[1],0,0,0), C0,12); \
    KRD(GL,2); GAPB(o[0]=__builtin_amdgcn_mfma_f32_32x32x16_bf16(PAF(2),VFR(2),o[0],0,0,0), C1,0); \
    KRD(GL,3); GAPB(o[1]=__builtin_amdgcn_mfma_f32_32x32x16_bf16(PAF(2),VFR(6),o[1],0,0,0), C1,4); \
    GAPB(o[0]=__builtin_amdgcn_mfma_f32_32x32x16_bf16(PAF(3),VFR(3),o[0],0,0,0), C1,8); \
    GAPB(o[1]=__builtin_amdgcn_mfma_f32_32x32x16_bf16(PAF(3),VFR(7),o[1],0,0,0), C1,12); \
    }while(0)
  int t=1;
  #undef CMASK
  #define CMASK(P0,P1,t) do{}while(0)
  for(;t+5<NT;t+=2){
    STEP(pB0,pB1,pA0,pA1,t,true,true,true);     WAIT_BAR(2); RESC(); ROT();
    STEP(pA0,pA1,pB0,pB1,t+1,true,true,true);   WAIT_BAR(2); RESC(); ROT();
  }
  #undef CMASK
  #define CMASK(P0,P1,t) do{int jb_=(t)-(NT-4); if(jb_>=0)cmask(P0,P1,jb_,qrel,hi);}while(0)
  #define ENDW(tt) do{ if((tt)+3<NT){WAIT_BAR(2);} else if((tt)+2<NT){WAIT_BAR(1);} else {WAIT_BAR(0);} }while(0)
  for(;t+1<NT;t+=2){
    STEP(pB0,pB1,pA0,pA1,t,(t+3<NT),(t+1<NT),(t+1<NT));       ENDW(t);   RESC(); ROT();
    STEP(pA0,pA1,pB0,pB1,t+1,(t+4<NT),(t+2<NT),(t+2<NT));     ENDW(t+1); RESC(); ROT();
  }
  STEP(pB0,pB1,pA0,pA1,NT-1,false,false,false); RESC();
  { float sacc=pB0[0]+pB0[1]; _Pragma("unroll") for(int r=2;r<16;++r)sacc+=pB0[r]; _Pragma("unroll") for(int r=0;r<16;++r)sacc+=pB1[r]; l_reg+=sacc;
    pw0=(u32x4){PKW(pB0,0),PKW(pB0,2),PKW(pB0,4),PKW(pB0,6)};pw1=(u32x4){PKW(pB0,8),PKW(pB0,10),PKW(pB0,12),PKW(pB0,14)};pw2=(u32x4){PKW(pB1,0),PKW(pB1,2),PKW(pB1,4),PKW(pB1,6)};pw3=(u32x4){PKW(pB1,8),PKW(pB1,10),PKW(pB1,12),PKW(pB1,14)};
    SBAR(); pv(o,vb0+sl_cur,PAF(0),PAF(1),PAF(2),PAF(3)); }
  #undef PKW
  #undef PAF
  #undef VFR
  #undef PIN
  #undef MX3
  #undef GAPA
  #undef GAPB
  #undef EX
  #undef VRD
  #undef KRD
  #undef STEP
  #undef ENDW
  {auto rr=__builtin_amdgcn_permlane32_swap(__float_as_uint(l_reg),__float_as_uint(l_reg),false,false);l_reg=__uint_as_float(rr[0])+__uint_as_float(rr[1]);}
  int lane_e=lane; asm volatile("":"+v"(lane_e));
  const int r32e=lane_e&31,hie=lane_e>>5;
  if(hie==0)wsf[32+r32e]=l_reg;asm volatile("s_waitcnt lgkmcnt(0)":::"memory");
  float rli[16];
  #pragma unroll
  for(int r=0;r<16;++r)rli[r]=__builtin_amdgcn_rcpf(wsf[32+crow(r,hie)]);
  bf16*Ow=O+(rowbase+q0+wid*QBLK)*OM+h*D; const bf16*OGw=OG+(rowbase+q0+wid*QBLK)*DM+h*D;
  { bf16*stg=(bf16*)(shm+LDS_OST)+wid*2048;
    #pragma unroll
    for(int r=0;r<16;++r){const int orow=crow(r,hie);
      #pragma unroll
      for(int d0=0;d0<2;++d0)stg[orow*64+d0*32+r32e]=(bf16)f2bf(o[d0][r]*rli[r]);}
    asm volatile("s_waitcnt lgkmcnt(0)":::"memory");
    #pragma unroll
    for(int i=0;i<4;++i){const int row=i*8+(lane_e>>3),ch=lane_e&7; const u32x4 v=*(const u32x4*)(stg+row*64+ch*8); const u32x4 g=*(const u32x4*)(OGw+(long)row*DM+ch*8); u32x4 w;
      #pragma unroll
      for(int e=0;e<4;++e){ const float lo=bflo(v[e])*sigmoidf_(bflo(g[e])), hh_=bfhi(v[e])*sigmoidf_(bfhi(g[e])); w[e]=pk2(lo,hh_); }
      ATTN_STORE16(Ow+(long)row*OM+ch*8,w);} }
  asm volatile("s_waitcnt lgkmcnt(0)\n\ts_barrier":::"memory");
  #undef QF
  #undef ABF
  #undef SETBM
  #undef BMF
  #undef DMA_K
  #undef DMA_V
  #undef CMASK
  #undef START
  #undef RESC
  #undef ROT
}
constexpr int ATTN_LDS_BYTES=LDS_BYTES;
#undef SBAR
#undef WAIT_BAR
}

constexpr int KP = 144;
__device__ __forceinline__ void p14_attention(Frame& F, const Args& a, int qword = CW_ATTQ) {
    const int tid0 = F.tid, lane0 = F.lane;
    const bf16* QKVG = (const bf16*)(F.ws + WS_QKVG); const float* C2 = (const float*)(F.ws + WS_C2); const float* CB = (const float*)(F.ws + WS_CB);
    bf16* Z2 = (bf16*)(F.ws + WS_Z2);
    LAS unsigned char* Ks = F.lds; LAS unsigned char* Vs = F.lds + 64 * KP; LAS float* bias = (LAS float*)(F.lds + 2 * 64 * KP); LAS int* uslot = (LAS int*)(F.lds + RING_BYTES + 192);
    constexpr int ATT_MAXT = (RING_BYTES - attn_body::ATTN_LDS_BYTES - 16) / 1024;
    float mq = 0.f, mk = 0.f;
    for (int i = 0; i < 64; ++i) { mq = fmaxf(mq, fabsf(a.in[21][i])); mk = fmaxf(mk, fabsf(a.in[22][i])); }
    const float THR2 = (2.f * 8.f * mq * mk * 1.01f + 30.f) * LOG2E;
    gu32* qctr = F.ctl + qword;
    LAS int* horder = (LAS int*)(F.lds + RING_BYTES + 256);
    __syncthreads();
    if (tid0 < NH) { const float mine = C2[(size_t)tid0 * T + T - 1]; int rank = 0;
        for (int o = 0; o < NH; ++o) { const float other = C2[(size_t)o * T + T - 1]; rank += (other > mine || (other == mine && o < tid0)) ? 1 : 0; }
        horder[rank] = tid0; }
    __syncthreads();
    for (;;) {
        __syncthreads();
        if (tid0 == 0) uslot[0] = (int)__hip_atomic_fetch_add(qctr, 1u, RLX_AGENT);
        __syncthreads();
        const int unit = uslot[0];
        if (unit >= NH * (T / 256)) break;
        const int h = horder[unit >> 6], qb = (T / 256 - 1) - (unit & 63), q0 = qb * 256;
        const float ct0 = C2[(size_t)h * T + q0];
        int jstart = 0;
        { int tot = 0; for (int j0 = 0; j0 < 4 * qb; j0 += 64) { const int j = j0 + lane0; const bool skip = (j < 4 * qb) && ((ct0 - CB[h * 256 + j]) < -THR2); tot += __popcll(__ballot(skip)); } jstart = tot; }
        jstart &= ~1;
        if (4 * qb + 4 - jstart <= ATT_MAXT) {
            attn_body::attn_unit<8>(h, qb, jstart, QKVG, QKVG + D, QKVG + 2 * D, QKVG + 3 * D, Z2, C2 + (size_t)h * T, (char*)F.lds);
            continue;
        }
        int tid_s = F.tid; asm volatile("" : "+v"(tid_s));
        const int tid = tid_s, lane = tid & 63, wid = F.wave, r32 = lane & 31, hi = lane >> 5;
        const int jend = 4 * qb + 3;
        const int qrow = q0 + wid * 32 + r32;
        bf16x8 qr[4];
#pragma unroll
        for (int d0 = 0; d0 < 4; ++d0) qr[d0] = *(const bf16x8*)(QKVG + (size_t)qrow * 4096 + h * 64 + d0 * 16 + hi * 8);
        f32x16 o0 = {}, o1 = {}; float m = -INFINITY, l = 0.f;
        const int lrow = tid >> 3, lch = tid & 7;
        u32x4 kreg, vreg; float breg = 0.f;
        auto gload = [&](int j) { const size_t row = (size_t)(64 * j + lrow) * 4096 + h * 64 + lch * 8;
            kreg = *(const u32x4*)(QKVG + row + D); vreg = *(const u32x4*)(QKVG + row + 2 * D); if (tid < 64) breg = -C2[(size_t)h * T + 64 * j + tid]; };
        gload(jstart);
        for (int j = jstart; j <= jend; ++j) {
            __syncthreads();
            *(LAS u32x4*)(Ks + lrow * KP + lch * 16) = kreg;
            { const int s_ = lrow >> 4, x_ = lrow & 15, p_ = s_ * 16 + ((x_ >> 2) & 1) * 8 + (((x_ >> 3) << 2) | (x_ & 3));
                const unsigned w_[4] = {vreg.x, vreg.y, vreg.z, vreg.w};
#pragma unroll
                for (int e = 0; e < 8; ++e) *(LAS unsigned short*)(Vs + (lch * 8 + e) * KP + p_ * 2) = (unsigned short)(w_[e >> 1] >> ((e & 1) * 16)); }
            if (tid < 64) bias[tid] = breg;
            __syncthreads();
            if (j < jend) gload(j + 1);
            f32x16 p0 = {}, p1 = {};
#pragma unroll
            for (int d0 = 0; d0 < 4; ++d0) {
                const bf16x8 k0 = *(const LAS bf16x8*)(Ks + r32 * KP + d0 * 32 + hi * 16);
                const bf16x8 k1 = *(const LAS bf16x8*)(Ks + (32 + r32) * KP + d0 * 32 + hi * 16);
                p0 = __builtin_amdgcn_mfma_f32_32x32x16_bf16(k0, qr[d0], p0, 0, 0, 0);
                p1 = __builtin_amdgcn_mfma_f32_32x32x16_bf16(k1, qr[d0], p1, 0, 0, 0);
            }
#pragma unroll
            for (int g4 = 0; g4 < 4; ++g4) { const f32x4 b0 = *(const LAS f32x4*)(bias + 8 * g4 + 4 * hi), b1 = *(const LAS f32x4*)(bias + 32 + 8 * g4 + 4 * hi);
#pragma unroll
                for (int i = 0; i < 4; ++i) { p0[4 * g4 + i] += b0[i]; p1[4 * g4 + i] += b1[i]; } }
            if (j >= 4 * qb) {
                const int kb = 64 * j;
#pragma unroll
                for (int r = 0; r < 16; ++r) { const int kv = kb + crow(r, hi); if (kv > qrow) p0[r] = -INFINITY; if (kv + 32 > qrow) p1[r] = -INFINITY; }
            }
            float mloc = fmaxf(p0[0], p1[0]);
#pragma unroll
            for (int r = 1; r < 16; ++r) mloc = fmaxf(mloc, fmaxf(p0[r], p1[r]));
            mloc = fmaxf(mloc, __shfl_xor(mloc, 32));
            const float mnew = fmaxf(m, mloc);
            const float alpha = exp2f(m - mnew);
            float ls = 0.f;
#pragma unroll
            for (int r = 0; r < 16; ++r) { p0[r] = exp2f(p0[r] - mnew); p1[r] = exp2f(p1[r] - mnew); ls += p0[r] + p1[r]; }
            l = l * alpha + ls; m = mnew;
#pragma unroll
            for (int r = 0; r < 16; ++r) { o0[r] *= alpha; o1[r] *= alpha; }
#pragma unroll
            for (int s = 0; s < 4; ++s) {
                u32x4 pw;
                if (s == 0) pw = (u32x4){pk2(p0[0], p0[1]), pk2(p0[2], p0[3]), pk2(p0[4], p0[5]), pk2(p0[6], p0[7])};
                else if (s == 1) pw = (u32x4){pk2(p0[8], p0[9]), pk2(p0[10], p0[11]), pk2(p0[12], p0[13]), pk2(p0[14], p0[15])};
                else if (s == 2) pw = (u32x4){pk2(p1[0], p1[1]), pk2(p1[2], p1[3]), pk2(p1[4], p1[5]), pk2(p1[6], p1[7])};
                else pw = (u32x4){pk2(p1[8], p1[9]), pk2(p1[10], p1[11]), pk2(p1[12], p1[13]), pk2(p1[14], p1[15])};
                const bf16x8 pf = __builtin_bit_cast(bf16x8, pw);
                const bf16x8 v0 = *(const LAS bf16x8*)(Vs + r32 * KP + s * 32 + hi * 16);
                const bf16x8 v1 = *(const LAS bf16x8*)(Vs + (32 + r32) * KP + s * 32 + hi * 16);
                o0 = __builtin_amdgcn_mfma_f32_32x32x16_bf16(v0, pf, o0, 0, 0, 0);
                o1 = __builtin_amdgcn_mfma_f32_32x32x16_bf16(v1, pf, o1, 0, 0, 0);
            }
        }
        l += __shfl_xor(l, 32);
        const float rl = 1.f / l;
#pragma unroll
        for (int dt = 0; dt < 2; ++dt)
#pragma unroll
            for (int g4 = 0; g4 < 4; ++g4) { const int d = 32 * dt + 8 * g4 + 4 * hi; const size_t col = (size_t)h * 64 + d;
                const u32x2 ogw = *(const u32x2*)(QKVG + (size_t)qrow * 4096 + 3 * D + col);
                const float og[4] = {bflo(ogw.x), bfhi(ogw.x), bflo(ogw.y), bfhi(ogw.y)}; float ov[4];
#pragma unroll
                for (int i = 0; i < 4; ++i) ov[i] = (dt == 0 ? o0[4 * g4 + i] : o1[4 * g4 + i]) * rl * sigmoidf_(og[i]);
                u32x2 w; w.x = pk2(ov[0], ov[1]); w.y = pk2(ov[2], ov[3]);
                *(u32x2*)(Z2 + (size_t)qrow * D + col) = w; }
    }
}

struct TokInfo { int e0, e1, p0, p1; float g0, g1; int d0, d1; };
__device__ __forceinline__ void p16_router(Frame& F, const Args& a) {
    const int lane = F.lane, tid = F.tid; const float* Hs = (const float*)(F.ws + WS_H); bf16* U = (bf16*)(F.ws + WS_U4);
    TokInfo* TI = (TokInfo*)(F.ws + WS_TOK);
    LAS float* wr_ = (LAS float*)F.lds;
    LAS int* lcnt = (LAS int*)(F.lds + 32768);
    const Row gr = ld_row(a.in[1] + 3 * D, lane);
    __syncthreads();
    for (int i = tid; i < NE * D; i += NTHREADS) { const int e = i & 7, k = i >> 3; wr_[e * D + k] = a.in[26][(size_t)k * NE + e]; }
    for (int tb = F.vcu * 64; tb < T; tb += F.G * 64) {
        __syncthreads();
        if (tid < 16) lcnt[tid] = 0;
        __syncthreads();
        int e0s[8], e1s[8], p0s[8], p1s[8]; float g0s[8];
#pragma unroll
        for (int qq = 0; qq < 2; ++qq) {
            Row u[4];
#pragma unroll
            for (int r = 0; r < 4; ++r) { const int t = tb + F.wave * 8 + 4 * qq + r; u[r] = rmsnorm_row(ld_row(Hs + (size_t)t * D, lane), gr); st_row_bf16(U + (size_t)t * D, lane, u[r]); }
            float lg[4][NE];
#pragma unroll
            for (int e = 0; e < NE; ++e) { float s4[4] = {0.f, 0.f, 0.f, 0.f};
#pragma unroll
                for (int j = 0; j < 4; ++j) { const f32x4 w = *(const LAS f32x4*)(wr_ + e * D + 256 * j + 4 * lane);
#pragma unroll
                    for (int r = 0; r < 4; ++r) s4[r] += (u[r].v[j][0] * w[0] + u[r].v[j][1] * w[1]) + (u[r].v[j][2] * w[2] + u[r].v[j][3] * w[3]); }
#pragma unroll
                for (int r = 0; r < 4; ++r) lg[r][e] = wave_sum(s4[r]); }
#pragma unroll
            for (int r = 0; r < 4; ++r) { const int q = 4 * qq + r;
                int b0 = 0; float v0 = lg[r][0];
#pragma unroll
                for (int e = 1; e < NE; ++e) if (lg[r][e] > v0) { v0 = lg[r][e]; b0 = e; }
                int b1 = -1; float v1 = -INFINITY;
#pragma unroll
                for (int e = 0; e < NE; ++e) if (e != b0 && lg[r][e] > v1) { v1 = lg[r][e]; b1 = e; }
                e0s[q] = b0; e1s[q] = b1; g0s[q] = 1.f / (1.f + __expf(v1 - v0));
                int pa = 0, pb = 0;
                if (lane == 0) { pa = atomicAdd((int*)&lcnt[b0], 1); pb = atomicAdd((int*)&lcnt[b1], 1); }
                p0s[q] = pa; p1s[q] = pb; }
        }
        __syncthreads();
        if (tid < NE) lcnt[8 + tid] = (int)__hip_atomic_fetch_add(F.ctl + CW_CNT + 64 * tid, (unsigned)lcnt[tid], RLX_AGENT);
        __syncthreads();
        if (lane == 0) {
#pragma unroll
            for (int q = 0; q < 8; ++q) { const int t = tb + F.wave * 8 + q; TokInfo ti; ti.e0 = e0s[q]; ti.e1 = e1s[q]; ti.p0 = lcnt[8 + e0s[q]] + p0s[q]; ti.p1 = lcnt[8 + e1s[q]] + p1s[q];
                ti.g0 = g0s[q]; ti.g1 = 1.f - g0s[q]; ti.d0 = 0; ti.d1 = 0; TI[t] = ti; }
        }
    }
    __syncthreads();
}
__device__ __forceinline__ int moe_ends(Frame& F, LAS int* ends) {
    __syncthreads();
    if (F.tid == 0) { int run = 0; for (int e = 0; e < NE; ++e) { const int c = (int)__hip_atomic_load(F.ctl + CW_CNT + 64 * e, RLX_AGENT); run += (c + 255) >> 8; ends[e] = run; } }
    __syncthreads();
    return ends[NE - 1];
}
__device__ __forceinline__ void p17_gather(Frame& F) {
    LAS int* ends = (LAS int*)(F.lds + RING_BYTES);
    moe_ends(F, ends);
    const bf16* U = (const bf16*)(F.ws + WS_U4); bf16* AM = (bf16*)(F.ws + WS_AM); TokInfo* TI = (TokInfo*)(F.ws + WS_TOK);
    for (int t = F.gw; t < T; t += F.NGW) {
        const TokInfo ti = TI[t];
        const int d0 = (ti.e0 ? ends[ti.e0 - 1] : 0) * 256 + ti.p0, d1 = (ti.e1 ? ends[ti.e1 - 1] : 0) * 256 + ti.p1;
        const u32x4* src = (const u32x4*)(U + (size_t)t * D) + F.lane; const u32x4 x0 = src[0], x1 = src[64];
        u32x4* o0 = (u32x4*)(AM + (size_t)d0 * D) + F.lane; o0[0] = x0; o0[64] = x1;
        u32x4* o1 = (u32x4*)(AM + (size_t)d1 * D) + F.lane; o1[0] = x0; o1[64] = x1;
        if (F.lane == 0) { TI[t].d0 = d0; TI[t].d1 = d1; }
    }
}
__device__ __forceinline__ void p20_combine(Frame& F, const Args& a) {
    const int lane = F.lane; const float* Hs = (const float*)(F.ws + WS_H); const bf16* YS = (const bf16*)(F.ws + WS_YS); const bf16* YSK = (const bf16*)(F.ws + WS_YSK); const TokInfo* TI = (const TokInfo*)(F.ws + WS_TOK);
    const Row gr = ld_row(a.in[2], lane);
    for (int t = F.gw; t < T; t += F.NGW) {
        const TokInfo ti = TI[t];
        Row hrow = ld_row(Hs + (size_t)t * D, lane);
#pragma unroll
        for (int which = 0; which < 2; ++which) { const int d = which ? ti.d1 : ti.d0; const float gw = which ? ti.g1 : ti.g0;
            if (d < MOE_RB1 * 256) { const Row y = ld_row_bf16(YS + (size_t)d * D, lane);
#pragma unroll
                for (int j = 0; j < 4; ++j) hrow.v[j] = hrow.v[j] + gw * y.v[j]; }
            else {
#pragma unroll
                for (int ks = 0; ks < MOE_TKS; ++ks) { const Row y = ld_row_bf16(YSK + ((size_t)ks * MOE_TROWS + (size_t)(d - MOE_RB1 * 256)) * D, lane);
#pragma unroll
                    for (int j = 0; j < 4; ++j) hrow.v[j] = hrow.v[j] + gw * y.v[j]; } } }
        st_row(a.out + (size_t)t * D, lane, rmsnorm_row(hrow, gr));
    }
}

constexpr int N_PHASES = 21;
__global__ void __launch_bounds__(NTHREADS, 2) trunk_fwd(Args args) {
    extern __shared__ __attribute__((aligned(16))) unsigned char lds_raw[];
    Frame F;
    F.lds = (LAS unsigned char*)lds_raw; F.ws = args.ws; F.ctl = (gu32*)(args.ws + WS_CTL);
    F.tid = threadIdx.x; F.lane = F.tid & 63; F.wave = __builtin_amdgcn_readfirstlane(F.tid >> 6);
    F.G = gridDim.x; { const int bx = blockIdx.x; F.vcu = (F.G % 8 == 0) ? (bx % 8) * (F.G / 8) + bx / 8 : bx; }
    F.gw = F.vcu * NWAVES + F.wave; F.NGW = F.G * NWAVES;
    volatile LAS unsigned* MISC = (volatile LAS unsigned*)(F.lds + MISC_OFF);
    for (int u = F.tid; u < (LDS_BYTES - RING_BYTES) / 4; u += NTHREADS) ((LAS unsigned*)(F.lds + RING_BYTES))[u] = 0u;
    __syncthreads();
    const int lo = args.ph_lo, hi = args.ph_hi;
    const bool use_bar = (hi - lo) > 1;
    XcdBarrier bar; bar.bar = (unsigned*)(F.ctl + CW_BAR); bar.x = 0; bar.st = nullptr;
    if (use_bar) bar = xcd_barrier_post((unsigned*)(F.ctl + CW_BAR), MISC + 8);
#ifdef ONLY_PHASE
#define IN(k) ((k) == ONLY_PHASE && lo <= (k) && (k) < hi)
#else
#define IN(k) (lo <= (k) && (k) < hi)
#endif
#define SEAM(k) do { if (IN((k) + 1)) xcd_barrier(bar); } while (0)
    unsigned char* ws = args.ws;
    const int c = (int)blockIdx.x;
    LAS unsigned char* ring = F.lds;

    if (IN(0)) { p0_prologue(F, args); p1_shift(F, args); p0_moe_weights(F, args, F.vcu, F.G, 1); } SEAM(0);
    if (IN(1)) {
        { pg8::Gemm g{D, 2 * D, 2 * D}; pg8::SchedPlain S; S.o.init(T / 256, 1, F.G, c); S.A = (const char*)(ws + WS_UB); S.B = (const char*)(ws + WS_W_L1); S.astep = (size_t)256 * D * 2; S.bstep = (size_t)256 * 2 * D * 2;
          pg8::EpiL1 E{(bf16*)(ws + WS_L1)};
          pg8::gemm_phase<pg8::EpiL1, pg8::SchedPlain, true>(ring, g, S, E); }
        { pg8::Gemm g{D, D, D}; pg8::SchedRKV S; S.o.init(T / 256, 12, F.G, c, F.G == 256 ? 64 : 0, 1); S.A = (const char*)(ws + WS_XS); S.B = (const char*)(ws + WS_W_RKV); S.astep = (size_t)256 * D * 2; S.bstep = (size_t)256 * D * 2; S.azstride = (size_t)T * D * 2;
          pg8::EpiRKV E{(bf16*)(ws + WS_R), (size_t)(WS_K - WS_R) / 2};
          pg8::gemm_phase<pg8::EpiRKV, pg8::SchedRKV, true>(ring, g, S, E); }
        } SEAM(1);
    if (IN(2)) {
        pg8::Gemm g{256, 256, 256}; pg8::SchedPlain S; S.o.init(T / 256, 12, F.G, c); S.A = (const char*)(ws + WS_L1); S.B = (const char*)(ws + WS_W_L2); S.astep = (size_t)256 * 256 * 2; S.bstep = (size_t)256 * 256 * 2;
        pg8::EpiL2 E{(float*)(ws + WS_LW), (bf16*)(ws + WS_AA), (bf16*)(ws + WS_G), args.in[5], args.in[8]};
        pg8::gemm_phase<pg8::EpiL2, pg8::SchedPlain, true>(ring, g, S, E);
        } SEAM(2);
    if (IN(3)) { p3_prep(F, args); } SEAM(3);
    if (IN(4)) { pa_chunk(F); } SEAM(4);
    if (IN(5)) { pb_chain(F);
        if (F.G == 256 && (F.vcu & 31) >= 8) p0_moe_weights(F, args, (F.vcu >> 5) * 24 + (F.vcu & 31) - 8, 192, 0);
        else if (F.G != 256) p0_moe_weights(F, args, F.vcu, F.G, 0); } SEAM(5);
    if (IN(6)) { pc_out(F, args); } SEAM(6);
    if (IN(7)) {
        pg8::Gemm g{D, D, D}; pg8::SchedPlain S; S.o.init(T / 256, 4, F.G, c); S.A = (const char*)(ws + WS_Z); S.B = (const char*)(ws + WS_W_O0); S.astep = (size_t)256 * D * 2; S.bstep = (size_t)256 * D * 2;
        pg8::EpiRes E{args.in[0], (float*)(ws + WS_H)};
        pg8::gemm_phase<pg8::EpiRes, pg8::SchedPlain, true>(ring, g, S, E);
        } SEAM(7);
    if (IN(8)) { p8_norm(F, args.in[1] + D, (bf16*)(ws + WS_U2)); } SEAM(8);
    if (IN(9)) {
        pg8::Gemm g{D, D, D}; pg8::SchedPlain S; S.o.init(T / 256, 2 * FF / 256, F.G, c); S.A = (const char*)(ws + WS_U2); S.B = (const char*)(ws + WS_W_GU); S.astep = (size_t)256 * D * 2; S.bstep = (size_t)256 * D * 2;
        pg8::EpiSwiGLU E{(bf16*)(ws + WS_ACT)};
        pg8::gemm_phase<pg8::EpiSwiGLU, pg8::SchedPlain, true>(ring, g, S, E);
        }
    SEAM(9);
    if (IN(10)) {
        pg8::Gemm g{FF, FF, FF}; pg8::SchedPlain S; S.o.init(T / 256, 4, F.G, c); S.A = (const char*)(ws + WS_ACT); S.B = (const char*)(ws + WS_W_DN); S.astep = (size_t)256 * FF * 2; S.bstep = (size_t)256 * FF * 2;
        pg8::EpiRes E{(const float*)(ws + WS_H), (float*)(ws + WS_H)};
        pg8::gemm_phase<pg8::EpiRes, pg8::SchedPlain, true>(ring, g, S, E);
        } SEAM(10);
    if (IN(11)) { p11_norm_forget(F, args); } SEAM(11);
    if (IN(12)) {
        pg8::Gemm g{D, D, D}; pg8::SchedPlain S; S.o.init(T / 256, 16, F.G, c); S.A = (const char*)(ws + WS_U3); S.B = (const char*)(ws + WS_W_IN); S.astep = (size_t)256 * D * 2; S.bstep = (size_t)256 * D * 2;
        p12_cumsum(F);
        pg8::EpiQKVG E{(bf16*)(ws + WS_QKVG), args.in[21], args.in[22]};
        pg8::gemm_phase<pg8::EpiQKVG, pg8::SchedPlain, true>(ring, g, S, E);
        } SEAM(12);
    if (IN(13)) { p14_attention(F, args, CW_ATTQ); } SEAM(13);
    if (IN(14)) {
        pg8::Gemm g{D, D, D}; pg8::SchedPlain S; S.o.init(T / 256, 4, F.G, c); S.A = (const char*)(ws + WS_Z2); S.B = (const char*)(ws + WS_W_FO); S.astep = (size_t)256 * D * 2; S.bstep = (size_t)256 * D * 2;
        pg8::EpiRes E{(const float*)(ws + WS_H), (float*)(ws + WS_H)};
        pg8::gemm_phase<pg8::EpiRes, pg8::SchedPlain, true>(ring, g, S, E);
        } SEAM(14);
    if (IN(15)) { p16_router(F, args); } SEAM(15);
    if (IN(16)) { p17_gather(F); } SEAM(16);
    if (IN(17)) {
        LAS int* ends = (LAS int*)(F.lds + RING_BYTES); const int nblk = moe_ends(F, ends);
        pg8::Gemm g{D, D, D}; pg8::SchedMoe S; S.o.init(nblk, 2 * FF / 256, F.G, c); S.A = (const char*)(ws + WS_AM); S.B = (const char*)(ws + WS_W_MGU); S.astep = (size_t)256 * D * 2; S.bstep = (size_t)256 * D * 2; S.bestride = (size_t)2 * FF * D * 2; S.ends = ends;
        pg8::EpiSwiGLU E{(bf16*)(ws + WS_ACT2)};
        pg8::gemm_phase<pg8::EpiSwiGLU, pg8::SchedMoe, true>(ring, g, S, E);
        } SEAM(17);
    if (IN(18)) {
        LAS int* ends = (LAS int*)(F.lds + RING_BYTES); const int nblk = moe_ends(F, ends);
        { pg8::Gemm g{FF, FF, FF}; pg8::SchedMoeK S; S.o.init(nblk < MOE_RB1 ? nblk : MOE_RB1, 4, F.G, c); S.A = (const char*)(ws + WS_ACT2); S.B = (const char*)(ws + WS_W_MDN); S.astep = (size_t)256 * FF * 2; S.bstep = (size_t)256 * FF * 2; S.bestride = (size_t)D * FF * 2;
          S.kbytes = 0; S.ends = ends; S.pm0 = 0;
          pg8::EpiBf16K E{(bf16*)(ws + WS_YS), 0};
          pg8::gemm_phase<pg8::EpiBf16K, pg8::SchedMoeK, true>(ring, g, S, E); }
        if (nblk > MOE_RB1) { pg8::Gemm g{FF, FF, FF / MOE_TKS}; pg8::SchedMoeK S; S.o.init(nblk - MOE_RB1, 4 * MOE_TKS, F.G, c); S.A = (const char*)(ws + WS_ACT2); S.B = (const char*)(ws + WS_W_MDN); S.astep = (size_t)256 * FF * 2; S.bstep = (size_t)256 * FF * 2; S.bestride = (size_t)D * FF * 2;
          S.kbytes = (size_t)(FF / MOE_TKS) * 2; S.ends = ends; S.pm0 = MOE_RB1;
          pg8::EpiBf16K E{(bf16*)(ws + WS_YSK), (size_t)MOE_TROWS * D};
          pg8::gemm_phase<pg8::EpiBf16K, pg8::SchedMoeK, true>(ring, g, S, E); }
        } SEAM(18);
    if (IN(19)) { p20_combine(F, args); }
#undef IN
#undef SEAM
}

extern "C" void kernel_launch(void* const* d_in, const int* in_sizes, int n_in, void* d_out, int out_size, void* d_ws, size_t ws_size, hipStream_t stream) {
    static int grid = 0;
    if (grid == 0) {
        if (n_in != 29 || out_size != T * D || ws_size < WS_END) { fprintf(stderr, "kernel_launch: unexpected problem (n_in %d out %d ws %zu)\n", n_in, out_size, ws_size); grid = -1; return; }
        int dev = 0, cus = 0;
        if (hipGetDevice(&dev) != hipSuccess || hipDeviceGetAttribute(&cus, hipDeviceAttributeMultiprocessorCount, dev) != hipSuccess) { grid = -1; return; }
        if (hipFuncSetAttribute((const void*)trunk_fwd, hipFuncAttributeMaxDynamicSharedMemorySize, LDS_BYTES) != hipSuccess) { fprintf(stderr, "kernel_launch: hipFuncSetAttribute failed\n"); grid = -1; return; }
        int per_cu = 0;
        if (hipOccupancyMaxActiveBlocksPerMultiprocessor(&per_cu, (const void*)trunk_fwd, NTHREADS, LDS_BYTES) != hipSuccess || per_cu < 1) fprintf(stderr, "kernel_launch: occupancy query says %d\n", per_cu);
        (void)hipGetLastError();
        grid = cus;
    }
    if (grid < 0) return;
    (void)hipMemsetAsync((char*)d_ws + WS_CTL, 0, CTL_ZERO_BYTES, stream);
    Args a{};
    for (int i = 0; i < 29; ++i) a.in[i] = (const float*)d_in[i];
    a.out = (float*)d_out; a.ws = (unsigned char*)d_ws;
    constexpr int NPH = 20;
    if (LAUNCH_MODE == 1) { a.ph_lo = 0; a.ph_hi = NPH; hipLaunchKernelGGL(trunk_fwd, dim3(grid), dim3(NTHREADS), LDS_BYTES, stream, a); }
    else for (int p = 0; p < NPH; ++p) { a.ph_lo = p; a.ph_hi = p + 1; hipLaunchKernelGGL(trunk_fwd, dim3(grid), dim3(NTHREADS), LDS_BYTES, stream, a); }
}
```
